# Optimizing an MI355X kernel written in HIP

```python
import jax, jax.numpy as jnp
from jax import lax
import numpy as np

D_MODEL = 2048
BATCH = 4
SEQ = 8192
DEPTH = 1

GRID_W = 64
CTX_LEN = 256
N_Q_HEADS = 16
N_KV_HEADS = 4
HEAD_DIM = 128
ATTN_Q_W = N_Q_HEADS * HEAD_DIM
ATTN_KV_W = N_KV_HEADS * HEAD_DIM
ROPE_THETA = 10000.0
Q_BLOCK = 128
RWKV_HEADS = 16
RWKV_HEAD = 64
RWKV_W = RWKV_HEADS * RWKV_HEAD
W_LORA = 64
A_LORA = 64
G_LORA = 128
RWKV_SPLITS = (RWKV_W, RWKV_W, RWKV_W, W_LORA, W_LORA, A_LORA, A_LORA, G_LORA)
RWKV_IN_W = 3 * RWKV_W + 2 * W_LORA + 2 * A_LORA + G_LORA
IN_SPLITS = (ATTN_Q_W, ATTN_KV_W, ATTN_KV_W, RWKV_IN_W, D_MODEL, D_MODEL)
IN_W = ATTN_Q_W + 2 * ATTN_KV_W + RWKV_IN_W + 2 * D_MODEL
D_FF = 5632
N_MOD = 9
EPS = 1e-6
GN_EPS = 64e-5

kernel_name = "hybrid_gqa_rwkv7_macaron_dit"


def split_cols(t, sizes):
    return jnp.split(t, np.cumsum(sizes)[:-1].tolist(), axis=-1)


def rms_norm(x, g):
    xf = x.astype(jnp.float32)
    y = xf * lax.rsqrt(jnp.mean(xf * xf, axis=-1, keepdims=True) + EPS)
    return y.astype(x.dtype) * g


def modulate(h, shift, scale):
    return h * (1 + scale) + shift


def swiglu(h, w_in, w_out):
    gt, up = jnp.split(h @ w_in, 2, axis=-1)
    return (jax.nn.silu(gt) * up) @ w_out


def ffn_sublayer(x, shift, scale, gate, g, w_in, w_out):
    return x + 0.5 * gate * swiglu(modulate(rms_norm(x, g), shift, scale), w_in, w_out)


def head_rms(t, g):
    tf = t.astype(jnp.float32)
    return (tf * lax.rsqrt(jnp.mean(tf * tf, axis=-1, keepdims=True) + EPS)).astype(t.dtype) * g


def grid_rope_tables(n_tok, dtype):
    rows = n_tok // GRID_W
    row = jnp.repeat(jnp.arange(rows, dtype=jnp.int32), GRID_W)
    col = jnp.tile(jnp.arange(GRID_W, dtype=jnp.int32), rows)
    axis_dim = HEAD_DIM // 2
    inv = ROPE_THETA ** (-jnp.arange(0, axis_dim, 2, dtype=jnp.float32) / axis_dim)
    ang_r = row.astype(jnp.float32)[:, None] * inv[None]
    ang_c = col.astype(jnp.float32)[:, None] * inv[None]
    tab = lambda a: (jnp.cos(a)[None, :, None, :].astype(dtype), jnp.sin(a)[None, :, None, :].astype(dtype))
    return tab(ang_r), tab(ang_c)


def rope_1d(t, cos, sin):
    t1, t2 = jnp.split(t, 2, axis=-1)
    return jnp.concatenate([t1 * cos - t2 * sin, t2 * cos + t1 * sin], axis=-1)


def axial_rope(t, tables):
    (cr, sr), (cc, sc) = tables
    t_row, t_col = jnp.split(t, 2, axis=-1)
    return jnp.concatenate([rope_1d(t_row, cr, sr), rope_1d(t_col, cc, sc)], axis=-1)


def gqa_blocks(q, k, v):
    B, T, _, hd = q.shape
    G = N_Q_HEADS // N_KV_HEADS
    nb = T // Q_BLOCK
    qb = jnp.moveaxis(q.reshape(B, nb, Q_BLOCK, N_KV_HEADS, G, hd), 1, 0)
    scale = hd ** -0.5

    def one(qblk):
        s = jnp.einsum('bqhgd,bkhd->bhgqk', qblk, k, preferred_element_type=jnp.float32) * scale
        p = jax.nn.softmax(s, axis=-1)
        return jnp.einsum('bhgqk,bkhd->bqhgd', p.astype(v.dtype), v)

    o = lax.map(one, qb)
    return jnp.moveaxis(o, 0, 1).reshape(B, T, N_Q_HEADS * hd)


def centered_shift(p):
    prev = jnp.pad(p[:, :-1], ((0, 0), (1, 0), (0, 0)))
    nxt = jnp.pad(p[:, 1:], ((0, 0), (0, 1), (0, 0)))
    return 0.5 * (prev + nxt)


def rwkv_prepare(p, mu, w0, w2, a0, a2, g2, k_k, k_a):
    B, T, _ = p.shape
    p = p + mu * (centered_shift(p) - p)
    r, k, v, lw_f, lw_b, la_f, la_b, lg = split_cols(p, RWKV_SPLITS)
    lw = jnp.stack([lw_f, lw_b])
    la = jnp.stack([la_f, la_b])
    w_raw = (w0[:, None, None, :] + jnp.einsum('zbtr,zrc->zbtc', jnp.tanh(lw), w2)).astype(jnp.float32)
    decay = jnp.exp(-jnp.exp(-jax.nn.softplus(-w_raw) - 0.5))
    a = jax.nn.sigmoid((a0[:, None, None, :] + jnp.einsum('zbtr,zrc->zbtc', la, a2)).astype(jnp.float32))
    g = jax.nn.sigmoid(lg) @ g2
    hs = lambda t: t.reshape(t.shape[:-1] + (RWKV_HEADS, RWKV_HEAD))
    rf, kf, vf = hs(r.astype(jnp.float32)), hs(k.astype(jnp.float32)), hs(v.astype(jnp.float32))
    kk = kf * hs(k_k.astype(jnp.float32))
    kk = kk / jnp.maximum(jnp.sqrt(jnp.sum(kk * kk, axis=-1, keepdims=True)), 1e-12)
    a_h = hs(a)
    k_mod = kf[None] * (1 + (a_h - 1) * hs(k_a.astype(jnp.float32)))
    b = kk[None] * a_h
    return rf, hs(decay), k_mod, vf, kk, b, g


def rwkv_scan(S0, feats, emit):
    rf, decay, k_mod, vf, kk, b, _ = feats
    shared = lambda t: jnp.moveaxis(jnp.stack([t, t[:, ::-1]]), 2, 0)
    perdir = lambda t: jnp.moveaxis(jnp.stack([t[0], t[1][:, ::-1]]), 2, 0)
    xs = (shared(rf), perdir(decay), perdir(k_mod), shared(vf), shared(-kk), perdir(b))

    def step(S, inp):
        r_t, w_t, k_t, v_t, a_t, b_t = inp
        sa = jnp.einsum('zbhvk,zbhk->zbhv', S, a_t)
        S = S * w_t[..., None, :] + sa[..., None] * b_t[..., None, :] + v_t[..., None] * k_t[..., None, :]
        y = jnp.einsum('zbhvk,zbhk->zbhv', S, r_t) if emit else None
        return S, y

    S, ys = lax.scan(step, S0, xs)
    if not emit:
        return S, None
    ys = jnp.moveaxis(ys, 0, 2)
    return S, ys[0] + ys[1][:, ::-1]


def rwkv_output(y, feats, r_k, ln_w, ln_b, dtype):
    rf, _, k_mod, vf, _, _, g = feats
    B, T, H, N = y.shape
    mu = jnp.mean(y, axis=-1, keepdims=True)
    var = jnp.mean(jnp.square(y - mu), axis=-1, keepdims=True)
    yn = ((y - mu) * lax.rsqrt(var + GN_EPS)).reshape(B, T, H * N) * ln_w + ln_b
    bonus = jnp.sum(rf[None] * k_mod * r_k.astype(jnp.float32), axis=(0, -1))[..., None] * vf
    return ((yn + bonus.reshape(B, T, H * N)) * g).astype(dtype)


def merge(ga, gr, attn_o, rwkv_o, w_oa, w_or, w_out):
    return (jax.nn.sigmoid(ga) * (attn_o @ w_oa) + jax.nn.sigmoid(gr) * (rwkv_o @ w_or)) @ w_out


def setup_inputs(seed: int = 0) -> dict:
    key = jax.random.key(seed)
    ks = jax.random.split(key, 36)
    f32 = jnp.float32
    L, D = DEPTH, D_MODEL
    nrm = lambda k, shape, s: jax.random.normal(k, shape, f32) * s
    return {
        "x": nrm(ks[0], (BATCH, SEQ, D), 1.0),
        "c": nrm(ks[1], (BATCH, D), 1.0),
        "ctx": nrm(ks[2], (BATCH, CTX_LEN, D), 1.0),
        "c_ctx": nrm(ks[3], (D,), 1.0),
        "w_mod": nrm(ks[4], (L, D, N_MOD * D), D ** -0.5),
        "b_mod": nrm(ks[5], (L, N_MOD * D), 0.01),
        "norm_ffn1": 1.0 + nrm(ks[6], (L, D), 0.01),
        "ffn1_w_in": nrm(ks[7], (L, D, 2 * D_FF), D ** -0.5),
        "ffn1_w_out": nrm(ks[8], (L, D_FF, D), D_FF ** -0.5),
        "norm_mix": 1.0 + nrm(ks[9], (L, D), 0.01),
        "w_in": nrm(ks[10], (L, D, IN_W), D ** -0.5),
        "q_norm": 1.0 + nrm(ks[11], (L, HEAD_DIM), 0.01),
        "k_norm": 1.0 + nrm(ks[12], (L, HEAD_DIM), 0.01),
        "rwkv_mu": jax.random.uniform(ks[13], (L, RWKV_IN_W), f32),
        "w0": jax.random.uniform(ks[14], (L, 2, RWKV_W), f32, -6.0, -1.0),
        "w2": nrm(ks[15], (L, 2, W_LORA, RWKV_W), 0.5 * W_LORA ** -0.5),
        "a0": nrm(ks[16], (L, 2, RWKV_W), 0.1),
        "a2": nrm(ks[17], (L, 2, A_LORA, RWKV_W), A_LORA ** -0.5),
        "g2": nrm(ks[18], (L, G_LORA, RWKV_W), G_LORA ** -0.5),
        "k_k": 0.85 + nrm(ks[19], (L, RWKV_W), 0.02),
        "k_a": 1.0 + nrm(ks[20], (L, RWKV_W), 0.02),
        "r_k": nrm(ks[21], (L, RWKV_HEADS, RWKV_HEAD), 0.1),
        "ln_x_w": 1.0 + nrm(ks[22], (L, RWKV_W), 0.01),
        "ln_x_b": nrm(ks[23], (L, RWKV_W), 0.01),
        "w_oa": nrm(ks[24], (L, ATTN_Q_W, D), ATTN_Q_W ** -0.5),
        "w_or": nrm(ks[25], (L, RWKV_W, D), RWKV_W ** -0.5),
        "w_out": nrm(ks[26], (L, D, D), D ** -0.5),
        "norm_ffn2": 1.0 + nrm(ks[27], (L, D), 0.01),
        "ffn2_w_in": nrm(ks[28], (L, D, 2 * D_FF), D ** -0.5),
        "ffn2_w_out": nrm(ks[29], (L, D_FF, D), D_FF ** -0.5),
        "norm_final": 1.0 + nrm(ks[30], (D,), 0.01),
    }


def reference(x, c, ctx, c_ctx, w_mod, b_mod, norm_ffn1, ffn1_w_in, ffn1_w_out, norm_mix, w_in,
              q_norm, k_norm, rwkv_mu, w0, w2, a0, a2, g2, k_k, k_a, r_k, ln_x_w, ln_x_b,
              w_oa, w_or, w_out, norm_ffn2, ffn2_w_in, ffn2_w_out, norm_final):
    B, S, D = x.shape
    tables = grid_rope_tables(S, x.dtype)
    cx = ctx
    hs = lambda t, h: t.reshape(t.shape[:-1] + (h, HEAD_DIM))
    for i in range(DEPTH):
        is_last = i == DEPTH - 1
        mod = (jax.nn.silu(c) @ w_mod[i] + b_mod[i]).reshape(B, N_MOD, 1, D)
        mod_c = (jax.nn.silu(c_ctx) @ w_mod[i] + b_mod[i]).reshape(N_MOD, D)

        x = ffn_sublayer(x, mod[:, 0], mod[:, 1], mod[:, 2], norm_ffn1[i], ffn1_w_in[i], ffn1_w_out[i])
        cx = ffn_sublayer(cx, mod_c[0], mod_c[1], mod_c[2], norm_ffn1[i], ffn1_w_in[i], ffn1_w_out[i])

        h = modulate(rms_norm(x, norm_mix[i]), mod[:, 3], mod[:, 4])
        hc = modulate(rms_norm(cx, norm_mix[i]), mod_c[3], mod_c[4])
        q, k, v, p_rw, ga, gr = split_cols(h @ w_in[i], IN_SPLITS)
        qc, kc, vc, p_rw_c, ga_c, gr_c = split_cols(hc @ w_in[i], IN_SPLITS)

        q = axial_rope(head_rms(hs(q, N_Q_HEADS), q_norm[i]), tables)
        k = axial_rope(head_rms(hs(k, N_KV_HEADS), k_norm[i]), tables)
        qc = head_rms(hs(qc, N_Q_HEADS), q_norm[i])
        kc = head_rms(hs(kc, N_KV_HEADS), k_norm[i])
        v, vc = hs(v, N_KV_HEADS), hs(vc, N_KV_HEADS)
        attn_lat = gqa_blocks(q, jnp.concatenate([k, kc], axis=1), jnp.concatenate([v, vc], axis=1))

        rw_args = (rwkv_mu[i], w0[i], w2[i], a0[i], a2[i], g2[i], k_k[i], k_a[i])
        feats_c = rwkv_prepare(p_rw_c, *rw_args)
        S0 = jnp.zeros((2, B, RWKV_HEADS, RWKV_HEAD, RWKV_HEAD), jnp.float32)
        S_ctx, y_c = rwkv_scan(S0, feats_c, emit=not is_last)
        feats = rwkv_prepare(p_rw, *rw_args)
        _, y = rwkv_scan(S_ctx, feats, emit=True)
        rwkv_lat = rwkv_output(y, feats, r_k[i], ln_x_w[i], ln_x_b[i], x.dtype)

        x = x + mod[:, 5] * merge(ga, gr, attn_lat, rwkv_lat, w_oa[i], w_or[i], w_out[i])

        if not is_last:
            attn_c = gqa_blocks(qc, kc, vc)
            rwkv_c = rwkv_output(y_c, feats_c, r_k[i], ln_x_w[i], ln_x_b[i], cx.dtype)
            cx = cx + mod_c[5] * merge(ga_c, gr_c, attn_c, rwkv_c, w_oa[i], w_or[i], w_out[i])
            cx = ffn_sublayer(cx, mod_c[6], mod_c[7], mod_c[8], norm_ffn2[i], ffn2_w_in[i], ffn2_w_out[i])

        x = ffn_sublayer(x, mod[:, 6], mod[:, 7], mod[:, 8], norm_ffn2[i], ffn2_w_in[i], ffn2_w_out[i])

    return rms_norm(x, norm_final)
```

```cpp
#include <hip/hip_runtime.h>
#include <hip/hip_cooperative_groups.h>
#include <cstdio>
#include <cstdint>
namespace cg = cooperative_groups;

#ifndef ONE_LAUNCH
#define ONE_LAUNCH 1
#endif

#define LAS __attribute__((address_space(3)))
typedef unsigned short bf16_t;
typedef short bf16x8 __attribute__((ext_vector_type(8)));
typedef short s16x4 __attribute__((ext_vector_type(4)));
typedef float f32x4 __attribute__((ext_vector_type(4)));
typedef float f32x2 __attribute__((ext_vector_type(2)));
typedef float f32x16 __attribute__((ext_vector_type(16)));
typedef unsigned u32x4 __attribute__((ext_vector_type(4)));
typedef unsigned u32x2 __attribute__((ext_vector_type(2)));

constexpr int DM = 2048, NB = 4, SEQ = 8192, CTXL = 256, MT = NB * SEQ, MC = NB * CTXL, MA = MT + MC;
constexpr int DFF = 5632, SKV = SEQ + CTXL, NMODC = 9 * DM;
constexpr int PRW_LD = 3584, SH_LD = 3072, LIN_LD = 384, LO_LD = 5120;
constexpr int LDS_BYTES = 131072;

constexpr size_t SZ_WA = (size_t)11264 * 2048 * 2, SZ_WB = (size_t)2048 * 5632 * 2;
constexpr size_t OFF_W1A = 0, OFF_W1B = OFF_W1A + SZ_WA, OFF_W2A = OFF_W1B + SZ_WB, OFF_W2B = OFF_W2A + SZ_WA;
constexpr size_t OFF_WRW = OFF_W2B + SZ_WB, OFF_WQKVG = OFF_WRW + (size_t)3584 * 2048 * 2, OFF_WOA = OFF_WQKVG + (size_t)7168 * 2048 * 2;
constexpr size_t OFF_WOR = OFF_WOA + (size_t)2048 * 2048 * 2, OFF_WOUT = OFF_WOR + (size_t)2048 * 1024 * 2, OFF_WLORA = OFF_WOUT + (size_t)2048 * 2048 * 2;
constexpr size_t OFF_MOD = OFF_WLORA + (size_t)5120 * 384 * 2, OFF_CX = OFF_MOD + (size_t)5 * NMODC * 4, OFF_H = OFF_CX + (size_t)MC * DM * 4;
constexpr size_t OFF_BIG = OFF_H + (size_t)MA * DM * 2;
constexpr size_t SZ_KV = (size_t)NB * SKV * 512 * 2;
constexpr size_t OFF_KB = OFF_W1A, OFF_VB = OFF_KB + SZ_KV;
static_assert(OFF_VB + SZ_KV <= OFF_W2A, "KV overlay");
constexpr size_t OFF_ACT = OFF_BIG;
constexpr size_t OFF_PRW = OFF_BIG, OFF_LO = OFF_BIG, OFF_SH = OFF_LO + (size_t)MA * LO_LD * 2, OFF_LIN = OFF_SH + (size_t)MA * SH_LD * 2, OFF_Y = OFF_LIN;
constexpr size_t OFF_Q = OFF_BIG, OFF_GA = OFF_Q + (size_t)MT * DM * 2, OFF_GR = OFF_GA + (size_t)MT * DM * 2;
constexpr size_t END_A = OFF_ACT + (size_t)MA * DFF * 2, END_B = OFF_Y + (size_t)2 * MT * 1024 * 2, END_C = OFF_LIN + (size_t)MA * LIN_LD * 2;
constexpr size_t WS_END = END_A > END_B ? (END_A > END_C ? END_A : END_C) : (END_B > END_C ? END_B : END_C);
static_assert((size_t)MA * PRW_LD * 2 <= (size_t)MA * LO_LD * 2, "PRW under LO");
static_assert(OFF_GR + (size_t)MT * DM * 2 <= OFF_Y, "GR below RWO");

struct Params {
  const float *x, *c, *ctx, *c_ctx, *w_mod, *b_mod, *norm_ffn1, *ffn1_w_in, *ffn1_w_out, *norm_mix, *w_in, *q_norm, *k_norm, *rwkv_mu, *w0, *w2, *a0, *a2,
      *g2, *k_k, *k_a, *r_k, *ln_x_w, *ln_x_b, *w_oa, *w_or, *w_out, *norm_ffn2, *ffn2_w_in, *ffn2_w_out, *norm_final;
  float* out; unsigned char* ws; int ph_lo, ph_hi;
};

__device__ __forceinline__ unsigned cvt_pk_bf16(float lo, float hi) { unsigned r; asm("v_cvt_pk_bf16_f32 %0, %1, %2" : "=v"(r) : "v"(lo), "v"(hi)); return r; }
__device__ __forceinline__ float bf2f(unsigned short b) { return __uint_as_float(((unsigned)b) << 16); }
__device__ __forceinline__ float bflo(unsigned w) { return __uint_as_float(w << 16); }
__device__ __forceinline__ float bfhi(unsigned w) { return __uint_as_float(w & 0xffff0000u); }
__device__ __forceinline__ unsigned short f2bf(float f) { return (unsigned short)(cvt_pk_bf16(f, 0.f) & 0xffffu); }
__device__ __forceinline__ float sigmoidf_(float x) { return __builtin_amdgcn_rcpf(1.f + __builtin_amdgcn_exp2f(-1.4426950408889634f * x)); }
template <int CTRL> __device__ __forceinline__ float dpp_mov(float x) { return __int_as_float(__builtin_amdgcn_update_dpp(0, __float_as_int(x), CTRL, 0xF, 0xF, true)); }
__device__ __forceinline__ float allred16(float x) {
  x += dpp_mov<0xB1>(x); x += dpp_mov<0x4E>(x); x += dpp_mov<0x141>(x); x += dpp_mov<0x140>(x); return x;
}

__device__ __forceinline__ float wave_sum(float v) {
  v = allred16(v);
  { auto rr = __builtin_amdgcn_permlane16_swap(__float_as_uint(v), __float_as_uint(v), false, false); v = __uint_as_float(rr[0]) + __uint_as_float(rr[1]); }
  { auto rr = __builtin_amdgcn_permlane32_swap(__float_as_uint(v), __float_as_uint(v), false, false); v = __uint_as_float(rr[0]) + __uint_as_float(rr[1]); }
  return v;
}

constexpr int BM = 256, BK = 64, HALF = 128, HTB = HALF * BK * 2;
__device__ __forceinline__ int lds_byte(int r, int c) { const int st = (r >> 4) * 2 + (c >> 5), rr = r & 15, cc = c & 31, ob = rr * 64 + cc * 2; return st * 1024 + (ob ^ (((ob >> 9) & 1) << 5)); }
__device__ __forceinline__ void stage_rc(int b, int& R, int& C) { const int st = b / 1024, sb = b % 1024, swz = sb ^ (((sb >> 9) & 1) << 5); R = (st >> 1) * 16 + swz / 64; C = (st & 1) * 32 + (swz % 64) / 2; }
__device__ __forceinline__ int perm32(int rho) { const int n = rho >> 4, i = rho & 15; return 8 * (i >> 2) + 4 * n + (i & 3); }

enum { M_SWIGLU = 0, M_RESID = 1, M_RW = 2, M_QKVG = 3, M_LORA = 4, M_T1 = 5, M_M = 6 };
struct Unit { const char* A; const char* B; int pm, pn, seg; };
struct GemmDesc {
  int K, mode, G, c;
  const bf16_t *A0, *B0; int pm00, nM0, nN0, n0;
  const bf16_t *A1, *B1; int pm01, nN1, n1;
  const float* xin; int gidx; float gscale;
  bf16_t* act;
};
__device__ __forceinline__ bool sched_next(const GemmDesc& d, int i, Unit& u) {
  long L = (long)i * d.G + d.c;
  if (L < d.n0) {
    int wgid = (int)L; const int nwg = d.n0;
    { const int q = nwg / 8, r = nwg % 8, xcd = wgid % 8, off = wgid / 8; wgid = (xcd < r ? xcd * (q + 1) : r * (q + 1) + (xcd - r) * q) + off; }
    const int nig = 8 * d.nN0, gid = wgid / nig, fm = gid * 8, gsz = (d.nM0 - fm) < 8 ? (d.nM0 - fm) : 8;
    const int pm = fm + ((wgid % nig) % gsz), pn = (wgid % nig) / gsz;
    u.pm = d.pm00 + pm; u.pn = pn; u.seg = 0;
    u.A = (const char*)d.A0 + (size_t)u.pm * 512 * d.K; u.B = (const char*)d.B0 + (size_t)pn * 512 * d.K; return true;
  }
  L -= d.n0;
  if (L < d.n1) {
    const int pm = (int)L / d.nN1, pn = (int)L % d.nN1; u.pm = d.pm01 + pm; u.pn = pn; u.seg = 1;
    u.A = (const char*)d.A1 + (size_t)u.pm * 512 * d.K; u.B = (const char*)d.B1 + (size_t)pn * 512 * d.K; return true;
  }
  return false;
}

__device__ __forceinline__ void gemm_epilogue(const f32x4 (&acc)[2][2][4][2], const Unit& u, const GemmDesc& d, const Params& P, int wr, int wc, int fr, int fq) {
  unsigned char* ws = P.ws;
  asm volatile("" : "+v"(fr), "+v"(fq));
  const int rl0 = wr * 64 + fr, cl0 = wc * 32 + 8 * fq;
  switch (d.mode) {
  case M_SWIGLU: {
    bf16_t* base = d.act + (size_t)u.pm * 256 * DFF + u.pn * 128 + cl0;
#pragma unroll
    for (int ai = 0; ai < 2; ++ai)
#pragma unroll
      for (int m = 0; m < 4; ++m) {
        const int row = rl0 + 128 * ai + 16 * m;
        float o[8];
#pragma unroll
        for (int n = 0; n < 2; ++n)
#pragma unroll
          for (int j = 0; j < 4; ++j) { const float g = acc[ai][0][m][n][j], up = acc[ai][1][m][n][j]; o[4 * n + j] = g * sigmoidf_(g) * up; }
        u32x4 w; w.x = cvt_pk_bf16(o[0], o[1]); w.y = cvt_pk_bf16(o[2], o[3]); w.z = cvt_pk_bf16(o[4], o[5]); w.w = cvt_pk_bf16(o[6], o[7]);
        *(u32x4*)(base + (size_t)row * DFF) = w;
      }
  } break;
  case M_RESID: {
    const bool isc = u.pm >= 128; const int b = isc ? 4 : (u.pm >> 5);
    const float* xin = isc ? P.ctx + (size_t)(u.pm - 128) * 256 * DM : d.xin + (size_t)u.pm * 256 * DM;
    float* xo = isc ? (float*)(ws + OFF_CX) + (size_t)(u.pm - 128) * 256 * DM : P.out + (size_t)u.pm * 256 * DM;
    const float* gate = (const float*)(ws + OFF_MOD) + b * NMODC + d.gidx * DM + u.pn * 256 + cl0;
    f32x4 g4[2][2];
#pragma unroll
    for (int bj = 0; bj < 2; ++bj)
#pragma unroll
      for (int n = 0; n < 2; ++n) g4[bj][n] = *(const f32x4*)(gate + 128 * bj + 4 * n) * d.gscale;
#pragma unroll
    for (int ai = 0; ai < 2; ++ai)
#pragma unroll
      for (int m = 0; m < 4; ++m) {
        const size_t ro = (size_t)(rl0 + 128 * ai + 16 * m) * DM + u.pn * 256 + cl0;
#pragma unroll
        for (int bj = 0; bj < 2; ++bj)
#pragma unroll
          for (int n = 0; n < 2; ++n) {
            const f32x4 xv = *(const f32x4*)(xin + ro + 128 * bj + 4 * n);
            *(f32x4*)(xo + ro + 128 * bj + 4 * n) = xv + g4[bj][n] * acc[ai][bj][m][n];
          }
      }
  } break;
  case M_RW: case M_QKVG: case M_LORA: {
    bf16_t* base; int ld; int act = 0; const float* bias = nullptr;
    if (d.mode == M_RW) {
      if (u.seg == 0) { base = (bf16_t*)(ws + OFF_PRW) + (size_t)u.pm * 256 * PRW_LD + u.pn * 256; ld = PRW_LD; }
      else { const int b = u.pm - 128; base = (bf16_t*)(ws + (u.pn < 2 ? OFF_KB : OFF_VB)) + (size_t)(b * SKV + SEQ) * 512 + (u.pn & 1) * 256; ld = 512; }
    } else if (d.mode == M_QKVG) {
      const int b = u.pm >> 5;
      if (u.pn < 8) { base = (bf16_t*)(ws + OFF_Q) + (size_t)u.pm * 256 * DM + u.pn * 256; ld = DM; }
      else if (u.pn < 12) { base = (bf16_t*)(ws + (u.pn < 10 ? OFF_KB : OFF_VB)) + (size_t)(u.pm * 256 + b * CTXL) * 512 + (u.pn & 1) * 256; ld = 512; }
      else { base = (bf16_t*)(ws + (u.pn < 20 ? OFF_GA : OFF_GR)) + (size_t)u.pm * 256 * DM + ((u.pn - 12) & 7) * 256; ld = DM; act = 1; }
    } else {
      base = (bf16_t*)(ws + OFF_LO) + (size_t)u.pm * 256 * LO_LD + u.pn * 256; ld = LO_LD;
      if (u.pn < 8) { act = 2; bias = P.w0 + u.pn * 256; } else if (u.pn < 16) { act = 1; bias = P.a0 + (u.pn - 8) * 256; }
    }
#pragma unroll
    for (int bj = 0; bj < 2; ++bj) {
      f32x4 b0 = {0.f, 0.f, 0.f, 0.f}, b1 = {0.f, 0.f, 0.f, 0.f};
      if (bias) { b0 = *(const f32x4*)(bias + 128 * bj + cl0); b1 = *(const f32x4*)(bias + 128 * bj + cl0 + 4); }
#pragma unroll
      for (int ai = 0; ai < 2; ++ai)
#pragma unroll
        for (int m = 0; m < 4; ++m) {
          const int row = rl0 + 128 * ai + 16 * m;
          f32x4 v0 = acc[ai][bj][m][0] + b0, v1 = acc[ai][bj][m][1] + b1;
          if (act) {
            const float sc = act == 2 ? 0.60653065971263342f * 1.4426950408889634f : 1.f;
#pragma unroll
            for (int j = 0; j < 4; ++j) { v0[j] = sc * sigmoidf_(v0[j]); v1[j] = sc * sigmoidf_(v1[j]); }
          }
          u32x4 w; w.x = cvt_pk_bf16(v0[0], v0[1]); w.y = cvt_pk_bf16(v0[2], v0[3]); w.z = cvt_pk_bf16(v1[0], v1[1]); w.w = cvt_pk_bf16(v1[2], v1[3]);
          *(u32x4*)(base + (size_t)row * ld + 128 * bj + cl0) = w;
        }
    }
  } break;
  case M_T1: case M_M: {
    bf16_t* ga = (bf16_t*)(ws + OFF_GA) + (size_t)u.pm * 256 * DM + u.pn * 256 + cl0;
    bf16_t* gr = (bf16_t*)(ws + OFF_GR) + (size_t)u.pm * 256 * DM + u.pn * 256 + cl0;
    const bool isM = d.mode == M_M;
#pragma unroll
    for (int ai = 0; ai < 2; ++ai)
#pragma unroll
      for (int m = 0; m < 4; ++m)
#pragma unroll
        for (int bj = 0; bj < 2; ++bj) {
          const size_t o = (size_t)(rl0 + 128 * ai + 16 * m) * DM + 128 * bj;
          const f32x4 v0 = acc[ai][bj][m][0], v1 = acc[ai][bj][m][1];
          const u32x4 a = *(const u32x4*)(ga + o);
          u32x4 w;
          if (!isM) {
            w.x = cvt_pk_bf16(bflo(a.x) * v0[0], bfhi(a.x) * v0[1]); w.y = cvt_pk_bf16(bflo(a.y) * v0[2], bfhi(a.y) * v0[3]);
            w.z = cvt_pk_bf16(bflo(a.z) * v1[0], bfhi(a.z) * v1[1]); w.w = cvt_pk_bf16(bflo(a.w) * v1[2], bfhi(a.w) * v1[3]);
            *(u32x4*)(ga + o) = w;
          } else {
            const u32x4 g = *(const u32x4*)(gr + o);
            w.x = cvt_pk_bf16(bflo(a.x) + bflo(g.x) * v0[0], bfhi(a.x) + bfhi(g.x) * v0[1]); w.y = cvt_pk_bf16(bflo(a.y) + bflo(g.y) * v0[2], bfhi(a.y) + bfhi(g.y) * v0[3]);
            w.z = cvt_pk_bf16(bflo(a.z) + bflo(g.z) * v1[0], bfhi(a.z) + bfhi(g.z) * v1[1]); w.w = cvt_pk_bf16(bflo(a.w) + bflo(g.w) * v1[2], bfhi(a.w) + bfhi(g.w) * v1[3]);
            *(u32x4*)(gr + o) = w;
          }
        }
  } break;
  }
}

__device__ __forceinline__ void gemm_phase(LAS unsigned char* lds, const GemmDesc& d, const Params& P, const int tid) {
  const int wid = __builtin_amdgcn_readfirstlane(tid >> 6), lane = tid & 63, wr = wid >> 2, wc = wid & 3, fr = lane & 15, fq = lane >> 4;
  const int K = d.K, nt = K / BK;
  unsigned voffA[2], voffB[2];
#pragma unroll
  for (int i = 0; i < 2; ++i) { int R, C; stage_rc(tid * 16 + i * 8192, R, C); const int Rb = (R & ~31) + perm32(R & 31);
    voffA[i] = (unsigned)(R * K + C) * 2u; voffB[i] = (unsigned)(Rb * K + C) * 2u; }
  const size_t kstep = (size_t)(BK * 2);
  const size_t hstep = (size_t)HALF * K * 2;
  const unsigned ldsw = (unsigned)wid * 1024u;
  const int aoff = lds_byte(wr * 64 + fr, fq * 8), boff = lds_byte(wc * 32 + fr, fq * 8);
#define PG8_SA(b, h) (((b) * 2 + (h)) * HTB)
#define PG8_SB(b, h) ((4 + (b) * 2 + (h)) * HTB)
#define PG8_STAGE(bufoff, gbase, voff) do { _Pragma("unroll") for (int _i = 0; _i < 2; ++_i) \
    __builtin_amdgcn_global_load_lds((const unsigned*)((const char*)(gbase) + (voff)[_i]), (LAS unsigned*)(lds + (bufoff) + ldsw + _i * 8192), 16, 0, 0); } while (0)
#define PG8_LDA(dst, b, h) do { _Pragma("unroll") for (int m = 0; m < 4; ++m) _Pragma("unroll") for (int k = 0; k < 2; ++k) dst[m][k] = *(const LAS bf16x8*)(lds + PG8_SA(b, h) + aoff + m * 2048 + k * 1024); } while (0)
#define PG8_LDB(dst, b, h) do { _Pragma("unroll") for (int n = 0; n < 2; ++n) _Pragma("unroll") for (int k = 0; k < 2; ++k) dst[n][k] = *(const LAS bf16x8*)(lds + PG8_SB(b, h) + boff + n * 2048 + k * 1024); } while (0)
#define PG8_MMA(ai, bj, At, Bt) do { __builtin_amdgcn_s_setprio(1); _Pragma("unroll") for (int m = 0; m < 4; ++m) _Pragma("unroll") for (int n = 0; n < 2; ++n) _Pragma("unroll") for (int k = 0; k < 2; ++k) \
    acc[ai][bj][m][n] = __builtin_amdgcn_mfma_f32_16x16x32_bf16(Bt[n][k], At[m][k], acc[ai][bj][m][n], 0, 0, 0); __builtin_amdgcn_s_setprio(0); } while (0)
#define PG8_WAIT_V(n) asm volatile("s_waitcnt vmcnt(" #n ")" ::: "memory")
#define PG8_WAIT_L(n) asm volatile("s_waitcnt lgkmcnt(" #n ")" ::: "memory")
#define PG8_BAR __builtin_amdgcn_s_barrier()
#define PG8_SCHED __builtin_amdgcn_sched_barrier(0)
  Unit cur, nxt; int ui = 0;
  if (!sched_next(d, 0, cur)) return;
  f32x4 acc[2][2][4][2];
#pragma unroll
  for (int a = 0; a < 2; ++a)
#pragma unroll
    for (int b = 0; b < 2; ++b)
#pragma unroll
      for (int m = 0; m < 4; ++m)
#pragma unroll
        for (int n = 0; n < 2; ++n) acc[a][b][m][n] = (f32x4){0.f, 0.f, 0.f, 0.f};
  bf16x8 At[4][2], B0[2][2], B1[2][2];
  const char* cA = cur.A; const char* cB = cur.B;
  PG8_STAGE(PG8_SB(0, 0), cB, voffB); PG8_STAGE(PG8_SA(0, 0), cA, voffA); PG8_STAGE(PG8_SB(0, 1), cB + hstep, voffB); PG8_STAGE(PG8_SA(0, 1), cA + hstep, voffA);
  if (wr == 1) PG8_BAR;
  PG8_WAIT_V(4); PG8_BAR;
  PG8_STAGE(PG8_SB(1, 0), cB + kstep, voffB); PG8_STAGE(PG8_SA(1, 0), cA + kstep, voffA); PG8_STAGE(PG8_SB(1, 1), cB + hstep + kstep, voffB);
  PG8_WAIT_V(6); PG8_BAR;
  for (;;) {
    const bool has_next = sched_next(d, ui + 1, nxt);
    const char* nA = has_next ? nxt.A : cA; const char* nB = has_next ? nxt.B : cB;
    for (int t = 0; t < nt; t += 2) {
      const bool last = (t == nt - 2);
      const char* a1 = cA + (size_t)(t + 1) * kstep;
      const char* a2 = last ? nA : cA + (size_t)(t + 2) * kstep; const char* b2 = last ? nB : cB + (size_t)(t + 2) * kstep;
      const char* a3 = a2 + kstep; const char* b3 = b2 + kstep;
      PG8_LDB(B0, 0, 0); PG8_SCHED; PG8_LDA(At, 0, 0); PG8_STAGE(PG8_SA(1, 1), a1 + hstep, voffA);
      PG8_WAIT_L(8); PG8_BAR; PG8_WAIT_L(0); PG8_MMA(0, 0, At, B0); PG8_BAR; PG8_SCHED;
      PG8_LDB(B1, 0, 1); PG8_STAGE(PG8_SB(0, 0), b2, voffB);
      PG8_BAR; PG8_WAIT_L(0); PG8_MMA(0, 1, At, B1); PG8_BAR;
      PG8_LDA(At, 0, 1); PG8_STAGE(PG8_SA(0, 0), a2, voffA);
      PG8_BAR; PG8_WAIT_L(0); PG8_MMA(1, 0, At, B0); PG8_BAR; PG8_SCHED;
      PG8_STAGE(PG8_SB(0, 1), b2 + hstep, voffB);
      PG8_WAIT_V(6); PG8_BAR; PG8_MMA(1, 1, At, B1); PG8_BAR;
      PG8_LDB(B0, 1, 0); PG8_SCHED; PG8_LDA(At, 1, 0); PG8_STAGE(PG8_SA(0, 1), a2 + hstep, voffA);
      PG8_WAIT_L(8); PG8_BAR; PG8_WAIT_L(0); PG8_MMA(0, 0, At, B0); PG8_BAR; PG8_SCHED;
      PG8_LDB(B1, 1, 1); PG8_STAGE(PG8_SB(1, 0), b3, voffB);
      PG8_BAR; PG8_WAIT_L(0); PG8_MMA(0, 1, At, B1); PG8_BAR;
      PG8_LDA(At, 1, 1); PG8_STAGE(PG8_SA(1, 0), a3, voffA);
      PG8_BAR; PG8_WAIT_L(0); PG8_MMA(1, 0, At, B0); PG8_BAR; PG8_SCHED;
      PG8_STAGE(PG8_SB(1, 1), b3 + hstep, voffB);
      PG8_WAIT_V(6); PG8_BAR; PG8_MMA(1, 1, At, B1); PG8_BAR;
    }
    gemm_epilogue(acc, cur, d, P, wr, wc, fr, fq);
    if (!has_next) break;
#pragma unroll
    for (int a = 0; a < 2; ++a)
#pragma unroll
      for (int b = 0; b < 2; ++b)
#pragma unroll
        for (int m = 0; m < 4; ++m)
#pragma unroll
          for (int n = 0; n < 2; ++n) acc[a][b][m][n] = (f32x4){0.f, 0.f, 0.f, 0.f};
    cur = nxt; cA = nA; cB = nB; ++ui;
  }
  PG8_WAIT_V(0);
  if (wr == 0) PG8_BAR;
  PG8_BAR;
#undef PG8_SA
#undef PG8_SB
#undef PG8_STAGE
#undef PG8_LDA
#undef PG8_LDB
#undef PG8_MMA
#undef PG8_WAIT_V
#undef PG8_WAIT_L
#undef PG8_BAR
#undef PG8_SCHED
}

namespace att {
constexpr int D = 128, NW = 8, QBLK = 32, KVBLK = 64;
constexpr float SCALE = 0.088388347648318440f;
constexpr float THR = 8.f;
constexpr int LDQ = 2048, LDK = 512, LDO = 2048;
constexpr size_t SHM_V = KVBLK * D * 2, SHM_K = KVBLK * D * 2;
#define KSWZ(row, colB) ((row) * 256 + ((colB) ^ (((row) & 7) << 4)))
#define SBAR() __builtin_amdgcn_sched_barrier(0)
__device__ __forceinline__ int crow(int r, int hi) { return (r & 3) + 8 * (r >> 2) + 4 * hi; }
__device__ __forceinline__ unsigned cvtpk(float lo, float hi) { unsigned r; asm volatile("v_cvt_pk_bf16_f32 %0, %1, %2" : "=v"(r) : "v"(lo), "v"(hi)); return r; }
__device__ __forceinline__ void partialSM(f32x16& p0, f32x16& p1, float& m_reg, float& mn, float& alpha) {
  constexpr float C = SCALE * 1.4426950408889634f;
  float pmax = p0[0];
#pragma unroll
  for (int r = 1; r < 16; ++r) pmax = fmaxf(pmax, p0[r]);
#pragma unroll
  for (int r = 0; r < 16; ++r) pmax = fmaxf(pmax, p1[r]);
  { auto rr = __builtin_amdgcn_permlane32_swap(__float_as_uint(pmax), __float_as_uint(pmax), false, false);
    pmax = fmaxf(__uint_as_float(rr[0]), __uint_as_float(rr[1])); }
  if (__builtin_expect(__all(pmax - m_reg <= THR / SCALE), 1)) { mn = m_reg; alpha = 1.f; }
  else { mn = fmaxf(m_reg, pmax); alpha = __builtin_amdgcn_exp2f((m_reg - mn) * C); m_reg = mn; }
  float mnC = -mn * C;
#pragma unroll
  for (int r = 0; r < 16; ++r) p0[r] = fmaf(p0[r], C, mnC);
#pragma unroll
  for (int r = 0; r < 16; ++r) p1[r] = fmaf(p1[r], C, mnC);
#pragma unroll
  for (int r = 0; r < 16; ++r) p0[r] = __builtin_amdgcn_exp2f(p0[r]);
}
__device__ __forceinline__ void finishSM(f32x16& p0, f32x16& p1, float alpha, float& l_reg, bf16x8& pa0, bf16x8& pa1, bf16x8& pa2, bf16x8& pa3) {
#pragma unroll
  for (int r = 0; r < 16; ++r) p1[r] = __builtin_amdgcn_exp2f(p1[r]);
  float ps = 0;
#pragma unroll
  for (int r = 0; r < 16; ++r) ps += p0[r];
#pragma unroll
  for (int r = 0; r < 16; ++r) ps += p1[r];
  { auto rr = __builtin_amdgcn_permlane32_swap(__float_as_uint(ps), __float_as_uint(ps), false, false);
    ps = __uint_as_float(rr[0]) + __uint_as_float(rr[1]); }
  l_reg = l_reg * alpha + ps;
#define PK4(P, BASE, OUT) do { unsigned a0 = cvtpk(P[BASE + 0], P[BASE + 1]), a1 = cvtpk(P[BASE + 2], P[BASE + 3]);   \
    unsigned b0 = cvtpk(P[BASE + 4], P[BASE + 5]), b1 = cvtpk(P[BASE + 6], P[BASE + 7]);                              \
    auto r0 = __builtin_amdgcn_permlane32_swap(a0, b0, false, false); auto r1 = __builtin_amdgcn_permlane32_swap(a1, b1, false, false); \
    u32x4 w = {r0[0], r1[0], r0[1], r1[1]}; OUT = *reinterpret_cast<bf16x8*>(&w); } while (0)
  PK4(p0, 0, pa0); PK4(p0, 8, pa1); PK4(p1, 0, pa2); PK4(p1, 8, pa3);
#undef PK4
}
__device__ __forceinline__ void qkt(f32x16& p0, f32x16& p1, const bf16_t* Ks, const bf16x8* qr, int r32, int hi) {
  p0 = f32x16{}; p1 = f32x16{};
#pragma unroll
  for (int d0 = 0; d0 < 8; ++d0) { int cb = (d0 * 16 + hi * 8) * 2;
    bf16x8 b0 = *reinterpret_cast<const bf16x8*>((const char*)Ks + KSWZ(r32, cb));
    bf16x8 b1 = *reinterpret_cast<const bf16x8*>((const char*)Ks + KSWZ(32 + r32, cb));
    p0 = __builtin_amdgcn_mfma_f32_32x32x16_bf16(b0, qr[d0], p0, 0, 0, 0);
    p1 = __builtin_amdgcn_mfma_f32_32x32x16_bf16(b1, qr[d0], p1, 0, 0, 0); }
}
__device__ __forceinline__ int v_st(int k, int c) { const int kk = (k & ~0xC) | ((k & 4) << 1) | ((k & 8) >> 1); return ((kk >> 3) * 4 + (c >> 5)) * 512 + ((kk & 7) * 32 + (c & 31)) * 2; }
__device__ __forceinline__ int v_rd_base(int lane) { return ((lane & 3) << 3) | (((lane >> 2) & 3) << 6) | (((lane >> 4) & 1) << 5) | (((lane >> 5) & 1) << 8); }
constexpr int v_rd_off(int d0, int ks, int half) { return d0 * 512 + ks * 4096 + half * 2048; }
template <int OFF> __device__ __forceinline__ s16x4 tr_read(int vb) {
  s16x4 r; asm volatile("ds_read_b64_tr_b16 %0, %1 offset:%2" : "=&v"(r) : "v"(vb), "i"(OFF) : "memory"); return r;
}
template <int D0> __device__ __forceinline__ void pv_one(f32x16& od, int vb, bf16x8 pa0, bf16x8 pa1, bf16x8 pa2, bf16x8 pa3) {
  const s16x4 l0 = tr_read<v_rd_off(D0, 0, 0)>(vb), h0 = tr_read<v_rd_off(D0, 0, 1)>(vb), l1 = tr_read<v_rd_off(D0, 1, 0)>(vb), h1 = tr_read<v_rd_off(D0, 1, 1)>(vb);
  const s16x4 l2 = tr_read<v_rd_off(D0, 2, 0)>(vb), h2 = tr_read<v_rd_off(D0, 2, 1)>(vb), l3 = tr_read<v_rd_off(D0, 3, 0)>(vb), h3 = tr_read<v_rd_off(D0, 3, 1)>(vb);
  asm volatile("s_waitcnt lgkmcnt(0)" ::: "memory"); SBAR();
#define PK(L, H) (bf16x8){L[0], L[1], L[2], L[3], H[0], H[1], H[2], H[3]}
  od = __builtin_amdgcn_mfma_f32_32x32x16_bf16(pa0, PK(l0, h0), od, 0, 0, 0);
  od = __builtin_amdgcn_mfma_f32_32x32x16_bf16(pa1, PK(l1, h1), od, 0, 0, 0);
  od = __builtin_amdgcn_mfma_f32_32x32x16_bf16(pa2, PK(l2, h2), od, 0, 0, 0);
  od = __builtin_amdgcn_mfma_f32_32x32x16_bf16(pa3, PK(l3, h3), od, 0, 0, 0);
#undef PK
}
__device__ __forceinline__ void pv_d0(f32x16* o, int vb, bf16x8 pa0, bf16x8 pa1, bf16x8 pa2, bf16x8 pa3) {
  pv_one<0>(o[0], vb, pa0, pa1, pa2, pa3); pv_one<1>(o[1], vb, pa0, pa1, pa2, pa3); pv_one<2>(o[2], vb, pa0, pa1, pa2, pa3); pv_one<3>(o[3], vb, pa0, pa1, pa2, pa3);
}
__device__ __forceinline__ void attn_dense_body(const bf16_t* __restrict__ Qb, const bf16_t* __restrict__ Kh, const bf16_t* __restrict__ Vh,
                                                bf16_t* __restrict__ Ob, int seq, char* lds, const int tid) {
  const int wid = tid >> 6, lane = tid & 63, r32 = lane & 31, hi = lane >> 5;
  bf16_t* V_lds = (bf16_t*)lds; bf16_t* K_lds = (bf16_t*)(lds + 2 * SHM_V);
  float* wsf = (float*)(lds + 2 * SHM_V + 2 * SHM_K) + wid * 64; float* li_l = wsf; float* al_l = wsf + 32;
  float m_reg = -1e30f, l_reg = 0; f32x16 o[4] = {}; bf16x8 qr[8];
  const bf16_t* Qw = Qb + (long)(wid * QBLK + r32) * LDQ + hi * 8;
#pragma unroll
  for (int d0 = 0; d0 < 8; ++d0) qr[d0] = *reinterpret_cast<const bf16x8*>(Qw + d0 * 16);
  const int sr = tid >> 4, sc = (tid & 15) * 8, vst0 = v_st(sr, sc), vst1 = v_st(32 + sr, sc);
  const int vb0 = (int)(uintptr_t)V_lds + v_rd_base(lane);
  struct { bf16x8 vs0, vs1, ks0, ks1; } sr_[2];
#define LD8(p) (*reinterpret_cast<const bf16x8*>(p))
#define SLOAD(i, k0) do { sr_[i].vs0 = LD8(&Vh[(long)((k0) + sr) * LDK + sc]); sr_[i].vs1 = LD8(&Vh[(long)((k0) + 32 + sr) * LDK + sc]); \
    sr_[i].ks0 = LD8(&Kh[(long)((k0) + sr) * LDK + sc]); sr_[i].ks1 = LD8(&Kh[(long)((k0) + 32 + sr) * LDK + sc]); } while (0)
#define SWRITE(b, i) do { *(bf16x8*)((char*)V_lds + (b) * SHM_V + vst0) = sr_[i].vs0;          \
    *(bf16x8*)((char*)V_lds + (b) * SHM_V + vst1) = sr_[i].vs1; int kc = sc * 2;               \
    *(bf16x8*)((char*)K_lds + (b) * SHM_K + KSWZ(sr, kc)) = sr_[i].ks0;                       \
    *(bf16x8*)((char*)K_lds + (b) * SHM_K + KSWZ(32 + sr, kc)) = sr_[i].ks1; } while (0)
#define SWAIT() asm volatile("s_waitcnt vmcnt(4)" ::: "memory")
#define RESC(a) do { if (__any((a) < 1.f)) { if (hi == 0) al_l[r32] = (a); asm volatile("s_waitcnt lgkmcnt(0)" ::: "memory"); \
    _Pragma("unroll") for (int d = 0; d < 4; ++d) _Pragma("unroll") for (int r = 0; r < 16; ++r) o[d][r] *= al_l[crow(r, hi)]; } } while (0)
  f32x16 pA0, pA1, pB0, pB1; float mnA, mnB, alA, alB; bf16x8 pa0, pa1, pa2, pa3; const int NT = seq / KVBLK;
  constexpr int SE = 0, SO = 1;
  SLOAD(SE, 0); asm volatile("s_waitcnt vmcnt(0)" ::: "memory"); SWRITE(0, SE); __syncthreads();
  qkt(pA0, pA1, K_lds, qr, r32, hi); partialSM(pA0, pA1, m_reg, mnA, alA);
  SLOAD(SO, KVBLK); if (2 < NT) SLOAD(SE, 2 * KVBLK);
  SWAIT(); SWRITE(1, SO); __syncthreads();
  for (int j = 1; j + 1 < NT; j += 2) {
    SBAR(); qkt(pB0, pB1, (bf16_t*)((char*)K_lds + SHM_K), qr, r32, hi);
    finishSM(pA0, pA1, alA, l_reg, pa0, pa1, pa2, pa3); SBAR();
    SLOAD(SO, (j + 2) * KVBLK); SBAR();
    pv_d0(o, vb0, pa0, pa1, pa2, pa3); partialSM(pB0, pB1, m_reg, mnB, alB);
    __syncthreads(); SWAIT(); SWRITE(0, SE);
    RESC(alB); __syncthreads();
    SBAR(); qkt(pA0, pA1, K_lds, qr, r32, hi);
    finishSM(pB0, pB1, alB, l_reg, pa0, pa1, pa2, pa3); SBAR();
    if (j + 3 < NT) SLOAD(SE, (j + 3) * KVBLK); SBAR();
    pv_d0(o, vb0 + (int)SHM_V, pa0, pa1, pa2, pa3); partialSM(pA0, pA1, m_reg, mnA, alA);
    __syncthreads(); SWAIT(); SWRITE(1, SO);
    RESC(alA); __syncthreads();
  }
  SBAR(); qkt(pB0, pB1, (bf16_t*)((char*)K_lds + SHM_K), qr, r32, hi);
  finishSM(pA0, pA1, alA, l_reg, pa0, pa1, pa2, pa3); SBAR();
  pv_d0(o, vb0, pa0, pa1, pa2, pa3); partialSM(pB0, pB1, m_reg, mnB, alB);
  __syncthreads(); RESC(alB);
  finishSM(pB0, pB1, alB, l_reg, pa0, pa1, pa2, pa3); SBAR();
  pv_d0(o, vb0 + (int)SHM_V, pa0, pa1, pa2, pa3);
  if (hi == 0) li_l[r32] = l_reg; asm volatile("s_waitcnt lgkmcnt(0)" ::: "memory");
  float rli[16];
#pragma unroll
  for (int r = 0; r < 16; ++r) rli[r] = __builtin_amdgcn_rcpf(li_l[crow(r, hi)]);
  bf16_t* Ow = Ob + (long)(wid * QBLK) * LDO;
#pragma unroll
  for (int r = 0; r < 16; ++r) { int orow = crow(r, hi);
#pragma unroll
    for (int d0 = 0; d0 < 4; ++d0) Ow[(long)orow * LDO + d0 * 32 + r32] = f2bf(o[d0][r] * rli[r]); }
#undef LD8
#undef SLOAD
#undef SWRITE
#undef SWAIT
#undef RESC
}
}

__device__ __forceinline__ void mod_phase(const Params& P, LAS unsigned char* lds, const int tid) {
  if (blockIdx.x >= 144) return;
  LAS float* sc = (LAS float*)lds; LAS float* red = sc + 5 * 2048;
  const int wid = tid >> 6, lane = tid & 63;
  for (int i = tid; i < 5 * 2048; i += 512) { const int j = i >> 11, k = i & 2047; const float v = (j < 4) ? P.c[j * 2048 + k] : P.c_ctx[k]; sc[i] = v * sigmoidf_(v); }
  __syncthreads();
  float* MOD = (float*)(P.ws + OFF_MOD);
  for (int task = blockIdx.x; task < 144; task += gridDim.x) {
    const int n0 = task * 128 + lane * 2;
    float a0[5], a1[5];
#pragma unroll
    for (int j = 0; j < 5; ++j) { a0[j] = 0.f; a1[j] = 0.f; }
    const float* wp = P.w_mod + (size_t)(wid * 256) * NMODC + n0;
#pragma unroll 8
    for (int k = 0; k < 256; ++k) {
      const f32x2 w = *(const f32x2*)(wp + (size_t)k * NMODC);
#pragma unroll
      for (int j = 0; j < 5; ++j) { const float s = sc[j * 2048 + wid * 256 + k]; a0[j] += s * w.x; a1[j] += s * w.y; }
    }
#pragma unroll
    for (int j = 0; j < 5; ++j) { red[(wid * 5 + j) * 128 + lane * 2] = a0[j]; red[(wid * 5 + j) * 128 + lane * 2 + 1] = a1[j]; }
    __syncthreads();
    for (int o = tid; o < 640; o += 512) { const int j = o >> 7, ci = o & 127; float s = 0.f;
#pragma unroll
      for (int w = 0; w < 8; ++w) s += red[(w * 5 + j) * 128 + ci];
      MOD[j * NMODC + task * 128 + ci] = s + P.b_mod[task * 128 + ci]; }
    __syncthreads();
  }
}
__device__ __forceinline__ void tr_item(const float* __restrict__ W, int ldw, int k0, int n0, bf16_t* __restrict__ WT, int ldt, int drow0, int dk0, LAS float* scr, int lane) {
#pragma unroll 8
  for (int i = 0; i < 32; ++i) { const int kk = 2 * i + (lane >> 5); scr[kk * 33 + (lane & 31)] = W[(size_t)(k0 + kk) * ldw + n0 + (lane & 31)]; }
  asm volatile("s_waitcnt lgkmcnt(0)" ::: "memory");
  const int c = lane & 7;
#pragma unroll
  for (int j = 0; j < 4; ++j) { const int n = (lane >> 3) + 8 * j; const LAS float* s = scr + (8 * c) * 33 + n;
    u32x4 o; o.x = cvt_pk_bf16(s[0 * 33], s[1 * 33]); o.y = cvt_pk_bf16(s[2 * 33], s[3 * 33]); o.z = cvt_pk_bf16(s[4 * 33], s[5 * 33]); o.w = cvt_pk_bf16(s[6 * 33], s[7 * 33]);
    *(u32x4*)(WT + (size_t)(drow0 + n) * ldt + dk0 + k0 + 8 * c) = o; }
  asm volatile("s_waitcnt lgkmcnt(0)" ::: "memory");
}
__device__ __forceinline__ void convert_phase(const Params& P, LAS unsigned char* lds, const int tid) {
  const int wid = tid >> 6, lane = tid & 63;
  LAS float* scr = (LAS float*)(lds + wid * 8704);
  unsigned char* ws = P.ws;
  bf16_t *W1A = (bf16_t*)(ws + OFF_W1A), *W1B = (bf16_t*)(ws + OFF_W1B), *W2A = (bf16_t*)(ws + OFF_W2A), *W2B = (bf16_t*)(ws + OFF_W2B);
  bf16_t *WRW = (bf16_t*)(ws + OFF_WRW), *WQKVG = (bf16_t*)(ws + OFF_WQKVG), *WOA = (bf16_t*)(ws + OFF_WOA), *WOR = (bf16_t*)(ws + OFF_WOR), *WOUT = (bf16_t*)(ws + OFF_WOUT), *WLORA = (bf16_t*)(ws + OFF_WLORA);
  const int G = gridDim.x, gw = (G - 1 - (int)blockIdx.x) * 8 + wid, NGW = G * 8;
  constexpr int NITEMS = 22528 + 11264 + 3456 + 7168 + 2048 + 1024 + 2048 + 192;
  for (int it = gw; it < NITEMS; it += NGW) {
    int r = it;
    if (r < 22528) { const int which = r >= 11264; r -= which * 11264; const int kb = r / 352, nb = r % 352, n0 = nb * 32;
      const int drow = n0 < DFF ? (n0 >> 7) * 256 + (n0 & 127) : ((n0 - DFF) >> 7) * 256 + 128 + ((n0 - DFF) & 127);
      tr_item(which ? P.ffn2_w_in : P.ffn1_w_in, 2 * DFF, kb * 64, n0, which ? W2A : W1A, 2048, drow, 0, scr, lane); continue; }
    r -= 22528;
    if (r < 11264) { const int which = r >= 5632; r -= which * 5632; const int kb = r >> 6, nb = r & 63;
      tr_item(which ? P.ffn2_w_out : P.ffn1_w_out, 2048, kb * 64, nb * 32, which ? W2B : W1B, DFF, nb * 32, 0, scr, lane); continue; }
    r -= 11264;
    if (r < 3456) { const int kb = r / 108, nb = r % 108; tr_item(P.w_in, 10624, kb * 64, 3072 + nb * 32, WRW, 2048, nb * 32, 0, scr, lane); continue; }
    r -= 3456;
    if (r < 7168) { const int kb = r / 224, nb = r % 224; const int n0 = nb < 96 ? nb * 32 : 6528 + (nb - 96) * 32;
      tr_item(P.w_in, 10624, kb * 64, n0, WQKVG, 2048, nb * 32, 0, scr, lane); continue; }
    r -= 7168;
    if (r < 2048) { tr_item(P.w_oa, 2048, (r >> 6) * 64, (r & 63) * 32, WOA, 2048, (r & 63) * 32, 0, scr, lane); continue; }
    r -= 2048;
    if (r < 1024) { tr_item(P.w_or, 2048, (r >> 6) * 64, (r & 63) * 32, WOR, 1024, (r & 63) * 32, 0, scr, lane); continue; }
    r -= 1024;
    if (r < 2048) { tr_item(P.w_out, 2048, (r >> 6) * 64, (r & 63) * 32, WOUT, 2048, (r & 63) * 32, 0, scr, lane); continue; }
    r -= 2048;
    if (r < 64) { const int z = r >> 5, nb = r & 31; tr_item(P.w2 + (size_t)z * 64 * 1024, 1024, 0, nb * 32, WLORA, LIN_LD, z * 1024 + nb * 32, z * 64, scr, lane); continue; }
    r -= 64;
    if (r < 64) { const int z = r >> 5, nb = r & 31; tr_item(P.a2 + (size_t)z * 64 * 1024, 1024, 0, nb * 32, WLORA, LIN_LD, 2048 + z * 1024 + nb * 32, 128 + z * 64, scr, lane); continue; }
    r -= 64;
    { const int kb = r >> 5, nb = r & 31; tr_item(P.g2, 1024, kb * 64, nb * 32, WLORA, LIN_LD, 4096 + nb * 32, 256, scr, lane); }
  }
  const int gt = blockIdx.x * 512 + tid, NT = G * 512;
  unsigned zz = 0u; asm volatile("" : "+v"(zz));
  const u32x4 z4 = {zz, zz, zz, zz};
  for (int i = gt; i < 128 * 256; i += NT) *(u32x4*)(WRW + (size_t)3456 * 2048 + (size_t)i * 8) = z4;
  for (int i = gt; i < 5120 * 48; i += NT) { const int row = i / 48, kc = (i % 48) * 8, rb = row >> 10;
    const int lo = rb < 4 ? rb * 64 : 256, hi = rb < 4 ? rb * 64 + 64 : 384;
    if (kc < lo || kc >= hi) *(u32x4*)(WLORA + (size_t)row * LIN_LD + kc) = z4; }
}
__device__ __forceinline__ void norm_mod_phase(const Params& P, const float* lat, const float* ctxp, int nrows, const float* g, int midx, const int tid) {
  const int wid = tid >> 6, lane = tid & 63;
  const int gw = blockIdx.x * 8 + wid, NGW = gridDim.x * 8;
  const float* MOD = (const float*)(P.ws + OFF_MOD); bf16_t* H = (bf16_t*)(P.ws + OFF_H);
  for (int r = gw; r < nrows; r += NGW) {
    const float* xr = r < MT ? lat + (size_t)r * DM : ctxp + (size_t)(r - MT) * DM;
    const int b = r < MT ? (r >> 13) : 4;
    const float* sh = MOD + b * NMODC + midx * DM; const float* scp = sh + DM;
    f32x4 v[8]; float ss = 0.f;
#pragma unroll
    for (int j = 0; j < 8; ++j) { v[j] = *(const f32x4*)(xr + j * 256 + lane * 4); ss += v[j].x * v[j].x + v[j].y * v[j].y + v[j].z * v[j].z + v[j].w * v[j].w; }
    ss = wave_sum(ss);
    const float rs = rsqrtf(ss * (1.f / DM) + 1e-6f);
#pragma unroll
    for (int j = 0; j < 8; ++j) { const int c = j * 256 + lane * 4;
      const f32x4 g4 = *(const f32x4*)(g + c), s4 = *(const f32x4*)(sh + c), c4 = *(const f32x4*)(scp + c);
      const f32x4 y = v[j] * rs * g4; const f32x4 h = y * (c4 + 1.f) + s4;
      u32x2 w; w.x = cvt_pk_bf16(h.x, h.y); w.y = cvt_pk_bf16(h.z, h.w);
      *(u32x2*)(H + (size_t)r * DM + c) = w; }
  }
}
__device__ __forceinline__ void shift_phase(const Params& P, const int tid) {
  const bf16_t* PRW = (const bf16_t*)(P.ws + OFF_PRW); bf16_t* SH = (bf16_t*)(P.ws + OFF_SH); bf16_t* LIN = (bf16_t*)(P.ws + OFF_LIN);
  const int gt = blockIdx.x * 512 + tid, NT = gridDim.x * 512;
  for (int idx = gt; idx < MA * 432; idx += NT) {
    const int r = idx / 432, c = (idx % 432) * 8;
    bool first, last;
    if (r < MT) { const int t = r & (SEQ - 1); first = t == 0; last = t == SEQ - 1; } else { const int t = (r - MT) & (CTXL - 1); first = t == 0; last = t == CTXL - 1; }
    const u32x4 z4 = {0u, 0u, 0u, 0u};
    const u32x4 p = *(const u32x4*)(PRW + (size_t)r * PRW_LD + c);
    const u32x4 pv = first ? z4 : *(const u32x4*)(PRW + (size_t)(r - 1) * PRW_LD + c);
    const u32x4 nx = last ? z4 : *(const u32x4*)(PRW + (size_t)(r + 1) * PRW_LD + c);
    const f32x4 m0 = *(const f32x4*)(P.rwkv_mu + c), m1 = *(const f32x4*)(P.rwkv_mu + c + 4);
    float o[8];
#define SHF(e, W, MU, HI) { const float pp = HI ? bfhi(p.W) : bflo(p.W), a = HI ? bfhi(pv.W) : bflo(pv.W), b = HI ? bfhi(nx.W) : bflo(nx.W); o[e] = pp + MU * (0.5f * (a + b) - pp); }
    SHF(0, x, m0.x, 0) SHF(1, x, m0.y, 1) SHF(2, y, m0.z, 0) SHF(3, y, m0.w, 1) SHF(4, z, m1.x, 0) SHF(5, z, m1.y, 1) SHF(6, w, m1.z, 0) SHF(7, w, m1.w, 1)
#undef SHF
    bf16_t* dst;
    if (c < 3072) dst = SH + (size_t)r * SH_LD + c;
    else { const int cl = c - 3072; dst = LIN + (size_t)r * LIN_LD + cl;
      if (cl < 128) {
#pragma unroll
        for (int e = 0; e < 8; ++e) { const float ex = __builtin_amdgcn_exp2f(2.8853900817779268f * o[e]); o[e] = 1.f - 2.f * __builtin_amdgcn_rcpf(ex + 1.f); }
      } else if (cl >= 256) {
#pragma unroll
        for (int e = 0; e < 8; ++e) o[e] = sigmoidf_(o[e]);
      } }
    u32x4 w; w.x = cvt_pk_bf16(o[0], o[1]); w.y = cvt_pk_bf16(o[2], o[3]); w.z = cvt_pk_bf16(o[4], o[5]); w.w = cvt_pk_bf16(o[6], o[7]);
    *(u32x4*)dst = w;
  }
}
__device__ __forceinline__ void scan_phase(const Params& P, LAS unsigned char* lds, const int tid) {
  LAS float* F = (LAS float*)lds;
  LAS unsigned short* YB = (LAS unsigned short*)(lds + 2 * 32 * 384 * 4);
  const bf16_t* SH = (const bf16_t*)(P.ws + OFF_SH); const bf16_t* LO = (const bf16_t*)(P.ws + OFF_LO); bf16_t* Y = (bf16_t*)(P.ws + OFF_Y);
  const int wid = tid >> 6, lane = tid & 63;
  constexpr int NCH = SKV / 32;
  for (int task = blockIdx.x; task < 256; task += gridDim.x) {
    const int half = (task >> 3) & 1, chain = (task & 7) | ((task >> 4) << 3);
    const int dir = chain & 1, h = (chain >> 1) & 15, b = chain >> 5, hc = h * 64;
    const float kk_c = P.k_k[hc + lane], ka_c = P.k_a[hc + lane];
    const int i_loc = wid * 4 + (lane >> 4), irow = half * 32 + i_loc, c0 = (lane & 15) * 4;
    f32x4 S = {0.f, 0.f, 0.f, 0.f};
    unsigned short sr[4], sk[4], sv[4], sl[4], sa[4];
#define ROWOF(g) ((g) < CTXL ? (MT + b * CTXL + (dir ? CTXL - 1 - (g) : (g))) : (b * SEQ + (dir ? SEQ - 1 - ((g) - CTXL) : ((g) - CTXL))))
#define SLOADQ(q) do { _Pragma("unroll") for (int e = 0; e < 4; ++e) { const int g_ = (q) * 32 + wid * 4 + e; const size_t row = (size_t)ROWOF(g_); \
      const bf16_t* ps = SH + row * SH_LD + hc + lane; const bf16_t* pl = LO + row * LO_LD + dir * 1024 + hc + lane; \
      sr[e] = ps[0]; sk[e] = ps[1024]; sv[e] = ps[2048]; sl[e] = pl[0]; sa[e] = pl[2048]; } } while (0)
#define SWRITEQ(buf) do { _Pragma("unroll") for (int e = 0; e < 4; ++e) { LAS float* f_ = F + ((buf) * 32 + wid * 4 + e) * 384 + lane; \
      const float r_ = bf2f(sr[e]), k_ = bf2f(sk[e]), v_ = bf2f(sv[e]), lam = bf2f(sl[e]), aa = bf2f(sa[e]); \
      const float kkr = k_ * kk_c; const float ssq = wave_sum(kkr * kkr); const float kk = kkr * rsqrtf(fmaxf(ssq, 1e-24f)); \
      f_[0] = __builtin_amdgcn_exp2f(-lam); f_[64] = -kk; f_[128] = kk * aa; f_[192] = k_ * (1.f + (aa - 1.f) * ka_c); f_[256] = r_; f_[320] = v_; } } while (0)
    SLOADQ(0); SWRITEQ(0); __syncthreads();
    for (int q = 0; q < NCH; ++q) {
      if (q + 1 < NCH) SLOADQ(q + 1);
      const LAS float* f = F + (q & 1) * 32 * 384;
      LAS unsigned short* yb = YB + (q & 1) * 1024;
#pragma unroll 4
      for (int s = 0; s < 32; ++s) {
        const LAS float* fs = f + s * 384;
        const f32x4 w4 = *(const LAS f32x4*)(fs + c0), a4 = *(const LAS f32x4*)(fs + 64 + c0), b4 = *(const LAS f32x4*)(fs + 128 + c0);
        const f32x4 k4 = *(const LAS f32x4*)(fs + 192 + c0), r4 = *(const LAS f32x4*)(fs + 256 + c0);
        const float vv = fs[320 + irow];
        float sa_ = (S.x * a4.x + S.y * a4.y) + (S.z * a4.z + S.w * a4.w);
        sa_ = allred16(sa_);
        S = S * w4 + (b4 * sa_ + k4 * vv);
        float y = (S.x * r4.x + S.y * r4.y) + (S.z * r4.z + S.w * r4.w);
        y = allred16(y);
        if ((lane & 15) == 0) yb[s * 32 + i_loc] = f2bf(y);
      }
      if (q + 1 < NCH) SWRITEQ((q + 1) & 1);
      __syncthreads();
      if (q >= 8) {
        const int s = tid >> 4, rp = (tid & 15) * 2; const int u = q * 32 + s - CTXL; const int t = dir ? SEQ - 1 - u : u;
        const unsigned val = *(const LAS unsigned*)(yb + s * 32 + rp);
        *(unsigned*)(Y + (size_t)dir * MT * 1024 + (size_t)(b * SEQ + t) * 1024 + hc + half * 32 + rp) = val;
      }
    }
    __syncthreads();
#undef ROWOF
#undef SLOADQ
#undef SWRITEQ
  }
}
__device__ __forceinline__ void rwkv_out_phase(const Params& P, const int tid) {
  const bf16_t* SH = (const bf16_t*)(P.ws + OFF_SH); const bf16_t* LO = (const bf16_t*)(P.ws + OFF_LO); bf16_t* Y = (bf16_t*)(P.ws + OFF_Y);
  const int wid = tid >> 6, lane = tid & 63;
  const int gw = blockIdx.x * 8 + wid, NGW = gridDim.x * 8;
  for (int task = gw; task < MT * 16; task += NGW) {
    const int tok = task >> 4, h = task & 15, c = h * 64 + lane;
    const float yf = bf2f(Y[(size_t)tok * 1024 + c]), ybk = bf2f(Y[(size_t)MT * 1024 + (size_t)tok * 1024 + c]);
    const float y = yf + ybk;
    const float mu = wave_sum(y) * (1.f / 64.f); const float dv = y - mu; const float var = wave_sum(dv * dv) * (1.f / 64.f);
    const float yn = dv * rsqrtf(var + 64e-5f) * P.ln_x_w[c] + P.ln_x_b[c];
    const bf16_t* ps = SH + (size_t)tok * SH_LD + c; const bf16_t* pl = LO + (size_t)tok * LO_LD + c;
    const float r = bf2f(ps[0]), k = bf2f(ps[1024]), v = bf2f(ps[2048]), af = bf2f(pl[2048]), ab = bf2f(pl[3072]), g = bf2f(pl[4096]);
    const float ka = P.k_a[c];
    const float kms = k * (1.f + (af - 1.f) * ka) + k * (1.f + (ab - 1.f) * ka);
    const float bonus = wave_sum(r * kms * P.r_k[c]);
    Y[(size_t)tok * 1024 + c] = f2bf((yn + bonus * v) * g);
  }
}
__device__ __forceinline__ void rope_phase(const Params& P, const int tid) {
  bf16_t* Q = (bf16_t*)(P.ws + OFF_Q); bf16_t* KB = (bf16_t*)(P.ws + OFF_KB);
  const int wid = tid >> 6, lane = tid & 63;
  const int gw = blockIdx.x * 8 + wid, NGW = gridDim.x * 8;
  const int d1 = lane + (lane >= 32 ? 32 : 0), d2 = d1 + 32;
  const float qg1 = P.q_norm[d1], qg2 = P.q_norm[d2], kg1 = P.k_norm[d1], kg2 = P.k_norm[d2];
  const float inv = __builtin_amdgcn_exp2f(-(float)(2 * (lane & 31)) * (13.287712379549449f / 64.f));
  for (int task = gw; task < MA; task += NGW) {
    if (task < MT) {
      const int tok = task, b = tok >> 13, t = tok & (SEQ - 1);
      const int pos = lane < 32 ? (t >> 6) : (t & 63);
      const float ang = (float)pos * inv;
      const float sn = __sinf(ang), cs = __cosf(ang);
#pragma unroll 4
      for (int hd = 0; hd < 20; ++hd) {
        bf16_t* p = hd < 16 ? Q + (size_t)tok * DM + hd * 128 : KB + (size_t)(tok + b * CTXL) * 512 + (hd - 16) * 128;
        const float g1 = hd < 16 ? qg1 : kg1, g2 = hd < 16 ? qg2 : kg2;
        const float t1 = bf2f(p[d1]), t2 = bf2f(p[d2]);
        const float ss = wave_sum(t1 * t1 + t2 * t2); const float rs = rsqrtf(ss * (1.f / 128.f) + 1e-6f);
        const float n1 = t1 * rs * g1, n2 = t2 * rs * g2;
        p[d1] = f2bf(n1 * cs - n2 * sn); p[d2] = f2bf(n2 * cs + n1 * sn);
      }
    } else {
      const int ct = task - MT, b = ct >> 8, t = ct & (CTXL - 1);
#pragma unroll
      for (int hd = 0; hd < 4; ++hd) {
        bf16_t* p = KB + (size_t)(b * SKV + SEQ + t) * 512 + hd * 128;
        const float t1 = bf2f(p[d1]), t2 = bf2f(p[d2]);
        const float ss = wave_sum(t1 * t1 + t2 * t2); const float rs = rsqrtf(ss * (1.f / 128.f) + 1e-6f);
        p[d1] = f2bf(t1 * rs * kg1); p[d2] = f2bf(t2 * rs * kg2);
      }
    }
  }
}
__device__ __forceinline__ void attn_phase(const Params& P, unsigned char* smem, const int tid) {
  bf16_t* Q = (bf16_t*)(P.ws + OFF_Q); const bf16_t* KB = (const bf16_t*)(P.ws + OFF_KB); const bf16_t* VB = (const bf16_t*)(P.ws + OFF_VB);
  for (int u = blockIdx.x; u < 2048; u += gridDim.x) {
    const int xcd = u & 7, slot = (u >> 3) & 31, rnd = u >> 8, pair = xcd + 8 * (rnd >> 2), w = (rnd & 3) * 32 + slot;
    const int b = pair >> 2, kvh = pair & 3, g = w & 3, qb = w >> 2, head = kvh * 4 + g;
    bf16_t* Qb = Q + (size_t)(b * SEQ + qb * 256) * DM + head * 128;
    const bf16_t* Kh = KB + (size_t)b * SKV * 512 + kvh * 128; const bf16_t* Vh = VB + (size_t)b * SKV * 512 + kvh * 128;
    att::attn_dense_body(Qb, Kh, Vh, Qb, SKV, (char*)smem, tid);
    __syncthreads();
  }
}
__device__ __forceinline__ void final_norm_phase(const Params& P, const int tid) {
  const int wid = tid >> 6, lane = tid & 63;
  const int gw = blockIdx.x * 8 + wid, NGW = gridDim.x * 8;
  for (int r = gw; r < MT; r += NGW) {
    float* xr = P.out + (size_t)r * DM;
    f32x4 v[8]; float ss = 0.f;
#pragma unroll
    for (int j = 0; j < 8; ++j) { v[j] = *(const f32x4*)(xr + j * 256 + lane * 4); ss += v[j].x * v[j].x + v[j].y * v[j].y + v[j].z * v[j].z + v[j].w * v[j].w; }
    ss = wave_sum(ss);
    const float rs = rsqrtf(ss * (1.f / DM) + 1e-6f);
#pragma unroll
    for (int j = 0; j < 8; ++j) { const int c = j * 256 + lane * 4; *(f32x4*)(xr + c) = v[j] * rs * *(const f32x4*)(P.norm_final + c); }
  }
}

constexpr int NPH = 20;
__device__ __forceinline__ bool gemm_desc(int ph, const Params& P, GemmDesc& d) {
  unsigned char* ws = P.ws;
  const bf16_t* H = (const bf16_t*)(ws + OFF_H);
  d.G = gridDim.x; d.c = blockIdx.x; d.A1 = nullptr; d.B1 = nullptr; d.pm01 = 0; d.nN1 = 1; d.n1 = 0; d.pm00 = 0; d.xin = nullptr; d.gidx = 0; d.gscale = 0.f; d.act = nullptr;
  switch (ph) {
  case 2: d.K = 2048; d.mode = M_SWIGLU; d.A0 = H; d.B0 = (const bf16_t*)(ws + OFF_W1A); d.nM0 = 132; d.nN0 = 44; d.act = (bf16_t*)(ws + OFF_ACT); break;
  case 3: d.K = DFF; d.mode = M_RESID; d.A0 = (const bf16_t*)(ws + OFF_ACT); d.B0 = (const bf16_t*)(ws + OFF_W1B); d.nM0 = 132; d.nN0 = 8; d.xin = P.x; d.gidx = 2; d.gscale = 0.5f; break;
  case 5: d.K = 2048; d.mode = M_RW; d.A0 = H; d.B0 = (const bf16_t*)(ws + OFF_WRW); d.nM0 = 132; d.nN0 = 14;
          d.A1 = H; d.B1 = (const bf16_t*)(ws + OFF_WQKVG) + (size_t)2048 * 2048; d.pm01 = 128; d.nN1 = 4; d.n1 = 16; break;
  case 7: d.K = 384; d.mode = M_LORA; d.A0 = (const bf16_t*)(ws + OFF_LIN); d.B0 = (const bf16_t*)(ws + OFF_WLORA); d.nM0 = 132; d.nN0 = 20; break;
  case 10: d.K = 2048; d.mode = M_QKVG; d.A0 = H; d.B0 = (const bf16_t*)(ws + OFF_WQKVG); d.nM0 = 128; d.nN0 = 28; break;
  case 13: d.K = 2048; d.mode = M_T1; d.A0 = (const bf16_t*)(ws + OFF_Q); d.B0 = (const bf16_t*)(ws + OFF_WOA); d.nM0 = 128; d.nN0 = 8; break;
  case 14: d.K = 1024; d.mode = M_M; d.A0 = (const bf16_t*)(ws + OFF_Y); d.B0 = (const bf16_t*)(ws + OFF_WOR); d.nM0 = 128; d.nN0 = 8; break;
  case 15: d.K = 2048; d.mode = M_RESID; d.A0 = (const bf16_t*)(ws + OFF_GR); d.B0 = (const bf16_t*)(ws + OFF_WOUT); d.nM0 = 128; d.nN0 = 8; d.xin = P.out; d.gidx = 5; d.gscale = 1.f; break;
  case 17: d.K = 2048; d.mode = M_SWIGLU; d.A0 = H; d.B0 = (const bf16_t*)(ws + OFF_W2A); d.nM0 = 128; d.nN0 = 44; d.act = (bf16_t*)(ws + OFF_ACT); break;
  case 18: d.K = DFF; d.mode = M_RESID; d.A0 = (const bf16_t*)(ws + OFF_ACT); d.B0 = (const bf16_t*)(ws + OFF_W2B); d.nM0 = 128; d.nN0 = 8; d.xin = P.out; d.gidx = 8; d.gscale = 0.5f; break;
  default: return false;
  }
  d.n0 = d.nM0 * d.nN0;
  return true;
}

__global__ void __launch_bounds__(512) mega_fwd(Params P) {
  extern __shared__ __attribute__((aligned(16))) unsigned char smem[];
  LAS unsigned char* lds = (LAS unsigned char*)smem;
  cg::grid_group grid = cg::this_grid();
#pragma nounroll
  for (int ph = P.ph_lo; ph < P.ph_hi; ++ph) {
    GemmDesc d;
    int tid = threadIdx.x; asm volatile("" : "+v"(tid));
    Params L = P; asm volatile("" : "+s"(L.ws), "+s"(L.out));
    if (gemm_desc(ph, L, d)) gemm_phase(lds, d, L, tid);
    else switch (ph) {
      case 0: mod_phase(L, lds, tid); __syncthreads(); convert_phase(L, lds, tid); break;
      case 1: norm_mod_phase(L, L.x, L.ctx, MA, L.norm_ffn1, 0, tid); break;
      case 4: norm_mod_phase(L, L.out, (const float*)(L.ws + OFF_CX), MA, L.norm_mix, 3, tid); break;
      case 6: shift_phase(L, tid); break;
      case 8: scan_phase(L, lds, tid); break;
      case 9: rwkv_out_phase(L, tid); break;
      case 11: rope_phase(L, tid); break;
      case 12: attn_phase(L, smem, tid); break;
      case 16: norm_mod_phase(L, L.out, nullptr, MT, L.norm_ffn2, 6, tid); break;
      case 19: final_norm_phase(L, tid); break;
      default: break;
    }
    if (ph + 1 < P.ph_hi) grid.sync();
  }
}

extern "C" void kernel_launch(void* const* d_in, const int* in_sizes, int n_in, void* d_out, int out_size, void* d_ws, size_t ws_size, hipStream_t stream) {
  static int grid_blocks = 0;
  if (!grid_blocks) {
    if (n_in != 31 || out_size != MT * DM || ws_size < WS_END) { fprintf(stderr, "kernel_launch: unexpected shapes n_in %d out %d ws %zu (need %zu)\n", n_in, out_size, ws_size, WS_END); return; }
    if (hipFuncSetAttribute((const void*)mega_fwd, hipFuncAttributeMaxDynamicSharedMemorySize, LDS_BYTES) != hipSuccess) { fprintf(stderr, "kernel_launch: hipFuncSetAttribute failed\n"); return; }
    int dev = 0, cus = 0, per_cu = 0;
    hipGetDevice(&dev);
    hipDeviceGetAttribute(&cus, hipDeviceAttributeMultiprocessorCount, dev);
    hipOccupancyMaxActiveBlocksPerMultiprocessor(&per_cu, mega_fwd, 512, LDS_BYTES);
    if (per_cu < 1) { fprintf(stderr, "kernel_launch: occupancy query returned %d\n", per_cu); per_cu = 1; }
    grid_blocks = cus;
  }
  Params p{};
  const float** pf = (const float**)&p;
  for (int i = 0; i < 31; ++i) pf[i] = (const float*)d_in[i];
  p.out = (float*)d_out; p.ws = (unsigned char*)d_ws;
#if ONE_LAUNCH
  p.ph_lo = 0; p.ph_hi = NPH;
  void* args[] = {&p};
  hipError_t e = hipLaunchCooperativeKernel((const void*)mega_fwd, dim3(grid_blocks), dim3(512), args, LDS_BYTES, stream);
  if (e != hipSuccess) fprintf(stderr, "cooperative launch failed: %s (grid %d)\n", hipGetErrorString(e), grid_blocks);
#else
  for (int ph = 0; ph < NPH; ++ph) { p.ph_lo = ph; p.ph_hi = ph + 1; hipLaunchKernelGGL(mega_fwd, dim3(grid_blocks), dim3(512), LDS_BYTES, stream, p); }
#endif
}
```

```cpp
#include <hip/hip_runtime.h>
#include <hip/hip_cooperative_groups.h>
#include <cstdio>
#include <cstdint>
namespace cg = cooperative_groups;

#ifndef ONE_LAUNCH
#define ONE_LAUNCH 1
#endif

#ifndef PROBE
#define PROBE 0
#endif
#define PROBE_LO 8
#define PROBE_HI 9
#define LAS __attribute__((address_space(3)))
typedef unsigned short bf16_t;
typedef short bf16x8 __attribute__((ext_vector_type(8)));
typedef short s16x4 __attribute__((ext_vector_type(4)));
typedef float f32x4 __attribute__((ext_vector_type(4)));
typedef float f32x2 __attribute__((ext_vector_type(2)));
typedef float f32x16 __attribute__((ext_vector_type(16)));
typedef unsigned u32x4 __attribute__((ext_vector_type(4)));
typedef unsigned u32x2 __attribute__((ext_vector_type(2)));

constexpr int DM = 2048, NB = 4, SEQ = 8192, CTXL = 256, MT = NB * SEQ, MC = NB * CTXL, MA = MT + MC;
constexpr int DFF = 5632, SKV = SEQ + CTXL, NMODC = 9 * DM;
constexpr int PRW_LD = 3584, SH_LD = 3072, LIN_LD = 384, LO_LD = 5120;
constexpr int LDS_BYTES = 131072;

constexpr size_t SZ_WA = (size_t)11264 * 2048 * 2, SZ_WB = (size_t)2048 * 5632 * 2;
constexpr size_t OFF_W1A = 0, OFF_W1B = OFF_W1A + SZ_WA, OFF_W2A = OFF_W1B + SZ_WB, OFF_W2B = OFF_W2A + SZ_WA;
constexpr size_t OFF_WRW = OFF_W2B + SZ_WB, OFF_WQKVG = OFF_WRW + (size_t)3584 * 2048 * 2, OFF_WOA = OFF_WQKVG + (size_t)7168 * 2048 * 2;
constexpr size_t OFF_WOR = OFF_WOA + (size_t)2048 * 2048 * 2, OFF_WOUT = OFF_WOR + (size_t)2048 * 1024 * 2, OFF_WLORA = OFF_WOUT + (size_t)2048 * 2048 * 2;
constexpr size_t OFF_MOD = OFF_WLORA + (size_t)5120 * 384 * 2, OFF_CX = OFF_MOD + (size_t)5 * NMODC * 4, OFF_H = OFF_CX + (size_t)MC * DM * 4;
constexpr size_t OFF_BIG = OFF_H + (size_t)MA * DM * 2;
constexpr size_t SZ_KV = (size_t)NB * SKV * 512 * 2;
constexpr size_t OFF_KB = OFF_W1A, OFF_VB = OFF_KB + SZ_KV;
static_assert(OFF_VB + SZ_KV <= OFF_W2A, "KV overlay");
constexpr size_t OFF_ACT = OFF_BIG;
constexpr size_t OFF_PRW = OFF_BIG, OFF_LO = OFF_BIG, OFF_SH = OFF_LO + (size_t)MA * LO_LD * 2, OFF_LIN = OFF_SH + (size_t)MA * SH_LD * 2, OFF_Y = OFF_LIN;
constexpr size_t OFF_Q = OFF_BIG, OFF_GA = OFF_Q + (size_t)MT * DM * 2, OFF_GR = OFF_GA + (size_t)MT * DM * 2;
constexpr size_t END_A = OFF_ACT + (size_t)MA * DFF * 2, END_B = OFF_Y + (size_t)2 * MT * 1024 * 2, END_C = OFF_LIN + (size_t)MA * LIN_LD * 2;
constexpr size_t WS_END = END_A > END_B ? (END_A > END_C ? END_A : END_C) : (END_B > END_C ? END_B : END_C);
static_assert((size_t)MA * PRW_LD * 2 <= (size_t)MA * LO_LD * 2, "PRW under LO");
static_assert(OFF_GR + (size_t)MT * DM * 2 <= OFF_Y, "GR below RWO");

struct Params {
  const float *x, *c, *ctx, *c_ctx, *w_mod, *b_mod, *norm_ffn1, *ffn1_w_in, *ffn1_w_out, *norm_mix, *w_in, *q_norm, *k_norm, *rwkv_mu, *w0, *w2, *a0, *a2,
      *g2, *k_k, *k_a, *r_k, *ln_x_w, *ln_x_b, *w_oa, *w_or, *w_out, *norm_ffn2, *ffn2_w_in, *ffn2_w_out, *norm_final;
  float* out; unsigned char* ws; int ph_lo, ph_hi; int bid, grd;
};

__device__ __forceinline__ unsigned cvt_pk_bf16(float lo, float hi) { unsigned r; asm("v_cvt_pk_bf16_f32 %0, %1, %2" : "=v"(r) : "v"(lo), "v"(hi)); return r; }
__device__ __forceinline__ float bf2f(unsigned short b) { return __uint_as_float(((unsigned)b) << 16); }
__device__ __forceinline__ float bflo(unsigned w) { return __uint_as_float(w << 16); }
__device__ __forceinline__ float bfhi(unsigned w) { return __uint_as_float(w & 0xffff0000u); }
__device__ __forceinline__ unsigned short f2bf(float f) { return (unsigned short)(cvt_pk_bf16(f, 0.f) & 0xffffu); }
__device__ __forceinline__ float sigmoidf_(float x) { return __builtin_amdgcn_rcpf(1.f + __builtin_amdgcn_exp2f(-1.4426950408889634f * x)); }
template <int CTRL> __device__ __forceinline__ float dpp_mov(float x) { return __int_as_float(__builtin_amdgcn_update_dpp(0, __float_as_int(x), CTRL, 0xF, 0xF, true)); }
__device__ __forceinline__ float allred16(float x) {
  x += dpp_mov<0xB1>(x); x += dpp_mov<0x4E>(x); x += dpp_mov<0x141>(x); x += dpp_mov<0x140>(x); return x;
}

__device__ __forceinline__ float wave_sum(float v) {
  v = allred16(v);
  { auto rr = __builtin_amdgcn_permlane16_swap(__float_as_uint(v), __float_as_uint(v), false, false); v = __uint_as_float(rr[0]) + __uint_as_float(rr[1]); }
  { auto rr = __builtin_amdgcn_permlane32_swap(__float_as_uint(v), __float_as_uint(v), false, false); v = __uint_as_float(rr[0]) + __uint_as_float(rr[1]); }
  return v;
}

constexpr int BM = 256, BK = 64, HALF = 128, HTB = HALF * BK * 2;
__device__ __forceinline__ int lds_byte(int r, int c) { const int st = (r >> 4) * 2 + (c >> 5), rr = r & 15, cc = c & 31, ob = rr * 64 + cc * 2; return st * 1024 + (ob ^ (((ob >> 9) & 1) << 5)); }
__device__ __forceinline__ void stage_rc(int b, int& R, int& C) { const int st = b / 1024, sb = b % 1024, swz = sb ^ (((sb >> 9) & 1) << 5); R = (st >> 1) * 16 + swz / 64; C = (st & 1) * 32 + (swz % 64) / 2; }
__device__ __forceinline__ int perm32(int rho) { const int n = rho >> 4, i = rho & 15; return 8 * (i >> 2) + 4 * n + (i & 3); }

enum { M_SWIGLU = 0, M_RESID = 1, M_RW = 2, M_QKVG = 3, M_LORA = 4, M_T1 = 5, M_M = 6 };
struct Unit { const char* A; const char* B; int pm, pn, seg; };
struct GemmDesc {
  int K, mode, G, c;
  const bf16_t *A0, *B0; int pm00, nM0, nN0, n0;
  const bf16_t *A1, *B1; int pm01, nN1, n1;
  const float* xin; int gidx; float gscale;
  bf16_t* act;
};
__device__ __forceinline__ bool sched_next(const GemmDesc& d, int i, Unit& u) {
  long L = (long)i * d.G + d.c;
  if (L < d.n0) {
    int wgid = (int)L; const int nwg = d.n0;
    { const int q = nwg / 8, r = nwg % 8, xcd = wgid % 8, off = wgid / 8; wgid = (xcd < r ? xcd * (q + 1) : r * (q + 1) + (xcd - r) * q) + off; }
    const int nig = 8 * d.nN0, gid = wgid / nig, fm = gid * 8, gsz = (d.nM0 - fm) < 8 ? (d.nM0 - fm) : 8;
    const int pm = fm + ((wgid % nig) % gsz), pn = (wgid % nig) / gsz;
    u.pm = d.pm00 + pm; u.pn = pn; u.seg = 0;
    u.A = (const char*)d.A0 + (size_t)u.pm * 512 * d.K; u.B = (const char*)d.B0 + (size_t)pn * 512 * d.K; return true;
  }
  L -= d.n0;
  if (L < d.n1) {
    const int pm = (int)L / d.nN1, pn = (int)L % d.nN1; u.pm = d.pm01 + pm; u.pn = pn; u.seg = 1;
    u.A = (const char*)d.A1 + (size_t)u.pm * 512 * d.K; u.B = (const char*)d.B1 + (size_t)pn * 512 * d.K; return true;
  }
  return false;
}

__device__ __forceinline__ void gemm_epilogue(const f32x4 (&acc)[2][2][4][2], const Unit& u, const GemmDesc& d, const Params& P, int wr, int wc, int fr, int fq) {
  unsigned char* ws = P.ws;
  asm volatile("" : "+v"(fr), "+v"(fq));
  const int rl0 = wr * 64 + fr, cl0 = wc * 32 + 8 * fq;
  switch (d.mode) {
  case M_SWIGLU: {
    bf16_t* base = d.act + (size_t)u.pm * 256 * DFF + u.pn * 128 + cl0;
#pragma unroll
    for (int ai = 0; ai < 2; ++ai)
#pragma unroll
      for (int m = 0; m < 4; ++m) {
        const int row = rl0 + 128 * ai + 16 * m;
        float o[8];
#pragma unroll
        for (int n = 0; n < 2; ++n)
#pragma unroll
          for (int j = 0; j < 4; ++j) { const float g = acc[ai][0][m][n][j], up = acc[ai][1][m][n][j]; o[4 * n + j] = g * sigmoidf_(g) * up; }
        u32x4 w; w.x = cvt_pk_bf16(o[0], o[1]); w.y = cvt_pk_bf16(o[2], o[3]); w.z = cvt_pk_bf16(o[4], o[5]); w.w = cvt_pk_bf16(o[6], o[7]);
        *(u32x4*)(base + (size_t)row * DFF) = w;
      }
  } break;
  case M_RESID: {
    const bool isc = u.pm >= 128; const int b = isc ? 4 : (u.pm >> 5);
    const float* xin = isc ? P.ctx + (size_t)(u.pm - 128) * 256 * DM : d.xin + (size_t)u.pm * 256 * DM;
    float* xo = isc ? (float*)(ws + OFF_CX) + (size_t)(u.pm - 128) * 256 * DM : P.out + (size_t)u.pm * 256 * DM;
    const float* gate = (const float*)(ws + OFF_MOD) + b * NMODC + d.gidx * DM + u.pn * 256 + cl0;
    f32x4 g4[2][2];
#pragma unroll
    for (int bj = 0; bj < 2; ++bj)
#pragma unroll
      for (int n = 0; n < 2; ++n) g4[bj][n] = *(const f32x4*)(gate + 128 * bj + 4 * n) * d.gscale;
#pragma unroll
    for (int ai = 0; ai < 2; ++ai)
#pragma unroll
      for (int m = 0; m < 4; ++m) {
        const size_t ro = (size_t)(rl0 + 128 * ai + 16 * m) * DM + u.pn * 256 + cl0;
#pragma unroll
        for (int bj = 0; bj < 2; ++bj)
#pragma unroll
          for (int n = 0; n < 2; ++n) {
            const f32x4 xv = *(const f32x4*)(xin + ro + 128 * bj + 4 * n);
            *(f32x4*)(xo + ro + 128 * bj + 4 * n) = xv + g4[bj][n] * acc[ai][bj][m][n];
          }
      }
  } break;
  case M_RW: case M_QKVG: case M_LORA: {
    bf16_t* base; int ld; int act = 0; const float* bias = nullptr;
    if (d.mode == M_RW) {
      if (u.seg == 0) { base = (bf16_t*)(ws + OFF_PRW) + (size_t)u.pm * 256 * PRW_LD + u.pn * 256; ld = PRW_LD; }
      else { const int b = u.pm - 128; base = (bf16_t*)(ws + (u.pn < 2 ? OFF_KB : OFF_VB)) + (size_t)(b * SKV + SEQ) * 512 + (u.pn & 1) * 256; ld = 512; }
    } else if (d.mode == M_QKVG) {
      const int b = u.pm >> 5;
      if (u.pn < 8) { base = (bf16_t*)(ws + OFF_Q) + (size_t)u.pm * 256 * DM + u.pn * 256; ld = DM; }
      else if (u.pn < 12) { base = (bf16_t*)(ws + (u.pn < 10 ? OFF_KB : OFF_VB)) + (size_t)(u.pm * 256 + b * CTXL) * 512 + (u.pn & 1) * 256; ld = 512; }
      else { base = (bf16_t*)(ws + (u.pn < 20 ? OFF_GA : OFF_GR)) + (size_t)u.pm * 256 * DM + ((u.pn - 12) & 7) * 256; ld = DM; act = 1; }
    } else {
      base = (bf16_t*)(ws + OFF_LO) + (size_t)u.pm * 256 * LO_LD + u.pn * 256; ld = LO_LD;
      if (u.pn < 8) { act = 2; bias = P.w0 + u.pn * 256; } else if (u.pn < 16) { act = 1; bias = P.a0 + (u.pn - 8) * 256; }
    }
#pragma unroll
    for (int bj = 0; bj < 2; ++bj) {
      f32x4 b0 = {0.f, 0.f, 0.f, 0.f}, b1 = {0.f, 0.f, 0.f, 0.f};
      if (bias) { b0 = *(const f32x4*)(bias + 128 * bj + cl0); b1 = *(const f32x4*)(bias + 128 * bj + cl0 + 4); }
#pragma unroll
      for (int ai = 0; ai < 2; ++ai)
#pragma unroll
        for (int m = 0; m < 4; ++m) {
          const int row = rl0 + 128 * ai + 16 * m;
          f32x4 v0 = acc[ai][bj][m][0] + b0, v1 = acc[ai][bj][m][1] + b1;
          if (act) {
            const float sc = act == 2 ? 0.60653065971263342f * 1.4426950408889634f : 1.f;
#pragma unroll
            for (int j = 0; j < 4; ++j) { v0[j] = sc * sigmoidf_(v0[j]); v1[j] = sc * sigmoidf_(v1[j]); }
          }
          u32x4 w; w.x = cvt_pk_bf16(v0[0], v0[1]); w.y = cvt_pk_bf16(v0[2], v0[3]); w.z = cvt_pk_bf16(v1[0], v1[1]); w.w = cvt_pk_bf16(v1[2], v1[3]);
          *(u32x4*)(base + (size_t)row * ld + 128 * bj + cl0) = w;
        }
    }
  } break;
  case M_T1: case M_M: {
    bf16_t* ga = (bf16_t*)(ws + OFF_GA) + (size_t)u.pm * 256 * DM + u.pn * 256 + cl0;
    bf16_t* gr = (bf16_t*)(ws + OFF_GR) + (size_t)u.pm * 256 * DM + u.pn * 256 + cl0;
    const bool isM = d.mode == M_M;
#pragma unroll
    for (int ai = 0; ai < 2; ++ai)
#pragma unroll
      for (int m = 0; m < 4; ++m)
#pragma unroll
        for (int bj = 0; bj < 2; ++bj) {
          const size_t o = (size_t)(rl0 + 128 * ai + 16 * m) * DM + 128 * bj;
          const f32x4 v0 = acc[ai][bj][m][0], v1 = acc[ai][bj][m][1];
          const u32x4 a = *(const u32x4*)(ga + o);
          u32x4 w;
          if (!isM) {
            w.x = cvt_pk_bf16(bflo(a.x) * v0[0], bfhi(a.x) * v0[1]); w.y = cvt_pk_bf16(bflo(a.y) * v0[2], bfhi(a.y) * v0[3]);
            w.z = cvt_pk_bf16(bflo(a.z) * v1[0], bfhi(a.z) * v1[1]); w.w = cvt_pk_bf16(bflo(a.w) * v1[2], bfhi(a.w) * v1[3]);
            *(u32x4*)(ga + o) = w;
          } else {
            const u32x4 g = *(const u32x4*)(gr + o);
            w.x = cvt_pk_bf16(bflo(a.x) + bflo(g.x) * v0[0], bfhi(a.x) + bfhi(g.x) * v0[1]); w.y = cvt_pk_bf16(bflo(a.y) + bflo(g.y) * v0[2], bfhi(a.y) + bfhi(g.y) * v0[3]);
            w.z = cvt_pk_bf16(bflo(a.z) + bflo(g.z) * v1[0], bfhi(a.z) + bfhi(g.z) * v1[1]); w.w = cvt_pk_bf16(bflo(a.w) + bflo(g.w) * v1[2], bfhi(a.w) + bfhi(g.w) * v1[3]);
            *(u32x4*)(gr + o) = w;
          }
        }
  } break;
  }
}

__device__ __forceinline__ void gemm_phase(LAS unsigned char* lds, const GemmDesc& d, const Params& P, const int tid) {
  const int wid = __builtin_amdgcn_readfirstlane(tid >> 6), lane = tid & 63, wr = wid >> 2, wc = wid & 3, fr = lane & 15, fq = lane >> 4;
  const int K = d.K, nt = K / BK;
  unsigned voffA[2], voffB[2];
#pragma unroll
  for (int i = 0; i < 2; ++i) { int R, C; stage_rc(tid * 16 + i * 8192, R, C); const int Rb = (R & ~31) + perm32(R & 31);
    voffA[i] = (unsigned)(R * K + C) * 2u; voffB[i] = (unsigned)(Rb * K + C) * 2u; }
  const size_t kstep = (size_t)(BK * 2);
  const size_t hstep = (size_t)HALF * K * 2;
  const unsigned ldsw = (unsigned)wid * 1024u;
  const int aoff = lds_byte(wr * 64 + fr, fq * 8), boff = lds_byte(wc * 32 + fr, fq * 8);
#define PG8_SA(b, h) (((b) * 2 + (h)) * HTB)
#define PG8_SB(b, h) ((4 + (b) * 2 + (h)) * HTB)
#define PG8_STAGE(bufoff, gbase, voff) do { _Pragma("unroll") for (int _i = 0; _i < 2; ++_i) \
    __builtin_amdgcn_global_load_lds((const unsigned*)((const char*)(gbase) + (voff)[_i]), (LAS unsigned*)(lds + (bufoff) + ldsw + _i * 8192), 16, 0, 0); } while (0)
#define PG8_LDA(dst, b, h) do { _Pragma("unroll") for (int m = 0; m < 4; ++m) _Pragma("unroll") for (int k = 0; k < 2; ++k) dst[m][k] = *(const LAS bf16x8*)(lds + PG8_SA(b, h) + aoff + m * 2048 + k * 1024); } while (0)
#define PG8_LDB(dst, b, h) do { _Pragma("unroll") for (int n = 0; n < 2; ++n) _Pragma("unroll") for (int k = 0; k < 2; ++k) dst[n][k] = *(const LAS bf16x8*)(lds + PG8_SB(b, h) + boff + n * 2048 + k * 1024); } while (0)
#define PG8_MMA(ai, bj, At, Bt) do { __builtin_amdgcn_s_setprio(1); _Pragma("unroll") for (int m = 0; m < 4; ++m) _Pragma("unroll") for (int n = 0; n < 2; ++n) _Pragma("unroll") for (int k = 0; k < 2; ++k) \
    acc[ai][bj][m][n] = __builtin_amdgcn_mfma_f32_16x16x32_bf16(Bt[n][k], At[m][k], acc[ai][bj][m][n], 0, 0, 0); __builtin_amdgcn_s_setprio(0); } while (0)
#define PG8_WAIT_V(n) asm volatile("s_waitcnt vmcnt(" #n ")" ::: "memory")
#define PG8_WAIT_L(n) asm volatile("s_waitcnt lgkmcnt(" #n ")" ::: "memory")
#define PG8_BAR __builtin_amdgcn_s_barrier()
#define PG8_SCHED __builtin_amdgcn_sched_barrier(0)
  Unit cur, nxt; int ui = 0;
  if (!sched_next(d, 0, cur)) return;
  f32x4 acc[2][2][4][2];
#pragma unroll
  for (int a = 0; a < 2; ++a)
#pragma unroll
    for (int b = 0; b < 2; ++b)
#pragma unroll
      for (int m = 0; m < 4; ++m)
#pragma unroll
        for (int n = 0; n < 2; ++n) acc[a][b][m][n] = (f32x4){0.f, 0.f, 0.f, 0.f};
  bf16x8 At[4][2], B0[2][2], B1[2][2];
  const char* cA = cur.A; const char* cB = cur.B;
  PG8_STAGE(PG8_SB(0, 0), cB, voffB); PG8_STAGE(PG8_SA(0, 0), cA, voffA); PG8_STAGE(PG8_SB(0, 1), cB + hstep, voffB); PG8_STAGE(PG8_SA(0, 1), cA + hstep, voffA);
  if (wr == 1) PG8_BAR;
  PG8_WAIT_V(4); PG8_BAR;
  PG8_STAGE(PG8_SB(1, 0), cB + kstep, voffB); PG8_STAGE(PG8_SA(1, 0), cA + kstep, voffA); PG8_STAGE(PG8_SB(1, 1), cB + hstep + kstep, voffB);
  PG8_WAIT_V(6); PG8_BAR;
  for (;;) {
    const bool has_next = sched_next(d, ui + 1, nxt);
    const char* nA = has_next ? nxt.A : cA; const char* nB = has_next ? nxt.B : cB;
    for (int t = 0; t < nt; t += 2) {
      const bool last = (t == nt - 2);
      const char* a1 = cA + (size_t)(t + 1) * kstep;
      const char* a2 = last ? nA : cA + (size_t)(t + 2) * kstep; const char* b2 = last ? nB : cB + (size_t)(t + 2) * kstep;
      const char* a3 = a2 + kstep; const char* b3 = b2 + kstep;
      PG8_LDB(B0, 0, 0); PG8_SCHED; PG8_LDA(At, 0, 0); PG8_STAGE(PG8_SA(1, 1), a1 + hstep, voffA);
      PG8_WAIT_L(8); PG8_BAR; PG8_WAIT_L(0); PG8_MMA(0, 0, At, B0); PG8_BAR; PG8_SCHED;
      PG8_LDB(B1, 0, 1); PG8_STAGE(PG8_SB(0, 0), b2, voffB);
      PG8_BAR; PG8_WAIT_L(0); PG8_MMA(0, 1, At, B1); PG8_BAR;
      PG8_LDA(At, 0, 1); PG8_STAGE(PG8_SA(0, 0), a2, voffA);
      PG8_BAR; PG8_WAIT_L(0); PG8_MMA(1, 0, At, B0); PG8_BAR; PG8_SCHED;
      PG8_STAGE(PG8_SB(0, 1), b2 + hstep, voffB);
      PG8_WAIT_V(6); PG8_BAR; PG8_MMA(1, 1, At, B1); PG8_BAR;
      PG8_LDB(B0, 1, 0); PG8_SCHED; PG8_LDA(At, 1, 0); PG8_STAGE(PG8_SA(0, 1), a2 + hstep, voffA);
      PG8_WAIT_L(8); PG8_BAR; PG8_WAIT_L(0); PG8_MMA(0, 0, At, B0); PG8_BAR; PG8_SCHED;
      PG8_LDB(B1, 1, 1); PG8_STAGE(PG8_SB(1, 0), b3, voffB);
      PG8_BAR; PG8_WAIT_L(0); PG8_MMA(0, 1, At, B1); PG8_BAR;
      PG8_LDA(At, 1, 1); PG8_STAGE(PG8_SA(1, 0), a3, voffA);
      PG8_BAR; PG8_WAIT_L(0); PG8_MMA(1, 0, At, B0); PG8_BAR; PG8_SCHED;
      PG8_STAGE(PG8_SB(1, 1), b3 + hstep, voffB);
      PG8_WAIT_V(6); PG8_BAR; PG8_MMA(1, 1, At, B1); PG8_BAR;
    }
    gemm_epilogue(acc, cur, d, P, wr, wc, fr, fq);
    if (!has_next) break;
#pragma unroll
    for (int a = 0; a < 2; ++a)
#pragma unroll
      for (int b = 0; b < 2; ++b)
#pragma unroll
        for (int m = 0; m < 4; ++m)
#pragma unroll
          for (int n = 0; n < 2; ++n) acc[a][b][m][n] = (f32x4){0.f, 0.f, 0.f, 0.f};
    cur = nxt; cA = nA; cB = nB; ++ui;
  }
  PG8_WAIT_V(0);
  if (wr == 0) PG8_BAR;
  PG8_BAR;
#undef PG8_SA
#undef PG8_SB
#undef PG8_STAGE
#undef PG8_LDA
#undef PG8_LDB
#undef PG8_MMA
#undef PG8_WAIT_V
#undef PG8_WAIT_L
#undef PG8_BAR
#undef PG8_SCHED
}

namespace att {
constexpr int D = 128, NW = 8, QBLK = 32, KVBLK = 64;
constexpr float SCALE = 0.088388347648318440f;
constexpr float THR = 8.f;
constexpr int LDQ = 2048, LDK = 512, LDO = 2048;
constexpr size_t SHM_V = KVBLK * D * 2, SHM_K = KVBLK * D * 2;
#define KSWZ(row, colB) ((row) * 256 + ((colB) ^ (((row) & 7) << 4)))
#define SBAR() __builtin_amdgcn_sched_barrier(0)
__device__ __forceinline__ int crow(int r, int hi) { return (r & 3) + 8 * (r >> 2) + 4 * hi; }
__device__ __forceinline__ unsigned cvtpk(float lo, float hi) { unsigned r; asm volatile("v_cvt_pk_bf16_f32 %0, %1, %2" : "=v"(r) : "v"(lo), "v"(hi)); return r; }
__device__ __forceinline__ void partialSM(f32x16& p0, f32x16& p1, float& m_reg, float& mn, float& alpha) {
  constexpr float C = SCALE * 1.4426950408889634f;
  float pmax = p0[0];
#pragma unroll
  for (int r = 1; r < 16; ++r) pmax = fmaxf(pmax, p0[r]);
#pragma unroll
  for (int r = 0; r < 16; ++r) pmax = fmaxf(pmax, p1[r]);
  { auto rr = __builtin_amdgcn_permlane32_swap(__float_as_uint(pmax), __float_as_uint(pmax), false, false);
    pmax = fmaxf(__uint_as_float(rr[0]), __uint_as_float(rr[1])); }
  if (__builtin_expect(__all(pmax - m_reg <= THR / SCALE), 1)) { mn = m_reg; alpha = 1.f; }
  else { mn = fmaxf(m_reg, pmax); alpha = __builtin_amdgcn_exp2f((m_reg - mn) * C); m_reg = mn; }
  float mnC = -mn * C;
#pragma unroll
  for (int r = 0; r < 16; ++r) p0[r] = fmaf(p0[r], C, mnC);
#pragma unroll
  for (int r = 0; r < 16; ++r) p1[r] = fmaf(p1[r], C, mnC);
#pragma unroll
  for (int r = 0; r < 16; ++r) p0[r] = __builtin_amdgcn_exp2f(p0[r]);
}
__device__ __forceinline__ void finishSM(f32x16& p0, f32x16& p1, float alpha, float& l_reg, bf16x8& pa0, bf16x8& pa1, bf16x8& pa2, bf16x8& pa3) {
#pragma unroll
  for (int r = 0; r < 16; ++r) p1[r] = __builtin_amdgcn_exp2f(p1[r]);
  float ps = 0;
#pragma unroll
  for (int r = 0; r < 16; ++r) ps += p0[r];
#pragma unroll
  for (int r = 0; r < 16; ++r) ps += p1[r];
  { auto rr = __builtin_amdgcn_permlane32_swap(__float_as_uint(ps), __float_as_uint(ps), false, false);
    ps = __uint_as_float(rr[0]) + __uint_as_float(rr[1]); }
  l_reg = l_reg * alpha + ps;
#define PK4(P, BASE, OUT) do { unsigned a0 = cvtpk(P[BASE + 0], P[BASE + 1]), a1 = cvtpk(P[BASE + 2], P[BASE + 3]);   \
    unsigned b0 = cvtpk(P[BASE + 4], P[BASE + 5]), b1 = cvtpk(P[BASE + 6], P[BASE + 7]);                              \
    auto r0 = __builtin_amdgcn_permlane32_swap(a0, b0, false, false); auto r1 = __builtin_amdgcn_permlane32_swap(a1, b1, false, false); \
    u32x4 w = {r0[0], r1[0], r0[1], r1[1]}; OUT = *reinterpret_cast<bf16x8*>(&w); } while (0)
  PK4(p0, 0, pa0); PK4(p0, 8, pa1); PK4(p1, 0, pa2); PK4(p1, 8, pa3);
#undef PK4
}
__device__ __forceinline__ void qkt(f32x16& p0, f32x16& p1, const bf16_t* Ks, const bf16x8* qr, int r32, int hi) {
  p0 = f32x16{}; p1 = f32x16{};
#pragma unroll
  for (int d0 = 0; d0 < 8; ++d0) { int cb = (d0 * 16 + hi * 8) * 2;
    bf16x8 b0 = *reinterpret_cast<const bf16x8*>((const char*)Ks + KSWZ(r32, cb));
    bf16x8 b1 = *reinterpret_cast<const bf16x8*>((const char*)Ks + KSWZ(32 + r32, cb));
    p0 = __builtin_amdgcn_mfma_f32_32x32x16_bf16(b0, qr[d0], p0, 0, 0, 0);
    p1 = __builtin_amdgcn_mfma_f32_32x32x16_bf16(b1, qr[d0], p1, 0, 0, 0); }
}
__device__ __forceinline__ int v_st(int k, int c) { const int kk = (k & ~0xC) | ((k & 4) << 1) | ((k & 8) >> 1); return ((kk >> 3) * 4 + (c >> 5)) * 512 + ((kk & 7) * 32 + (c & 31)) * 2; }
__device__ __forceinline__ int v_rd_base(int lane) { return ((lane & 3) << 3) | (((lane >> 2) & 3) << 6) | (((lane >> 4) & 1) << 5) | (((lane >> 5) & 1) << 8); }
constexpr int v_rd_off(int d0, int ks, int half) { return d0 * 512 + ks * 4096 + half * 2048; }
template <int OFF> __device__ __forceinline__ s16x4 tr_read(int vb) {
  s16x4 r; asm volatile("ds_read_b64_tr_b16 %0, %1 offset:%2" : "=&v"(r) : "v"(vb), "i"(OFF) : "memory"); return r;
}
template <int D0> __device__ __forceinline__ void pv_one(f32x16& od, int vb, bf16x8 pa0, bf16x8 pa1, bf16x8 pa2, bf16x8 pa3) {
  const s16x4 l0 = tr_read<v_rd_off(D0, 0, 0)>(vb), h0 = tr_read<v_rd_off(D0, 0, 1)>(vb), l1 = tr_read<v_rd_off(D0, 1, 0)>(vb), h1 = tr_read<v_rd_off(D0, 1, 1)>(vb);
  const s16x4 l2 = tr_read<v_rd_off(D0, 2, 0)>(vb), h2 = tr_read<v_rd_off(D0, 2, 1)>(vb), l3 = tr_read<v_rd_off(D0, 3, 0)>(vb), h3 = tr_read<v_rd_off(D0, 3, 1)>(vb);
  asm volatile("s_waitcnt lgkmcnt(0)" ::: "memory"); SBAR();
#define PK(L, H) (bf16x8){L[0], L[1], L[2], L[3], H[0], H[1], H[2], H[3]}
  od = __builtin_amdgcn_mfma_f32_32x32x16_bf16(pa0, PK(l0, h0), od, 0, 0, 0);
  od = __builtin_amdgcn_mfma_f32_32x32x16_bf16(pa1, PK(l1, h1), od, 0, 0, 0);
  od = __builtin_amdgcn_mfma_f32_32x32x16_bf16(pa2, PK(l2, h2), od, 0, 0, 0);
  od = __builtin_amdgcn_mfma_f32_32x32x16_bf16(pa3, PK(l3, h3), od, 0, 0, 0);
#undef PK
}
__device__ __forceinline__ void pv_d0(f32x16* o, int vb, bf16x8 pa0, bf16x8 pa1, bf16x8 pa2, bf16x8 pa3) {
  pv_one<0>(o[0], vb, pa0, pa1, pa2, pa3); pv_one<1>(o[1], vb, pa0, pa1, pa2, pa3); pv_one<2>(o[2], vb, pa0, pa1, pa2, pa3); pv_one<3>(o[3], vb, pa0, pa1, pa2, pa3);
}
__device__ __forceinline__ void attn_dense_body(const bf16_t* __restrict__ Qb, const bf16_t* __restrict__ Kh, const bf16_t* __restrict__ Vh,
                                                bf16_t* __restrict__ Ob, int seq, char* lds, const int tid) {
  const int wid = tid >> 6, lane = tid & 63, r32 = lane & 31, hi = lane >> 5;
  bf16_t* V_lds = (bf16_t*)lds; bf16_t* K_lds = (bf16_t*)(lds + 2 * SHM_V);
  float* wsf = (float*)(lds + 2 * SHM_V + 2 * SHM_K) + wid * 64; float* li_l = wsf; float* al_l = wsf + 32;
  float m_reg = -1e30f, l_reg = 0; f32x16 o[4] = {}; bf16x8 qr[8];
  const bf16_t* Qw = Qb + (long)(wid * QBLK + r32) * LDQ + hi * 8;
#pragma unroll
  for (int d0 = 0; d0 < 8; ++d0) qr[d0] = *reinterpret_cast<const bf16x8*>(Qw + d0 * 16);
  const int sr = tid >> 4, sc = (tid & 15) * 8, vst0 = v_st(sr, sc), vst1 = v_st(32 + sr, sc);
  const int vb0 = (int)(uintptr_t)V_lds + v_rd_base(lane);
  struct { bf16x8 vs0, vs1, ks0, ks1; } sr_[2];
#define LD8(p) (*reinterpret_cast<const bf16x8*>(p))
  const unsigned voff = (unsigned)(sr * LDK + sc) * 2u;
#define SLOAD(i, k0) do { const char* vb_ = (const char*)(Vh + (size_t)(k0) * LDK); const char* kb_ = (const char*)(Kh + (size_t)(k0) * LDK); \
    sr_[i].vs0 = LD8(vb_ + voff); sr_[i].vs1 = LD8(vb_ + 32 * LDK * 2 + voff); sr_[i].ks0 = LD8(kb_ + voff); sr_[i].ks1 = LD8(kb_ + 32 * LDK * 2 + voff); } while (0)
#define SWRITE(b, i) do { *(bf16x8*)((char*)V_lds + (b) * SHM_V + vst0) = sr_[i].vs0;          \
    *(bf16x8*)((char*)V_lds + (b) * SHM_V + vst1) = sr_[i].vs1; int kc = sc * 2;               \
    *(bf16x8*)((char*)K_lds + (b) * SHM_K + KSWZ(sr, kc)) = sr_[i].ks0;                       \
    *(bf16x8*)((char*)K_lds + (b) * SHM_K + KSWZ(32 + sr, kc)) = sr_[i].ks1; } while (0)
#define SWAIT() asm volatile("s_waitcnt vmcnt(4)" ::: "memory")
#define RESC(a) do { if (__any((a) < 1.f)) { if (hi == 0) al_l[r32] = (a); asm volatile("s_waitcnt lgkmcnt(0)" ::: "memory"); \
    _Pragma("unroll") for (int d = 0; d < 4; ++d) _Pragma("unroll") for (int r = 0; r < 16; ++r) o[d][r] *= al_l[crow(r, hi)]; } } while (0)
  f32x16 pA0, pA1, pB0, pB1; float mnA, mnB, alA, alB; bf16x8 pa0, pa1, pa2, pa3; const int NT = seq / KVBLK;
  constexpr int SE = 0, SO = 1;
  SLOAD(SE, 0); asm volatile("s_waitcnt vmcnt(0)" ::: "memory"); SWRITE(0, SE); __syncthreads();
  qkt(pA0, pA1, K_lds, qr, r32, hi); partialSM(pA0, pA1, m_reg, mnA, alA);
  SLOAD(SO, KVBLK); if (2 < NT) SLOAD(SE, 2 * KVBLK);
  SWAIT(); SWRITE(1, SO); __syncthreads();
  for (int j = 1; j + 1 < NT; j += 2) {
    SBAR(); qkt(pB0, pB1, (bf16_t*)((char*)K_lds + SHM_K), qr, r32, hi);
    finishSM(pA0, pA1, alA, l_reg, pa0, pa1, pa2, pa3); SBAR();
    SLOAD(SO, (j + 2) * KVBLK); SBAR();
    pv_d0(o, vb0, pa0, pa1, pa2, pa3); partialSM(pB0, pB1, m_reg, mnB, alB);
    __syncthreads(); SWAIT(); SWRITE(0, SE);
    RESC(alB); __syncthreads();
    SBAR(); qkt(pA0, pA1, K_lds, qr, r32, hi);
    finishSM(pB0, pB1, alB, l_reg, pa0, pa1, pa2, pa3); SBAR();
    if (j + 3 < NT) SLOAD(SE, (j + 3) * KVBLK); SBAR();
    pv_d0(o, vb0 + (int)SHM_V, pa0, pa1, pa2, pa3); partialSM(pA0, pA1, m_reg, mnA, alA);
    __syncthreads(); SWAIT(); SWRITE(1, SO);
    RESC(alA); __syncthreads();
  }
  SBAR(); qkt(pB0, pB1, (bf16_t*)((char*)K_lds + SHM_K), qr, r32, hi);
  finishSM(pA0, pA1, alA, l_reg, pa0, pa1, pa2, pa3); SBAR();
  pv_d0(o, vb0, pa0, pa1, pa2, pa3); partialSM(pB0, pB1, m_reg, mnB, alB);
  __syncthreads(); RESC(alB);
  finishSM(pB0, pB1, alB, l_reg, pa0, pa1, pa2, pa3); SBAR();
  pv_d0(o, vb0 + (int)SHM_V, pa0, pa1, pa2, pa3);
  if (hi == 0) li_l[r32] = l_reg; asm volatile("s_waitcnt lgkmcnt(0)" ::: "memory");
  float rli[16];
#pragma unroll
  for (int r = 0; r < 16; ++r) rli[r] = __builtin_amdgcn_rcpf(li_l[crow(r, hi)]);
  bf16_t* Ow = Ob + (long)(wid * QBLK) * LDO;
#pragma unroll
  for (int r = 0; r < 16; ++r) { int orow = crow(r, hi);
#pragma unroll
    for (int d0 = 0; d0 < 4; ++d0) Ow[(long)orow * LDO + d0 * 32 + r32] = f2bf(o[d0][r] * rli[r]); }
#undef LD8
#undef SLOAD
#undef SWRITE
#undef SWAIT
#undef RESC
}
}

__device__ __forceinline__ void mod_phase(const Params& P, LAS unsigned char* lds, const int tid) {
  if (P.bid >= 144) return;
  LAS float* sc = (LAS float*)lds; LAS float* red = sc + 5 * 2048;
  const int wid = tid >> 6, lane = tid & 63;
  for (int i = tid; i < 5 * 2048; i += 512) { const int j = i >> 11, k = i & 2047; const float v = (j < 4) ? P.c[j * 2048 + k] : P.c_ctx[k]; sc[i] = v * sigmoidf_(v); }
  __syncthreads();
  float* MOD = (float*)(P.ws + OFF_MOD);
  for (int task = P.bid; task < 144; task += P.grd) {
    const int n0 = task * 128 + lane * 2;
    float a0[5], a1[5];
#pragma unroll
    for (int j = 0; j < 5; ++j) { a0[j] = 0.f; a1[j] = 0.f; }
    const float* wp = P.w_mod + (size_t)(wid * 256) * NMODC + n0;
#pragma unroll 8
    for (int k = 0; k < 256; ++k) {
      const f32x2 w = *(const f32x2*)(wp + (size_t)k * NMODC);
#pragma unroll
      for (int j = 0; j < 5; ++j) { const float s = sc[j * 2048 + wid * 256 + k]; a0[j] += s * w.x; a1[j] += s * w.y; }
    }
#pragma unroll
    for (int j = 0; j < 5; ++j) { red[(wid * 5 + j) * 128 + lane * 2] = a0[j]; red[(wid * 5 + j) * 128 + lane * 2 + 1] = a1[j]; }
    __syncthreads();
    for (int o = tid; o < 640; o += 512) { const int j = o >> 7, ci = o & 127; float s = 0.f;
#pragma unroll
      for (int w = 0; w < 8; ++w) s += red[(w * 5 + j) * 128 + ci];
      MOD[j * NMODC + task * 128 + ci] = s + P.b_mod[task * 128 + ci]; }
    __syncthreads();
  }
}
__device__ __forceinline__ void tr_item(const float* __restrict__ W, int ldw, int k0, int n0, bf16_t* __restrict__ WT, int ldt, int drow0, int dk0, LAS float* scr, int lane) {
#pragma unroll 32
  for (int i = 0; i < 32; ++i) { const int kk = 2 * i + (lane >> 5); scr[kk * 33 + (lane & 31)] = W[(size_t)(k0 + kk) * ldw + n0 + (lane & 31)]; }
  asm volatile("s_waitcnt lgkmcnt(0)" ::: "memory");
  const int c = lane & 7;
#pragma unroll
  for (int j = 0; j < 4; ++j) { const int n = (lane >> 3) + 8 * j; const LAS float* s = scr + (8 * c) * 33 + n;
    u32x4 o; o.x = cvt_pk_bf16(s[0 * 33], s[1 * 33]); o.y = cvt_pk_bf16(s[2 * 33], s[3 * 33]); o.z = cvt_pk_bf16(s[4 * 33], s[5 * 33]); o.w = cvt_pk_bf16(s[6 * 33], s[7 * 33]);
    *(u32x4*)(WT + (size_t)(drow0 + n) * ldt + dk0 + k0 + 8 * c) = o; }
  asm volatile("s_waitcnt lgkmcnt(0)" ::: "memory");
}
__device__ __forceinline__ void convert_phase(const Params& P, LAS unsigned char* lds, const int tid) {
  const int wid = tid >> 6, lane = tid & 63;
  LAS float* scr = (LAS float*)(lds + wid * 8704);
  unsigned char* ws = P.ws;
  bf16_t *W1A = (bf16_t*)(ws + OFF_W1A), *W1B = (bf16_t*)(ws + OFF_W1B), *W2A = (bf16_t*)(ws + OFF_W2A), *W2B = (bf16_t*)(ws + OFF_W2B);
  bf16_t *WRW = (bf16_t*)(ws + OFF_WRW), *WQKVG = (bf16_t*)(ws + OFF_WQKVG), *WOA = (bf16_t*)(ws + OFF_WOA), *WOR = (bf16_t*)(ws + OFF_WOR), *WOUT = (bf16_t*)(ws + OFF_WOUT), *WLORA = (bf16_t*)(ws + OFF_WLORA);
  const int G = P.grd, gw = (G - 1 - P.bid) * 8 + wid, NGW = G * 8;
  constexpr int NITEMS = 22528 + 11264 + 3456 + 7168 + 2048 + 1024 + 2048 + 192;
  for (int it = gw; it < NITEMS; it += NGW) {
    int r = it;
    if (r < 22528) { const int which = r >= 11264; r -= which * 11264; const int kb = r / 352, nb = r % 352, n0 = nb * 32;
      const int drow = n0 < DFF ? (n0 >> 7) * 256 + (n0 & 127) : ((n0 - DFF) >> 7) * 256 + 128 + ((n0 - DFF) & 127);
      tr_item(which ? P.ffn2_w_in : P.ffn1_w_in, 2 * DFF, kb * 64, n0, which ? W2A : W1A, 2048, drow, 0, scr, lane); continue; }
    r -= 22528;
    if (r < 11264) { const int which = r >= 5632; r -= which * 5632; const int kb = r >> 6, nb = r & 63;
      tr_item(which ? P.ffn2_w_out : P.ffn1_w_out, 2048, kb * 64, nb * 32, which ? W2B : W1B, DFF, nb * 32, 0, scr, lane); continue; }
    r -= 11264;
    if (r < 3456) { const int kb = r / 108, nb = r % 108; tr_item(P.w_in, 10624, kb * 64, 3072 + nb * 32, WRW, 2048, nb * 32, 0, scr, lane); continue; }
    r -= 3456;
    if (r < 7168) { const int kb = r / 224, nb = r % 224; const int n0 = nb < 96 ? nb * 32 : 6528 + (nb - 96) * 32;
      tr_item(P.w_in, 10624, kb * 64, n0, WQKVG, 2048, nb * 32, 0, scr, lane); continue; }
    r -= 7168;
    if (r < 2048) { tr_item(P.w_oa, 2048, (r >> 6) * 64, (r & 63) * 32, WOA, 2048, (r & 63) * 32, 0, scr, lane); continue; }
    r -= 2048;
    if (r < 1024) { tr_item(P.w_or, 2048, (r >> 6) * 64, (r & 63) * 32, WOR, 1024, (r & 63) * 32, 0, scr, lane); continue; }
    r -= 1024;
    if (r < 2048) { tr_item(P.w_out, 2048, (r >> 6) * 64, (r & 63) * 32, WOUT, 2048, (r & 63) * 32, 0, scr, lane); continue; }
    r -= 2048;
    if (r < 64) { const int z = r >> 5, nb = r & 31; tr_item(P.w2 + (size_t)z * 64 * 1024, 1024, 0, nb * 32, WLORA, LIN_LD, z * 1024 + nb * 32, z * 64, scr, lane); continue; }
    r -= 64;
    if (r < 64) { const int z = r >> 5, nb = r & 31; tr_item(P.a2 + (size_t)z * 64 * 1024, 1024, 0, nb * 32, WLORA, LIN_LD, 2048 + z * 1024 + nb * 32, 128 + z * 64, scr, lane); continue; }
    r -= 64;
    { const int kb = r >> 5, nb = r & 31; tr_item(P.g2, 1024, kb * 64, nb * 32, WLORA, LIN_LD, 4096 + nb * 32, 256, scr, lane); }
  }
  const int gt = P.bid * 512 + tid, NT = G * 512;
  unsigned zz = 0u; asm volatile("" : "+v"(zz));
  const u32x4 z4 = {zz, zz, zz, zz};
  for (int i = gt; i < 128 * 256; i += NT) *(u32x4*)(WRW + (size_t)3456 * 2048 + (size_t)i * 8) = z4;
  for (int i = gt; i < 5120 * 48; i += NT) { const int row = i / 48, kc = (i % 48) * 8, rb = row >> 10;
    const int lo = rb < 4 ? rb * 64 : 256, hi = rb < 4 ? rb * 64 + 64 : 384;
    if (kc < lo || kc >= hi) *(u32x4*)(WLORA + (size_t)row * LIN_LD + kc) = z4; }
}
__device__ __forceinline__ void norm_mod_phase(const Params& P, const float* __restrict__ lat, const float* __restrict__ ctxp, int nrows, const float* __restrict__ g, int midx, const int tid) {
  const int wid = tid >> 6, lane = tid & 63;
  const int gw = P.bid * 8 + wid, NGW = P.grd * 8;
  const float* __restrict__ MOD = (const float*)(P.ws + OFF_MOD); bf16_t* __restrict__ H = (bf16_t*)(P.ws + OFF_H);
  for (int r = gw; r < nrows; r += NGW) {
    const float* xr = r < MT ? lat + (size_t)r * DM : ctxp + (size_t)(r - MT) * DM;
    const int b = r < MT ? (r >> 13) : 4;
    const float* sh = MOD + b * NMODC + midx * DM; const float* scp = sh + DM;
    f32x4 v[8], g4[8], s4[8], c4[8]; float ss = 0.f;
#pragma unroll
    for (int j = 0; j < 8; ++j) v[j] = *(const f32x4*)(xr + j * 256 + lane * 4);
#pragma unroll
    for (int j = 0; j < 8; ++j) { const int c = j * 256 + lane * 4; g4[j] = *(const f32x4*)(g + c); s4[j] = *(const f32x4*)(sh + c); c4[j] = *(const f32x4*)(scp + c); }
#pragma unroll
    for (int j = 0; j < 8; ++j) ss += v[j].x * v[j].x + v[j].y * v[j].y + v[j].z * v[j].z + v[j].w * v[j].w;
    ss = wave_sum(ss);
    const float rs = rsqrtf(ss * (1.f / DM) + 1e-6f);
#pragma unroll
    for (int j = 0; j < 8; ++j) { const int c = j * 256 + lane * 4;
      const f32x4 y = v[j] * rs * g4[j]; const f32x4 h = y * (c4[j] + 1.f) + s4[j];
      u32x2 w; w.x = cvt_pk_bf16(h.x, h.y); w.y = cvt_pk_bf16(h.z, h.w);
      *(u32x2*)(H + (size_t)r * DM + c) = w; }
  }
}
__device__ __forceinline__ void shift_phase(const Params& P, const int tid) {
  const bf16_t* PRW = (const bf16_t*)(P.ws + OFF_PRW); bf16_t* SH = (bf16_t*)(P.ws + OFF_SH); bf16_t* LIN = (bf16_t*)(P.ws + OFF_LIN);
  const int gt = P.bid * 512 + tid, NT = P.grd * 512;
  for (int idx = gt; idx < MA * 432; idx += NT) {
    const int r = idx / 432, c = (idx % 432) * 8;
    bool first, last;
    if (r < MT) { const int t = r & (SEQ - 1); first = t == 0; last = t == SEQ - 1; } else { const int t = (r - MT) & (CTXL - 1); first = t == 0; last = t == CTXL - 1; }
    const u32x4 z4 = {0u, 0u, 0u, 0u};
    const u32x4 p = *(const u32x4*)(PRW + (size_t)r * PRW_LD + c);
    const u32x4 pv = first ? z4 : *(const u32x4*)(PRW + (size_t)(r - 1) * PRW_LD + c);
    const u32x4 nx = last ? z4 : *(const u32x4*)(PRW + (size_t)(r + 1) * PRW_LD + c);
    const f32x4 m0 = *(const f32x4*)(P.rwkv_mu + c), m1 = *(const f32x4*)(P.rwkv_mu + c + 4);
    float o[8];
#define SHF(e, W, MU, HI) { const float pp = HI ? bfhi(p.W) : bflo(p.W), a = HI ? bfhi(pv.W) : bflo(pv.W), b = HI ? bfhi(nx.W) : bflo(nx.W); o[e] = pp + MU * (0.5f * (a + b) - pp); }
    SHF(0, x, m0.x, 0) SHF(1, x, m0.y, 1) SHF(2, y, m0.z, 0) SHF(3, y, m0.w, 1) SHF(4, z, m1.x, 0) SHF(5, z, m1.y, 1) SHF(6, w, m1.z, 0) SHF(7, w, m1.w, 1)
#undef SHF
    bf16_t* dst;
    if (c < 3072) dst = SH + (size_t)r * SH_LD + c;
    else { const int cl = c - 3072; dst = LIN + (size_t)r * LIN_LD + cl;
      if (cl < 128) {
#pragma unroll
        for (int e = 0; e < 8; ++e) { const float ex = __builtin_amdgcn_exp2f(2.8853900817779268f * o[e]); o[e] = 1.f - 2.f * __builtin_amdgcn_rcpf(ex + 1.f); }
      } else if (cl >= 256) {
#pragma unroll
        for (int e = 0; e < 8; ++e) o[e] = sigmoidf_(o[e]);
      } }
    u32x4 w; w.x = cvt_pk_bf16(o[0], o[1]); w.y = cvt_pk_bf16(o[2], o[3]); w.z = cvt_pk_bf16(o[4], o[5]); w.w = cvt_pk_bf16(o[6], o[7]);
    *(u32x4*)dst = w;
  }
}
__device__ __forceinline__ float SFMA(float a, float b, float c) { float d; asm("v_fma_f32 %0, %1, %2, %3" : "=v"(d) : "v"(a), "v"(b), "v"(c)); return d; }
__device__ __forceinline__ float SMUL(float a, float b) { float d; asm("v_mul_f32 %0, %1, %2" : "=v"(d) : "v"(a), "v"(b)); return d; }
__device__ __forceinline__ float allred8(float x) { x += dpp_mov<0xB1>(x); x += dpp_mov<0x4E>(x); x += dpp_mov<0x141>(x); return x; }
__device__ __forceinline__ void scan_phase(const Params& P, LAS unsigned char* lds, const int tid) {
  LAS float* F = (LAS float*)lds;
  LAS unsigned short* YB = (LAS unsigned short*)(lds + 2 * 32 * 384 * 4);
  const bf16_t* SH = (const bf16_t*)(P.ws + OFF_SH); const bf16_t* LO = (const bf16_t*)(P.ws + OFF_LO); bf16_t* Y = (bf16_t*)(P.ws + OFF_Y);
  const int wid = __builtin_amdgcn_readfirstlane(tid >> 6), lane = tid & 63;
  constexpr int NCH = SKV / 32;
#define SCAN_BAR() do { asm volatile("s_waitcnt lgkmcnt(0)" ::: "memory"); __builtin_amdgcn_s_barrier(); asm volatile("" ::: "memory"); } while (0)
  for (int task = P.bid; task < 256; task += P.grd) {
    const int half = (task >> 3) & 1, chain = (task & 7) | ((task >> 4) << 3);
    const int dir = chain & 1, h = (chain >> 1) & 15, b = chain >> 5, hc = h * 64;
#define ROWOF(g) ((g) < CTXL ? (MT + b * CTXL + (dir ? CTXL - 1 - (g) : (g))) : (b * SEQ + (dir ? SEQ - 1 - ((g) - CTXL) : ((g) - CTXL))))
    if (wid < 4) {
      const int rloc = wid * 8 + (lane >> 3), irow = half * 32 + rloc, cA = (lane & 7) * 4, cB = 32 + cA;
      f32x4 S0 = {0.f, 0.f, 0.f, 0.f}, S1 = {0.f, 0.f, 0.f, 0.f};
      SCAN_BAR();
      for (int q = 0; q < NCH; ++q) {
        const LAS float* f = F + (q & 1) * 32 * 384;
        LAS unsigned short* yb = YB + (q & 1) * 1024;
        f32x4 w0 = *(const LAS f32x4*)(f + cA), w1 = *(const LAS f32x4*)(f + cB);
        f32x4 a0 = *(const LAS f32x4*)(f + 64 + cA), a1 = *(const LAS f32x4*)(f + 64 + cB);
        f32x4 b0 = *(const LAS f32x4*)(f + 128 + cA), b1 = *(const LAS f32x4*)(f + 128 + cB);
        f32x4 k0 = *(const LAS f32x4*)(f + 192 + cA), k1 = *(const LAS f32x4*)(f + 192 + cB);
        f32x4 r0 = *(const LAS f32x4*)(f + 256 + cA), r1 = *(const LAS f32x4*)(f + 256 + cB);
        float vv = f[320 + irow];
        float ykeep = 0.f;
#pragma unroll 2
        for (int s = 0; s < 32; ++s) {
          const LAS float* fn = f + (s < 31 ? s + 1 : 31) * 384;
          const f32x4 nw0 = *(const LAS f32x4*)(fn + cA), nw1 = *(const LAS f32x4*)(fn + cB);
          const f32x4 na0 = *(const LAS f32x4*)(fn + 64 + cA), na1 = *(const LAS f32x4*)(fn + 64 + cB);
          const f32x4 nb0 = *(const LAS f32x4*)(fn + 128 + cA), nb1 = *(const LAS f32x4*)(fn + 128 + cB);
          const f32x4 nk0 = *(const LAS f32x4*)(fn + 192 + cA), nk1 = *(const LAS f32x4*)(fn + 192 + cB);
          const f32x4 nr0 = *(const LAS f32x4*)(fn + 256 + cA), nr1 = *(const LAS f32x4*)(fn + 256 + cB);
          const float nvv = fn[320 + irow];
          __builtin_amdgcn_sched_barrier(0);
          f32x4 p = S0 * a0 + S1 * a1;
          const float sa_ = allred8((p.x + p.y) + (p.z + p.w));
          S0 = S0 * w0 + (b0 * sa_ + k0 * vv);
          S1 = S1 * w1 + (b1 * sa_ + k1 * vv);
          p = S0 * r0 + S1 * r1;
          const float y = allred8((p.x + p.y) + (p.z + p.w));
          ykeep = ((s & 7) == (lane & 7)) ? y : ykeep;
          if ((s & 7) == 7) yb[((s & ~7) + (lane & 7)) * 32 + rloc] = f2bf(ykeep);
          __builtin_amdgcn_sched_barrier(0);
          w0 = nw0; w1 = nw1; a0 = na0; a1 = na1; b0 = nb0; b1 = nb1; k0 = nk0; k1 = nk1; r0 = nr0; r1 = nr1; vv = nvv;
        }
        SCAN_BAR();
      }
    } else {
      const int sw = wid - 4, hw = lane >> 5, cp = (lane & 31) * 2;
      const f32x2 kk_c = *(const f32x2*)(P.k_k + hc + cp), ka_c = *(const f32x2*)(P.k_a + hc + cp);
      unsigned voS[4], voL[4];
#pragma unroll
      for (int e = 0; e < 4; ++e) { const int tk = hw * 4 + e, ro = dir ? 7 - tk : tk; voS[e] = (unsigned)(ro * SH_LD + cp) * 2u; voL[e] = (unsigned)(ro * LO_LD + cp) * 2u; }
      unsigned sr[4], sk[4], sv[4], sl[4], sa[4];
#define RMIN(q) ({ const int g0_ = (q) * 32 + sw * 8; const int ra_ = ROWOF(g0_), rb_ = ROWOF(g0_ + 7); ra_ < rb_ ? ra_ : rb_; })
#define SLOADQ(q) do { const size_t rmin_ = (size_t)RMIN(q); const char* bs_ = (const char*)(SH + rmin_ * SH_LD + hc); const char* bl_ = (const char*)(LO + rmin_ * LO_LD + dir * 1024 + hc); \
      _Pragma("unroll") for (int e = 0; e < 4; ++e) { sr[e] = *(const unsigned*)(bs_ + voS[e]); sk[e] = *(const unsigned*)(bs_ + 2048 + voS[e]); sv[e] = *(const unsigned*)(bs_ + 4096 + voS[e]); \
        sl[e] = *(const unsigned*)(bl_ + voL[e]); sa[e] = *(const unsigned*)(bl_ + 4096 + voL[e]); } } while (0)
#define SWRITEQ(buf) do { _Pragma("unroll") for (int e = 0; e < 4; ++e) { LAS float* f_ = F + ((buf) * 32 + sw * 8 + hw * 4 + e) * 384 + cp; \
      const f32x2 r_ = {bflo(sr[e]), bfhi(sr[e])}, k_ = {bflo(sk[e]), bfhi(sk[e])}, v_ = {bflo(sv[e]), bfhi(sv[e])}, lam = {bflo(sl[e]), bfhi(sl[e])}, aa = {bflo(sa[e]), bfhi(sa[e])}; \
      const f32x2 kkr = k_ * kk_c; float ssq = allred16(kkr.x * kkr.x + kkr.y * kkr.y); \
      { auto rr_ = __builtin_amdgcn_permlane16_swap(__float_as_uint(ssq), __float_as_uint(ssq), false, false); ssq = __uint_as_float(rr_[0]) + __uint_as_float(rr_[1]); } \
      const f32x2 kk = kkr * rsqrtf(fmaxf(ssq, 1e-24f)); \
      f32x2 wv; wv.x = __builtin_amdgcn_exp2f(-lam.x); wv.y = __builtin_amdgcn_exp2f(-lam.y); \
      *(LAS f32x2*)(f_) = wv; *(LAS f32x2*)(f_ + 64) = -kk; *(LAS f32x2*)(f_ + 128) = kk * aa; *(LAS f32x2*)(f_ + 192) = k_ * ((aa - 1.f) * ka_c + 1.f); \
      *(LAS f32x2*)(f_ + 256) = r_; *(LAS f32x2*)(f_ + 320) = v_; } } while (0)
      SLOADQ(0); SWRITEQ(0); SLOADQ(1);
      SCAN_BAR();
      for (int q = 0; q < NCH; ++q) {
        if (q >= 9) {
          const int qq = q - 1; const LAS unsigned short* yb = YB + (qq & 1) * 1024;
          const int t256 = sw * 64 + lane, s = t256 >> 3, rp = (t256 & 7) * 4; const int u = qq * 32 + s - CTXL; const int t = dir ? SEQ - 1 - u : u;
          const u32x2 val = *(const LAS u32x2*)(yb + s * 32 + rp);
          *(u32x2*)(Y + (size_t)dir * MT * 1024 + (size_t)(b * SEQ + t) * 1024 + hc + half * 32 + rp) = val;
        }
        if (q + 1 < NCH) SWRITEQ((q + 1) & 1);
        if (q + 2 < NCH) SLOADQ(q + 2);
        SCAN_BAR();
      }
      {
        const int qq = NCH - 1; const LAS unsigned short* yb = YB + (qq & 1) * 1024;
        const int t256 = sw * 64 + lane, s = t256 >> 3, rp = (t256 & 7) * 4; const int u = qq * 32 + s - CTXL; const int t = dir ? SEQ - 1 - u : u;
        const u32x2 val = *(const LAS u32x2*)(yb + s * 32 + rp);
        *(u32x2*)(Y + (size_t)dir * MT * 1024 + (size_t)(b * SEQ + t) * 1024 + hc + half * 32 + rp) = val;
      }
#undef SLOADQ
#undef SWRITEQ
#undef RMIN
    }
#undef ROWOF
    __syncthreads();
  }
#undef SCAN_BAR
}
__device__ __forceinline__ float half_sum(float v) {
  v = allred16(v);
  auto rr = __builtin_amdgcn_permlane16_swap(__float_as_uint(v), __float_as_uint(v), false, false); return __uint_as_float(rr[0]) + __uint_as_float(rr[1]);
}
__device__ __forceinline__ void rwkv_out_phase(const Params& P, const int tid) {
  const bf16_t* SH = (const bf16_t*)(P.ws + OFF_SH); const bf16_t* LO = (const bf16_t*)(P.ws + OFF_LO); bf16_t* Y = (bf16_t*)(P.ws + OFF_Y);
  const int wid = tid >> 6, lane = tid & 63, hw = lane >> 5, cp = (lane & 31) * 2;
  const int gw = P.bid * 8 + wid, NGW = P.grd * 8;
  for (int task = gw * 2; task < MT * 8; task += NGW * 2) {
    unsigned yf[2], ybk[2], rr[2], kk[2], vv[2], af[2], ab[2], gg[2]; int cc[2]; size_t tk[2];
#pragma unroll
    for (int u = 0; u < 2; ++u) { const int t_ = task + u; tk[u] = (size_t)(t_ >> 3); cc[u] = ((t_ & 7) * 2 + hw) * 64 + cp;
      const bf16_t* py = Y + tk[u] * 1024 + cc[u]; const bf16_t* ps = SH + tk[u] * SH_LD + cc[u]; const bf16_t* pl = LO + tk[u] * LO_LD + cc[u];
      yf[u] = *(const unsigned*)py; ybk[u] = *(const unsigned*)(py + (size_t)MT * 1024);
      rr[u] = *(const unsigned*)ps; kk[u] = *(const unsigned*)(ps + 1024); vv[u] = *(const unsigned*)(ps + 2048);
      af[u] = *(const unsigned*)(pl + 2048); ab[u] = *(const unsigned*)(pl + 3072); gg[u] = *(const unsigned*)(pl + 4096); }
    unsigned res[2];
#pragma unroll
    for (int u = 0; u < 2; ++u) {
      const f32x2 lw = *(const f32x2*)(P.ln_x_w + cc[u]), lb = *(const f32x2*)(P.ln_x_b + cc[u]), ka = *(const f32x2*)(P.k_a + cc[u]), rk = *(const f32x2*)(P.r_k + cc[u]);
      const f32x2 y = {bflo(yf[u]) + bflo(ybk[u]), bfhi(yf[u]) + bfhi(ybk[u])};
      const float mu = half_sum(y.x + y.y) * (1.f / 64.f); const f32x2 dv = y - mu; const float var = half_sum(dv.x * dv.x + dv.y * dv.y) * (1.f / 64.f);
      const f32x2 yn = dv * rsqrtf(var + 64e-5f) * lw + lb;
      const f32x2 r = {bflo(rr[u]), bfhi(rr[u])}, k = {bflo(kk[u]), bfhi(kk[u])}, v = {bflo(vv[u]), bfhi(vv[u])};
      const f32x2 a1 = {bflo(af[u]), bfhi(af[u])}, a2 = {bflo(ab[u]), bfhi(ab[u])}, g = {bflo(gg[u]), bfhi(gg[u])};
      const f32x2 kms = k * ((a1 - 1.f) * ka + 1.f) + k * ((a2 - 1.f) * ka + 1.f);
      const f32x2 bt = r * kms * rk;
      const float bonus = half_sum(bt.x + bt.y);
      const f32x2 o = (yn + v * bonus) * g;
      res[u] = cvt_pk_bf16(o.x, o.y);
    }
#pragma unroll
    for (int u = 0; u < 2; ++u) *(unsigned*)(Y + tk[u] * 1024 + cc[u]) = res[u];
  }
}
__device__ __forceinline__ void rope_phase(const Params& P, const int tid) {
  bf16_t* Q = (bf16_t*)(P.ws + OFF_Q); bf16_t* KB = (bf16_t*)(P.ws + OFF_KB);
  const int wid = tid >> 6, lane = tid & 63, hw = lane >> 5, li = lane & 31;
  const int gw = P.bid * 8 + wid, NGW = P.grd * 8;
  const int d1 = li < 16 ? 2 * li : 64 + 2 * (li - 16);
  const f32x2 qgA = *(const f32x2*)(P.q_norm + d1), qgB = *(const f32x2*)(P.q_norm + d1 + 32), kgA = *(const f32x2*)(P.k_norm + d1), kgB = *(const f32x2*)(P.k_norm + d1 + 32);
  const int j0 = 2 * (li & 15);
  const float inv0 = __builtin_amdgcn_exp2f(-(float)(2 * j0) * (13.287712379549449f / 64.f)), inv1 = __builtin_amdgcn_exp2f(-(float)(2 * j0 + 2) * (13.287712379549449f / 64.f));
  for (int task = gw; task < MA; task += NGW) {
    if (task < MT) {
      const int tok = task, b = tok >> 13, t = tok & (SEQ - 1);
      const float pos = (float)(li < 16 ? (t >> 6) : (t & 63));
      const float an0 = pos * inv0, an1 = pos * inv1;
      const f32x2 sn = {__sinf(an0), __sinf(an1)}, cs = {__cosf(an0), __cosf(an1)};
      unsigned lo[10], hi[10]; bf16_t* ptr[10];
#pragma unroll
      for (int i = 0; i < 10; ++i) { const int hd = 2 * i + hw;
        ptr[i] = (hd < 16 ? Q + (size_t)tok * DM + hd * 128 : KB + (size_t)(tok + b * CTXL) * 512 + (hd - 16) * 128) + d1;
        lo[i] = *(const unsigned*)ptr[i]; hi[i] = *(const unsigned*)(ptr[i] + 32); }
#pragma unroll
      for (int i = 0; i < 10; ++i) { const bool isq = i < 8;
        const f32x2 t1 = {bflo(lo[i]), bfhi(lo[i])}, t2 = {bflo(hi[i]), bfhi(hi[i])};
        const float ss = half_sum((t1.x * t1.x + t1.y * t1.y) + (t2.x * t2.x + t2.y * t2.y)); const float rs = rsqrtf(ss * (1.f / 128.f) + 1e-6f);
        const f32x2 n1 = t1 * rs * (isq ? qgA : kgA), n2 = t2 * rs * (isq ? qgB : kgB);
        const f32x2 o1 = n1 * cs - n2 * sn, o2 = n2 * cs + n1 * sn;
        lo[i] = cvt_pk_bf16(o1.x, o1.y); hi[i] = cvt_pk_bf16(o2.x, o2.y); }
#pragma unroll
      for (int i = 0; i < 10; ++i) { *(unsigned*)ptr[i] = lo[i]; *(unsigned*)(ptr[i] + 32) = hi[i]; }
    } else {
      const int ct = task - MT, b = ct >> 8, t = ct & (CTXL - 1);
      unsigned lo[2], hi[2]; bf16_t* ptr[2];
#pragma unroll
      for (int i = 0; i < 2; ++i) { ptr[i] = KB + (size_t)(b * SKV + SEQ + t) * 512 + (2 * i + hw) * 128 + d1; lo[i] = *(const unsigned*)ptr[i]; hi[i] = *(const unsigned*)(ptr[i] + 32); }
#pragma unroll
      for (int i = 0; i < 2; ++i) {
        const f32x2 t1 = {bflo(lo[i]), bfhi(lo[i])}, t2 = {bflo(hi[i]), bfhi(hi[i])};
        const float ss = half_sum((t1.x * t1.x + t1.y * t1.y) + (t2.x * t2.x + t2.y * t2.y)); const float rs = rsqrtf(ss * (1.f / 128.f) + 1e-6f);
        const f32x2 n1 = t1 * rs * kgA, n2 = t2 * rs * kgB;
        *(unsigned*)ptr[i] = cvt_pk_bf16(n1.x, n1.y); *(unsigned*)(ptr[i] + 32) = cvt_pk_bf16(n2.x, n2.y); }
    }
  }
}
__device__ __forceinline__ void attn_phase(const Params& P, unsigned char* smem, const int tid) {
  bf16_t* Q = (bf16_t*)(P.ws + OFF_Q); const bf16_t* KB = (const bf16_t*)(P.ws + OFF_KB); const bf16_t* VB = (const bf16_t*)(P.ws + OFF_VB);
  for (int u = P.bid; u < 2048; u += P.grd) {
    const int xcd = u & 7, slot = (u >> 3) & 31, rnd = u >> 8, pair = xcd + 8 * (rnd >> 2), w = (rnd & 3) * 32 + slot;
    const int b = pair >> 2, kvh = pair & 3, g = w & 3, qb = w >> 2, head = kvh * 4 + g;
    bf16_t* Qb = Q + (size_t)(b * SEQ + qb * 256) * DM + head * 128;
    const bf16_t* Kh = KB + (size_t)b * SKV * 512 + kvh * 128; const bf16_t* Vh = VB + (size_t)b * SKV * 512 + kvh * 128;
    att::attn_dense_body(Qb, Kh, Vh, Qb, SKV, (char*)smem, tid);
    __syncthreads();
  }
}
__device__ __forceinline__ void final_norm_phase(const Params& P, const int tid) {
  const int wid = tid >> 6, lane = tid & 63;
  const int gw = P.bid * 8 + wid, NGW = P.grd * 8;
  f32x4 g4[8];
#pragma unroll
  for (int j = 0; j < 8; ++j) g4[j] = *(const f32x4*)(P.norm_final + j * 256 + lane * 4);
  for (int r = gw; r < MT; r += NGW) {
    float* xr = P.out + (size_t)r * DM;
    f32x4 v[8]; float ss = 0.f;
#pragma unroll
    for (int j = 0; j < 8; ++j) v[j] = *(const f32x4*)(xr + j * 256 + lane * 4);
#pragma unroll
    for (int j = 0; j < 8; ++j) ss += v[j].x * v[j].x + v[j].y * v[j].y + v[j].z * v[j].z + v[j].w * v[j].w;
    ss = wave_sum(ss);
    const float rs = rsqrtf(ss * (1.f / DM) + 1e-6f);
#pragma unroll
    for (int j = 0; j < 8; ++j) *(f32x4*)(xr + j * 256 + lane * 4) = v[j] * rs * g4[j];
  }
}

constexpr int NPH = 20;
__device__ __forceinline__ bool gemm_desc(int ph, const Params& P, GemmDesc& d) {
  unsigned char* ws = P.ws;
  const bf16_t* H = (const bf16_t*)(ws + OFF_H);
  d.G = P.grd; d.c = P.bid; d.A1 = nullptr; d.B1 = nullptr; d.pm01 = 0; d.nN1 = 1; d.n1 = 0; d.pm00 = 0; d.xin = nullptr; d.gidx = 0; d.gscale = 0.f; d.act = nullptr;
  switch (ph) {
  case 2: d.K = 2048; d.mode = M_SWIGLU; d.A0 = H; d.B0 = (const bf16_t*)(ws + OFF_W1A); d.nM0 = 132; d.nN0 = 44; d.act = (bf16_t*)(ws + OFF_ACT); break;
  case 3: d.K = DFF; d.mode = M_RESID; d.A0 = (const bf16_t*)(ws + OFF_ACT); d.B0 = (const bf16_t*)(ws + OFF_W1B); d.nM0 = 132; d.nN0 = 8; d.xin = P.x; d.gidx = 2; d.gscale = 0.5f; break;
  case 5: d.K = 2048; d.mode = M_RW; d.A0 = H; d.B0 = (const bf16_t*)(ws + OFF_WRW); d.nM0 = 132; d.nN0 = 14;
          d.A1 = H; d.B1 = (const bf16_t*)(ws + OFF_WQKVG) + (size_t)2048 * 2048; d.pm01 = 128; d.nN1 = 4; d.n1 = 16; break;
  case 7: d.K = 384; d.mode = M_LORA; d.A0 = (const bf16_t*)(ws + OFF_LIN); d.B0 = (const bf16_t*)(ws + OFF_WLORA); d.nM0 = 132; d.nN0 = 20; break;
  case 10: d.K = 2048; d.mode = M_QKVG; d.A0 = H; d.B0 = (const bf16_t*)(ws + OFF_WQKVG); d.nM0 = 128; d.nN0 = 28; break;
  case 13: d.K = 2048; d.mode = M_T1; d.A0 = (const bf16_t*)(ws + OFF_Q); d.B0 = (const bf16_t*)(ws + OFF_WOA); d.nM0 = 128; d.nN0 = 8; break;
  case 14: d.K = 1024; d.mode = M_M; d.A0 = (const bf16_t*)(ws + OFF_Y); d.B0 = (const bf16_t*)(ws + OFF_WOR); d.nM0 = 128; d.nN0 = 8; break;
  case 15: d.K = 2048; d.mode = M_RESID; d.A0 = (const bf16_t*)(ws + OFF_GR); d.B0 = (const bf16_t*)(ws + OFF_WOUT); d.nM0 = 128; d.nN0 = 8; d.xin = P.out; d.gidx = 5; d.gscale = 1.f; break;
  case 17: d.K = 2048; d.mode = M_SWIGLU; d.A0 = H; d.B0 = (const bf16_t*)(ws + OFF_W2A); d.nM0 = 128; d.nN0 = 44; d.act = (bf16_t*)(ws + OFF_ACT); break;
  case 18: d.K = DFF; d.mode = M_RESID; d.A0 = (const bf16_t*)(ws + OFF_ACT); d.B0 = (const bf16_t*)(ws + OFF_W2B); d.nM0 = 128; d.nN0 = 8; d.xin = P.out; d.gidx = 8; d.gscale = 0.5f; break;
  default: return false;
  }
  d.n0 = d.nM0 * d.nN0;
  return true;
}

__global__ void __launch_bounds__(512) mega_fwd(Params P) {
  extern __shared__ __attribute__((aligned(16))) unsigned char smem[];
  LAS unsigned char* lds = (LAS unsigned char*)smem;
  cg::grid_group grid = cg::this_grid();
#pragma nounroll
  for (int ph = P.ph_lo; ph < P.ph_hi; ++ph) {
    GemmDesc d;
    int tid = threadIdx.x; asm volatile("" : "+v"(tid));
#if PROBE
    if (blockIdx.x == 0 && tid == 0) ((LAS unsigned long long*)(lds + LDS_BYTES))[ph] = __builtin_amdgcn_s_memrealtime();
#endif
    const __attribute__((address_space(4))) Params* kp = (const __attribute__((address_space(4))) Params*)__builtin_amdgcn_kernarg_segment_ptr();
    asm volatile("" : "+s"(kp));
#if defined(__HIP_DEVICE_COMPILE__)
    Params L = *kp;
#else
    Params L = P;
#endif
    { int b_ = blockIdx.x, g_ = gridDim.x; asm volatile("" : "+s"(b_), "+s"(g_)); L.bid = b_; L.grd = g_; }
    if (gemm_desc(ph, L, d)) gemm_phase(lds, d, L, tid);
    else switch (ph) {
      case 0: mod_phase(L, lds, tid); __syncthreads(); convert_phase(L, lds, tid); break;
      case 1: norm_mod_phase(L, L.x, L.ctx, MA, L.norm_ffn1, 0, tid); break;
      case 4: norm_mod_phase(L, L.out, (const float*)(L.ws + OFF_CX), MA, L.norm_mix, 3, tid); break;
      case 6: shift_phase(L, tid); break;
      case 8: scan_phase(L, lds, tid); break;
      case 9: rwkv_out_phase(L, tid); break;
      case 11: rope_phase(L, tid); break;
      case 12: attn_phase(L, smem, tid); break;
      case 16: norm_mod_phase(L, L.out, nullptr, MT, L.norm_ffn2, 6, tid); break;
      case 19: final_norm_phase(L, tid); break;
      default: break;
    }
    if (ph + 1 < P.ph_hi) grid.sync();
  }
#if PROBE
  grid.sync();
  if (blockIdx.x == 0) {
    LAS unsigned long long* TS = (LAS unsigned long long*)(lds + LDS_BYTES);
    if (threadIdx.x == 0) TS[NPH] = __builtin_amdgcn_s_memrealtime();
    __syncthreads();
    const int K = (int)((TS[PROBE_HI] - TS[PROBE_LO]) / 100ull);
    int t2 = threadIdx.x; asm volatile("" : "+v"(t2));
    for (int i = t2; i < K && i < 16000; i += 512) P.out[(size_t)i * 4099] += 0.1f;
  }
#endif
}

extern "C" void kernel_launch(void* const* d_in, const int* in_sizes, int n_in, void* d_out, int out_size, void* d_ws, size_t ws_size, hipStream_t stream) {
  static int grid_blocks = 0;
  if (!grid_blocks) {
    if (n_in != 31 || out_size != MT * DM || ws_size < WS_END) { fprintf(stderr, "kernel_launch: unexpected shapes n_in %d out %d ws %zu (need %zu)\n", n_in, out_size, ws_size, WS_END); return; }
    if (hipFuncSetAttribute((const void*)mega_fwd, hipFuncAttributeMaxDynamicSharedMemorySize, LDS_BYTES + 256) != hipSuccess) { fprintf(stderr, "kernel_launch: hipFuncSetAttribute failed\n"); return; }
    int dev = 0, cus = 0, per_cu = 0;
    hipGetDevice(&dev);
    hipDeviceGetAttribute(&cus, hipDeviceAttributeMultiprocessorCount, dev);
    hipOccupancyMaxActiveBlocksPerMultiprocessor(&per_cu, mega_fwd, 512, LDS_BYTES + 256);
    if (per_cu < 1) { fprintf(stderr, "kernel_launch: occupancy query returned %d\n", per_cu); per_cu = 1; }
    grid_blocks = cus;
  }
  Params p{};
  const float** pf = (const float**)&p;
  for (int i = 0; i < 31; ++i) pf[i] = (const float*)d_in[i];
  p.out = (float*)d_out; p.ws = (unsigned char*)d_ws; p.bid = 0; p.grd = 0;
#if ONE_LAUNCH
  p.ph_lo = 0; p.ph_hi = NPH;
  void* args[] = {&p};
  hipError_t e = hipLaunchCooperativeKernel((const void*)mega_fwd, dim3(grid_blocks), dim3(512), args, LDS_BYTES + 256, stream);
  if (e != hipSuccess) fprintf(stderr, "cooperative launch failed: %s (grid %d)\n", hipGetErrorString(e), grid_blocks);
#else
  for (int ph = 0; ph < NPH; ++ph) { p.ph_lo = ph; p.ph_hi = ph + 1; hipLaunchKernelGGL(mega_fwd, dim3(grid_blocks), dim3(512), LDS_BYTES + 256, stream, p); }
#endif
}
```

```cpp
#include <hip/hip_runtime.h>
#include <hip/hip_cooperative_groups.h>
#include <cstdio>
#include <cstdint>
namespace cg = cooperative_groups;

#ifndef ONE_LAUNCH
#define ONE_LAUNCH 1
#endif

#ifndef PROBE
#define PROBE 0
#endif
#define PROBE_LO 8
#define PROBE_HI 9
#define LAS __attribute__((address_space(3)))
typedef unsigned short bf16_t;
typedef short bf16x8 __attribute__((ext_vector_type(8)));
typedef short s16x4 __attribute__((ext_vector_type(4)));
typedef float f32x4 __attribute__((ext_vector_type(4)));
typedef float f32x2 __attribute__((ext_vector_type(2)));
typedef float f32x16 __attribute__((ext_vector_type(16)));
typedef unsigned u32x4 __attribute__((ext_vector_type(4)));
typedef unsigned u32x2 __attribute__((ext_vector_type(2)));

constexpr int DM = 2048, NB = 4, SEQ = 8192, CTXL = 256, MT = NB * SEQ, MC = NB * CTXL, MA = MT + MC;
constexpr int DFF = 5632, SKV = SEQ + CTXL, NMODC = 9 * DM;
constexpr int PRW_LD = 3584, SH_LD = 3072, LIN_LD = 384, LO_LD = 5120;
constexpr int LDS_BYTES = 131072;

constexpr size_t SZ_WA = (size_t)11264 * 2048 * 2, SZ_WB = (size_t)2048 * 5632 * 2;
constexpr size_t OFF_W1A = 0, OFF_W1B = OFF_W1A + SZ_WA, OFF_W2A = OFF_W1B + SZ_WB, OFF_W2B = OFF_W2A + SZ_WA;
constexpr size_t OFF_WRW = OFF_W2B + SZ_WB, OFF_WQKVG = OFF_WRW + (size_t)3584 * 2048 * 2, OFF_WOA = OFF_WQKVG + (size_t)7168 * 2048 * 2;
constexpr size_t OFF_WOR = OFF_WOA + (size_t)2048 * 2048 * 2, OFF_WOUT = OFF_WOR + (size_t)2048 * 1024 * 2, OFF_WLORA = OFF_WOUT + (size_t)2048 * 2048 * 2;
constexpr size_t OFF_MOD = OFF_WLORA + (size_t)5120 * 384 * 2, OFF_CX = OFF_MOD + (size_t)5 * NMODC * 4, OFF_H = OFF_CX + (size_t)MC * DM * 4;
constexpr size_t OFF_BIG = OFF_H + (size_t)MA * DM * 2;
constexpr size_t SZ_KV = (size_t)NB * SKV * 512 * 2;
constexpr size_t OFF_KB = OFF_W1A, OFF_VB = OFF_KB + SZ_KV;
static_assert(OFF_VB + SZ_KV <= OFF_W2A, "KV overlay");
constexpr size_t OFF_ACT = OFF_BIG;
constexpr size_t OFF_PRW = OFF_BIG, OFF_LO = OFF_BIG, OFF_SH = OFF_LO + (size_t)MA * LO_LD * 2, OFF_LIN = OFF_SH + (size_t)MA * SH_LD * 2, OFF_Y = OFF_LIN;
constexpr size_t OFF_Q = OFF_BIG, OFF_GA = OFF_Q + (size_t)MT * DM * 2, OFF_GR = OFF_GA + (size_t)MT * DM * 2;
constexpr size_t END_A = OFF_ACT + (size_t)MA * DFF * 2, END_B = OFF_Y + (size_t)2 * MT * 1024 * 2, END_C = OFF_LIN + (size_t)MA * LIN_LD * 2;
constexpr size_t WS_END = END_A > END_B ? (END_A > END_C ? END_A : END_C) : (END_B > END_C ? END_B : END_C);
constexpr size_t OFF_BAR = (WS_END + 255) / 256 * 256, WS_TOTAL = OFF_BAR + 3456 * 4;
static_assert((size_t)MA * PRW_LD * 2 <= (size_t)MA * LO_LD * 2, "PRW under LO");
static_assert(OFF_GR + (size_t)MT * DM * 2 <= OFF_Y, "GR below RWO");

struct Params {
  const float *x, *c, *ctx, *c_ctx, *w_mod, *b_mod, *norm_ffn1, *ffn1_w_in, *ffn1_w_out, *norm_mix, *w_in, *q_norm, *k_norm, *rwkv_mu, *w0, *w2, *a0, *a2,
      *g2, *k_k, *k_a, *r_k, *ln_x_w, *ln_x_b, *w_oa, *w_or, *w_out, *norm_ffn2, *ffn2_w_in, *ffn2_w_out, *norm_final;
  float* out; unsigned char* ws; int ph_lo, ph_hi; int bid, grd;
};

__device__ __forceinline__ unsigned cvt_pk_bf16(float lo, float hi) { unsigned r; asm("v_cvt_pk_bf16_f32 %0, %1, %2" : "=v"(r) : "v"(lo), "v"(hi)); return r; }
__device__ __forceinline__ float bf2f(unsigned short b) { return __uint_as_float(((unsigned)b) << 16); }
__device__ __forceinline__ float bflo(unsigned w) { return __uint_as_float(w << 16); }
__device__ __forceinline__ float bfhi(unsigned w) { return __uint_as_float(w & 0xffff0000u); }
__device__ __forceinline__ unsigned short f2bf(float f) { return (unsigned short)(cvt_pk_bf16(f, 0.f) & 0xffffu); }
__device__ __forceinline__ float sigmoidf_(float x) { return __builtin_amdgcn_rcpf(1.f + __builtin_amdgcn_exp2f(-1.4426950408889634f * x)); }
template <int CTRL> __device__ __forceinline__ float dpp_mov(float x) { return __int_as_float(__builtin_amdgcn_update_dpp(0, __float_as_int(x), CTRL, 0xF, 0xF, true)); }
__device__ __forceinline__ float allred16(float x) {
  x += dpp_mov<0xB1>(x); x += dpp_mov<0x4E>(x); x += dpp_mov<0x141>(x); x += dpp_mov<0x140>(x); return x;
}

__device__ __forceinline__ float wave_sum(float v) {
  v = allred16(v);
  { auto rr = __builtin_amdgcn_permlane16_swap(__float_as_uint(v), __float_as_uint(v), false, false); v = __uint_as_float(rr[0]) + __uint_as_float(rr[1]); }
  { auto rr = __builtin_amdgcn_permlane32_swap(__float_as_uint(v), __float_as_uint(v), false, false); v = __uint_as_float(rr[0]) + __uint_as_float(rr[1]); }
  return v;
}

constexpr int BM = 256, BK = 64, HALF = 128, HTB = HALF * BK * 2;
__device__ __forceinline__ int lds_byte(int r, int c) { const int st = (r >> 4) * 2 + (c >> 5), rr = r & 15, cc = c & 31, ob = rr * 64 + cc * 2; return st * 1024 + (ob ^ (((ob >> 9) & 1) << 5)); }
__device__ __forceinline__ void stage_rc(int b, int& R, int& C) { const int st = b / 1024, sb = b % 1024, swz = sb ^ (((sb >> 9) & 1) << 5); R = (st >> 1) * 16 + swz / 64; C = (st & 1) * 32 + (swz % 64) / 2; }
__device__ __forceinline__ int perm32(int rho) { const int n = rho >> 4, i = rho & 15; return 8 * (i >> 2) + 4 * n + (i & 3); }

enum { M_SWIGLU = 0, M_RESID = 1, M_RW = 2, M_QKVG = 3, M_LORA = 4, M_T1 = 5, M_M = 6 };
struct Unit { const char* A; const char* B; int pm, pn, seg; };
struct GemmDesc {
  int K, mode, G, c;
  const bf16_t *A0, *B0; int pm00, nM0, nN0, n0;
  const bf16_t *A1, *B1; int pm01, nN1, n1;
  const float* xin; int gidx; float gscale;
  bf16_t* act;
};
__device__ __forceinline__ bool sched_next(const GemmDesc& d, int i, Unit& u) {
  long L = (long)i * d.G + d.c;
  if (L < d.n0) {
    int wgid = (int)L; const int nwg = d.n0;
    { const int q = nwg / 8, r = nwg % 8, xcd = wgid % 8, off = wgid / 8; wgid = (xcd < r ? xcd * (q + 1) : r * (q + 1) + (xcd - r) * q) + off; }
    const int nig = 8 * d.nN0, gid = wgid / nig, fm = gid * 8, gsz = (d.nM0 - fm) < 8 ? (d.nM0 - fm) : 8;
    const int pm = fm + ((wgid % nig) % gsz), pn = (wgid % nig) / gsz;
    u.pm = d.pm00 + pm; u.pn = pn; u.seg = 0;
    u.A = (const char*)d.A0 + (size_t)u.pm * 512 * d.K; u.B = (const char*)d.B0 + (size_t)pn * 512 * d.K; return true;
  }
  L -= d.n0;
  if (L < d.n1) {
    const int pm = (int)L / d.nN1, pn = (int)L % d.nN1; u.pm = d.pm01 + pm; u.pn = pn; u.seg = 1;
    u.A = (const char*)d.A1 + (size_t)u.pm * 512 * d.K; u.B = (const char*)d.B1 + (size_t)pn * 512 * d.K; return true;
  }
  return false;
}

__device__ __forceinline__ void gemm_epilogue(const f32x4 (&acc)[2][2][4][2], const Unit& u, const GemmDesc& d, const Params& P, int wr, int wc, int fr, int fq) {
  unsigned char* ws = P.ws;
  asm volatile("" : "+v"(fr), "+v"(fq));
  const int rl0 = wr * 64 + fr, cl0 = wc * 32 + 8 * fq;
  switch (d.mode) {
  case M_SWIGLU: {
    bf16_t* base = d.act + (size_t)u.pm * 256 * DFF + u.pn * 128 + cl0;
#pragma unroll
    for (int ai = 0; ai < 2; ++ai)
#pragma unroll
      for (int m = 0; m < 4; ++m) {
        const int row = rl0 + 128 * ai + 16 * m;
        float o[8];
#pragma unroll
        for (int n = 0; n < 2; ++n)
#pragma unroll
          for (int j = 0; j < 4; ++j) { const float g = acc[ai][0][m][n][j], up = acc[ai][1][m][n][j]; o[4 * n + j] = g * sigmoidf_(g) * up; }
        u32x4 w; w.x = cvt_pk_bf16(o[0], o[1]); w.y = cvt_pk_bf16(o[2], o[3]); w.z = cvt_pk_bf16(o[4], o[5]); w.w = cvt_pk_bf16(o[6], o[7]);
        *(u32x4*)(base + (size_t)row * DFF) = w;
      }
  } break;
  case M_RESID: {
    const bool isc = u.pm >= 128; const int b = isc ? 4 : (u.pm >> 5);
    const float* xin = isc ? P.ctx + (size_t)(u.pm - 128) * 256 * DM : d.xin + (size_t)u.pm * 256 * DM;
    float* xo = isc ? (float*)(ws + OFF_CX) + (size_t)(u.pm - 128) * 256 * DM : P.out + (size_t)u.pm * 256 * DM;
    const float* gate = (const float*)(ws + OFF_MOD) + b * NMODC + d.gidx * DM + u.pn * 256 + cl0;
    f32x4 g4[2][2];
#pragma unroll
    for (int bj = 0; bj < 2; ++bj)
#pragma unroll
      for (int n = 0; n < 2; ++n) g4[bj][n] = *(const f32x4*)(gate + 128 * bj + 4 * n) * d.gscale;
#pragma unroll
    for (int ai = 0; ai < 2; ++ai)
#pragma unroll
      for (int m = 0; m < 4; ++m) {
        const size_t ro = (size_t)(rl0 + 128 * ai + 16 * m) * DM + u.pn * 256 + cl0;
#pragma unroll
        for (int bj = 0; bj < 2; ++bj)
#pragma unroll
          for (int n = 0; n < 2; ++n) {
            const f32x4 xv = *(const f32x4*)(xin + ro + 128 * bj + 4 * n);
            *(f32x4*)(xo + ro + 128 * bj + 4 * n) = xv + g4[bj][n] * acc[ai][bj][m][n];
          }
      }
  } break;
  case M_RW: case M_QKVG: case M_LORA: {
    bf16_t* base; int ld; int act = 0; const float* bias = nullptr;
    if (d.mode == M_RW) {
      if (u.seg == 0) { base = (bf16_t*)(ws + OFF_PRW) + (size_t)u.pm * 256 * PRW_LD + u.pn * 256; ld = PRW_LD; }
      else { const int b = u.pm - 128; base = (bf16_t*)(ws + (u.pn < 2 ? OFF_KB : OFF_VB)) + (size_t)(b * SKV + SEQ) * 512 + (u.pn & 1) * 256; ld = 512; }
    } else if (d.mode == M_QKVG) {
      const int b = u.pm >> 5;
      if (u.pn < 8) { base = (bf16_t*)(ws + OFF_Q) + (size_t)u.pm * 256 * DM + u.pn * 256; ld = DM; }
      else if (u.pn < 12) { base = (bf16_t*)(ws + (u.pn < 10 ? OFF_KB : OFF_VB)) + (size_t)(u.pm * 256 + b * CTXL) * 512 + (u.pn & 1) * 256; ld = 512; }
      else { base = (bf16_t*)(ws + (u.pn < 20 ? OFF_GA : OFF_GR)) + (size_t)u.pm * 256 * DM + ((u.pn - 12) & 7) * 256; ld = DM; act = 1; }
    } else {
      base = (bf16_t*)(ws + OFF_LO) + (size_t)u.pm * 256 * LO_LD + u.pn * 256; ld = LO_LD;
      if (u.pn < 8) { act = 2; bias = P.w0 + u.pn * 256; } else if (u.pn < 16) { act = 1; bias = P.a0 + (u.pn - 8) * 256; }
    }
#pragma unroll
    for (int bj = 0; bj < 2; ++bj) {
      f32x4 b0 = {0.f, 0.f, 0.f, 0.f}, b1 = {0.f, 0.f, 0.f, 0.f};
      if (bias) { b0 = *(const f32x4*)(bias + 128 * bj + cl0); b1 = *(const f32x4*)(bias + 128 * bj + cl0 + 4); }
#pragma unroll
      for (int ai = 0; ai < 2; ++ai)
#pragma unroll
        for (int m = 0; m < 4; ++m) {
          const int row = rl0 + 128 * ai + 16 * m;
          f32x4 v0 = acc[ai][bj][m][0] + b0, v1 = acc[ai][bj][m][1] + b1;
          if (act) {
            const float sc = act == 2 ? 0.60653065971263342f * 1.4426950408889634f : 1.f;
#pragma unroll
            for (int j = 0; j < 4; ++j) { v0[j] = sc * sigmoidf_(v0[j]); v1[j] = sc * sigmoidf_(v1[j]); }
          }
          u32x4 w; w.x = cvt_pk_bf16(v0[0], v0[1]); w.y = cvt_pk_bf16(v0[2], v0[3]); w.z = cvt_pk_bf16(v1[0], v1[1]); w.w = cvt_pk_bf16(v1[2], v1[3]);
          *(u32x4*)(base + (size_t)row * ld + 128 * bj + cl0) = w;
        }
    }
  } break;
  case M_T1: case M_M: {
    bf16_t* ga = (bf16_t*)(ws + OFF_GA) + (size_t)u.pm * 256 * DM + u.pn * 256 + cl0;
    bf16_t* gr = (bf16_t*)(ws + OFF_GR) + (size_t)u.pm * 256 * DM + u.pn * 256 + cl0;
    const bool isM = d.mode == M_M;
#pragma unroll
    for (int ai = 0; ai < 2; ++ai)
#pragma unroll
      for (int m = 0; m < 4; ++m)
#pragma unroll
        for (int bj = 0; bj < 2; ++bj) {
          const size_t o = (size_t)(rl0 + 128 * ai + 16 * m) * DM + 128 * bj;
          const f32x4 v0 = acc[ai][bj][m][0], v1 = acc[ai][bj][m][1];
          const u32x4 a = *(const u32x4*)(ga + o);
          u32x4 w;
          if (!isM) {
            w.x = cvt_pk_bf16(bflo(a.x) * v0[0], bfhi(a.x) * v0[1]); w.y = cvt_pk_bf16(bflo(a.y) * v0[2], bfhi(a.y) * v0[3]);
            w.z = cvt_pk_bf16(bflo(a.z) * v1[0], bfhi(a.z) * v1[1]); w.w = cvt_pk_bf16(bflo(a.w) * v1[2], bfhi(a.w) * v1[3]);
            *(u32x4*)(ga + o) = w;
          } else {
            const u32x4 g = *(const u32x4*)(gr + o);
            w.x = cvt_pk_bf16(bflo(a.x) + bflo(g.x) * v0[0], bfhi(a.x) + bfhi(g.x) * v0[1]); w.y = cvt_pk_bf16(bflo(a.y) + bflo(g.y) * v0[2], bfhi(a.y) + bfhi(g.y) * v0[3]);
            w.z = cvt_pk_bf16(bflo(a.z) + bflo(g.z) * v1[0], bfhi(a.z) + bfhi(g.z) * v1[1]); w.w = cvt_pk_bf16(bflo(a.w) + bflo(g.w) * v1[2], bfhi(a.w) + bfhi(g.w) * v1[3]);
            *(u32x4*)(gr + o) = w;
          }
        }
  } break;
  }
}

__device__ __forceinline__ void gemm_phase(LAS unsigned char* lds, const GemmDesc& d, const Params& P, const int tid) {
  const int wid = __builtin_amdgcn_readfirstlane(tid >> 6), lane = tid & 63, wr = wid >> 2, wc = wid & 3, fr = lane & 15, fq = lane >> 4;
  const int K = d.K, nt = K / BK;
  unsigned voffA[2], voffB[2];
#pragma unroll
  for (int i = 0; i < 2; ++i) { int R, C; stage_rc(tid * 16 + i * 8192, R, C); const int Rb = (R & ~31) + perm32(R & 31);
    voffA[i] = (unsigned)(R * K + C) * 2u; voffB[i] = (unsigned)(Rb * K + C) * 2u; }
  const size_t kstep = (size_t)(BK * 2);
  const size_t hstep = (size_t)HALF * K * 2;
  const unsigned ldsw = (unsigned)wid * 1024u;
  const int aoff = lds_byte(wr * 64 + fr, fq * 8), boff = lds_byte(wc * 32 + fr, fq * 8);
#define PG8_SA(b, h) (((b) * 2 + (h)) * HTB)
#define PG8_SB(b, h) ((4 + (b) * 2 + (h)) * HTB)
#define PG8_STAGE(bufoff, gbase, voff) do { _Pragma("unroll") for (int _i = 0; _i < 2; ++_i) \
    __builtin_amdgcn_global_load_lds((const unsigned*)((const char*)(gbase) + (voff)[_i]), (LAS unsigned*)(lds + (bufoff) + ldsw + _i * 8192), 16, 0, 0); } while (0)
#define PG8_LDA(dst, b, h) do { _Pragma("unroll") for (int m = 0; m < 4; ++m) _Pragma("unroll") for (int k = 0; k < 2; ++k) dst[m][k] = *(const LAS bf16x8*)(lds + PG8_SA(b, h) + aoff + m * 2048 + k * 1024); } while (0)
#define PG8_LDB(dst, b, h) do { _Pragma("unroll") for (int n = 0; n < 2; ++n) _Pragma("unroll") for (int k = 0; k < 2; ++k) dst[n][k] = *(const LAS bf16x8*)(lds + PG8_SB(b, h) + boff + n * 2048 + k * 1024); } while (0)
#define PG8_MMA(ai, bj, At, Bt) do { __builtin_amdgcn_s_setprio(1); _Pragma("unroll") for (int m = 0; m < 4; ++m) _Pragma("unroll") for (int n = 0; n < 2; ++n) _Pragma("unroll") for (int k = 0; k < 2; ++k) \
    acc[ai][bj][m][n] = __builtin_amdgcn_mfma_f32_16x16x32_bf16(Bt[n][k], At[m][k], acc[ai][bj][m][n], 0, 0, 0); __builtin_amdgcn_s_setprio(0); } while (0)
#define PG8_WAIT_V(n) asm volatile("s_waitcnt vmcnt(" #n ")" ::: "memory")
#define PG8_WAIT_L(n) asm volatile("s_waitcnt lgkmcnt(" #n ")" ::: "memory")
#define PG8_BAR __builtin_amdgcn_s_barrier()
#define PG8_SCHED __builtin_amdgcn_sched_barrier(0)
  Unit cur, nxt; int ui = 0;
  if (!sched_next(d, 0, cur)) return;
  f32x4 acc[2][2][4][2];
#pragma unroll
  for (int a = 0; a < 2; ++a)
#pragma unroll
    for (int b = 0; b < 2; ++b)
#pragma unroll
      for (int m = 0; m < 4; ++m)
#pragma unroll
        for (int n = 0; n < 2; ++n) acc[a][b][m][n] = (f32x4){0.f, 0.f, 0.f, 0.f};
  bf16x8 At[4][2], B0[2][2], B1[2][2];
  const char* cA = cur.A; const char* cB = cur.B;
  PG8_STAGE(PG8_SB(0, 0), cB, voffB); PG8_STAGE(PG8_SA(0, 0), cA, voffA); PG8_STAGE(PG8_SB(0, 1), cB + hstep, voffB); PG8_STAGE(PG8_SA(0, 1), cA + hstep, voffA);
  if (wr == 1) PG8_BAR;
  PG8_WAIT_V(4); PG8_BAR;
  PG8_STAGE(PG8_SB(1, 0), cB + kstep, voffB); PG8_STAGE(PG8_SA(1, 0), cA + kstep, voffA); PG8_STAGE(PG8_SB(1, 1), cB + hstep + kstep, voffB);
  PG8_WAIT_V(6); PG8_BAR;
  for (;;) {
    const bool has_next = sched_next(d, ui + 1, nxt);
    const char* nA = has_next ? nxt.A : cA; const char* nB = has_next ? nxt.B : cB;
    for (int t = 0; t < nt; t += 2) {
      const bool last = (t == nt - 2);
      const char* a1 = cA + (size_t)(t + 1) * kstep;
      const char* a2 = last ? nA : cA + (size_t)(t + 2) * kstep; const char* b2 = last ? nB : cB + (size_t)(t + 2) * kstep;
      const char* a3 = a2 + kstep; const char* b3 = b2 + kstep;
      PG8_LDB(B0, 0, 0); PG8_SCHED; PG8_LDA(At, 0, 0); PG8_STAGE(PG8_SA(1, 1), a1 + hstep, voffA);
      PG8_WAIT_L(8); PG8_BAR; PG8_WAIT_L(0); PG8_MMA(0, 0, At, B0); PG8_BAR; PG8_SCHED;
      PG8_LDB(B1, 0, 1); PG8_STAGE(PG8_SB(0, 0), b2, voffB);
      PG8_BAR; PG8_WAIT_L(0); PG8_MMA(0, 1, At, B1); PG8_BAR;
      PG8_LDA(At, 0, 1); PG8_STAGE(PG8_SA(0, 0), a2, voffA);
      PG8_BAR; PG8_WAIT_L(0); PG8_MMA(1, 0, At, B0); PG8_BAR; PG8_SCHED;
      PG8_STAGE(PG8_SB(0, 1), b2 + hstep, voffB);
      PG8_WAIT_V(6); PG8_BAR; PG8_MMA(1, 1, At, B1); PG8_BAR;
      PG8_LDB(B0, 1, 0); PG8_SCHED; PG8_LDA(At, 1, 0); PG8_STAGE(PG8_SA(0, 1), a2 + hstep, voffA);
      PG8_WAIT_L(8); PG8_BAR; PG8_WAIT_L(0); PG8_MMA(0, 0, At, B0); PG8_BAR; PG8_SCHED;
      PG8_LDB(B1, 1, 1); PG8_STAGE(PG8_SB(1, 0), b3, voffB);
      PG8_BAR; PG8_WAIT_L(0); PG8_MMA(0, 1, At, B1); PG8_BAR;
      PG8_LDA(At, 1, 1); PG8_STAGE(PG8_SA(1, 0), a3, voffA);
      PG8_BAR; PG8_WAIT_L(0); PG8_MMA(1, 0, At, B0); PG8_BAR; PG8_SCHED;
      PG8_STAGE(PG8_SB(1, 1), b3 + hstep, voffB);
      PG8_WAIT_V(6); PG8_BAR; PG8_MMA(1, 1, At, B1); PG8_BAR;
    }
    gemm_epilogue(acc, cur, d, P, wr, wc, fr, fq);
    if (!has_next) break;
#pragma unroll
    for (int a = 0; a < 2; ++a)
#pragma unroll
      for (int b = 0; b < 2; ++b)
#pragma unroll
        for (int m = 0; m < 4; ++m)
#pragma unroll
          for (int n = 0; n < 2; ++n) acc[a][b][m][n] = (f32x4){0.f, 0.f, 0.f, 0.f};
    cur = nxt; cA = nA; cB = nB; ++ui;
  }
  PG8_WAIT_V(0);
  if (wr == 0) PG8_BAR;
  PG8_BAR;
#undef PG8_SA
#undef PG8_SB
#undef PG8_STAGE
#undef PG8_LDA
#undef PG8_LDB
#undef PG8_MMA
#undef PG8_WAIT_V
#undef PG8_WAIT_L
#undef PG8_BAR
#undef PG8_SCHED
}

namespace att {
constexpr int D = 128, NW = 8, QBLK = 32, KVBLK = 64;
constexpr float SCALE = 0.088388347648318440f;
constexpr float THR = 8.f;
constexpr int LDQ = 2048, LDK = 512, LDO = 2048;
constexpr size_t SHM_V = KVBLK * D * 2, SHM_K = KVBLK * D * 2;
#define KSWZ(row, colB) ((row) * 256 + ((colB) ^ (((row) & 7) << 4)))
#define SBAR() __builtin_amdgcn_sched_barrier(0)
__device__ __forceinline__ int crow(int r, int hi) { return (r & 3) + 8 * (r >> 2) + 4 * hi; }
__device__ __forceinline__ unsigned cvtpk(float lo, float hi) { unsigned r; asm volatile("v_cvt_pk_bf16_f32 %0, %1, %2" : "=v"(r) : "v"(lo), "v"(hi)); return r; }
__device__ __forceinline__ void partialSM(f32x16& p0, f32x16& p1, float& m_reg, float& mn, float& alpha) {
  constexpr float C = SCALE * 1.4426950408889634f;
  float pmax = p0[0];
#pragma unroll
  for (int r = 1; r < 16; ++r) pmax = fmaxf(pmax, p0[r]);
#pragma unroll
  for (int r = 0; r < 16; ++r) pmax = fmaxf(pmax, p1[r]);
  { auto rr = __builtin_amdgcn_permlane32_swap(__float_as_uint(pmax), __float_as_uint(pmax), false, false);
    pmax = fmaxf(__uint_as_float(rr[0]), __uint_as_float(rr[1])); }
  if (__builtin_expect(__all(pmax - m_reg <= THR / SCALE), 1)) { mn = m_reg; alpha = 1.f; }
  else { mn = fmaxf(m_reg, pmax); alpha = __builtin_amdgcn_exp2f((m_reg - mn) * C); m_reg = mn; }
  float mnC = -mn * C;
#pragma unroll
  for (int r = 0; r < 16; ++r) p0[r] = fmaf(p0[r], C, mnC);
#pragma unroll
  for (int r = 0; r < 16; ++r) p1[r] = fmaf(p1[r], C, mnC);
#pragma unroll
  for (int r = 0; r < 16; ++r) p0[r] = __builtin_amdgcn_exp2f(p0[r]);
}
__device__ __forceinline__ void finishSM(f32x16& p0, f32x16& p1, float alpha, float& l_reg, bf16x8& pa0, bf16x8& pa1, bf16x8& pa2, bf16x8& pa3) {
#pragma unroll
  for (int r = 0; r < 16; ++r) p1[r] = __builtin_amdgcn_exp2f(p1[r]);
  float ps = 0;
#pragma unroll
  for (int r = 0; r < 16; ++r) ps += p0[r];
#pragma unroll
  for (int r = 0; r < 16; ++r) ps += p1[r];
  { auto rr = __builtin_amdgcn_permlane32_swap(__float_as_uint(ps), __float_as_uint(ps), false, false);
    ps = __uint_as_float(rr[0]) + __uint_as_float(rr[1]); }
  l_reg = l_reg * alpha + ps;
#define PK4(P, BASE, OUT) do { unsigned a0 = cvtpk(P[BASE + 0], P[BASE + 1]), a1 = cvtpk(P[BASE + 2], P[BASE + 3]);   \
    unsigned b0 = cvtpk(P[BASE + 4], P[BASE + 5]), b1 = cvtpk(P[BASE + 6], P[BASE + 7]);                              \
    auto r0 = __builtin_amdgcn_permlane32_swap(a0, b0, false, false); auto r1 = __builtin_amdgcn_permlane32_swap(a1, b1, false, false); \
    u32x4 w = {r0[0], r1[0], r0[1], r1[1]}; OUT = *reinterpret_cast<bf16x8*>(&w); } while (0)
  PK4(p0, 0, pa0); PK4(p0, 8, pa1); PK4(p1, 0, pa2); PK4(p1, 8, pa3);
#undef PK4
}
__device__ __forceinline__ void qkt(f32x16& p0, f32x16& p1, const bf16_t* Ks, const bf16x8* qr, int r32, int hi) {
  p0 = f32x16{}; p1 = f32x16{};
#pragma unroll
  for (int d0 = 0; d0 < 8; ++d0) { int cb = (d0 * 16 + hi * 8) * 2;
    bf16x8 b0 = *reinterpret_cast<const bf16x8*>((const char*)Ks + KSWZ(r32, cb));
    bf16x8 b1 = *reinterpret_cast<const bf16x8*>((const char*)Ks + KSWZ(32 + r32, cb));
    p0 = __builtin_amdgcn_mfma_f32_32x32x16_bf16(b0, qr[d0], p0, 0, 0, 0);
    p1 = __builtin_amdgcn_mfma_f32_32x32x16_bf16(b1, qr[d0], p1, 0, 0, 0); }
}
__device__ __forceinline__ int v_st(int k, int c) { const int kk = (k & ~0xC) | ((k & 4) << 1) | ((k & 8) >> 1); return ((kk >> 3) * 4 + (c >> 5)) * 512 + ((kk & 7) * 32 + (c & 31)) * 2; }
__device__ __forceinline__ int v_rd_base(int lane) { return ((lane & 3) << 3) | (((lane >> 2) & 3) << 6) | (((lane >> 4) & 1) << 5) | (((lane >> 5) & 1) << 8); }
constexpr int v_rd_off(int d0, int ks, int half) { return d0 * 512 + ks * 4096 + half * 2048; }
template <int OFF> __device__ __forceinline__ s16x4 tr_read(int vb) {
  s16x4 r; asm volatile("ds_read_b64_tr_b16 %0, %1 offset:%2" : "=&v"(r) : "v"(vb), "i"(OFF) : "memory"); return r;
}
template <int D0> __device__ __forceinline__ void pv_one(f32x16& od, int vb, bf16x8 pa0, bf16x8 pa1, bf16x8 pa2, bf16x8 pa3) {
  const s16x4 l0 = tr_read<v_rd_off(D0, 0, 0)>(vb), h0 = tr_read<v_rd_off(D0, 0, 1)>(vb), l1 = tr_read<v_rd_off(D0, 1, 0)>(vb), h1 = tr_read<v_rd_off(D0, 1, 1)>(vb);
  const s16x4 l2 = tr_read<v_rd_off(D0, 2, 0)>(vb), h2 = tr_read<v_rd_off(D0, 2, 1)>(vb), l3 = tr_read<v_rd_off(D0, 3, 0)>(vb), h3 = tr_read<v_rd_off(D0, 3, 1)>(vb);
  asm volatile("s_waitcnt lgkmcnt(0)" ::: "memory"); SBAR();
#define PK(L, H) (bf16x8){L[0], L[1], L[2], L[3], H[0], H[1], H[2], H[3]}
  od = __builtin_amdgcn_mfma_f32_32x32x16_bf16(pa0, PK(l0, h0), od, 0, 0, 0);
  od = __builtin_amdgcn_mfma_f32_32x32x16_bf16(pa1, PK(l1, h1), od, 0, 0, 0);
  od = __builtin_amdgcn_mfma_f32_32x32x16_bf16(pa2, PK(l2, h2), od, 0, 0, 0);
  od = __builtin_amdgcn_mfma_f32_32x32x16_bf16(pa3, PK(l3, h3), od, 0, 0, 0);
#undef PK
}
__device__ __forceinline__ void pv_d0(f32x16* o, int vb, bf16x8 pa0, bf16x8 pa1, bf16x8 pa2, bf16x8 pa3) {
  pv_one<0>(o[0], vb, pa0, pa1, pa2, pa3); pv_one<1>(o[1], vb, pa0, pa1, pa2, pa3); pv_one<2>(o[2], vb, pa0, pa1, pa2, pa3); pv_one<3>(o[3], vb, pa0, pa1, pa2, pa3);
}
__device__ __forceinline__ void attn_dense_body(const bf16_t* __restrict__ Qb, const bf16_t* __restrict__ Kh, const bf16_t* __restrict__ Vh,
                                                bf16_t* __restrict__ Ob, int seq, char* lds, const int tid) {
  const int wid = tid >> 6, lane = tid & 63, r32 = lane & 31, hi = lane >> 5;
  bf16_t* V_lds = (bf16_t*)lds; bf16_t* K_lds = (bf16_t*)(lds + 2 * SHM_V);
  float* wsf = (float*)(lds + 2 * SHM_V + 2 * SHM_K) + wid * 64; float* li_l = wsf; float* al_l = wsf + 32;
  float m_reg = -1e30f, l_reg = 0; f32x16 o[4] = {}; bf16x8 qr[8];
  const bf16_t* Qw = Qb + (long)(wid * QBLK + r32) * LDQ + hi * 8;
#pragma unroll
  for (int d0 = 0; d0 < 8; ++d0) qr[d0] = *reinterpret_cast<const bf16x8*>(Qw + d0 * 16);
  const int sr = tid >> 4, sc = (tid & 15) * 8, vst0 = v_st(sr, sc), vst1 = v_st(32 + sr, sc);
  const int vb0 = (int)(uintptr_t)V_lds + v_rd_base(lane);
  struct { bf16x8 vs0, vs1, ks0, ks1; } sr_[2];
#define LD8(p) (*reinterpret_cast<const bf16x8*>(p))
  const unsigned voff = (unsigned)(sr * LDK + sc) * 2u;
#define SLOAD(i, k0) do { const char* vb_ = (const char*)(Vh + (size_t)(k0) * LDK); const char* kb_ = (const char*)(Kh + (size_t)(k0) * LDK); \
    sr_[i].vs0 = LD8(vb_ + voff); sr_[i].vs1 = LD8(vb_ + 32 * LDK * 2 + voff); sr_[i].ks0 = LD8(kb_ + voff); sr_[i].ks1 = LD8(kb_ + 32 * LDK * 2 + voff); } while (0)
#define SWRITE(b, i) do { *(bf16x8*)((char*)V_lds + (b) * SHM_V + vst0) = sr_[i].vs0;          \
    *(bf16x8*)((char*)V_lds + (b) * SHM_V + vst1) = sr_[i].vs1; int kc = sc * 2;               \
    *(bf16x8*)((char*)K_lds + (b) * SHM_K + KSWZ(sr, kc)) = sr_[i].ks0;                       \
    *(bf16x8*)((char*)K_lds + (b) * SHM_K + KSWZ(32 + sr, kc)) = sr_[i].ks1; } while (0)
#define SWAIT() asm volatile("s_waitcnt vmcnt(4)" ::: "memory")
#define RESC(a) do { if (__any((a) < 1.f)) { if (hi == 0) al_l[r32] = (a); asm volatile("s_waitcnt lgkmcnt(0)" ::: "memory"); \
    _Pragma("unroll") for (int d = 0; d < 4; ++d) _Pragma("unroll") for (int r = 0; r < 16; ++r) o[d][r] *= al_l[crow(r, hi)]; } } while (0)
  f32x16 pA0, pA1, pB0, pB1; float mnA, mnB, alA, alB; bf16x8 pa0, pa1, pa2, pa3; const int NT = seq / KVBLK;
  constexpr int SE = 0, SO = 1;
  SLOAD(SE, 0); asm volatile("s_waitcnt vmcnt(0)" ::: "memory"); SWRITE(0, SE); __syncthreads();
  qkt(pA0, pA1, K_lds, qr, r32, hi); partialSM(pA0, pA1, m_reg, mnA, alA);
  SLOAD(SO, KVBLK); if (2 < NT) SLOAD(SE, 2 * KVBLK);
  SWAIT(); SWRITE(1, SO); __syncthreads();
  for (int j = 1; j + 1 < NT; j += 2) {
    SBAR(); qkt(pB0, pB1, (bf16_t*)((char*)K_lds + SHM_K), qr, r32, hi);
    finishSM(pA0, pA1, alA, l_reg, pa0, pa1, pa2, pa3); SBAR();
    SLOAD(SO, (j + 2) * KVBLK); SBAR();
    pv_d0(o, vb0, pa0, pa1, pa2, pa3); partialSM(pB0, pB1, m_reg, mnB, alB);
    __syncthreads(); SWAIT(); SWRITE(0, SE);
    RESC(alB); __syncthreads();
    SBAR(); qkt(pA0, pA1, K_lds, qr, r32, hi);
    finishSM(pB0, pB1, alB, l_reg, pa0, pa1, pa2, pa3); SBAR();
    if (j + 3 < NT) SLOAD(SE, (j + 3) * KVBLK); SBAR();
    pv_d0(o, vb0 + (int)SHM_V, pa0, pa1, pa2, pa3); partialSM(pA0, pA1, m_reg, mnA, alA);
    __syncthreads(); SWAIT(); SWRITE(1, SO);
    RESC(alA); __syncthreads();
  }
  SBAR(); qkt(pB0, pB1, (bf16_t*)((char*)K_lds + SHM_K), qr, r32, hi);
  finishSM(pA0, pA1, alA, l_reg, pa0, pa1, pa2, pa3); SBAR();
  pv_d0(o, vb0, pa0, pa1, pa2, pa3); partialSM(pB0, pB1, m_reg, mnB, alB);
  __syncthreads(); RESC(alB);
  finishSM(pB0, pB1, alB, l_reg, pa0, pa1, pa2, pa3); SBAR();
  pv_d0(o, vb0 + (int)SHM_V, pa0, pa1, pa2, pa3);
  if (hi == 0) li_l[r32] = l_reg; asm volatile("s_waitcnt lgkmcnt(0)" ::: "memory");
  float rli[16];
#pragma unroll
  for (int r = 0; r < 16; ++r) rli[r] = __builtin_amdgcn_rcpf(li_l[crow(r, hi)]);
  bf16_t* Ow = Ob + (long)(wid * QBLK) * LDO;
#pragma unroll
  for (int r = 0; r < 16; ++r) { int orow = crow(r, hi);
#pragma unroll
    for (int d0 = 0; d0 < 4; ++d0) Ow[(long)orow * LDO + d0 * 32 + r32] = f2bf(o[d0][r] * rli[r]); }
#undef LD8
#undef SLOAD
#undef SWRITE
#undef SWAIT
#undef RESC
}
}

__device__ __forceinline__ void mod_phase(const Params& P, LAS unsigned char* lds, const int tid) {
  if (P.bid >= 144) return;
  LAS float* sc = (LAS float*)lds; LAS float* red = sc + 5 * 2048;
  const int wid = tid >> 6, lane = tid & 63;
  for (int i = tid; i < 5 * 2048; i += 512) { const int j = i >> 11, k = i & 2047; const float v = (j < 4) ? P.c[j * 2048 + k] : P.c_ctx[k]; sc[i] = v * sigmoidf_(v); }
  __syncthreads();
  float* MOD = (float*)(P.ws + OFF_MOD);
  for (int task = P.bid; task < 144; task += P.grd) {
    const int n0 = task * 128 + lane * 2;
    float a0[5], a1[5];
#pragma unroll
    for (int j = 0; j < 5; ++j) { a0[j] = 0.f; a1[j] = 0.f; }
    const float* wp = P.w_mod + (size_t)(wid * 256) * NMODC + n0;
#pragma unroll 8
    for (int k = 0; k < 256; ++k) {
      const f32x2 w = *(const f32x2*)(wp + (size_t)k * NMODC);
#pragma unroll
      for (int j = 0; j < 5; ++j) { const float s = sc[j * 2048 + wid * 256 + k]; a0[j] += s * w.x; a1[j] += s * w.y; }
    }
#pragma unroll
    for (int j = 0; j < 5; ++j) { red[(wid * 5 + j) * 128 + lane * 2] = a0[j]; red[(wid * 5 + j) * 128 + lane * 2 + 1] = a1[j]; }
    __syncthreads();
    for (int o = tid; o < 640; o += 512) { const int j = o >> 7, ci = o & 127; float s = 0.f;
#pragma unroll
      for (int w = 0; w < 8; ++w) s += red[(w * 5 + j) * 128 + ci];
      MOD[j * NMODC + task * 128 + ci] = s + P.b_mod[task * 128 + ci]; }
    __syncthreads();
  }
}
__device__ __forceinline__ void tr_item(const float* __restrict__ W, int ldw, int k0, int n0, bf16_t* __restrict__ WT, int ldt, int drow0, int dk0, LAS float* scr, int lane) {
#pragma unroll 32
  for (int i = 0; i < 32; ++i) { const int kk = 2 * i + (lane >> 5); scr[kk * 33 + (lane & 31)] = W[(size_t)(k0 + kk) * ldw + n0 + (lane & 31)]; }
  asm volatile("s_waitcnt lgkmcnt(0)" ::: "memory");
  const int c = lane & 7;
#pragma unroll
  for (int j = 0; j < 4; ++j) { const int n = (lane >> 3) + 8 * j; const LAS float* s = scr + (8 * c) * 33 + n;
    u32x4 o; o.x = cvt_pk_bf16(s[0 * 33], s[1 * 33]); o.y = cvt_pk_bf16(s[2 * 33], s[3 * 33]); o.z = cvt_pk_bf16(s[4 * 33], s[5 * 33]); o.w = cvt_pk_bf16(s[6 * 33], s[7 * 33]);
    *(u32x4*)(WT + (size_t)(drow0 + n) * ldt + dk0 + k0 + 8 * c) = o; }
  asm volatile("s_waitcnt lgkmcnt(0)" ::: "memory");
}
__device__ __forceinline__ void convert_phase(const Params& P, LAS unsigned char* lds, const int tid) {
  const int wid = tid >> 6, lane = tid & 63;
  LAS float* scr = (LAS float*)(lds + wid * 8704);
  unsigned char* ws = P.ws;
  bf16_t *W1A = (bf16_t*)(ws + OFF_W1A), *W1B = (bf16_t*)(ws + OFF_W1B), *W2A = (bf16_t*)(ws + OFF_W2A), *W2B = (bf16_t*)(ws + OFF_W2B);
  bf16_t *WRW = (bf16_t*)(ws + OFF_WRW), *WQKVG = (bf16_t*)(ws + OFF_WQKVG), *WOA = (bf16_t*)(ws + OFF_WOA), *WOR = (bf16_t*)(ws + OFF_WOR), *WOUT = (bf16_t*)(ws + OFF_WOUT), *WLORA = (bf16_t*)(ws + OFF_WLORA);
  const int G = P.grd, gw = (G - 1 - P.bid) * 8 + wid, NGW = G * 8;
  constexpr int NITEMS = 22528 + 11264 + 3456 + 7168 + 2048 + 1024 + 2048 + 192;
  for (int it = gw; it < NITEMS; it += NGW) {
    int r = it;
    if (r < 22528) { const int which = r >= 11264; r -= which * 11264; const int kb = r / 352, nb = r % 352, n0 = nb * 32;
      const int drow = n0 < DFF ? (n0 >> 7) * 256 + (n0 & 127) : ((n0 - DFF) >> 7) * 256 + 128 + ((n0 - DFF) & 127);
      tr_item(which ? P.ffn2_w_in : P.ffn1_w_in, 2 * DFF, kb * 64, n0, which ? W2A : W1A, 2048, drow, 0, scr, lane); continue; }
    r -= 22528;
    if (r < 11264) { const int which = r >= 5632; r -= which * 5632; const int kb = r >> 6, nb = r & 63;
      tr_item(which ? P.ffn2_w_out : P.ffn1_w_out, 2048, kb * 64, nb * 32, which ? W2B : W1B, DFF, nb * 32, 0, scr, lane); continue; }
    r -= 11264;
    if (r < 3456) { const int kb = r / 108, nb = r % 108; tr_item(P.w_in, 10624, kb * 64, 3072 + nb * 32, WRW, 2048, nb * 32, 0, scr, lane); continue; }
    r -= 3456;
    if (r < 7168) { const int kb = r / 224, nb = r % 224; const int n0 = nb < 96 ? nb * 32 : 6528 + (nb - 96) * 32;
      tr_item(P.w_in, 10624, kb * 64, n0, WQKVG, 2048, nb * 32, 0, scr, lane); continue; }
    r -= 7168;
    if (r < 2048) { tr_item(P.w_oa, 2048, (r >> 6) * 64, (r & 63) * 32, WOA, 2048, (r & 63) * 32, 0, scr, lane); continue; }
    r -= 2048;
    if (r < 1024) { tr_item(P.w_or, 2048, (r >> 6) * 64, (r & 63) * 32, WOR, 1024, (r & 63) * 32, 0, scr, lane); continue; }
    r -= 1024;
    if (r < 2048) { tr_item(P.w_out, 2048, (r >> 6) * 64, (r & 63) * 32, WOUT, 2048, (r & 63) * 32, 0, scr, lane); continue; }
    r -= 2048;
    if (r < 64) { const int z = r >> 5, nb = r & 31; tr_item(P.w2 + (size_t)z * 64 * 1024, 1024, 0, nb * 32, WLORA, LIN_LD, z * 1024 + nb * 32, z * 64, scr, lane); continue; }
    r -= 64;
    if (r < 64) { const int z = r >> 5, nb = r & 31; tr_item(P.a2 + (size_t)z * 64 * 1024, 1024, 0, nb * 32, WLORA, LIN_LD, 2048 + z * 1024 + nb * 32, 128 + z * 64, scr, lane); continue; }
    r -= 64;
    { const int kb = r >> 5, nb = r & 31; tr_item(P.g2, 1024, kb * 64, nb * 32, WLORA, LIN_LD, 4096 + nb * 32, 256, scr, lane); }
  }
  const int gt = P.bid * 512 + tid, NT = G * 512;
  unsigned zz = 0u; asm volatile("" : "+v"(zz));
  const u32x4 z4 = {zz, zz, zz, zz};
  for (int i = gt; i < 128 * 256; i += NT) *(u32x4*)(WRW + (size_t)3456 * 2048 + (size_t)i * 8) = z4;
  for (int i = gt; i < 5120 * 48; i += NT) { const int row = i / 48, kc = (i % 48) * 8, rb = row >> 10;
    const int lo = rb < 4 ? rb * 64 : 256, hi = rb < 4 ? rb * 64 + 64 : 384;
    if (kc < lo || kc >= hi) *(u32x4*)(WLORA + (size_t)row * LIN_LD + kc) = z4; }
}
__device__ __forceinline__ void norm_mod_phase(const Params& P, const float* __restrict__ lat, const float* __restrict__ ctxp, int nrows, const float* __restrict__ g, int midx, const int tid) {
  const int wid = tid >> 6, lane = tid & 63;
  const int gw = P.bid * 8 + wid, NGW = P.grd * 8;
  const float* __restrict__ MOD = (const float*)(P.ws + OFF_MOD); bf16_t* __restrict__ H = (bf16_t*)(P.ws + OFF_H);
  for (int r = gw; r < nrows; r += NGW) {
    const float* xr = r < MT ? lat + (size_t)r * DM : ctxp + (size_t)(r - MT) * DM;
    const int b = r < MT ? (r >> 13) : 4;
    const float* sh = MOD + b * NMODC + midx * DM; const float* scp = sh + DM;
    f32x4 v[8], g4[8], s4[8], c4[8]; float ss = 0.f;
#pragma unroll
    for (int j = 0; j < 8; ++j) v[j] = *(const f32x4*)(xr + j * 256 + lane * 4);
#pragma unroll
    for (int j = 0; j < 8; ++j) { const int c = j * 256 + lane * 4; g4[j] = *(const f32x4*)(g + c); s4[j] = *(const f32x4*)(sh + c); c4[j] = *(const f32x4*)(scp + c); }
#pragma unroll
    for (int j = 0; j < 8; ++j) ss += v[j].x * v[j].x + v[j].y * v[j].y + v[j].z * v[j].z + v[j].w * v[j].w;
    ss = wave_sum(ss);
    const float rs = rsqrtf(ss * (1.f / DM) + 1e-6f);
#pragma unroll
    for (int j = 0; j < 8; ++j) { const int c = j * 256 + lane * 4;
      const f32x4 y = v[j] * rs * g4[j]; const f32x4 h = y * (c4[j] + 1.f) + s4[j];
      u32x2 w; w.x = cvt_pk_bf16(h.x, h.y); w.y = cvt_pk_bf16(h.z, h.w);
      *(u32x2*)(H + (size_t)r * DM + c) = w; }
  }
}
__device__ __forceinline__ void shift_phase(const Params& P, const int tid) {
  const bf16_t* PRW = (const bf16_t*)(P.ws + OFF_PRW); bf16_t* SH = (bf16_t*)(P.ws + OFF_SH); bf16_t* LIN = (bf16_t*)(P.ws + OFF_LIN);
  const int gt = P.bid * 512 + tid, NT = P.grd * 512;
  for (int idx = gt; idx < MA * 432; idx += NT) {
    const int r = idx / 432, c = (idx % 432) * 8;
    bool first, last;
    if (r < MT) { const int t = r & (SEQ - 1); first = t == 0; last = t == SEQ - 1; } else { const int t = (r - MT) & (CTXL - 1); first = t == 0; last = t == CTXL - 1; }
    const u32x4 z4 = {0u, 0u, 0u, 0u};
    const u32x4 p = *(const u32x4*)(PRW + (size_t)r * PRW_LD + c);
    const u32x4 pv = first ? z4 : *(const u32x4*)(PRW + (size_t)(r - 1) * PRW_LD + c);
    const u32x4 nx = last ? z4 : *(const u32x4*)(PRW + (size_t)(r + 1) * PRW_LD + c);
    const f32x4 m0 = *(const f32x4*)(P.rwkv_mu + c), m1 = *(const f32x4*)(P.rwkv_mu + c + 4);
    float o[8];
#define SHF(e, W, MU, HI) { const float pp = HI ? bfhi(p.W) : bflo(p.W), a = HI ? bfhi(pv.W) : bflo(pv.W), b = HI ? bfhi(nx.W) : bflo(nx.W); o[e] = pp + MU * (0.5f * (a + b) - pp); }
    SHF(0, x, m0.x, 0) SHF(1, x, m0.y, 1) SHF(2, y, m0.z, 0) SHF(3, y, m0.w, 1) SHF(4, z, m1.x, 0) SHF(5, z, m1.y, 1) SHF(6, w, m1.z, 0) SHF(7, w, m1.w, 1)
#undef SHF
    bf16_t* dst;
    if (c < 3072) dst = SH + (size_t)r * SH_LD + c;
    else { const int cl = c - 3072; dst = LIN + (size_t)r * LIN_LD + cl;
      if (cl < 128) {
#pragma unroll
        for (int e = 0; e < 8; ++e) { const float ex = __builtin_amdgcn_exp2f(2.8853900817779268f * o[e]); o[e] = 1.f - 2.f * __builtin_amdgcn_rcpf(ex + 1.f); }
      } else if (cl >= 256) {
#pragma unroll
        for (int e = 0; e < 8; ++e) o[e] = sigmoidf_(o[e]);
      } }
    u32x4 w; w.x = cvt_pk_bf16(o[0], o[1]); w.y = cvt_pk_bf16(o[2], o[3]); w.z = cvt_pk_bf16(o[4], o[5]); w.w = cvt_pk_bf16(o[6], o[7]);
    *(u32x4*)dst = w;
  }
}
__device__ __forceinline__ float SFMA(float a, float b, float c) { float d; asm("v_fma_f32 %0, %1, %2, %3" : "=v"(d) : "v"(a), "v"(b), "v"(c)); return d; }
__device__ __forceinline__ float SMUL(float a, float b) { float d; asm("v_mul_f32 %0, %1, %2" : "=v"(d) : "v"(a), "v"(b)); return d; }
__device__ __forceinline__ float allred8(float x) { x += dpp_mov<0xB1>(x); x += dpp_mov<0x4E>(x); x += dpp_mov<0x141>(x); return x; }
__device__ __forceinline__ void scan_phase(const Params& P, LAS unsigned char* lds, const int tid) {
  LAS float* F = (LAS float*)lds;
  LAS unsigned short* YB = (LAS unsigned short*)(lds + 2 * 32 * 384 * 4);
  const bf16_t* SH = (const bf16_t*)(P.ws + OFF_SH); const bf16_t* LO = (const bf16_t*)(P.ws + OFF_LO); bf16_t* Y = (bf16_t*)(P.ws + OFF_Y);
  const int wid = __builtin_amdgcn_readfirstlane(tid >> 6), lane = tid & 63;
  constexpr int NCH = SKV / 32;
#define SCAN_BAR() do { asm volatile("s_waitcnt lgkmcnt(0)" ::: "memory"); __builtin_amdgcn_s_barrier(); asm volatile("" ::: "memory"); } while (0)
  for (int task = P.bid; task < 256; task += P.grd) {
    const int half = (task >> 3) & 1, chain = (task & 7) | ((task >> 4) << 3);
    const int dir = chain & 1, h = (chain >> 1) & 15, b = chain >> 5, hc = h * 64;
#define ROWOF(g) ((g) < CTXL ? (MT + b * CTXL + (dir ? CTXL - 1 - (g) : (g))) : (b * SEQ + (dir ? SEQ - 1 - ((g) - CTXL) : ((g) - CTXL))))
    if (wid < 4) {
      const int rloc = wid * 8 + (lane >> 3), irow = half * 32 + rloc, cA = (lane & 7) * 4, cB = 32 + cA;
      f32x4 S0 = {0.f, 0.f, 0.f, 0.f}, S1 = {0.f, 0.f, 0.f, 0.f};
      SCAN_BAR();
      for (int q = 0; q < NCH; ++q) {
        const LAS float* f = F + (q & 1) * 32 * 384;
        LAS unsigned short* yb = YB + (q & 1) * 1024;
        f32x4 w0 = *(const LAS f32x4*)(f + cA), w1 = *(const LAS f32x4*)(f + cB);
        f32x4 a0 = *(const LAS f32x4*)(f + 64 + cA), a1 = *(const LAS f32x4*)(f + 64 + cB);
        f32x4 b0 = *(const LAS f32x4*)(f + 128 + cA), b1 = *(const LAS f32x4*)(f + 128 + cB);
        f32x4 k0 = *(const LAS f32x4*)(f + 192 + cA), k1 = *(const LAS f32x4*)(f + 192 + cB);
        f32x4 r0 = *(const LAS f32x4*)(f + 256 + cA), r1 = *(const LAS f32x4*)(f + 256 + cB);
        float vv = f[320 + irow];
        float ykeep = 0.f;
#pragma unroll 2
        for (int s = 0; s < 32; ++s) {
          const LAS float* fn = f + (s < 31 ? s + 1 : 31) * 384;
          const f32x4 nw0 = *(const LAS f32x4*)(fn + cA), nw1 = *(const LAS f32x4*)(fn + cB);
          const f32x4 na0 = *(const LAS f32x4*)(fn + 64 + cA), na1 = *(const LAS f32x4*)(fn + 64 + cB);
          const f32x4 nb0 = *(const LAS f32x4*)(fn + 128 + cA), nb1 = *(const LAS f32x4*)(fn + 128 + cB);
          const f32x4 nk0 = *(const LAS f32x4*)(fn + 192 + cA), nk1 = *(const LAS f32x4*)(fn + 192 + cB);
          const f32x4 nr0 = *(const LAS f32x4*)(fn + 256 + cA), nr1 = *(const LAS f32x4*)(fn + 256 + cB);
          const float nvv = fn[320 + irow];
          __builtin_amdgcn_sched_barrier(0);
          f32x4 p = S0 * a0 + S1 * a1;
          const float sa_ = allred8((p.x + p.y) + (p.z + p.w));
          S0 = S0 * w0 + (b0 * sa_ + k0 * vv);
          S1 = S1 * w1 + (b1 * sa_ + k1 * vv);
          p = S0 * r0 + S1 * r1;
          const float y = allred8((p.x + p.y) + (p.z + p.w));
          ykeep = ((s & 7) == (lane & 7)) ? y : ykeep;
          if ((s & 7) == 7) yb[((s & ~7) + (lane & 7)) * 32 + rloc] = f2bf(ykeep);
          __builtin_amdgcn_sched_barrier(0);
          w0 = nw0; w1 = nw1; a0 = na0; a1 = na1; b0 = nb0; b1 = nb1; k0 = nk0; k1 = nk1; r0 = nr0; r1 = nr1; vv = nvv;
        }
        SCAN_BAR();
      }
    } else {
      const int sw = wid - 4, hw = lane >> 5, cp = (lane & 31) * 2;
      const f32x2 kk_c = *(const f32x2*)(P.k_k + hc + cp), ka_c = *(const f32x2*)(P.k_a + hc + cp);
      unsigned voS[4], voL[4];
#pragma unroll
      for (int e = 0; e < 4; ++e) { const int tk = hw * 4 + e, ro = dir ? 7 - tk : tk; voS[e] = (unsigned)(ro * SH_LD + cp) * 2u; voL[e] = (unsigned)(ro * LO_LD + cp) * 2u; }
      unsigned sr[4], sk[4], sv[4], sl[4], sa[4];
#define RMIN(q) ({ const int g0_ = (q) * 32 + sw * 8; const int ra_ = ROWOF(g0_), rb_ = ROWOF(g0_ + 7); ra_ < rb_ ? ra_ : rb_; })
#define SLOADQ(q) do { const size_t rmin_ = (size_t)RMIN(q); const char* bs_ = (const char*)(SH + rmin_ * SH_LD + hc); const char* bl_ = (const char*)(LO + rmin_ * LO_LD + dir * 1024 + hc); \
      _Pragma("unroll") for (int e = 0; e < 4; ++e) { sr[e] = *(const unsigned*)(bs_ + voS[e]); sk[e] = *(const unsigned*)(bs_ + 2048 + voS[e]); sv[e] = *(const unsigned*)(bs_ + 4096 + voS[e]); \
        sl[e] = *(const unsigned*)(bl_ + voL[e]); sa[e] = *(const unsigned*)(bl_ + 4096 + voL[e]); } } while (0)
#define SWRITEQ(buf) do { _Pragma("unroll") for (int e = 0; e < 4; ++e) { LAS float* f_ = F + ((buf) * 32 + sw * 8 + hw * 4 + e) * 384 + cp; \
      const f32x2 r_ = {bflo(sr[e]), bfhi(sr[e])}, k_ = {bflo(sk[e]), bfhi(sk[e])}, v_ = {bflo(sv[e]), bfhi(sv[e])}, lam = {bflo(sl[e]), bfhi(sl[e])}, aa = {bflo(sa[e]), bfhi(sa[e])}; \
      const f32x2 kkr = k_ * kk_c; float ssq = allred16(kkr.x * kkr.x + kkr.y * kkr.y); \
      { auto rr_ = __builtin_amdgcn_permlane16_swap(__float_as_uint(ssq), __float_as_uint(ssq), false, false); ssq = __uint_as_float(rr_[0]) + __uint_as_float(rr_[1]); } \
      const f32x2 kk = kkr * rsqrtf(fmaxf(ssq, 1e-24f)); \
      f32x2 wv; wv.x = __builtin_amdgcn_exp2f(-lam.x); wv.y = __builtin_amdgcn_exp2f(-lam.y); \
      *(LAS f32x2*)(f_) = wv; *(LAS f32x2*)(f_ + 64) = -kk; *(LAS f32x2*)(f_ + 128) = kk * aa; *(LAS f32x2*)(f_ + 192) = k_ * ((aa - 1.f) * ka_c + 1.f); \
      *(LAS f32x2*)(f_ + 256) = r_; *(LAS f32x2*)(f_ + 320) = v_; } } while (0)
      SLOADQ(0); SWRITEQ(0); SLOADQ(1);
      SCAN_BAR();
      for (int q = 0; q < NCH; ++q) {
        if (q >= 9) {
          const int qq = q - 1; const LAS unsigned short* yb = YB + (qq & 1) * 1024;
          const int t256 = sw * 64 + lane, s = t256 >> 3, rp = (t256 & 7) * 4; const int u = qq * 32 + s - CTXL; const int t = dir ? SEQ - 1 - u : u;
          const u32x2 val = *(const LAS u32x2*)(yb + s * 32 + rp);
          *(u32x2*)(Y + (size_t)dir * MT * 1024 + (size_t)(b * SEQ + t) * 1024 + hc + half * 32 + rp) = val;
        }
        if (q + 1 < NCH) SWRITEQ((q + 1) & 1);
        if (q + 2 < NCH) SLOADQ(q + 2);
        SCAN_BAR();
      }
      {
        const int qq = NCH - 1; const LAS unsigned short* yb = YB + (qq & 1) * 1024;
        const int t256 = sw * 64 + lane, s = t256 >> 3, rp = (t256 & 7) * 4; const int u = qq * 32 + s - CTXL; const int t = dir ? SEQ - 1 - u : u;
        const u32x2 val = *(const LAS u32x2*)(yb + s * 32 + rp);
        *(u32x2*)(Y + (size_t)dir * MT * 1024 + (size_t)(b * SEQ + t) * 1024 + hc + half * 32 + rp) = val;
      }
#undef SLOADQ
#undef SWRITEQ
#undef RMIN
    }
#undef ROWOF
    __syncthreads();
  }
#undef SCAN_BAR
}
__device__ __forceinline__ float half_sum(float v) {
  v = allred16(v);
  auto rr = __builtin_amdgcn_permlane16_swap(__float_as_uint(v), __float_as_uint(v), false, false); return __uint_as_float(rr[0]) + __uint_as_float(rr[1]);
}
__device__ __forceinline__ void rwkv_out_phase(const Params& P, const int tid) {
  const bf16_t* SH = (const bf16_t*)(P.ws + OFF_SH); const bf16_t* LO = (const bf16_t*)(P.ws + OFF_LO); bf16_t* Y = (bf16_t*)(P.ws + OFF_Y);
  const int wid = tid >> 6, lane = tid & 63, hw = lane >> 5, cp = (lane & 31) * 2;
  const int gw = P.bid * 8 + wid, NGW = P.grd * 8;
  for (int task = gw * 2; task < MT * 8; task += NGW * 2) {
    unsigned yf[2], ybk[2], rr[2], kk[2], vv[2], af[2], ab[2], gg[2]; int cc[2]; size_t tk[2];
#pragma unroll
    for (int u = 0; u < 2; ++u) { const int t_ = task + u; tk[u] = (size_t)(t_ >> 3); cc[u] = ((t_ & 7) * 2 + hw) * 64 + cp;
      const bf16_t* py = Y + tk[u] * 1024 + cc[u]; const bf16_t* ps = SH + tk[u] * SH_LD + cc[u]; const bf16_t* pl = LO + tk[u] * LO_LD + cc[u];
      yf[u] = *(const unsigned*)py; ybk[u] = *(const unsigned*)(py + (size_t)MT * 1024);
      rr[u] = *(const unsigned*)ps; kk[u] = *(const unsigned*)(ps + 1024); vv[u] = *(const unsigned*)(ps + 2048);
      af[u] = *(const unsigned*)(pl + 2048); ab[u] = *(const unsigned*)(pl + 3072); gg[u] = *(const unsigned*)(pl + 4096); }
    unsigned res[2];
#pragma unroll
    for (int u = 0; u < 2; ++u) {
      const f32x2 lw = *(const f32x2*)(P.ln_x_w + cc[u]), lb = *(const f32x2*)(P.ln_x_b + cc[u]), ka = *(const f32x2*)(P.k_a + cc[u]), rk = *(const f32x2*)(P.r_k + cc[u]);
      const f32x2 y = {bflo(yf[u]) + bflo(ybk[u]), bfhi(yf[u]) + bfhi(ybk[u])};
      const float mu = half_sum(y.x + y.y) * (1.f / 64.f); const f32x2 dv = y - mu; const float var = half_sum(dv.x * dv.x + dv.y * dv.y) * (1.f / 64.f);
      const f32x2 yn = dv * rsqrtf(var + 64e-5f) * lw + lb;
      const f32x2 r = {bflo(rr[u]), bfhi(rr[u])}, k = {bflo(kk[u]), bfhi(kk[u])}, v = {bflo(vv[u]), bfhi(vv[u])};
      const f32x2 a1 = {bflo(af[u]), bfhi(af[u])}, a2 = {bflo(ab[u]), bfhi(ab[u])}, g = {bflo(gg[u]), bfhi(gg[u])};
      const f32x2 kms = k * ((a1 - 1.f) * ka + 1.f) + k * ((a2 - 1.f) * ka + 1.f);
      const f32x2 bt = r * kms * rk;
      const float bonus = half_sum(bt.x + bt.y);
      const f32x2 o = (yn + v * bonus) * g;
      res[u] = cvt_pk_bf16(o.x, o.y);
    }
#pragma unroll
    for (int u = 0; u < 2; ++u) *(unsigned*)(Y + tk[u] * 1024 + cc[u]) = res[u];
  }
}
__device__ __forceinline__ void rope_phase(const Params& P, const int tid) {
  bf16_t* Q = (bf16_t*)(P.ws + OFF_Q); bf16_t* KB = (bf16_t*)(P.ws + OFF_KB);
  const int wid = tid >> 6, lane = tid & 63, hw = lane >> 5, li = lane & 31;
  const int gw = P.bid * 8 + wid, NGW = P.grd * 8;
  const int d1 = li < 16 ? 2 * li : 64 + 2 * (li - 16);
  const f32x2 qgA = *(const f32x2*)(P.q_norm + d1), qgB = *(const f32x2*)(P.q_norm + d1 + 32), kgA = *(const f32x2*)(P.k_norm + d1), kgB = *(const f32x2*)(P.k_norm + d1 + 32);
  const int j0 = 2 * (li & 15);
  const float inv0 = __builtin_amdgcn_exp2f(-(float)(2 * j0) * (13.287712379549449f / 64.f)), inv1 = __builtin_amdgcn_exp2f(-(float)(2 * j0 + 2) * (13.287712379549449f / 64.f));
  for (int task = gw; task < MA; task += NGW) {
    if (task < MT) {
      const int tok = task, b = tok >> 13, t = tok & (SEQ - 1);
      const float pos = (float)(li < 16 ? (t >> 6) : (t & 63));
      const float an0 = pos * inv0, an1 = pos * inv1;
      const f32x2 sn = {__sinf(an0), __sinf(an1)}, cs = {__cosf(an0), __cosf(an1)};
      unsigned lo[10], hi[10]; bf16_t* ptr[10];
#pragma unroll
      for (int i = 0; i < 10; ++i) { const int hd = 2 * i + hw;
        ptr[i] = (hd < 16 ? Q + (size_t)tok * DM + hd * 128 : KB + (size_t)(tok + b * CTXL) * 512 + (hd - 16) * 128) + d1;
        lo[i] = *(const unsigned*)ptr[i]; hi[i] = *(const unsigned*)(ptr[i] + 32); }
#pragma unroll
      for (int i = 0; i < 10; ++i) { const bool isq = i < 8;
        const f32x2 t1 = {bflo(lo[i]), bfhi(lo[i])}, t2 = {bflo(hi[i]), bfhi(hi[i])};
        const float ss = half_sum((t1.x * t1.x + t1.y * t1.y) + (t2.x * t2.x + t2.y * t2.y)); const float rs = rsqrtf(ss * (1.f / 128.f) + 1e-6f);
        const f32x2 n1 = t1 * rs * (isq ? qgA : kgA), n2 = t2 * rs * (isq ? qgB : kgB);
        const f32x2 o1 = n1 * cs - n2 * sn, o2 = n2 * cs + n1 * sn;
        lo[i] = cvt_pk_bf16(o1.x, o1.y); hi[i] = cvt_pk_bf16(o2.x, o2.y); }
#pragma unroll
      for (int i = 0; i < 10; ++i) { *(unsigned*)ptr[i] = lo[i]; *(unsigned*)(ptr[i] + 32) = hi[i]; }
    } else {
      const int ct = task - MT, b = ct >> 8, t = ct & (CTXL - 1);
      unsigned lo[2], hi[2]; bf16_t* ptr[2];
#pragma unroll
      for (int i = 0; i < 2; ++i) { ptr[i] = KB + (size_t)(b * SKV + SEQ + t) * 512 + (2 * i + hw) * 128 + d1; lo[i] = *(const unsigned*)ptr[i]; hi[i] = *(const unsigned*)(ptr[i] + 32); }
#pragma unroll
      for (int i = 0; i < 2; ++i) {
        const f32x2 t1 = {bflo(lo[i]), bfhi(lo[i])}, t2 = {bflo(hi[i]), bfhi(hi[i])};
        const float ss = half_sum((t1.x * t1.x + t1.y * t1.y) + (t2.x * t2.x + t2.y * t2.y)); const float rs = rsqrtf(ss * (1.f / 128.f) + 1e-6f);
        const f32x2 n1 = t1 * rs * kgA, n2 = t2 * rs * kgB;
        *(unsigned*)ptr[i] = cvt_pk_bf16(n1.x, n1.y); *(unsigned*)(ptr[i] + 32) = cvt_pk_bf16(n2.x, n2.y); }
    }
  }
}
__device__ __forceinline__ void attn_phase(const Params& P, unsigned char* smem, const int tid) {
  bf16_t* Q = (bf16_t*)(P.ws + OFF_Q); const bf16_t* KB = (const bf16_t*)(P.ws + OFF_KB); const bf16_t* VB = (const bf16_t*)(P.ws + OFF_VB);
  for (int u = P.bid; u < 2048; u += P.grd) {
    const int xcd = u & 7, slot = (u >> 3) & 31, rnd = u >> 8, pair = xcd + 8 * (rnd >> 2), w = (rnd & 3) * 32 + slot;
    const int b = pair >> 2, kvh = pair & 3, g = w & 3, qb = w >> 2, head = kvh * 4 + g;
    bf16_t* Qb = Q + (size_t)(b * SEQ + qb * 256) * DM + head * 128;
    const bf16_t* Kh = KB + (size_t)b * SKV * 512 + kvh * 128; const bf16_t* Vh = VB + (size_t)b * SKV * 512 + kvh * 128;
    att::attn_dense_body(Qb, Kh, Vh, Qb, SKV, (char*)smem, tid);
    __syncthreads();
  }
}
__device__ __forceinline__ void final_norm_phase(const Params& P, const int tid) {
  const int wid = tid >> 6, lane = tid & 63;
  const int gw = P.bid * 8 + wid, NGW = P.grd * 8;
  f32x4 g4[8];
#pragma unroll
  for (int j = 0; j < 8; ++j) g4[j] = *(const f32x4*)(P.norm_final + j * 256 + lane * 4);
  for (int r = gw; r < MT; r += NGW) {
    float* xr = P.out + (size_t)r * DM;
    f32x4 v[8]; float ss = 0.f;
#pragma unroll
    for (int j = 0; j < 8; ++j) v[j] = *(const f32x4*)(xr + j * 256 + lane * 4);
#pragma unroll
    for (int j = 0; j < 8; ++j) ss += v[j].x * v[j].x + v[j].y * v[j].y + v[j].z * v[j].z + v[j].w * v[j].w;
    ss = wave_sum(ss);
    const float rs = rsqrtf(ss * (1.f / DM) + 1e-6f);
#pragma unroll
    for (int j = 0; j < 8; ++j) *(f32x4*)(xr + j * 256 + lane * 4) = v[j] * rs * g4[j];
  }
}


#define XB_TMO      128
#define XB_XCNT(j)  (256  + 64 * (j))
#define XB_XSUB(j)  (1280 + 64 * (j))
#define XB_XGEN(j)  (2304 + 64 * (j))
#define XB_TOP      3328
#define XB_TOPGEN   3392
#define XCD_BAR_WORDS 3456
#define XB_SPIN_CAP (1u << 18)
__device__ __forceinline__ unsigned xb_ld(unsigned* p)              { return __hip_atomic_load(p, __ATOMIC_RELAXED, __HIP_MEMORY_SCOPE_AGENT); }
__device__ __forceinline__ unsigned xb_add(unsigned* p, unsigned v) { return __hip_atomic_fetch_add(p, v, __ATOMIC_RELAXED, __HIP_MEMORY_SCOPE_AGENT); }
__device__ __forceinline__ unsigned xb_xcc_id() { return (unsigned)__builtin_amdgcn_s_getreg((3 << 11) | 20) & 0xFu; }
#define XB_SPIN(cond, bar) do { unsigned _sp = 0; while (cond) { __builtin_amdgcn_s_sleep(1); \
    if ((++_sp & 255u) == 0u) { if (xb_ld(&(bar)[XB_TMO])) break; if (_sp > XB_SPIN_CAP) { atomicAdd(&(bar)[XB_TMO], 1u); break; } } } } while (0)
__device__ __forceinline__ void xcd_barrier_complete(unsigned* bar, unsigned x, unsigned& nloc, unsigned& nx) {
    const unsigned G = gridDim.x * gridDim.y * gridDim.z;
    unsigned sum, cnt, mine, sp = 0u;
    for (;;) {
        sum = 0u; cnt = 0u; mine = 0u;
#pragma unroll
        for (unsigned j = 0; j < 16; ++j) { const unsigned c = xb_ld(&bar[XB_XCNT(j)]); sum += c; cnt += (c > 0u) ? 1u : 0u; mine = (j == x) ? c : mine; }
        if (sum == G) break;
        __builtin_amdgcn_s_sleep(1);
        if ((++sp & 255u) == 0u) { if (xb_ld(&bar[XB_TMO])) break; if (sp > XB_SPIN_CAP) { atomicAdd(&bar[XB_TMO], 1u); break; } }
    }
    nloc = mine > 0u ? mine : 1u; nx = cnt > 0u ? cnt : 1u;
}
__device__ __forceinline__ void xcd_barrier(unsigned* bar, volatile LAS unsigned* st) {
    asm volatile("s_waitcnt vmcnt(0)" ::: "memory");
    __syncthreads();
    if (threadIdx.x == 0) {
        __builtin_amdgcn_s_waitcnt(0);
        const unsigned x = xb_xcc_id();
        unsigned nloc = st[0], nx = st[1];
        if (nloc == 0u) { xcd_barrier_complete(bar, x, nloc, nx); st[0] = nloc; st[1] = nx; }
        const unsigned old = xb_add(&bar[XB_XSUB(x)], 1u);
        const unsigned gen = old / nloc;
        if (old + 1u == (gen + 1u) * nloc) {
            __builtin_amdgcn_fence(__ATOMIC_RELEASE, "agent");
            asm volatile("s_waitcnt vmcnt(0)" ::: "memory");
            const unsigned og = xb_add(&bar[XB_TOP], 1u);
            const unsigned tg = og / nx;
            if (og + 1u == (tg + 1u) * nx) xb_add(&bar[XB_TOPGEN], 1u);
            else XB_SPIN(xb_ld(&bar[XB_TOPGEN]) == tg, bar);
            __builtin_amdgcn_fence(__ATOMIC_ACQUIRE, "agent");
            xb_add(&bar[XB_XGEN(x)], 1u);
            asm volatile("s_waitcnt vmcnt(0)" ::: "memory");
        } else {
            XB_SPIN(xb_ld(&bar[XB_XGEN(x)]) == gen, bar);
            __builtin_amdgcn_fence(__ATOMIC_ACQUIRE, "agent");
            asm volatile("s_waitcnt vmcnt(0)" ::: "memory");
        }
    }
    __syncthreads();
}

constexpr int NPH = 20;
__device__ __forceinline__ bool gemm_desc(int ph, const Params& P, GemmDesc& d) {
  unsigned char* ws = P.ws;
  const bf16_t* H = (const bf16_t*)(ws + OFF_H);
  d.G = P.grd; d.c = P.bid; d.A1 = nullptr; d.B1 = nullptr; d.pm01 = 0; d.nN1 = 1; d.n1 = 0; d.pm00 = 0; d.xin = nullptr; d.gidx = 0; d.gscale = 0.f; d.act = nullptr;
  switch (ph) {
  case 2: d.K = 2048; d.mode = M_SWIGLU; d.A0 = H; d.B0 = (const bf16_t*)(ws + OFF_W1A); d.nM0 = 132; d.nN0 = 44; d.act = (bf16_t*)(ws + OFF_ACT); break;
  case 3: d.K = DFF; d.mode = M_RESID; d.A0 = (const bf16_t*)(ws + OFF_ACT); d.B0 = (const bf16_t*)(ws + OFF_W1B); d.nM0 = 132; d.nN0 = 8; d.xin = P.x; d.gidx = 2; d.gscale = 0.5f; break;
  case 5: d.K = 2048; d.mode = M_RW; d.A0 = H; d.B0 = (const bf16_t*)(ws + OFF_WRW); d.nM0 = 132; d.nN0 = 14;
          d.A1 = H; d.B1 = (const bf16_t*)(ws + OFF_WQKVG) + (size_t)2048 * 2048; d.pm01 = 128; d.nN1 = 4; d.n1 = 16; break;
  case 7: d.K = 384; d.mode = M_LORA; d.A0 = (const bf16_t*)(ws + OFF_LIN); d.B0 = (const bf16_t*)(ws + OFF_WLORA); d.nM0 = 132; d.nN0 = 20; break;
  case 10: d.K = 2048; d.mode = M_QKVG; d.A0 = H; d.B0 = (const bf16_t*)(ws + OFF_WQKVG); d.nM0 = 128; d.nN0 = 28; break;
  case 13: d.K = 2048; d.mode = M_T1; d.A0 = (const bf16_t*)(ws + OFF_Q); d.B0 = (const bf16_t*)(ws + OFF_WOA); d.nM0 = 128; d.nN0 = 8; break;
  case 14: d.K = 1024; d.mode = M_M; d.A0 = (const bf16_t*)(ws + OFF_Y); d.B0 = (const bf16_t*)(ws + OFF_WOR); d.nM0 = 128; d.nN0 = 8; break;
  case 15: d.K = 2048; d.mode = M_RESID; d.A0 = (const bf16_t*)(ws + OFF_GR); d.B0 = (const bf16_t*)(ws + OFF_WOUT); d.nM0 = 128; d.nN0 = 8; d.xin = P.out; d.gidx = 5; d.gscale = 1.f; break;
  case 17: d.K = 2048; d.mode = M_SWIGLU; d.A0 = H; d.B0 = (const bf16_t*)(ws + OFF_W2A); d.nM0 = 128; d.nN0 = 44; d.act = (bf16_t*)(ws + OFF_ACT); break;
  case 18: d.K = DFF; d.mode = M_RESID; d.A0 = (const bf16_t*)(ws + OFF_ACT); d.B0 = (const bf16_t*)(ws + OFF_W2B); d.nM0 = 128; d.nN0 = 8; d.xin = P.out; d.gidx = 8; d.gscale = 0.5f; break;
  default: return false;
  }
  d.n0 = d.nM0 * d.nN0;
  return true;
}

__global__ void __launch_bounds__(512) mega_fwd(Params P) {
  extern __shared__ __attribute__((aligned(16))) unsigned char smem[];
  LAS unsigned char* lds = (LAS unsigned char*)smem;
  cg::grid_group grid = cg::this_grid();
  volatile LAS unsigned* bst = (volatile LAS unsigned*)(lds + LDS_BYTES + 192);
  unsigned* gbar = (unsigned*)(P.ws + OFF_BAR);
#if ONE_LAUNCH
  if (threadIdx.x == 0) { bst[0] = 0u; bst[1] = 0u; (void)xb_add(&gbar[XB_XCNT(xb_xcc_id())], 1u); }
  __syncthreads();
#endif
#pragma nounroll
  for (int ph = P.ph_lo; ph < P.ph_hi; ++ph) {
    GemmDesc d;
    int tid = threadIdx.x; asm volatile("" : "+v"(tid));
#if PROBE
    if (blockIdx.x == 0 && tid == 0) ((LAS unsigned long long*)(lds + LDS_BYTES))[ph] = __builtin_amdgcn_s_memrealtime();
#endif
    const __attribute__((address_space(4))) Params* kp = (const __attribute__((address_space(4))) Params*)__builtin_amdgcn_kernarg_segment_ptr();
    asm volatile("" : "+s"(kp));
#if defined(__HIP_DEVICE_COMPILE__)
    Params L = *kp;
#else
    Params L = P;
#endif
    { int b_ = blockIdx.x, g_ = gridDim.x; asm volatile("" : "+s"(b_), "+s"(g_)); L.bid = b_; L.grd = g_; }
    if (gemm_desc(ph, L, d)) gemm_phase(lds, d, L, tid);
    else switch (ph) {
      case 0: mod_phase(L, lds, tid); __syncthreads(); convert_phase(L, lds, tid); break;
      case 1: norm_mod_phase(L, L.x, L.ctx, MA, L.norm_ffn1, 0, tid); break;
      case 4: norm_mod_phase(L, L.out, (const float*)(L.ws + OFF_CX), MA, L.norm_mix, 3, tid); break;
      case 6: shift_phase(L, tid); break;
      case 8: scan_phase(L, lds, tid); break;
      case 9: rwkv_out_phase(L, tid); break;
      case 11: rope_phase(L, tid); break;
      case 12: attn_phase(L, smem, tid); break;
      case 16: norm_mod_phase(L, L.out, nullptr, MT, L.norm_ffn2, 6, tid); break;
      case 19: final_norm_phase(L, tid); break;
      default: break;
    }
    if (ph + 1 < P.ph_hi) { if (ph == 0) grid.sync(); else xcd_barrier(gbar, bst); }
  }
#if PROBE
  grid.sync();
  if (blockIdx.x == 0) {
    LAS unsigned long long* TS = (LAS unsigned long long*)(lds + LDS_BYTES);
    if (threadIdx.x == 0) TS[NPH] = __builtin_amdgcn_s_memrealtime();
    __syncthreads();
    const int K = (int)((TS[PROBE_HI] - TS[PROBE_LO]) / 100ull);
    int t2 = threadIdx.x; asm volatile("" : "+v"(t2));
    for (int i = t2; i < K && i < 16000; i += 512) P.out[(size_t)i * 4099] += 0.1f;
  }
#endif
}

extern "C" void kernel_launch(void* const* d_in, const int* in_sizes, int n_in, void* d_out, int out_size, void* d_ws, size_t ws_size, hipStream_t stream) {
  static int grid_blocks = 0;
  if (!grid_blocks) {
    if (n_in != 31 || out_size != MT * DM || ws_size < WS_TOTAL) { fprintf(stderr, "kernel_launch: unexpected shapes n_in %d out %d ws %zu (need %zu)\n", n_in, out_size, ws_size, WS_TOTAL); return; }
    if (hipFuncSetAttribute((const void*)mega_fwd, hipFuncAttributeMaxDynamicSharedMemorySize, LDS_BYTES + 256) != hipSuccess) { fprintf(stderr, "kernel_launch: hipFuncSetAttribute failed\n"); return; }
    int dev = 0, cus = 0, per_cu = 0;
    hipGetDevice(&dev);
    hipDeviceGetAttribute(&cus, hipDeviceAttributeMultiprocessorCount, dev);
    hipOccupancyMaxActiveBlocksPerMultiprocessor(&per_cu, mega_fwd, 512, LDS_BYTES + 256);
    if (per_cu < 1) { fprintf(stderr, "kernel_launch: occupancy query returned %d\n", per_cu); per_cu = 1; }
    grid_blocks = cus;
  }
  Params p{};
  const float** pf = (const float**)&p;
  for (int i = 0; i < 31; ++i) pf[i] = (const float*)d_in[i];
  p.out = (float*)d_out; p.ws = (unsigned char*)d_ws; p.bid = 0; p.grd = 0;
#if ONE_LAUNCH
  p.ph_lo = 0; p.ph_hi = NPH;
  if (hipMemsetAsync((char*)d_ws + OFF_BAR, 0, 3456 * 4, stream) != hipSuccess) { fprintf(stderr, "kernel_launch: memset of barrier words failed\n"); return; }
  void* args[] = {&p};
  hipError_t e = hipLaunchCooperativeKernel((const void*)mega_fwd, dim3(grid_blocks), dim3(512), args, LDS_BYTES + 256, stream);
  if (e != hipSuccess) fprintf(stderr, "cooperative launch failed: %s (grid %d)\n", hipGetErrorString(e), grid_blocks);
#else
  for (int ph = 0; ph < NPH; ++ph) { p.ph_lo = ph; p.ph_hi = ph + 1; hipLaunchKernelGGL(mega_fwd, dim3(grid_blocks), dim3(512), LDS_BYTES + 256, stream, p); }
#endif
}
```

```cpp
#include <hip/hip_runtime.h>
#include <hip/hip_cooperative_groups.h>
#include <cstdio>
#include <cstdint>
namespace cg = cooperative_groups;

#ifndef ONE_LAUNCH
#define ONE_LAUNCH 1
#endif

#ifndef PROBE
#define PROBE 0
#endif
#define PROBE_LO 8
#define PROBE_HI 9
#define LAS __attribute__((address_space(3)))
typedef unsigned short bf16_t;
typedef short bf16x8 __attribute__((ext_vector_type(8)));
typedef short s16x4 __attribute__((ext_vector_type(4)));
typedef float f32x4 __attribute__((ext_vector_type(4)));
typedef float f32x2 __attribute__((ext_vector_type(2)));
typedef float f32x16 __attribute__((ext_vector_type(16)));
typedef unsigned u32x4 __attribute__((ext_vector_type(4)));
typedef unsigned u32x2 __attribute__((ext_vector_type(2)));

constexpr int DM = 2048, NB = 4, SEQ = 8192, CTXL = 256, MT = NB * SEQ, MC = NB * CTXL, MA = MT + MC;
constexpr int DFF = 5632, SKV = SEQ + CTXL, NMODC = 9 * DM;
constexpr int PRW_LD = 3584, SH_LD = 3072, LIN_LD = 384, LO_LD = 5120;
constexpr int LDS_BYTES = 131072;

constexpr size_t SZ_WA = (size_t)11264 * 2048 * 2, SZ_WB = (size_t)2048 * 5632 * 2;
constexpr size_t OFF_W1A = 0, OFF_W1B = OFF_W1A + SZ_WA, OFF_W2A = OFF_W1B + SZ_WB, OFF_W2B = OFF_W2A + SZ_WA;
constexpr size_t OFF_WRW = OFF_W2B + SZ_WB, OFF_WQKVG = OFF_WRW + (size_t)3584 * 2048 * 2, OFF_WOA = OFF_WQKVG + (size_t)7168 * 2048 * 2;
constexpr size_t OFF_WOR = OFF_WOA + (size_t)2048 * 2048 * 2, OFF_WOUT = OFF_WOR + (size_t)2048 * 1024 * 2, OFF_WLORA = OFF_WOUT + (size_t)2048 * 2048 * 2;
constexpr size_t OFF_MOD = OFF_WLORA + (size_t)5120 * 384 * 2, OFF_CX = OFF_MOD + (size_t)5 * NMODC * 4, OFF_H = OFF_CX + (size_t)MC * DM * 4;
constexpr size_t OFF_BIG = OFF_H + (size_t)MA * DM * 2;
constexpr size_t SZ_KV = (size_t)NB * SKV * 512 * 2;
constexpr size_t OFF_KB = OFF_W1A, OFF_VB = OFF_KB + SZ_KV;
static_assert(OFF_VB + SZ_KV <= OFF_W2A, "KV overlay");
constexpr size_t OFF_ACT = OFF_BIG;
constexpr size_t OFF_PART = OFF_ACT + (size_t)MA * DFF * 2;
constexpr size_t OFF_PRW = OFF_BIG, OFF_LO = OFF_BIG, OFF_SH = OFF_LO + (size_t)MA * LO_LD * 2, OFF_LIN = OFF_SH + (size_t)MA * SH_LD * 2, OFF_Y = OFF_LIN;
constexpr size_t OFF_Q = OFF_BIG, OFF_GA = OFF_Q + (size_t)MT * DM * 2, OFF_GR = OFF_GA + (size_t)MT * DM * 2;
constexpr size_t END_A = OFF_ACT + (size_t)MA * DFF * 2, END_B = OFF_Y + (size_t)2 * MT * 1024 * 2, END_C = OFF_LIN + (size_t)MA * LIN_LD * 2;
constexpr size_t WS_END = END_A > END_B ? (END_A > END_C ? END_A : END_C) : (END_B > END_C ? END_B : END_C);
constexpr size_t OFF_BAR = (WS_END + 255) / 256 * 256, WS_TOTAL = OFF_BAR + 3456 * 4;
static_assert((size_t)MA * PRW_LD * 2 <= (size_t)MA * LO_LD * 2, "PRW under LO");
static_assert(OFF_GR + (size_t)MT * DM * 2 <= OFF_Y, "GR below RWO");

struct Params {
  const float *x, *c, *ctx, *c_ctx, *w_mod, *b_mod, *norm_ffn1, *ffn1_w_in, *ffn1_w_out, *norm_mix, *w_in, *q_norm, *k_norm, *rwkv_mu, *w0, *w2, *a0, *a2,
      *g2, *k_k, *k_a, *r_k, *ln_x_w, *ln_x_b, *w_oa, *w_or, *w_out, *norm_ffn2, *ffn2_w_in, *ffn2_w_out, *norm_final;
  float* out; unsigned char* ws; int ph_lo, ph_hi; int bid, grd;
};

__device__ __forceinline__ unsigned cvt_pk_bf16(float lo, float hi) { unsigned r; asm("v_cvt_pk_bf16_f32 %0, %1, %2" : "=v"(r) : "v"(lo), "v"(hi)); return r; }
__device__ __forceinline__ float bf2f(unsigned short b) { return __uint_as_float(((unsigned)b) << 16); }
__device__ __forceinline__ float bflo(unsigned w) { return __uint_as_float(w << 16); }
__device__ __forceinline__ float bfhi(unsigned w) { return __uint_as_float(w & 0xffff0000u); }
__device__ __forceinline__ unsigned short f2bf(float f) { return (unsigned short)(cvt_pk_bf16(f, 0.f) & 0xffffu); }
__device__ __forceinline__ float sigmoidf_(float x) { return __builtin_amdgcn_rcpf(1.f + __builtin_amdgcn_exp2f(-1.4426950408889634f * x)); }
template <int CTRL> __device__ __forceinline__ float dpp_mov(float x) { return __int_as_float(__builtin_amdgcn_update_dpp(0, __float_as_int(x), CTRL, 0xF, 0xF, true)); }
__device__ __forceinline__ float allred16(float x) {
  x += dpp_mov<0xB1>(x); x += dpp_mov<0x4E>(x); x += dpp_mov<0x141>(x); x += dpp_mov<0x140>(x); return x;
}

__device__ __forceinline__ float wave_sum(float v) {
  v = allred16(v);
  { auto rr = __builtin_amdgcn_permlane16_swap(__float_as_uint(v), __float_as_uint(v), false, false); v = __uint_as_float(rr[0]) + __uint_as_float(rr[1]); }
  { auto rr = __builtin_amdgcn_permlane32_swap(__float_as_uint(v), __float_as_uint(v), false, false); v = __uint_as_float(rr[0]) + __uint_as_float(rr[1]); }
  return v;
}

constexpr int BM = 256, BK = 64, HALF = 128, HTB = HALF * BK * 2;
__device__ __forceinline__ int lds_byte(int r, int c) { const int st = (r >> 4) * 2 + (c >> 5), rr = r & 15, cc = c & 31, ob = rr * 64 + cc * 2; return st * 1024 + (ob ^ (((ob >> 9) & 1) << 5)); }
__device__ __forceinline__ void stage_rc(int b, int& R, int& C) { const int st = b / 1024, sb = b % 1024, swz = sb ^ (((sb >> 9) & 1) << 5); R = (st >> 1) * 16 + swz / 64; C = (st & 1) * 32 + (swz % 64) / 2; }
__device__ __forceinline__ int perm32(int rho) { const int n = rho >> 4, i = rho & 15; return 8 * (i >> 2) + 4 * n + (i & 3); }

enum { M_SWIGLU = 0, M_RESID = 1, M_RW = 2, M_QKVG = 3, M_LORA = 4, M_T1 = 5, M_M = 6 };
struct Unit { const char* A; const char* B; int pm, pn, seg, nt; };
struct GemmDesc {
  int K, mode, G, c;
  const bf16_t *A0, *B0; int pm00, nM0, nN0, n0;
  const bf16_t *A1, *B1; int pm01, nN1, n1;
  int nt0, nt1, ksplit1;
  const float* xin; int gidx; float gscale;
  bf16_t* act;
};
__device__ __forceinline__ bool sched_next(const GemmDesc& d, int i, Unit& u) {
  long L = (long)i * d.G + d.c;
  if (L < d.n0) {
    int wgid = (int)L; const int nwg = d.n0;
    { const int q = nwg / 8, r = nwg % 8, xcd = wgid % 8, off = wgid / 8; wgid = (xcd < r ? xcd * (q + 1) : r * (q + 1) + (xcd - r) * q) + off; }
    const int nig = 8 * d.nN0, gid = wgid / nig, fm = gid * 8, gsz = (d.nM0 - fm) < 8 ? (d.nM0 - fm) : 8;
    const int pm = fm + ((wgid % nig) % gsz), pn = (wgid % nig) / gsz;
    u.pm = d.pm00 + pm; u.pn = pn; u.seg = 0; u.nt = d.nt0;
    u.A = (const char*)d.A0 + (size_t)u.pm * 512 * d.K; u.B = (const char*)d.B0 + (size_t)pn * 512 * d.K;
    if (d.mode == M_LORA) { const int ko = (pn < 8 ? 0 : (pn < 16 ? 128 : 256)) * 2; u.A += ko; u.B += ko; }
    return true;
  }
  L -= d.n0;
  if (L < d.n1) {
    const int sp = (int)L % d.ksplit1, l2 = (int)L / d.ksplit1;
    const int pm = l2 / d.nN1, pn = l2 % d.nN1; u.pm = d.pm01 + pm; u.pn = pn; u.seg = 1 + sp; u.nt = d.nt1;
    const size_t ko = (size_t)sp * d.nt1 * 128;
    u.A = (const char*)d.A1 + (size_t)u.pm * 512 * d.K + ko; u.B = (const char*)d.B1 + (size_t)pn * 512 * d.K + ko; return true;
  }
  return false;
}

__device__ __forceinline__ void gemm_epilogue(const f32x4 (&acc)[2][2][4][2], const Unit& u, const GemmDesc& d, const Params& P, int wr, int wc, int fr, int fq) {
  unsigned char* ws = P.ws;
  asm volatile("" : "+v"(fr), "+v"(fq));
  const int rl0 = wr * 64 + fr, cl0 = wc * 32 + 8 * fq;
  switch (d.mode) {
  case M_SWIGLU: {
    bf16_t* base = d.act + (size_t)u.pm * 256 * DFF + u.pn * 128 + cl0;
#pragma unroll
    for (int ai = 0; ai < 2; ++ai)
#pragma unroll
      for (int m = 0; m < 4; ++m) {
        const int row = rl0 + 128 * ai + 16 * m;
        float o[8];
#pragma unroll
        for (int n = 0; n < 2; ++n)
#pragma unroll
          for (int j = 0; j < 4; ++j) { const float g = acc[ai][0][m][n][j], up = acc[ai][1][m][n][j]; o[4 * n + j] = g * sigmoidf_(g) * up; }
        u32x4 w; w.x = cvt_pk_bf16(o[0], o[1]); w.y = cvt_pk_bf16(o[2], o[3]); w.z = cvt_pk_bf16(o[4], o[5]); w.w = cvt_pk_bf16(o[6], o[7]);
        *(u32x4*)(base + (size_t)row * DFF) = w;
      }
  } break;
  case M_RESID: {
    if (u.seg >= 1) {
      float* po = (float*)(ws + OFF_PART) + (size_t)(u.seg - 1) * MC * DM + (size_t)(u.pm - 128) * 256 * DM + u.pn * 256 + cl0;
#pragma unroll
      for (int ai = 0; ai < 2; ++ai)
#pragma unroll
        for (int m = 0; m < 4; ++m)
#pragma unroll
          for (int bj = 0; bj < 2; ++bj)
#pragma unroll
            for (int n = 0; n < 2; ++n) *(f32x4*)(po + (size_t)(rl0 + 128 * ai + 16 * m) * DM + 128 * bj + 4 * n) = acc[ai][bj][m][n];
      break;
    }
    const bool isc = u.pm >= 128; const int b = isc ? 4 : (u.pm >> 5);
    const float* xin = isc ? P.ctx + (size_t)(u.pm - 128) * 256 * DM : d.xin + (size_t)u.pm * 256 * DM;
    float* xo = isc ? (float*)(ws + OFF_CX) + (size_t)(u.pm - 128) * 256 * DM : P.out + (size_t)u.pm * 256 * DM;
    const float* gate = (const float*)(ws + OFF_MOD) + b * NMODC + d.gidx * DM + u.pn * 256 + cl0;
    f32x4 g4[2][2];
#pragma unroll
    for (int bj = 0; bj < 2; ++bj)
#pragma unroll
      for (int n = 0; n < 2; ++n) g4[bj][n] = *(const f32x4*)(gate + 128 * bj + 4 * n) * d.gscale;
#pragma unroll
    for (int ai = 0; ai < 2; ++ai)
#pragma unroll
      for (int m = 0; m < 4; ++m) {
        const size_t ro = (size_t)(rl0 + 128 * ai + 16 * m) * DM + u.pn * 256 + cl0;
#pragma unroll
        for (int bj = 0; bj < 2; ++bj)
#pragma unroll
          for (int n = 0; n < 2; ++n) {
            const f32x4 xv = *(const f32x4*)(xin + ro + 128 * bj + 4 * n);
            *(f32x4*)(xo + ro + 128 * bj + 4 * n) = xv + g4[bj][n] * acc[ai][bj][m][n];
          }
      }
  } break;
  case M_RW: case M_QKVG: case M_LORA: {
    bf16_t* base; int ld; int act = 0; const float* bias = nullptr;
    if (d.mode == M_RW) {
      if (u.seg == 0) { base = (bf16_t*)(ws + OFF_PRW) + (size_t)u.pm * 256 * PRW_LD + u.pn * 256; ld = PRW_LD; }
      else { const int b = u.pm - 128; base = (bf16_t*)(ws + (u.pn < 2 ? OFF_KB : OFF_VB)) + (size_t)(b * SKV + SEQ) * 512 + (u.pn & 1) * 256; ld = 512; }
    } else if (d.mode == M_QKVG) {
      const int b = u.pm >> 5;
      if (u.pn < 8) { base = (bf16_t*)(ws + OFF_Q) + (size_t)u.pm * 256 * DM + u.pn * 256; ld = DM; }
      else if (u.pn < 12) { base = (bf16_t*)(ws + (u.pn < 10 ? OFF_KB : OFF_VB)) + (size_t)(u.pm * 256 + b * CTXL) * 512 + (u.pn & 1) * 256; ld = 512; }
      else { base = (bf16_t*)(ws + (u.pn < 20 ? OFF_GA : OFF_GR)) + (size_t)u.pm * 256 * DM + ((u.pn - 12) & 7) * 256; ld = DM; act = 1; }
    } else {
      base = (bf16_t*)(ws + OFF_LO) + (size_t)u.pm * 256 * LO_LD + u.pn * 256; ld = LO_LD;
      if (u.pn < 8) { act = 2; bias = P.w0 + u.pn * 256; } else if (u.pn < 16) { act = 1; bias = P.a0 + (u.pn - 8) * 256; }
    }
#pragma unroll
    for (int bj = 0; bj < 2; ++bj) {
      f32x4 b0 = {0.f, 0.f, 0.f, 0.f}, b1 = {0.f, 0.f, 0.f, 0.f};
      if (bias) { b0 = *(const f32x4*)(bias + 128 * bj + cl0); b1 = *(const f32x4*)(bias + 128 * bj + cl0 + 4); }
#pragma unroll
      for (int ai = 0; ai < 2; ++ai)
#pragma unroll
        for (int m = 0; m < 4; ++m) {
          const int row = rl0 + 128 * ai + 16 * m;
          f32x4 v0 = acc[ai][bj][m][0] + b0, v1 = acc[ai][bj][m][1] + b1;
          if (act) {
            const float sc = act == 2 ? 0.60653065971263342f * 1.4426950408889634f : 1.f;
#pragma unroll
            for (int j = 0; j < 4; ++j) { v0[j] = sc * sigmoidf_(v0[j]); v1[j] = sc * sigmoidf_(v1[j]); }
          }
          u32x4 w; w.x = cvt_pk_bf16(v0[0], v0[1]); w.y = cvt_pk_bf16(v0[2], v0[3]); w.z = cvt_pk_bf16(v1[0], v1[1]); w.w = cvt_pk_bf16(v1[2], v1[3]);
          *(u32x4*)(base + (size_t)row * ld + 128 * bj + cl0) = w;
        }
    }
  } break;
  case M_T1: case M_M: {
    bf16_t* ga = (bf16_t*)(ws + OFF_GA) + (size_t)u.pm * 256 * DM + u.pn * 256 + cl0;
    bf16_t* gr = (bf16_t*)(ws + OFF_GR) + (size_t)u.pm * 256 * DM + u.pn * 256 + cl0;
    const bool isM = d.mode == M_M;
#pragma unroll
    for (int ai = 0; ai < 2; ++ai)
#pragma unroll
      for (int m = 0; m < 4; ++m)
#pragma unroll
        for (int bj = 0; bj < 2; ++bj) {
          const size_t o = (size_t)(rl0 + 128 * ai + 16 * m) * DM + 128 * bj;
          const f32x4 v0 = acc[ai][bj][m][0], v1 = acc[ai][bj][m][1];
          const u32x4 a = *(const u32x4*)(ga + o);
          u32x4 w;
          if (!isM) {
            w.x = cvt_pk_bf16(bflo(a.x) * v0[0], bfhi(a.x) * v0[1]); w.y = cvt_pk_bf16(bflo(a.y) * v0[2], bfhi(a.y) * v0[3]);
            w.z = cvt_pk_bf16(bflo(a.z) * v1[0], bfhi(a.z) * v1[1]); w.w = cvt_pk_bf16(bflo(a.w) * v1[2], bfhi(a.w) * v1[3]);
            *(u32x4*)(ga + o) = w;
          } else {
            const u32x4 g = *(const u32x4*)(gr + o);
            w.x = cvt_pk_bf16(bflo(a.x) + bflo(g.x) * v0[0], bfhi(a.x) + bfhi(g.x) * v0[1]); w.y = cvt_pk_bf16(bflo(a.y) + bflo(g.y) * v0[2], bfhi(a.y) + bfhi(g.y) * v0[3]);
            w.z = cvt_pk_bf16(bflo(a.z) + bflo(g.z) * v1[0], bfhi(a.z) + bfhi(g.z) * v1[1]); w.w = cvt_pk_bf16(bflo(a.w) + bflo(g.w) * v1[2], bfhi(a.w) + bfhi(g.w) * v1[3]);
            *(u32x4*)(gr + o) = w;
          }
        }
  } break;
  }
}

__device__ __forceinline__ void gemm_phase(LAS unsigned char* lds, const GemmDesc& d, const Params& P, const int tid) {
  const int wid = __builtin_amdgcn_readfirstlane(tid >> 6), lane = tid & 63, wr = wid >> 2, wc = wid & 3, fr = lane & 15, fq = lane >> 4;
  const int K = d.K;
  unsigned voffA[2], voffB[2];
#pragma unroll
  for (int i = 0; i < 2; ++i) { int R, C; stage_rc(tid * 16 + i * 8192, R, C); const int Rb = (R & ~31) + perm32(R & 31);
    voffA[i] = (unsigned)(R * K + C) * 2u; voffB[i] = (unsigned)(Rb * K + C) * 2u; }
  const size_t kstep = (size_t)(BK * 2);
  const size_t hstep = (size_t)HALF * K * 2;
  const unsigned ldsw = (unsigned)wid * 1024u;
  const int aoff = lds_byte(wr * 64 + fr, fq * 8), boff = lds_byte(wc * 32 + fr, fq * 8);
#define PG8_SA(b, h) (((b) * 2 + (h)) * HTB)
#define PG8_SB(b, h) ((4 + (b) * 2 + (h)) * HTB)
#define PG8_STAGE(bufoff, gbase, voff) do { _Pragma("unroll") for (int _i = 0; _i < 2; ++_i) \
    __builtin_amdgcn_global_load_lds((const unsigned*)((const char*)(gbase) + (voff)[_i]), (LAS unsigned*)(lds + (bufoff) + ldsw + _i * 8192), 16, 0, 0); } while (0)
#define PG8_LDA(dst, b, h) do { _Pragma("unroll") for (int m = 0; m < 4; ++m) _Pragma("unroll") for (int k = 0; k < 2; ++k) dst[m][k] = *(const LAS bf16x8*)(lds + PG8_SA(b, h) + aoff + m * 2048 + k * 1024); } while (0)
#define PG8_LDB(dst, b, h) do { _Pragma("unroll") for (int n = 0; n < 2; ++n) _Pragma("unroll") for (int k = 0; k < 2; ++k) dst[n][k] = *(const LAS bf16x8*)(lds + PG8_SB(b, h) + boff + n * 2048 + k * 1024); } while (0)
#define PG8_MMA(ai, bj, At, Bt) do { __builtin_amdgcn_s_setprio(1); _Pragma("unroll") for (int m = 0; m < 4; ++m) _Pragma("unroll") for (int n = 0; n < 2; ++n) _Pragma("unroll") for (int k = 0; k < 2; ++k) \
    acc[ai][bj][m][n] = __builtin_amdgcn_mfma_f32_16x16x32_bf16(Bt[n][k], At[m][k], acc[ai][bj][m][n], 0, 0, 0); __builtin_amdgcn_s_setprio(0); } while (0)
#define PG8_WAIT_V(n) asm volatile("s_waitcnt vmcnt(" #n ")" ::: "memory")
#define PG8_WAIT_L(n) asm volatile("s_waitcnt lgkmcnt(" #n ")" ::: "memory")
#define PG8_BAR __builtin_amdgcn_s_barrier()
#define PG8_SCHED __builtin_amdgcn_sched_barrier(0)
  Unit cur, nxt; int ui = 0;
  if (!sched_next(d, 0, cur)) return;
  f32x4 acc[2][2][4][2];
#pragma unroll
  for (int a = 0; a < 2; ++a)
#pragma unroll
    for (int b = 0; b < 2; ++b)
#pragma unroll
      for (int m = 0; m < 4; ++m)
#pragma unroll
        for (int n = 0; n < 2; ++n) acc[a][b][m][n] = (f32x4){0.f, 0.f, 0.f, 0.f};
  bf16x8 At[4][2], B0[2][2], B1[2][2];
  const char* cA = cur.A; const char* cB = cur.B;
  PG8_STAGE(PG8_SB(0, 0), cB, voffB); PG8_STAGE(PG8_SA(0, 0), cA, voffA); PG8_STAGE(PG8_SB(0, 1), cB + hstep, voffB); PG8_STAGE(PG8_SA(0, 1), cA + hstep, voffA);
  if (wr == 1) PG8_BAR;
  PG8_WAIT_V(4); PG8_BAR;
  PG8_STAGE(PG8_SB(1, 0), cB + kstep, voffB); PG8_STAGE(PG8_SA(1, 0), cA + kstep, voffA); PG8_STAGE(PG8_SB(1, 1), cB + hstep + kstep, voffB);
  PG8_WAIT_V(6); PG8_BAR;
  for (;;) {
    const bool has_next = sched_next(d, ui + 1, nxt);
    const char* nA = has_next ? nxt.A : cA; const char* nB = has_next ? nxt.B : cB;
    const int nt = cur.nt;
    for (int t = 0; t < nt; t += 2) {
      const bool last = (t == nt - 2);
      const char* a1 = cA + (size_t)(t + 1) * kstep;
      const char* a2 = last ? nA : cA + (size_t)(t + 2) * kstep; const char* b2 = last ? nB : cB + (size_t)(t + 2) * kstep;
      const char* a3 = a2 + kstep; const char* b3 = b2 + kstep;
      PG8_LDB(B0, 0, 0); PG8_SCHED; PG8_LDA(At, 0, 0); PG8_STAGE(PG8_SA(1, 1), a1 + hstep, voffA);
      PG8_WAIT_L(8); PG8_BAR; PG8_WAIT_L(0); PG8_MMA(0, 0, At, B0); PG8_BAR; PG8_SCHED;
      PG8_LDB(B1, 0, 1); PG8_STAGE(PG8_SB(0, 0), b2, voffB);
      PG8_BAR; PG8_WAIT_L(0); PG8_MMA(0, 1, At, B1); PG8_BAR;
      PG8_LDA(At, 0, 1); PG8_STAGE(PG8_SA(0, 0), a2, voffA);
      PG8_BAR; PG8_WAIT_L(0); PG8_MMA(1, 0, At, B0); PG8_BAR; PG8_SCHED;
      PG8_STAGE(PG8_SB(0, 1), b2 + hstep, voffB);
      PG8_WAIT_V(6); PG8_BAR; PG8_MMA(1, 1, At, B1); PG8_BAR;
      PG8_LDB(B0, 1, 0); PG8_SCHED; PG8_LDA(At, 1, 0); PG8_STAGE(PG8_SA(0, 1), a2 + hstep, voffA);
      PG8_WAIT_L(8); PG8_BAR; PG8_WAIT_L(0); PG8_MMA(0, 0, At, B0); PG8_BAR; PG8_SCHED;
      PG8_LDB(B1, 1, 1); PG8_STAGE(PG8_SB(1, 0), b3, voffB);
      PG8_BAR; PG8_WAIT_L(0); PG8_MMA(0, 1, At, B1); PG8_BAR;
      PG8_LDA(At, 1, 1); PG8_STAGE(PG8_SA(1, 0), a3, voffA);
      PG8_BAR; PG8_WAIT_L(0); PG8_MMA(1, 0, At, B0); PG8_BAR; PG8_SCHED;
      PG8_STAGE(PG8_SB(1, 1), b3 + hstep, voffB);
      PG8_WAIT_V(6); PG8_BAR; PG8_MMA(1, 1, At, B1); PG8_BAR;
    }
    gemm_epilogue(acc, cur, d, P, wr, wc, fr, fq);
    if (!has_next) break;
#pragma unroll
    for (int a = 0; a < 2; ++a)
#pragma unroll
      for (int b = 0; b < 2; ++b)
#pragma unroll
        for (int m = 0; m < 4; ++m)
#pragma unroll
          for (int n = 0; n < 2; ++n) acc[a][b][m][n] = (f32x4){0.f, 0.f, 0.f, 0.f};
    cur = nxt; cA = nA; cB = nB; ++ui;
  }
  PG8_WAIT_V(0);
  if (wr == 0) PG8_BAR;
  PG8_BAR;
#undef PG8_SA
#undef PG8_SB
#undef PG8_STAGE
#undef PG8_LDA
#undef PG8_LDB
#undef PG8_MMA
#undef PG8_WAIT_V
#undef PG8_WAIT_L
#undef PG8_BAR
#undef PG8_SCHED
}

namespace att {
constexpr int D = 128, NW = 8, QBLK = 32, KVBLK = 64;
constexpr float SCALE = 0.088388347648318440f;
constexpr float THR = 8.f;
constexpr int LDQ = 2048, LDK = 512, LDO = 2048;
constexpr size_t SHM_V = KVBLK * D * 2, SHM_K = KVBLK * D * 2;
#define KSWZ(row, colB) ((row) * 256 + ((colB) ^ (((row) & 7) << 4)))
#define SBAR() __builtin_amdgcn_sched_barrier(0)
__device__ __forceinline__ int crow(int r, int hi) { return (r & 3) + 8 * (r >> 2) + 4 * hi; }
__device__ __forceinline__ unsigned cvtpk(float lo, float hi) { unsigned r; asm volatile("v_cvt_pk_bf16_f32 %0, %1, %2" : "=v"(r) : "v"(lo), "v"(hi)); return r; }
__device__ __forceinline__ void partialSM(f32x16& p0, f32x16& p1, float& m_reg, float& mn, float& alpha) {
  constexpr float C = SCALE * 1.4426950408889634f;
  float pmax = p0[0];
#pragma unroll
  for (int r = 1; r < 16; ++r) pmax = fmaxf(pmax, p0[r]);
#pragma unroll
  for (int r = 0; r < 16; ++r) pmax = fmaxf(pmax, p1[r]);
  { auto rr = __builtin_amdgcn_permlane32_swap(__float_as_uint(pmax), __float_as_uint(pmax), false, false);
    pmax = fmaxf(__uint_as_float(rr[0]), __uint_as_float(rr[1])); }
  if (__builtin_expect(__all(pmax - m_reg <= THR / SCALE), 1)) { mn = m_reg; alpha = 1.f; }
  else { mn = fmaxf(m_reg, pmax); alpha = __builtin_amdgcn_exp2f((m_reg - mn) * C); m_reg = mn; }
  float mnC = -mn * C;
#pragma unroll
  for (int r = 0; r < 16; ++r) p0[r] = fmaf(p0[r], C, mnC);
#pragma unroll
  for (int r = 0; r < 16; ++r) p1[r] = fmaf(p1[r], C, mnC);
#pragma unroll
  for (int r = 0; r < 16; ++r) p0[r] = __builtin_amdgcn_exp2f(p0[r]);
}
__device__ __forceinline__ void finishSM(f32x16& p0, f32x16& p1, float alpha, float& l_reg, bf16x8& pa0, bf16x8& pa1, bf16x8& pa2, bf16x8& pa3) {
#pragma unroll
  for (int r = 0; r < 16; ++r) p1[r] = __builtin_amdgcn_exp2f(p1[r]);
  float ps = 0;
#pragma unroll
  for (int r = 0; r < 16; ++r) ps += p0[r];
#pragma unroll
  for (int r = 0; r < 16; ++r) ps += p1[r];
  { auto rr = __builtin_amdgcn_permlane32_swap(__float_as_uint(ps), __float_as_uint(ps), false, false);
    ps = __uint_as_float(rr[0]) + __uint_as_float(rr[1]); }
  l_reg = l_reg * alpha + ps;
#define PK4(P, BASE, OUT) do { unsigned a0 = cvtpk(P[BASE + 0], P[BASE + 1]), a1 = cvtpk(P[BASE + 2], P[BASE + 3]);   \
    unsigned b0 = cvtpk(P[BASE + 4], P[BASE + 5]), b1 = cvtpk(P[BASE + 6], P[BASE + 7]);                              \
    auto r0 = __builtin_amdgcn_permlane32_swap(a0, b0, false, false); auto r1 = __builtin_amdgcn_permlane32_swap(a1, b1, false, false); \
    u32x4 w = {r0[0], r1[0], r0[1], r1[1]}; OUT = *reinterpret_cast<bf16x8*>(&w); } while (0)
  PK4(p0, 0, pa0); PK4(p0, 8, pa1); PK4(p1, 0, pa2); PK4(p1, 8, pa3);
#undef PK4
}
__device__ __forceinline__ void qkt(f32x16& p0, f32x16& p1, const bf16_t* Ks, const bf16x8* qr, int r32, int hi) {
  p0 = f32x16{}; p1 = f32x16{};
#pragma unroll
  for (int d0 = 0; d0 < 8; ++d0) { int cb = (d0 * 16 + hi * 8) * 2;
    bf16x8 b0 = *reinterpret_cast<const bf16x8*>((const char*)Ks + KSWZ(r32, cb));
    bf16x8 b1 = *reinterpret_cast<const bf16x8*>((const char*)Ks + KSWZ(32 + r32, cb));
    p0 = __builtin_amdgcn_mfma_f32_32x32x16_bf16(b0, qr[d0], p0, 0, 0, 0);
    p1 = __builtin_amdgcn_mfma_f32_32x32x16_bf16(b1, qr[d0], p1, 0, 0, 0); }
}
__device__ __forceinline__ int v_st(int k, int c) { const int kk = (k & ~0xC) | ((k & 4) << 1) | ((k & 8) >> 1); return ((kk >> 3) * 4 + (c >> 5)) * 512 + ((kk & 7) * 32 + (c & 31)) * 2; }
__device__ __forceinline__ int v_rd_base(int lane) { return ((lane & 3) << 3) | (((lane >> 2) & 3) << 6) | (((lane >> 4) & 1) << 5) | (((lane >> 5) & 1) << 8); }
constexpr int v_rd_off(int d0, int ks, int half) { return d0 * 512 + ks * 4096 + half * 2048; }
template <int OFF> __device__ __forceinline__ s16x4 tr_read(int vb) {
  s16x4 r; asm volatile("ds_read_b64_tr_b16 %0, %1 offset:%2" : "=&v"(r) : "v"(vb), "i"(OFF) : "memory"); return r;
}
template <int D0> __device__ __forceinline__ void pv_one(f32x16& od, int vb, bf16x8 pa0, bf16x8 pa1, bf16x8 pa2, bf16x8 pa3) {
  const s16x4 l0 = tr_read<v_rd_off(D0, 0, 0)>(vb), h0 = tr_read<v_rd_off(D0, 0, 1)>(vb), l1 = tr_read<v_rd_off(D0, 1, 0)>(vb), h1 = tr_read<v_rd_off(D0, 1, 1)>(vb);
  const s16x4 l2 = tr_read<v_rd_off(D0, 2, 0)>(vb), h2 = tr_read<v_rd_off(D0, 2, 1)>(vb), l3 = tr_read<v_rd_off(D0, 3, 0)>(vb), h3 = tr_read<v_rd_off(D0, 3, 1)>(vb);
  asm volatile("s_waitcnt lgkmcnt(0)" ::: "memory"); SBAR();
#define PK(L, H) (bf16x8){L[0], L[1], L[2], L[3], H[0], H[1], H[2], H[3]}
  od = __builtin_amdgcn_mfma_f32_32x32x16_bf16(pa0, PK(l0, h0), od, 0, 0, 0);
  od = __builtin_amdgcn_mfma_f32_32x32x16_bf16(pa1, PK(l1, h1), od, 0, 0, 0);
  od = __builtin_amdgcn_mfma_f32_32x32x16_bf16(pa2, PK(l2, h2), od, 0, 0, 0);
  od = __builtin_amdgcn_mfma_f32_32x32x16_bf16(pa3, PK(l3, h3), od, 0, 0, 0);
#undef PK
}
__device__ __forceinline__ void pv_d0(f32x16* o, int vb, bf16x8 pa0, bf16x8 pa1, bf16x8 pa2, bf16x8 pa3) {
  pv_one<0>(o[0], vb, pa0, pa1, pa2, pa3); pv_one<1>(o[1], vb, pa0, pa1, pa2, pa3); pv_one<2>(o[2], vb, pa0, pa1, pa2, pa3); pv_one<3>(o[3], vb, pa0, pa1, pa2, pa3);
}
__device__ __forceinline__ void attn_dense_body(const bf16_t* __restrict__ Qb, const bf16_t* __restrict__ Kh, const bf16_t* __restrict__ Vh,
                                                bf16_t* __restrict__ Ob, int seq, char* lds, const int tid) {
  const int wid = tid >> 6, lane = tid & 63, r32 = lane & 31, hi = lane >> 5;
  bf16_t* V_lds = (bf16_t*)lds; bf16_t* K_lds = (bf16_t*)(lds + 2 * SHM_V);
  float* wsf = (float*)(lds + 2 * SHM_V + 2 * SHM_K) + wid * 64; float* li_l = wsf; float* al_l = wsf + 32;
  float m_reg = -1e30f, l_reg = 0; f32x16 o[4] = {}; bf16x8 qr[8];
  const bf16_t* Qw = Qb + (long)(wid * QBLK + r32) * LDQ + hi * 8;
#pragma unroll
  for (int d0 = 0; d0 < 8; ++d0) qr[d0] = *reinterpret_cast<const bf16x8*>(Qw + d0 * 16);
  const int sr = tid >> 4, sc = (tid & 15) * 8, vst0 = v_st(sr, sc), vst1 = v_st(32 + sr, sc);
  const int vb0 = (int)(uintptr_t)V_lds + v_rd_base(lane);
  struct { bf16x8 vs0, vs1, ks0, ks1; } sr_[2];
#define LD8(p) (*reinterpret_cast<const bf16x8*>(p))
  const unsigned voff = (unsigned)(sr * LDK + sc) * 2u;
#define SLOAD(i, k0) do { const char* vb_ = (const char*)(Vh + (size_t)(k0) * LDK); const char* kb_ = (const char*)(Kh + (size_t)(k0) * LDK); \
    sr_[i].vs0 = LD8(vb_ + voff); sr_[i].vs1 = LD8(vb_ + 32 * LDK * 2 + voff); sr_[i].ks0 = LD8(kb_ + voff); sr_[i].ks1 = LD8(kb_ + 32 * LDK * 2 + voff); } while (0)
#define SWRITE(b, i) do { *(bf16x8*)((char*)V_lds + (b) * SHM_V + vst0) = sr_[i].vs0;          \
    *(bf16x8*)((char*)V_lds + (b) * SHM_V + vst1) = sr_[i].vs1; int kc = sc * 2;               \
    *(bf16x8*)((char*)K_lds + (b) * SHM_K + KSWZ(sr, kc)) = sr_[i].ks0;                       \
    *(bf16x8*)((char*)K_lds + (b) * SHM_K + KSWZ(32 + sr, kc)) = sr_[i].ks1; } while (0)
#define SWAIT() asm volatile("s_waitcnt vmcnt(4)" ::: "memory")
#define RESC(a) do { if (__any((a) < 1.f)) { if (hi == 0) al_l[r32] = (a); asm volatile("s_waitcnt lgkmcnt(0)" ::: "memory"); \
    _Pragma("unroll") for (int d = 0; d < 4; ++d) _Pragma("unroll") for (int r = 0; r < 16; ++r) o[d][r] *= al_l[crow(r, hi)]; } } while (0)
  f32x16 pA0, pA1, pB0, pB1; float mnA, mnB, alA, alB; bf16x8 pa0, pa1, pa2, pa3; const int NT = seq / KVBLK;
  constexpr int SE = 0, SO = 1;
  SLOAD(SE, 0); asm volatile("s_waitcnt vmcnt(0)" ::: "memory"); SWRITE(0, SE); __syncthreads();
  qkt(pA0, pA1, K_lds, qr, r32, hi); partialSM(pA0, pA1, m_reg, mnA, alA);
  SLOAD(SO, KVBLK); if (2 < NT) SLOAD(SE, 2 * KVBLK);
  SWAIT(); SWRITE(1, SO); __syncthreads();
  for (int j = 1; j + 1 < NT; j += 2) {
    SBAR(); qkt(pB0, pB1, (bf16_t*)((char*)K_lds + SHM_K), qr, r32, hi);
    finishSM(pA0, pA1, alA, l_reg, pa0, pa1, pa2, pa3); SBAR();
    SLOAD(SO, (j + 2) * KVBLK); SBAR();
    pv_d0(o, vb0, pa0, pa1, pa2, pa3); partialSM(pB0, pB1, m_reg, mnB, alB);
    __syncthreads(); SWAIT(); SWRITE(0, SE);
    RESC(alB); __syncthreads();
    SBAR(); qkt(pA0, pA1, K_lds, qr, r32, hi);
    finishSM(pB0, pB1, alB, l_reg, pa0, pa1, pa2, pa3); SBAR();
    if (j + 3 < NT) SLOAD(SE, (j + 3) * KVBLK); SBAR();
    pv_d0(o, vb0 + (int)SHM_V, pa0, pa1, pa2, pa3); partialSM(pA0, pA1, m_reg, mnA, alA);
    __syncthreads(); SWAIT(); SWRITE(1, SO);
    RESC(alA); __syncthreads();
  }
  SBAR(); qkt(pB0, pB1, (bf16_t*)((char*)K_lds + SHM_K), qr, r32, hi);
  finishSM(pA0, pA1, alA, l_reg, pa0, pa1, pa2, pa3); SBAR();
  pv_d0(o, vb0, pa0, pa1, pa2, pa3); partialSM(pB0, pB1, m_reg, mnB, alB);
  __syncthreads(); RESC(alB);
  finishSM(pB0, pB1, alB, l_reg, pa0, pa1, pa2, pa3); SBAR();
  pv_d0(o, vb0 + (int)SHM_V, pa0, pa1, pa2, pa3);
  if (hi == 0) li_l[r32] = l_reg; asm volatile("s_waitcnt lgkmcnt(0)" ::: "memory");
  float rli[16];
#pragma unroll
  for (int r = 0; r < 16; ++r) rli[r] = __builtin_amdgcn_rcpf(li_l[crow(r, hi)]);
  bf16_t* Ow = Ob + (long)(wid * QBLK) * LDO;
#pragma unroll
  for (int r = 0; r < 16; ++r) { int orow = crow(r, hi);
#pragma unroll
    for (int d0 = 0; d0 < 4; ++d0) Ow[(long)orow * LDO + d0 * 32 + r32] = f2bf(o[d0][r] * rli[r]); }
#undef LD8
#undef SLOAD
#undef SWRITE
#undef SWAIT
#undef RESC
}
}

__device__ __forceinline__ void mod_phase(const Params& P, LAS unsigned char* lds, const int tid) {
  LAS float* sc = (LAS float*)lds; LAS float* red = sc + 5 * 2048;
  const int wid = tid >> 6, lane = tid & 63;
  for (int i = tid; i < 5 * 2048; i += 512) { const int j = i >> 11, k = i & 2047; const float v = (j < 4) ? P.c[j * 2048 + k] : P.c_ctx[k]; sc[i] = v * sigmoidf_(v); }
  __syncthreads();
  float* MOD = (float*)(P.ws + OFF_MOD);
  for (int task = P.bid; task < 256; task += P.grd) {
    const int n0 = task * 72 + lane * 2;
    float a0[5], a1[5];
#pragma unroll
    for (int j = 0; j < 5; ++j) { a0[j] = 0.f; a1[j] = 0.f; }
    if (lane < 36) {
      const float* wp = P.w_mod + (size_t)(wid * 256) * NMODC + n0;
#pragma unroll 16
      for (int k = 0; k < 256; ++k) {
        const f32x2 w = *(const f32x2*)(wp + (size_t)k * NMODC);
#pragma unroll
        for (int j = 0; j < 5; ++j) { const float s = sc[j * 2048 + wid * 256 + k]; a0[j] += s * w.x; a1[j] += s * w.y; }
      }
#pragma unroll
      for (int j = 0; j < 5; ++j) { red[(wid * 5 + j) * 72 + lane * 2] = a0[j]; red[(wid * 5 + j) * 72 + lane * 2 + 1] = a1[j]; }
    }
    __syncthreads();
    if (tid < 360) { const int j = tid / 72, ci = tid % 72; float s = 0.f;
#pragma unroll
      for (int w = 0; w < 8; ++w) s += red[(w * 5 + j) * 72 + ci];
      MOD[j * NMODC + task * 72 + ci] = s + P.b_mod[task * 72 + ci]; }
    __syncthreads();
  }
}
__device__ __forceinline__ void tr_item(const float* __restrict__ W, int ldw, int k0, int n0, bf16_t* __restrict__ WT, int ldt, int drow0, int dk0, LAS float* scr, int lane) {
#pragma unroll 32
  for (int i = 0; i < 32; ++i) { const int kk = 2 * i + (lane >> 5); scr[kk * 33 + (lane & 31)] = W[(size_t)(k0 + kk) * ldw + n0 + (lane & 31)]; }
  asm volatile("s_waitcnt lgkmcnt(0)" ::: "memory");
  const int c = lane & 7;
#pragma unroll
  for (int j = 0; j < 4; ++j) { const int n = (lane >> 3) + 8 * j; const LAS float* s = scr + (8 * c) * 33 + n;
    u32x4 o; o.x = cvt_pk_bf16(s[0 * 33], s[1 * 33]); o.y = cvt_pk_bf16(s[2 * 33], s[3 * 33]); o.z = cvt_pk_bf16(s[4 * 33], s[5 * 33]); o.w = cvt_pk_bf16(s[6 * 33], s[7 * 33]);
    *(u32x4*)(WT + (size_t)(drow0 + n) * ldt + dk0 + k0 + 8 * c) = o; }
  asm volatile("s_waitcnt lgkmcnt(0)" ::: "memory");
}
__device__ __forceinline__ void convert_phase(const Params& P, LAS unsigned char* lds, const int tid) {
  const int wid = tid >> 6, lane = tid & 63;
  LAS float* scr = (LAS float*)(lds + wid * 8704);
  unsigned char* ws = P.ws;
  bf16_t *W1A = (bf16_t*)(ws + OFF_W1A), *W1B = (bf16_t*)(ws + OFF_W1B), *W2A = (bf16_t*)(ws + OFF_W2A), *W2B = (bf16_t*)(ws + OFF_W2B);
  bf16_t *WRW = (bf16_t*)(ws + OFF_WRW), *WQKVG = (bf16_t*)(ws + OFF_WQKVG), *WOA = (bf16_t*)(ws + OFF_WOA), *WOR = (bf16_t*)(ws + OFF_WOR), *WOUT = (bf16_t*)(ws + OFF_WOUT), *WLORA = (bf16_t*)(ws + OFF_WLORA);
  const int G = P.grd, gw = P.bid * 8 + wid, NGW = G * 8;
  constexpr int NITEMS = 22528 + 11264 + 3456 + 7168 + 2048 + 1024 + 2048 + 192;
  for (int it = gw; it < NITEMS; it += NGW) {
    int r = it;
    if (r < 22528) { const int which = r >= 11264; r -= which * 11264; const int kb = r / 352, nb = r % 352, n0 = nb * 32;
      const int drow = n0 < DFF ? (n0 >> 7) * 256 + (n0 & 127) : ((n0 - DFF) >> 7) * 256 + 128 + ((n0 - DFF) & 127);
      tr_item(which ? P.ffn2_w_in : P.ffn1_w_in, 2 * DFF, kb * 64, n0, which ? W2A : W1A, 2048, drow, 0, scr, lane); continue; }
    r -= 22528;
    if (r < 11264) { const int which = r >= 5632; r -= which * 5632; const int kb = r >> 6, nb = r & 63;
      tr_item(which ? P.ffn2_w_out : P.ffn1_w_out, 2048, kb * 64, nb * 32, which ? W2B : W1B, DFF, nb * 32, 0, scr, lane); continue; }
    r -= 11264;
    if (r < 3456) { const int kb = r / 108, nb = r % 108; tr_item(P.w_in, 10624, kb * 64, 3072 + nb * 32, WRW, 2048, nb * 32, 0, scr, lane); continue; }
    r -= 3456;
    if (r < 7168) { const int kb = r / 224, nb = r % 224; const int n0 = nb < 96 ? nb * 32 : 6528 + (nb - 96) * 32;
      tr_item(P.w_in, 10624, kb * 64, n0, WQKVG, 2048, nb * 32, 0, scr, lane); continue; }
    r -= 7168;
    if (r < 2048) { tr_item(P.w_oa, 2048, (r >> 6) * 64, (r & 63) * 32, WOA, 2048, (r & 63) * 32, 0, scr, lane); continue; }
    r -= 2048;
    if (r < 1024) { tr_item(P.w_or, 2048, (r >> 6) * 64, (r & 63) * 32, WOR, 1024, (r & 63) * 32, 0, scr, lane); continue; }
    r -= 1024;
    if (r < 2048) { tr_item(P.w_out, 2048, (r >> 6) * 64, (r & 63) * 32, WOUT, 2048, (r & 63) * 32, 0, scr, lane); continue; }
    r -= 2048;
    if (r < 64) { const int z = r >> 5, nb = r & 31; tr_item(P.w2 + (size_t)z * 64 * 1024, 1024, 0, nb * 32, WLORA, LIN_LD, z * 1024 + nb * 32, z * 64, scr, lane); continue; }
    r -= 64;
    if (r < 64) { const int z = r >> 5, nb = r & 31; tr_item(P.a2 + (size_t)z * 64 * 1024, 1024, 0, nb * 32, WLORA, LIN_LD, 2048 + z * 1024 + nb * 32, 128 + z * 64, scr, lane); continue; }
    r -= 64;
    { const int kb = r >> 5, nb = r & 31; tr_item(P.g2, 1024, kb * 64, nb * 32, WLORA, LIN_LD, 4096 + nb * 32, 256, scr, lane); }
  }
  const int gt = P.bid * 512 + tid, NT = G * 512;
  unsigned zz = 0u; asm volatile("" : "+v"(zz));
  const u32x4 z4 = {zz, zz, zz, zz};
  for (int i = gt; i < 128 * 256; i += NT) *(u32x4*)(WRW + (size_t)3456 * 2048 + (size_t)i * 8) = z4;
  for (int i = gt; i < 5120 * 48; i += NT) { const int row = i / 48, kc = (i % 48) * 8, rb = row >> 10;
    const int lo = rb < 4 ? rb * 64 : 256, hi = rb < 4 ? rb * 64 + 64 : 384;
    if (kc < lo || kc >= hi) *(u32x4*)(WLORA + (size_t)row * LIN_LD + kc) = z4; }
}
__device__ __forceinline__ void norm_mod_phase(const Params& P, const float* __restrict__ lat, const float* __restrict__ ctxp, int nrows, const float* __restrict__ g, int midx, const float* __restrict__ parts, const int tid) {
  const int wid = tid >> 6, lane = tid & 63;
  const int gw = P.bid * 8 + wid, NGW = P.grd * 8;
  const float* __restrict__ MOD = (const float*)(P.ws + OFF_MOD); bf16_t* __restrict__ H = (bf16_t*)(P.ws + OFF_H);
  for (int r = gw; r < nrows; r += NGW) {
    const float* xr = r < MT ? lat + (size_t)r * DM : ctxp + (size_t)(r - MT) * DM;
    const int b = r < MT ? (r >> 13) : 4;
    const float* sh = MOD + b * NMODC + midx * DM; const float* scp = sh + DM;
    f32x4 v[8], g4[8], s4[8], c4[8]; float ss = 0.f;
#pragma unroll
    for (int j = 0; j < 8; ++j) v[j] = *(const f32x4*)(xr + j * 256 + lane * 4);
    if (parts && r >= MT) {
      const float* pp = parts + (size_t)(r - MT) * DM; const float* gt = MOD + 4 * NMODC + 2 * DM;
#pragma unroll
      for (int j = 0; j < 8; ++j) { const int c = j * 256 + lane * 4;
        const f32x4 s = (*(const f32x4*)(pp + c) + *(const f32x4*)(pp + (size_t)MC * DM + c)) + (*(const f32x4*)(pp + (size_t)2 * MC * DM + c) + *(const f32x4*)(pp + (size_t)3 * MC * DM + c));
        v[j] = v[j] + *(const f32x4*)(gt + c) * 0.5f * s; }
    }
#pragma unroll
    for (int j = 0; j < 8; ++j) { const int c = j * 256 + lane * 4; g4[j] = *(const f32x4*)(g + c); s4[j] = *(const f32x4*)(sh + c); c4[j] = *(const f32x4*)(scp + c); }
#pragma unroll
    for (int j = 0; j < 8; ++j) ss += v[j].x * v[j].x + v[j].y * v[j].y + v[j].z * v[j].z + v[j].w * v[j].w;
    ss = wave_sum(ss);
    const float rs = rsqrtf(ss * (1.f / DM) + 1e-6f);
#pragma unroll
    for (int j = 0; j < 8; ++j) { const int c = j * 256 + lane * 4;
      const f32x4 y = v[j] * rs * g4[j]; const f32x4 h = y * (c4[j] + 1.f) + s4[j];
      u32x2 w; w.x = cvt_pk_bf16(h.x, h.y); w.y = cvt_pk_bf16(h.z, h.w);
      *(u32x2*)(H + (size_t)r * DM + c) = w; }
  }
}
__device__ __forceinline__ void shift_phase(const Params& P, const int tid) {
  const bf16_t* PRW = (const bf16_t*)(P.ws + OFF_PRW); bf16_t* SH = (bf16_t*)(P.ws + OFF_SH); bf16_t* LIN = (bf16_t*)(P.ws + OFF_LIN);
  const int gt = P.bid * 512 + tid, NT = P.grd * 512;
  for (int idx = gt; idx < MA * 432; idx += NT) {
    const int r = idx / 432, c = (idx % 432) * 8;
    bool first, last;
    if (r < MT) { const int t = r & (SEQ - 1); first = t == 0; last = t == SEQ - 1; } else { const int t = (r - MT) & (CTXL - 1); first = t == 0; last = t == CTXL - 1; }
    const u32x4 z4 = {0u, 0u, 0u, 0u};
    const u32x4 p = *(const u32x4*)(PRW + (size_t)r * PRW_LD + c);
    const u32x4 pv = first ? z4 : *(const u32x4*)(PRW + (size_t)(r - 1) * PRW_LD + c);
    const u32x4 nx = last ? z4 : *(const u32x4*)(PRW + (size_t)(r + 1) * PRW_LD + c);
    const f32x4 m0 = *(const f32x4*)(P.rwkv_mu + c), m1 = *(const f32x4*)(P.rwkv_mu + c + 4);
    float o[8];
#define SHF(e, W, MU, HI) { const float pp = HI ? bfhi(p.W) : bflo(p.W), a = HI ? bfhi(pv.W) : bflo(pv.W), b = HI ? bfhi(nx.W) : bflo(nx.W); o[e] = pp + MU * (0.5f * (a + b) - pp); }
    SHF(0, x, m0.x, 0) SHF(1, x, m0.y, 1) SHF(2, y, m0.z, 0) SHF(3, y, m0.w, 1) SHF(4, z, m1.x, 0) SHF(5, z, m1.y, 1) SHF(6, w, m1.z, 0) SHF(7, w, m1.w, 1)
#undef SHF
    bf16_t* dst;
    if (c < 3072) dst = SH + (size_t)r * SH_LD + c;
    else { const int cl = c - 3072; dst = LIN + (size_t)r * LIN_LD + cl;
      if (cl < 128) {
#pragma unroll
        for (int e = 0; e < 8; ++e) { const float ex = __builtin_amdgcn_exp2f(2.8853900817779268f * o[e]); o[e] = 1.f - 2.f * __builtin_amdgcn_rcpf(ex + 1.f); }
      } else if (cl >= 256) {
#pragma unroll
        for (int e = 0; e < 8; ++e) o[e] = sigmoidf_(o[e]);
      } }
    u32x4 w; w.x = cvt_pk_bf16(o[0], o[1]); w.y = cvt_pk_bf16(o[2], o[3]); w.z = cvt_pk_bf16(o[4], o[5]); w.w = cvt_pk_bf16(o[6], o[7]);
    *(u32x4*)dst = w;
  }
}
__device__ __forceinline__ float SFMA(float a, float b, float c) { float d; asm("v_fma_f32 %0, %1, %2, %3" : "=v"(d) : "v"(a), "v"(b), "v"(c)); return d; }
__device__ __forceinline__ float SMUL(float a, float b) { float d; asm("v_mul_f32 %0, %1, %2" : "=v"(d) : "v"(a), "v"(b)); return d; }
__device__ __forceinline__ float allred8(float x) { x += dpp_mov<0xB1>(x); x += dpp_mov<0x4E>(x); x += dpp_mov<0x141>(x); return x; }
__device__ __forceinline__ void scan_phase(const Params& P, LAS unsigned char* lds, const int tid) {
  LAS float* F = (LAS float*)lds;
  LAS unsigned short* YB = (LAS unsigned short*)(lds + 2 * 32 * 384 * 4);
  const bf16_t* SH = (const bf16_t*)(P.ws + OFF_SH); const bf16_t* LO = (const bf16_t*)(P.ws + OFF_LO); bf16_t* Y = (bf16_t*)(P.ws + OFF_Y);
  const int wid = __builtin_amdgcn_readfirstlane(tid >> 6), lane = tid & 63;
  constexpr int NCH = SKV / 32;
#define SCAN_BAR() do { asm volatile("s_waitcnt lgkmcnt(0)" ::: "memory"); __builtin_amdgcn_s_barrier(); asm volatile("" ::: "memory"); } while (0)
  for (int task = P.bid; task < 256; task += P.grd) {
    const int half = (task >> 3) & 1, chain = (task & 7) | ((task >> 4) << 3);
    const int dir = chain & 1, h = (chain >> 1) & 15, b = chain >> 5, hc = h * 64;
#define ROWOF(g) ((g) < CTXL ? (MT + b * CTXL + (dir ? CTXL - 1 - (g) : (g))) : (b * SEQ + (dir ? SEQ - 1 - ((g) - CTXL) : ((g) - CTXL))))
    if (wid < 4) {
      const int rloc = wid * 8 + (lane >> 3), irow = half * 32 + rloc, cA = (lane & 7) * 4, cB = 32 + cA;
      f32x4 S0 = {0.f, 0.f, 0.f, 0.f}, S1 = {0.f, 0.f, 0.f, 0.f};
      SCAN_BAR();
      for (int q = 0; q < NCH; ++q) {
        const LAS float* f = F + (q & 1) * 32 * 384;
        LAS unsigned short* yb = YB + (q & 1) * 1024;
        f32x4 w0 = *(const LAS f32x4*)(f + cA), w1 = *(const LAS f32x4*)(f + cB);
        f32x4 a0 = *(const LAS f32x4*)(f + 64 + cA), a1 = *(const LAS f32x4*)(f + 64 + cB);
        f32x4 b0 = *(const LAS f32x4*)(f + 128 + cA), b1 = *(const LAS f32x4*)(f + 128 + cB);
        f32x4 k0 = *(const LAS f32x4*)(f + 192 + cA), k1 = *(const LAS f32x4*)(f + 192 + cB);
        f32x4 r0 = *(const LAS f32x4*)(f + 256 + cA), r1 = *(const LAS f32x4*)(f + 256 + cB);
        float vv = f[320 + irow];
        float ykeep = 0.f;
#pragma unroll 2
        for (int s = 0; s < 32; ++s) {
          const LAS float* fn = f + (s < 31 ? s + 1 : 31) * 384;
          const f32x4 nw0 = *(const LAS f32x4*)(fn + cA), nw1 = *(const LAS f32x4*)(fn + cB);
          const f32x4 na0 = *(const LAS f32x4*)(fn + 64 + cA), na1 = *(const LAS f32x4*)(fn + 64 + cB);
          const f32x4 nb0 = *(const LAS f32x4*)(fn + 128 + cA), nb1 = *(const LAS f32x4*)(fn + 128 + cB);
          const f32x4 nk0 = *(const LAS f32x4*)(fn + 192 + cA), nk1 = *(const LAS f32x4*)(fn + 192 + cB);
          const f32x4 nr0 = *(const LAS f32x4*)(fn + 256 + cA), nr1 = *(const LAS f32x4*)(fn + 256 + cB);
          const float nvv = fn[320 + irow];
          __builtin_amdgcn_sched_barrier(0);
          f32x4 p = S0 * a0 + S1 * a1;
          const float sa_ = allred8((p.x + p.y) + (p.z + p.w));
          S0 = S0 * w0 + (b0 * sa_ + k0 * vv);
          S1 = S1 * w1 + (b1 * sa_ + k1 * vv);
          p = S0 * r0 + S1 * r1;
          const float y = allred8((p.x + p.y) + (p.z + p.w));
          ykeep = ((s & 7) == (lane & 7)) ? y : ykeep;
          if ((s & 7) == 7) yb[((s & ~7) + (lane & 7)) * 32 + rloc] = f2bf(ykeep);
          __builtin_amdgcn_sched_barrier(0);
          w0 = nw0; w1 = nw1; a0 = na0; a1 = na1; b0 = nb0; b1 = nb1; k0 = nk0; k1 = nk1; r0 = nr0; r1 = nr1; vv = nvv;
        }
        SCAN_BAR();
      }
    } else {
      const int sw = wid - 4, hw = lane >> 5, cp = (lane & 31) * 2;
      const f32x2 kk_c = *(const f32x2*)(P.k_k + hc + cp), ka_c = *(const f32x2*)(P.k_a + hc + cp);
      unsigned voS[4], voL[4];
#pragma unroll
      for (int e = 0; e < 4; ++e) { const int tk = hw * 4 + e, ro = dir ? 7 - tk : tk; voS[e] = (unsigned)(ro * SH_LD + cp) * 2u; voL[e] = (unsigned)(ro * LO_LD + cp) * 2u; }
      unsigned sr[4], sk[4], sv[4], sl[4], sa[4];
#define RMIN(q) ({ const int g0_ = (q) * 32 + sw * 8; const int ra_ = ROWOF(g0_), rb_ = ROWOF(g0_ + 7); ra_ < rb_ ? ra_ : rb_; })
#define SLOADQ(q) do { const size_t rmin_ = (size_t)RMIN(q); const char* bs_ = (const char*)(SH + rmin_ * SH_LD + hc); const char* bl_ = (const char*)(LO + rmin_ * LO_LD + dir * 1024 + hc); \
      _Pragma("unroll") for (int e = 0; e < 4; ++e) { sr[e] = *(const unsigned*)(bs_ + voS[e]); sk[e] = *(const unsigned*)(bs_ + 2048 + voS[e]); sv[e] = *(const unsigned*)(bs_ + 4096 + voS[e]); \
        sl[e] = *(const unsigned*)(bl_ + voL[e]); sa[e] = *(const unsigned*)(bl_ + 4096 + voL[e]); } } while (0)
#define SWRITEQ(buf) do { _Pragma("unroll") for (int e = 0; e < 4; ++e) { LAS float* f_ = F + ((buf) * 32 + sw * 8 + hw * 4 + e) * 384 + cp; \
      const f32x2 r_ = {bflo(sr[e]), bfhi(sr[e])}, k_ = {bflo(sk[e]), bfhi(sk[e])}, v_ = {bflo(sv[e]), bfhi(sv[e])}, lam = {bflo(sl[e]), bfhi(sl[e])}, aa = {bflo(sa[e]), bfhi(sa[e])}; \
      const f32x2 kkr = k_ * kk_c; float ssq = allred16(kkr.x * kkr.x + kkr.y * kkr.y); \
      { auto rr_ = __builtin_amdgcn_permlane16_swap(__float_as_uint(ssq), __float_as_uint(ssq), false, false); ssq = __uint_as_float(rr_[0]) + __uint_as_float(rr_[1]); } \
      const f32x2 kk = kkr * rsqrtf(fmaxf(ssq, 1e-24f)); \
      f32x2 wv; wv.x = __builtin_amdgcn_exp2f(-lam.x); wv.y = __builtin_amdgcn_exp2f(-lam.y); \
      *(LAS f32x2*)(f_) = wv; *(LAS f32x2*)(f_ + 64) = -kk; *(LAS f32x2*)(f_ + 128) = kk * aa; *(LAS f32x2*)(f_ + 192) = k_ * ((aa - 1.f) * ka_c + 1.f); \
      *(LAS f32x2*)(f_ + 256) = r_; *(LAS f32x2*)(f_ + 320) = v_; } } while (0)
      SLOADQ(0); SWRITEQ(0); SLOADQ(1);
      SCAN_BAR();
      for (int q = 0; q < NCH; ++q) {
        if (q >= 9) {
          const int qq = q - 1; const LAS unsigned short* yb = YB + (qq & 1) * 1024;
          const int t256 = sw * 64 + lane, s = t256 >> 3, rp = (t256 & 7) * 4; const int u = qq * 32 + s - CTXL; const int t = dir ? SEQ - 1 - u : u;
          const u32x2 val = *(const LAS u32x2*)(yb + s * 32 + rp);
          *(u32x2*)(Y + (size_t)dir * MT * 1024 + (size_t)(b * SEQ + t) * 1024 + hc + half * 32 + rp) = val;
        }
        if (q + 1 < NCH) SWRITEQ((q + 1) & 1);
        if (q + 2 < NCH) SLOADQ(q + 2);
        SCAN_BAR();
      }
      {
        const int qq = NCH - 1; const LAS unsigned short* yb = YB + (qq & 1) * 1024;
        const int t256 = sw * 64 + lane, s = t256 >> 3, rp = (t256 & 7) * 4; const int u = qq * 32 + s - CTXL; const int t = dir ? SEQ - 1 - u : u;
        const u32x2 val = *(const LAS u32x2*)(yb + s * 32 + rp);
        *(u32x2*)(Y + (size_t)dir * MT * 1024 + (size_t)(b * SEQ + t) * 1024 + hc + half * 32 + rp) = val;
      }
#undef SLOADQ
#undef SWRITEQ
#undef RMIN
    }
#undef ROWOF
    __syncthreads();
  }
#undef SCAN_BAR
}
__device__ __forceinline__ float half_sum(float v) {
  v = allred16(v);
  auto rr = __builtin_amdgcn_permlane16_swap(__float_as_uint(v), __float_as_uint(v), false, false); return __uint_as_float(rr[0]) + __uint_as_float(rr[1]);
}
__device__ __forceinline__ void rwkv_out_phase(const Params& P, const int tid) {
  const bf16_t* SH = (const bf16_t*)(P.ws + OFF_SH); const bf16_t* LO = (const bf16_t*)(P.ws + OFF_LO); bf16_t* Y = (bf16_t*)(P.ws + OFF_Y);
  const int wid = tid >> 6, lane = tid & 63, hw = lane >> 5, cp = (lane & 31) * 2;
  const int gw = P.bid * 8 + wid, NGW = P.grd * 8;
  for (int task = gw * 2; task < MT * 8; task += NGW * 2) {
    unsigned yf[2], ybk[2], rr[2], kk[2], vv[2], af[2], ab[2], gg[2]; int cc[2]; size_t tk[2];
#pragma unroll
    for (int u = 0; u < 2; ++u) { const int t_ = task + u; tk[u] = (size_t)(t_ >> 3); cc[u] = ((t_ & 7) * 2 + hw) * 64 + cp;
      const bf16_t* py = Y + tk[u] * 1024 + cc[u]; const bf16_t* ps = SH + tk[u] * SH_LD + cc[u]; const bf16_t* pl = LO + tk[u] * LO_LD + cc[u];
      yf[u] = *(const unsigned*)py; ybk[u] = *(const unsigned*)(py + (size_t)MT * 1024);
      rr[u] = *(const unsigned*)ps; kk[u] = *(const unsigned*)(ps + 1024); vv[u] = *(const unsigned*)(ps + 2048);
      af[u] = *(const unsigned*)(pl + 2048); ab[u] = *(const unsigned*)(pl + 3072); gg[u] = *(const unsigned*)(pl + 4096); }
    unsigned res[2];
#pragma unroll
    for (int u = 0; u < 2; ++u) {
      const f32x2 lw = *(const f32x2*)(P.ln_x_w + cc[u]), lb = *(const f32x2*)(P.ln_x_b + cc[u]), ka = *(const f32x2*)(P.k_a + cc[u]), rk = *(const f32x2*)(P.r_k + cc[u]);
      const f32x2 y = {bflo(yf[u]) + bflo(ybk[u]), bfhi(yf[u]) + bfhi(ybk[u])};
      const float mu = half_sum(y.x + y.y) * (1.f / 64.f); const f32x2 dv = y - mu; const float var = half_sum(dv.x * dv.x + dv.y * dv.y) * (1.f / 64.f);
      const f32x2 yn = dv * rsqrtf(var + 64e-5f) * lw + lb;
      const f32x2 r = {bflo(rr[u]), bfhi(rr[u])}, k = {bflo(kk[u]), bfhi(kk[u])}, v = {bflo(vv[u]), bfhi(vv[u])};
      const f32x2 a1 = {bflo(af[u]), bfhi(af[u])}, a2 = {bflo(ab[u]), bfhi(ab[u])}, g = {bflo(gg[u]), bfhi(gg[u])};
      const f32x2 kms = k * ((a1 - 1.f) * ka + 1.f) + k * ((a2 - 1.f) * ka + 1.f);
      const f32x2 bt = r * kms * rk;
      const float bonus = half_sum(bt.x + bt.y);
      const f32x2 o = (yn + v * bonus) * g;
      res[u] = cvt_pk_bf16(o.x, o.y);
    }
#pragma unroll
    for (int u = 0; u < 2; ++u) *(unsigned*)(Y + tk[u] * 1024 + cc[u]) = res[u];
  }
}
__device__ __forceinline__ void rope_phase(const Params& P, const int tid) {
  bf16_t* Q = (bf16_t*)(P.ws + OFF_Q); bf16_t* KB = (bf16_t*)(P.ws + OFF_KB);
  const int wid = tid >> 6, lane = tid & 63, hw = lane >> 5, li = lane & 31;
  const int gw = P.bid * 8 + wid, NGW = P.grd * 8;
  const int d1 = li < 16 ? 2 * li : 64 + 2 * (li - 16);
  const f32x2 qgA = *(const f32x2*)(P.q_norm + d1), qgB = *(const f32x2*)(P.q_norm + d1 + 32), kgA = *(const f32x2*)(P.k_norm + d1), kgB = *(const f32x2*)(P.k_norm + d1 + 32);
  const int j0 = 2 * (li & 15);
  const float inv0 = __builtin_amdgcn_exp2f(-(float)(2 * j0) * (13.287712379549449f / 64.f)), inv1 = __builtin_amdgcn_exp2f(-(float)(2 * j0 + 2) * (13.287712379549449f / 64.f));
  for (int task = gw; task < MA; task += NGW) {
    if (task < MT) {
      const int tok = task, b = tok >> 13, t = tok & (SEQ - 1);
      const float pos = (float)(li < 16 ? (t >> 6) : (t & 63));
      const float an0 = pos * inv0, an1 = pos * inv1;
      const f32x2 sn = {__sinf(an0), __sinf(an1)}, cs = {__cosf(an0), __cosf(an1)};
      unsigned lo[10], hi[10]; bf16_t* ptr[10];
#pragma unroll
      for (int i = 0; i < 10; ++i) { const int hd = 2 * i + hw;
        ptr[i] = (hd < 16 ? Q + (size_t)tok * DM + hd * 128 : KB + (size_t)(tok + b * CTXL) * 512 + (hd - 16) * 128) + d1;
        lo[i] = *(const unsigned*)ptr[i]; hi[i] = *(const unsigned*)(ptr[i] + 32); }
#pragma unroll
      for (int i = 0; i < 10; ++i) { const bool isq = i < 8;
        const f32x2 t1 = {bflo(lo[i]), bfhi(lo[i])}, t2 = {bflo(hi[i]), bfhi(hi[i])};
        const float ss = half_sum((t1.x * t1.x + t1.y * t1.y) + (t2.x * t2.x + t2.y * t2.y)); const float rs = rsqrtf(ss * (1.f / 128.f) + 1e-6f);
        const f32x2 n1 = t1 * rs * (isq ? qgA : kgA), n2 = t2 * rs * (isq ? qgB : kgB);
        const f32x2 o1 = n1 * cs - n2 * sn, o2 = n2 * cs + n1 * sn;
        lo[i] = cvt_pk_bf16(o1.x, o1.y); hi[i] = cvt_pk_bf16(o2.x, o2.y); }
#pragma unroll
      for (int i = 0; i < 10; ++i) { *(unsigned*)ptr[i] = lo[i]; *(unsigned*)(ptr[i] + 32) = hi[i]; }
    } else {
      const int ct = task - MT, b = ct >> 8, t = ct & (CTXL - 1);
      unsigned lo[2], hi[2]; bf16_t* ptr[2];
#pragma unroll
      for (int i = 0; i < 2; ++i) { ptr[i] = KB + (size_t)(b * SKV + SEQ + t) * 512 + (2 * i + hw) * 128 + d1; lo[i] = *(const unsigned*)ptr[i]; hi[i] = *(const unsigned*)(ptr[i] + 32); }
#pragma unroll
      for (int i = 0; i < 2; ++i) {
        const f32x2 t1 = {bflo(lo[i]), bfhi(lo[i])}, t2 = {bflo(hi[i]), bfhi(hi[i])};
        const float ss = half_sum((t1.x * t1.x + t1.y * t1.y) + (t2.x * t2.x + t2.y * t2.y)); const float rs = rsqrtf(ss * (1.f / 128.f) + 1e-6f);
        const f32x2 n1 = t1 * rs * kgA, n2 = t2 * rs * kgB;
        *(unsigned*)ptr[i] = cvt_pk_bf16(n1.x, n1.y); *(unsigned*)(ptr[i] + 32) = cvt_pk_bf16(n2.x, n2.y); }
    }
  }
}
__device__ __forceinline__ void attn_phase(const Params& P, unsigned char* smem, const int tid) {
  bf16_t* Q = (bf16_t*)(P.ws + OFF_Q); const bf16_t* KB = (const bf16_t*)(P.ws + OFF_KB); const bf16_t* VB = (const bf16_t*)(P.ws + OFF_VB);
  for (int u = P.bid; u < 2048; u += P.grd) {
    const int xcd = u & 7, slot = (u >> 3) & 31, rnd = u >> 8, pair = xcd + 8 * (rnd >> 2), w = (rnd & 3) * 32 + slot;
    const int b = pair >> 2, kvh = pair & 3, g = w & 3, qb = w >> 2, head = kvh * 4 + g;
    bf16_t* Qb = Q + (size_t)(b * SEQ + qb * 256) * DM + head * 128;
    const bf16_t* Kh = KB + (size_t)b * SKV * 512 + kvh * 128; const bf16_t* Vh = VB + (size_t)b * SKV * 512 + kvh * 128;
    att::attn_dense_body(Qb, Kh, Vh, Qb, SKV, (char*)smem, tid);
    __syncthreads();
  }
}
__device__ __forceinline__ void final_norm_phase(const Params& P, const int tid) {
  const int wid = tid >> 6, lane = tid & 63;
  const int gw = P.bid * 8 + wid, NGW = P.grd * 8;
  f32x4 g4[8];
#pragma unroll
  for (int j = 0; j < 8; ++j) g4[j] = *(const f32x4*)(P.norm_final + j * 256 + lane * 4);
  for (int r = gw; r < MT; r += NGW) {
    float* xr = P.out + (size_t)r * DM;
    f32x4 v[8]; float ss = 0.f;
#pragma unroll
    for (int j = 0; j < 8; ++j) v[j] = *(const f32x4*)(xr + j * 256 + lane * 4);
#pragma unroll
    for (int j = 0; j < 8; ++j) ss += v[j].x * v[j].x + v[j].y * v[j].y + v[j].z * v[j].z + v[j].w * v[j].w;
    ss = wave_sum(ss);
    const float rs = rsqrtf(ss * (1.f / DM) + 1e-6f);
#pragma unroll
    for (int j = 0; j < 8; ++j) *(f32x4*)(xr + j * 256 + lane * 4) = v[j] * rs * g4[j];
  }
}


#define XB_TMO      128
#define XB_XCNT(j)  (256  + 64 * (j))
#define XB_XSUB(j)  (1280 + 64 * (j))
#define XB_XGEN(j)  (2304 + 64 * (j))
#define XB_TOP      3328
#define XB_TOPGEN   3392
#define XCD_BAR_WORDS 3456
#define XB_SPIN_CAP (1u << 18)
__device__ __forceinline__ unsigned xb_ld(unsigned* p)              { return __hip_atomic_load(p, __ATOMIC_RELAXED, __HIP_MEMORY_SCOPE_AGENT); }
__device__ __forceinline__ unsigned xb_add(unsigned* p, unsigned v) { return __hip_atomic_fetch_add(p, v, __ATOMIC_RELAXED, __HIP_MEMORY_SCOPE_AGENT); }
__device__ __forceinline__ unsigned xb_xcc_id() { return (unsigned)__builtin_amdgcn_s_getreg((3 << 11) | 20) & 0xFu; }
#define XB_SPIN(cond, bar) do { unsigned _sp = 0; while (cond) { __builtin_amdgcn_s_sleep(1); \
    if ((++_sp & 255u) == 0u) { if (xb_ld(&(bar)[XB_TMO])) break; if (_sp > XB_SPIN_CAP) { atomicAdd(&(bar)[XB_TMO], 1u); break; } } } } while (0)
__device__ __forceinline__ void xcd_barrier_complete(unsigned* bar, unsigned x, unsigned& nloc, unsigned& nx) {
    const unsigned G = gridDim.x * gridDim.y * gridDim.z;
    unsigned sum, cnt, mine, sp = 0u;
    for (;;) {
        sum = 0u; cnt = 0u; mine = 0u;
#pragma unroll
        for (unsigned j = 0; j < 16; ++j) { const unsigned c = xb_ld(&bar[XB_XCNT(j)]); sum += c; cnt += (c > 0u) ? 1u : 0u; mine = (j == x) ? c : mine; }
        if (sum == G) break;
        __builtin_amdgcn_s_sleep(1);
        if ((++sp & 255u) == 0u) { if (xb_ld(&bar[XB_TMO])) break; if (sp > XB_SPIN_CAP) { atomicAdd(&bar[XB_TMO], 1u); break; } }
    }
    nloc = mine > 0u ? mine : 1u; nx = cnt > 0u ? cnt : 1u;
}
__device__ __forceinline__ void xcd_barrier(unsigned* bar, volatile LAS unsigned* st) {
    asm volatile("s_waitcnt vmcnt(0)" ::: "memory");
    __syncthreads();
    if (threadIdx.x == 0) {
        __builtin_amdgcn_s_waitcnt(0);
        const unsigned x = xb_xcc_id();
        unsigned nloc = st[0], nx = st[1];
        if (nloc == 0u) { xcd_barrier_complete(bar, x, nloc, nx); st[0] = nloc; st[1] = nx; }
        const unsigned old = xb_add(&bar[XB_XSUB(x)], 1u);
        const unsigned gen = old / nloc;
        if (old + 1u == (gen + 1u) * nloc) {
            __builtin_amdgcn_fence(__ATOMIC_RELEASE, "agent");
            asm volatile("s_waitcnt vmcnt(0)" ::: "memory");
            const unsigned og = xb_add(&bar[XB_TOP], 1u);
            const unsigned tg = og / nx;
            if (og + 1u == (tg + 1u) * nx) xb_add(&bar[XB_TOPGEN], 1u);
            else XB_SPIN(xb_ld(&bar[XB_TOPGEN]) == tg, bar);
            __builtin_amdgcn_fence(__ATOMIC_ACQUIRE, "agent");
            xb_add(&bar[XB_XGEN(x)], 1u);
            asm volatile("s_waitcnt vmcnt(0)" ::: "memory");
        } else {
            XB_SPIN(xb_ld(&bar[XB_XGEN(x)]) == gen, bar);
            __builtin_amdgcn_fence(__ATOMIC_ACQUIRE, "agent");
            asm volatile("s_waitcnt vmcnt(0)" ::: "memory");
        }
    }
    __syncthreads();
}

constexpr int NPH = 20;
__device__ __forceinline__ bool gemm_desc(int ph, const Params& P, GemmDesc& d) {
  unsigned char* ws = P.ws;
  const bf16_t* H = (const bf16_t*)(ws + OFF_H);
  d.nt0 = 0; d.nt1 = 0; d.ksplit1 = 1; d.G = P.grd; d.c = P.bid; d.A1 = nullptr; d.B1 = nullptr; d.pm01 = 0; d.nN1 = 1; d.n1 = 0; d.pm00 = 0; d.xin = nullptr; d.gidx = 0; d.gscale = 0.f; d.act = nullptr;
  switch (ph) {
  case 2: d.K = 2048; d.mode = M_SWIGLU; d.A0 = H; d.B0 = (const bf16_t*)(ws + OFF_W1A); d.nM0 = 132; d.nN0 = 44; d.act = (bf16_t*)(ws + OFF_ACT); break;
  case 3: d.K = DFF; d.mode = M_RESID; d.A0 = (const bf16_t*)(ws + OFF_ACT); d.B0 = (const bf16_t*)(ws + OFF_W1B); d.nM0 = 128; d.nN0 = 8; d.xin = P.x; d.gidx = 2; d.gscale = 0.5f;
          d.A1 = d.A0; d.B1 = d.B0; d.pm01 = 128; d.nN1 = 8; d.ksplit1 = 4; d.nt1 = 22; d.n1 = 4 * 8 * 4; break;
  case 5: d.K = 2048; d.mode = M_RW; d.A0 = H; d.B0 = (const bf16_t*)(ws + OFF_WRW); d.nM0 = 132; d.nN0 = 14;
          d.A1 = H; d.B1 = (const bf16_t*)(ws + OFF_WQKVG) + (size_t)2048 * 2048; d.pm01 = 128; d.nN1 = 4; d.n1 = 16; break;
  case 7: d.K = 384; d.mode = M_LORA; d.A0 = (const bf16_t*)(ws + OFF_LIN); d.B0 = (const bf16_t*)(ws + OFF_WLORA); d.nM0 = 132; d.nN0 = 20; break;
  case 10: d.K = 2048; d.mode = M_QKVG; d.A0 = H; d.B0 = (const bf16_t*)(ws + OFF_WQKVG); d.nM0 = 128; d.nN0 = 28; break;
  case 13: d.K = 2048; d.mode = M_T1; d.A0 = (const bf16_t*)(ws + OFF_Q); d.B0 = (const bf16_t*)(ws + OFF_WOA); d.nM0 = 128; d.nN0 = 8; break;
  case 14: d.K = 1024; d.mode = M_M; d.A0 = (const bf16_t*)(ws + OFF_Y); d.B0 = (const bf16_t*)(ws + OFF_WOR); d.nM0 = 128; d.nN0 = 8; break;
  case 15: d.K = 2048; d.mode = M_RESID; d.A0 = (const bf16_t*)(ws + OFF_GR); d.B0 = (const bf16_t*)(ws + OFF_WOUT); d.nM0 = 128; d.nN0 = 8; d.xin = P.out; d.gidx = 5; d.gscale = 1.f; break;
  case 17: d.K = 2048; d.mode = M_SWIGLU; d.A0 = H; d.B0 = (const bf16_t*)(ws + OFF_W2A); d.nM0 = 128; d.nN0 = 44; d.act = (bf16_t*)(ws + OFF_ACT); break;
  case 18: d.K = DFF; d.mode = M_RESID; d.A0 = (const bf16_t*)(ws + OFF_ACT); d.B0 = (const bf16_t*)(ws + OFF_W2B); d.nM0 = 128; d.nN0 = 8; d.xin = P.out; d.gidx = 8; d.gscale = 0.5f; break;
  default: return false;
  }
  d.n0 = d.nM0 * d.nN0;
  if (!d.nt0) d.nt0 = d.K / BK;
  if (!d.nt1) d.nt1 = d.K / BK;
  if (d.mode == M_LORA) d.nt0 = 2;
  return true;
}

__global__ void __launch_bounds__(512) mega_fwd(Params P) {
  extern __shared__ __attribute__((aligned(16))) unsigned char smem[];
  LAS unsigned char* lds = (LAS unsigned char*)smem;
  cg::grid_group grid = cg::this_grid();
  volatile LAS unsigned* bst = (volatile LAS unsigned*)(lds + LDS_BYTES + 192);
  unsigned* gbar = (unsigned*)(P.ws + OFF_BAR);
#if ONE_LAUNCH
  if (threadIdx.x == 0) { bst[0] = 0u; bst[1] = 0u; (void)xb_add(&gbar[XB_XCNT(xb_xcc_id())], 1u); }
  __syncthreads();
#endif
#pragma nounroll
  for (int ph = P.ph_lo; ph < P.ph_hi; ++ph) {
    GemmDesc d;
    int tid = threadIdx.x; asm volatile("" : "+v"(tid));
#if PROBE
    if (blockIdx.x == 0 && tid == 0) ((LAS unsigned long long*)(lds + LDS_BYTES))[ph] = __builtin_amdgcn_s_memrealtime();
#endif
    const __attribute__((address_space(4))) Params* kp = (const __attribute__((address_space(4))) Params*)__builtin_amdgcn_kernarg_segment_ptr();
    asm volatile("" : "+s"(kp));
#if defined(__HIP_DEVICE_COMPILE__)
    Params L = *kp;
#else
    Params L = P;
#endif
    { int b_ = blockIdx.x, g_ = gridDim.x; asm volatile("" : "+s"(b_), "+s"(g_)); L.bid = b_; L.grd = g_; }
    if (gemm_desc(ph, L, d)) gemm_phase(lds, d, L, tid);
    else switch (ph) {
      case 0: mod_phase(L, lds, tid); __syncthreads(); convert_phase(L, lds, tid); break;
      case 1: norm_mod_phase(L, L.x, L.ctx, MA, L.norm_ffn1, 0, nullptr, tid); break;
      case 4: norm_mod_phase(L, L.out, L.ctx, MA, L.norm_mix, 3, (const float*)(L.ws + OFF_PART), tid); break;
      case 6: shift_phase(L, tid); break;
      case 8: scan_phase(L, lds, tid); break;
      case 9: rwkv_out_phase(L, tid); break;
      case 11: rope_phase(L, tid); break;
      case 12: attn_phase(L, smem, tid); break;
      case 16: norm_mod_phase(L, L.out, nullptr, MT, L.norm_ffn2, 6, nullptr, tid); break;
      case 19: final_norm_phase(L, tid); break;
      default: break;
    }
    if (ph + 1 < P.ph_hi) { if (ph == 0) grid.sync(); else if (ph != 13 || !ONE_LAUNCH) xcd_barrier(gbar, bst); }
  }
#if PROBE
  grid.sync();
  if (blockIdx.x == 0) {
    LAS unsigned long long* TS = (LAS unsigned long long*)(lds + LDS_BYTES);
    if (threadIdx.x == 0) TS[NPH] = __builtin_amdgcn_s_memrealtime();
    __syncthreads();
    const int K = (int)((TS[PROBE_HI] - TS[PROBE_LO]) / 100ull);
    int t2 = threadIdx.x; asm volatile("" : "+v"(t2));
    for (int i = t2; i < K && i < 16000; i += 512) P.out[(size_t)i * 4099] += 0.1f;
  }
#endif
}

extern "C" void kernel_launch(void* const* d_in, const int* in_sizes, int n_in, void* d_out, int out_size, void* d_ws, size_t ws_size, hipStream_t stream) {
  static int grid_blocks = 0;
  if (!grid_blocks) {
    if (n_in != 31 || out_size != MT * DM || ws_size < WS_TOTAL) { fprintf(stderr, "kernel_launch: unexpected shapes n_in %d out %d ws %zu (need %zu)\n", n_in, out_size, ws_size, WS_TOTAL); return; }
    if (hipFuncSetAttribute((const void*)mega_fwd, hipFuncAttributeMaxDynamicSharedMemorySize, LDS_BYTES + 256) != hipSuccess) { fprintf(stderr, "kernel_launch: hipFuncSetAttribute failed\n"); return; }
    int dev = 0, cus = 0, per_cu = 0;
    hipGetDevice(&dev);
    hipDeviceGetAttribute(&cus, hipDeviceAttributeMultiprocessorCount, dev);
    hipOccupancyMaxActiveBlocksPerMultiprocessor(&per_cu, mega_fwd, 512, LDS_BYTES + 256);
    if (per_cu < 1) { fprintf(stderr, "kernel_launch: occupancy query returned %d\n", per_cu); per_cu = 1; }
    grid_blocks = cus;
  }
  Params p{};
  const float** pf = (const float**)&p;
  for (int i = 0; i < 31; ++i) pf[i] = (const float*)d_in[i];
  p.out = (float*)d_out; p.ws = (unsigned char*)d_ws; p.bid = 0; p.grd = 0;
#if ONE_LAUNCH
  p.ph_lo = 0; p.ph_hi = NPH;
  if (hipMemsetAsync((char*)d_ws + OFF_BAR, 0, 3456 * 4, stream) != hipSuccess) { fprintf(stderr, "kernel_launch: memset of barrier words failed\n"); return; }
  void* args[] = {&p};
  hipError_t e = hipLaunchCooperativeKernel((const void*)mega_fwd, dim3(grid_blocks), dim3(512), args, LDS_BYTES + 256, stream);
  if (e != hipSuccess) fprintf(stderr, "cooperative launch failed: %s (grid %d)\n", hipGetErrorString(e), grid_blocks);
#else
  for (int ph = 0; ph < NPH; ++ph) { p.ph_lo = ph; p.ph_hi = ph + 1; hipLaunchKernelGGL(mega_fwd, dim3(grid_blocks), dim3(512), LDS_BYTES + 256, stream, p); }
#endif
}
```

```cpp
#include <hip/hip_runtime.h>
#include <hip/hip_cooperative_groups.h>
#include <cstdio>
#include <cstdint>
namespace cg = cooperative_groups;

#ifndef ONE_LAUNCH
#define ONE_LAUNCH 1
#endif

#ifndef PROBE
#define PROBE 0
#endif
#define PROBE_LO 8
#define PROBE_HI 9
#define LAS __attribute__((address_space(3)))
typedef unsigned short bf16_t;
typedef short bf16x8 __attribute__((ext_vector_type(8)));
typedef short s16x4 __attribute__((ext_vector_type(4)));
typedef float f32x4 __attribute__((ext_vector_type(4)));
typedef float f32x2 __attribute__((ext_vector_type(2)));
typedef float f32x16 __attribute__((ext_vector_type(16)));
typedef unsigned u32x4 __attribute__((ext_vector_type(4)));
typedef unsigned u32x2 __attribute__((ext_vector_type(2)));

constexpr int DM = 2048, NB = 4, SEQ = 8192, CTXL = 256, MT = NB * SEQ, MC = NB * CTXL, MA = MT + MC;
constexpr int DFF = 5632, SKV = SEQ + CTXL, NMODC = 9 * DM;
constexpr int PRW_LD = 3584, SH_LD = 3072, LIN_LD = 384, LO_LD = 5120;
constexpr int LDS_BYTES = 131072;

constexpr size_t SZ_WA = (size_t)11264 * 2048 * 2, SZ_WB = (size_t)2048 * 5632 * 2;
constexpr size_t OFF_W1A = 0, OFF_W1B = OFF_W1A + SZ_WA, OFF_W2A = OFF_W1B + SZ_WB, OFF_W2B = OFF_W2A + SZ_WA;
constexpr size_t OFF_WRW = OFF_W2B + SZ_WB, OFF_WQKVG = OFF_WRW + (size_t)3584 * 2048 * 2, OFF_WOA = OFF_WQKVG + (size_t)7168 * 2048 * 2;
constexpr size_t OFF_WOR = OFF_WOA + (size_t)2048 * 2048 * 2, OFF_WOUT = OFF_WOR + (size_t)2048 * 1024 * 2, OFF_WLORA = OFF_WOUT + (size_t)2048 * 2048 * 2;
constexpr size_t OFF_MOD = OFF_WLORA + (size_t)5120 * 384 * 2, OFF_CX = OFF_MOD + (size_t)5 * NMODC * 4, OFF_H = OFF_CX + (size_t)MC * DM * 4;
constexpr size_t OFF_BIG = OFF_H + (size_t)MA * DM * 2;
constexpr size_t SZ_KV = (size_t)NB * SKV * 512 * 2;
constexpr size_t OFF_KB = OFF_W1A, OFF_VB = OFF_KB + SZ_KV;
static_assert(OFF_VB + SZ_KV <= OFF_W2A, "KV overlay");
constexpr size_t OFF_ACT = OFF_BIG;
constexpr size_t OFF_PART = OFF_ACT + (size_t)MA * DFF * 2;
constexpr size_t OFF_PRW = OFF_BIG, OFF_LO = OFF_BIG, OFF_SH = OFF_LO + (size_t)MA * LO_LD * 2, OFF_LIN = OFF_SH + (size_t)MA * SH_LD * 2, OFF_Y = OFF_LIN;
constexpr size_t OFF_Q = OFF_BIG, OFF_GA = OFF_Q + (size_t)MT * DM * 2, OFF_GR = OFF_GA + (size_t)MT * DM * 2;
constexpr size_t END_A = OFF_ACT + (size_t)MA * DFF * 2, END_B = OFF_Y + (size_t)2 * MT * 1024 * 2, END_C = OFF_LIN + (size_t)MA * LIN_LD * 2;
constexpr size_t WS_END = END_A > END_B ? (END_A > END_C ? END_A : END_C) : (END_B > END_C ? END_B : END_C);
constexpr size_t OFF_BAR = (WS_END + 255) / 256 * 256, WS_TOTAL = OFF_BAR + 3456 * 4;
static_assert((size_t)MA * PRW_LD * 2 <= (size_t)MA * LO_LD * 2, "PRW under LO");
static_assert(OFF_GR + (size_t)MT * DM * 2 <= OFF_Y, "GR below RWO");

struct Params {
  const float *x, *c, *ctx, *c_ctx, *w_mod, *b_mod, *norm_ffn1, *ffn1_w_in, *ffn1_w_out, *norm_mix, *w_in, *q_norm, *k_norm, *rwkv_mu, *w0, *w2, *a0, *a2,
      *g2, *k_k, *k_a, *r_k, *ln_x_w, *ln_x_b, *w_oa, *w_or, *w_out, *norm_ffn2, *ffn2_w_in, *ffn2_w_out, *norm_final;
  float* out; unsigned char* ws; int ph_lo, ph_hi; int bid, grd;
};

__device__ __forceinline__ unsigned cvt_pk_bf16(float lo, float hi) { unsigned r; asm("v_cvt_pk_bf16_f32 %0, %1, %2" : "=v"(r) : "v"(lo), "v"(hi)); return r; }
__device__ __forceinline__ float bf2f(unsigned short b) { return __uint_as_float(((unsigned)b) << 16); }
__device__ __forceinline__ float bflo(unsigned w) { return __uint_as_float(w << 16); }
__device__ __forceinline__ float bfhi(unsigned w) { return __uint_as_float(w & 0xffff0000u); }
__device__ __forceinline__ unsigned short f2bf(float f) { return (unsigned short)(cvt_pk_bf16(f, 0.f) & 0xffffu); }
__device__ __forceinline__ float sigmoidf_(float x) { return __builtin_amdgcn_rcpf(1.f + __builtin_amdgcn_exp2f(-1.4426950408889634f * x)); }
template <int CTRL> __device__ __forceinline__ float dpp_mov(float x) { return __int_as_float(__builtin_amdgcn_update_dpp(0, __float_as_int(x), CTRL, 0xF, 0xF, true)); }
__device__ __forceinline__ float allred16(float x) {
  x += dpp_mov<0xB1>(x); x += dpp_mov<0x4E>(x); x += dpp_mov<0x141>(x); x += dpp_mov<0x140>(x); return x;
}

__device__ __forceinline__ float wave_sum(float v) {
  v = allred16(v);
  { auto rr = __builtin_amdgcn_permlane16_swap(__float_as_uint(v), __float_as_uint(v), false, false); v = __uint_as_float(rr[0]) + __uint_as_float(rr[1]); }
  { auto rr = __builtin_amdgcn_permlane32_swap(__float_as_uint(v), __float_as_uint(v), false, false); v = __uint_as_float(rr[0]) + __uint_as_float(rr[1]); }
  return v;
}

constexpr int BM = 256, BK = 64, HALF = 128, HTB = HALF * BK * 2;
__device__ __forceinline__ int lds_byte(int r, int c) { const int st = (r >> 4) * 2 + (c >> 5), rr = r & 15, cc = c & 31, ob = rr * 64 + cc * 2; return st * 1024 + (ob ^ (((ob >> 9) & 1) << 5)); }
__device__ __forceinline__ void stage_rc(int b, int& R, int& C) { const int st = b / 1024, sb = b % 1024, swz = sb ^ (((sb >> 9) & 1) << 5); R = (st >> 1) * 16 + swz / 64; C = (st & 1) * 32 + (swz % 64) / 2; }
__device__ __forceinline__ int perm32(int rho) { const int n = rho >> 4, i = rho & 15; return 8 * (i >> 2) + 4 * n + (i & 3); }

enum { M_SWIGLU = 0, M_RESID = 1, M_RW = 2, M_QKVG = 3, M_LORA = 4, M_T1 = 5, M_M = 6 };
struct Unit { const char* A; const char* B; int pm, pn, seg, nt; };
struct GemmDesc {
  int K, mode, G, c;
  const bf16_t *A0, *B0; int pm00, nM0, nN0, n0;
  const bf16_t *A1, *B1; int pm01, nN1, n1;
  int nt0, nt1, ksplit1;
  const float* xin; int gidx; float gscale;
  bf16_t* act;
};
__device__ __forceinline__ bool sched_next(const GemmDesc& d, int i, Unit& u) {
  long L = (long)i * d.G + d.c;
  if (L < d.n0) {
    int wgid = (int)L; const int nwg = d.n0;
    { const int q = nwg / 8, r = nwg % 8, xcd = wgid % 8, off = wgid / 8; wgid = (xcd < r ? xcd * (q + 1) : r * (q + 1) + (xcd - r) * q) + off; }
    const int nig = 8 * d.nN0, gid = wgid / nig, fm = gid * 8, gsz = (d.nM0 - fm) < 8 ? (d.nM0 - fm) : 8;
    const int pm = fm + ((wgid % nig) % gsz), pn = (wgid % nig) / gsz;
    u.pm = d.pm00 + pm; u.pn = pn; u.seg = 0; u.nt = d.nt0;
    u.A = (const char*)d.A0 + (size_t)u.pm * 512 * d.K; u.B = (const char*)d.B0 + (size_t)pn * 512 * d.K;
    if (d.mode == M_LORA) { const int ko = (pn < 8 ? 0 : (pn < 16 ? 128 : 256)) * 2; u.A += ko; u.B += ko; }
    return true;
  }
  L -= d.n0;
  if (L < d.n1) {
    const int sp = (int)L % d.ksplit1, l2 = (int)L / d.ksplit1;
    const int pm = l2 / d.nN1, pn = l2 % d.nN1; u.pm = d.pm01 + pm; u.pn = pn; u.seg = 1 + sp; u.nt = d.nt1;
    const size_t ko = (size_t)sp * d.nt1 * 128;
    u.A = (const char*)d.A1 + (size_t)u.pm * 512 * d.K + ko; u.B = (const char*)d.B1 + (size_t)pn * 512 * d.K + ko; return true;
  }
  return false;
}

__device__ __forceinline__ void gemm_epilogue(const f32x4 (&acc)[2][2][4][2], const Unit& u, const GemmDesc& d, const Params& P, int wr, int wc, int fr, int fq) {
  unsigned char* ws = P.ws;
  asm volatile("" : "+v"(fr), "+v"(fq));
  const int rl0 = wr * 64 + fr, cl0 = wc * 32 + 8 * fq;
  switch (d.mode) {
  case M_SWIGLU: {
    bf16_t* base = d.act + (size_t)u.pm * 256 * DFF + u.pn * 128 + cl0;
#pragma unroll
    for (int ai = 0; ai < 2; ++ai)
#pragma unroll
      for (int m = 0; m < 4; ++m) {
        const int row = rl0 + 128 * ai + 16 * m;
        float o[8];
#pragma unroll
        for (int n = 0; n < 2; ++n)
#pragma unroll
          for (int j = 0; j < 4; ++j) { const float g = acc[ai][0][m][n][j], up = acc[ai][1][m][n][j]; o[4 * n + j] = g * sigmoidf_(g) * up; }
        u32x4 w; w.x = cvt_pk_bf16(o[0], o[1]); w.y = cvt_pk_bf16(o[2], o[3]); w.z = cvt_pk_bf16(o[4], o[5]); w.w = cvt_pk_bf16(o[6], o[7]);
        *(u32x4*)(base + (size_t)row * DFF) = w;
      }
  } break;
  case M_RESID: {
    if (u.seg >= 1) {
      float* po = (float*)(ws + OFF_PART) + (size_t)(u.seg - 1) * MC * DM + (size_t)(u.pm - 128) * 256 * DM + u.pn * 256 + cl0;
#pragma unroll
      for (int ai = 0; ai < 2; ++ai)
#pragma unroll
        for (int m = 0; m < 4; ++m)
#pragma unroll
          for (int bj = 0; bj < 2; ++bj)
#pragma unroll
            for (int n = 0; n < 2; ++n) *(f32x4*)(po + (size_t)(rl0 + 128 * ai + 16 * m) * DM + 128 * bj + 4 * n) = acc[ai][bj][m][n];
      break;
    }
    const bool isc = u.pm >= 128; const int b = isc ? 4 : (u.pm >> 5);
    const float* xin = isc ? P.ctx + (size_t)(u.pm - 128) * 256 * DM : d.xin + (size_t)u.pm * 256 * DM;
    float* xo = isc ? (float*)(ws + OFF_CX) + (size_t)(u.pm - 128) * 256 * DM : P.out + (size_t)u.pm * 256 * DM;
    const float* gate = (const float*)(ws + OFF_MOD) + b * NMODC + d.gidx * DM + u.pn * 256 + cl0;
    f32x4 g4[2][2];
#pragma unroll
    for (int bj = 0; bj < 2; ++bj)
#pragma unroll
      for (int n = 0; n < 2; ++n) g4[bj][n] = *(const f32x4*)(gate + 128 * bj + 4 * n) * d.gscale;
#pragma unroll
    for (int ai = 0; ai < 2; ++ai)
#pragma unroll
      for (int m = 0; m < 4; ++m) {
        const size_t ro = (size_t)(rl0 + 128 * ai + 16 * m) * DM + u.pn * 256 + cl0;
#pragma unroll
        for (int bj = 0; bj < 2; ++bj)
#pragma unroll
          for (int n = 0; n < 2; ++n) {
            const f32x4 xv = *(const f32x4*)(xin + ro + 128 * bj + 4 * n);
            *(f32x4*)(xo + ro + 128 * bj + 4 * n) = xv + g4[bj][n] * acc[ai][bj][m][n];
          }
      }
  } break;
  case M_RW: case M_QKVG: case M_LORA: {
    bf16_t* base; int ld; int act = 0; const float* bias = nullptr;
    if (d.mode == M_RW) {
      if (u.seg == 0) { base = (bf16_t*)(ws + OFF_PRW) + (size_t)u.pm * 256 * PRW_LD + u.pn * 256; ld = PRW_LD; }
      else { const int b = u.pm - 128; base = (bf16_t*)(ws + (u.pn < 2 ? OFF_KB : OFF_VB)) + (size_t)(b * SKV + SEQ) * 512 + (u.pn & 1) * 256; ld = 512; }
    } else if (d.mode == M_QKVG) {
      const int b = u.pm >> 5;
      if (u.pn < 8) { base = (bf16_t*)(ws + OFF_Q) + (size_t)u.pm * 256 * DM + u.pn * 256; ld = DM; }
      else if (u.pn < 12) { base = (bf16_t*)(ws + (u.pn < 10 ? OFF_KB : OFF_VB)) + (size_t)(u.pm * 256 + b * CTXL) * 512 + (u.pn & 1) * 256; ld = 512; }
      else { base = (bf16_t*)(ws + (u.pn < 20 ? OFF_GA : OFF_GR)) + (size_t)u.pm * 256 * DM + ((u.pn - 12) & 7) * 256; ld = DM; act = 1; }
    } else {
      base = (bf16_t*)(ws + OFF_LO) + (size_t)u.pm * 256 * LO_LD + u.pn * 256; ld = LO_LD;
      if (u.pn < 8) { act = 2; bias = P.w0 + u.pn * 256; } else if (u.pn < 16) { act = 1; bias = P.a0 + (u.pn - 8) * 256; }
    }
#pragma unroll
    for (int bj = 0; bj < 2; ++bj) {
      f32x4 b0 = {0.f, 0.f, 0.f, 0.f}, b1 = {0.f, 0.f, 0.f, 0.f};
      if (bias) { b0 = *(const f32x4*)(bias + 128 * bj + cl0); b1 = *(const f32x4*)(bias + 128 * bj + cl0 + 4); }
#pragma unroll
      for (int ai = 0; ai < 2; ++ai)
#pragma unroll
        for (int m = 0; m < 4; ++m) {
          const int row = rl0 + 128 * ai + 16 * m;
          f32x4 v0 = acc[ai][bj][m][0] + b0, v1 = acc[ai][bj][m][1] + b1;
          if (act) {
            const float sc = act == 2 ? 0.60653065971263342f * 1.4426950408889634f : 1.f;
#pragma unroll
            for (int j = 0; j < 4; ++j) { v0[j] = sc * sigmoidf_(v0[j]); v1[j] = sc * sigmoidf_(v1[j]); }
          }
          u32x4 w; w.x = cvt_pk_bf16(v0[0], v0[1]); w.y = cvt_pk_bf16(v0[2], v0[3]); w.z = cvt_pk_bf16(v1[0], v1[1]); w.w = cvt_pk_bf16(v1[2], v1[3]);
          *(u32x4*)(base + (size_t)row * ld + 128 * bj + cl0) = w;
        }
    }
  } break;
  case M_T1: case M_M: {
    bf16_t* ga = (bf16_t*)(ws + OFF_GA) + (size_t)u.pm * 256 * DM + u.pn * 256 + cl0;
    bf16_t* gr = (bf16_t*)(ws + OFF_GR) + (size_t)u.pm * 256 * DM + u.pn * 256 + cl0;
    const bool isM = d.mode == M_M;
#pragma unroll
    for (int ai = 0; ai < 2; ++ai)
#pragma unroll
      for (int m = 0; m < 4; ++m)
#pragma unroll
        for (int bj = 0; bj < 2; ++bj) {
          const size_t o = (size_t)(rl0 + 128 * ai + 16 * m) * DM + 128 * bj;
          const f32x4 v0 = acc[ai][bj][m][0], v1 = acc[ai][bj][m][1];
          const u32x4 a = *(const u32x4*)(ga + o);
          u32x4 w;
          if (!isM) {
            w.x = cvt_pk_bf16(bflo(a.x) * v0[0], bfhi(a.x) * v0[1]); w.y = cvt_pk_bf16(bflo(a.y) * v0[2], bfhi(a.y) * v0[3]);
            w.z = cvt_pk_bf16(bflo(a.z) * v1[0], bfhi(a.z) * v1[1]); w.w = cvt_pk_bf16(bflo(a.w) * v1[2], bfhi(a.w) * v1[3]);
            *(u32x4*)(ga + o) = w;
          } else {
            const u32x4 g = *(const u32x4*)(gr + o);
            w.x = cvt_pk_bf16(bflo(a.x) + bflo(g.x) * v0[0], bfhi(a.x) + bfhi(g.x) * v0[1]); w.y = cvt_pk_bf16(bflo(a.y) + bflo(g.y) * v0[2], bfhi(a.y) + bfhi(g.y) * v0[3]);
            w.z = cvt_pk_bf16(bflo(a.z) + bflo(g.z) * v1[0], bfhi(a.z) + bfhi(g.z) * v1[1]); w.w = cvt_pk_bf16(bflo(a.w) + bflo(g.w) * v1[2], bfhi(a.w) + bfhi(g.w) * v1[3]);
            *(u32x4*)(gr + o) = w;
          }
        }
  } break;
  }
}

__device__ __forceinline__ void gemm_phase(LAS unsigned char* lds, const GemmDesc& d, const Params& P, const int tid) {
  const int wid = __builtin_amdgcn_readfirstlane(tid >> 6), lane = tid & 63, wr = wid >> 2, wc = wid & 3, fr = lane & 15, fq = lane >> 4;
  const int K = d.K;
  unsigned voffA[2], voffB[2];
#pragma unroll
  for (int i = 0; i < 2; ++i) { int R, C; stage_rc(tid * 16 + i * 8192, R, C); const int Rb = (R & ~31) + perm32(R & 31);
    voffA[i] = (unsigned)(R * K + C) * 2u; voffB[i] = (unsigned)(Rb * K + C) * 2u; }
  const size_t kstep = (size_t)(BK * 2);
  const size_t hstep = (size_t)HALF * K * 2;
  const unsigned ldsw = (unsigned)wid * 1024u;
  const int aoff = lds_byte(wr * 64 + fr, fq * 8), boff = lds_byte(wc * 32 + fr, fq * 8);
#define PG8_SA(b, h) (((b) * 2 + (h)) * HTB)
#define PG8_SB(b, h) ((4 + (b) * 2 + (h)) * HTB)
#define PG8_STAGE(bufoff, gbase, voff) do { _Pragma("unroll") for (int _i = 0; _i < 2; ++_i) \
    __builtin_amdgcn_global_load_lds((const unsigned*)((const char*)(gbase) + (voff)[_i]), (LAS unsigned*)(lds + (bufoff) + ldsw + _i * 8192), 16, 0, 0); } while (0)
#define PG8_LDA(dst, b, h) do { _Pragma("unroll") for (int m = 0; m < 4; ++m) _Pragma("unroll") for (int k = 0; k < 2; ++k) dst[m][k] = *(const LAS bf16x8*)(lds + PG8_SA(b, h) + aoff + m * 2048 + k * 1024); } while (0)
#define PG8_LDB(dst, b, h) do { _Pragma("unroll") for (int n = 0; n < 2; ++n) _Pragma("unroll") for (int k = 0; k < 2; ++k) dst[n][k] = *(const LAS bf16x8*)(lds + PG8_SB(b, h) + boff + n * 2048 + k * 1024); } while (0)
#define PG8_MMA(ai, bj, At, Bt) do { __builtin_amdgcn_s_setprio(1); _Pragma("unroll") for (int m = 0; m < 4; ++m) _Pragma("unroll") for (int n = 0; n < 2; ++n) _Pragma("unroll") for (int k = 0; k < 2; ++k) \
    acc[ai][bj][m][n] = __builtin_amdgcn_mfma_f32_16x16x32_bf16(Bt[n][k], At[m][k], acc[ai][bj][m][n], 0, 0, 0); __builtin_amdgcn_s_setprio(0); } while (0)
#define PG8_WAIT_V(n) asm volatile("s_waitcnt vmcnt(" #n ")" ::: "memory")
#define PG8_WAIT_L(n) asm volatile("s_waitcnt lgkmcnt(" #n ")" ::: "memory")
#define PG8_BAR __builtin_amdgcn_s_barrier()
#define PG8_SCHED __builtin_amdgcn_sched_barrier(0)
  Unit cur, nxt; int ui = 0;
  if (!sched_next(d, 0, cur)) return;
  f32x4 acc[2][2][4][2];
#pragma unroll
  for (int a = 0; a < 2; ++a)
#pragma unroll
    for (int b = 0; b < 2; ++b)
#pragma unroll
      for (int m = 0; m < 4; ++m)
#pragma unroll
        for (int n = 0; n < 2; ++n) acc[a][b][m][n] = (f32x4){0.f, 0.f, 0.f, 0.f};
  bf16x8 At[4][2], B0[2][2], B1[2][2];
  const char* cA = cur.A; const char* cB = cur.B;
  PG8_STAGE(PG8_SB(0, 0), cB, voffB); PG8_STAGE(PG8_SB(0, 1), cB + hstep, voffB); PG8_STAGE(PG8_SA(0, 0), cA, voffA); PG8_STAGE(PG8_SA(0, 1), cA + hstep, voffA);
  if (wr == 1) PG8_BAR;
  PG8_WAIT_V(2); PG8_BAR;
  PG8_STAGE(PG8_SB(1, 0), cB + kstep, voffB); PG8_STAGE(PG8_SA(1, 0), cA + kstep, voffA); PG8_STAGE(PG8_SB(1, 1), cB + hstep + kstep, voffB);
  PG8_WAIT_V(6); PG8_BAR;
  for (;;) {
    const bool has_next = sched_next(d, ui + 1, nxt);
    const char* nA = has_next ? nxt.A : cA; const char* nB = has_next ? nxt.B : cB;
    const int nt = cur.nt;
    for (int t = 0; t < nt; t += 2) {
      const bool last = (t == nt - 2);
      const char* a1 = cA + (size_t)(t + 1) * kstep;
      const char* a2 = last ? nA : cA + (size_t)(t + 2) * kstep; const char* b2 = last ? nB : cB + (size_t)(t + 2) * kstep;
      const char* a3 = a2 + kstep; const char* b3 = b2 + kstep;
      PG8_LDB(B0, 0, 0); PG8_LDB(B1, 0, 1); PG8_SCHED; PG8_LDA(At, 0, 0); PG8_STAGE(PG8_SA(1, 1), a1 + hstep, voffA);
      PG8_WAIT_V(8); PG8_WAIT_L(0); PG8_BAR; PG8_MMA(0, 0, At, B0); PG8_MMA(0, 1, At, B1); PG8_BAR; PG8_SCHED;
      PG8_LDA(At, 0, 1); PG8_STAGE(PG8_SB(0, 0), b2, voffB); PG8_STAGE(PG8_SB(0, 1), b2 + hstep, voffB); PG8_STAGE(PG8_SA(0, 0), a2, voffA);
      PG8_WAIT_V(8); PG8_WAIT_L(0); PG8_BAR; PG8_MMA(1, 0, At, B0); PG8_MMA(1, 1, At, B1); PG8_BAR; PG8_SCHED;
      PG8_LDB(B0, 1, 0); PG8_LDB(B1, 1, 1); PG8_SCHED; PG8_LDA(At, 1, 0); PG8_STAGE(PG8_SA(0, 1), a2 + hstep, voffA);
      PG8_WAIT_V(8); PG8_WAIT_L(0); PG8_BAR; PG8_MMA(0, 0, At, B0); PG8_MMA(0, 1, At, B1); PG8_BAR; PG8_SCHED;
      PG8_LDA(At, 1, 1); PG8_STAGE(PG8_SB(1, 0), b3, voffB); PG8_STAGE(PG8_SB(1, 1), b3 + hstep, voffB); PG8_STAGE(PG8_SA(1, 0), a3, voffA);
      PG8_WAIT_V(8); PG8_WAIT_L(0); PG8_BAR; PG8_MMA(1, 0, At, B0); PG8_MMA(1, 1, At, B1); PG8_BAR; PG8_SCHED;
    }
    if (wr == 0) PG8_BAR;
    gemm_epilogue(acc, cur, d, P, wr, wc, fr, fq);
    if (!has_next) break;
#pragma unroll
    for (int a = 0; a < 2; ++a)
#pragma unroll
      for (int b = 0; b < 2; ++b)
#pragma unroll
        for (int m = 0; m < 4; ++m)
#pragma unroll
          for (int n = 0; n < 2; ++n) acc[a][b][m][n] = (f32x4){0.f, 0.f, 0.f, 0.f};
    cur = nxt; cA = nA; cB = nB; ++ui;
    if (wr == 1) PG8_BAR;
  }
  PG8_WAIT_V(0);
  PG8_BAR;
#undef PG8_SA
#undef PG8_SB
#undef PG8_STAGE
#undef PG8_LDA
#undef PG8_LDB
#undef PG8_MMA
#undef PG8_WAIT_V
#undef PG8_WAIT_L
#undef PG8_BAR
#undef PG8_SCHED
}

namespace att {
constexpr int D = 128, NW = 8, QBLK = 32, KVBLK = 64;
constexpr float SCALE = 0.088388347648318440f;
constexpr float THR = 8.f;
constexpr int LDQ = 2048, LDK = 512, LDO = 2048;
constexpr size_t SHM_V = KVBLK * D * 2, SHM_K = KVBLK * D * 2;
#define KSWZ(row, colB) ((row) * 256 + ((colB) ^ (((row) & 7) << 4)))
#define SBAR() __builtin_amdgcn_sched_barrier(0)
__device__ __forceinline__ int crow(int r, int hi) { return (r & 3) + 8 * (r >> 2) + 4 * hi; }
__device__ __forceinline__ unsigned cvtpk(float lo, float hi) { unsigned r; asm volatile("v_cvt_pk_bf16_f32 %0, %1, %2" : "=v"(r) : "v"(lo), "v"(hi)); return r; }
__device__ __forceinline__ void partialSM(f32x16& p0, f32x16& p1, float& m_reg, float& mn, float& alpha) {
  constexpr float C = SCALE * 1.4426950408889634f;
  float pmax = p0[0];
#pragma unroll
  for (int r = 1; r < 16; ++r) pmax = fmaxf(pmax, p0[r]);
#pragma unroll
  for (int r = 0; r < 16; ++r) pmax = fmaxf(pmax, p1[r]);
  { auto rr = __builtin_amdgcn_permlane32_swap(__float_as_uint(pmax), __float_as_uint(pmax), false, false);
    pmax = fmaxf(__uint_as_float(rr[0]), __uint_as_float(rr[1])); }
  if (__builtin_expect(__all(pmax - m_reg <= THR / SCALE), 1)) { mn = m_reg; alpha = 1.f; }
  else { mn = fmaxf(m_reg, pmax); alpha = __builtin_amdgcn_exp2f((m_reg - mn) * C); m_reg = mn; }
  float mnC = -mn * C;
#pragma unroll
  for (int r = 0; r < 16; ++r) p0[r] = fmaf(p0[r], C, mnC);
#pragma unroll
  for (int r = 0; r < 16; ++r) p1[r] = fmaf(p1[r], C, mnC);
#pragma unroll
  for (int r = 0; r < 16; ++r) p0[r] = __builtin_amdgcn_exp2f(p0[r]);
}
__device__ __forceinline__ void finishSM(f32x16& p0, f32x16& p1, float alpha, float& l_reg, bf16x8& pa0, bf16x8& pa1, bf16x8& pa2, bf16x8& pa3) {
#pragma unroll
  for (int r = 0; r < 16; ++r) p1[r] = __builtin_amdgcn_exp2f(p1[r]);
  float ps = 0;
#pragma unroll
  for (int r = 0; r < 16; ++r) ps += p0[r];
#pragma unroll
  for (int r = 0; r < 16; ++r) ps += p1[r];
  { auto rr = __builtin_amdgcn_permlane32_swap(__float_as_uint(ps), __float_as_uint(ps), false, false);
    ps = __uint_as_float(rr[0]) + __uint_as_float(rr[1]); }
  l_reg = l_reg * alpha + ps;
#define PK4(P, BASE, OUT) do { unsigned a0 = cvtpk(P[BASE + 0], P[BASE + 1]), a1 = cvtpk(P[BASE + 2], P[BASE + 3]);   \
    unsigned b0 = cvtpk(P[BASE + 4], P[BASE + 5]), b1 = cvtpk(P[BASE + 6], P[BASE + 7]);                              \
    auto r0 = __builtin_amdgcn_permlane32_swap(a0, b0, false, false); auto r1 = __builtin_amdgcn_permlane32_swap(a1, b1, false, false); \
    u32x4 w = {r0[0], r1[0], r0[1], r1[1]}; OUT = *reinterpret_cast<bf16x8*>(&w); } while (0)
  PK4(p0, 0, pa0); PK4(p0, 8, pa1); PK4(p1, 0, pa2); PK4(p1, 8, pa3);
#undef PK4
}
__device__ __forceinline__ void qkt(f32x16& p0, f32x16& p1, const bf16_t* Ks, const bf16x8* qr, int r32, int hi) {
  p0 = f32x16{}; p1 = f32x16{};
#pragma unroll
  for (int d0 = 0; d0 < 8; ++d0) { int cb = (d0 * 16 + hi * 8) * 2;
    bf16x8 b0 = *reinterpret_cast<const bf16x8*>((const char*)Ks + KSWZ(r32, cb));
    bf16x8 b1 = *reinterpret_cast<const bf16x8*>((const char*)Ks + KSWZ(32 + r32, cb));
    p0 = __builtin_amdgcn_mfma_f32_32x32x16_bf16(b0, qr[d0], p0, 0, 0, 0);
    p1 = __builtin_amdgcn_mfma_f32_32x32x16_bf16(b1, qr[d0], p1, 0, 0, 0); }
}
__device__ __forceinline__ int v_st(int k, int c) { const int kk = (k & ~0xC) | ((k & 4) << 1) | ((k & 8) >> 1); return ((kk >> 3) * 4 + (c >> 5)) * 512 + ((kk & 7) * 32 + (c & 31)) * 2; }
__device__ __forceinline__ int v_rd_base(int lane) { return ((lane & 3) << 3) | (((lane >> 2) & 3) << 6) | (((lane >> 4) & 1) << 5) | (((lane >> 5) & 1) << 8); }
constexpr int v_rd_off(int d0, int ks, int half) { return d0 * 512 + ks * 4096 + half * 2048; }
template <int OFF> __device__ __forceinline__ s16x4 tr_read(int vb) {
  s16x4 r; asm volatile("ds_read_b64_tr_b16 %0, %1 offset:%2" : "=&v"(r) : "v"(vb), "i"(OFF) : "memory"); return r;
}
template <int D0> __device__ __forceinline__ void pv_one(f32x16& od, int vb, bf16x8 pa0, bf16x8 pa1, bf16x8 pa2, bf16x8 pa3) {
  const s16x4 l0 = tr_read<v_rd_off(D0, 0, 0)>(vb), h0 = tr_read<v_rd_off(D0, 0, 1)>(vb), l1 = tr_read<v_rd_off(D0, 1, 0)>(vb), h1 = tr_read<v_rd_off(D0, 1, 1)>(vb);
  const s16x4 l2 = tr_read<v_rd_off(D0, 2, 0)>(vb), h2 = tr_read<v_rd_off(D0, 2, 1)>(vb), l3 = tr_read<v_rd_off(D0, 3, 0)>(vb), h3 = tr_read<v_rd_off(D0, 3, 1)>(vb);
  asm volatile("s_waitcnt lgkmcnt(0)" ::: "memory"); SBAR();
#define PK(L, H) (bf16x8){L[0], L[1], L[2], L[3], H[0], H[1], H[2], H[3]}
  od = __builtin_amdgcn_mfma_f32_32x32x16_bf16(pa0, PK(l0, h0), od, 0, 0, 0);
  od = __builtin_amdgcn_mfma_f32_32x32x16_bf16(pa1, PK(l1, h1), od, 0, 0, 0);
  od = __builtin_amdgcn_mfma_f32_32x32x16_bf16(pa2, PK(l2, h2), od, 0, 0, 0);
  od = __builtin_amdgcn_mfma_f32_32x32x16_bf16(pa3, PK(l3, h3), od, 0, 0, 0);
#undef PK
}
__device__ __forceinline__ void pv_d0(f32x16* o, int vb, bf16x8 pa0, bf16x8 pa1, bf16x8 pa2, bf16x8 pa3) {
  pv_one<0>(o[0], vb, pa0, pa1, pa2, pa3); pv_one<1>(o[1], vb, pa0, pa1, pa2, pa3); pv_one<2>(o[2], vb, pa0, pa1, pa2, pa3); pv_one<3>(o[3], vb, pa0, pa1, pa2, pa3);
}
__device__ __forceinline__ void attn_dense_body(const bf16_t* __restrict__ Qb, const bf16_t* __restrict__ Kh, const bf16_t* __restrict__ Vh,
                                                bf16_t* __restrict__ Ob, int seq, char* lds, const int tid) {
  const int wid = tid >> 6, lane = tid & 63, r32 = lane & 31, hi = lane >> 5;
  bf16_t* V_lds = (bf16_t*)lds; bf16_t* K_lds = (bf16_t*)(lds + 2 * SHM_V);
  float* wsf = (float*)(lds + 2 * SHM_V + 2 * SHM_K) + wid * 64; float* li_l = wsf; float* al_l = wsf + 32;
  float m_reg = -1e30f, l_reg = 0; f32x16 o[4] = {}; bf16x8 qr[8];
  const bf16_t* Qw = Qb + (long)(wid * QBLK + r32) * LDQ + hi * 8;
#pragma unroll
  for (int d0 = 0; d0 < 8; ++d0) qr[d0] = *reinterpret_cast<const bf16x8*>(Qw + d0 * 16);
  const int sr = tid >> 4, sc = (tid & 15) * 8, vst0 = v_st(sr, sc), vst1 = v_st(32 + sr, sc);
  const int vb0 = (int)(uintptr_t)V_lds + v_rd_base(lane);
  struct { bf16x8 vs0, vs1, ks0, ks1; } sr_[2];
#define LD8(p) (*reinterpret_cast<const bf16x8*>(p))
  const unsigned voff = (unsigned)(sr * LDK + sc) * 2u;
#define SLOAD(i, k0) do { const char* vb_ = (const char*)(Vh + (size_t)(k0) * LDK); const char* kb_ = (const char*)(Kh + (size_t)(k0) * LDK); \
    sr_[i].vs0 = LD8(vb_ + voff); sr_[i].vs1 = LD8(vb_ + 32 * LDK * 2 + voff); sr_[i].ks0 = LD8(kb_ + voff); sr_[i].ks1 = LD8(kb_ + 32 * LDK * 2 + voff); } while (0)
#define SWRITE(b, i) do { *(bf16x8*)((char*)V_lds + (b) * SHM_V + vst0) = sr_[i].vs0;          \
    *(bf16x8*)((char*)V_lds + (b) * SHM_V + vst1) = sr_[i].vs1; int kc = sc * 2;               \
    *(bf16x8*)((char*)K_lds + (b) * SHM_K + KSWZ(sr, kc)) = sr_[i].ks0;                       \
    *(bf16x8*)((char*)K_lds + (b) * SHM_K + KSWZ(32 + sr, kc)) = sr_[i].ks1; } while (0)
#define SWAIT() asm volatile("s_waitcnt vmcnt(4)" ::: "memory")
#define RESC(a) do { if (__any((a) < 1.f)) { if (hi == 0) al_l[r32] = (a); asm volatile("s_waitcnt lgkmcnt(0)" ::: "memory"); \
    _Pragma("unroll") for (int d = 0; d < 4; ++d) _Pragma("unroll") for (int r = 0; r < 16; ++r) o[d][r] *= al_l[crow(r, hi)]; } } while (0)
  f32x16 pA0, pA1, pB0, pB1; float mnA, mnB, alA, alB; bf16x8 pa0, pa1, pa2, pa3; const int NT = seq / KVBLK;
  constexpr int SE = 0, SO = 1;
  SLOAD(SE, 0); asm volatile("s_waitcnt vmcnt(0)" ::: "memory"); SWRITE(0, SE); __syncthreads();
  qkt(pA0, pA1, K_lds, qr, r32, hi); partialSM(pA0, pA1, m_reg, mnA, alA);
  SLOAD(SO, KVBLK); if (2 < NT) SLOAD(SE, 2 * KVBLK);
  SWAIT(); SWRITE(1, SO); __syncthreads();
  for (int j = 1; j + 1 < NT; j += 2) {
    SBAR(); qkt(pB0, pB1, (bf16_t*)((char*)K_lds + SHM_K), qr, r32, hi);
    finishSM(pA0, pA1, alA, l_reg, pa0, pa1, pa2, pa3); SBAR();
    SLOAD(SO, (j + 2) * KVBLK); SBAR();
    pv_d0(o, vb0, pa0, pa1, pa2, pa3); partialSM(pB0, pB1, m_reg, mnB, alB);
    __syncthreads(); SWAIT(); SWRITE(0, SE);
    RESC(alB); __syncthreads();
    SBAR(); qkt(pA0, pA1, K_lds, qr, r32, hi);
    finishSM(pB0, pB1, alB, l_reg, pa0, pa1, pa2, pa3); SBAR();
    if (j + 3 < NT) SLOAD(SE, (j + 3) * KVBLK); SBAR();
    pv_d0(o, vb0 + (int)SHM_V, pa0, pa1, pa2, pa3); partialSM(pA0, pA1, m_reg, mnA, alA);
    __syncthreads(); SWAIT(); SWRITE(1, SO);
    RESC(alA); __syncthreads();
  }
  SBAR(); qkt(pB0, pB1, (bf16_t*)((char*)K_lds + SHM_K), qr, r32, hi);
  finishSM(pA0, pA1, alA, l_reg, pa0, pa1, pa2, pa3); SBAR();
  pv_d0(o, vb0, pa0, pa1, pa2, pa3); partialSM(pB0, pB1, m_reg, mnB, alB);
  __syncthreads(); RESC(alB);
  finishSM(pB0, pB1, alB, l_reg, pa0, pa1, pa2, pa3); SBAR();
  pv_d0(o, vb0 + (int)SHM_V, pa0, pa1, pa2, pa3);
  if (hi == 0) li_l[r32] = l_reg; asm volatile("s_waitcnt lgkmcnt(0)" ::: "memory");
  float rli[16];
#pragma unroll
  for (int r = 0; r < 16; ++r) rli[r] = __builtin_amdgcn_rcpf(li_l[crow(r, hi)]);
  bf16_t* Ow = Ob + (long)(wid * QBLK) * LDO;
#pragma unroll
  for (int r = 0; r < 16; ++r) { int orow = crow(r, hi);
#pragma unroll
    for (int d0 = 0; d0 < 4; ++d0) Ow[(long)orow * LDO + d0 * 32 + r32] = f2bf(o[d0][r] * rli[r]); }
#undef LD8
#undef SLOAD
#undef SWRITE
#undef SWAIT
#undef RESC
}
}

__device__ __forceinline__ void mod_phase(const Params& P, LAS unsigned char* lds, const int tid) {
  LAS float* sc = (LAS float*)lds; LAS float* red = sc + 5 * 2048;
  const int wid = tid >> 6, lane = tid & 63;
  for (int i = tid; i < 5 * 2048; i += 512) { const int j = i >> 11, k = i & 2047; const float v = (j < 4) ? P.c[j * 2048 + k] : P.c_ctx[k]; sc[i] = v * sigmoidf_(v); }
  __syncthreads();
  float* MOD = (float*)(P.ws + OFF_MOD);
  for (int task = P.bid; task < 256; task += P.grd) {
    const int n0 = task * 72 + lane * 2;
    float a0[5], a1[5];
#pragma unroll
    for (int j = 0; j < 5; ++j) { a0[j] = 0.f; a1[j] = 0.f; }
    if (lane < 36) {
      const float* wp = P.w_mod + (size_t)(wid * 256) * NMODC + n0;
#pragma unroll 16
      for (int k = 0; k < 256; ++k) {
        const f32x2 w = *(const f32x2*)(wp + (size_t)k * NMODC);
#pragma unroll
        for (int j = 0; j < 5; ++j) { const float s = sc[j * 2048 + wid * 256 + k]; a0[j] += s * w.x; a1[j] += s * w.y; }
      }
#pragma unroll
      for (int j = 0; j < 5; ++j) { red[(wid * 5 + j) * 72 + lane * 2] = a0[j]; red[(wid * 5 + j) * 72 + lane * 2 + 1] = a1[j]; }
    }
    __syncthreads();
    if (tid < 360) { const int j = tid / 72, ci = tid % 72; float s = 0.f;
#pragma unroll
      for (int w = 0; w < 8; ++w) s += red[(w * 5 + j) * 72 + ci];
      MOD[j * NMODC + task * 72 + ci] = s + P.b_mod[task * 72 + ci]; }
    __syncthreads();
  }
}
__device__ __forceinline__ void tr_item(const float* __restrict__ W, int ldw, int k0, int n0, bf16_t* __restrict__ WT, int ldt, int drow0, int dk0, LAS float* scr, int lane) {
#pragma unroll 32
  for (int i = 0; i < 32; ++i) { const int kk = 2 * i + (lane >> 5); scr[kk * 33 + (lane & 31)] = W[(size_t)(k0 + kk) * ldw + n0 + (lane & 31)]; }
  asm volatile("s_waitcnt lgkmcnt(0)" ::: "memory");
  const int c = lane & 7;
#pragma unroll
  for (int j = 0; j < 4; ++j) { const int n = (lane >> 3) + 8 * j; const LAS float* s = scr + (8 * c) * 33 + n;
    u32x4 o; o.x = cvt_pk_bf16(s[0 * 33], s[1 * 33]); o.y = cvt_pk_bf16(s[2 * 33], s[3 * 33]); o.z = cvt_pk_bf16(s[4 * 33], s[5 * 33]); o.w = cvt_pk_bf16(s[6 * 33], s[7 * 33]);
    *(u32x4*)(WT + (size_t)(drow0 + n) * ldt + dk0 + k0 + 8 * c) = o; }
  asm volatile("s_waitcnt lgkmcnt(0)" ::: "memory");
}
__device__ __forceinline__ void convert_phase(const Params& P, LAS unsigned char* lds, const int tid) {
  const int wid = tid >> 6, lane = tid & 63;
  LAS float* scr = (LAS float*)(lds + wid * 8704);
  unsigned char* ws = P.ws;
  bf16_t *W1A = (bf16_t*)(ws + OFF_W1A), *W1B = (bf16_t*)(ws + OFF_W1B), *W2A = (bf16_t*)(ws + OFF_W2A), *W2B = (bf16_t*)(ws + OFF_W2B);
  bf16_t *WRW = (bf16_t*)(ws + OFF_WRW), *WQKVG = (bf16_t*)(ws + OFF_WQKVG), *WOA = (bf16_t*)(ws + OFF_WOA), *WOR = (bf16_t*)(ws + OFF_WOR), *WOUT = (bf16_t*)(ws + OFF_WOUT), *WLORA = (bf16_t*)(ws + OFF_WLORA);
  const int G = P.grd, gw = P.bid * 8 + wid, NGW = G * 8;
  constexpr int NITEMS = 22528 + 11264 + 3456 + 7168 + 2048 + 1024 + 2048 + 192;
  for (int it = gw; it < NITEMS; it += NGW) {
    int r = it;
    if (r < 22528) { const int which = r >= 11264; r -= which * 11264; const int kb = r / 352, nb = r % 352, n0 = nb * 32;
      const int drow = n0 < DFF ? (n0 >> 7) * 256 + (n0 & 127) : ((n0 - DFF) >> 7) * 256 + 128 + ((n0 - DFF) & 127);
      tr_item(which ? P.ffn2_w_in : P.ffn1_w_in, 2 * DFF, kb * 64, n0, which ? W2A : W1A, 2048, drow, 0, scr, lane); continue; }
    r -= 22528;
    if (r < 11264) { const int which = r >= 5632; r -= which * 5632; const int kb = r >> 6, nb = r & 63;
      tr_item(which ? P.ffn2_w_out : P.ffn1_w_out, 2048, kb * 64, nb * 32, which ? W2B : W1B, DFF, nb * 32, 0, scr, lane); continue; }
    r -= 11264;
    if (r < 3456) { const int kb = r / 108, nb = r % 108; tr_item(P.w_in, 10624, kb * 64, 3072 + nb * 32, WRW, 2048, nb * 32, 0, scr, lane); continue; }
    r -= 3456;
    if (r < 7168) { const int kb = r / 224, nb = r % 224; const int n0 = nb < 96 ? nb * 32 : 6528 + (nb - 96) * 32;
      tr_item(P.w_in, 10624, kb * 64, n0, WQKVG, 2048, nb * 32, 0, scr, lane); continue; }
    r -= 7168;
    if (r < 2048) { tr_item(P.w_oa, 2048, (r >> 6) * 64, (r & 63) * 32, WOA, 2048, (r & 63) * 32, 0, scr, lane); continue; }
    r -= 2048;
    if (r < 1024) { tr_item(P.w_or, 2048, (r >> 6) * 64, (r & 63) * 32, WOR, 1024, (r & 63) * 32, 0, scr, lane); continue; }
    r -= 1024;
    if (r < 2048) { tr_item(P.w_out, 2048, (r >> 6) * 64, (r & 63) * 32, WOUT, 2048, (r & 63) * 32, 0, scr, lane); continue; }
    r -= 2048;
    if (r < 64) { const int z = r >> 5, nb = r & 31; tr_item(P.w2 + (size_t)z * 64 * 1024, 1024, 0, nb * 32, WLORA, LIN_LD, z * 1024 + nb * 32, z * 64, scr, lane); continue; }
    r -= 64;
    if (r < 64) { const int z = r >> 5, nb = r & 31; tr_item(P.a2 + (size_t)z * 64 * 1024, 1024, 0, nb * 32, WLORA, LIN_LD, 2048 + z * 1024 + nb * 32, 128 + z * 64, scr, lane); continue; }
    r -= 64;
    { const int kb = r >> 5, nb = r & 31; tr_item(P.g2, 1024, kb * 64, nb * 32, WLORA, LIN_LD, 4096 + nb * 32, 256, scr, lane); }
  }
  const int gt = P.bid * 512 + tid, NT = G * 512;
  unsigned zz = 0u; asm volatile("" : "+v"(zz));
  const u32x4 z4 = {zz, zz, zz, zz};
  for (int i = gt; i < 128 * 256; i += NT) *(u32x4*)(WRW + (size_t)3456 * 2048 + (size_t)i * 8) = z4;
  for (int i = gt; i < 5120 * 48; i += NT) { const int row = i / 48, kc = (i % 48) * 8, rb = row >> 10;
    const int lo = rb < 4 ? rb * 64 : 256, hi = rb < 4 ? rb * 64 + 64 : 384;
    if (kc < lo || kc >= hi) *(u32x4*)(WLORA + (size_t)row * LIN_LD + kc) = z4; }
}
__device__ __forceinline__ void norm_mod_phase(const Params& P, const float* __restrict__ lat, const float* __restrict__ ctxp, int nrows, const float* __restrict__ g, int midx, const float* __restrict__ parts, const int tid) {
  const int wid = tid >> 6, lane = tid & 63;
  const int gw = P.bid * 8 + wid, NGW = P.grd * 8;
  const float* __restrict__ MOD = (const float*)(P.ws + OFF_MOD); bf16_t* __restrict__ H = (bf16_t*)(P.ws + OFF_H);
  for (int r = gw; r < nrows; r += NGW) {
    const float* xr = r < MT ? lat + (size_t)r * DM : ctxp + (size_t)(r - MT) * DM;
    const int b = r < MT ? (r >> 13) : 4;
    const float* sh = MOD + b * NMODC + midx * DM; const float* scp = sh + DM;
    f32x4 v[8], g4[8], s4[8], c4[8]; float ss = 0.f;
#pragma unroll
    for (int j = 0; j < 8; ++j) v[j] = *(const f32x4*)(xr + j * 256 + lane * 4);
    if (parts && r >= MT) {
      const float* pp = parts + (size_t)(r - MT) * DM; const float* gt = MOD + 4 * NMODC + 2 * DM;
#pragma unroll
      for (int j = 0; j < 8; ++j) { const int c = j * 256 + lane * 4;
        const f32x4 s = (*(const f32x4*)(pp + c) + *(const f32x4*)(pp + (size_t)MC * DM + c)) + (*(const f32x4*)(pp + (size_t)2 * MC * DM + c) + *(const f32x4*)(pp + (size_t)3 * MC * DM + c));
        v[j] = v[j] + *(const f32x4*)(gt + c) * 0.5f * s; }
    }
#pragma unroll
    for (int j = 0; j < 8; ++j) { const int c = j * 256 + lane * 4; g4[j] = *(const f32x4*)(g + c); s4[j] = *(const f32x4*)(sh + c); c4[j] = *(const f32x4*)(scp + c); }
#pragma unroll
    for (int j = 0; j < 8; ++j) ss += v[j].x * v[j].x + v[j].y * v[j].y + v[j].z * v[j].z + v[j].w * v[j].w;
    ss = wave_sum(ss);
    const float rs = rsqrtf(ss * (1.f / DM) + 1e-6f);
#pragma unroll
    for (int j = 0; j < 8; ++j) { const int c = j * 256 + lane * 4;
      const f32x4 y = v[j] * rs * g4[j]; const f32x4 h = y * (c4[j] + 1.f) + s4[j];
      u32x2 w; w.x = cvt_pk_bf16(h.x, h.y); w.y = cvt_pk_bf16(h.z, h.w);
      *(u32x2*)(H + (size_t)r * DM + c) = w; }
  }
}
__device__ __forceinline__ void shift_phase(const Params& P, const int tid) {
  const bf16_t* PRW = (const bf16_t*)(P.ws + OFF_PRW); bf16_t* SH = (bf16_t*)(P.ws + OFF_SH); bf16_t* LIN = (bf16_t*)(P.ws + OFF_LIN);
  const int gt = P.bid * 512 + tid, NT = P.grd * 512;
  for (int idx = gt; idx < MA * 432; idx += NT) {
    const int r = idx / 432, c = (idx % 432) * 8;
    bool first, last;
    if (r < MT) { const int t = r & (SEQ - 1); first = t == 0; last = t == SEQ - 1; } else { const int t = (r - MT) & (CTXL - 1); first = t == 0; last = t == CTXL - 1; }
    const u32x4 z4 = {0u, 0u, 0u, 0u};
    const u32x4 p = *(const u32x4*)(PRW + (size_t)r * PRW_LD + c);
    const u32x4 pv = first ? z4 : *(const u32x4*)(PRW + (size_t)(r - 1) * PRW_LD + c);
    const u32x4 nx = last ? z4 : *(const u32x4*)(PRW + (size_t)(r + 1) * PRW_LD + c);
    const f32x4 m0 = *(const f32x4*)(P.rwkv_mu + c), m1 = *(const f32x4*)(P.rwkv_mu + c + 4);
    float o[8];
#define SHF(e, W, MU, HI) { const float pp = HI ? bfhi(p.W) : bflo(p.W), a = HI ? bfhi(pv.W) : bflo(pv.W), b = HI ? bfhi(nx.W) : bflo(nx.W); o[e] = pp + MU * (0.5f * (a + b) - pp); }
    SHF(0, x, m0.x, 0) SHF(1, x, m0.y, 1) SHF(2, y, m0.z, 0) SHF(3, y, m0.w, 1) SHF(4, z, m1.x, 0) SHF(5, z, m1.y, 1) SHF(6, w, m1.z, 0) SHF(7, w, m1.w, 1)
#undef SHF
    bf16_t* dst;
    if (c < 3072) dst = SH + (size_t)r * SH_LD + c;
    else { const int cl = c - 3072; dst = LIN + (size_t)r * LIN_LD + cl;
      if (cl < 128) {
#pragma unroll
        for (int e = 0; e < 8; ++e) { const float ex = __builtin_amdgcn_exp2f(2.8853900817779268f * o[e]); o[e] = 1.f - 2.f * __builtin_amdgcn_rcpf(ex + 1.f); }
      } else if (cl >= 256) {
#pragma unroll
        for (int e = 0; e < 8; ++e) o[e] = sigmoidf_(o[e]);
      } }
    u32x4 w; w.x = cvt_pk_bf16(o[0], o[1]); w.y = cvt_pk_bf16(o[2], o[3]); w.z = cvt_pk_bf16(o[4], o[5]); w.w = cvt_pk_bf16(o[6], o[7]);
    *(u32x4*)dst = w;
  }
}
__device__ __forceinline__ float SFMA(float a, float b, float c) { float d; asm("v_fma_f32 %0, %1, %2, %3" : "=v"(d) : "v"(a), "v"(b), "v"(c)); return d; }
__device__ __forceinline__ float SMUL(float a, float b) { float d; asm("v_mul_f32 %0, %1, %2" : "=v"(d) : "v"(a), "v"(b)); return d; }
__device__ __forceinline__ float allred8(float x) { x += dpp_mov<0xB1>(x); x += dpp_mov<0x4E>(x); x += dpp_mov<0x141>(x); return x; }
__device__ __forceinline__ void scan_phase(const Params& P, LAS unsigned char* lds, const int tid) {
  LAS float* F = (LAS float*)lds;
  LAS unsigned short* YB = (LAS unsigned short*)(lds + 2 * 32 * 384 * 4);
  const bf16_t* SH = (const bf16_t*)(P.ws + OFF_SH); const bf16_t* LO = (const bf16_t*)(P.ws + OFF_LO); bf16_t* Y = (bf16_t*)(P.ws + OFF_Y);
  const int wid = __builtin_amdgcn_readfirstlane(tid >> 6), lane = tid & 63;
  constexpr int NCH = SKV / 32;
#define SCAN_BAR() do { asm volatile("s_waitcnt lgkmcnt(0)" ::: "memory"); __builtin_amdgcn_s_barrier(); asm volatile("" ::: "memory"); } while (0)
  for (int task = P.bid; task < 256; task += P.grd) {
    const int half = (task >> 3) & 1, chain = (task & 7) | ((task >> 4) << 3);
    const int dir = chain & 1, h = (chain >> 1) & 15, b = chain >> 5, hc = h * 64;
#define ROWOF(g) ((g) < CTXL ? (MT + b * CTXL + (dir ? CTXL - 1 - (g) : (g))) : (b * SEQ + (dir ? SEQ - 1 - ((g) - CTXL) : ((g) - CTXL))))
    if (wid < 4) {
      const int rloc = wid * 8 + (lane >> 3), irow = half * 32 + rloc, cA = (lane & 7) * 4, cB = 32 + cA;
      f32x4 S0 = {0.f, 0.f, 0.f, 0.f}, S1 = {0.f, 0.f, 0.f, 0.f};
      SCAN_BAR();
      for (int q = 0; q < NCH; ++q) {
        const LAS float* f = F + (q & 1) * 32 * 384;
        LAS unsigned short* yb = YB + (q & 1) * 1024;
        f32x4 w0 = *(const LAS f32x4*)(f + cA), w1 = *(const LAS f32x4*)(f + cB);
        f32x4 a0 = *(const LAS f32x4*)(f + 64 + cA), a1 = *(const LAS f32x4*)(f + 64 + cB);
        f32x4 b0 = *(const LAS f32x4*)(f + 128 + cA), b1 = *(const LAS f32x4*)(f + 128 + cB);
        f32x4 k0 = *(const LAS f32x4*)(f + 192 + cA), k1 = *(const LAS f32x4*)(f + 192 + cB);
        f32x4 r0 = *(const LAS f32x4*)(f + 256 + cA), r1 = *(const LAS f32x4*)(f + 256 + cB);
        float vv = f[320 + irow];
        float ykeep = 0.f;
#pragma unroll 2
        for (int s = 0; s < 32; ++s) {
          const LAS float* fn = f + (s < 31 ? s + 1 : 31) * 384;
          const f32x4 nw0 = *(const LAS f32x4*)(fn + cA), nw1 = *(const LAS f32x4*)(fn + cB);
          const f32x4 na0 = *(const LAS f32x4*)(fn + 64 + cA), na1 = *(const LAS f32x4*)(fn + 64 + cB);
          const f32x4 nb0 = *(const LAS f32x4*)(fn + 128 + cA), nb1 = *(const LAS f32x4*)(fn + 128 + cB);
          const f32x4 nk0 = *(const LAS f32x4*)(fn + 192 + cA), nk1 = *(const LAS f32x4*)(fn + 192 + cB);
          const f32x4 nr0 = *(const LAS f32x4*)(fn + 256 + cA), nr1 = *(const LAS f32x4*)(fn + 256 + cB);
          const float nvv = fn[320 + irow];
          __builtin_amdgcn_sched_barrier(0);
          f32x4 p = S0 * a0 + S1 * a1;
          const float sa_ = allred8((p.x + p.y) + (p.z + p.w));
          S0 = S0 * w0 + (b0 * sa_ + k0 * vv);
          S1 = S1 * w1 + (b1 * sa_ + k1 * vv);
          p = S0 * r0 + S1 * r1;
          const float y = allred8((p.x + p.y) + (p.z + p.w));
          ykeep = ((s & 7) == (lane & 7)) ? y : ykeep;
          if ((s & 7) == 7) yb[((s & ~7) + (lane & 7)) * 32 + rloc] = f2bf(ykeep);
          __builtin_amdgcn_sched_barrier(0);
          w0 = nw0; w1 = nw1; a0 = na0; a1 = na1; b0 = nb0; b1 = nb1; k0 = nk0; k1 = nk1; r0 = nr0; r1 = nr1; vv = nvv;
        }
        SCAN_BAR();
      }
    } else {
      const int sw = wid - 4, hw = lane >> 5, cp = (lane & 31) * 2;
      const f32x2 kk_c = *(const f32x2*)(P.k_k + hc + cp), ka_c = *(const f32x2*)(P.k_a + hc + cp);
      unsigned voS[4], voL[4];
#pragma unroll
      for (int e = 0; e < 4; ++e) { const int tk = hw * 4 + e, ro = dir ? 7 - tk : tk; voS[e] = (unsigned)(ro * SH_LD + cp) * 2u; voL[e] = (unsigned)(ro * LO_LD + cp) * 2u; }
      unsigned sr[4], sk[4], sv[4], sl[4], sa[4];
#define RMIN(q) ({ const int g0_ = (q) * 32 + sw * 8; const int ra_ = ROWOF(g0_), rb_ = ROWOF(g0_ + 7); ra_ < rb_ ? ra_ : rb_; })
#define SLOADQ(q) do { const size_t rmin_ = (size_t)RMIN(q); const char* bs_ = (const char*)(SH + rmin_ * SH_LD + hc); const char* bl_ = (const char*)(LO + rmin_ * LO_LD + dir * 1024 + hc); \
      _Pragma("unroll") for (int e = 0; e < 4; ++e) { sr[e] = *(const unsigned*)(bs_ + voS[e]); sk[e] = *(const unsigned*)(bs_ + 2048 + voS[e]); sv[e] = *(const unsigned*)(bs_ + 4096 + voS[e]); \
        sl[e] = *(const unsigned*)(bl_ + voL[e]); sa[e] = *(const unsigned*)(bl_ + 4096 + voL[e]); } } while (0)
#define SWRITEQ(buf) do { _Pragma("unroll") for (int e = 0; e < 4; ++e) { LAS float* f_ = F + ((buf) * 32 + sw * 8 + hw * 4 + e) * 384 + cp; \
      const f32x2 r_ = {bflo(sr[e]), bfhi(sr[e])}, k_ = {bflo(sk[e]), bfhi(sk[e])}, v_ = {bflo(sv[e]), bfhi(sv[e])}, lam = {bflo(sl[e]), bfhi(sl[e])}, aa = {bflo(sa[e]), bfhi(sa[e])}; \
      const f32x2 kkr = k_ * kk_c; float ssq = allred16(kkr.x * kkr.x + kkr.y * kkr.y); \
      { auto rr_ = __builtin_amdgcn_permlane16_swap(__float_as_uint(ssq), __float_as_uint(ssq), false, false); ssq = __uint_as_float(rr_[0]) + __uint_as_float(rr_[1]); } \
      const f32x2 kk = kkr * rsqrtf(fmaxf(ssq, 1e-24f)); \
      f32x2 wv; wv.x = __builtin_amdgcn_exp2f(-lam.x); wv.y = __builtin_amdgcn_exp2f(-lam.y); \
      *(LAS f32x2*)(f_) = wv; *(LAS f32x2*)(f_ + 64) = -kk; *(LAS f32x2*)(f_ + 128) = kk * aa; *(LAS f32x2*)(f_ + 192) = k_ * ((aa - 1.f) * ka_c + 1.f); \
      *(LAS f32x2*)(f_ + 256) = r_; *(LAS f32x2*)(f_ + 320) = v_; } } while (0)
      SLOADQ(0); SWRITEQ(0); SLOADQ(1);
      SCAN_BAR();
      for (int q = 0; q < NCH; ++q) {
        if (q >= 9) {
          const int qq = q - 1; const LAS unsigned short* yb = YB + (qq & 1) * 1024;
          const int t256 = sw * 64 + lane, s = t256 >> 3, rp = (t256 & 7) * 4; const int u = qq * 32 + s - CTXL; const int t = dir ? SEQ - 1 - u : u;
          const u32x2 val = *(const LAS u32x2*)(yb + s * 32 + rp);
          *(u32x2*)(Y + (size_t)dir * MT * 1024 + (size_t)(b * SEQ + t) * 1024 + hc + half * 32 + rp) = val;
        }
        if (q + 1 < NCH) SWRITEQ((q + 1) & 1);
        if (q + 2 < NCH) SLOADQ(q + 2);
        SCAN_BAR();
      }
      {
        const int qq = NCH - 1; const LAS unsigned short* yb = YB + (qq & 1) * 1024;
        const int t256 = sw * 64 + lane, s = t256 >> 3, rp = (t256 & 7) * 4; const int u = qq * 32 + s - CTXL; const int t = dir ? SEQ - 1 - u : u;
        const u32x2 val = *(const LAS u32x2*)(yb + s * 32 + rp);
        *(u32x2*)(Y + (size_t)dir * MT * 1024 + (size_t)(b * SEQ + t) * 1024 + hc + half * 32 + rp) = val;
      }
#undef SLOADQ
#undef SWRITEQ
#undef RMIN
    }
#undef ROWOF
    __syncthreads();
  }
#undef SCAN_BAR
}
__device__ __forceinline__ float half_sum(float v) {
  v = allred16(v);
  auto rr = __builtin_amdgcn_permlane16_swap(__float_as_uint(v), __float_as_uint(v), false, false); return __uint_as_float(rr[0]) + __uint_as_float(rr[1]);
}
__device__ __forceinline__ void rwkv_out_phase(const Params& P, const int tid) {
  const bf16_t* SH = (const bf16_t*)(P.ws + OFF_SH); const bf16_t* LO = (const bf16_t*)(P.ws + OFF_LO); bf16_t* Y = (bf16_t*)(P.ws + OFF_Y);
  const int wid = tid >> 6, lane = tid & 63, hw = lane >> 5, cp = (lane & 31) * 2;
  const int gw = P.bid * 8 + wid, NGW = P.grd * 8;
  for (int task = gw * 2; task < MT * 8; task += NGW * 2) {
    unsigned yf[2], ybk[2], rr[2], kk[2], vv[2], af[2], ab[2], gg[2]; int cc[2]; size_t tk[2];
#pragma unroll
    for (int u = 0; u < 2; ++u) { const int t_ = task + u; tk[u] = (size_t)(t_ >> 3); cc[u] = ((t_ & 7) * 2 + hw) * 64 + cp;
      const bf16_t* py = Y + tk[u] * 1024 + cc[u]; const bf16_t* ps = SH + tk[u] * SH_LD + cc[u]; const bf16_t* pl = LO + tk[u] * LO_LD + cc[u];
      yf[u] = *(const unsigned*)py; ybk[u] = *(const unsigned*)(py + (size_t)MT * 1024);
      rr[u] = *(const unsigned*)ps; kk[u] = *(const unsigned*)(ps + 1024); vv[u] = *(const unsigned*)(ps + 2048);
      af[u] = *(const unsigned*)(pl + 2048); ab[u] = *(const unsigned*)(pl + 3072); gg[u] = *(const unsigned*)(pl + 4096); }
    unsigned res[2];
#pragma unroll
    for (int u = 0; u < 2; ++u) {
      const f32x2 lw = *(const f32x2*)(P.ln_x_w + cc[u]), lb = *(const f32x2*)(P.ln_x_b + cc[u]), ka = *(const f32x2*)(P.k_a + cc[u]), rk = *(const f32x2*)(P.r_k + cc[u]);
      const f32x2 y = {bflo(yf[u]) + bflo(ybk[u]), bfhi(yf[u]) + bfhi(ybk[u])};
      const float mu = half_sum(y.x + y.y) * (1.f / 64.f); const f32x2 dv = y - mu; const float var = half_sum(dv.x * dv.x + dv.y * dv.y) * (1.f / 64.f);
      const f32x2 yn = dv * rsqrtf(var + 64e-5f) * lw + lb;
      const f32x2 r = {bflo(rr[u]), bfhi(rr[u])}, k = {bflo(kk[u]), bfhi(kk[u])}, v = {bflo(vv[u]), bfhi(vv[u])};
      const f32x2 a1 = {bflo(af[u]), bfhi(af[u])}, a2 = {bflo(ab[u]), bfhi(ab[u])}, g = {bflo(gg[u]), bfhi(gg[u])};
      const f32x2 kms = k * ((a1 - 1.f) * ka + 1.f) + k * ((a2 - 1.f) * ka + 1.f);
      const f32x2 bt = r * kms * rk;
      const float bonus = half_sum(bt.x + bt.y);
      const f32x2 o = (yn + v * bonus) * g;
      res[u] = cvt_pk_bf16(o.x, o.y);
    }
#pragma unroll
    for (int u = 0; u < 2; ++u) *(unsigned*)(Y + tk[u] * 1024 + cc[u]) = res[u];
  }
}
__device__ __forceinline__ void rope_phase(const Params& P, const int tid) {
  bf16_t* Q = (bf16_t*)(P.ws + OFF_Q); bf16_t* KB = (bf16_t*)(P.ws + OFF_KB);
  const int wid = tid >> 6, lane = tid & 63, hw = lane >> 5, li = lane & 31;
  const int gw = P.bid * 8 + wid, NGW = P.grd * 8;
  const int d1 = li < 16 ? 2 * li : 64 + 2 * (li - 16);
  const f32x2 qgA = *(const f32x2*)(P.q_norm + d1), qgB = *(const f32x2*)(P.q_norm + d1 + 32), kgA = *(const f32x2*)(P.k_norm + d1), kgB = *(const f32x2*)(P.k_norm + d1 + 32);
  const int j0 = 2 * (li & 15);
  const float inv0 = __builtin_amdgcn_exp2f(-(float)(2 * j0) * (13.287712379549449f / 64.f)), inv1 = __builtin_amdgcn_exp2f(-(float)(2 * j0 + 2) * (13.287712379549449f / 64.f));
  for (int task = gw; task < MA; task += NGW) {
    if (task < MT) {
      const int tok = task, b = tok >> 13, t = tok & (SEQ - 1);
      const float pos = (float)(li < 16 ? (t >> 6) : (t & 63));
      const float an0 = pos * inv0, an1 = pos * inv1;
      const f32x2 sn = {__sinf(an0), __sinf(an1)}, cs = {__cosf(an0), __cosf(an1)};
      unsigned lo[10], hi[10]; bf16_t* ptr[10];
#pragma unroll
      for (int i = 0; i < 10; ++i) { const int hd = 2 * i + hw;
        ptr[i] = (hd < 16 ? Q + (size_t)tok * DM + hd * 128 : KB + (size_t)(tok + b * CTXL) * 512 + (hd - 16) * 128) + d1;
        lo[i] = *(const unsigned*)ptr[i]; hi[i] = *(const unsigned*)(ptr[i] + 32); }
#pragma unroll
      for (int i = 0; i < 10; ++i) { const bool isq = i < 8;
        const f32x2 t1 = {bflo(lo[i]), bfhi(lo[i])}, t2 = {bflo(hi[i]), bfhi(hi[i])};
        const float ss = half_sum((t1.x * t1.x + t1.y * t1.y) + (t2.x * t2.x + t2.y * t2.y)); const float rs = rsqrtf(ss * (1.f / 128.f) + 1e-6f);
        const f32x2 n1 = t1 * rs * (isq ? qgA : kgA), n2 = t2 * rs * (isq ? qgB : kgB);
        const f32x2 o1 = n1 * cs - n2 * sn, o2 = n2 * cs + n1 * sn;
        lo[i] = cvt_pk_bf16(o1.x, o1.y); hi[i] = cvt_pk_bf16(o2.x, o2.y); }
#pragma unroll
      for (int i = 0; i < 10; ++i) { *(unsigned*)ptr[i] = lo[i]; *(unsigned*)(ptr[i] + 32) = hi[i]; }
    } else {
      const int ct = task - MT, b = ct >> 8, t = ct & (CTXL - 1);
      unsigned lo[2], hi[2]; bf16_t* ptr[2];
#pragma unroll
      for (int i = 0; i < 2; ++i) { ptr[i] = KB + (size_t)(b * SKV + SEQ + t) * 512 + (2 * i + hw) * 128 + d1; lo[i] = *(const unsigned*)ptr[i]; hi[i] = *(const unsigned*)(ptr[i] + 32); }
#pragma unroll
      for (int i = 0; i < 2; ++i) {
        const f32x2 t1 = {bflo(lo[i]), bfhi(lo[i])}, t2 = {bflo(hi[i]), bfhi(hi[i])};
        const float ss = half_sum((t1.x * t1.x + t1.y * t1.y) + (t2.x * t2.x + t2.y * t2.y)); const float rs = rsqrtf(ss * (1.f / 128.f) + 1e-6f);
        const f32x2 n1 = t1 * rs * kgA, n2 = t2 * rs * kgB;
        *(unsigned*)ptr[i] = cvt_pk_bf16(n1.x, n1.y); *(unsigned*)(ptr[i] + 32) = cvt_pk_bf16(n2.x, n2.y); }
    }
  }
}
__device__ __forceinline__ void attn_phase(const Params& P, unsigned char* smem, const int tid) {
  bf16_t* Q = (bf16_t*)(P.ws + OFF_Q); const bf16_t* KB = (const bf16_t*)(P.ws + OFF_KB); const bf16_t* VB = (const bf16_t*)(P.ws + OFF_VB);
  for (int u = P.bid; u < 2048; u += P.grd) {
    const int xcd = u & 7, slot = (u >> 3) & 31, rnd = u >> 8, pair = xcd + 8 * (rnd >> 2), w = (rnd & 3) * 32 + slot;
    const int b = pair >> 2, kvh = pair & 3, g = w & 3, qb = w >> 2, head = kvh * 4 + g;
    bf16_t* Qb = Q + (size_t)(b * SEQ + qb * 256) * DM + head * 128;
    const bf16_t* Kh = KB + (size_t)b * SKV * 512 + kvh * 128; const bf16_t* Vh = VB + (size_t)b * SKV * 512 + kvh * 128;
    att::attn_dense_body(Qb, Kh, Vh, Qb, SKV, (char*)smem, tid);
    __syncthreads();
  }
}
__device__ __forceinline__ void final_norm_phase(const Params& P, const int tid) {
  const int wid = tid >> 6, lane = tid & 63;
  const int gw = P.bid * 8 + wid, NGW = P.grd * 8;
  f32x4 g4[8];
#pragma unroll
  for (int j = 0; j < 8; ++j) g4[j] = *(const f32x4*)(P.norm_final + j * 256 + lane * 4);
  for (int r = gw; r < MT; r += NGW) {
    float* xr = P.out + (size_t)r * DM;
    f32x4 v[8]; float ss = 0.f;
#pragma unroll
    for (int j = 0; j < 8; ++j) v[j] = *(const f32x4*)(xr + j * 256 + lane * 4);
#pragma unroll
    for (int j = 0; j < 8; ++j) ss += v[j].x * v[j].x + v[j].y * v[j].y + v[j].z * v[j].z + v[j].w * v[j].w;
    ss = wave_sum(ss);
    const float rs = rsqrtf(ss * (1.f / DM) + 1e-6f);
#pragma unroll
    for (int j = 0; j < 8; ++j) *(f32x4*)(xr + j * 256 + lane * 4) = v[j] * rs * g4[j];
  }
}


#define XB_TMO      128
#define XB_XCNT(j)  (256  + 64 * (j))
#define XB_XSUB(j)  (1280 + 64 * (j))
#define XB_XGEN(j)  (2304 + 64 * (j))
#define XB_TOP      3328
#define XB_TOPGEN   3392
#define XCD_BAR_WORDS 3456
#define XB_SPIN_CAP (1u << 18)
__device__ __forceinline__ unsigned xb_ld(unsigned* p)              { return __hip_atomic_load(p, __ATOMIC_RELAXED, __HIP_MEMORY_SCOPE_AGENT); }
__device__ __forceinline__ unsigned xb_add(unsigned* p, unsigned v) { return __hip_atomic_fetch_add(p, v, __ATOMIC_RELAXED, __HIP_MEMORY_SCOPE_AGENT); }
__device__ __forceinline__ unsigned xb_xcc_id() { return (unsigned)__builtin_amdgcn_s_getreg((3 << 11) | 20) & 0xFu; }
#define XB_SPIN(cond, bar) do { unsigned _sp = 0; while (cond) { __builtin_amdgcn_s_sleep(1); \
    if ((++_sp & 255u) == 0u) { if (xb_ld(&(bar)[XB_TMO])) break; if (_sp > XB_SPIN_CAP) { atomicAdd(&(bar)[XB_TMO], 1u); break; } } } } while (0)
__device__ __forceinline__ void xcd_barrier_complete(unsigned* bar, unsigned x, unsigned& nloc, unsigned& nx) {
    const unsigned G = gridDim.x * gridDim.y * gridDim.z;
    unsigned sum, cnt, mine, sp = 0u;
    for (;;) {
        sum = 0u; cnt = 0u; mine = 0u;
#pragma unroll
        for (unsigned j = 0; j < 16; ++j) { const unsigned c = xb_ld(&bar[XB_XCNT(j)]); sum += c; cnt += (c > 0u) ? 1u : 0u; mine = (j == x) ? c : mine; }
        if (sum == G) break;
        __builtin_amdgcn_s_sleep(1);
        if ((++sp & 255u) == 0u) { if (xb_ld(&bar[XB_TMO])) break; if (sp > XB_SPIN_CAP) { atomicAdd(&bar[XB_TMO], 1u); break; } }
    }
    nloc = mine > 0u ? mine : 1u; nx = cnt > 0u ? cnt : 1u;
}
__device__ __forceinline__ void xcd_barrier(unsigned* bar, volatile LAS unsigned* st) {
    asm volatile("s_waitcnt vmcnt(0)" ::: "memory");
    __syncthreads();
    if (threadIdx.x == 0) {
        __builtin_amdgcn_s_waitcnt(0);
        const unsigned x = xb_xcc_id();
        unsigned nloc = st[0], nx = st[1];
        if (nloc == 0u) { xcd_barrier_complete(bar, x, nloc, nx); st[0] = nloc; st[1] = nx; }
        const unsigned old = xb_add(&bar[XB_XSUB(x)], 1u);
        const unsigned gen = old / nloc;
        if (old + 1u == (gen + 1u) * nloc) {
            __builtin_amdgcn_fence(__ATOMIC_RELEASE, "agent");
            asm volatile("s_waitcnt vmcnt(0)" ::: "memory");
            const unsigned og = xb_add(&bar[XB_TOP], 1u);
            const unsigned tg = og / nx;
            if (og + 1u == (tg + 1u) * nx) xb_add(&bar[XB_TOPGEN], 1u);
            else XB_SPIN(xb_ld(&bar[XB_TOPGEN]) == tg, bar);
            __builtin_amdgcn_fence(__ATOMIC_ACQUIRE, "agent");
            xb_add(&bar[XB_XGEN(x)], 1u);
            asm volatile("s_waitcnt vmcnt(0)" ::: "memory");
        } else {
            XB_SPIN(xb_ld(&bar[XB_XGEN(x)]) == gen, bar);
            __builtin_amdgcn_fence(__ATOMIC_ACQUIRE, "agent");
            asm volatile("s_waitcnt vmcnt(0)" ::: "memory");
        }
    }
    __syncthreads();
}

constexpr int NPH = 20;
__device__ __forceinline__ bool gemm_desc(int ph, const Params& P, GemmDesc& d) {
  unsigned char* ws = P.ws;
  const bf16_t* H = (const bf16_t*)(ws + OFF_H);
  d.nt0 = 0; d.nt1 = 0; d.ksplit1 = 1; d.G = P.grd; d.c = P.bid; d.A1 = nullptr; d.B1 = nullptr; d.pm01 = 0; d.nN1 = 1; d.n1 = 0; d.pm00 = 0; d.xin = nullptr; d.gidx = 0; d.gscale = 0.f; d.act = nullptr;
  switch (ph) {
  case 2: d.K = 2048; d.mode = M_SWIGLU; d.A0 = H; d.B0 = (const bf16_t*)(ws + OFF_W1A); d.nM0 = 132; d.nN0 = 44; d.act = (bf16_t*)(ws + OFF_ACT); break;
  case 3: d.K = DFF; d.mode = M_RESID; d.A0 = (const bf16_t*)(ws + OFF_ACT); d.B0 = (const bf16_t*)(ws + OFF_W1B); d.nM0 = 128; d.nN0 = 8; d.xin = P.x; d.gidx = 2; d.gscale = 0.5f;
          d.A1 = d.A0; d.B1 = d.B0; d.pm01 = 128; d.nN1 = 8; d.ksplit1 = 4; d.nt1 = 22; d.n1 = 4 * 8 * 4; break;
  case 5: d.K = 2048; d.mode = M_RW; d.A0 = H; d.B0 = (const bf16_t*)(ws + OFF_WRW); d.nM0 = 132; d.nN0 = 14;
          d.A1 = H; d.B1 = (const bf16_t*)(ws + OFF_WQKVG) + (size_t)2048 * 2048; d.pm01 = 128; d.nN1 = 4; d.n1 = 16; break;
  case 7: d.K = 384; d.mode = M_LORA; d.A0 = (const bf16_t*)(ws + OFF_LIN); d.B0 = (const bf16_t*)(ws + OFF_WLORA); d.nM0 = 132; d.nN0 = 20; break;
  case 10: d.K = 2048; d.mode = M_QKVG; d.A0 = H; d.B0 = (const bf16_t*)(ws + OFF_WQKVG); d.nM0 = 128; d.nN0 = 28; break;
  case 13: d.K = 2048; d.mode = M_T1; d.A0 = (const bf16_t*)(ws + OFF_Q); d.B0 = (const bf16_t*)(ws + OFF_WOA); d.nM0 = 128; d.nN0 = 8; break;
  case 14: d.K = 1024; d.mode = M_M; d.A0 = (const bf16_t*)(ws + OFF_Y); d.B0 = (const bf16_t*)(ws + OFF_WOR); d.nM0 = 128; d.nN0 = 8; break;
  case 15: d.K = 2048; d.mode = M_RESID; d.A0 = (const bf16_t*)(ws + OFF_GR); d.B0 = (const bf16_t*)(ws + OFF_WOUT); d.nM0 = 128; d.nN0 = 8; d.xin = P.out; d.gidx = 5; d.gscale = 1.f; break;
  case 17: d.K = 2048; d.mode = M_SWIGLU; d.A0 = H; d.B0 = (const bf16_t*)(ws + OFF_W2A); d.nM0 = 128; d.nN0 = 44; d.act = (bf16_t*)(ws + OFF_ACT); break;
  case 18: d.K = DFF; d.mode = M_RESID; d.A0 = (const bf16_t*)(ws + OFF_ACT); d.B0 = (const bf16_t*)(ws + OFF_W2B); d.nM0 = 128; d.nN0 = 8; d.xin = P.out; d.gidx = 8; d.gscale = 0.5f; break;
  default: return false;
  }
  d.n0 = d.nM0 * d.nN0;
  if (!d.nt0) d.nt0 = d.K / BK;
  if (!d.nt1) d.nt1 = d.K / BK;
  if (d.mode == M_LORA) d.nt0 = 2;
  return true;
}

__global__ void __launch_bounds__(512) mega_fwd(Params P) {
  extern __shared__ __attribute__((aligned(16))) unsigned char smem[];
  LAS unsigned char* lds = (LAS unsigned char*)smem;
  cg::grid_group grid = cg::this_grid();
  volatile LAS unsigned* bst = (volatile LAS unsigned*)(lds + LDS_BYTES + 192);
  unsigned* gbar = (unsigned*)(P.ws + OFF_BAR);
#if ONE_LAUNCH
  if (threadIdx.x == 0) { bst[0] = 0u; bst[1] = 0u; (void)xb_add(&gbar[XB_XCNT(xb_xcc_id())], 1u); }
  __syncthreads();
#endif
#pragma nounroll
  for (int ph = P.ph_lo; ph < P.ph_hi; ++ph) {
    GemmDesc d;
    int tid = threadIdx.x; asm volatile("" : "+v"(tid));
#if PROBE
    if (blockIdx.x == 0 && tid == 0) ((LAS unsigned long long*)(lds + LDS_BYTES))[ph] = __builtin_amdgcn_s_memrealtime();
#endif
    const __attribute__((address_space(4))) Params* kp = (const __attribute__((address_space(4))) Params*)__builtin_amdgcn_kernarg_segment_ptr();
    asm volatile("" : "+s"(kp));
#if defined(__HIP_DEVICE_COMPILE__)
    Params L = *kp;
#else
    Params L = P;
#endif
    { int b_ = blockIdx.x, g_ = gridDim.x; asm volatile("" : "+s"(b_), "+s"(g_)); L.bid = b_; L.grd = g_; }
    if (gemm_desc(ph, L, d)) gemm_phase(lds, d, L, tid);
    else switch (ph) {
      case 0: mod_phase(L, lds, tid); __syncthreads(); convert_phase(L, lds, tid); break;
      case 1: norm_mod_phase(L, L.x, L.ctx, MA, L.norm_ffn1, 0, nullptr, tid); break;
      case 4: norm_mod_phase(L, L.out, L.ctx, MA, L.norm_mix, 3, (const float*)(L.ws + OFF_PART), tid); break;
      case 6: shift_phase(L, tid); break;
      case 8: scan_phase(L, lds, tid); break;
      case 9: rwkv_out_phase(L, tid); break;
      case 11: rope_phase(L, tid); break;
      case 12: attn_phase(L, smem, tid); break;
      case 16: norm_mod_phase(L, L.out, nullptr, MT, L.norm_ffn2, 6, nullptr, tid); break;
      case 19: final_norm_phase(L, tid); break;
      default: break;
    }
    if (ph + 1 < P.ph_hi) { if (ph == 0) grid.sync(); else if (ph != 13 || !ONE_LAUNCH) xcd_barrier(gbar, bst); }
  }
#if PROBE
  grid.sync();
  if (blockIdx.x == 0) {
    LAS unsigned long long* TS = (LAS unsigned long long*)(lds + LDS_BYTES);
    if (threadIdx.x == 0) TS[NPH] = __builtin_amdgcn_s_memrealtime();
    __syncthreads();
    const int K = (int)((TS[PROBE_HI] - TS[PROBE_LO]) / 100ull);
    int t2 = threadIdx.x; asm volatile("" : "+v"(t2));
    for (int i = t2; i < K && i < 16000; i += 512) P.out[(size_t)i * 4099] += 0.1f;
  }
#endif
}

extern "C" void kernel_launch(void* const* d_in, const int* in_sizes, int n_in, void* d_out, int out_size, void* d_ws, size_t ws_size, hipStream_t stream) {
  static int grid_blocks = 0;
  if (!grid_blocks) {
    if (n_in != 31 || out_size != MT * DM || ws_size < WS_TOTAL) { fprintf(stderr, "kernel_launch: unexpected shapes n_in %d out %d ws %zu (need %zu)\n", n_in, out_size, ws_size, WS_TOTAL); return; }
    if (hipFuncSetAttribute((const void*)mega_fwd, hipFuncAttributeMaxDynamicSharedMemorySize, LDS_BYTES + 256) != hipSuccess) { fprintf(stderr, "kernel_launch: hipFuncSetAttribute failed\n"); return; }
    int dev = 0, cus = 0, per_cu = 0;
    hipGetDevice(&dev);
    hipDeviceGetAttribute(&cus, hipDeviceAttributeMultiprocessorCount, dev);
    hipOccupancyMaxActiveBlocksPerMultiprocessor(&per_cu, mega_fwd, 512, LDS_BYTES + 256);
    if (per_cu < 1) { fprintf(stderr, "kernel_launch: occupancy query returned %d\n", per_cu); per_cu = 1; }
    grid_blocks = cus;
  }
  Params p{};
  const float** pf = (const float**)&p;
  for (int i = 0; i < 31; ++i) pf[i] = (const float*)d_in[i];
  p.out = (float*)d_out; p.ws = (unsigned char*)d_ws; p.bid = 0; p.grd = 0;
#if ONE_LAUNCH
  p.ph_lo = 0; p.ph_hi = NPH;
  if (hipMemsetAsync((char*)d_ws + OFF_BAR, 0, 3456 * 4, stream) != hipSuccess) { fprintf(stderr, "kernel_launch: memset of barrier words failed\n"); return; }
  void* args[] = {&p};
  hipError_t e = hipLaunchCooperativeKernel((const void*)mega_fwd, dim3(grid_blocks), dim3(512), args, LDS_BYTES + 256, stream);
  if (e != hipSuccess) fprintf(stderr, "cooperative launch failed: %s (grid %d)\n", hipGetErrorString(e), grid_blocks);
#else
  for (int ph = 0; ph < NPH; ++ph) { p.ph_lo = ph; p.ph_hi = ph + 1; hipLaunchKernelGGL(mega_fwd, dim3(grid_blocks), dim3(512), LDS_BYTES + 256, stream, p); }
#endif
}
```

```cpp
#include <hip/hip_runtime.h>
#include <hip/hip_cooperative_groups.h>
#include <cstdio>
#include <cstdint>
namespace cg = cooperative_groups;

#ifndef ONE_LAUNCH
#define ONE_LAUNCH 1
#endif

#ifndef PROBE
#define PROBE 0
#endif
#define PROBE_LO 8
#define PROBE_HI 9
#define LAS __attribute__((address_space(3)))
typedef unsigned short bf16_t;
typedef short bf16x8 __attribute__((ext_vector_type(8)));
typedef short s16x4 __attribute__((ext_vector_type(4)));
typedef float f32x4 __attribute__((ext_vector_type(4)));
typedef float f32x2 __attribute__((ext_vector_type(2)));
typedef float f32x16 __attribute__((ext_vector_type(16)));
typedef unsigned u32x4 __attribute__((ext_vector_type(4)));
typedef unsigned u32x2 __attribute__((ext_vector_type(2)));

constexpr int DM = 2048, NB = 4, SEQ = 8192, CTXL = 256, MT = NB * SEQ, MC = NB * CTXL, MA = MT + MC;
constexpr int DFF = 5632, SKV = SEQ + CTXL, NMODC = 9 * DM;
constexpr int PRW_LD = 3584, SH_LD = 3072, LIN_LD = 384, LO_LD = 5120;
constexpr int LDS_BYTES = 131072;

constexpr size_t SZ_WA = (size_t)11264 * 2048 * 2, SZ_WB = (size_t)2048 * 5632 * 2;
constexpr size_t OFF_W1A = 0, OFF_W1B = OFF_W1A + SZ_WA, OFF_W2A = OFF_W1B + SZ_WB, OFF_W2B = OFF_W2A + SZ_WA;
constexpr size_t OFF_WRW = OFF_W2B + SZ_WB, OFF_WQKVG = OFF_WRW + (size_t)3584 * 2048 * 2, OFF_WOA = OFF_WQKVG + (size_t)7168 * 2048 * 2;
constexpr size_t OFF_WOR = OFF_WOA + (size_t)2048 * 2048 * 2, OFF_WOUT = OFF_WOR + (size_t)2048 * 1024 * 2, OFF_WLORA = OFF_WOUT + (size_t)2048 * 2048 * 2;
constexpr size_t OFF_MOD = OFF_WLORA + (size_t)5120 * 384 * 2, OFF_CX = OFF_MOD + (size_t)5 * NMODC * 4, OFF_H = OFF_CX + (size_t)MC * DM * 4;
constexpr size_t OFF_BIG = OFF_H + (size_t)MA * DM * 2;
constexpr size_t SZ_KV = (size_t)NB * SKV * 512 * 2;
constexpr size_t OFF_KB = OFF_W1A, OFF_VB = OFF_KB + SZ_KV;
static_assert(OFF_VB + SZ_KV <= OFF_W2A, "KV overlay");
constexpr size_t OFF_ACT = OFF_BIG;
constexpr size_t OFF_PART = OFF_ACT + (size_t)MA * DFF * 2;
constexpr size_t OFF_PRW = OFF_BIG, OFF_LO = OFF_BIG, OFF_SH = OFF_LO + (size_t)MA * LO_LD * 2, OFF_LIN = OFF_SH + (size_t)MA * SH_LD * 2, OFF_Y = OFF_LIN;
constexpr size_t OFF_Q = OFF_BIG, OFF_GA = OFF_Q + (size_t)MT * DM * 2, OFF_GR = OFF_GA + (size_t)MT * DM * 2;
constexpr size_t END_A = OFF_ACT + (size_t)MA * DFF * 2, END_B = OFF_Y + (size_t)2 * MT * 1024 * 2, END_C = OFF_LIN + (size_t)MA * LIN_LD * 2;
constexpr size_t WS_END = END_A > END_B ? (END_A > END_C ? END_A : END_C) : (END_B > END_C ? END_B : END_C);
constexpr size_t OFF_BAR = (WS_END + 255) / 256 * 256, WS_TOTAL = OFF_BAR + 3456 * 4;
static_assert((size_t)MA * PRW_LD * 2 <= (size_t)MA * LO_LD * 2, "PRW under LO");
static_assert(OFF_GR + (size_t)MT * DM * 2 <= OFF_Y, "GR below RWO");

struct Params {
  const float *x, *c, *ctx, *c_ctx, *w_mod, *b_mod, *norm_ffn1, *ffn1_w_in, *ffn1_w_out, *norm_mix, *w_in, *q_norm, *k_norm, *rwkv_mu, *w0, *w2, *a0, *a2,
      *g2, *k_k, *k_a, *r_k, *ln_x_w, *ln_x_b, *w_oa, *w_or, *w_out, *norm_ffn2, *ffn2_w_in, *ffn2_w_out, *norm_final;
  float* out; unsigned char* ws; int ph_lo, ph_hi; int bid, grd;
};

__device__ __forceinline__ unsigned cvt_pk_bf16(float lo, float hi) { unsigned r; asm("v_cvt_pk_bf16_f32 %0, %1, %2" : "=v"(r) : "v"(lo), "v"(hi)); return r; }
__device__ __forceinline__ float bf2f(unsigned short b) { return __uint_as_float(((unsigned)b) << 16); }
__device__ __forceinline__ float bflo(unsigned w) { return __uint_as_float(w << 16); }
__device__ __forceinline__ float bfhi(unsigned w) { return __uint_as_float(w & 0xffff0000u); }
__device__ __forceinline__ unsigned short f2bf(float f) { return (unsigned short)(cvt_pk_bf16(f, 0.f) & 0xffffu); }
__device__ __forceinline__ float sigmoidf_(float x) { return __builtin_amdgcn_rcpf(1.f + __builtin_amdgcn_exp2f(-1.4426950408889634f * x)); }
template <int CTRL> __device__ __forceinline__ float dpp_mov(float x) { return __int_as_float(__builtin_amdgcn_update_dpp(0, __float_as_int(x), CTRL, 0xF, 0xF, true)); }
__device__ __forceinline__ float allred16(float x) {
  x += dpp_mov<0xB1>(x); x += dpp_mov<0x4E>(x); x += dpp_mov<0x141>(x); x += dpp_mov<0x140>(x); return x;
}

__device__ __forceinline__ float wave_sum(float v) {
  v = allred16(v);
  { auto rr = __builtin_amdgcn_permlane16_swap(__float_as_uint(v), __float_as_uint(v), false, false); v = __uint_as_float(rr[0]) + __uint_as_float(rr[1]); }
  { auto rr = __builtin_amdgcn_permlane32_swap(__float_as_uint(v), __float_as_uint(v), false, false); v = __uint_as_float(rr[0]) + __uint_as_float(rr[1]); }
  return v;
}

constexpr int BM = 256, BK = 64, HALF = 128, HTB = HALF * BK * 2;
__device__ __forceinline__ int lds_byte(int r, int c) { const int st = (r >> 4) * 2 + (c >> 5), rr = r & 15, cc = c & 31, ob = rr * 64 + cc * 2; return st * 1024 + (ob ^ (((ob >> 9) & 1) << 5)); }
__device__ __forceinline__ void stage_rc(int b, int& R, int& C) { const int st = b / 1024, sb = b % 1024, swz = sb ^ (((sb >> 9) & 1) << 5); R = (st >> 1) * 16 + swz / 64; C = (st & 1) * 32 + (swz % 64) / 2; }
__device__ __forceinline__ int perm32(int rho) { const int n = rho >> 4, i = rho & 15; return 8 * (i >> 2) + 4 * n + (i & 3); }

enum { M_SWIGLU = 0, M_RESID = 1, M_RW = 2, M_QKVG = 3, M_LORA = 4, M_T1 = 5, M_M = 6 };
struct Unit { const char* A; const char* B; int pm, pn, seg, nt; };
struct GemmDesc {
  int K, mode, G, c;
  const bf16_t *A0, *B0; int pm00, nM0, nN0, n0;
  const bf16_t *A1, *B1; int pm01, nN1, n1;
  int a_tiled;
  int nt0, nt1, ksplit1;
  const float* xin; int gidx; float gscale;
  bf16_t* act;
};
__device__ __forceinline__ bool sched_next(const GemmDesc& d, int i, Unit& u) {
  long L = (long)i * d.G + d.c;
  if (L < d.n0) {
    int wgid = (int)L; const int nwg = d.n0;
    { const int q = nwg / 8, r = nwg % 8, xcd = wgid % 8, off = wgid / 8; wgid = (xcd < r ? xcd * (q + 1) : r * (q + 1) + (xcd - r) * q) + off; }
    const int nig = 8 * d.nN0, gid = wgid / nig, fm = gid * 8, gsz = (d.nM0 - fm) < 8 ? (d.nM0 - fm) : 8;
    const int pm = fm + ((wgid % nig) % gsz), pn = (wgid % nig) / gsz;
    u.pm = d.pm00 + pm; u.pn = pn; u.seg = 0; u.nt = d.nt0;
    u.A = (const char*)d.A0 + (size_t)u.pm * 512 * d.K; u.B = (const char*)d.B0 + (size_t)pn * 512 * d.K;
    if (d.mode == M_LORA) { const int ko = (pn < 8 ? 0 : (pn < 16 ? 128 : 256)) * 2; u.A += ko; u.B += ko; }
    return true;
  }
  L -= d.n0;
  if (L < d.n1) {
    const int sp = (int)L % d.ksplit1, l2 = (int)L / d.ksplit1;
    const int pm = l2 / d.nN1, pn = l2 % d.nN1; u.pm = d.pm01 + pm; u.pn = pn; u.seg = 1 + sp; u.nt = d.nt1;
    const size_t ko = (size_t)sp * d.nt1 * 128, koA = d.a_tiled ? (size_t)sp * d.nt1 * 32768 : ko;
    u.A = (const char*)d.A1 + (size_t)u.pm * 512 * d.K + koA; u.B = (const char*)d.B1 + (size_t)pn * 512 * d.K + ko; return true;
  }
  return false;
}

__device__ __forceinline__ void gemm_epilogue(const f32x4 (&acc)[2][2][4][2], const Unit& u, const GemmDesc& d, const Params& P, int wr, int wc, int fr, int fq) {
  unsigned char* ws = P.ws;
  asm volatile("" : "+v"(fr), "+v"(fq));
  const int rl0 = wr * 64 + fr, cl0 = wc * 32 + 8 * fq;
  switch (d.mode) {
  case M_SWIGLU: {
    bf16_t* base = d.act + ((size_t)(u.pm * 88 + u.pn * 2 + (cl0 >> 6)) * 256) * 64 + (cl0 & 63);
#pragma unroll
    for (int ai = 0; ai < 2; ++ai)
#pragma unroll
      for (int m = 0; m < 4; ++m) {
        const int row = rl0 + 128 * ai + 16 * m;
        float o[8];
#pragma unroll
        for (int n = 0; n < 2; ++n)
#pragma unroll
          for (int j = 0; j < 4; ++j) { const float g = acc[ai][0][m][n][j], up = acc[ai][1][m][n][j]; o[4 * n + j] = g * sigmoidf_(g) * up; }
        u32x4 w; w.x = cvt_pk_bf16(o[0], o[1]); w.y = cvt_pk_bf16(o[2], o[3]); w.z = cvt_pk_bf16(o[4], o[5]); w.w = cvt_pk_bf16(o[6], o[7]);
        *(u32x4*)(base + (size_t)row * 64) = w;
      }
  } break;
  case M_RESID: {
    if (u.seg >= 1) {
      float* po = (float*)(ws + OFF_PART) + (size_t)(u.seg - 1) * MC * DM + (size_t)(u.pm - 128) * 256 * DM + u.pn * 256 + cl0;
#pragma unroll
      for (int ai = 0; ai < 2; ++ai)
#pragma unroll
        for (int m = 0; m < 4; ++m)
#pragma unroll
          for (int bj = 0; bj < 2; ++bj)
#pragma unroll
            for (int n = 0; n < 2; ++n) *(f32x4*)(po + (size_t)(rl0 + 128 * ai + 16 * m) * DM + 128 * bj + 4 * n) = acc[ai][bj][m][n];
      break;
    }
    const bool isc = u.pm >= 128; const int b = isc ? 4 : (u.pm >> 5);
    const float* xin = isc ? P.ctx + (size_t)(u.pm - 128) * 256 * DM : d.xin + (size_t)u.pm * 256 * DM;
    float* xo = isc ? (float*)(ws + OFF_CX) + (size_t)(u.pm - 128) * 256 * DM : P.out + (size_t)u.pm * 256 * DM;
    const float* gate = (const float*)(ws + OFF_MOD) + b * NMODC + d.gidx * DM + u.pn * 256 + cl0;
    f32x4 g4[2][2];
#pragma unroll
    for (int bj = 0; bj < 2; ++bj)
#pragma unroll
      for (int n = 0; n < 2; ++n) g4[bj][n] = *(const f32x4*)(gate + 128 * bj + 4 * n) * d.gscale;
#pragma unroll
    for (int ai = 0; ai < 2; ++ai)
#pragma unroll
      for (int m = 0; m < 4; ++m) {
        const size_t ro = (size_t)(rl0 + 128 * ai + 16 * m) * DM + u.pn * 256 + cl0;
#pragma unroll
        for (int bj = 0; bj < 2; ++bj)
#pragma unroll
          for (int n = 0; n < 2; ++n) {
            const f32x4 xv = *(const f32x4*)(xin + ro + 128 * bj + 4 * n);
            *(f32x4*)(xo + ro + 128 * bj + 4 * n) = xv + g4[bj][n] * acc[ai][bj][m][n];
          }
      }
  } break;
  case M_RW: case M_QKVG: case M_LORA: {
    bf16_t* base; int ld; int act = 0; const float* bias = nullptr;
    if (d.mode == M_RW) {
      if (u.seg == 0) { base = (bf16_t*)(ws + OFF_PRW) + (size_t)u.pm * 256 * PRW_LD + u.pn * 256; ld = PRW_LD; }
      else { const int b = u.pm - 128; base = (bf16_t*)(ws + (u.pn < 2 ? OFF_KB : OFF_VB)) + (size_t)(b * SKV + SEQ) * 512 + (u.pn & 1) * 256; ld = 512; }
    } else if (d.mode == M_QKVG) {
      const int b = u.pm >> 5;
      if (u.pn < 8) { base = (bf16_t*)(ws + OFF_Q) + (size_t)u.pm * 256 * DM + u.pn * 256; ld = DM; }
      else if (u.pn < 12) { base = (bf16_t*)(ws + (u.pn < 10 ? OFF_KB : OFF_VB)) + (size_t)(u.pm * 256 + b * CTXL) * 512 + (u.pn & 1) * 256; ld = 512; }
      else { base = (bf16_t*)(ws + (u.pn < 20 ? OFF_GA : OFF_GR)) + (size_t)u.pm * 256 * DM + ((u.pn - 12) & 7) * 256; ld = DM; act = 1; }
    } else {
      base = (bf16_t*)(ws + OFF_LO) + (size_t)u.pm * 256 * LO_LD + u.pn * 256; ld = LO_LD;
      if (u.pn < 8) { act = 2; bias = P.w0 + u.pn * 256; } else if (u.pn < 16) { act = 1; bias = P.a0 + (u.pn - 8) * 256; }
    }
#pragma unroll
    for (int bj = 0; bj < 2; ++bj) {
      f32x4 b0 = {0.f, 0.f, 0.f, 0.f}, b1 = {0.f, 0.f, 0.f, 0.f};
      if (bias) { b0 = *(const f32x4*)(bias + 128 * bj + cl0); b1 = *(const f32x4*)(bias + 128 * bj + cl0 + 4); }
#pragma unroll
      for (int ai = 0; ai < 2; ++ai)
#pragma unroll
        for (int m = 0; m < 4; ++m) {
          const int row = rl0 + 128 * ai + 16 * m;
          f32x4 v0 = acc[ai][bj][m][0] + b0, v1 = acc[ai][bj][m][1] + b1;
          if (act) {
            const float sc = act == 2 ? 0.60653065971263342f * 1.4426950408889634f : 1.f;
#pragma unroll
            for (int j = 0; j < 4; ++j) { v0[j] = sc * sigmoidf_(v0[j]); v1[j] = sc * sigmoidf_(v1[j]); }
          }
          u32x4 w; w.x = cvt_pk_bf16(v0[0], v0[1]); w.y = cvt_pk_bf16(v0[2], v0[3]); w.z = cvt_pk_bf16(v1[0], v1[1]); w.w = cvt_pk_bf16(v1[2], v1[3]);
          *(u32x4*)(base + (size_t)row * ld + 128 * bj + cl0) = w;
        }
    }
  } break;
  case M_T1: case M_M: {
    bf16_t* ga = (bf16_t*)(ws + OFF_GA) + (size_t)u.pm * 256 * DM + u.pn * 256 + cl0;
    bf16_t* gr = (bf16_t*)(ws + OFF_GR) + (size_t)u.pm * 256 * DM + u.pn * 256 + cl0;
    const bool isM = d.mode == M_M;
#pragma unroll
    for (int ai = 0; ai < 2; ++ai)
#pragma unroll
      for (int m = 0; m < 4; ++m)
#pragma unroll
        for (int bj = 0; bj < 2; ++bj) {
          const size_t o = (size_t)(rl0 + 128 * ai + 16 * m) * DM + 128 * bj;
          const f32x4 v0 = acc[ai][bj][m][0], v1 = acc[ai][bj][m][1];
          const u32x4 a = *(const u32x4*)(ga + o);
          u32x4 w;
          if (!isM) {
            w.x = cvt_pk_bf16(bflo(a.x) * v0[0], bfhi(a.x) * v0[1]); w.y = cvt_pk_bf16(bflo(a.y) * v0[2], bfhi(a.y) * v0[3]);
            w.z = cvt_pk_bf16(bflo(a.z) * v1[0], bfhi(a.z) * v1[1]); w.w = cvt_pk_bf16(bflo(a.w) * v1[2], bfhi(a.w) * v1[3]);
            *(u32x4*)(ga + o) = w;
          } else {
            const u32x4 g = *(const u32x4*)(gr + o);
            w.x = cvt_pk_bf16(bflo(a.x) + bflo(g.x) * v0[0], bfhi(a.x) + bfhi(g.x) * v0[1]); w.y = cvt_pk_bf16(bflo(a.y) + bflo(g.y) * v0[2], bfhi(a.y) + bfhi(g.y) * v0[3]);
            w.z = cvt_pk_bf16(bflo(a.z) + bflo(g.z) * v1[0], bfhi(a.z) + bfhi(g.z) * v1[1]); w.w = cvt_pk_bf16(bflo(a.w) + bflo(g.w) * v1[2], bfhi(a.w) + bfhi(g.w) * v1[3]);
            *(u32x4*)(gr + o) = w;
          }
        }
  } break;
  }
}

__device__ __forceinline__ void gemm_phase(LAS unsigned char* lds, const GemmDesc& d, const Params& P, const int tid) {
  const int wid = __builtin_amdgcn_readfirstlane(tid >> 6), lane = tid & 63, wr = wid >> 2, wc = wid & 3, fr = lane & 15, fq = lane >> 4;
  const int K = d.K;
  unsigned voffA[2], voffB[2];
#pragma unroll
  for (int i = 0; i < 2; ++i) { int R, C; stage_rc(tid * 16 + i * 8192, R, C); const int Rb = (R & ~31) + perm32(R & 31);
    voffA[i] = d.a_tiled ? (unsigned)(R * 64 + C) * 2u : (unsigned)(R * K + C) * 2u; voffB[i] = (unsigned)(Rb * K + C) * 2u; }
  const size_t kstep = (size_t)(BK * 2);
  const size_t hstep = (size_t)HALF * K * 2;
  const size_t kstepA = d.a_tiled ? (size_t)32768 : kstep, hstepA = d.a_tiled ? (size_t)16384 : hstep;
  const unsigned ldsw = (unsigned)wid * 1024u;
  const int aoff = lds_byte(wr * 64 + fr, fq * 8), boff = lds_byte(wc * 32 + fr, fq * 8);
#define PG8_SA(b, h) (((b) * 2 + (h)) * HTB)
#define PG8_SB(b, h) ((4 + (b) * 2 + (h)) * HTB)
#define PG8_STAGE(bufoff, gbase, voff) do { _Pragma("unroll") for (int _i = 0; _i < 2; ++_i) \
    __builtin_amdgcn_global_load_lds((const unsigned*)((const char*)(gbase) + (voff)[_i]), (LAS unsigned*)(lds + (bufoff) + ldsw + _i * 8192), 16, 0, 0); } while (0)
#define PG8_LDA(dst, b, h) do { _Pragma("unroll") for (int m = 0; m < 4; ++m) _Pragma("unroll") for (int k = 0; k < 2; ++k) dst[m][k] = *(const LAS bf16x8*)(lds + PG8_SA(b, h) + aoff + m * 2048 + k * 1024); } while (0)
#define PG8_LDB(dst, b, h) do { _Pragma("unroll") for (int n = 0; n < 2; ++n) _Pragma("unroll") for (int k = 0; k < 2; ++k) dst[n][k] = *(const LAS bf16x8*)(lds + PG8_SB(b, h) + boff + n * 2048 + k * 1024); } while (0)
#define PG8_MMA(ai, bj, At, Bt) do { __builtin_amdgcn_s_setprio(1); _Pragma("unroll") for (int m = 0; m < 4; ++m) _Pragma("unroll") for (int n = 0; n < 2; ++n) _Pragma("unroll") for (int k = 0; k < 2; ++k) \
    acc[ai][bj][m][n] = __builtin_amdgcn_mfma_f32_16x16x32_bf16(Bt[n][k], At[m][k], acc[ai][bj][m][n], 0, 0, 0); __builtin_amdgcn_s_setprio(0); } while (0)
#define PG8_WAIT_V(n) asm volatile("s_waitcnt vmcnt(" #n ")" ::: "memory")
#define PG8_WAIT_L(n) asm volatile("s_waitcnt lgkmcnt(" #n ")" ::: "memory")
#define PG8_BAR __builtin_amdgcn_s_barrier()
#define PG8_SCHED __builtin_amdgcn_sched_barrier(0)
  Unit cur, nxt; int ui = 0;
  if (!sched_next(d, 0, cur)) return;
  f32x4 acc[2][2][4][2];
#pragma unroll
  for (int a = 0; a < 2; ++a)
#pragma unroll
    for (int b = 0; b < 2; ++b)
#pragma unroll
      for (int m = 0; m < 4; ++m)
#pragma unroll
        for (int n = 0; n < 2; ++n) acc[a][b][m][n] = (f32x4){0.f, 0.f, 0.f, 0.f};
  bf16x8 At[4][2], B0[2][2], B1[2][2];
  const char* cA = cur.A; const char* cB = cur.B;
  PG8_STAGE(PG8_SB(0, 0), cB, voffB); PG8_STAGE(PG8_SB(0, 1), cB + hstep, voffB); PG8_STAGE(PG8_SA(0, 0), cA, voffA); PG8_STAGE(PG8_SA(0, 1), cA + hstepA, voffA);
  if (wr == 1) PG8_BAR;
  PG8_WAIT_V(2); PG8_BAR;
  PG8_STAGE(PG8_SB(1, 0), cB + kstep, voffB); PG8_STAGE(PG8_SA(1, 0), cA + kstepA, voffA); PG8_STAGE(PG8_SB(1, 1), cB + hstep + kstep, voffB);
  PG8_WAIT_V(6); PG8_BAR;
  for (;;) {
    const bool has_next = sched_next(d, ui + 1, nxt);
    const char* nA = has_next ? nxt.A : cA; const char* nB = has_next ? nxt.B : cB;
    const int nt = cur.nt;
    for (int t = 0; t < nt; t += 2) {
      const bool last = (t == nt - 2);
      const char* a1 = cA + (size_t)(t + 1) * kstepA;
      const char* a2 = last ? nA : cA + (size_t)(t + 2) * kstepA; const char* b2 = last ? nB : cB + (size_t)(t + 2) * kstep;
      const char* a3 = a2 + kstepA; const char* b3 = b2 + kstep;
      PG8_LDB(B0, 0, 0); PG8_LDB(B1, 0, 1); PG8_SCHED; PG8_LDA(At, 0, 0); PG8_STAGE(PG8_SA(1, 1), a1 + hstepA, voffA);
      PG8_WAIT_V(8); PG8_WAIT_L(0); PG8_BAR; PG8_MMA(0, 0, At, B0); PG8_MMA(0, 1, At, B1); PG8_BAR; PG8_SCHED;
      PG8_LDA(At, 0, 1); PG8_STAGE(PG8_SB(0, 0), b2, voffB); PG8_STAGE(PG8_SB(0, 1), b2 + hstep, voffB); PG8_STAGE(PG8_SA(0, 0), a2, voffA);
      PG8_WAIT_V(8); PG8_WAIT_L(0); PG8_BAR; PG8_MMA(1, 0, At, B0); PG8_MMA(1, 1, At, B1); PG8_BAR; PG8_SCHED;
      PG8_LDB(B0, 1, 0); PG8_LDB(B1, 1, 1); PG8_SCHED; PG8_LDA(At, 1, 0); PG8_STAGE(PG8_SA(0, 1), a2 + hstepA, voffA);
      PG8_WAIT_V(8); PG8_WAIT_L(0); PG8_BAR; PG8_MMA(0, 0, At, B0); PG8_MMA(0, 1, At, B1); PG8_BAR; PG8_SCHED;
      PG8_LDA(At, 1, 1); PG8_STAGE(PG8_SB(1, 0), b3, voffB); PG8_STAGE(PG8_SB(1, 1), b3 + hstep, voffB); PG8_STAGE(PG8_SA(1, 0), a3, voffA);
      PG8_WAIT_V(8); PG8_WAIT_L(0); PG8_BAR; PG8_MMA(1, 0, At, B0); PG8_MMA(1, 1, At, B1); PG8_BAR; PG8_SCHED;
    }
    if (wr == 0) PG8_BAR;
    gemm_epilogue(acc, cur, d, P, wr, wc, fr, fq);
    if (!has_next) break;
#pragma unroll
    for (int a = 0; a < 2; ++a)
#pragma unroll
      for (int b = 0; b < 2; ++b)
#pragma unroll
        for (int m = 0; m < 4; ++m)
#pragma unroll
          for (int n = 0; n < 2; ++n) acc[a][b][m][n] = (f32x4){0.f, 0.f, 0.f, 0.f};
    cur = nxt; cA = nA; cB = nB; ++ui;
    if (wr == 1) PG8_BAR;
  }
  PG8_WAIT_V(0);
  PG8_BAR;
#undef PG8_SA
#undef PG8_SB
#undef PG8_STAGE
#undef PG8_LDA
#undef PG8_LDB
#undef PG8_MMA
#undef PG8_WAIT_V
#undef PG8_WAIT_L
#undef PG8_BAR
#undef PG8_SCHED
}

namespace att {
constexpr int D = 128, NW = 8, QBLK = 32, KVBLK = 64;
constexpr float SCALE = 0.088388347648318440f;
constexpr float THR = 8.f;
constexpr int LDQ = 2048, LDK = 512, LDO = 2048;
constexpr size_t SHM_V = KVBLK * D * 2, SHM_K = KVBLK * D * 2;
#define KSWZ(row, colB) ((row) * 256 + ((colB) ^ (((row) & 7) << 4)))
#define SBAR() __builtin_amdgcn_sched_barrier(0)
__device__ __forceinline__ int crow(int r, int hi) { return (r & 3) + 8 * (r >> 2) + 4 * hi; }
__device__ __forceinline__ unsigned cvtpk(float lo, float hi) { unsigned r; asm volatile("v_cvt_pk_bf16_f32 %0, %1, %2" : "=v"(r) : "v"(lo), "v"(hi)); return r; }
__device__ __forceinline__ void partialSM(f32x16& p0, f32x16& p1, float& m_reg, float& mn, float& alpha) {
  constexpr float C = SCALE * 1.4426950408889634f;
  float pmax = p0[0];
#pragma unroll
  for (int r = 1; r < 16; ++r) pmax = fmaxf(pmax, p0[r]);
#pragma unroll
  for (int r = 0; r < 16; ++r) pmax = fmaxf(pmax, p1[r]);
  { auto rr = __builtin_amdgcn_permlane32_swap(__float_as_uint(pmax), __float_as_uint(pmax), false, false);
    pmax = fmaxf(__uint_as_float(rr[0]), __uint_as_float(rr[1])); }
  if (__builtin_expect(__all(pmax - m_reg <= THR / SCALE), 1)) { mn = m_reg; alpha = 1.f; }
  else { mn = fmaxf(m_reg, pmax); alpha = __builtin_amdgcn_exp2f((m_reg - mn) * C); m_reg = mn; }
  float mnC = -mn * C;
#pragma unroll
  for (int r = 0; r < 16; ++r) p0[r] = fmaf(p0[r], C, mnC);
#pragma unroll
  for (int r = 0; r < 16; ++r) p1[r] = fmaf(p1[r], C, mnC);
#pragma unroll
  for (int r = 0; r < 16; ++r) p0[r] = __builtin_amdgcn_exp2f(p0[r]);
}
__device__ __forceinline__ void finishSM(f32x16& p0, f32x16& p1, float alpha, float& l_reg, bf16x8& pa0, bf16x8& pa1, bf16x8& pa2, bf16x8& pa3) {
#pragma unroll
  for (int r = 0; r < 16; ++r) p1[r] = __builtin_amdgcn_exp2f(p1[r]);
  float ps = 0;
#pragma unroll
  for (int r = 0; r < 16; ++r) ps += p0[r];
#pragma unroll
  for (int r = 0; r < 16; ++r) ps += p1[r];
  { auto rr = __builtin_amdgcn_permlane32_swap(__float_as_uint(ps), __float_as_uint(ps), false, false);
    ps = __uint_as_float(rr[0]) + __uint_as_float(rr[1]); }
  l_reg = l_reg * alpha + ps;
#define PK4(P, BASE, OUT) do { unsigned a0 = cvtpk(P[BASE + 0], P[BASE + 1]), a1 = cvtpk(P[BASE + 2], P[BASE + 3]);   \
    unsigned b0 = cvtpk(P[BASE + 4], P[BASE + 5]), b1 = cvtpk(P[BASE + 6], P[BASE + 7]);                              \
    auto r0 = __builtin_amdgcn_permlane32_swap(a0, b0, false, false); auto r1 = __builtin_amdgcn_permlane32_swap(a1, b1, false, false); \
    u32x4 w = {r0[0], r1[0], r0[1], r1[1]}; OUT = *reinterpret_cast<bf16x8*>(&w); } while (0)
  PK4(p0, 0, pa0); PK4(p0, 8, pa1); PK4(p1, 0, pa2); PK4(p1, 8, pa3);
#undef PK4
}
__device__ __forceinline__ void qkt(f32x16& p0, f32x16& p1, const bf16_t* Ks, const bf16x8* qr, int r32, int hi) {
  p0 = f32x16{}; p1 = f32x16{};
#pragma unroll
  for (int d0 = 0; d0 < 8; ++d0) { int cb = (d0 * 16 + hi * 8) * 2;
    bf16x8 b0 = *reinterpret_cast<const bf16x8*>((const char*)Ks + KSWZ(r32, cb));
    bf16x8 b1 = *reinterpret_cast<const bf16x8*>((const char*)Ks + KSWZ(32 + r32, cb));
    p0 = __builtin_amdgcn_mfma_f32_32x32x16_bf16(b0, qr[d0], p0, 0, 0, 0);
    p1 = __builtin_amdgcn_mfma_f32_32x32x16_bf16(b1, qr[d0], p1, 0, 0, 0); }
}
__device__ __forceinline__ int v_st(int k, int c) { const int kk = (k & ~0xC) | ((k & 4) << 1) | ((k & 8) >> 1); return ((kk >> 3) * 4 + (c >> 5)) * 512 + ((kk & 7) * 32 + (c & 31)) * 2; }
__device__ __forceinline__ int v_rd_base(int lane) { return ((lane & 3) << 3) | (((lane >> 2) & 3) << 6) | (((lane >> 4) & 1) << 5) | (((lane >> 5) & 1) << 8); }
constexpr int v_rd_off(int d0, int ks, int half) { return d0 * 512 + ks * 4096 + half * 2048; }
template <int OFF> __device__ __forceinline__ s16x4 tr_read(int vb) {
  s16x4 r; asm volatile("ds_read_b64_tr_b16 %0, %1 offset:%2" : "=&v"(r) : "v"(vb), "i"(OFF) : "memory"); return r;
}
template <int D0> __device__ __forceinline__ void pv_one(f32x16& od, int vb, bf16x8 pa0, bf16x8 pa1, bf16x8 pa2, bf16x8 pa3) {
  const s16x4 l0 = tr_read<v_rd_off(D0, 0, 0)>(vb), h0 = tr_read<v_rd_off(D0, 0, 1)>(vb), l1 = tr_read<v_rd_off(D0, 1, 0)>(vb), h1 = tr_read<v_rd_off(D0, 1, 1)>(vb);
  const s16x4 l2 = tr_read<v_rd_off(D0, 2, 0)>(vb), h2 = tr_read<v_rd_off(D0, 2, 1)>(vb), l3 = tr_read<v_rd_off(D0, 3, 0)>(vb), h3 = tr_read<v_rd_off(D0, 3, 1)>(vb);
  asm volatile("s_waitcnt lgkmcnt(0)" ::: "memory"); SBAR();
#define PK(L, H) (bf16x8){L[0], L[1], L[2], L[3], H[0], H[1], H[2], H[3]}
  od = __builtin_amdgcn_mfma_f32_32x32x16_bf16(pa0, PK(l0, h0), od, 0, 0, 0);
  od = __builtin_amdgcn_mfma_f32_32x32x16_bf16(pa1, PK(l1, h1), od, 0, 0, 0);
  od = __builtin_amdgcn_mfma_f32_32x32x16_bf16(pa2, PK(l2, h2), od, 0, 0, 0);
  od = __builtin_amdgcn_mfma_f32_32x32x16_bf16(pa3, PK(l3, h3), od, 0, 0, 0);
#undef PK
}
__device__ __forceinline__ void pv_d0(f32x16* o, int vb, bf16x8 pa0, bf16x8 pa1, bf16x8 pa2, bf16x8 pa3) {
  pv_one<0>(o[0], vb, pa0, pa1, pa2, pa3); pv_one<1>(o[1], vb, pa0, pa1, pa2, pa3); pv_one<2>(o[2], vb, pa0, pa1, pa2, pa3); pv_one<3>(o[3], vb, pa0, pa1, pa2, pa3);
}
__device__ __forceinline__ void attn_dense_body(const bf16_t* __restrict__ Qb, const bf16_t* __restrict__ Kh, const bf16_t* __restrict__ Vh,
                                                bf16_t* __restrict__ Ob, int seq, char* lds, const int tid) {
  const int wid = tid >> 6, lane = tid & 63, r32 = lane & 31, hi = lane >> 5;
  bf16_t* V_lds = (bf16_t*)lds; bf16_t* K_lds = (bf16_t*)(lds + 2 * SHM_V);
  float* wsf = (float*)(lds + 2 * SHM_V + 2 * SHM_K) + wid * 64; float* li_l = wsf; float* al_l = wsf + 32;
  float m_reg = -1e30f, l_reg = 0; f32x16 o[4] = {}; bf16x8 qr[8];
  const bf16_t* Qw = Qb + (long)(wid * QBLK + r32) * LDQ + hi * 8;
#pragma unroll
  for (int d0 = 0; d0 < 8; ++d0) qr[d0] = *reinterpret_cast<const bf16x8*>(Qw + d0 * 16);
  const int sr = tid >> 4, sc = (tid & 15) * 8, vst0 = v_st(sr, sc), vst1 = v_st(32 + sr, sc);
  const int vb0 = (int)(uintptr_t)V_lds + v_rd_base(lane);
  struct { bf16x8 vs0, vs1, ks0, ks1; } sr_[2];
#define LD8(p) (*reinterpret_cast<const bf16x8*>(p))
  const unsigned voff = (unsigned)(sr * LDK + sc) * 2u;
#define SLOAD(i, k0) do { const char* vb_ = (const char*)(Vh + (size_t)(k0) * LDK); const char* kb_ = (const char*)(Kh + (size_t)(k0) * LDK); \
    sr_[i].vs0 = LD8(vb_ + voff); sr_[i].vs1 = LD8(vb_ + 32 * LDK * 2 + voff); sr_[i].ks0 = LD8(kb_ + voff); sr_[i].ks1 = LD8(kb_ + 32 * LDK * 2 + voff); } while (0)
#define SWRITE(b, i) do { *(bf16x8*)((char*)V_lds + (b) * SHM_V + vst0) = sr_[i].vs0;          \
    *(bf16x8*)((char*)V_lds + (b) * SHM_V + vst1) = sr_[i].vs1; int kc = sc * 2;               \
    *(bf16x8*)((char*)K_lds + (b) * SHM_K + KSWZ(sr, kc)) = sr_[i].ks0;                       \
    *(bf16x8*)((char*)K_lds + (b) * SHM_K + KSWZ(32 + sr, kc)) = sr_[i].ks1; } while (0)
#define SWAIT() asm volatile("s_waitcnt vmcnt(4)" ::: "memory")
#define RESC(a) do { if (__any((a) < 1.f)) { if (hi == 0) al_l[r32] = (a); asm volatile("s_waitcnt lgkmcnt(0)" ::: "memory"); \
    _Pragma("unroll") for (int d = 0; d < 4; ++d) _Pragma("unroll") for (int r = 0; r < 16; ++r) o[d][r] *= al_l[crow(r, hi)]; } } while (0)
  f32x16 pA0, pA1, pB0, pB1; float mnA, mnB, alA, alB; bf16x8 pa0, pa1, pa2, pa3; const int NT = seq / KVBLK;
  constexpr int SE = 0, SO = 1;
  SLOAD(SE, 0); asm volatile("s_waitcnt vmcnt(0)" ::: "memory"); SWRITE(0, SE); __syncthreads();
  qkt(pA0, pA1, K_lds, qr, r32, hi); partialSM(pA0, pA1, m_reg, mnA, alA);
  SLOAD(SO, KVBLK); if (2 < NT) SLOAD(SE, 2 * KVBLK);
  SWAIT(); SWRITE(1, SO); __syncthreads();
  for (int j = 1; j + 1 < NT; j += 2) {
    SBAR(); qkt(pB0, pB1, (bf16_t*)((char*)K_lds + SHM_K), qr, r32, hi);
    finishSM(pA0, pA1, alA, l_reg, pa0, pa1, pa2, pa3); SBAR();
    SLOAD(SO, (j + 2) * KVBLK); SBAR();
    pv_d0(o, vb0, pa0, pa1, pa2, pa3); partialSM(pB0, pB1, m_reg, mnB, alB);
    __syncthreads(); SWAIT(); SWRITE(0, SE);
    RESC(alB); __syncthreads();
    SBAR(); qkt(pA0, pA1, K_lds, qr, r32, hi);
    finishSM(pB0, pB1, alB, l_reg, pa0, pa1, pa2, pa3); SBAR();
    if (j + 3 < NT) SLOAD(SE, (j + 3) * KVBLK); SBAR();
    pv_d0(o, vb0 + (int)SHM_V, pa0, pa1, pa2, pa3); partialSM(pA0, pA1, m_reg, mnA, alA);
    __syncthreads(); SWAIT(); SWRITE(1, SO);
    RESC(alA); __syncthreads();
  }
  SBAR(); qkt(pB0, pB1, (bf16_t*)((char*)K_lds + SHM_K), qr, r32, hi);
  finishSM(pA0, pA1, alA, l_reg, pa0, pa1, pa2, pa3); SBAR();
  pv_d0(o, vb0, pa0, pa1, pa2, pa3); partialSM(pB0, pB1, m_reg, mnB, alB);
  __syncthreads(); RESC(alB);
  finishSM(pB0, pB1, alB, l_reg, pa0, pa1, pa2, pa3); SBAR();
  pv_d0(o, vb0 + (int)SHM_V, pa0, pa1, pa2, pa3);
  if (hi == 0) li_l[r32] = l_reg; asm volatile("s_waitcnt lgkmcnt(0)" ::: "memory");
  float rli[16];
#pragma unroll
  for (int r = 0; r < 16; ++r) rli[r] = __builtin_amdgcn_rcpf(li_l[crow(r, hi)]);
  bf16_t* Ow = Ob + (long)(wid * QBLK) * LDO;
#pragma unroll
  for (int r = 0; r < 16; ++r) { int orow = crow(r, hi);
#pragma unroll
    for (int d0 = 0; d0 < 4; ++d0) Ow[(long)orow * LDO + d0 * 32 + r32] = f2bf(o[d0][r] * rli[r]); }
#undef LD8
#undef SLOAD
#undef SWRITE
#undef SWAIT
#undef RESC
}
}

__device__ __forceinline__ void mod_phase(const Params& P, LAS unsigned char* lds, const int tid) {
  LAS float* sc = (LAS float*)lds; LAS float* red = sc + 5 * 2048;
  const int wid = tid >> 6, lane = tid & 63;
  for (int i = tid; i < 5 * 2048; i += 512) { const int j = i >> 11, k = i & 2047; const float v = (j < 4) ? P.c[j * 2048 + k] : P.c_ctx[k]; sc[i] = v * sigmoidf_(v); }
  __syncthreads();
  float* MOD = (float*)(P.ws + OFF_MOD);
  for (int task = P.bid; task < 256; task += P.grd) {
    const int n0 = task * 72 + lane * 2;
    float a0[5], a1[5];
#pragma unroll
    for (int j = 0; j < 5; ++j) { a0[j] = 0.f; a1[j] = 0.f; }
    if (lane < 36) {
      const float* wp = P.w_mod + (size_t)(wid * 256) * NMODC + n0;
#pragma unroll 16
      for (int k = 0; k < 256; ++k) {
        const f32x2 w = *(const f32x2*)(wp + (size_t)k * NMODC);
#pragma unroll
        for (int j = 0; j < 5; ++j) { const float s = sc[j * 2048 + wid * 256 + k]; a0[j] += s * w.x; a1[j] += s * w.y; }
      }
#pragma unroll
      for (int j = 0; j < 5; ++j) { red[(wid * 5 + j) * 72 + lane * 2] = a0[j]; red[(wid * 5 + j) * 72 + lane * 2 + 1] = a1[j]; }
    }
    __syncthreads();
    if (tid < 360) { const int j = tid / 72, ci = tid % 72; float s = 0.f;
#pragma unroll
      for (int w = 0; w < 8; ++w) s += red[(w * 5 + j) * 72 + ci];
      MOD[j * NMODC + task * 72 + ci] = s + P.b_mod[task * 72 + ci]; }
    __syncthreads();
  }
}
__device__ __forceinline__ void tr_item(const float* __restrict__ W, int ldw, int k0, int n0, bf16_t* __restrict__ WT, int ldt, int drow0, int dk0, LAS float* scr, int lane) {
#pragma unroll 32
  for (int i = 0; i < 32; ++i) { const int kk = 2 * i + (lane >> 5); scr[kk * 33 + (lane & 31)] = W[(size_t)(k0 + kk) * ldw + n0 + (lane & 31)]; }
  asm volatile("s_waitcnt lgkmcnt(0)" ::: "memory");
  const int c = lane & 7;
#pragma unroll
  for (int j = 0; j < 4; ++j) { const int n = (lane >> 3) + 8 * j; const LAS float* s = scr + (8 * c) * 33 + n;
    u32x4 o; o.x = cvt_pk_bf16(s[0 * 33], s[1 * 33]); o.y = cvt_pk_bf16(s[2 * 33], s[3 * 33]); o.z = cvt_pk_bf16(s[4 * 33], s[5 * 33]); o.w = cvt_pk_bf16(s[6 * 33], s[7 * 33]);
    *(u32x4*)(WT + (size_t)(drow0 + n) * ldt + dk0 + k0 + 8 * c) = o; }
  asm volatile("s_waitcnt lgkmcnt(0)" ::: "memory");
}
__device__ __forceinline__ void convert_phase(const Params& P, LAS unsigned char* lds, const int tid) {
  const int wid = tid >> 6, lane = tid & 63;
  LAS float* scr = (LAS float*)(lds + wid * 8704);
  unsigned char* ws = P.ws;
  bf16_t *W1A = (bf16_t*)(ws + OFF_W1A), *W1B = (bf16_t*)(ws + OFF_W1B), *W2A = (bf16_t*)(ws + OFF_W2A), *W2B = (bf16_t*)(ws + OFF_W2B);
  bf16_t *WRW = (bf16_t*)(ws + OFF_WRW), *WQKVG = (bf16_t*)(ws + OFF_WQKVG), *WOA = (bf16_t*)(ws + OFF_WOA), *WOR = (bf16_t*)(ws + OFF_WOR), *WOUT = (bf16_t*)(ws + OFF_WOUT), *WLORA = (bf16_t*)(ws + OFF_WLORA);
  const int G = P.grd, gw = P.bid * 8 + wid, NGW = G * 8;
  constexpr int NITEMS = 22528 + 11264 + 3456 + 7168 + 2048 + 1024 + 2048 + 192;
  for (int it = gw; it < NITEMS; it += NGW) {
    int r = it;
    if (r < 22528) { const int which = r >= 11264; r -= which * 11264; const int kb = r / 352, nb = r % 352, n0 = nb * 32;
      const int drow = n0 < DFF ? (n0 >> 7) * 256 + (n0 & 127) : ((n0 - DFF) >> 7) * 256 + 128 + ((n0 - DFF) & 127);
      tr_item(which ? P.ffn2_w_in : P.ffn1_w_in, 2 * DFF, kb * 64, n0, which ? W2A : W1A, 2048, drow, 0, scr, lane); continue; }
    r -= 22528;
    if (r < 11264) { const int which = r >= 5632; r -= which * 5632; const int kb = r >> 6, nb = r & 63;
      tr_item(which ? P.ffn2_w_out : P.ffn1_w_out, 2048, kb * 64, nb * 32, which ? W2B : W1B, DFF, nb * 32, 0, scr, lane); continue; }
    r -= 11264;
    if (r < 3456) { const int kb = r / 108, nb = r % 108; tr_item(P.w_in, 10624, kb * 64, 3072 + nb * 32, WRW, 2048, nb * 32, 0, scr, lane); continue; }
    r -= 3456;
    if (r < 7168) { const int kb = r / 224, nb = r % 224; const int n0 = nb < 96 ? nb * 32 : 6528 + (nb - 96) * 32;
      tr_item(P.w_in, 10624, kb * 64, n0, WQKVG, 2048, nb * 32, 0, scr, lane); continue; }
    r -= 7168;
    if (r < 2048) { tr_item(P.w_oa, 2048, (r >> 6) * 64, (r & 63) * 32, WOA, 2048, (r & 63) * 32, 0, scr, lane); continue; }
    r -= 2048;
    if (r < 1024) { tr_item(P.w_or, 2048, (r >> 6) * 64, (r & 63) * 32, WOR, 1024, (r & 63) * 32, 0, scr, lane); continue; }
    r -= 1024;
    if (r < 2048) { tr_item(P.w_out, 2048, (r >> 6) * 64, (r & 63) * 32, WOUT, 2048, (r & 63) * 32, 0, scr, lane); continue; }
    r -= 2048;
    if (r < 64) { const int z = r >> 5, nb = r & 31; tr_item(P.w2 + (size_t)z * 64 * 1024, 1024, 0, nb * 32, WLORA, LIN_LD, z * 1024 + nb * 32, z * 64, scr, lane); continue; }
    r -= 64;
    if (r < 64) { const int z = r >> 5, nb = r & 31; tr_item(P.a2 + (size_t)z * 64 * 1024, 1024, 0, nb * 32, WLORA, LIN_LD, 2048 + z * 1024 + nb * 32, 128 + z * 64, scr, lane); continue; }
    r -= 64;
    { const int kb = r >> 5, nb = r & 31; tr_item(P.g2, 1024, kb * 64, nb * 32, WLORA, LIN_LD, 4096 + nb * 32, 256, scr, lane); }
  }
  const int gt = P.bid * 512 + tid, NT = G * 512;
  unsigned zz = 0u; asm volatile("" : "+v"(zz));
  const u32x4 z4 = {zz, zz, zz, zz};
  for (int i = gt; i < 128 * 256; i += NT) *(u32x4*)(WRW + (size_t)3456 * 2048 + (size_t)i * 8) = z4;
  for (int i = gt; i < 5120 * 48; i += NT) { const int row = i / 48, kc = (i % 48) * 8, rb = row >> 10;
    const int lo = rb < 4 ? rb * 64 : 256, hi = rb < 4 ? rb * 64 + 64 : 384;
    if (kc < lo || kc >= hi) *(u32x4*)(WLORA + (size_t)row * LIN_LD + kc) = z4; }
}
__device__ __forceinline__ void norm_mod_phase(const Params& P, const float* __restrict__ lat, const float* __restrict__ ctxp, int nrows, const float* __restrict__ g, int midx, const float* __restrict__ parts, const int tid) {
  const int wid = tid >> 6, lane = tid & 63;
  const int gw = P.bid * 8 + wid, NGW = P.grd * 8;
  const float* __restrict__ MOD = (const float*)(P.ws + OFF_MOD); bf16_t* __restrict__ H = (bf16_t*)(P.ws + OFF_H);
  for (int r = gw; r < nrows; r += NGW) {
    const float* xr = r < MT ? lat + (size_t)r * DM : ctxp + (size_t)(r - MT) * DM;
    const int b = r < MT ? (r >> 13) : 4;
    const float* sh = MOD + b * NMODC + midx * DM; const float* scp = sh + DM;
    f32x4 v[8], g4[8], s4[8], c4[8]; float ss = 0.f;
#pragma unroll
    for (int j = 0; j < 8; ++j) v[j] = *(const f32x4*)(xr + j * 256 + lane * 4);
    if (parts && r >= MT) {
      const float* pp = parts + (size_t)(r - MT) * DM; const float* gt = MOD + 4 * NMODC + 2 * DM;
#pragma unroll
      for (int j = 0; j < 8; ++j) { const int c = j * 256 + lane * 4;
        const f32x4 s = (*(const f32x4*)(pp + c) + *(const f32x4*)(pp + (size_t)MC * DM + c)) + (*(const f32x4*)(pp + (size_t)2 * MC * DM + c) + *(const f32x4*)(pp + (size_t)3 * MC * DM + c));
        v[j] = v[j] + *(const f32x4*)(gt + c) * 0.5f * s; }
    }
#pragma unroll
    for (int j = 0; j < 8; ++j) { const int c = j * 256 + lane * 4; g4[j] = *(const f32x4*)(g + c); s4[j] = *(const f32x4*)(sh + c); c4[j] = *(const f32x4*)(scp + c); }
#pragma unroll
    for (int j = 0; j < 8; ++j) ss += v[j].x * v[j].x + v[j].y * v[j].y + v[j].z * v[j].z + v[j].w * v[j].w;
    ss = wave_sum(ss);
    const float rs = rsqrtf(ss * (1.f / DM) + 1e-6f);
#pragma unroll
    for (int j = 0; j < 8; ++j) { const int c = j * 256 + lane * 4;
      const f32x4 y = v[j] * rs * g4[j]; const f32x4 h = y * (c4[j] + 1.f) + s4[j];
      u32x2 w; w.x = cvt_pk_bf16(h.x, h.y); w.y = cvt_pk_bf16(h.z, h.w);
      *(u32x2*)(H + (size_t)r * DM + c) = w; }
  }
}
__device__ __forceinline__ void shift_phase(const Params& P, const int tid) {
  const bf16_t* __restrict__ PRW = (const bf16_t*)(P.ws + OFF_PRW); bf16_t* __restrict__ SH = (bf16_t*)(P.ws + OFF_SH); bf16_t* __restrict__ LIN = (bf16_t*)(P.ws + OFF_LIN);
  const int gt = P.bid * 512 + tid, NT = P.grd * 512;
#pragma unroll 2
  for (int idx = gt; idx < MA * 432; idx += NT) {
    const int r = idx / 432, c = (idx % 432) * 8;
    bool first, last;
    if (r < MT) { const int t = r & (SEQ - 1); first = t == 0; last = t == SEQ - 1; } else { const int t = (r - MT) & (CTXL - 1); first = t == 0; last = t == CTXL - 1; }
    const u32x4 z4 = {0u, 0u, 0u, 0u};
    const u32x4 p = *(const u32x4*)(PRW + (size_t)r * PRW_LD + c);
    const u32x4 pv = first ? z4 : *(const u32x4*)(PRW + (size_t)(r - 1) * PRW_LD + c);
    const u32x4 nx = last ? z4 : *(const u32x4*)(PRW + (size_t)(r + 1) * PRW_LD + c);
    const f32x4 m0 = *(const f32x4*)(P.rwkv_mu + c), m1 = *(const f32x4*)(P.rwkv_mu + c + 4);
    float o[8];
#define SHF(e, W, MU, HI) { const float pp = HI ? bfhi(p.W) : bflo(p.W), a = HI ? bfhi(pv.W) : bflo(pv.W), b = HI ? bfhi(nx.W) : bflo(nx.W); o[e] = pp + MU * (0.5f * (a + b) - pp); }
    SHF(0, x, m0.x, 0) SHF(1, x, m0.y, 1) SHF(2, y, m0.z, 0) SHF(3, y, m0.w, 1) SHF(4, z, m1.x, 0) SHF(5, z, m1.y, 1) SHF(6, w, m1.z, 0) SHF(7, w, m1.w, 1)
#undef SHF
    bf16_t* dst;
    if (c < 3072) dst = SH + (size_t)r * SH_LD + c;
    else { const int cl = c - 3072; dst = LIN + (size_t)r * LIN_LD + cl;
      if (cl < 128) {
#pragma unroll
        for (int e = 0; e < 8; ++e) { const float ex = __builtin_amdgcn_exp2f(2.8853900817779268f * o[e]); o[e] = 1.f - 2.f * __builtin_amdgcn_rcpf(ex + 1.f); }
      } else if (cl >= 256) {
#pragma unroll
        for (int e = 0; e < 8; ++e) o[e] = sigmoidf_(o[e]);
      } }
    u32x4 w; w.x = cvt_pk_bf16(o[0], o[1]); w.y = cvt_pk_bf16(o[2], o[3]); w.z = cvt_pk_bf16(o[4], o[5]); w.w = cvt_pk_bf16(o[6], o[7]);
    *(u32x4*)dst = w;
  }
}
__device__ __forceinline__ float SFMA(float a, float b, float c) { float d; asm("v_fma_f32 %0, %1, %2, %3" : "=v"(d) : "v"(a), "v"(b), "v"(c)); return d; }
__device__ __forceinline__ float SMUL(float a, float b) { float d; asm("v_mul_f32 %0, %1, %2" : "=v"(d) : "v"(a), "v"(b)); return d; }
__device__ __forceinline__ float allred8(float x) { x += dpp_mov<0xB1>(x); x += dpp_mov<0x4E>(x); x += dpp_mov<0x141>(x); return x; }
__device__ __forceinline__ void scan_phase(const Params& P, LAS unsigned char* lds, const int tid) {
  LAS float* F = (LAS float*)lds;
  LAS unsigned short* YB = (LAS unsigned short*)(lds + 2 * 32 * 384 * 4);
  const bf16_t* SH = (const bf16_t*)(P.ws + OFF_SH); const bf16_t* LO = (const bf16_t*)(P.ws + OFF_LO); bf16_t* Y = (bf16_t*)(P.ws + OFF_Y);
  const int wid = __builtin_amdgcn_readfirstlane(tid >> 6), lane = tid & 63;
  constexpr int NCH = SKV / 32;
#define SCAN_BAR() do { asm volatile("s_waitcnt lgkmcnt(0)" ::: "memory"); __builtin_amdgcn_s_barrier(); asm volatile("" ::: "memory"); } while (0)
  for (int task = P.bid; task < 256; task += P.grd) {
    const int half = (task >> 3) & 1, chain = (task & 7) | ((task >> 4) << 3);
    const int dir = chain & 1, h = (chain >> 1) & 15, b = chain >> 5, hc = h * 64;
#define ROWOF(g) ((g) < CTXL ? (MT + b * CTXL + (dir ? CTXL - 1 - (g) : (g))) : (b * SEQ + (dir ? SEQ - 1 - ((g) - CTXL) : ((g) - CTXL))))
    if (wid < 4) {
      const int rloc = wid * 8 + (lane >> 3), irow = half * 32 + rloc, cA = (lane & 7) * 4, cB = 32 + cA;
      f32x4 S0 = {0.f, 0.f, 0.f, 0.f}, S1 = {0.f, 0.f, 0.f, 0.f};
      SCAN_BAR();
      for (int q = 0; q < NCH; ++q) {
        const LAS float* f = F + (q & 1) * 32 * 384;
        LAS unsigned short* yb = YB + (q & 1) * 1024;
        f32x4 w0 = *(const LAS f32x4*)(f + cA), w1 = *(const LAS f32x4*)(f + cB);
        f32x4 a0 = *(const LAS f32x4*)(f + 64 + cA), a1 = *(const LAS f32x4*)(f + 64 + cB);
        f32x4 b0 = *(const LAS f32x4*)(f + 128 + cA), b1 = *(const LAS f32x4*)(f + 128 + cB);
        f32x4 k0 = *(const LAS f32x4*)(f + 192 + cA), k1 = *(const LAS f32x4*)(f + 192 + cB);
        f32x4 r0 = *(const LAS f32x4*)(f + 256 + cA), r1 = *(const LAS f32x4*)(f + 256 + cB);
        float vv = f[320 + irow];
        float ykeep = 0.f;
#pragma unroll 2
        for (int s = 0; s < 32; ++s) {
          const LAS float* fn = f + (s < 31 ? s + 1 : 31) * 384;
          const f32x4 nw0 = *(const LAS f32x4*)(fn + cA), nw1 = *(const LAS f32x4*)(fn + cB);
          const f32x4 na0 = *(const LAS f32x4*)(fn + 64 + cA), na1 = *(const LAS f32x4*)(fn + 64 + cB);
          const f32x4 nb0 = *(const LAS f32x4*)(fn + 128 + cA), nb1 = *(const LAS f32x4*)(fn + 128 + cB);
          const f32x4 nk0 = *(const LAS f32x4*)(fn + 192 + cA), nk1 = *(const LAS f32x4*)(fn + 192 + cB);
          const f32x4 nr0 = *(const LAS f32x4*)(fn + 256 + cA), nr1 = *(const LAS f32x4*)(fn + 256 + cB);
          const float nvv = fn[320 + irow];
          __builtin_amdgcn_sched_barrier(0);
          f32x4 p = S0 * a0 + S1 * a1;
          const float sa_ = allred8((p.x + p.y) + (p.z + p.w));
          S0 = S0 * w0 + (b0 * sa_ + k0 * vv);
          S1 = S1 * w1 + (b1 * sa_ + k1 * vv);
          p = S0 * r0 + S1 * r1;
          const float y = allred8((p.x + p.y) + (p.z + p.w));
          ykeep = ((s & 7) == (lane & 7)) ? y : ykeep;
          if ((s & 7) == 7) yb[((s & ~7) + (lane & 7)) * 32 + rloc] = f2bf(ykeep);
          __builtin_amdgcn_sched_barrier(0);
          w0 = nw0; w1 = nw1; a0 = na0; a1 = na1; b0 = nb0; b1 = nb1; k0 = nk0; k1 = nk1; r0 = nr0; r1 = nr1; vv = nvv;
        }
        SCAN_BAR();
      }
    } else {
      const int sw = wid - 4, hw = lane >> 5, cp = (lane & 31) * 2;
      const f32x2 kk_c = *(const f32x2*)(P.k_k + hc + cp), ka_c = *(const f32x2*)(P.k_a + hc + cp);
      unsigned voS[4], voL[4];
#pragma unroll
      for (int e = 0; e < 4; ++e) { const int tk = hw * 4 + e, ro = dir ? 7 - tk : tk; voS[e] = (unsigned)(ro * SH_LD + cp) * 2u; voL[e] = (unsigned)(ro * LO_LD + cp) * 2u; }
      unsigned sr[4], sk[4], sv[4], sl[4], sa[4];
#define RMIN(q) ({ const int g0_ = (q) * 32 + sw * 8; const int ra_ = ROWOF(g0_), rb_ = ROWOF(g0_ + 7); ra_ < rb_ ? ra_ : rb_; })
#define SLOADQ(q) do { const size_t rmin_ = (size_t)RMIN(q); const char* bs_ = (const char*)(SH + rmin_ * SH_LD + hc); const char* bl_ = (const char*)(LO + rmin_ * LO_LD + dir * 1024 + hc); \
      _Pragma("unroll") for (int e = 0; e < 4; ++e) { sr[e] = *(const unsigned*)(bs_ + voS[e]); sk[e] = *(const unsigned*)(bs_ + 2048 + voS[e]); sv[e] = *(const unsigned*)(bs_ + 4096 + voS[e]); \
        sl[e] = *(const unsigned*)(bl_ + voL[e]); sa[e] = *(const unsigned*)(bl_ + 4096 + voL[e]); } } while (0)
#define SWRITEQ(buf) do { _Pragma("unroll") for (int e = 0; e < 4; ++e) { LAS float* f_ = F + ((buf) * 32 + sw * 8 + hw * 4 + e) * 384 + cp; \
      const f32x2 r_ = {bflo(sr[e]), bfhi(sr[e])}, k_ = {bflo(sk[e]), bfhi(sk[e])}, v_ = {bflo(sv[e]), bfhi(sv[e])}, lam = {bflo(sl[e]), bfhi(sl[e])}, aa = {bflo(sa[e]), bfhi(sa[e])}; \
      const f32x2 kkr = k_ * kk_c; float ssq = allred16(kkr.x * kkr.x + kkr.y * kkr.y); \
      { auto rr_ = __builtin_amdgcn_permlane16_swap(__float_as_uint(ssq), __float_as_uint(ssq), false, false); ssq = __uint_as_float(rr_[0]) + __uint_as_float(rr_[1]); } \
      const f32x2 kk = kkr * rsqrtf(fmaxf(ssq, 1e-24f)); \
      f32x2 wv; wv.x = __builtin_amdgcn_exp2f(-lam.x); wv.y = __builtin_amdgcn_exp2f(-lam.y); \
      *(LAS f32x2*)(f_) = wv; *(LAS f32x2*)(f_ + 64) = -kk; *(LAS f32x2*)(f_ + 128) = kk * aa; *(LAS f32x2*)(f_ + 192) = k_ * ((aa - 1.f) * ka_c + 1.f); \
      *(LAS f32x2*)(f_ + 256) = r_; *(LAS f32x2*)(f_ + 320) = v_; } } while (0)
      SLOADQ(0); SWRITEQ(0); SLOADQ(1);
      SCAN_BAR();
      for (int q = 0; q < NCH; ++q) {
        if (q >= 9) {
          const int qq = q - 1; const LAS unsigned short* yb = YB + (qq & 1) * 1024;
          const int t256 = sw * 64 + lane, s = t256 >> 3, rp = (t256 & 7) * 4; const int u = qq * 32 + s - CTXL; const int t = dir ? SEQ - 1 - u : u;
          const u32x2 val = *(const LAS u32x2*)(yb + s * 32 + rp);
          *(u32x2*)(Y + (size_t)dir * MT * 1024 + (size_t)(b * SEQ + t) * 1024 + hc + half * 32 + rp) = val;
        }
        if (q + 1 < NCH) SWRITEQ((q + 1) & 1);
        if (q + 2 < NCH) SLOADQ(q + 2);
        SCAN_BAR();
      }
      {
        const int qq = NCH - 1; const LAS unsigned short* yb = YB + (qq & 1) * 1024;
        const int t256 = sw * 64 + lane, s = t256 >> 3, rp = (t256 & 7) * 4; const int u = qq * 32 + s - CTXL; const int t = dir ? SEQ - 1 - u : u;
        const u32x2 val = *(const LAS u32x2*)(yb + s * 32 + rp);
        *(u32x2*)(Y + (size_t)dir * MT * 1024 + (size_t)(b * SEQ + t) * 1024 + hc + half * 32 + rp) = val;
      }
#undef SLOADQ
#undef SWRITEQ
#undef RMIN
    }
#undef ROWOF
    __syncthreads();
  }
#undef SCAN_BAR
}
__device__ __forceinline__ float half_sum(float v) {
  v = allred16(v);
  auto rr = __builtin_amdgcn_permlane16_swap(__float_as_uint(v), __float_as_uint(v), false, false); return __uint_as_float(rr[0]) + __uint_as_float(rr[1]);
}
__device__ __forceinline__ void rwkv_out_phase(const Params& P, const int tid) {
  const bf16_t* SH = (const bf16_t*)(P.ws + OFF_SH); const bf16_t* LO = (const bf16_t*)(P.ws + OFF_LO); bf16_t* Y = (bf16_t*)(P.ws + OFF_Y);
  const int wid = tid >> 6, lane = tid & 63, hw = lane >> 5, cp = (lane & 31) * 2;
  const int gw = P.bid * 8 + wid, NGW = P.grd * 8;
  for (int task = gw * 2; task < MT * 8; task += NGW * 2) {
    unsigned yf[2], ybk[2], rr[2], kk[2], vv[2], af[2], ab[2], gg[2]; int cc[2]; size_t tk[2];
#pragma unroll
    for (int u = 0; u < 2; ++u) { const int t_ = task + u; tk[u] = (size_t)(t_ >> 3); cc[u] = ((t_ & 7) * 2 + hw) * 64 + cp;
      const bf16_t* py = Y + tk[u] * 1024 + cc[u]; const bf16_t* ps = SH + tk[u] * SH_LD + cc[u]; const bf16_t* pl = LO + tk[u] * LO_LD + cc[u];
      yf[u] = *(const unsigned*)py; ybk[u] = *(const unsigned*)(py + (size_t)MT * 1024);
      rr[u] = *(const unsigned*)ps; kk[u] = *(const unsigned*)(ps + 1024); vv[u] = *(const unsigned*)(ps + 2048);
      af[u] = *(const unsigned*)(pl + 2048); ab[u] = *(const unsigned*)(pl + 3072); gg[u] = *(const unsigned*)(pl + 4096); }
    unsigned res[2];
#pragma unroll
    for (int u = 0; u < 2; ++u) {
      const f32x2 lw = *(const f32x2*)(P.ln_x_w + cc[u]), lb = *(const f32x2*)(P.ln_x_b + cc[u]), ka = *(const f32x2*)(P.k_a + cc[u]), rk = *(const f32x2*)(P.r_k + cc[u]);
      const f32x2 y = {bflo(yf[u]) + bflo(ybk[u]), bfhi(yf[u]) + bfhi(ybk[u])};
      const float mu = half_sum(y.x + y.y) * (1.f / 64.f); const f32x2 dv = y - mu; const float var = half_sum(dv.x * dv.x + dv.y * dv.y) * (1.f / 64.f);
      const f32x2 yn = dv * rsqrtf(var + 64e-5f) * lw + lb;
      const f32x2 r = {bflo(rr[u]), bfhi(rr[u])}, k = {bflo(kk[u]), bfhi(kk[u])}, v = {bflo(vv[u]), bfhi(vv[u])};
      const f32x2 a1 = {bflo(af[u]), bfhi(af[u])}, a2 = {bflo(ab[u]), bfhi(ab[u])}, g = {bflo(gg[u]), bfhi(gg[u])};
      const f32x2 kms = k * ((a1 - 1.f) * ka + 1.f) + k * ((a2 - 1.f) * ka + 1.f);
      const f32x2 bt = r * kms * rk;
      const float bonus = half_sum(bt.x + bt.y);
      const f32x2 o = (yn + v * bonus) * g;
      res[u] = cvt_pk_bf16(o.x, o.y);
    }
#pragma unroll
    for (int u = 0; u < 2; ++u) *(unsigned*)(Y + tk[u] * 1024 + cc[u]) = res[u];
  }
}
__device__ __forceinline__ void rope_phase(const Params& P, const int tid) {
  bf16_t* Q = (bf16_t*)(P.ws + OFF_Q); bf16_t* KB = (bf16_t*)(P.ws + OFF_KB);
  const int wid = tid >> 6, lane = tid & 63, hw = lane >> 5, li = lane & 31;
  const int gw = P.bid * 8 + wid, NGW = P.grd * 8;
  const int d1 = li < 16 ? 2 * li : 64 + 2 * (li - 16);
  const f32x2 qgA = *(const f32x2*)(P.q_norm + d1), qgB = *(const f32x2*)(P.q_norm + d1 + 32), kgA = *(const f32x2*)(P.k_norm + d1), kgB = *(const f32x2*)(P.k_norm + d1 + 32);
  const int j0 = 2 * (li & 15);
  const float inv0 = __builtin_amdgcn_exp2f(-(float)(2 * j0) * (13.287712379549449f / 64.f)), inv1 = __builtin_amdgcn_exp2f(-(float)(2 * j0 + 2) * (13.287712379549449f / 64.f));
  for (int task = gw; task < MA; task += NGW) {
    if (task < MT) {
      const int tok = task, b = tok >> 13, t = tok & (SEQ - 1);
      const float pos = (float)(li < 16 ? (t >> 6) : (t & 63));
      const float an0 = pos * inv0, an1 = pos * inv1;
      const f32x2 sn = {__sinf(an0), __sinf(an1)}, cs = {__cosf(an0), __cosf(an1)};
      unsigned lo[10], hi[10]; bf16_t* ptr[10];
#pragma unroll
      for (int i = 0; i < 10; ++i) { const int hd = 2 * i + hw;
        ptr[i] = (hd < 16 ? Q + (size_t)tok * DM + hd * 128 : KB + (size_t)(tok + b * CTXL) * 512 + (hd - 16) * 128) + d1;
        lo[i] = *(const unsigned*)ptr[i]; hi[i] = *(const unsigned*)(ptr[i] + 32); }
#pragma unroll
      for (int i = 0; i < 10; ++i) { const bool isq = i < 8;
        const f32x2 t1 = {bflo(lo[i]), bfhi(lo[i])}, t2 = {bflo(hi[i]), bfhi(hi[i])};
        const float ss = half_sum((t1.x * t1.x + t1.y * t1.y) + (t2.x * t2.x + t2.y * t2.y)); const float rs = rsqrtf(ss * (1.f / 128.f) + 1e-6f);
        const f32x2 n1 = t1 * rs * (isq ? qgA : kgA), n2 = t2 * rs * (isq ? qgB : kgB);
        const f32x2 o1 = n1 * cs - n2 * sn, o2 = n2 * cs + n1 * sn;
        lo[i] = cvt_pk_bf16(o1.x, o1.y); hi[i] = cvt_pk_bf16(o2.x, o2.y); }
#pragma unroll
      for (int i = 0; i < 10; ++i) { *(unsigned*)ptr[i] = lo[i]; *(unsigned*)(ptr[i] + 32) = hi[i]; }
    } else {
      const int ct = task - MT, b = ct >> 8, t = ct & (CTXL - 1);
      unsigned lo[2], hi[2]; bf16_t* ptr[2];
#pragma unroll
      for (int i = 0; i < 2; ++i) { ptr[i] = KB + (size_t)(b * SKV + SEQ + t) * 512 + (2 * i + hw) * 128 + d1; lo[i] = *(const unsigned*)ptr[i]; hi[i] = *(const unsigned*)(ptr[i] + 32); }
#pragma unroll
      for (int i = 0; i < 2; ++i) {
        const f32x2 t1 = {bflo(lo[i]), bfhi(lo[i])}, t2 = {bflo(hi[i]), bfhi(hi[i])};
        const float ss = half_sum((t1.x * t1.x + t1.y * t1.y) + (t2.x * t2.x + t2.y * t2.y)); const float rs = rsqrtf(ss * (1.f / 128.f) + 1e-6f);
        const f32x2 n1 = t1 * rs * kgA, n2 = t2 * rs * kgB;
        *(unsigned*)ptr[i] = cvt_pk_bf16(n1.x, n1.y); *(unsigned*)(ptr[i] + 32) = cvt_pk_bf16(n2.x, n2.y); }
    }
  }
}
__device__ __forceinline__ void attn_phase(const Params& P, unsigned char* smem, const int tid) {
  bf16_t* Q = (bf16_t*)(P.ws + OFF_Q); const bf16_t* KB = (const bf16_t*)(P.ws + OFF_KB); const bf16_t* VB = (const bf16_t*)(P.ws + OFF_VB);
  for (int u = P.bid; u < 2048; u += P.grd) {
    const int xcd = u & 7, slot = (u >> 3) & 31, rnd = u >> 8, pair = xcd + 8 * (rnd >> 2), w = (rnd & 3) * 32 + slot;
    const int b = pair >> 2, kvh = pair & 3, g = w & 3, qb = w >> 2, head = kvh * 4 + g;
    bf16_t* Qb = Q + (size_t)(b * SEQ + qb * 256) * DM + head * 128;
    const bf16_t* Kh = KB + (size_t)b * SKV * 512 + kvh * 128; const bf16_t* Vh = VB + (size_t)b * SKV * 512 + kvh * 128;
    att::attn_dense_body(Qb, Kh, Vh, Qb, SKV, (char*)smem, tid);
    __syncthreads();
  }
}
__device__ __forceinline__ void final_norm_phase(const Params& P, const int tid) {
  const int wid = tid >> 6, lane = tid & 63;
  const int gw = P.bid * 8 + wid, NGW = P.grd * 8;
  f32x4 g4[8];
#pragma unroll
  for (int j = 0; j < 8; ++j) g4[j] = *(const f32x4*)(P.norm_final + j * 256 + lane * 4);
  for (int r = gw; r < MT; r += NGW) {
    float* xr = P.out + (size_t)r * DM;
    f32x4 v[8]; float ss = 0.f;
#pragma unroll
    for (int j = 0; j < 8; ++j) v[j] = *(const f32x4*)(xr + j * 256 + lane * 4);
#pragma unroll
    for (int j = 0; j < 8; ++j) ss += v[j].x * v[j].x + v[j].y * v[j].y + v[j].z * v[j].z + v[j].w * v[j].w;
    ss = wave_sum(ss);
    const float rs = rsqrtf(ss * (1.f / DM) + 1e-6f);
#pragma unroll
    for (int j = 0; j < 8; ++j) *(f32x4*)(xr + j * 256 + lane * 4) = v[j] * rs * g4[j];
  }
}


#define XB_TMO      128
#define XB_XCNT(j)  (256  + 64 * (j))
#define XB_XSUB(j)  (1280 + 64 * (j))
#define XB_XGEN(j)  (2304 + 64 * (j))
#define XB_TOP      3328
#define XB_TOPGEN   3392
#define XCD_BAR_WORDS 3456
#define XB_SPIN_CAP (1u << 18)
__device__ __forceinline__ unsigned xb_ld(unsigned* p)              { return __hip_atomic_load(p, __ATOMIC_RELAXED, __HIP_MEMORY_SCOPE_AGENT); }
__device__ __forceinline__ unsigned xb_add(unsigned* p, unsigned v) { return __hip_atomic_fetch_add(p, v, __ATOMIC_RELAXED, __HIP_MEMORY_SCOPE_AGENT); }
__device__ __forceinline__ unsigned xb_xcc_id() { return (unsigned)__builtin_amdgcn_s_getreg((3 << 11) | 20) & 0xFu; }
#define XB_SPIN(cond, bar) do { unsigned _sp = 0; while (cond) { __builtin_amdgcn_s_sleep(1); \
    if ((++_sp & 255u) == 0u) { if (xb_ld(&(bar)[XB_TMO])) break; if (_sp > XB_SPIN_CAP) { atomicAdd(&(bar)[XB_TMO], 1u); break; } } } } while (0)
__device__ __forceinline__ void xcd_barrier_complete(unsigned* bar, unsigned x, unsigned& nloc, unsigned& nx) {
    const unsigned G = gridDim.x * gridDim.y * gridDim.z;
    unsigned sum, cnt, mine, sp = 0u;
    for (;;) {
        sum = 0u; cnt = 0u; mine = 0u;
#pragma unroll
        for (unsigned j = 0; j < 16; ++j) { const unsigned c = xb_ld(&bar[XB_XCNT(j)]); sum += c; cnt += (c > 0u) ? 1u : 0u; mine = (j == x) ? c : mine; }
        if (sum == G) break;
        __builtin_amdgcn_s_sleep(1);
        if ((++sp & 255u) == 0u) { if (xb_ld(&bar[XB_TMO])) break; if (sp > XB_SPIN_CAP) { atomicAdd(&bar[XB_TMO], 1u); break; } }
    }
    nloc = mine > 0u ? mine : 1u; nx = cnt > 0u ? cnt : 1u;
}
__device__ __forceinline__ void xcd_barrier(unsigned* bar, volatile LAS unsigned* st) {
    asm volatile("s_waitcnt vmcnt(0)" ::: "memory");
    __syncthreads();
    if (threadIdx.x == 0) {
        __builtin_amdgcn_s_waitcnt(0);
        const unsigned x = xb_xcc_id();
        unsigned nloc = st[0], nx = st[1];
        if (nloc == 0u) { xcd_barrier_complete(bar, x, nloc, nx); st[0] = nloc; st[1] = nx; }
        const unsigned old = xb_add(&bar[XB_XSUB(x)], 1u);
        const unsigned gen = old / nloc;
        if (old + 1u == (gen + 1u) * nloc) {
            __builtin_amdgcn_fence(__ATOMIC_RELEASE, "agent");
            asm volatile("s_waitcnt vmcnt(0)" ::: "memory");
            const unsigned og = xb_add(&bar[XB_TOP], 1u);
            const unsigned tg = og / nx;
            if (og + 1u == (tg + 1u) * nx) xb_add(&bar[XB_TOPGEN], 1u);
            else XB_SPIN(xb_ld(&bar[XB_TOPGEN]) == tg, bar);
            __builtin_amdgcn_fence(__ATOMIC_ACQUIRE, "agent");
            xb_add(&bar[XB_XGEN(x)], 1u);
            asm volatile("s_waitcnt vmcnt(0)" ::: "memory");
        } else {
            XB_SPIN(xb_ld(&bar[XB_XGEN(x)]) == gen, bar);
            __builtin_amdgcn_fence(__ATOMIC_ACQUIRE, "agent");
            asm volatile("s_waitcnt vmcnt(0)" ::: "memory");
        }
    }
    __syncthreads();
}

constexpr int NPH = 20;
__device__ __forceinline__ bool gemm_desc(int ph, const Params& P, GemmDesc& d) {
  unsigned char* ws = P.ws;
  const bf16_t* H = (const bf16_t*)(ws + OFF_H);
  d.a_tiled = 0; d.nt0 = 0; d.nt1 = 0; d.ksplit1 = 1; d.G = P.grd; d.c = P.bid; d.A1 = nullptr; d.B1 = nullptr; d.pm01 = 0; d.nN1 = 1; d.n1 = 0; d.pm00 = 0; d.xin = nullptr; d.gidx = 0; d.gscale = 0.f; d.act = nullptr;
  switch (ph) {
  case 2: d.K = 2048; d.mode = M_SWIGLU; d.A0 = H; d.B0 = (const bf16_t*)(ws + OFF_W1A); d.nM0 = 132; d.nN0 = 44; d.act = (bf16_t*)(ws + OFF_ACT); break;
  case 3: d.a_tiled = 1; d.K = DFF; d.mode = M_RESID; d.A0 = (const bf16_t*)(ws + OFF_ACT); d.B0 = (const bf16_t*)(ws + OFF_W1B); d.nM0 = 128; d.nN0 = 8; d.xin = P.x; d.gidx = 2; d.gscale = 0.5f;
          d.A1 = d.A0; d.B1 = d.B0; d.pm01 = 128; d.nN1 = 8; d.ksplit1 = 4; d.nt1 = 22; d.n1 = 4 * 8 * 4; break;
  case 5: d.K = 2048; d.mode = M_RW; d.A0 = H; d.B0 = (const bf16_t*)(ws + OFF_WRW); d.nM0 = 132; d.nN0 = 14;
          d.A1 = H; d.B1 = (const bf16_t*)(ws + OFF_WQKVG) + (size_t)2048 * 2048; d.pm01 = 128; d.nN1 = 4; d.n1 = 16; break;
  case 7: d.K = 384; d.mode = M_LORA; d.A0 = (const bf16_t*)(ws + OFF_LIN); d.B0 = (const bf16_t*)(ws + OFF_WLORA); d.nM0 = 132; d.nN0 = 20; break;
  case 10: d.K = 2048; d.mode = M_QKVG; d.A0 = H; d.B0 = (const bf16_t*)(ws + OFF_WQKVG); d.nM0 = 128; d.nN0 = 28; break;
  case 13: d.K = 2048; d.mode = M_T1; d.A0 = (const bf16_t*)(ws + OFF_Q); d.B0 = (const bf16_t*)(ws + OFF_WOA); d.nM0 = 128; d.nN0 = 8; break;
  case 14: d.K = 1024; d.mode = M_M; d.A0 = (const bf16_t*)(ws + OFF_Y); d.B0 = (const bf16_t*)(ws + OFF_WOR); d.nM0 = 128; d.nN0 = 8; break;
  case 15: d.K = 2048; d.mode = M_RESID; d.A0 = (const bf16_t*)(ws + OFF_GR); d.B0 = (const bf16_t*)(ws + OFF_WOUT); d.nM0 = 128; d.nN0 = 8; d.xin = P.out; d.gidx = 5; d.gscale = 1.f; break;
  case 17: d.K = 2048; d.mode = M_SWIGLU; d.A0 = H; d.B0 = (const bf16_t*)(ws + OFF_W2A); d.nM0 = 128; d.nN0 = 44; d.act = (bf16_t*)(ws + OFF_ACT); break;
  case 18: d.a_tiled = 1; d.K = DFF; d.mode = M_RESID; d.A0 = (const bf16_t*)(ws + OFF_ACT); d.B0 = (const bf16_t*)(ws + OFF_W2B); d.nM0 = 128; d.nN0 = 8; d.xin = P.out; d.gidx = 8; d.gscale = 0.5f; break;
  default: return false;
  }
  d.n0 = d.nM0 * d.nN0;
  if (!d.nt0) d.nt0 = d.K / BK;
  if (!d.nt1) d.nt1 = d.K / BK;
  if (d.mode == M_LORA) d.nt0 = 2;
  return true;
}

__global__ void __launch_bounds__(512) mega_fwd(Params P) {
  extern __shared__ __attribute__((aligned(16))) unsigned char smem[];
  LAS unsigned char* lds = (LAS unsigned char*)smem;
  cg::grid_group grid = cg::this_grid();
  volatile LAS unsigned* bst = (volatile LAS unsigned*)(lds + LDS_BYTES + 192);
  unsigned* gbar = (unsigned*)(P.ws + OFF_BAR);
#if ONE_LAUNCH
  if (threadIdx.x == 0) { bst[0] = 0u; bst[1] = 0u; (void)xb_add(&gbar[XB_XCNT(xb_xcc_id())], 1u); }
  __syncthreads();
#endif
#pragma nounroll
  for (int ph = P.ph_lo; ph < P.ph_hi; ++ph) {
    GemmDesc d;
    int tid = threadIdx.x; asm volatile("" : "+v"(tid));
#if PROBE
    if (blockIdx.x == 0 && tid == 0) ((LAS unsigned long long*)(lds + LDS_BYTES))[ph] = __builtin_amdgcn_s_memrealtime();
#endif
    const __attribute__((address_space(4))) Params* kp = (const __attribute__((address_space(4))) Params*)__builtin_amdgcn_kernarg_segment_ptr();
    asm volatile("" : "+s"(kp));
#if defined(__HIP_DEVICE_COMPILE__)
    Params L = *kp;
#else
    Params L = P;
#endif
    { int b_ = blockIdx.x, g_ = gridDim.x; asm volatile("" : "+s"(b_), "+s"(g_)); L.bid = b_; L.grd = g_; }
    if (gemm_desc(ph, L, d)) gemm_phase(lds, d, L, tid);
    else switch (ph) {
      case 0: mod_phase(L, lds, tid); __syncthreads(); convert_phase(L, lds, tid); break;
      case 1: norm_mod_phase(L, L.x, L.ctx, MA, L.norm_ffn1, 0, nullptr, tid); break;
      case 4: norm_mod_phase(L, L.out, L.ctx, MA, L.norm_mix, 3, (const float*)(L.ws + OFF_PART), tid); break;
      case 6: shift_phase(L, tid); break;
      case 8: scan_phase(L, lds, tid); break;
      case 9: rwkv_out_phase(L, tid); break;
      case 11: rope_phase(L, tid); break;
      case 12: attn_phase(L, smem, tid); break;
      case 16: norm_mod_phase(L, L.out, nullptr, MT, L.norm_ffn2, 6, nullptr, tid); break;
      case 19: final_norm_phase(L, tid); break;
      default: break;
    }
    if (ph + 1 < P.ph_hi) { if (ph == 0) grid.sync(); else if (ph != 13 || !ONE_LAUNCH) xcd_barrier(gbar, bst); }
  }
#if PROBE
  grid.sync();
  if (blockIdx.x == 0) {
    LAS unsigned long long* TS = (LAS unsigned long long*)(lds + LDS_BYTES);
    if (threadIdx.x == 0) TS[NPH] = __builtin_amdgcn_s_memrealtime();
    __syncthreads();
    const int K = (int)((TS[PROBE_HI] - TS[PROBE_LO]) / 100ull);
    int t2 = threadIdx.x; asm volatile("" : "+v"(t2));
    for (int i = t2; i < K && i < 16000; i += 512) P.out[(size_t)i * 4099] += 0.1f;
  }
#endif
}

extern "C" void kernel_launch(void* const* d_in, const int* in_sizes, int n_in, void* d_out, int out_size, void* d_ws, size_t ws_size, hipStream_t stream) {
  static int grid_blocks = 0;
  if (!grid_blocks) {
    if (n_in != 31 || out_size != MT * DM || ws_size < WS_TOTAL) { fprintf(stderr, "kernel_launch: unexpected shapes n_in %d out %d ws %zu (need %zu)\n", n_in, out_size, ws_size, WS_TOTAL); return; }
    if (hipFuncSetAttribute((const void*)mega_fwd, hipFuncAttributeMaxDynamicSharedMemorySize, LDS_BYTES + 256) != hipSuccess) { fprintf(stderr, "kernel_launch: hipFuncSetAttribute failed\n"); return; }
    int dev = 0, cus = 0, per_cu = 0;
    hipGetDevice(&dev);
    hipDeviceGetAttribute(&cus, hipDeviceAttributeMultiprocessorCount, dev);
    hipOccupancyMaxActiveBlocksPerMultiprocessor(&per_cu, mega_fwd, 512, LDS_BYTES + 256);
    if (per_cu < 1) { fprintf(stderr, "kernel_launch: occupancy query returned %d\n", per_cu); per_cu = 1; }
    grid_blocks = cus;
  }
  Params p{};
  const float** pf = (const float**)&p;
  for (int i = 0; i < 31; ++i) pf[i] = (const float*)d_in[i];
  p.out = (float*)d_out; p.ws = (unsigned char*)d_ws; p.bid = 0; p.grd = 0;
#if ONE_LAUNCH
  p.ph_lo = 0; p.ph_hi = NPH;
  if (hipMemsetAsync((char*)d_ws + OFF_BAR, 0, 3456 * 4, stream) != hipSuccess) { fprintf(stderr, "kernel_launch: memset of barrier words failed\n"); return; }
  void* args[] = {&p};
  hipError_t e = hipLaunchCooperativeKernel((const void*)mega_fwd, dim3(grid_blocks), dim3(512), args, LDS_BYTES + 256, stream);
  if (e != hipSuccess) fprintf(stderr, "cooperative launch failed: %s (grid %d)\n", hipGetErrorString(e), grid_blocks);
#else
  for (int ph = 0; ph < NPH; ++ph) { p.ph_lo = ph; p.ph_hi = ph + 1; hipLaunchKernelGGL(mega_fwd, dim3(grid_blocks), dim3(512), LDS_BYTES + 256, stream, p); }
#endif
}
```

```cpp
#include <hip/hip_runtime.h>
#include <hip/hip_cooperative_groups.h>
#include <cstdio>
#include <cstdint>
namespace cg = cooperative_groups;

#ifndef ONE_LAUNCH
#define ONE_LAUNCH 1
#endif

#ifndef PROBE
#define PROBE 0
#endif
#define PROBE_LO 8
#define PROBE_HI 9
#define LAS __attribute__((address_space(3)))
typedef unsigned short bf16_t;
typedef short bf16x8 __attribute__((ext_vector_type(8)));
typedef short s16x4 __attribute__((ext_vector_type(4)));
typedef float f32x4 __attribute__((ext_vector_type(4)));
typedef float f32x2 __attribute__((ext_vector_type(2)));
typedef float f32x16 __attribute__((ext_vector_type(16)));
typedef unsigned u32x4 __attribute__((ext_vector_type(4)));
typedef unsigned u32x2 __attribute__((ext_vector_type(2)));

constexpr int DM = 2048, NB = 4, SEQ = 8192, CTXL = 256, MT = NB * SEQ, MC = NB * CTXL, MA = MT + MC;
constexpr int DFF = 5632, SKV = SEQ + CTXL, NMODC = 9 * DM;
constexpr int PRW_LD = 3584, SH_LD = 3072, LIN_LD = 384, LO_LD = 5120;
constexpr int LDS_BYTES = 139264;

constexpr size_t SZ_WA = (size_t)11264 * 2048 * 2, SZ_WB = (size_t)2048 * 5632 * 2;
constexpr size_t OFF_W1A = 0, OFF_W1B = OFF_W1A + SZ_WA, OFF_W2A = OFF_W1B + SZ_WB, OFF_W2B = OFF_W2A + SZ_WA;
constexpr size_t OFF_WRW = OFF_W2B + SZ_WB, OFF_WQKVG = OFF_WRW + (size_t)3584 * 2048 * 2, OFF_WOA = OFF_WQKVG + (size_t)7168 * 2048 * 2;
constexpr size_t OFF_WOR = OFF_WOA + (size_t)2048 * 2048 * 2, OFF_WOUT = OFF_WOR + (size_t)2048 * 1024 * 2, OFF_WLORA = OFF_WOUT + (size_t)2048 * 2048 * 2;
constexpr size_t OFF_MOD = OFF_WLORA + (size_t)5120 * 384 * 2, OFF_CX = OFF_MOD + (size_t)5 * NMODC * 4, OFF_H = OFF_CX + (size_t)MC * DM * 4;
constexpr size_t OFF_BIG = OFF_H + (size_t)MA * DM * 2;
constexpr size_t SZ_KV = (size_t)NB * SKV * 512 * 2;
constexpr size_t OFF_KB = OFF_W1A, OFF_VB = OFF_KB + SZ_KV;
static_assert(OFF_VB + SZ_KV <= OFF_W2A, "KV overlay");
constexpr size_t OFF_ACT = OFF_BIG;
constexpr size_t OFF_PART = OFF_ACT + (size_t)MA * DFF * 2;
constexpr size_t OFF_PRW = OFF_BIG, OFF_LO = OFF_BIG, OFF_SH = OFF_LO + (size_t)MA * LO_LD * 2, OFF_LIN = OFF_SH + (size_t)MA * SH_LD * 2, OFF_Y = OFF_LIN;
constexpr size_t OFF_Q = OFF_BIG, OFF_GA = OFF_Q + (size_t)MT * DM * 2, OFF_GR = OFF_GA + (size_t)MT * DM * 2;
constexpr size_t END_A = OFF_ACT + (size_t)MA * DFF * 2, END_B = OFF_Y + (size_t)2 * MT * 1024 * 2, END_C = OFF_LIN + (size_t)MA * LIN_LD * 2;
constexpr size_t WS_END = END_A > END_B ? (END_A > END_C ? END_A : END_C) : (END_B > END_C ? END_B : END_C);
constexpr size_t OFF_BAR = (WS_END + 255) / 256 * 256, WS_TOTAL = OFF_BAR + 3456 * 4;
static_assert((size_t)MA * PRW_LD * 2 <= (size_t)MA * LO_LD * 2, "PRW under LO");
static_assert(OFF_GR + (size_t)MT * DM * 2 <= OFF_Y, "GR below RWO");

struct Params {
  const float *x, *c, *ctx, *c_ctx, *w_mod, *b_mod, *norm_ffn1, *ffn1_w_in, *ffn1_w_out, *norm_mix, *w_in, *q_norm, *k_norm, *rwkv_mu, *w0, *w2, *a0, *a2,
      *g2, *k_k, *k_a, *r_k, *ln_x_w, *ln_x_b, *w_oa, *w_or, *w_out, *norm_ffn2, *ffn2_w_in, *ffn2_w_out, *norm_final;
  float* out; unsigned char* ws; int ph_lo, ph_hi; int bid, grd;
};

__device__ __forceinline__ unsigned cvt_pk_bf16(float lo, float hi) { unsigned r; asm("v_cvt_pk_bf16_f32 %0, %1, %2" : "=v"(r) : "v"(lo), "v"(hi)); return r; }
__device__ __forceinline__ float bf2f(unsigned short b) { return __uint_as_float(((unsigned)b) << 16); }
__device__ __forceinline__ float bflo(unsigned w) { return __uint_as_float(w << 16); }
__device__ __forceinline__ float bfhi(unsigned w) { return __uint_as_float(w & 0xffff0000u); }
__device__ __forceinline__ unsigned short f2bf(float f) { return (unsigned short)(cvt_pk_bf16(f, 0.f) & 0xffffu); }
__device__ __forceinline__ float sigmoidf_(float x) { return __builtin_amdgcn_rcpf(1.f + __builtin_amdgcn_exp2f(-1.4426950408889634f * x)); }
template <int CTRL> __device__ __forceinline__ float dpp_mov(float x) { return __int_as_float(__builtin_amdgcn_update_dpp(0, __float_as_int(x), CTRL, 0xF, 0xF, true)); }
__device__ __forceinline__ float allred16(float x) {
  x += dpp_mov<0xB1>(x); x += dpp_mov<0x4E>(x); x += dpp_mov<0x141>(x); x += dpp_mov<0x140>(x); return x;
}

__device__ __forceinline__ float wave_sum(float v) {
  v = allred16(v);
  { auto rr = __builtin_amdgcn_permlane16_swap(__float_as_uint(v), __float_as_uint(v), false, false); v = __uint_as_float(rr[0]) + __uint_as_float(rr[1]); }
  { auto rr = __builtin_amdgcn_permlane32_swap(__float_as_uint(v), __float_as_uint(v), false, false); v = __uint_as_float(rr[0]) + __uint_as_float(rr[1]); }
  return v;
}

constexpr int BM = 256, BK = 64, HALF = 128, HTB = HALF * BK * 2;
__device__ __forceinline__ int lds_byte(int r, int c) { const int st = (r >> 4) * 2 + (c >> 5), rr = r & 15, cc = c & 31, ob = rr * 64 + cc * 2; return st * 1024 + (ob ^ (((ob >> 9) & 1) << 5)); }
__device__ __forceinline__ void stage_rc(int b, int& R, int& C) { const int st = b / 1024, sb = b % 1024, swz = sb ^ (((sb >> 9) & 1) << 5); R = (st >> 1) * 16 + swz / 64; C = (st & 1) * 32 + (swz % 64) / 2; }
__device__ __forceinline__ int perm32(int rho) { const int n = rho >> 4, i = rho & 15; return 8 * (i >> 2) + 4 * n + (i & 3); }

enum { M_SWIGLU = 0, M_RESID = 1, M_RW = 2, M_QKVG = 3, M_LORA = 4, M_T1 = 5, M_M = 6 };
struct Unit { const char* A; const char* B; int pm, pn, seg, nt; };
struct GemmDesc {
  int K, mode, G, c;
  const bf16_t *A0, *B0; int pm00, nM0, nN0, n0;
  const bf16_t *A1, *B1; int pm01, nN1, n1;
  int a_tiled;
  int nt0, nt1, ksplit1;
  const float* xin; int gidx; float gscale;
  bf16_t* act;
};
__device__ __forceinline__ bool sched_next(const GemmDesc& d, int i, Unit& u) {
  long L = (long)i * d.G + d.c;
  if (L < d.n0) {
    int wgid = (int)L; const int nwg = d.n0;
    { const int q = nwg / 8, r = nwg % 8, xcd = wgid % 8, off = wgid / 8; wgid = (xcd < r ? xcd * (q + 1) : r * (q + 1) + (xcd - r) * q) + off; }
    const int nig = 8 * d.nN0, gid = wgid / nig, fm = gid * 8, gsz = (d.nM0 - fm) < 8 ? (d.nM0 - fm) : 8;
    const int pm = fm + ((wgid % nig) % gsz), pn = (wgid % nig) / gsz;
    u.pm = d.pm00 + pm; u.pn = pn; u.seg = 0; u.nt = d.nt0;
    u.A = (const char*)d.A0 + (size_t)u.pm * 512 * d.K; u.B = (const char*)d.B0 + (size_t)pn * 512 * d.K;
    if (d.mode == M_LORA) { const int ko = (pn < 8 ? 0 : (pn < 16 ? 128 : 256)) * 2; u.A += ko; u.B += ko; }
    return true;
  }
  L -= d.n0;
  if (L < d.n1) {
    const int sp = (int)L % d.ksplit1, l2 = (int)L / d.ksplit1;
    const int pm = l2 / d.nN1, pn = l2 % d.nN1; u.pm = d.pm01 + pm; u.pn = pn; u.seg = 1 + sp; u.nt = d.nt1;
    const size_t ko = (size_t)sp * d.nt1 * 128, koA = d.a_tiled ? (size_t)sp * d.nt1 * 32768 : ko;
    u.A = (const char*)d.A1 + (size_t)u.pm * 512 * d.K + koA; u.B = (const char*)d.B1 + (size_t)pn * 512 * d.K + ko; return true;
  }
  return false;
}

__device__ __forceinline__ void gemm_epilogue(const f32x4 (&acc)[2][2][4][2], const Unit& u, const GemmDesc& d, const Params& P, int wr, int wc, int fr, int fq) {
  unsigned char* ws = P.ws;
  asm volatile("" : "+v"(fr), "+v"(fq));
  const int rl0 = wr * 64 + fr, cl0 = wc * 32 + 8 * fq;
  switch (d.mode) {
  case M_SWIGLU: {
    bf16_t* base = d.act + ((size_t)(u.pm * 88 + u.pn * 2 + (cl0 >> 6)) * 256) * 64 + (cl0 & 63);
#pragma unroll
    for (int ai = 0; ai < 2; ++ai)
#pragma unroll
      for (int m = 0; m < 4; ++m) {
        const int row = rl0 + 128 * ai + 16 * m;
        float o[8];
#pragma unroll
        for (int n = 0; n < 2; ++n)
#pragma unroll
          for (int j = 0; j < 4; ++j) { const float g = acc[ai][0][m][n][j], up = acc[ai][1][m][n][j]; o[4 * n + j] = g * sigmoidf_(g) * up; }
        u32x4 w; w.x = cvt_pk_bf16(o[0], o[1]); w.y = cvt_pk_bf16(o[2], o[3]); w.z = cvt_pk_bf16(o[4], o[5]); w.w = cvt_pk_bf16(o[6], o[7]);
        *(u32x4*)(base + (size_t)row * 64) = w;
      }
  } break;
  case M_RESID: {
    if (u.seg >= 1) {
      float* po = (float*)(ws + OFF_PART) + (size_t)(u.seg - 1) * MC * DM + (size_t)(u.pm - 128) * 256 * DM + u.pn * 256 + cl0;
#pragma unroll
      for (int ai = 0; ai < 2; ++ai)
#pragma unroll
        for (int m = 0; m < 4; ++m)
#pragma unroll
          for (int bj = 0; bj < 2; ++bj)
#pragma unroll
            for (int n = 0; n < 2; ++n) *(f32x4*)(po + (size_t)(rl0 + 128 * ai + 16 * m) * DM + 128 * bj + 4 * n) = acc[ai][bj][m][n];
      break;
    }
    const bool isc = u.pm >= 128; const int b = isc ? 4 : (u.pm >> 5);
    const float* xin = isc ? P.ctx + (size_t)(u.pm - 128) * 256 * DM : d.xin + (size_t)u.pm * 256 * DM;
    float* xo = isc ? (float*)(ws + OFF_CX) + (size_t)(u.pm - 128) * 256 * DM : P.out + (size_t)u.pm * 256 * DM;
    const float* gate = (const float*)(ws + OFF_MOD) + b * NMODC + d.gidx * DM + u.pn * 256 + cl0;
    f32x4 g4[2][2];
#pragma unroll
    for (int bj = 0; bj < 2; ++bj)
#pragma unroll
      for (int n = 0; n < 2; ++n) g4[bj][n] = *(const f32x4*)(gate + 128 * bj + 4 * n) * d.gscale;
#pragma unroll
    for (int ai = 0; ai < 2; ++ai)
#pragma unroll
      for (int m = 0; m < 4; ++m) {
        const size_t ro = (size_t)(rl0 + 128 * ai + 16 * m) * DM + u.pn * 256 + cl0;
#pragma unroll
        for (int bj = 0; bj < 2; ++bj)
#pragma unroll
          for (int n = 0; n < 2; ++n) {
            const f32x4 xv = *(const f32x4*)(xin + ro + 128 * bj + 4 * n);
            *(f32x4*)(xo + ro + 128 * bj + 4 * n) = xv + g4[bj][n] * acc[ai][bj][m][n];
          }
      }
  } break;
  case M_RW: case M_QKVG: case M_LORA: {
    bf16_t* base; int ld; int act = 0; const float* bias = nullptr;
    if (d.mode == M_RW) {
      if (u.seg == 0) { base = (bf16_t*)(ws + OFF_PRW) + (size_t)u.pm * 256 * PRW_LD + u.pn * 256; ld = PRW_LD; }
      else { const int b = u.pm - 128; base = (bf16_t*)(ws + (u.pn < 2 ? OFF_KB : OFF_VB)) + (size_t)(b * SKV + SEQ) * 512 + (u.pn & 1) * 256; ld = 512; }
    } else if (d.mode == M_QKVG) {
      const int b = u.pm >> 5;
      if (u.pn < 8) { base = (bf16_t*)(ws + OFF_Q) + (size_t)u.pm * 256 * DM + u.pn * 256; ld = DM; }
      else if (u.pn < 12) { base = (bf16_t*)(ws + (u.pn < 10 ? OFF_KB : OFF_VB)) + (size_t)(u.pm * 256 + b * CTXL) * 512 + (u.pn & 1) * 256; ld = 512; }
      else { base = (bf16_t*)(ws + (u.pn < 20 ? OFF_GA : OFF_GR)) + (size_t)u.pm * 256 * DM + ((u.pn - 12) & 7) * 256; ld = DM; act = 1; }
    } else {
      base = (bf16_t*)(ws + OFF_LO) + (size_t)u.pm * 256 * LO_LD + u.pn * 256; ld = LO_LD;
      if (u.pn < 8) { act = 2; bias = P.w0 + u.pn * 256; } else if (u.pn < 16) { act = 1; bias = P.a0 + (u.pn - 8) * 256; }
    }
#pragma unroll
    for (int bj = 0; bj < 2; ++bj) {
      f32x4 b0 = {0.f, 0.f, 0.f, 0.f}, b1 = {0.f, 0.f, 0.f, 0.f};
      if (bias) { b0 = *(const f32x4*)(bias + 128 * bj + cl0); b1 = *(const f32x4*)(bias + 128 * bj + cl0 + 4); }
#pragma unroll
      for (int ai = 0; ai < 2; ++ai)
#pragma unroll
        for (int m = 0; m < 4; ++m) {
          const int row = rl0 + 128 * ai + 16 * m;
          f32x4 v0 = acc[ai][bj][m][0] + b0, v1 = acc[ai][bj][m][1] + b1;
          if (act) {
            const float sc = act == 2 ? 0.60653065971263342f * 1.4426950408889634f : 1.f;
#pragma unroll
            for (int j = 0; j < 4; ++j) { v0[j] = sc * sigmoidf_(v0[j]); v1[j] = sc * sigmoidf_(v1[j]); }
          }
          u32x4 w; w.x = cvt_pk_bf16(v0[0], v0[1]); w.y = cvt_pk_bf16(v0[2], v0[3]); w.z = cvt_pk_bf16(v1[0], v1[1]); w.w = cvt_pk_bf16(v1[2], v1[3]);
          *(u32x4*)(base + (size_t)row * ld + 128 * bj + cl0) = w;
        }
    }
  } break;
  case M_T1: case M_M: {
    bf16_t* ga = (bf16_t*)(ws + OFF_GA) + (size_t)u.pm * 256 * DM + u.pn * 256 + cl0;
    bf16_t* gr = (bf16_t*)(ws + OFF_GR) + (size_t)u.pm * 256 * DM + u.pn * 256 + cl0;
    const bool isM = d.mode == M_M;
#pragma unroll
    for (int ai = 0; ai < 2; ++ai)
#pragma unroll
      for (int m = 0; m < 4; ++m)
#pragma unroll
        for (int bj = 0; bj < 2; ++bj) {
          const size_t o = (size_t)(rl0 + 128 * ai + 16 * m) * DM + 128 * bj;
          const f32x4 v0 = acc[ai][bj][m][0], v1 = acc[ai][bj][m][1];
          const u32x4 a = *(const u32x4*)(ga + o);
          u32x4 w;
          if (!isM) {
            w.x = cvt_pk_bf16(bflo(a.x) * v0[0], bfhi(a.x) * v0[1]); w.y = cvt_pk_bf16(bflo(a.y) * v0[2], bfhi(a.y) * v0[3]);
            w.z = cvt_pk_bf16(bflo(a.z) * v1[0], bfhi(a.z) * v1[1]); w.w = cvt_pk_bf16(bflo(a.w) * v1[2], bfhi(a.w) * v1[3]);
            *(u32x4*)(ga + o) = w;
          } else {
            const u32x4 g = *(const u32x4*)(gr + o);
            w.x = cvt_pk_bf16(bflo(a.x) + bflo(g.x) * v0[0], bfhi(a.x) + bfhi(g.x) * v0[1]); w.y = cvt_pk_bf16(bflo(a.y) + bflo(g.y) * v0[2], bfhi(a.y) + bfhi(g.y) * v0[3]);
            w.z = cvt_pk_bf16(bflo(a.z) + bflo(g.z) * v1[0], bfhi(a.z) + bfhi(g.z) * v1[1]); w.w = cvt_pk_bf16(bflo(a.w) + bflo(g.w) * v1[2], bfhi(a.w) + bfhi(g.w) * v1[3]);
            *(u32x4*)(gr + o) = w;
          }
        }
  } break;
  }
}

__device__ __forceinline__ void gemm_phase(LAS unsigned char* lds, const GemmDesc& d, const Params& P, const int tid) {
  const int wid = __builtin_amdgcn_readfirstlane(tid >> 6), lane = tid & 63, wr = wid >> 2, wc = wid & 3, fr = lane & 15, fq = lane >> 4;
  const int K = d.K;
  unsigned voffA[2], voffB[2];
#pragma unroll
  for (int i = 0; i < 2; ++i) { int R, C; stage_rc(tid * 16 + i * 8192, R, C); const int Rb = (R & ~31) + perm32(R & 31);
    voffA[i] = d.a_tiled ? (unsigned)(R * 64 + C) * 2u : (unsigned)(R * K + C) * 2u; voffB[i] = (unsigned)(Rb * K + C) * 2u; }
  const size_t kstep = (size_t)(BK * 2);
  const size_t hstep = (size_t)HALF * K * 2;
  const size_t kstepA = d.a_tiled ? (size_t)32768 : kstep, hstepA = d.a_tiled ? (size_t)16384 : hstep;
  const unsigned ldsw = (unsigned)wid * 1024u;
  const int aoff = lds_byte(wr * 64 + fr, fq * 8), boff = lds_byte(wc * 32 + fr, fq * 8);
#define PG8_SA(b, h) (((b) * 2 + (h)) * HTB)
#define PG8_SB(b, h) ((4 + (b) * 2 + (h)) * HTB)
#define PG8_STAGE(bufoff, gbase, voff) do { _Pragma("unroll") for (int _i = 0; _i < 2; ++_i) \
    __builtin_amdgcn_global_load_lds((const unsigned*)((const char*)(gbase) + (voff)[_i]), (LAS unsigned*)(lds + (bufoff) + ldsw + _i * 8192), 16, 0, 0); } while (0)
#define PG8_LDA(dst, b, h) do { _Pragma("unroll") for (int m = 0; m < 4; ++m) _Pragma("unroll") for (int k = 0; k < 2; ++k) dst[m][k] = *(const LAS bf16x8*)(lds + PG8_SA(b, h) + aoff + m * 2048 + k * 1024); } while (0)
#define PG8_LDB(dst, b, h) do { _Pragma("unroll") for (int n = 0; n < 2; ++n) _Pragma("unroll") for (int k = 0; k < 2; ++k) dst[n][k] = *(const LAS bf16x8*)(lds + PG8_SB(b, h) + boff + n * 2048 + k * 1024); } while (0)
#define PG8_MMA(ai, bj, At, Bt) do { __builtin_amdgcn_s_setprio(1); _Pragma("unroll") for (int m = 0; m < 4; ++m) _Pragma("unroll") for (int n = 0; n < 2; ++n) _Pragma("unroll") for (int k = 0; k < 2; ++k) \
    acc[ai][bj][m][n] = __builtin_amdgcn_mfma_f32_16x16x32_bf16(Bt[n][k], At[m][k], acc[ai][bj][m][n], 0, 0, 0); __builtin_amdgcn_s_setprio(0); } while (0)
#define PG8_WAIT_V(n) asm volatile("s_waitcnt vmcnt(" #n ")" ::: "memory")
#define PG8_WAIT_L(n) asm volatile("s_waitcnt lgkmcnt(" #n ")" ::: "memory")
#define PG8_BAR __builtin_amdgcn_s_barrier()
#define PG8_SCHED __builtin_amdgcn_sched_barrier(0)
  Unit cur, nxt; int ui = 0;
  if (!sched_next(d, 0, cur)) return;
  f32x4 acc[2][2][4][2];
#pragma unroll
  for (int a = 0; a < 2; ++a)
#pragma unroll
    for (int b = 0; b < 2; ++b)
#pragma unroll
      for (int m = 0; m < 4; ++m)
#pragma unroll
        for (int n = 0; n < 2; ++n) acc[a][b][m][n] = (f32x4){0.f, 0.f, 0.f, 0.f};
  bf16x8 At[4][2], B0[2][2], B1[2][2];
  const char* cA = cur.A; const char* cB = cur.B;
  PG8_STAGE(PG8_SB(0, 0), cB, voffB); PG8_STAGE(PG8_SB(0, 1), cB + hstep, voffB); PG8_STAGE(PG8_SA(0, 0), cA, voffA); PG8_STAGE(PG8_SA(0, 1), cA + hstepA, voffA);
  if (wr == 1) PG8_BAR;
  PG8_WAIT_V(2); PG8_BAR;
  PG8_STAGE(PG8_SB(1, 0), cB + kstep, voffB); PG8_STAGE(PG8_SA(1, 0), cA + kstepA, voffA); PG8_STAGE(PG8_SB(1, 1), cB + hstep + kstep, voffB);
  PG8_WAIT_V(6); PG8_BAR;
  for (;;) {
    const bool has_next = sched_next(d, ui + 1, nxt);
    const char* nA = has_next ? nxt.A : cA; const char* nB = has_next ? nxt.B : cB;
    const int nt = cur.nt;
    for (int t = 0; t < nt; t += 2) {
      const bool last = (t == nt - 2);
      const char* a1 = cA + (size_t)(t + 1) * kstepA;
      const char* a2 = last ? nA : cA + (size_t)(t + 2) * kstepA; const char* b2 = last ? nB : cB + (size_t)(t + 2) * kstep;
      const char* a3 = a2 + kstepA; const char* b3 = b2 + kstep;
      PG8_LDB(B0, 0, 0); PG8_LDB(B1, 0, 1); PG8_SCHED; PG8_LDA(At, 0, 0); PG8_STAGE(PG8_SA(1, 1), a1 + hstepA, voffA);
      PG8_WAIT_V(8); PG8_WAIT_L(0); PG8_BAR; PG8_MMA(0, 0, At, B0); PG8_MMA(0, 1, At, B1); PG8_BAR; PG8_SCHED;
      PG8_LDA(At, 0, 1); PG8_STAGE(PG8_SB(0, 0), b2, voffB); PG8_STAGE(PG8_SB(0, 1), b2 + hstep, voffB); PG8_STAGE(PG8_SA(0, 0), a2, voffA);
      PG8_WAIT_V(8); PG8_WAIT_L(0); PG8_BAR; PG8_MMA(1, 0, At, B0); PG8_MMA(1, 1, At, B1); PG8_BAR; PG8_SCHED;
      PG8_LDB(B0, 1, 0); PG8_LDB(B1, 1, 1); PG8_SCHED; PG8_LDA(At, 1, 0); PG8_STAGE(PG8_SA(0, 1), a2 + hstepA, voffA);
      PG8_WAIT_V(8); PG8_WAIT_L(0); PG8_BAR; PG8_MMA(0, 0, At, B0); PG8_MMA(0, 1, At, B1); PG8_BAR; PG8_SCHED;
      PG8_LDA(At, 1, 1); PG8_STAGE(PG8_SB(1, 0), b3, voffB); PG8_STAGE(PG8_SB(1, 1), b3 + hstep, voffB); PG8_STAGE(PG8_SA(1, 0), a3, voffA);
      PG8_WAIT_V(8); PG8_WAIT_L(0); PG8_BAR; PG8_MMA(1, 0, At, B0); PG8_MMA(1, 1, At, B1); PG8_BAR; PG8_SCHED;
    }
    if (wr == 0) PG8_BAR;
    gemm_epilogue(acc, cur, d, P, wr, wc, fr, fq);
    if (!has_next) break;
#pragma unroll
    for (int a = 0; a < 2; ++a)
#pragma unroll
      for (int b = 0; b < 2; ++b)
#pragma unroll
        for (int m = 0; m < 4; ++m)
#pragma unroll
          for (int n = 0; n < 2; ++n) acc[a][b][m][n] = (f32x4){0.f, 0.f, 0.f, 0.f};
    cur = nxt; cA = nA; cB = nB; ++ui;
    if (wr == 1) PG8_BAR;
  }
  PG8_WAIT_V(0);
  PG8_BAR;
#undef PG8_SA
#undef PG8_SB
#undef PG8_STAGE
#undef PG8_LDA
#undef PG8_LDB
#undef PG8_MMA
#undef PG8_WAIT_V
#undef PG8_WAIT_L
#undef PG8_BAR
#undef PG8_SCHED
}

namespace att {
constexpr int D = 128, NW = 8, QBLK = 32, KVBLK = 64;
constexpr float SCALE = 0.088388347648318440f;
constexpr float THR = 8.f;
constexpr int LDQ = 2048, LDK = 512, LDO = 2048;
constexpr size_t SHM_V = KVBLK * D * 2, SHM_K = KVBLK * D * 2;
#define KSWZ(row, colB) ((row) * 256 + ((colB) ^ (((row) & 7) << 4)))
#define SBAR() __builtin_amdgcn_sched_barrier(0)
__device__ __forceinline__ int crow(int r, int hi) { return (r & 3) + 8 * (r >> 2) + 4 * hi; }
__device__ __forceinline__ unsigned cvtpk(float lo, float hi) { unsigned r; asm volatile("v_cvt_pk_bf16_f32 %0, %1, %2" : "=v"(r) : "v"(lo), "v"(hi)); return r; }
__device__ __forceinline__ void partialSM(f32x16& p0, f32x16& p1, float& m_reg, float& mn, float& alpha) {
  constexpr float C = SCALE * 1.4426950408889634f;
  float pmax = p0[0];
#pragma unroll
  for (int r = 1; r < 16; ++r) pmax = fmaxf(pmax, p0[r]);
#pragma unroll
  for (int r = 0; r < 16; ++r) pmax = fmaxf(pmax, p1[r]);
  { auto rr = __builtin_amdgcn_permlane32_swap(__float_as_uint(pmax), __float_as_uint(pmax), false, false);
    pmax = fmaxf(__uint_as_float(rr[0]), __uint_as_float(rr[1])); }
  if (__builtin_expect(__all(pmax - m_reg <= THR / SCALE), 1)) { mn = m_reg; alpha = 1.f; }
  else { mn = fmaxf(m_reg, pmax); alpha = __builtin_amdgcn_exp2f((m_reg - mn) * C); m_reg = mn; }
  float mnC = -mn * C;
#pragma unroll
  for (int r = 0; r < 16; ++r) p0[r] = fmaf(p0[r], C, mnC);
#pragma unroll
  for (int r = 0; r < 16; ++r) p1[r] = fmaf(p1[r], C, mnC);
#pragma unroll
  for (int r = 0; r < 16; ++r) p0[r] = __builtin_amdgcn_exp2f(p0[r]);
}
__device__ __forceinline__ void finishSM(f32x16& p0, f32x16& p1, float alpha, float& l_reg, bf16x8& pa0, bf16x8& pa1, bf16x8& pa2, bf16x8& pa3) {
#pragma unroll
  for (int r = 0; r < 16; ++r) p1[r] = __builtin_amdgcn_exp2f(p1[r]);
  float ps = 0;
#pragma unroll
  for (int r = 0; r < 16; ++r) ps += p0[r];
#pragma unroll
  for (int r = 0; r < 16; ++r) ps += p1[r];
  { auto rr = __builtin_amdgcn_permlane32_swap(__float_as_uint(ps), __float_as_uint(ps), false, false);
    ps = __uint_as_float(rr[0]) + __uint_as_float(rr[1]); }
  l_reg = l_reg * alpha + ps;
#define PK4(P, BASE, OUT) do { unsigned a0 = cvtpk(P[BASE + 0], P[BASE + 1]), a1 = cvtpk(P[BASE + 2], P[BASE + 3]);   \
    unsigned b0 = cvtpk(P[BASE + 4], P[BASE + 5]), b1 = cvtpk(P[BASE + 6], P[BASE + 7]);                              \
    auto r0 = __builtin_amdgcn_permlane32_swap(a0, b0, false, false); auto r1 = __builtin_amdgcn_permlane32_swap(a1, b1, false, false); \
    u32x4 w = {r0[0], r1[0], r0[1], r1[1]}; OUT = *reinterpret_cast<bf16x8*>(&w); } while (0)
  PK4(p0, 0, pa0); PK4(p0, 8, pa1); PK4(p1, 0, pa2); PK4(p1, 8, pa3);
#undef PK4
}
__device__ __forceinline__ void qkt(f32x16& p0, f32x16& p1, const bf16_t* Ks, const bf16x8* qr, int r32, int hi) {
  p0 = f32x16{}; p1 = f32x16{};
#pragma unroll
  for (int d0 = 0; d0 < 8; ++d0) { int cb = (d0 * 16 + hi * 8) * 2;
    bf16x8 b0 = *reinterpret_cast<const bf16x8*>((const char*)Ks + KSWZ(r32, cb));
    bf16x8 b1 = *reinterpret_cast<const bf16x8*>((const char*)Ks + KSWZ(32 + r32, cb));
    p0 = __builtin_amdgcn_mfma_f32_32x32x16_bf16(b0, qr[d0], p0, 0, 0, 0);
    p1 = __builtin_amdgcn_mfma_f32_32x32x16_bf16(b1, qr[d0], p1, 0, 0, 0); }
}
__device__ __forceinline__ int v_st(int k, int c) { const int kk = (k & ~0xC) | ((k & 4) << 1) | ((k & 8) >> 1); return ((kk >> 3) * 4 + (c >> 5)) * 512 + ((kk & 7) * 32 + (c & 31)) * 2; }
__device__ __forceinline__ int v_rd_base(int lane) { return ((lane & 3) << 3) | (((lane >> 2) & 3) << 6) | (((lane >> 4) & 1) << 5) | (((lane >> 5) & 1) << 8); }
constexpr int v_rd_off(int d0, int ks, int half) { return d0 * 512 + ks * 4096 + half * 2048; }
template <int OFF> __device__ __forceinline__ s16x4 tr_read(int vb) {
  s16x4 r; asm volatile("ds_read_b64_tr_b16 %0, %1 offset:%2" : "=&v"(r) : "v"(vb), "i"(OFF) : "memory"); return r;
}
template <int D0> __device__ __forceinline__ void pv_one(f32x16& od, int vb, bf16x8 pa0, bf16x8 pa1, bf16x8 pa2, bf16x8 pa3) {
  const s16x4 l0 = tr_read<v_rd_off(D0, 0, 0)>(vb), h0 = tr_read<v_rd_off(D0, 0, 1)>(vb), l1 = tr_read<v_rd_off(D0, 1, 0)>(vb), h1 = tr_read<v_rd_off(D0, 1, 1)>(vb);
  const s16x4 l2 = tr_read<v_rd_off(D0, 2, 0)>(vb), h2 = tr_read<v_rd_off(D0, 2, 1)>(vb), l3 = tr_read<v_rd_off(D0, 3, 0)>(vb), h3 = tr_read<v_rd_off(D0, 3, 1)>(vb);
  asm volatile("s_waitcnt lgkmcnt(0)" ::: "memory"); SBAR();
#define PK(L, H) (bf16x8){L[0], L[1], L[2], L[3], H[0], H[1], H[2], H[3]}
  od = __builtin_amdgcn_mfma_f32_32x32x16_bf16(pa0, PK(l0, h0), od, 0, 0, 0);
  od = __builtin_amdgcn_mfma_f32_32x32x16_bf16(pa1, PK(l1, h1), od, 0, 0, 0);
  od = __builtin_amdgcn_mfma_f32_32x32x16_bf16(pa2, PK(l2, h2), od, 0, 0, 0);
  od = __builtin_amdgcn_mfma_f32_32x32x16_bf16(pa3, PK(l3, h3), od, 0, 0, 0);
#undef PK
}
__device__ __forceinline__ void pv_d0(f32x16* o, int vb, bf16x8 pa0, bf16x8 pa1, bf16x8 pa2, bf16x8 pa3) {
  pv_one<0>(o[0], vb, pa0, pa1, pa2, pa3); pv_one<1>(o[1], vb, pa0, pa1, pa2, pa3); pv_one<2>(o[2], vb, pa0, pa1, pa2, pa3); pv_one<3>(o[3], vb, pa0, pa1, pa2, pa3);
}
__device__ __forceinline__ void attn_dense_body(const bf16_t* __restrict__ Qb, const bf16_t* __restrict__ Kh, const bf16_t* __restrict__ Vh,
                                                bf16_t* __restrict__ Ob, int seq, char* lds, const int tid) {
  const int wid = tid >> 6, lane = tid & 63, r32 = lane & 31, hi = lane >> 5;
  bf16_t* V_lds = (bf16_t*)lds; bf16_t* K_lds = (bf16_t*)(lds + 2 * SHM_V);
  float* wsf = (float*)(lds + 2 * SHM_V + 2 * SHM_K) + wid * 64; float* li_l = wsf; float* al_l = wsf + 32;
  float m_reg = -1e30f, l_reg = 0; f32x16 o[4] = {}; bf16x8 qr[8];
  const bf16_t* Qw = Qb + (long)(wid * QBLK + r32) * LDQ + hi * 8;
#pragma unroll
  for (int d0 = 0; d0 < 8; ++d0) qr[d0] = *reinterpret_cast<const bf16x8*>(Qw + d0 * 16);
  const int sr = tid >> 4, sc = (tid & 15) * 8, vst0 = v_st(sr, sc), vst1 = v_st(32 + sr, sc);
  const int vb0 = (int)(uintptr_t)V_lds + v_rd_base(lane);
  struct { bf16x8 vs0, vs1, ks0, ks1; } sr_[2];
#define LD8(p) (*reinterpret_cast<const bf16x8*>(p))
  const unsigned voff = (unsigned)(sr * LDK + sc) * 2u;
#define SLOAD(i, k0) do { const char* vb_ = (const char*)(Vh + (size_t)(k0) * LDK); const char* kb_ = (const char*)(Kh + (size_t)(k0) * LDK); \
    sr_[i].vs0 = LD8(vb_ + voff); sr_[i].vs1 = LD8(vb_ + 32 * LDK * 2 + voff); sr_[i].ks0 = LD8(kb_ + voff); sr_[i].ks1 = LD8(kb_ + 32 * LDK * 2 + voff); } while (0)
#define SWRITE(b, i) do { *(bf16x8*)((char*)V_lds + (b) * SHM_V + vst0) = sr_[i].vs0;          \
    *(bf16x8*)((char*)V_lds + (b) * SHM_V + vst1) = sr_[i].vs1; int kc = sc * 2;               \
    *(bf16x8*)((char*)K_lds + (b) * SHM_K + KSWZ(sr, kc)) = sr_[i].ks0;                       \
    *(bf16x8*)((char*)K_lds + (b) * SHM_K + KSWZ(32 + sr, kc)) = sr_[i].ks1; } while (0)
#define SWAIT() asm volatile("s_waitcnt vmcnt(4)" ::: "memory")
#define RESC(a) do { if (__any((a) < 1.f)) { if (hi == 0) al_l[r32] = (a); asm volatile("s_waitcnt lgkmcnt(0)" ::: "memory"); \
    _Pragma("unroll") for (int d = 0; d < 4; ++d) _Pragma("unroll") for (int r = 0; r < 16; ++r) o[d][r] *= al_l[crow(r, hi)]; } } while (0)
  f32x16 pA0, pA1, pB0, pB1; float mnA, mnB, alA, alB; bf16x8 pa0, pa1, pa2, pa3; const int NT = seq / KVBLK;
  constexpr int SE = 0, SO = 1;
  SLOAD(SE, 0); asm volatile("s_waitcnt vmcnt(0)" ::: "memory"); SWRITE(0, SE); __syncthreads();
  qkt(pA0, pA1, K_lds, qr, r32, hi); partialSM(pA0, pA1, m_reg, mnA, alA);
  SLOAD(SO, KVBLK); if (2 < NT) SLOAD(SE, 2 * KVBLK);
  SWAIT(); SWRITE(1, SO); __syncthreads();
  for (int j = 1; j + 1 < NT; j += 2) {
    SBAR(); qkt(pB0, pB1, (bf16_t*)((char*)K_lds + SHM_K), qr, r32, hi);
    finishSM(pA0, pA1, alA, l_reg, pa0, pa1, pa2, pa3); SBAR();
    SLOAD(SO, (j + 2) * KVBLK); SBAR();
    pv_d0(o, vb0, pa0, pa1, pa2, pa3); partialSM(pB0, pB1, m_reg, mnB, alB);
    __syncthreads(); SWAIT(); SWRITE(0, SE);
    RESC(alB); __syncthreads();
    SBAR(); qkt(pA0, pA1, K_lds, qr, r32, hi);
    finishSM(pB0, pB1, alB, l_reg, pa0, pa1, pa2, pa3); SBAR();
    if (j + 3 < NT) SLOAD(SE, (j + 3) * KVBLK); SBAR();
    pv_d0(o, vb0 + (int)SHM_V, pa0, pa1, pa2, pa3); partialSM(pA0, pA1, m_reg, mnA, alA);
    __syncthreads(); SWAIT(); SWRITE(1, SO);
    RESC(alA); __syncthreads();
  }
  SBAR(); qkt(pB0, pB1, (bf16_t*)((char*)K_lds + SHM_K), qr, r32, hi);
  finishSM(pA0, pA1, alA, l_reg, pa0, pa1, pa2, pa3); SBAR();
  pv_d0(o, vb0, pa0, pa1, pa2, pa3); partialSM(pB0, pB1, m_reg, mnB, alB);
  __syncthreads(); RESC(alB);
  finishSM(pB0, pB1, alB, l_reg, pa0, pa1, pa2, pa3); SBAR();
  pv_d0(o, vb0 + (int)SHM_V, pa0, pa1, pa2, pa3);
  if (hi == 0) li_l[r32] = l_reg; asm volatile("s_waitcnt lgkmcnt(0)" ::: "memory");
  float rli[16];
#pragma unroll
  for (int r = 0; r < 16; ++r) rli[r] = __builtin_amdgcn_rcpf(li_l[crow(r, hi)]);
  bf16_t* Ow = Ob + (long)(wid * QBLK) * LDO;
#pragma unroll
  for (int r = 0; r < 16; ++r) { int orow = crow(r, hi);
#pragma unroll
    for (int d0 = 0; d0 < 4; ++d0) Ow[(long)orow * LDO + d0 * 32 + r32] = f2bf(o[d0][r] * rli[r]); }
#undef LD8
#undef SLOAD
#undef SWRITE
#undef SWAIT
#undef RESC
}
}

__device__ __forceinline__ void mod_phase(const Params& P, LAS unsigned char* lds, const int tid) {
  LAS float* sc = (LAS float*)lds; LAS float* red = sc + 5 * 2048;
  const int wid = tid >> 6, lane = tid & 63;
  for (int i = tid; i < 5 * 2048; i += 512) { const int j = i >> 11, k = i & 2047; const float v = (j < 4) ? P.c[j * 2048 + k] : P.c_ctx[k]; sc[i] = v * sigmoidf_(v); }
  __syncthreads();
  float* MOD = (float*)(P.ws + OFF_MOD);
  for (int task = P.bid; task < 256; task += P.grd) {
    const int n0 = task * 72 + lane * 2;
    float a0[5], a1[5];
#pragma unroll
    for (int j = 0; j < 5; ++j) { a0[j] = 0.f; a1[j] = 0.f; }
    if (lane < 36) {
      const float* wp = P.w_mod + (size_t)(wid * 256) * NMODC + n0;
#pragma unroll 16
      for (int k = 0; k < 256; ++k) {
        const f32x2 w = *(const f32x2*)(wp + (size_t)k * NMODC);
#pragma unroll
        for (int j = 0; j < 5; ++j) { const float s = sc[j * 2048 + wid * 256 + k]; a0[j] += s * w.x; a1[j] += s * w.y; }
      }
#pragma unroll
      for (int j = 0; j < 5; ++j) { red[(wid * 5 + j) * 72 + lane * 2] = a0[j]; red[(wid * 5 + j) * 72 + lane * 2 + 1] = a1[j]; }
    }
    __syncthreads();
    if (tid < 360) { const int j = tid / 72, ci = tid % 72; float s = 0.f;
#pragma unroll
      for (int w = 0; w < 8; ++w) s += red[(w * 5 + j) * 72 + ci];
      MOD[j * NMODC + task * 72 + ci] = s + P.b_mod[task * 72 + ci]; }
    __syncthreads();
  }
}
__device__ __forceinline__ void tr_load(float (&tv)[32], const float* __restrict__ W, int ldw, int k0, int n0, int lane) {
#pragma unroll
  for (int i = 0; i < 32; ++i) { const int kk = 2 * i + (lane >> 5); tv[i] = W[(size_t)(k0 + kk) * ldw + n0 + (lane & 31)]; }
}
__device__ __forceinline__ void tr_store(const float (&tv)[32], int k0, bf16_t* __restrict__ WT, int ldt, int drow0, int dk0, LAS float* scr, int lane) {
#pragma unroll
  for (int i = 0; i < 32; ++i) { const int kk = 2 * i + (lane >> 5); scr[kk * 33 + (lane & 31)] = tv[i]; }
  asm volatile("s_waitcnt lgkmcnt(0)" ::: "memory");
  const int c = lane & 7;
#pragma unroll
  for (int j = 0; j < 4; ++j) { const int n = (lane >> 3) + 8 * j; const LAS float* s = scr + (8 * c) * 33 + n;
    u32x4 o; o.x = cvt_pk_bf16(s[0 * 33], s[1 * 33]); o.y = cvt_pk_bf16(s[2 * 33], s[3 * 33]); o.z = cvt_pk_bf16(s[4 * 33], s[5 * 33]); o.w = cvt_pk_bf16(s[6 * 33], s[7 * 33]);
    *(u32x4*)(WT + (size_t)(drow0 + n) * ldt + dk0 + k0 + 8 * c) = o; }
  asm volatile("s_waitcnt lgkmcnt(0)" ::: "memory");
}
__device__ __forceinline__ void tr_item(const float* __restrict__ W, int ldw, int k0, int n0, bf16_t* __restrict__ WT, int ldt, int drow0, int dk0, LAS float* scr, int lane) {
  float tv[32]; tr_load(tv, W, ldw, k0, n0, lane); tr_store(tv, k0, WT, ldt, drow0, dk0, scr, lane);
}
constexpr int N_LATE = 16896 + 6144 + 2048 + 1024 + 2048;
__device__ __forceinline__ void late_item_addr(const Params& P, int j, const float*& W, int& ldw, int& k0, int& n0, bf16_t*& WT, int& ldt, int& drow) {
  if (j < 11264) { const int kb = j / 352, nb = j % 352; n0 = nb * 32; k0 = kb * 64; W = P.ffn2_w_in; ldw = 2 * DFF; WT = (bf16_t*)(P.ws + OFF_W2A); ldt = 2048;
    drow = n0 < DFF ? (n0 >> 7) * 256 + (n0 & 127) : ((n0 - DFF) >> 7) * 256 + 128 + ((n0 - DFF) & 127); return; }
  j -= 11264;
  if (j < 5632) { const int kb = j >> 6, nb = j & 63; n0 = nb * 32; k0 = kb * 64; W = P.ffn2_w_out; ldw = 2048; WT = (bf16_t*)(P.ws + OFF_W2B); ldt = DFF; drow = n0; return; }
  j -= 5632;
  if (j < 6144) { const int kb = j / 192, nbi = j % 192, nb = nbi < 64 ? nbi : nbi + 32;
    n0 = nb < 96 ? nb * 32 : 6528 + (nb - 96) * 32; k0 = kb * 64; W = P.w_in; ldw = 10624; WT = (bf16_t*)(P.ws + OFF_WQKVG); ldt = 2048; drow = nb * 32; return; }
  j -= 6144;
  if (j < 2048) { k0 = (j >> 6) * 64; n0 = (j & 63) * 32; W = P.w_oa; ldw = 2048; WT = (bf16_t*)(P.ws + OFF_WOA); ldt = 2048; drow = n0; return; }
  j -= 2048;
  if (j < 1024) { k0 = (j >> 6) * 64; n0 = (j & 63) * 32; W = P.w_or; ldw = 2048; WT = (bf16_t*)(P.ws + OFF_WOR); ldt = 1024; drow = n0; return; }
  j -= 1024;
  k0 = (j >> 6) * 64; n0 = (j & 63) * 32; W = P.w_out; ldw = 2048; WT = (bf16_t*)(P.ws + OFF_WOUT); ldt = 2048; drow = n0;
}
__device__ __forceinline__ void convert_phase(const Params& P, LAS unsigned char* lds, const int tid) {
  const int wid = tid >> 6, lane = tid & 63;
  LAS float* scr = (LAS float*)(lds + wid * 8704);
  unsigned char* ws = P.ws;
  bf16_t *W1A = (bf16_t*)(ws + OFF_W1A), *W1B = (bf16_t*)(ws + OFF_W1B), *W2A = (bf16_t*)(ws + OFF_W2A), *W2B = (bf16_t*)(ws + OFF_W2B);
  bf16_t *WRW = (bf16_t*)(ws + OFF_WRW), *WQKVG = (bf16_t*)(ws + OFF_WQKVG), *WOA = (bf16_t*)(ws + OFF_WOA), *WOR = (bf16_t*)(ws + OFF_WOR), *WOUT = (bf16_t*)(ws + OFF_WOUT), *WLORA = (bf16_t*)(ws + OFF_WLORA);
  const int G = P.grd, gw = P.bid * 8 + wid, NGW = G * 8;
  constexpr int NITEMS = 22528 + 11264 + 3456 + 7168 + 2048 + 1024 + 2048 + 192;
  for (int it = gw; it < NITEMS; it += NGW) {
    int r = it;
    if (r < 22528) { const int which = r >= 11264; r -= which * 11264; const int kb = r / 352, nb = r % 352, n0 = nb * 32;
      const int drow = n0 < DFF ? (n0 >> 7) * 256 + (n0 & 127) : ((n0 - DFF) >> 7) * 256 + 128 + ((n0 - DFF) & 127);
      if (!which) tr_item(P.ffn1_w_in, 2 * DFF, kb * 64, n0, W1A, 2048, drow, 0, scr, lane);
      continue; }
    r -= 22528;
    if (r < 11264) { const int which = r >= 5632; r -= which * 5632; const int kb = r >> 6, nb = r & 63;
      if (!which) tr_item(P.ffn1_w_out, 2048, kb * 64, nb * 32, W1B, DFF, nb * 32, 0, scr, lane);
      continue; }
    r -= 11264;
    if (r < 3456) { const int kb = r / 108, nb = r % 108; tr_item(P.w_in, 10624, kb * 64, 3072 + nb * 32, WRW, 2048, nb * 32, 0, scr, lane); continue; }
    r -= 3456;
    if (r < 7168) { const int kb = r / 224, nb = r % 224; const int n0 = nb < 96 ? nb * 32 : 6528 + (nb - 96) * 32;
      if (nb >= 64 && nb < 96) tr_item(P.w_in, 10624, kb * 64, n0, WQKVG, 2048, nb * 32, 0, scr, lane);
      continue; }
    r -= 7168;
    if (r < 2048) continue;
    r -= 2048;
    if (r < 1024) continue;
    r -= 1024;
    if (r < 2048) continue;
    r -= 2048;
    if (r < 64) { const int z = r >> 5, nb = r & 31; tr_item(P.w2 + (size_t)z * 64 * 1024, 1024, 0, nb * 32, WLORA, LIN_LD, z * 1024 + nb * 32, z * 64, scr, lane); continue; }
    r -= 64;
    if (r < 64) { const int z = r >> 5, nb = r & 31; tr_item(P.a2 + (size_t)z * 64 * 1024, 1024, 0, nb * 32, WLORA, LIN_LD, 2048 + z * 1024 + nb * 32, 128 + z * 64, scr, lane); continue; }
    r -= 64;
    { const int kb = r >> 5, nb = r & 31; tr_item(P.g2, 1024, kb * 64, nb * 32, WLORA, LIN_LD, 4096 + nb * 32, 256, scr, lane); }
  }
  const int gt = P.bid * 512 + tid, NT = G * 512;
  unsigned zz = 0u; asm volatile("" : "+v"(zz));
  const u32x4 z4 = {zz, zz, zz, zz};
  for (int i = gt; i < 128 * 256; i += NT) *(u32x4*)(WRW + (size_t)3456 * 2048 + (size_t)i * 8) = z4;
  for (int i = gt; i < 5120 * 48; i += NT) { const int row = i / 48, kc = (i % 48) * 8, rb = row >> 10;
    const int lo = rb < 4 ? rb * 64 : 256, hi = rb < 4 ? rb * 64 + 64 : 384;
    if (kc < lo || kc >= hi) *(u32x4*)(WLORA + (size_t)row * LIN_LD + kc) = z4; }
}
__device__ __forceinline__ void norm_mod_phase(const Params& P, const float* __restrict__ lat, const float* __restrict__ ctxp, int nrows, const float* __restrict__ g, int midx, const float* __restrict__ parts, const int tid) {
  const int wid = tid >> 6, lane = tid & 63;
  const int gw = P.bid * 8 + wid, NGW = P.grd * 8;
  const float* __restrict__ MOD = (const float*)(P.ws + OFF_MOD); bf16_t* __restrict__ H = (bf16_t*)(P.ws + OFF_H);
  for (int r = gw; r < nrows; r += NGW) {
    const float* xr = r < MT ? lat + (size_t)r * DM : ctxp + (size_t)(r - MT) * DM;
    const int b = r < MT ? (r >> 13) : 4;
    const float* sh = MOD + b * NMODC + midx * DM; const float* scp = sh + DM;
    f32x4 v[8], g4[8], s4[8], c4[8]; float ss = 0.f;
#pragma unroll
    for (int j = 0; j < 8; ++j) v[j] = *(const f32x4*)(xr + j * 256 + lane * 4);
    if (parts && r >= MT) {
      const float* pp = parts + (size_t)(r - MT) * DM; const float* gt = MOD + 4 * NMODC + 2 * DM;
#pragma unroll
      for (int j = 0; j < 8; ++j) { const int c = j * 256 + lane * 4;
        const f32x4 s = (*(const f32x4*)(pp + c) + *(const f32x4*)(pp + (size_t)MC * DM + c)) + (*(const f32x4*)(pp + (size_t)2 * MC * DM + c) + *(const f32x4*)(pp + (size_t)3 * MC * DM + c));
        v[j] = v[j] + *(const f32x4*)(gt + c) * 0.5f * s; }
    }
#pragma unroll
    for (int j = 0; j < 8; ++j) { const int c = j * 256 + lane * 4; g4[j] = *(const f32x4*)(g + c); s4[j] = *(const f32x4*)(sh + c); c4[j] = *(const f32x4*)(scp + c); }
#pragma unroll
    for (int j = 0; j < 8; ++j) ss += v[j].x * v[j].x + v[j].y * v[j].y + v[j].z * v[j].z + v[j].w * v[j].w;
    ss = wave_sum(ss);
    const float rs = rsqrtf(ss * (1.f / DM) + 1e-6f);
#pragma unroll
    for (int j = 0; j < 8; ++j) { const int c = j * 256 + lane * 4;
      const f32x4 y = v[j] * rs * g4[j]; const f32x4 h = y * (c4[j] + 1.f) + s4[j];
      u32x2 w; w.x = cvt_pk_bf16(h.x, h.y); w.y = cvt_pk_bf16(h.z, h.w);
      *(u32x2*)(H + (size_t)r * DM + c) = w; }
  }
}
__device__ __forceinline__ void shift_phase(const Params& P, const int tid) {
  const bf16_t* __restrict__ PRW = (const bf16_t*)(P.ws + OFF_PRW); bf16_t* __restrict__ SH = (bf16_t*)(P.ws + OFF_SH); bf16_t* __restrict__ LIN = (bf16_t*)(P.ws + OFF_LIN);
  const int gt = P.bid * 512 + tid, NT = P.grd * 512;
#pragma unroll 2
  for (int idx = gt; idx < MA * 432; idx += NT) {
    const int r = idx / 432, c = (idx % 432) * 8;
    bool first, last;
    if (r < MT) { const int t = r & (SEQ - 1); first = t == 0; last = t == SEQ - 1; } else { const int t = (r - MT) & (CTXL - 1); first = t == 0; last = t == CTXL - 1; }
    const u32x4 z4 = {0u, 0u, 0u, 0u};
    const u32x4 p = *(const u32x4*)(PRW + (size_t)r * PRW_LD + c);
    const u32x4 pv = first ? z4 : *(const u32x4*)(PRW + (size_t)(r - 1) * PRW_LD + c);
    const u32x4 nx = last ? z4 : *(const u32x4*)(PRW + (size_t)(r + 1) * PRW_LD + c);
    const f32x4 m0 = *(const f32x4*)(P.rwkv_mu + c), m1 = *(const f32x4*)(P.rwkv_mu + c + 4);
    float o[8];
#define SHF(e, W, MU, HI) { const float pp = HI ? bfhi(p.W) : bflo(p.W), a = HI ? bfhi(pv.W) : bflo(pv.W), b = HI ? bfhi(nx.W) : bflo(nx.W); o[e] = pp + MU * (0.5f * (a + b) - pp); }
    SHF(0, x, m0.x, 0) SHF(1, x, m0.y, 1) SHF(2, y, m0.z, 0) SHF(3, y, m0.w, 1) SHF(4, z, m1.x, 0) SHF(5, z, m1.y, 1) SHF(6, w, m1.z, 0) SHF(7, w, m1.w, 1)
#undef SHF
    bf16_t* dst;
    if (c < 3072) dst = SH + (size_t)r * SH_LD + c;
    else { const int cl = c - 3072; dst = LIN + (size_t)r * LIN_LD + cl;
      if (cl < 128) {
#pragma unroll
        for (int e = 0; e < 8; ++e) { const float ex = __builtin_amdgcn_exp2f(2.8853900817779268f * o[e]); o[e] = 1.f - 2.f * __builtin_amdgcn_rcpf(ex + 1.f); }
      } else if (cl >= 256) {
#pragma unroll
        for (int e = 0; e < 8; ++e) o[e] = sigmoidf_(o[e]);
      } }
    u32x4 w; w.x = cvt_pk_bf16(o[0], o[1]); w.y = cvt_pk_bf16(o[2], o[3]); w.z = cvt_pk_bf16(o[4], o[5]); w.w = cvt_pk_bf16(o[6], o[7]);
    *(u32x4*)dst = w;
  }
}
__device__ __forceinline__ float SFMA(float a, float b, float c) { float d; asm("v_fma_f32 %0, %1, %2, %3" : "=v"(d) : "v"(a), "v"(b), "v"(c)); return d; }
__device__ __forceinline__ float SMUL(float a, float b) { float d; asm("v_mul_f32 %0, %1, %2" : "=v"(d) : "v"(a), "v"(b)); return d; }
__device__ __forceinline__ float allred8(float x) { x += dpp_mov<0xB1>(x); x += dpp_mov<0x4E>(x); x += dpp_mov<0x141>(x); return x; }
__device__ __forceinline__ void scan_phase(const Params& P, LAS unsigned char* lds, const int tid) {
  LAS float* F = (LAS float*)lds;
  LAS unsigned short* YB = (LAS unsigned short*)(lds + 2 * 32 * 384 * 4);
  const bf16_t* SH = (const bf16_t*)(P.ws + OFF_SH); const bf16_t* LO = (const bf16_t*)(P.ws + OFF_LO); bf16_t* Y = (bf16_t*)(P.ws + OFF_Y);
  const int wid = __builtin_amdgcn_readfirstlane(tid >> 6), lane = tid & 63;
  constexpr int NCH = SKV / 32;
#define SCAN_BAR() do { asm volatile("s_waitcnt lgkmcnt(0)" ::: "memory"); __builtin_amdgcn_s_barrier(); asm volatile("" ::: "memory"); } while (0)
  for (int task = P.bid; task < 256; task += P.grd) {
    const int half = (task >> 3) & 1, chain = (task & 7) | ((task >> 4) << 3);
    const int dir = chain & 1, h = (chain >> 1) & 15, b = chain >> 5, hc = h * 64;
#define ROWOF(g) ((g) < CTXL ? (MT + b * CTXL + (dir ? CTXL - 1 - (g) : (g))) : (b * SEQ + (dir ? SEQ - 1 - ((g) - CTXL) : ((g) - CTXL))))
    if (wid < 4) {
      const int rloc = wid * 8 + (lane >> 3), irow = half * 32 + rloc, cA = (lane & 7) * 4, cB = 32 + cA;
      f32x4 S0 = {0.f, 0.f, 0.f, 0.f}, S1 = {0.f, 0.f, 0.f, 0.f};
      SCAN_BAR();
      for (int q = 0; q < NCH; ++q) {
        const LAS float* f = F + (q & 1) * 32 * 384;
        LAS unsigned short* yb = YB + (q & 1) * 1024;
        f32x4 w0 = *(const LAS f32x4*)(f + cA), w1 = *(const LAS f32x4*)(f + cB);
        f32x4 a0 = *(const LAS f32x4*)(f + 64 + cA), a1 = *(const LAS f32x4*)(f + 64 + cB);
        f32x4 b0 = *(const LAS f32x4*)(f + 128 + cA), b1 = *(const LAS f32x4*)(f + 128 + cB);
        f32x4 k0 = *(const LAS f32x4*)(f + 192 + cA), k1 = *(const LAS f32x4*)(f + 192 + cB);
        f32x4 r0 = *(const LAS f32x4*)(f + 256 + cA), r1 = *(const LAS f32x4*)(f + 256 + cB);
        float vv = f[320 + irow];
        float ykeep = 0.f;
#pragma unroll 2
        for (int s = 0; s < 32; ++s) {
          const LAS float* fn = f + (s < 31 ? s + 1 : 31) * 384;
          const f32x4 nw0 = *(const LAS f32x4*)(fn + cA), nw1 = *(const LAS f32x4*)(fn + cB);
          const f32x4 na0 = *(const LAS f32x4*)(fn + 64 + cA), na1 = *(const LAS f32x4*)(fn + 64 + cB);
          const f32x4 nb0 = *(const LAS f32x4*)(fn + 128 + cA), nb1 = *(const LAS f32x4*)(fn + 128 + cB);
          const f32x4 nk0 = *(const LAS f32x4*)(fn + 192 + cA), nk1 = *(const LAS f32x4*)(fn + 192 + cB);
          const f32x4 nr0 = *(const LAS f32x4*)(fn + 256 + cA), nr1 = *(const LAS f32x4*)(fn + 256 + cB);
          const float nvv = fn[320 + irow];
          __builtin_amdgcn_sched_barrier(0);
          f32x4 p = S0 * a0 + S1 * a1;
          const float sa_ = allred8((p.x + p.y) + (p.z + p.w));
          S0 = S0 * w0 + (b0 * sa_ + k0 * vv);
          S1 = S1 * w1 + (b1 * sa_ + k1 * vv);
          p = S0 * r0 + S1 * r1;
          const float y = allred8((p.x + p.y) + (p.z + p.w));
          ykeep = ((s & 7) == (lane & 7)) ? y : ykeep;
          if ((s & 7) == 7) yb[((s & ~7) + (lane & 7)) * 32 + rloc] = f2bf(ykeep);
          __builtin_amdgcn_sched_barrier(0);
          w0 = nw0; w1 = nw1; a0 = na0; a1 = na1; b0 = nb0; b1 = nb1; k0 = nk0; k1 = nk1; r0 = nr0; r1 = nr1; vv = nvv;
        }
        SCAN_BAR();
      }
    } else {
      const int sw = wid - 4, hw = lane >> 5, cp = (lane & 31) * 2;
      const f32x2 kk_c = *(const f32x2*)(P.k_k + hc + cp), ka_c = *(const f32x2*)(P.k_a + hc + cp);
      unsigned voS[4], voL[4];
#pragma unroll
      for (int e = 0; e < 4; ++e) { const int tk = hw * 4 + e, ro = dir ? 7 - tk : tk; voS[e] = (unsigned)(ro * SH_LD + cp) * 2u; voL[e] = (unsigned)(ro * LO_LD + cp) * 2u; }
      unsigned sr[4], sk[4], sv[4], sl[4], sa[4];
#define RMIN(q) ({ const int g0_ = (q) * 32 + sw * 8; const int ra_ = ROWOF(g0_), rb_ = ROWOF(g0_ + 7); ra_ < rb_ ? ra_ : rb_; })
#define SLOADQ(q) do { const size_t rmin_ = (size_t)RMIN(q); const char* bs_ = (const char*)(SH + rmin_ * SH_LD + hc); const char* bl_ = (const char*)(LO + rmin_ * LO_LD + dir * 1024 + hc); \
      _Pragma("unroll") for (int e = 0; e < 4; ++e) { sr[e] = *(const unsigned*)(bs_ + voS[e]); sk[e] = *(const unsigned*)(bs_ + 2048 + voS[e]); sv[e] = *(const unsigned*)(bs_ + 4096 + voS[e]); \
        sl[e] = *(const unsigned*)(bl_ + voL[e]); sa[e] = *(const unsigned*)(bl_ + 4096 + voL[e]); } } while (0)
#define SWRITEQ(buf) do { _Pragma("unroll") for (int e = 0; e < 4; ++e) { LAS float* f_ = F + ((buf) * 32 + sw * 8 + hw * 4 + e) * 384 + cp; \
      const f32x2 r_ = {bflo(sr[e]), bfhi(sr[e])}, k_ = {bflo(sk[e]), bfhi(sk[e])}, v_ = {bflo(sv[e]), bfhi(sv[e])}, lam = {bflo(sl[e]), bfhi(sl[e])}, aa = {bflo(sa[e]), bfhi(sa[e])}; \
      const f32x2 kkr = k_ * kk_c; float ssq = allred16(kkr.x * kkr.x + kkr.y * kkr.y); \
      { auto rr_ = __builtin_amdgcn_permlane16_swap(__float_as_uint(ssq), __float_as_uint(ssq), false, false); ssq = __uint_as_float(rr_[0]) + __uint_as_float(rr_[1]); } \
      const f32x2 kk = kkr * rsqrtf(fmaxf(ssq, 1e-24f)); \
      f32x2 wv; wv.x = __builtin_amdgcn_exp2f(-lam.x); wv.y = __builtin_amdgcn_exp2f(-lam.y); \
      *(LAS f32x2*)(f_) = wv; *(LAS f32x2*)(f_ + 64) = -kk; *(LAS f32x2*)(f_ + 128) = kk * aa; *(LAS f32x2*)(f_ + 192) = k_ * ((aa - 1.f) * ka_c + 1.f); \
      *(LAS f32x2*)(f_ + 256) = r_; *(LAS f32x2*)(f_ + 320) = v_; } } while (0)
      LAS float* trscr = (LAS float*)(lds + 102400 + sw * 8704);
      float tv[32]; int w2j = task * 4 + sw;
      SLOADQ(0); SWRITEQ(0); SLOADQ(1);
      SCAN_BAR();
      for (int q = 0; q < NCH; ++q) {
        if (q >= 9) {
          const int qq = q - 1; const LAS unsigned short* yb = YB + (qq & 1) * 1024;
          const int t256 = sw * 64 + lane, s = t256 >> 3, rp = (t256 & 7) * 4; const int u = qq * 32 + s - CTXL; const int t = dir ? SEQ - 1 - u : u;
          const u32x2 val = *(const LAS u32x2*)(yb + s * 32 + rp);
          *(u32x2*)(Y + (size_t)dir * MT * 1024 + (size_t)(b * SEQ + t) * 1024 + hc + half * 32 + rp) = val;
        }
        if (q + 1 < NCH) SWRITEQ((q + 1) & 1);
        if ((q & 7) == 3 && w2j < N_LATE) {
          const float* W_; int ldw_, k0_, n0_, ldt_, drow_; bf16_t* WT_; late_item_addr(P, w2j, W_, ldw_, k0_, n0_, WT_, ldt_, drow_);
          tr_store(tv, k0_, WT_, ldt_, drow_, 0, trscr, lane); w2j += 1024;
        }
        if (q + 2 < NCH) SLOADQ(q + 2);
        if ((q & 7) == 2 && w2j < N_LATE) {
          const float* W_; int ldw_, k0_, n0_, ldt_, drow_; bf16_t* WT_; late_item_addr(P, w2j, W_, ldw_, k0_, n0_, WT_, ldt_, drow_);
          tr_load(tv, W_, ldw_, k0_, n0_, lane);
        }
        SCAN_BAR();
      }
      {
        const int qq = NCH - 1; const LAS unsigned short* yb = YB + (qq & 1) * 1024;
        const int t256 = sw * 64 + lane, s = t256 >> 3, rp = (t256 & 7) * 4; const int u = qq * 32 + s - CTXL; const int t = dir ? SEQ - 1 - u : u;
        const u32x2 val = *(const LAS u32x2*)(yb + s * 32 + rp);
        *(u32x2*)(Y + (size_t)dir * MT * 1024 + (size_t)(b * SEQ + t) * 1024 + hc + half * 32 + rp) = val;
      }
#undef SLOADQ
#undef SWRITEQ
#undef RMIN
    }
#undef ROWOF
    __syncthreads();
  }
#undef SCAN_BAR
}
__device__ __forceinline__ float half_sum(float v) {
  v = allred16(v);
  auto rr = __builtin_amdgcn_permlane16_swap(__float_as_uint(v), __float_as_uint(v), false, false); return __uint_as_float(rr[0]) + __uint_as_float(rr[1]);
}
__device__ __forceinline__ void rwkv_out_phase(const Params& P, const int tid) {
  const bf16_t* SH = (const bf16_t*)(P.ws + OFF_SH); const bf16_t* LO = (const bf16_t*)(P.ws + OFF_LO); bf16_t* Y = (bf16_t*)(P.ws + OFF_Y);
  const int wid = tid >> 6, lane = tid & 63, hw = lane >> 5, cp = (lane & 31) * 2;
  const int gw = P.bid * 8 + wid, NGW = P.grd * 8;
  for (int task = gw * 2; task < MT * 8; task += NGW * 2) {
    unsigned yf[2], ybk[2], rr[2], kk[2], vv[2], af[2], ab[2], gg[2]; int cc[2]; size_t tk[2];
#pragma unroll
    for (int u = 0; u < 2; ++u) { const int t_ = task + u; tk[u] = (size_t)(t_ >> 3); cc[u] = ((t_ & 7) * 2 + hw) * 64 + cp;
      const bf16_t* py = Y + tk[u] * 1024 + cc[u]; const bf16_t* ps = SH + tk[u] * SH_LD + cc[u]; const bf16_t* pl = LO + tk[u] * LO_LD + cc[u];
      yf[u] = *(const unsigned*)py; ybk[u] = *(const unsigned*)(py + (size_t)MT * 1024);
      rr[u] = *(const unsigned*)ps; kk[u] = *(const unsigned*)(ps + 1024); vv[u] = *(const unsigned*)(ps + 2048);
      af[u] = *(const unsigned*)(pl + 2048); ab[u] = *(const unsigned*)(pl + 3072); gg[u] = *(const unsigned*)(pl + 4096); }
    unsigned res[2];
#pragma unroll
    for (int u = 0; u < 2; ++u) {
      const f32x2 lw = *(const f32x2*)(P.ln_x_w + cc[u]), lb = *(const f32x2*)(P.ln_x_b + cc[u]), ka = *(const f32x2*)(P.k_a + cc[u]), rk = *(const f32x2*)(P.r_k + cc[u]);
      const f32x2 y = {bflo(yf[u]) + bflo(ybk[u]), bfhi(yf[u]) + bfhi(ybk[u])};
      const float mu = half_sum(y.x + y.y) * (1.f / 64.f); const f32x2 dv = y - mu; const float var = half_sum(dv.x * dv.x + dv.y * dv.y) * (1.f / 64.f);
      const f32x2 yn = dv * rsqrtf(var + 64e-5f) * lw + lb;
      const f32x2 r = {bflo(rr[u]), bfhi(rr[u])}, k = {bflo(kk[u]), bfhi(kk[u])}, v = {bflo(vv[u]), bfhi(vv[u])};
      const f32x2 a1 = {bflo(af[u]), bfhi(af[u])}, a2 = {bflo(ab[u]), bfhi(ab[u])}, g = {bflo(gg[u]), bfhi(gg[u])};
      const f32x2 kms = k * ((a1 - 1.f) * ka + 1.f) + k * ((a2 - 1.f) * ka + 1.f);
      const f32x2 bt = r * kms * rk;
      const float bonus = half_sum(bt.x + bt.y);
      const f32x2 o = (yn + v * bonus) * g;
      res[u] = cvt_pk_bf16(o.x, o.y);
    }
#pragma unroll
    for (int u = 0; u < 2; ++u) *(unsigned*)(Y + tk[u] * 1024 + cc[u]) = res[u];
  }
}
__device__ __forceinline__ void rope_phase(const Params& P, const int tid) {
  bf16_t* Q = (bf16_t*)(P.ws + OFF_Q); bf16_t* KB = (bf16_t*)(P.ws + OFF_KB);
  const int wid = tid >> 6, lane = tid & 63, hw = lane >> 5, li = lane & 31;
  const int gw = P.bid * 8 + wid, NGW = P.grd * 8;
  const int d1 = li < 16 ? 2 * li : 64 + 2 * (li - 16);
  const f32x2 qgA = *(const f32x2*)(P.q_norm + d1), qgB = *(const f32x2*)(P.q_norm + d1 + 32), kgA = *(const f32x2*)(P.k_norm + d1), kgB = *(const f32x2*)(P.k_norm + d1 + 32);
  const int j0 = 2 * (li & 15);
  const float inv0 = __builtin_amdgcn_exp2f(-(float)(2 * j0) * (13.287712379549449f / 64.f)), inv1 = __builtin_amdgcn_exp2f(-(float)(2 * j0 + 2) * (13.287712379549449f / 64.f));
  for (int task = gw; task < MA; task += NGW) {
    if (task < MT) {
      const int tok = task, b = tok >> 13, t = tok & (SEQ - 1);
      const float pos = (float)(li < 16 ? (t >> 6) : (t & 63));
      const float an0 = pos * inv0, an1 = pos * inv1;
      const f32x2 sn = {__sinf(an0), __sinf(an1)}, cs = {__cosf(an0), __cosf(an1)};
      unsigned lo[10], hi[10]; bf16_t* ptr[10];
#pragma unroll
      for (int i = 0; i < 10; ++i) { const int hd = 2 * i + hw;
        ptr[i] = (hd < 16 ? Q + (size_t)tok * DM + hd * 128 : KB + (size_t)(tok + b * CTXL) * 512 + (hd - 16) * 128) + d1;
        lo[i] = *(const unsigned*)ptr[i]; hi[i] = *(const unsigned*)(ptr[i] + 32); }
#pragma unroll
      for (int i = 0; i < 10; ++i) { const bool isq = i < 8;
        const f32x2 t1 = {bflo(lo[i]), bfhi(lo[i])}, t2 = {bflo(hi[i]), bfhi(hi[i])};
        const float ss = half_sum((t1.x * t1.x + t1.y * t1.y) + (t2.x * t2.x + t2.y * t2.y)); const float rs = rsqrtf(ss * (1.f / 128.f) + 1e-6f);
        const f32x2 n1 = t1 * rs * (isq ? qgA : kgA), n2 = t2 * rs * (isq ? qgB : kgB);
        const f32x2 o1 = n1 * cs - n2 * sn, o2 = n2 * cs + n1 * sn;
        lo[i] = cvt_pk_bf16(o1.x, o1.y); hi[i] = cvt_pk_bf16(o2.x, o2.y); }
#pragma unroll
      for (int i = 0; i < 10; ++i) { *(unsigned*)ptr[i] = lo[i]; *(unsigned*)(ptr[i] + 32) = hi[i]; }
    } else {
      const int ct = task - MT, b = ct >> 8, t = ct & (CTXL - 1);
      unsigned lo[2], hi[2]; bf16_t* ptr[2];
#pragma unroll
      for (int i = 0; i < 2; ++i) { ptr[i] = KB + (size_t)(b * SKV + SEQ + t) * 512 + (2 * i + hw) * 128 + d1; lo[i] = *(const unsigned*)ptr[i]; hi[i] = *(const unsigned*)(ptr[i] + 32); }
#pragma unroll
      for (int i = 0; i < 2; ++i) {
        const f32x2 t1 = {bflo(lo[i]), bfhi(lo[i])}, t2 = {bflo(hi[i]), bfhi(hi[i])};
        const float ss = half_sum((t1.x * t1.x + t1.y * t1.y) + (t2.x * t2.x + t2.y * t2.y)); const float rs = rsqrtf(ss * (1.f / 128.f) + 1e-6f);
        const f32x2 n1 = t1 * rs * kgA, n2 = t2 * rs * kgB;
        *(unsigned*)ptr[i] = cvt_pk_bf16(n1.x, n1.y); *(unsigned*)(ptr[i] + 32) = cvt_pk_bf16(n2.x, n2.y); }
    }
  }
}
__device__ __forceinline__ void attn_phase(const Params& P, unsigned char* smem, const int tid) {
  bf16_t* Q = (bf16_t*)(P.ws + OFF_Q); const bf16_t* KB = (const bf16_t*)(P.ws + OFF_KB); const bf16_t* VB = (const bf16_t*)(P.ws + OFF_VB);
  for (int u = P.bid; u < 2048; u += P.grd) {
    const int xcd = u & 7, slot = (u >> 3) & 31, rnd = u >> 8, pair = xcd + 8 * (rnd >> 2), w = (rnd & 3) * 32 + slot;
    const int b = pair >> 2, kvh = pair & 3, g = w & 3, qb = w >> 2, head = kvh * 4 + g;
    bf16_t* Qb = Q + (size_t)(b * SEQ + qb * 256) * DM + head * 128;
    const bf16_t* Kh = KB + (size_t)b * SKV * 512 + kvh * 128; const bf16_t* Vh = VB + (size_t)b * SKV * 512 + kvh * 128;
    att::attn_dense_body(Qb, Kh, Vh, Qb, SKV, (char*)smem, tid);
    __syncthreads();
  }
}
__device__ __forceinline__ void final_norm_phase(const Params& P, const int tid) {
  const int wid = tid >> 6, lane = tid & 63;
  const int gw = P.bid * 8 + wid, NGW = P.grd * 8;
  f32x4 g4[8];
#pragma unroll
  for (int j = 0; j < 8; ++j) g4[j] = *(const f32x4*)(P.norm_final + j * 256 + lane * 4);
  for (int r = gw; r < MT; r += NGW) {
    float* xr = P.out + (size_t)r * DM;
    f32x4 v[8]; float ss = 0.f;
#pragma unroll
    for (int j = 0; j < 8; ++j) v[j] = *(const f32x4*)(xr + j * 256 + lane * 4);
#pragma unroll
    for (int j = 0; j < 8; ++j) ss += v[j].x * v[j].x + v[j].y * v[j].y + v[j].z * v[j].z + v[j].w * v[j].w;
    ss = wave_sum(ss);
    const float rs = rsqrtf(ss * (1.f / DM) + 1e-6f);
#pragma unroll
    for (int j = 0; j < 8; ++j) *(f32x4*)(xr + j * 256 + lane * 4) = v[j] * rs * g4[j];
  }
}


#define XB_TMO      128
#define XB_XCNT(j)  (256  + 64 * (j))
#define XB_XSUB(j)  (1280 + 64 * (j))
#define XB_XGEN(j)  (2304 + 64 * (j))
#define XB_TOP      3328
#define XB_TOPGEN   3392
#define XCD_BAR_WORDS 3456
#define XB_SPIN_CAP (1u << 18)
__device__ __forceinline__ unsigned xb_ld(unsigned* p)              { return __hip_atomic_load(p, __ATOMIC_RELAXED, __HIP_MEMORY_SCOPE_AGENT); }
__device__ __forceinline__ unsigned xb_add(unsigned* p, unsigned v) { return __hip_atomic_fetch_add(p, v, __ATOMIC_RELAXED, __HIP_MEMORY_SCOPE_AGENT); }
__device__ __forceinline__ unsigned xb_xcc_id() { return (unsigned)__builtin_amdgcn_s_getreg((3 << 11) | 20) & 0xFu; }
#define XB_SPIN(cond, bar) do { unsigned _sp = 0; while (cond) { __builtin_amdgcn_s_sleep(1); \
    if ((++_sp & 255u) == 0u) { if (xb_ld(&(bar)[XB_TMO])) break; if (_sp > XB_SPIN_CAP) { atomicAdd(&(bar)[XB_TMO], 1u); break; } } } } while (0)
__device__ __forceinline__ void xcd_barrier_complete(unsigned* bar, unsigned x, unsigned& nloc, unsigned& nx) {
    const unsigned G = gridDim.x * gridDim.y * gridDim.z;
    unsigned sum, cnt, mine, sp = 0u;
    for (;;) {
        sum = 0u; cnt = 0u; mine = 0u;
#pragma unroll
        for (unsigned j = 0; j < 16; ++j) { const unsigned c = xb_ld(&bar[XB_XCNT(j)]); sum += c; cnt += (c > 0u) ? 1u : 0u; mine = (j == x) ? c : mine; }
        if (sum == G) break;
        __builtin_amdgcn_s_sleep(1);
        if ((++sp & 255u) == 0u) { if (xb_ld(&bar[XB_TMO])) break; if (sp > XB_SPIN_CAP) { atomicAdd(&bar[XB_TMO], 1u); break; } }
    }
    nloc = mine > 0u ? mine : 1u; nx = cnt > 0u ? cnt : 1u;
}
__device__ __forceinline__ void xcd_barrier(unsigned* bar, volatile LAS unsigned* st) {
    asm volatile("s_waitcnt vmcnt(0)" ::: "memory");
    __syncthreads();
    if (threadIdx.x == 0) {
        __builtin_amdgcn_s_waitcnt(0);
        const unsigned x = xb_xcc_id();
        unsigned nloc = st[0], nx = st[1];
        if (nloc == 0u) { xcd_barrier_complete(bar, x, nloc, nx); st[0] = nloc; st[1] = nx; }
        const unsigned old = xb_add(&bar[XB_XSUB(x)], 1u);
        const unsigned gen = old / nloc;
        if (old + 1u == (gen + 1u) * nloc) {
            __builtin_amdgcn_fence(__ATOMIC_RELEASE, "agent");
            asm volatile("s_waitcnt vmcnt(0)" ::: "memory");
            const unsigned og = xb_add(&bar[XB_TOP], 1u);
            const unsigned tg = og / nx;
            if (og + 1u == (tg + 1u) * nx) xb_add(&bar[XB_TOPGEN], 1u);
            else XB_SPIN(xb_ld(&bar[XB_TOPGEN]) == tg, bar);
            __builtin_amdgcn_fence(__ATOMIC_ACQUIRE, "agent");
            xb_add(&bar[XB_XGEN(x)], 1u);
            asm volatile("s_waitcnt vmcnt(0)" ::: "memory");
        } else {
            XB_SPIN(xb_ld(&bar[XB_XGEN(x)]) == gen, bar);
            __builtin_amdgcn_fence(__ATOMIC_ACQUIRE, "agent");
            asm volatile("s_waitcnt vmcnt(0)" ::: "memory");
        }
    }
    __syncthreads();
}

constexpr int NPH = 20;
__device__ __forceinline__ bool gemm_desc(int ph, const Params& P, GemmDesc& d) {
  unsigned char* ws = P.ws;
  const bf16_t* H = (const bf16_t*)(ws + OFF_H);
  d.a_tiled = 0; d.nt0 = 0; d.nt1 = 0; d.ksplit1 = 1; d.G = P.grd; d.c = P.bid; d.A1 = nullptr; d.B1 = nullptr; d.pm01 = 0; d.nN1 = 1; d.n1 = 0; d.pm00 = 0; d.xin = nullptr; d.gidx = 0; d.gscale = 0.f; d.act = nullptr;
  switch (ph) {
  case 2: d.K = 2048; d.mode = M_SWIGLU; d.A0 = H; d.B0 = (const bf16_t*)(ws + OFF_W1A); d.nM0 = 132; d.nN0 = 44; d.act = (bf16_t*)(ws + OFF_ACT); break;
  case 3: d.a_tiled = 1; d.K = DFF; d.mode = M_RESID; d.A0 = (const bf16_t*)(ws + OFF_ACT); d.B0 = (const bf16_t*)(ws + OFF_W1B); d.nM0 = 128; d.nN0 = 8; d.xin = P.x; d.gidx = 2; d.gscale = 0.5f;
          d.A1 = d.A0; d.B1 = d.B0; d.pm01 = 128; d.nN1 = 8; d.ksplit1 = 4; d.nt1 = 22; d.n1 = 4 * 8 * 4; break;
  case 5: d.K = 2048; d.mode = M_RW; d.A0 = H; d.B0 = (const bf16_t*)(ws + OFF_WRW); d.nM0 = 132; d.nN0 = 14;
          d.A1 = H; d.B1 = (const bf16_t*)(ws + OFF_WQKVG) + (size_t)2048 * 2048; d.pm01 = 128; d.nN1 = 4; d.n1 = 16; break;
  case 7: d.K = 384; d.mode = M_LORA; d.A0 = (const bf16_t*)(ws + OFF_LIN); d.B0 = (const bf16_t*)(ws + OFF_WLORA); d.nM0 = 132; d.nN0 = 20; break;
  case 10: d.K = 2048; d.mode = M_QKVG; d.A0 = H; d.B0 = (const bf16_t*)(ws + OFF_WQKVG); d.nM0 = 128; d.nN0 = 28; break;
  case 13: d.K = 2048; d.mode = M_T1; d.A0 = (const bf16_t*)(ws + OFF_Q); d.B0 = (const bf16_t*)(ws + OFF_WOA); d.nM0 = 128; d.nN0 = 8; break;
  case 14: d.K = 1024; d.mode = M_M; d.A0 = (const bf16_t*)(ws + OFF_Y); d.B0 = (const bf16_t*)(ws + OFF_WOR); d.nM0 = 128; d.nN0 = 8; break;
  case 15: d.K = 2048; d.mode = M_RESID; d.A0 = (const bf16_t*)(ws + OFF_GR); d.B0 = (const bf16_t*)(ws + OFF_WOUT); d.nM0 = 128; d.nN0 = 8; d.xin = P.out; d.gidx = 5; d.gscale = 1.f; break;
  case 17: d.K = 2048; d.mode = M_SWIGLU; d.A0 = H; d.B0 = (const bf16_t*)(ws + OFF_W2A); d.nM0 = 128; d.nN0 = 44; d.act = (bf16_t*)(ws + OFF_ACT); break;
  case 18: d.a_tiled = 1; d.K = DFF; d.mode = M_RESID; d.A0 = (const bf16_t*)(ws + OFF_ACT); d.B0 = (const bf16_t*)(ws + OFF_W2B); d.nM0 = 128; d.nN0 = 8; d.xin = P.out; d.gidx = 8; d.gscale = 0.5f; break;
  default: return false;
  }
  d.n0 = d.nM0 * d.nN0;
  if (!d.nt0) d.nt0 = d.K / BK;
  if (!d.nt1) d.nt1 = d.K / BK;
  if (d.mode == M_LORA) d.nt0 = 2;
  return true;
}

__global__ void __launch_bounds__(512) mega_fwd(Params P) {
  extern __shared__ __attribute__((aligned(16))) unsigned char smem[];
  LAS unsigned char* lds = (LAS unsigned char*)smem;
  cg::grid_group grid = cg::this_grid();
  volatile LAS unsigned* bst = (volatile LAS unsigned*)(lds + LDS_BYTES + 192);
  unsigned* gbar = (unsigned*)(P.ws + OFF_BAR);
#if ONE_LAUNCH
  if (threadIdx.x == 0) { bst[0] = 0u; bst[1] = 0u; (void)xb_add(&gbar[XB_XCNT(xb_xcc_id())], 1u); }
  __syncthreads();
#endif
#pragma nounroll
  for (int ph = P.ph_lo; ph < P.ph_hi; ++ph) {
    GemmDesc d;
    int tid = threadIdx.x; asm volatile("" : "+v"(tid));
#if PROBE
    if (blockIdx.x == 0 && tid == 0) ((LAS unsigned long long*)(lds + LDS_BYTES))[ph] = __builtin_amdgcn_s_memrealtime();
#endif
    const __attribute__((address_space(4))) Params* kp = (const __attribute__((address_space(4))) Params*)__builtin_amdgcn_kernarg_segment_ptr();
    asm volatile("" : "+s"(kp));
#if defined(__HIP_DEVICE_COMPILE__)
    Params L = *kp;
#else
    Params L = P;
#endif
    { int b_ = blockIdx.x, g_ = gridDim.x; asm volatile("" : "+s"(b_), "+s"(g_)); L.bid = b_; L.grd = g_; }
    if (gemm_desc(ph, L, d)) gemm_phase(lds, d, L, tid);
    else switch (ph) {
      case 0: mod_phase(L, lds, tid); __syncthreads(); convert_phase(L, lds, tid); break;
      case 1: norm_mod_phase(L, L.x, L.ctx, MA, L.norm_ffn1, 0, nullptr, tid); break;
      case 4: norm_mod_phase(L, L.out, L.ctx, MA, L.norm_mix, 3, (const float*)(L.ws + OFF_PART), tid); break;
      case 6: shift_phase(L, tid); break;
      case 8: scan_phase(L, lds, tid); break;
      case 9: rwkv_out_phase(L, tid); break;
      case 11: rope_phase(L, tid); break;
      case 12: attn_phase(L, smem, tid); break;
      case 16: norm_mod_phase(L, L.out, nullptr, MT, L.norm_ffn2, 6, nullptr, tid); break;
      case 19: final_norm_phase(L, tid); break;
      default: break;
    }
    if (ph + 1 < P.ph_hi) { if (ph == 0) grid.sync(); else if (ph != 13 || !ONE_LAUNCH) xcd_barrier(gbar, bst); }
  }
#if PROBE
  grid.sync();
  if (blockIdx.x == 0) {
    LAS unsigned long long* TS = (LAS unsigned long long*)(lds + LDS_BYTES);
    if (threadIdx.x == 0) TS[NPH] = __builtin_amdgcn_s_memrealtime();
    __syncthreads();
    const int K = (int)((TS[PROBE_HI] - TS[PROBE_LO]) / 100ull);
    int t2 = threadIdx.x; asm volatile("" : "+v"(t2));
    for (int i = t2; i < K && i < 16000; i += 512) P.out[(size_t)i * 4099] += 0.1f;
  }
#endif
}

extern "C" void kernel_launch(void* const* d_in, const int* in_sizes, int n_in, void* d_out, int out_size, void* d_ws, size_t ws_size, hipStream_t stream) {
  static int grid_blocks = 0;
  if (!grid_blocks) {
    if (n_in != 31 || out_size != MT * DM || ws_size < WS_TOTAL) { fprintf(stderr, "kernel_launch: unexpected shapes n_in %d out %d ws %zu (need %zu)\n", n_in, out_size, ws_size, WS_TOTAL); return; }
    if (hipFuncSetAttribute((const void*)mega_fwd, hipFuncAttributeMaxDynamicSharedMemorySize, LDS_BYTES + 256) != hipSuccess) { fprintf(stderr, "kernel_launch: hipFuncSetAttribute failed\n"); return; }
    int dev = 0, cus = 0, per_cu = 0;
    hipGetDevice(&dev);
    hipDeviceGetAttribute(&cus, hipDeviceAttributeMultiprocessorCount, dev);
    hipOccupancyMaxActiveBlocksPerMultiprocessor(&per_cu, mega_fwd, 512, LDS_BYTES + 256);
    if (per_cu < 1) { fprintf(stderr, "kernel_launch: occupancy query returned %d\n", per_cu); per_cu = 1; }
    grid_blocks = cus;
  }
  Params p{};
  const float** pf = (const float**)&p;
  for (int i = 0; i < 31; ++i) pf[i] = (const float*)d_in[i];
  p.out = (float*)d_out; p.ws = (unsigned char*)d_ws; p.bid = 0; p.grd = 0;
#if ONE_LAUNCH
  p.ph_lo = 0; p.ph_hi = NPH;
  if (hipMemsetAsync((char*)d_ws + OFF_BAR, 0, 3456 * 4, stream) != hipSuccess) { fprintf(stderr, "kernel_launch: memset of barrier words failed\n"); return; }
  void* args[] = {&p};
  hipError_t e = hipLaunchCooperativeKernel((const void*)mega_fwd, dim3(grid_blocks), dim3(512), args, LDS_BYTES + 256, stream);
  if (e != hipSuccess) fprintf(stderr, "cooperative launch failed: %s (grid %d)\n", hipGetErrorString(e), grid_blocks);
#else
  for (int ph = 0; ph < NPH; ++ph) { p.ph_lo = ph; p.ph_hi = ph + 1; hipLaunchKernelGGL(mega_fwd, dim3(grid_blocks), dim3(512), LDS_BYTES + 256, stream, p); }
#endif
}
```

```cpp
#include <hip/hip_runtime.h>
#include <hip/hip_cooperative_groups.h>
#include <cstdio>
#include <cstdint>
namespace cg = cooperative_groups;

#ifndef ONE_LAUNCH
#define ONE_LAUNCH 1
#endif

#ifndef PROBE
#define PROBE 0
#endif
#define PROBE_LO 8
#define PROBE_HI 9
#define LAS __attribute__((address_space(3)))
typedef unsigned short bf16_t;
typedef short bf16x8 __attribute__((ext_vector_type(8)));
typedef short s16x4 __attribute__((ext_vector_type(4)));
typedef float f32x4 __attribute__((ext_vector_type(4)));
typedef float f32x2 __attribute__((ext_vector_type(2)));
typedef float f32x16 __attribute__((ext_vector_type(16)));
typedef unsigned u32x4 __attribute__((ext_vector_type(4)));
typedef unsigned u32x2 __attribute__((ext_vector_type(2)));

constexpr int DM = 2048, NB = 4, SEQ = 8192, CTXL = 256, MT = NB * SEQ, MC = NB * CTXL, MA = MT + MC;
constexpr int DFF = 5632, SKV = SEQ + CTXL, NMODC = 9 * DM;
constexpr int PRW_LD = 3584, SH_LD = 3072, LIN_LD = 384, LO_LD = 5120;
constexpr int LDS_BYTES = 139264;

constexpr size_t SZ_WA = (size_t)11264 * 2048 * 2, SZ_WB = (size_t)2048 * 5632 * 2;
constexpr size_t OFF_W1A = 0, OFF_W1B = OFF_W1A + SZ_WA, OFF_W2A = OFF_W1B + SZ_WB, OFF_W2B = OFF_W2A + SZ_WA;
constexpr size_t OFF_WRW = OFF_W2B + SZ_WB, OFF_WQKVG = OFF_WRW + (size_t)3584 * 2048 * 2, OFF_WOA = OFF_WQKVG + (size_t)7168 * 2048 * 2;
constexpr size_t OFF_WOR = OFF_WOA + (size_t)2048 * 2048 * 2, OFF_WOUT = OFF_WOR + (size_t)2048 * 1024 * 2, OFF_WLORA = OFF_WOUT + (size_t)2048 * 2048 * 2;
constexpr size_t OFF_MOD = OFF_WLORA + (size_t)5120 * 384 * 2, OFF_CX = OFF_MOD + (size_t)5 * NMODC * 4, OFF_H = OFF_CX + (size_t)MC * DM * 4;
constexpr size_t OFF_BIG = OFF_H + (size_t)MA * DM * 2;
constexpr size_t SZ_KV = (size_t)NB * SKV * 512 * 2;
constexpr size_t OFF_KB = OFF_W1A, OFF_VB = OFF_KB + SZ_KV;
static_assert(OFF_VB + SZ_KV <= OFF_W2A, "KV overlay");
constexpr size_t OFF_ACT = OFF_BIG;
constexpr size_t OFF_PART = OFF_ACT + (size_t)MA * DFF * 2;
constexpr size_t OFF_PRW = OFF_BIG, OFF_LO = OFF_BIG, OFF_SH = OFF_LO + (size_t)MA * LO_LD * 2, OFF_LIN = OFF_SH + (size_t)MA * SH_LD * 2, OFF_Y = OFF_LIN;
constexpr size_t OFF_Q = OFF_BIG, OFF_GA = OFF_Q + (size_t)MT * DM * 2, OFF_GR = OFF_GA + (size_t)MT * DM * 2;
constexpr size_t END_A = OFF_ACT + (size_t)MA * DFF * 2, END_B = OFF_Y + (size_t)2 * MT * 1024 * 2, END_C = OFF_LIN + (size_t)MA * LIN_LD * 2;
constexpr size_t WS_END = END_A > END_B ? (END_A > END_C ? END_A : END_C) : (END_B > END_C ? END_B : END_C);
constexpr size_t OFF_BAR = (WS_END + 255) / 256 * 256, WS_TOTAL = OFF_BAR + 3456 * 4;
static_assert((size_t)MA * PRW_LD * 2 <= (size_t)MA * LO_LD * 2, "PRW under LO");
static_assert(OFF_GR + (size_t)MT * DM * 2 <= OFF_Y, "GR below RWO");

struct Params {
  const float *x, *c, *ctx, *c_ctx, *w_mod, *b_mod, *norm_ffn1, *ffn1_w_in, *ffn1_w_out, *norm_mix, *w_in, *q_norm, *k_norm, *rwkv_mu, *w0, *w2, *a0, *a2,
      *g2, *k_k, *k_a, *r_k, *ln_x_w, *ln_x_b, *w_oa, *w_or, *w_out, *norm_ffn2, *ffn2_w_in, *ffn2_w_out, *norm_final;
  float* out; unsigned char* ws; int ph_lo, ph_hi; int bid, grd;
};

__device__ __forceinline__ unsigned cvt_pk_bf16(float lo, float hi) { unsigned r; asm("v_cvt_pk_bf16_f32 %0, %1, %2" : "=v"(r) : "v"(lo), "v"(hi)); return r; }
__device__ __forceinline__ float bf2f(unsigned short b) { return __uint_as_float(((unsigned)b) << 16); }
__device__ __forceinline__ float bflo(unsigned w) { return __uint_as_float(w << 16); }
__device__ __forceinline__ float bfhi(unsigned w) { return __uint_as_float(w & 0xffff0000u); }
__device__ __forceinline__ unsigned short f2bf(float f) { return (unsigned short)(cvt_pk_bf16(f, 0.f) & 0xffffu); }
__device__ __forceinline__ float sigmoidf_(float x) { return __builtin_amdgcn_rcpf(1.f + __builtin_amdgcn_exp2f(-1.4426950408889634f * x)); }
template <int CTRL> __device__ __forceinline__ float dpp_mov(float x) { return __int_as_float(__builtin_amdgcn_update_dpp(0, __float_as_int(x), CTRL, 0xF, 0xF, true)); }
__device__ __forceinline__ float allred16(float x) {
  x += dpp_mov<0xB1>(x); x += dpp_mov<0x4E>(x); x += dpp_mov<0x141>(x); x += dpp_mov<0x140>(x); return x;
}

__device__ __forceinline__ float wave_sum(float v) {
  v = allred16(v);
  { auto rr = __builtin_amdgcn_permlane16_swap(__float_as_uint(v), __float_as_uint(v), false, false); v = __uint_as_float(rr[0]) + __uint_as_float(rr[1]); }
  { auto rr = __builtin_amdgcn_permlane32_swap(__float_as_uint(v), __float_as_uint(v), false, false); v = __uint_as_float(rr[0]) + __uint_as_float(rr[1]); }
  return v;
}

constexpr int BM = 256, BK = 64, HALF = 128, HTB = HALF * BK * 2;
__device__ __forceinline__ int lds_byte(int r, int c) { const int st = (r >> 4) * 2 + (c >> 5), rr = r & 15, cc = c & 31, ob = rr * 64 + cc * 2; return st * 1024 + (ob ^ (((ob >> 9) & 1) << 5)); }
__device__ __forceinline__ void stage_rc(int b, int& R, int& C) { const int st = b / 1024, sb = b % 1024, swz = sb ^ (((sb >> 9) & 1) << 5); R = (st >> 1) * 16 + swz / 64; C = (st & 1) * 32 + (swz % 64) / 2; }
__device__ __forceinline__ int perm32(int rho) { const int n = rho >> 4, i = rho & 15; return 8 * (i >> 2) + 4 * n + (i & 3); }

enum { M_SWIGLU = 0, M_RESID = 1, M_RW = 2, M_QKVG = 3, M_LORA = 4, M_T1 = 5, M_M = 6 };
struct Unit { const char* A; const char* B; int pm, pn, seg, nt; };
struct GemmDesc {
  int K, mode, G, c;
  const bf16_t *A0, *B0; int pm00, nM0, nN0, n0;
  const bf16_t *A1, *B1; int pm01, nN1, n1;
  int a_tiled;
  int nt0, nt1, ksplit1;
  const float* xin; int gidx; float gscale;
  bf16_t* act;
};
__device__ __forceinline__ bool sched_next(const GemmDesc& d, int i, Unit& u) {
  long L = (long)i * d.G + d.c;
  if (L < d.n0) {
    int wgid = (int)L; const int nwg = d.n0;
    { const int q = nwg / 8, r = nwg % 8, xcd = wgid % 8, off = wgid / 8; wgid = (xcd < r ? xcd * (q + 1) : r * (q + 1) + (xcd - r) * q) + off; }
    const int nig = 8 * d.nN0, gid = wgid / nig, fm = gid * 8, gsz = (d.nM0 - fm) < 8 ? (d.nM0 - fm) : 8;
    const int pm = fm + ((wgid % nig) % gsz), pn = (wgid % nig) / gsz;
    u.pm = d.pm00 + pm; u.pn = pn; u.seg = 0; u.nt = d.nt0;
    u.A = (const char*)d.A0 + (size_t)u.pm * 512 * d.K; u.B = (const char*)d.B0 + (size_t)pn * 512 * d.K;
    if (d.mode == M_LORA) { const int ko = (pn < 8 ? 0 : (pn < 16 ? 128 : 256)) * 2; u.A += ko; u.B += ko; }
    return true;
  }
  L -= d.n0;
  if (L < d.n1) {
    const int sp = (int)L % d.ksplit1, l2 = (int)L / d.ksplit1;
    const int pm = l2 / d.nN1, pn = l2 % d.nN1; u.pm = d.pm01 + pm; u.pn = pn; u.seg = 1 + sp; u.nt = d.nt1;
    const size_t ko = (size_t)sp * d.nt1 * 128, koA = d.a_tiled ? (size_t)sp * d.nt1 * 32768 : ko;
    u.A = (const char*)d.A1 + (size_t)u.pm * 512 * d.K + koA; u.B = (const char*)d.B1 + (size_t)pn * 512 * d.K + ko; return true;
  }
  return false;
}

__device__ __forceinline__ void gemm_epilogue(const f32x4 (&acc)[2][2][4][2], const Unit& u, const GemmDesc& d, const Params& P, int wr, int wc, int fr, int fq) {
  unsigned char* ws = P.ws;
  asm volatile("" : "+v"(fr), "+v"(fq));
  const int rl0 = wr * 64 + fr, cl0 = wc * 32 + 8 * fq;
  switch (d.mode) {
  case M_SWIGLU: {
    bf16_t* base = d.act + ((size_t)(u.pm * 88 + u.pn * 2 + (cl0 >> 6)) * 256) * 64 + (cl0 & 63);
#pragma unroll
    for (int ai = 0; ai < 2; ++ai)
#pragma unroll
      for (int m = 0; m < 4; ++m) {
        const int row = rl0 + 128 * ai + 16 * m;
        float o[8];
#pragma unroll
        for (int n = 0; n < 2; ++n)
#pragma unroll
          for (int j = 0; j < 4; ++j) { const float g = acc[ai][0][m][n][j], up = acc[ai][1][m][n][j]; o[4 * n + j] = g * sigmoidf_(g) * up; }
        u32x4 w; w.x = cvt_pk_bf16(o[0], o[1]); w.y = cvt_pk_bf16(o[2], o[3]); w.z = cvt_pk_bf16(o[4], o[5]); w.w = cvt_pk_bf16(o[6], o[7]);
        *(u32x4*)(base + (size_t)row * 64) = w;
      }
  } break;
  case M_RESID: {
    if (u.seg >= 1) {
      float* po = (float*)(ws + OFF_PART) + (size_t)(u.seg - 1) * MC * DM + (size_t)(u.pm - 128) * 256 * DM + u.pn * 256 + cl0;
#pragma unroll
      for (int ai = 0; ai < 2; ++ai)
#pragma unroll
        for (int m = 0; m < 4; ++m)
#pragma unroll
          for (int bj = 0; bj < 2; ++bj)
#pragma unroll
            for (int n = 0; n < 2; ++n) *(f32x4*)(po + (size_t)(rl0 + 128 * ai + 16 * m) * DM + 128 * bj + 4 * n) = acc[ai][bj][m][n];
      break;
    }
    const bool isc = u.pm >= 128; const int b = isc ? 4 : (u.pm >> 5);
    const float* xin = isc ? P.ctx + (size_t)(u.pm - 128) * 256 * DM : d.xin + (size_t)u.pm * 256 * DM;
    float* xo = isc ? (float*)(ws + OFF_CX) + (size_t)(u.pm - 128) * 256 * DM : P.out + (size_t)u.pm * 256 * DM;
    const float* gate = (const float*)(ws + OFF_MOD) + b * NMODC + d.gidx * DM + u.pn * 256 + cl0;
    f32x4 g4[2][2];
#pragma unroll
    for (int bj = 0; bj < 2; ++bj)
#pragma unroll
      for (int n = 0; n < 2; ++n) g4[bj][n] = *(const f32x4*)(gate + 128 * bj + 4 * n) * d.gscale;
#pragma unroll
    for (int ai = 0; ai < 2; ++ai)
#pragma unroll
      for (int m = 0; m < 4; ++m) {
        const size_t ro = (size_t)(rl0 + 128 * ai + 16 * m) * DM + u.pn * 256 + cl0;
#pragma unroll
        for (int bj = 0; bj < 2; ++bj)
#pragma unroll
          for (int n = 0; n < 2; ++n) {
            const f32x4 xv = *(const f32x4*)(xin + ro + 128 * bj + 4 * n);
            *(f32x4*)(xo + ro + 128 * bj + 4 * n) = xv + g4[bj][n] * acc[ai][bj][m][n];
          }
      }
  } break;
  case M_RW: case M_QKVG: case M_LORA: {
    bf16_t* base; int ld; int act = 0; const float* bias = nullptr;
    if (d.mode == M_RW) {
      if (u.seg == 0) { base = (bf16_t*)(ws + OFF_PRW) + (size_t)u.pm * 256 * PRW_LD + u.pn * 256; ld = PRW_LD; }
      else { const int b = u.pm - 128; base = (bf16_t*)(ws + (u.pn < 2 ? OFF_KB : OFF_VB)) + (size_t)(b * SKV + SEQ) * 512 + (u.pn & 1) * 256; ld = 512; }
    } else if (d.mode == M_QKVG) {
      const int b = u.pm >> 5;
      if (u.pn < 8) { base = (bf16_t*)(ws + OFF_Q) + (size_t)u.pm * 256 * DM + u.pn * 256; ld = DM; }
      else if (u.pn < 12) { base = (bf16_t*)(ws + (u.pn < 10 ? OFF_KB : OFF_VB)) + (size_t)(u.pm * 256 + b * CTXL) * 512 + (u.pn & 1) * 256; ld = 512; }
      else { base = (bf16_t*)(ws + (u.pn < 20 ? OFF_GA : OFF_GR)) + (size_t)u.pm * 256 * DM + ((u.pn - 12) & 7) * 256; ld = DM; act = 1; }
    } else {
      base = (bf16_t*)(ws + OFF_LO) + (size_t)u.pm * 256 * LO_LD + u.pn * 256; ld = LO_LD;
      if (u.pn < 8) { act = 2; bias = P.w0 + u.pn * 256; } else if (u.pn < 16) { act = 1; bias = P.a0 + (u.pn - 8) * 256; }
    }
#pragma unroll
    for (int bj = 0; bj < 2; ++bj) {
      f32x4 b0 = {0.f, 0.f, 0.f, 0.f}, b1 = {0.f, 0.f, 0.f, 0.f};
      if (bias) { b0 = *(const f32x4*)(bias + 128 * bj + cl0); b1 = *(const f32x4*)(bias + 128 * bj + cl0 + 4); }
#pragma unroll
      for (int ai = 0; ai < 2; ++ai)
#pragma unroll
        for (int m = 0; m < 4; ++m) {
          const int row = rl0 + 128 * ai + 16 * m;
          f32x4 v0 = acc[ai][bj][m][0] + b0, v1 = acc[ai][bj][m][1] + b1;
          if (act) {
            const float sc = act == 2 ? 0.60653065971263342f * 1.4426950408889634f : 1.f;
#pragma unroll
            for (int j = 0; j < 4; ++j) { v0[j] = sc * sigmoidf_(v0[j]); v1[j] = sc * sigmoidf_(v1[j]); }
          }
          u32x4 w; w.x = cvt_pk_bf16(v0[0], v0[1]); w.y = cvt_pk_bf16(v0[2], v0[3]); w.z = cvt_pk_bf16(v1[0], v1[1]); w.w = cvt_pk_bf16(v1[2], v1[3]);
          *(u32x4*)(base + (size_t)row * ld + 128 * bj + cl0) = w;
        }
    }
  } break;
  case M_T1: case M_M: {
    bf16_t* ga = (bf16_t*)(ws + OFF_GA) + (size_t)u.pm * 256 * DM + u.pn * 256 + cl0;
    bf16_t* gr = (bf16_t*)(ws + OFF_GR) + (size_t)u.pm * 256 * DM + u.pn * 256 + cl0;
    const bool isM = d.mode == M_M;
#pragma unroll
    for (int ai = 0; ai < 2; ++ai)
#pragma unroll
      for (int m = 0; m < 4; ++m)
#pragma unroll
        for (int bj = 0; bj < 2; ++bj) {
          const size_t o = (size_t)(rl0 + 128 * ai + 16 * m) * DM + 128 * bj;
          const f32x4 v0 = acc[ai][bj][m][0], v1 = acc[ai][bj][m][1];
          const u32x4 a = *(const u32x4*)(ga + o);
          u32x4 w;
          if (!isM) {
            w.x = cvt_pk_bf16(bflo(a.x) * v0[0], bfhi(a.x) * v0[1]); w.y = cvt_pk_bf16(bflo(a.y) * v0[2], bfhi(a.y) * v0[3]);
            w.z = cvt_pk_bf16(bflo(a.z) * v1[0], bfhi(a.z) * v1[1]); w.w = cvt_pk_bf16(bflo(a.w) * v1[2], bfhi(a.w) * v1[3]);
            *(u32x4*)(ga + o) = w;
          } else {
            const u32x4 g = *(const u32x4*)(gr + o);
            w.x = cvt_pk_bf16(bflo(a.x) + bflo(g.x) * v0[0], bfhi(a.x) + bfhi(g.x) * v0[1]); w.y = cvt_pk_bf16(bflo(a.y) + bflo(g.y) * v0[2], bfhi(a.y) + bfhi(g.y) * v0[3]);
            w.z = cvt_pk_bf16(bflo(a.z) + bflo(g.z) * v1[0], bfhi(a.z) + bfhi(g.z) * v1[1]); w.w = cvt_pk_bf16(bflo(a.w) + bflo(g.w) * v1[2], bfhi(a.w) + bfhi(g.w) * v1[3]);
            *(u32x4*)(gr + o) = w;
          }
        }
  } break;
  }
}

__device__ __forceinline__ void gemm_phase(LAS unsigned char* lds, const GemmDesc& d, const Params& P, const int tid) {
  const int wid = __builtin_amdgcn_readfirstlane(tid >> 6), lane = tid & 63, wr = wid >> 2, wc = wid & 3, fr = lane & 15, fq = lane >> 4;
  const int K = d.K;
  unsigned voffA[2], voffB[2];
#pragma unroll
  for (int i = 0; i < 2; ++i) { int R, C; stage_rc(tid * 16 + i * 8192, R, C); const int Rb = (R & ~31) + perm32(R & 31);
    voffA[i] = d.a_tiled ? (unsigned)(R * 64 + C) * 2u : (unsigned)(R * K + C) * 2u; voffB[i] = (unsigned)(Rb * K + C) * 2u; }
  const size_t kstep = (size_t)(BK * 2);
  const size_t hstep = (size_t)HALF * K * 2;
  const size_t kstepA = d.a_tiled ? (size_t)32768 : kstep, hstepA = d.a_tiled ? (size_t)16384 : hstep;
  const unsigned ldsw = (unsigned)wid * 1024u;
  const int aoff = lds_byte(wr * 64 + fr, fq * 8), boff = lds_byte(wc * 32 + fr, fq * 8);
#define PG8_SA(b, h) (((b) * 2 + (h)) * HTB)
#define PG8_SB(b, h) ((4 + (b) * 2 + (h)) * HTB)
#define PG8_STAGE(bufoff, gbase, voff) do { _Pragma("unroll") for (int _i = 0; _i < 2; ++_i) \
    __builtin_amdgcn_global_load_lds((const unsigned*)((const char*)(gbase) + (voff)[_i]), (LAS unsigned*)(lds + (bufoff) + ldsw + _i * 8192), 16, 0, 0); } while (0)
#define PG8_LDA(dst, b, h) do { _Pragma("unroll") for (int m = 0; m < 4; ++m) _Pragma("unroll") for (int k = 0; k < 2; ++k) dst[m][k] = *(const LAS bf16x8*)(lds + PG8_SA(b, h) + aoff + m * 2048 + k * 1024); } while (0)
#define PG8_LDB(dst, b, h) do { _Pragma("unroll") for (int n = 0; n < 2; ++n) _Pragma("unroll") for (int k = 0; k < 2; ++k) dst[n][k] = *(const LAS bf16x8*)(lds + PG8_SB(b, h) + boff + n * 2048 + k * 1024); } while (0)
#define PG8_MMA(ai, bj, At, Bt) do { __builtin_amdgcn_s_setprio(1); _Pragma("unroll") for (int m = 0; m < 4; ++m) _Pragma("unroll") for (int n = 0; n < 2; ++n) _Pragma("unroll") for (int k = 0; k < 2; ++k) \
    acc[ai][bj][m][n] = __builtin_amdgcn_mfma_f32_16x16x32_bf16(Bt[n][k], At[m][k], acc[ai][bj][m][n], 0, 0, 0); __builtin_amdgcn_s_setprio(0); } while (0)
#define PG8_WAIT_V(n) asm volatile("s_waitcnt vmcnt(" #n ")" ::: "memory")
#define PG8_WAIT_L(n) asm volatile("s_waitcnt lgkmcnt(" #n ")" ::: "memory")
#define PG8_BAR __builtin_amdgcn_s_barrier()
#define PG8_SCHED __builtin_amdgcn_sched_barrier(0)
  Unit cur, nxt; int ui = 0;
  if (!sched_next(d, 0, cur)) return;
  f32x4 acc[2][2][4][2];
#pragma unroll
  for (int a = 0; a < 2; ++a)
#pragma unroll
    for (int b = 0; b < 2; ++b)
#pragma unroll
      for (int m = 0; m < 4; ++m)
#pragma unroll
        for (int n = 0; n < 2; ++n) acc[a][b][m][n] = (f32x4){0.f, 0.f, 0.f, 0.f};
  bf16x8 At[4][2], B0[2][2], B1[2][2];
  const char* cA = cur.A; const char* cB = cur.B;
  PG8_STAGE(PG8_SB(0, 0), cB, voffB); PG8_STAGE(PG8_SB(0, 1), cB + hstep, voffB); PG8_STAGE(PG8_SA(0, 0), cA, voffA); PG8_STAGE(PG8_SA(0, 1), cA + hstepA, voffA);
  if (wr == 1) PG8_BAR;
  PG8_WAIT_V(2); PG8_BAR;
  PG8_STAGE(PG8_SB(1, 0), cB + kstep, voffB); PG8_STAGE(PG8_SA(1, 0), cA + kstepA, voffA); PG8_STAGE(PG8_SB(1, 1), cB + hstep + kstep, voffB);
  PG8_WAIT_V(6); PG8_BAR;
  for (;;) {
    const bool has_next = sched_next(d, ui + 1, nxt);
    const char* nA = has_next ? nxt.A : cA; const char* nB = has_next ? nxt.B : cB;
    const int nt = cur.nt;
    for (int t = 0; t < nt; t += 2) {
      const bool last = (t == nt - 2);
      const char* a1 = cA + (size_t)(t + 1) * kstepA;
      const char* a2 = last ? nA : cA + (size_t)(t + 2) * kstepA; const char* b2 = last ? nB : cB + (size_t)(t + 2) * kstep;
      const char* a3 = a2 + kstepA; const char* b3 = b2 + kstep;
      PG8_LDB(B0, 0, 0); PG8_LDB(B1, 0, 1); PG8_SCHED; PG8_LDA(At, 0, 0); PG8_STAGE(PG8_SA(1, 1), a1 + hstepA, voffA);
      PG8_WAIT_V(8); PG8_WAIT_L(0); PG8_BAR; PG8_MMA(0, 0, At, B0); PG8_MMA(0, 1, At, B1); PG8_BAR; PG8_SCHED;
      PG8_LDA(At, 0, 1); PG8_STAGE(PG8_SB(0, 0), b2, voffB); PG8_STAGE(PG8_SB(0, 1), b2 + hstep, voffB); PG8_STAGE(PG8_SA(0, 0), a2, voffA);
      PG8_WAIT_V(8); PG8_WAIT_L(0); PG8_BAR; PG8_MMA(1, 0, At, B0); PG8_MMA(1, 1, At, B1); PG8_BAR; PG8_SCHED;
      PG8_LDB(B0, 1, 0); PG8_LDB(B1, 1, 1); PG8_SCHED; PG8_LDA(At, 1, 0); PG8_STAGE(PG8_SA(0, 1), a2 + hstepA, voffA);
      PG8_WAIT_V(8); PG8_WAIT_L(0); PG8_BAR; PG8_MMA(0, 0, At, B0); PG8_MMA(0, 1, At, B1); PG8_BAR; PG8_SCHED;
      PG8_LDA(At, 1, 1); PG8_STAGE(PG8_SB(1, 0), b3, voffB); PG8_STAGE(PG8_SB(1, 1), b3 + hstep, voffB); PG8_STAGE(PG8_SA(1, 0), a3, voffA);
      PG8_WAIT_V(8); PG8_WAIT_L(0); PG8_BAR; PG8_MMA(1, 0, At, B0); PG8_MMA(1, 1, At, B1); PG8_BAR; PG8_SCHED;
    }
    if (wr == 0) PG8_BAR;
    gemm_epilogue(acc, cur, d, P, wr, wc, fr, fq);
    if (!has_next) break;
#pragma unroll
    for (int a = 0; a < 2; ++a)
#pragma unroll
      for (int b = 0; b < 2; ++b)
#pragma unroll
        for (int m = 0; m < 4; ++m)
#pragma unroll
          for (int n = 0; n < 2; ++n) acc[a][b][m][n] = (f32x4){0.f, 0.f, 0.f, 0.f};
    cur = nxt; cA = nA; cB = nB; ++ui;
    if (wr == 1) PG8_BAR;
  }
  PG8_WAIT_V(0);
  PG8_BAR;
#undef PG8_SA
#undef PG8_SB
#undef PG8_STAGE
#undef PG8_LDA
#undef PG8_LDB
#undef PG8_MMA
#undef PG8_WAIT_V
#undef PG8_WAIT_L
#undef PG8_BAR
#undef PG8_SCHED
}

namespace att {
constexpr int D = 128, NW = 8, QBLK = 32, KVBLK = 64;
constexpr float SCALE = 0.088388347648318440f;
constexpr float THR = 8.f;
constexpr int LDQ = 2048, LDK = 512, LDO = 2048;
constexpr size_t SHM_V = KVBLK * D * 2, SHM_K = KVBLK * D * 2;
#define KSWZ(row, colB) ((row) * 256 + ((colB) ^ (((row) & 7) << 4)))
#define SBAR() __builtin_amdgcn_sched_barrier(0)
__device__ __forceinline__ int crow(int r, int hi) { return (r & 3) + 8 * (r >> 2) + 4 * hi; }
__device__ __forceinline__ unsigned cvtpk(float lo, float hi) { unsigned r; asm volatile("v_cvt_pk_bf16_f32 %0, %1, %2" : "=v"(r) : "v"(lo), "v"(hi)); return r; }
__device__ __forceinline__ void partialSM(f32x16& p0, f32x16& p1, float& m_reg, float& mn, float& alpha) {
  constexpr float C = SCALE * 1.4426950408889634f;
  float pmax = p0[0];
#pragma unroll
  for (int r = 1; r < 16; ++r) pmax = fmaxf(pmax, p0[r]);
#pragma unroll
  for (int r = 0; r < 16; ++r) pmax = fmaxf(pmax, p1[r]);
  { auto rr = __builtin_amdgcn_permlane32_swap(__float_as_uint(pmax), __float_as_uint(pmax), false, false);
    pmax = fmaxf(__uint_as_float(rr[0]), __uint_as_float(rr[1])); }
  if (__builtin_expect(__all(pmax - m_reg <= THR / SCALE), 1)) { mn = m_reg; alpha = 1.f; }
  else { mn = fmaxf(m_reg, pmax); alpha = __builtin_amdgcn_exp2f((m_reg - mn) * C); m_reg = mn; }
  float mnC = -mn * C;
#pragma unroll
  for (int r = 0; r < 16; ++r) p0[r] = fmaf(p0[r], C, mnC);
#pragma unroll
  for (int r = 0; r < 16; ++r) p1[r] = fmaf(p1[r], C, mnC);
#pragma unroll
  for (int r = 0; r < 16; ++r) p0[r] = __builtin_amdgcn_exp2f(p0[r]);
}
__device__ __forceinline__ void finishSM(f32x16& p0, f32x16& p1, float alpha, float& l_reg, bf16x8& pa0, bf16x8& pa1, bf16x8& pa2, bf16x8& pa3) {
#pragma unroll
  for (int r = 0; r < 16; ++r) p1[r] = __builtin_amdgcn_exp2f(p1[r]);
  float ps = 0;
#pragma unroll
  for (int r = 0; r < 16; ++r) ps += p0[r];
#pragma unroll
  for (int r = 0; r < 16; ++r) ps += p1[r];
  { auto rr = __builtin_amdgcn_permlane32_swap(__float_as_uint(ps), __float_as_uint(ps), false, false);
    ps = __uint_as_float(rr[0]) + __uint_as_float(rr[1]); }
  l_reg = l_reg * alpha + ps;
#define PK4(P, BASE, OUT) do { unsigned a0 = cvtpk(P[BASE + 0], P[BASE + 1]), a1 = cvtpk(P[BASE + 2], P[BASE + 3]);   \
    unsigned b0 = cvtpk(P[BASE + 4], P[BASE + 5]), b1 = cvtpk(P[BASE + 6], P[BASE + 7]);                              \
    auto r0 = __builtin_amdgcn_permlane32_swap(a0, b0, false, false); auto r1 = __builtin_amdgcn_permlane32_swap(a1, b1, false, false); \
    u32x4 w = {r0[0], r1[0], r0[1], r1[1]}; OUT = *reinterpret_cast<bf16x8*>(&w); } while (0)
  PK4(p0, 0, pa0); PK4(p0, 8, pa1); PK4(p1, 0, pa2); PK4(p1, 8, pa3);
#undef PK4
}
__device__ __forceinline__ void qkt(f32x16& p0, f32x16& p1, const bf16_t* Ks, const bf16x8* qr, int r32, int hi) {
  p0 = f32x16{}; p1 = f32x16{};
#pragma unroll
  for (int d0 = 0; d0 < 8; ++d0) { int cb = (d0 * 16 + hi * 8) * 2;
    bf16x8 b0 = *reinterpret_cast<const bf16x8*>((const char*)Ks + KSWZ(r32, cb));
    bf16x8 b1 = *reinterpret_cast<const bf16x8*>((const char*)Ks + KSWZ(32 + r32, cb));
    p0 = __builtin_amdgcn_mfma_f32_32x32x16_bf16(b0, qr[d0], p0, 0, 0, 0);
    p1 = __builtin_amdgcn_mfma_f32_32x32x16_bf16(b1, qr[d0], p1, 0, 0, 0); }
}
__device__ __forceinline__ int v_st(int k, int c) { const int kk = (k & ~0xC) | ((k & 4) << 1) | ((k & 8) >> 1); return ((kk >> 3) * 4 + (c >> 5)) * 512 + ((kk & 7) * 32 + (c & 31)) * 2; }
__device__ __forceinline__ int v_rd_base(int lane) { return ((lane & 3) << 3) | (((lane >> 2) & 3) << 6) | (((lane >> 4) & 1) << 5) | (((lane >> 5) & 1) << 8); }
constexpr int v_rd_off(int d0, int ks, int half) { return d0 * 512 + ks * 4096 + half * 2048; }
template <int OFF> __device__ __forceinline__ s16x4 tr_read(int vb) {
  s16x4 r; asm volatile("ds_read_b64_tr_b16 %0, %1 offset:%2" : "=&v"(r) : "v"(vb), "i"(OFF) : "memory"); return r;
}
template <int D0> __device__ __forceinline__ void pv_one(f32x16& od, int vb, bf16x8 pa0, bf16x8 pa1, bf16x8 pa2, bf16x8 pa3) {
  const s16x4 l0 = tr_read<v_rd_off(D0, 0, 0)>(vb), h0 = tr_read<v_rd_off(D0, 0, 1)>(vb), l1 = tr_read<v_rd_off(D0, 1, 0)>(vb), h1 = tr_read<v_rd_off(D0, 1, 1)>(vb);
  const s16x4 l2 = tr_read<v_rd_off(D0, 2, 0)>(vb), h2 = tr_read<v_rd_off(D0, 2, 1)>(vb), l3 = tr_read<v_rd_off(D0, 3, 0)>(vb), h3 = tr_read<v_rd_off(D0, 3, 1)>(vb);
  asm volatile("s_waitcnt lgkmcnt(0)" ::: "memory"); SBAR();
#define PK(L, H) (bf16x8){L[0], L[1], L[2], L[3], H[0], H[1], H[2], H[3]}
  od = __builtin_amdgcn_mfma_f32_32x32x16_bf16(pa0, PK(l0, h0), od, 0, 0, 0);
  od = __builtin_amdgcn_mfma_f32_32x32x16_bf16(pa1, PK(l1, h1), od, 0, 0, 0);
  od = __builtin_amdgcn_mfma_f32_32x32x16_bf16(pa2, PK(l2, h2), od, 0, 0, 0);
  od = __builtin_amdgcn_mfma_f32_32x32x16_bf16(pa3, PK(l3, h3), od, 0, 0, 0);
#undef PK
}
__device__ __forceinline__ void pv_d0(f32x16* o, int vb, bf16x8 pa0, bf16x8 pa1, bf16x8 pa2, bf16x8 pa3) {
  pv_one<0>(o[0], vb, pa0, pa1, pa2, pa3); pv_one<1>(o[1], vb, pa0, pa1, pa2, pa3); pv_one<2>(o[2], vb, pa0, pa1, pa2, pa3); pv_one<3>(o[3], vb, pa0, pa1, pa2, pa3);
}
__device__ __forceinline__ void attn_dense_body(const bf16_t* __restrict__ Qb, const bf16_t* __restrict__ Kh, const bf16_t* __restrict__ Vh,
                                                bf16_t* __restrict__ Ob, int seq, char* lds, const int tid) {
  const int wid = tid >> 6, lane = tid & 63, r32 = lane & 31, hi = lane >> 5;
  bf16_t* V_lds = (bf16_t*)lds; bf16_t* K_lds = (bf16_t*)(lds + 2 * SHM_V);
  float* wsf = (float*)(lds + 2 * SHM_V + 2 * SHM_K) + wid * 64; float* li_l = wsf; float* al_l = wsf + 32;
  float m_reg = -1e30f, l_reg = 0; f32x16 o[4] = {}; bf16x8 qr[8];
  const bf16_t* Qw = Qb + (long)(wid * QBLK + r32) * LDQ + hi * 8;
#pragma unroll
  for (int d0 = 0; d0 < 8; ++d0) qr[d0] = *reinterpret_cast<const bf16x8*>(Qw + d0 * 16);
  const int sr = tid >> 4, sc = (tid & 15) * 8, vst0 = v_st(sr, sc), vst1 = v_st(32 + sr, sc);
  const int vb0 = (int)(uintptr_t)V_lds + v_rd_base(lane);
  struct { bf16x8 vs0, vs1, ks0, ks1; } sr_[2];
#define LD8(p) (*reinterpret_cast<const bf16x8*>(p))
  const unsigned voff = (unsigned)(sr * LDK + sc) * 2u;
#define SLOAD(i, k0) do { const char* vb_ = (const char*)(Vh + (size_t)(k0) * LDK); const char* kb_ = (const char*)(Kh + (size_t)(k0) * LDK); \
    sr_[i].vs0 = LD8(vb_ + voff); sr_[i].vs1 = LD8(vb_ + 32 * LDK * 2 + voff); sr_[i].ks0 = LD8(kb_ + voff); sr_[i].ks1 = LD8(kb_ + 32 * LDK * 2 + voff); } while (0)
#define SWRITE(b, i) do { *(bf16x8*)((char*)V_lds + (b) * SHM_V + vst0) = sr_[i].vs0;          \
    *(bf16x8*)((char*)V_lds + (b) * SHM_V + vst1) = sr_[i].vs1; int kc = sc * 2;               \
    *(bf16x8*)((char*)K_lds + (b) * SHM_K + KSWZ(sr, kc)) = sr_[i].ks0;                       \
    *(bf16x8*)((char*)K_lds + (b) * SHM_K + KSWZ(32 + sr, kc)) = sr_[i].ks1; } while (0)
#define SWAIT() asm volatile("s_waitcnt vmcnt(4)" ::: "memory")
#define RESC(a) do { if (__any((a) < 1.f)) { if (hi == 0) al_l[r32] = (a); asm volatile("s_waitcnt lgkmcnt(0)" ::: "memory"); \
    _Pragma("unroll") for (int d = 0; d < 4; ++d) _Pragma("unroll") for (int r = 0; r < 16; ++r) o[d][r] *= al_l[crow(r, hi)]; } } while (0)
  f32x16 pA0, pA1, pB0, pB1; float mnA, mnB, alA, alB; bf16x8 pa0, pa1, pa2, pa3; const int NT = seq / KVBLK;
  constexpr int SE = 0, SO = 1;
  SLOAD(SE, 0); asm volatile("s_waitcnt vmcnt(0)" ::: "memory"); SWRITE(0, SE); __syncthreads();
  qkt(pA0, pA1, K_lds, qr, r32, hi); partialSM(pA0, pA1, m_reg, mnA, alA);
  SLOAD(SO, KVBLK); if (2 < NT) SLOAD(SE, 2 * KVBLK);
  SWAIT(); SWRITE(1, SO); __syncthreads();
  for (int j = 1; j + 1 < NT; j += 2) {
    SBAR(); qkt(pB0, pB1, (bf16_t*)((char*)K_lds + SHM_K), qr, r32, hi);
    finishSM(pA0, pA1, alA, l_reg, pa0, pa1, pa2, pa3); SBAR();
    SLOAD(SO, (j + 2) * KVBLK); SBAR();
    pv_d0(o, vb0, pa0, pa1, pa2, pa3); partialSM(pB0, pB1, m_reg, mnB, alB);
    __syncthreads(); SWAIT(); SWRITE(0, SE);
    RESC(alB); __syncthreads();
    SBAR(); qkt(pA0, pA1, K_lds, qr, r32, hi);
    finishSM(pB0, pB1, alB, l_reg, pa0, pa1, pa2, pa3); SBAR();
    if (j + 3 < NT) SLOAD(SE, (j + 3) * KVBLK); SBAR();
    pv_d0(o, vb0 + (int)SHM_V, pa0, pa1, pa2, pa3); partialSM(pA0, pA1, m_reg, mnA, alA);
    __syncthreads(); SWAIT(); SWRITE(1, SO);
    RESC(alA); __syncthreads();
  }
  SBAR(); qkt(pB0, pB1, (bf16_t*)((char*)K_lds + SHM_K), qr, r32, hi);
  finishSM(pA0, pA1, alA, l_reg, pa0, pa1, pa2, pa3); SBAR();
  pv_d0(o, vb0, pa0, pa1, pa2, pa3); partialSM(pB0, pB1, m_reg, mnB, alB);
  __syncthreads(); RESC(alB);
  finishSM(pB0, pB1, alB, l_reg, pa0, pa1, pa2, pa3); SBAR();
  pv_d0(o, vb0 + (int)SHM_V, pa0, pa1, pa2, pa3);
  if (hi == 0) li_l[r32] = l_reg; asm volatile("s_waitcnt lgkmcnt(0)" ::: "memory");
  float rli[16];
#pragma unroll
  for (int r = 0; r < 16; ++r) rli[r] = __builtin_amdgcn_rcpf(li_l[crow(r, hi)]);
  bf16_t* Ow = Ob + (long)(wid * QBLK) * LDO;
#pragma unroll
  for (int r = 0; r < 16; ++r) { int orow = crow(r, hi);
#pragma unroll
    for (int d0 = 0; d0 < 4; ++d0) Ow[(long)orow * LDO + d0 * 32 + r32] = f2bf(o[d0][r] * rli[r]); }
#undef LD8
#undef SLOAD
#undef SWRITE
#undef SWAIT
#undef RESC
}
}

__device__ __forceinline__ void mod_phase(const Params& P, LAS unsigned char* lds, const int tid) {
  LAS float* sc = (LAS float*)lds; LAS float* red = sc + 5 * 2048;
  const int wid = tid >> 6, lane = tid & 63;
  for (int i = tid; i < 5 * 2048; i += 512) { const int j = i >> 11, k = i & 2047; const float v = (j < 4) ? P.c[j * 2048 + k] : P.c_ctx[k]; sc[i] = v * sigmoidf_(v); }
  __syncthreads();
  float* MOD = (float*)(P.ws + OFF_MOD);
  for (int task = P.bid; task < 256; task += P.grd) {
    const int n0 = task * 72 + lane * 2;
    float a0[5], a1[5];
#pragma unroll
    for (int j = 0; j < 5; ++j) { a0[j] = 0.f; a1[j] = 0.f; }
    if (lane < 36) {
      const float* wp = P.w_mod + (size_t)(wid * 256) * NMODC + n0;
#pragma unroll 16
      for (int k = 0; k < 256; ++k) {
        const f32x2 w = *(const f32x2*)(wp + (size_t)k * NMODC);
#pragma unroll
        for (int j = 0; j < 5; ++j) { const float s = sc[j * 2048 + wid * 256 + k]; a0[j] += s * w.x; a1[j] += s * w.y; }
      }
#pragma unroll
      for (int j = 0; j < 5; ++j) { red[(wid * 5 + j) * 72 + lane * 2] = a0[j]; red[(wid * 5 + j) * 72 + lane * 2 + 1] = a1[j]; }
    }
    __syncthreads();
    if (tid < 360) { const int j = tid / 72, ci = tid % 72; float s = 0.f;
#pragma unroll
      for (int w = 0; w < 8; ++w) s += red[(w * 5 + j) * 72 + ci];
      MOD[j * NMODC + task * 72 + ci] = s + P.b_mod[task * 72 + ci]; }
    __syncthreads();
  }
}
__device__ __forceinline__ void tr_load(float (&tv)[32], const float* __restrict__ W, int ldw, int k0, int n0, int lane) {
#pragma unroll
  for (int i = 0; i < 32; ++i) { const int kk = 2 * i + (lane >> 5); tv[i] = W[(size_t)(k0 + kk) * ldw + n0 + (lane & 31)]; }
}
__device__ __forceinline__ void tr_store(const float (&tv)[32], int k0, bf16_t* __restrict__ WT, int ldt, int drow0, int dk0, LAS float* scr, int lane) {
#pragma unroll
  for (int i = 0; i < 32; ++i) { const int kk = 2 * i + (lane >> 5); scr[kk * 33 + (lane & 31)] = tv[i]; }
  asm volatile("s_waitcnt lgkmcnt(0)" ::: "memory");
  const int c = lane & 7;
#pragma unroll
  for (int j = 0; j < 4; ++j) { const int n = (lane >> 3) + 8 * j; const LAS float* s = scr + (8 * c) * 33 + n;
    u32x4 o; o.x = cvt_pk_bf16(s[0 * 33], s[1 * 33]); o.y = cvt_pk_bf16(s[2 * 33], s[3 * 33]); o.z = cvt_pk_bf16(s[4 * 33], s[5 * 33]); o.w = cvt_pk_bf16(s[6 * 33], s[7 * 33]);
    *(u32x4*)(WT + (size_t)(drow0 + n) * ldt + dk0 + k0 + 8 * c) = o; }
  asm volatile("s_waitcnt lgkmcnt(0)" ::: "memory");
}
__device__ __forceinline__ void tr_item(const float* __restrict__ W, int ldw, int k0, int n0, bf16_t* __restrict__ WT, int ldt, int drow0, int dk0, LAS float* scr, int lane) {
  float tv[32]; tr_load(tv, W, ldw, k0, n0, lane); tr_store(tv, k0, WT, ldt, drow0, dk0, scr, lane);
}
constexpr int N_LATE = 16896 + 6144 + 2048 + 1024 + 2048;
__device__ __forceinline__ void late_item_addr(const Params& P, int j, const float*& W, int& ldw, int& k0, int& n0, bf16_t*& WT, int& ldt, int& drow) {
  if (j < 11264) { const int kb = j / 352, nb = j % 352; n0 = nb * 32; k0 = kb * 64; W = P.ffn2_w_in; ldw = 2 * DFF; WT = (bf16_t*)(P.ws + OFF_W2A); ldt = 2048;
    drow = n0 < DFF ? (n0 >> 7) * 256 + (n0 & 127) : ((n0 - DFF) >> 7) * 256 + 128 + ((n0 - DFF) & 127); return; }
  j -= 11264;
  if (j < 5632) { const int kb = j >> 6, nb = j & 63; n0 = nb * 32; k0 = kb * 64; W = P.ffn2_w_out; ldw = 2048; WT = (bf16_t*)(P.ws + OFF_W2B); ldt = DFF; drow = n0; return; }
  j -= 5632;
  if (j < 6144) { const int kb = j / 192, nbi = j % 192, nb = nbi < 64 ? nbi : nbi + 32;
    n0 = nb < 96 ? nb * 32 : 6528 + (nb - 96) * 32; k0 = kb * 64; W = P.w_in; ldw = 10624; WT = (bf16_t*)(P.ws + OFF_WQKVG); ldt = 2048; drow = nb * 32; return; }
  j -= 6144;
  if (j < 2048) { k0 = (j >> 6) * 64; n0 = (j & 63) * 32; W = P.w_oa; ldw = 2048; WT = (bf16_t*)(P.ws + OFF_WOA); ldt = 2048; drow = n0; return; }
  j -= 2048;
  if (j < 1024) { k0 = (j >> 6) * 64; n0 = (j & 63) * 32; W = P.w_or; ldw = 2048; WT = (bf16_t*)(P.ws + OFF_WOR); ldt = 1024; drow = n0; return; }
  j -= 1024;
  k0 = (j >> 6) * 64; n0 = (j & 63) * 32; W = P.w_out; ldw = 2048; WT = (bf16_t*)(P.ws + OFF_WOUT); ldt = 2048; drow = n0;
}
__device__ __forceinline__ void convert_phase(const Params& P, LAS unsigned char* lds, const int tid) {
  const int wid = tid >> 6, lane = tid & 63;
  LAS float* scr = (LAS float*)(lds + wid * 8704);
  unsigned char* ws = P.ws;
  bf16_t *W1A = (bf16_t*)(ws + OFF_W1A), *W1B = (bf16_t*)(ws + OFF_W1B), *W2A = (bf16_t*)(ws + OFF_W2A), *W2B = (bf16_t*)(ws + OFF_W2B);
  bf16_t *WRW = (bf16_t*)(ws + OFF_WRW), *WQKVG = (bf16_t*)(ws + OFF_WQKVG), *WOA = (bf16_t*)(ws + OFF_WOA), *WOR = (bf16_t*)(ws + OFF_WOR), *WOUT = (bf16_t*)(ws + OFF_WOUT), *WLORA = (bf16_t*)(ws + OFF_WLORA);
  const int G = P.grd, gw = P.bid * 8 + wid, NGW = G * 8;
  constexpr int NITEMS = 22528 + 11264 + 3456 + 7168 + 2048 + 1024 + 2048 + 192;
  for (int it = gw; it < NITEMS; it += NGW) {
    int r = it;
    if (r < 22528) { const int which = r >= 11264; r -= which * 11264; const int kb = r / 352, nb = r % 352, n0 = nb * 32;
      const int drow = n0 < DFF ? (n0 >> 7) * 256 + (n0 & 127) : ((n0 - DFF) >> 7) * 256 + 128 + ((n0 - DFF) & 127);
      if (!which) tr_item(P.ffn1_w_in, 2 * DFF, kb * 64, n0, W1A, 2048, drow, 0, scr, lane);
      continue; }
    r -= 22528;
    if (r < 11264) { const int which = r >= 5632; r -= which * 5632; const int kb = r >> 6, nb = r & 63;
      if (!which) tr_item(P.ffn1_w_out, 2048, kb * 64, nb * 32, W1B, DFF, nb * 32, 0, scr, lane);
      continue; }
    r -= 11264;
    if (r < 3456) { const int kb = r / 108, nb = r % 108; tr_item(P.w_in, 10624, kb * 64, 3072 + nb * 32, WRW, 2048, nb * 32, 0, scr, lane); continue; }
    r -= 3456;
    if (r < 7168) { const int kb = r / 224, nb = r % 224; const int n0 = nb < 96 ? nb * 32 : 6528 + (nb - 96) * 32;
      if (nb >= 64 && nb < 96) tr_item(P.w_in, 10624, kb * 64, n0, WQKVG, 2048, nb * 32, 0, scr, lane);
      continue; }
    r -= 7168;
    if (r < 2048) continue;
    r -= 2048;
    if (r < 1024) continue;
    r -= 1024;
    if (r < 2048) continue;
    r -= 2048;
    if (r < 64) { const int z = r >> 5, nb = r & 31; tr_item(P.w2 + (size_t)z * 64 * 1024, 1024, 0, nb * 32, WLORA, LIN_LD, z * 1024 + nb * 32, z * 64, scr, lane); continue; }
    r -= 64;
    if (r < 64) { const int z = r >> 5, nb = r & 31; tr_item(P.a2 + (size_t)z * 64 * 1024, 1024, 0, nb * 32, WLORA, LIN_LD, 2048 + z * 1024 + nb * 32, 128 + z * 64, scr, lane); continue; }
    r -= 64;
    { const int kb = r >> 5, nb = r & 31; tr_item(P.g2, 1024, kb * 64, nb * 32, WLORA, LIN_LD, 4096 + nb * 32, 256, scr, lane); }
  }
  const int gt = P.bid * 512 + tid, NT = G * 512;
  unsigned zz = 0u; asm volatile("" : "+v"(zz));
  const u32x4 z4 = {zz, zz, zz, zz};
  for (int i = gt; i < 128 * 256; i += NT) *(u32x4*)(WRW + (size_t)3456 * 2048 + (size_t)i * 8) = z4;
  for (int i = gt; i < 5120 * 48; i += NT) { const int row = i / 48, kc = (i % 48) * 8, rb = row >> 10;
    const int lo = rb < 4 ? rb * 64 : 256, hi = rb < 4 ? rb * 64 + 64 : 384;
    if (kc < lo || kc >= hi) *(u32x4*)(WLORA + (size_t)row * LIN_LD + kc) = z4; }
}
__device__ __forceinline__ void norm_mod_phase(const Params& P, const float* __restrict__ lat, const float* __restrict__ ctxp, int nrows, const float* __restrict__ g, int midx, const float* __restrict__ parts, const int tid) {
  const int wid = tid >> 6, lane = tid & 63;
  const int gw = P.bid * 8 + wid, NGW = P.grd * 8;
  const float* __restrict__ MOD = (const float*)(P.ws + OFF_MOD); bf16_t* __restrict__ H = (bf16_t*)(P.ws + OFF_H);
  for (int r = gw; r < nrows; r += NGW) {
    const float* xr = r < MT ? lat + (size_t)r * DM : ctxp + (size_t)(r - MT) * DM;
    const int b = r < MT ? (r >> 13) : 4;
    const float* sh = MOD + b * NMODC + midx * DM; const float* scp = sh + DM;
    f32x4 v[8], g4[8], s4[8], c4[8]; float ss = 0.f;
#pragma unroll
    for (int j = 0; j < 8; ++j) v[j] = *(const f32x4*)(xr + j * 256 + lane * 4);
    if (parts && r >= MT) {
      const float* pp = parts + (size_t)(r - MT) * DM; const float* gt = MOD + 4 * NMODC + 2 * DM;
#pragma unroll
      for (int j = 0; j < 8; ++j) { const int c = j * 256 + lane * 4;
        const f32x4 s = (*(const f32x4*)(pp + c) + *(const f32x4*)(pp + (size_t)MC * DM + c)) + (*(const f32x4*)(pp + (size_t)2 * MC * DM + c) + *(const f32x4*)(pp + (size_t)3 * MC * DM + c));
        v[j] = v[j] + *(const f32x4*)(gt + c) * 0.5f * s; }
    }
#pragma unroll
    for (int j = 0; j < 8; ++j) { const int c = j * 256 + lane * 4; g4[j] = *(const f32x4*)(g + c); s4[j] = *(const f32x4*)(sh + c); c4[j] = *(const f32x4*)(scp + c); }
#pragma unroll
    for (int j = 0; j < 8; ++j) ss += v[j].x * v[j].x + v[j].y * v[j].y + v[j].z * v[j].z + v[j].w * v[j].w;
    ss = wave_sum(ss);
    const float rs = rsqrtf(ss * (1.f / DM) + 1e-6f);
#pragma unroll
    for (int j = 0; j < 8; ++j) { const int c = j * 256 + lane * 4;
      const f32x4 y = v[j] * rs * g4[j]; const f32x4 h = y * (c4[j] + 1.f) + s4[j];
      u32x2 w; w.x = cvt_pk_bf16(h.x, h.y); w.y = cvt_pk_bf16(h.z, h.w);
      *(u32x2*)(H + (size_t)r * DM + c) = w; }
  }
}
__device__ __forceinline__ void shift_phase(const Params& P, const int tid) {
  const bf16_t* __restrict__ PRW = (const bf16_t*)(P.ws + OFF_PRW); bf16_t* __restrict__ SH = (bf16_t*)(P.ws + OFF_SH); bf16_t* __restrict__ LIN = (bf16_t*)(P.ws + OFF_LIN);
  const int gt = P.bid * 512 + tid, NT = P.grd * 512;
#pragma unroll 2
  for (int idx = gt; idx < MA * 432; idx += NT) {
    const int r = idx / 432, c = (idx % 432) * 8;
    bool first, last;
    if (r < MT) { const int t = r & (SEQ - 1); first = t == 0; last = t == SEQ - 1; } else { const int t = (r - MT) & (CTXL - 1); first = t == 0; last = t == CTXL - 1; }
    const u32x4 z4 = {0u, 0u, 0u, 0u};
    const u32x4 p = *(const u32x4*)(PRW + (size_t)r * PRW_LD + c);
    const u32x4 pv = first ? z4 : *(const u32x4*)(PRW + (size_t)(r - 1) * PRW_LD + c);
    const u32x4 nx = last ? z4 : *(const u32x4*)(PRW + (size_t)(r + 1) * PRW_LD + c);
    const f32x4 m0 = *(const f32x4*)(P.rwkv_mu + c), m1 = *(const f32x4*)(P.rwkv_mu + c + 4);
    float o[8];
#define SHF(e, W, MU, HI) { const float pp = HI ? bfhi(p.W) : bflo(p.W), a = HI ? bfhi(pv.W) : bflo(pv.W), b = HI ? bfhi(nx.W) : bflo(nx.W); o[e] = pp + MU * (0.5f * (a + b) - pp); }
    SHF(0, x, m0.x, 0) SHF(1, x, m0.y, 1) SHF(2, y, m0.z, 0) SHF(3, y, m0.w, 1) SHF(4, z, m1.x, 0) SHF(5, z, m1.y, 1) SHF(6, w, m1.z, 0) SHF(7, w, m1.w, 1)
#undef SHF
    bf16_t* dst;
    if (c < 3072) dst = SH + (size_t)r * SH_LD + c;
    else { const int cl = c - 3072; dst = LIN + (size_t)r * LIN_LD + cl;
      if (cl < 128) {
#pragma unroll
        for (int e = 0; e < 8; ++e) { const float ex = __builtin_amdgcn_exp2f(2.8853900817779268f * o[e]); o[e] = 1.f - 2.f * __builtin_amdgcn_rcpf(ex + 1.f); }
      } else if (cl >= 256) {
#pragma unroll
        for (int e = 0; e < 8; ++e) o[e] = sigmoidf_(o[e]);
      } }
    u32x4 w; w.x = cvt_pk_bf16(o[0], o[1]); w.y = cvt_pk_bf16(o[2], o[3]); w.z = cvt_pk_bf16(o[4], o[5]); w.w = cvt_pk_bf16(o[6], o[7]);
    *(u32x4*)dst = w;
  }
}
__device__ __forceinline__ float SFMA(float a, float b, float c) { float d; asm("v_fma_f32 %0, %1, %2, %3" : "=v"(d) : "v"(a), "v"(b), "v"(c)); return d; }
__device__ __forceinline__ float SMUL(float a, float b) { float d; asm("v_mul_f32 %0, %1, %2" : "=v"(d) : "v"(a), "v"(b)); return d; }
__device__ __forceinline__ float allred8(float x) { x += dpp_mov<0xB1>(x); x += dpp_mov<0x4E>(x); x += dpp_mov<0x141>(x); return x; }
__device__ __forceinline__ void scan_phase(const Params& P, LAS unsigned char* lds, const int tid) {
  constexpr int FSTEP = 320, FBUF = 32 * FSTEP + 4 * 64;
  LAS float* F = (LAS float*)lds;
  LAS unsigned short* YB = (LAS unsigned short*)(lds + 2 * FBUF * 4);
  constexpr int TR_OFF = 2 * FBUF * 4 + 4096;
  const bf16_t* SH = (const bf16_t*)(P.ws + OFF_SH); const bf16_t* LO = (const bf16_t*)(P.ws + OFF_LO); bf16_t* Y = (bf16_t*)(P.ws + OFF_Y);
  const int wid = __builtin_amdgcn_readfirstlane(tid >> 6), lane = tid & 63;
  constexpr int NCH = SKV / 32;
#define SCAN_BAR() do { asm volatile("s_waitcnt lgkmcnt(0)" ::: "memory"); __builtin_amdgcn_s_barrier(); asm volatile("" ::: "memory"); } while (0)
  for (int task = P.bid; task < 256; task += P.grd) {
    const int half = (task >> 3) & 1, chain = (task & 7) | ((task >> 4) << 3);
    const int dir = chain & 1, h = (chain >> 1) & 15, b = chain >> 5, hc = h * 64;
#define ROWOF(g) ((g) < CTXL ? (MT + b * CTXL + (dir ? CTXL - 1 - (g) : (g))) : (b * SEQ + (dir ? SEQ - 1 - ((g) - CTXL) : ((g) - CTXL))))
    if (wid < 4) {
      const int rloc = wid * 8 + (lane >> 3), irow = half * 32 + rloc, cA = (lane & 7) * 4, cB = 32 + cA;
      f32x4 S0 = {0.f, 0.f, 0.f, 0.f}, S1 = {0.f, 0.f, 0.f, 0.f};
      SCAN_BAR();
      for (int q = 0; q < NCH; ++q) {
        const LAS float* f = F + (q & 1) * FBUF;
        LAS unsigned short* yb = YB + (q & 1) * 1024;
        f32x4 a0 = *(const LAS f32x4*)(f + cA), a1 = *(const LAS f32x4*)(f + cB);
        f32x4 b0 = *(const LAS f32x4*)(f + 64 + cA), b1 = *(const LAS f32x4*)(f + 64 + cB);
        f32x4 k0 = *(const LAS f32x4*)(f + 128 + cA), k1 = *(const LAS f32x4*)(f + 128 + cB);
        f32x4 r0 = *(const LAS f32x4*)(f + 192 + cA), r1 = *(const LAS f32x4*)(f + 192 + cB);
        float vv = f[256 + irow];
        float ykeep = 0.f; f32x4 gA = {1.f, 1.f, 1.f, 1.f}, gB = gA;
#pragma unroll 2
        for (int s = 0; s < 32; ++s) {
          const LAS float* fn = f + (s < 31 ? s + 1 : 31) * FSTEP;
          const f32x4 na0 = *(const LAS f32x4*)(fn + cA), na1 = *(const LAS f32x4*)(fn + cB);
          const f32x4 nb0 = *(const LAS f32x4*)(fn + 64 + cA), nb1 = *(const LAS f32x4*)(fn + 64 + cB);
          const f32x4 nk0 = *(const LAS f32x4*)(fn + 128 + cA), nk1 = *(const LAS f32x4*)(fn + 128 + cB);
          const f32x4 nr0 = *(const LAS f32x4*)(fn + 192 + cA), nr1 = *(const LAS f32x4*)(fn + 192 + cB);
          const float nvv = fn[256 + irow];
          if ((s & 7) == 5) { const LAS float* gp = f + 32 * FSTEP + (s >> 3) * 64; gA = *(const LAS f32x4*)(gp + cA); gB = *(const LAS f32x4*)(gp + cB); }
          __builtin_amdgcn_sched_barrier(0);
          f32x4 p = S0 * a0 + S1 * a1;
          const float sa_ = allred8((p.x + p.y) + (p.z + p.w));
          S0 = __builtin_elementwise_fma(k0, (f32x4){vv, vv, vv, vv}, __builtin_elementwise_fma(b0, (f32x4){sa_, sa_, sa_, sa_}, S0));
          S1 = __builtin_elementwise_fma(k1, (f32x4){vv, vv, vv, vv}, __builtin_elementwise_fma(b1, (f32x4){sa_, sa_, sa_, sa_}, S1));
          p = S0 * r0 + S1 * r1;
          const float y = allred8((p.x + p.y) + (p.z + p.w));
          ykeep = ((s & 7) == (lane & 7)) ? y : ykeep;
          if ((s & 7) == 7) {
            yb[((s & ~7) + (lane & 7)) * 32 + rloc] = f2bf(ykeep);
            S0 = S0 * gA; S1 = S1 * gB;
          }
          __builtin_amdgcn_sched_barrier(0);
          a0 = na0; a1 = na1; b0 = nb0; b1 = nb1; k0 = nk0; k1 = nk1; r0 = nr0; r1 = nr1; vv = nvv;
        }
        SCAN_BAR();
      }
    } else {
      const int sw = wid - 4, hw = lane >> 5, cp = (lane & 31) * 2;
      const f32x2 kk_c = *(const f32x2*)(P.k_k + hc + cp), ka_c = *(const f32x2*)(P.k_a + hc + cp);
      unsigned voS[4], voL[4];
#pragma unroll
      for (int e = 0; e < 4; ++e) { const int tk = hw * 4 + e, ro = dir ? 7 - tk : tk; voS[e] = (unsigned)(ro * SH_LD + cp) * 2u; voL[e] = (unsigned)(ro * LO_LD + cp) * 2u; }
      unsigned sr[4], sk[4], sv[4], sl[4], sa[4];
#define RMIN(q) ({ const int g0_ = (q) * 32 + sw * 8; const int ra_ = ROWOF(g0_), rb_ = ROWOF(g0_ + 7); ra_ < rb_ ? ra_ : rb_; })
#define SLOADQ(q) do { const size_t rmin_ = (size_t)RMIN(q); const char* bs_ = (const char*)(SH + rmin_ * SH_LD + hc); const char* bl_ = (const char*)(LO + rmin_ * LO_LD + dir * 1024 + hc); \
      _Pragma("unroll") for (int e = 0; e < 4; ++e) { sr[e] = *(const unsigned*)(bs_ + voS[e]); sk[e] = *(const unsigned*)(bs_ + 2048 + voS[e]); sv[e] = *(const unsigned*)(bs_ + 4096 + voS[e]); \
        sl[e] = *(const unsigned*)(bl_ + voL[e]); sa[e] = *(const unsigned*)(bl_ + 4096 + voL[e]); } } while (0)
#define EX2V(V) (f32x2){__builtin_amdgcn_exp2f((V).x), __builtin_amdgcn_exp2f((V).y)}
#define SWRITEQ(buf) do { \
      f32x2 Lc[4]; { f32x2 run = {0.f, 0.f}; _Pragma("unroll") for (int e = 0; e < 4; ++e) { run = run + (f32x2){bflo(sl[e]), bfhi(sl[e])}; Lc[e] = run; } } \
      f32x2 qlo, qhi; { auto r0_ = __builtin_amdgcn_permlane32_swap(__float_as_uint(Lc[3].x), __float_as_uint(Lc[3].x), false, false); \
                        auto r1_ = __builtin_amdgcn_permlane32_swap(__float_as_uint(Lc[3].y), __float_as_uint(Lc[3].y), false, false); \
                        qlo = (f32x2){__uint_as_float(r0_[0]), __uint_as_float(r1_[0])}; qhi = (f32x2){__uint_as_float(r0_[1]), __uint_as_float(r1_[1])}; } \
      const f32x2 base_ = hw ? qlo : (f32x2){0.f, 0.f}; \
      if (hw == 0) *(LAS f32x2*)(F + (buf) * FBUF + 32 * FSTEP + sw * 64 + cp) = EX2V(-(qlo + qhi)); \
      f32x2 Pm = EX2V(-base_); \
      _Pragma("unroll") for (int e = 0; e < 4; ++e) { LAS float* f_ = F + (buf) * FBUF + (sw * 8 + hw * 4 + e) * FSTEP + cp; \
        const f32x2 r_ = {bflo(sr[e]), bfhi(sr[e])}, k_ = {bflo(sk[e]), bfhi(sk[e])}, v_ = {bflo(sv[e]), bfhi(sv[e])}, aa = {bflo(sa[e]), bfhi(sa[e])}; \
        const f32x2 lj = base_ + Lc[e]; \
        const f32x2 Pj = EX2V(-lj), Pi = EX2V(lj); \
        const f32x2 kkr = k_ * kk_c; float ssq = allred16(kkr.x * kkr.x + kkr.y * kkr.y); \
        { auto rr_ = __builtin_amdgcn_permlane16_swap(__float_as_uint(ssq), __float_as_uint(ssq), false, false); ssq = __uint_as_float(rr_[0]) + __uint_as_float(rr_[1]); } \
        const f32x2 kk = kkr * rsqrtf(fmaxf(ssq, 1e-24f)); const f32x2 kki = kk * Pi; \
        *(LAS f32x2*)(f_) = -kk * Pm; *(LAS f32x2*)(f_ + 64) = kki * aa; *(LAS f32x2*)(f_ + 128) = k_ * ((aa - 1.f) * ka_c + 1.f) * Pi; \
        *(LAS f32x2*)(f_ + 192) = r_ * Pj; *(LAS f32x2*)(f_ + 256) = v_; Pm = Pj; } } while (0)
      LAS float* trscr = (LAS float*)(lds + TR_OFF + sw * 8704);
      float tv[32]; int w2j = task * 4 + sw;
      SLOADQ(0); SWRITEQ(0); SLOADQ(1);
      SCAN_BAR();
      for (int q = 0; q < NCH; ++q) {
        if (q >= 9) {
          const int qq = q - 1; const LAS unsigned short* yb = YB + (qq & 1) * 1024;
          const int t256 = sw * 64 + lane, s = t256 >> 3, rp = (t256 & 7) * 4; const int u = qq * 32 + s - CTXL; const int t = dir ? SEQ - 1 - u : u;
          const u32x2 val = *(const LAS u32x2*)(yb + s * 32 + rp);
          *(u32x2*)(Y + (size_t)dir * MT * 1024 + (size_t)(b * SEQ + t) * 1024 + hc + half * 32 + rp) = val;
        }
        if (q + 1 < NCH) SWRITEQ((q + 1) & 1);
        if ((q & 7) == 3 && w2j < N_LATE) {
          const float* W_; int ldw_, k0_, n0_, ldt_, drow_; bf16_t* WT_; late_item_addr(P, w2j, W_, ldw_, k0_, n0_, WT_, ldt_, drow_);
          tr_store(tv, k0_, WT_, ldt_, drow_, 0, trscr, lane); w2j += 1024;
        }
        if (q + 2 < NCH) SLOADQ(q + 2);
        if ((q & 7) == 2 && w2j < N_LATE) {
          const float* W_; int ldw_, k0_, n0_, ldt_, drow_; bf16_t* WT_; late_item_addr(P, w2j, W_, ldw_, k0_, n0_, WT_, ldt_, drow_);
          tr_load(tv, W_, ldw_, k0_, n0_, lane);
        }
        SCAN_BAR();
      }
      {
        const int qq = NCH - 1; const LAS unsigned short* yb = YB + (qq & 1) * 1024;
        const int t256 = sw * 64 + lane, s = t256 >> 3, rp = (t256 & 7) * 4; const int u = qq * 32 + s - CTXL; const int t = dir ? SEQ - 1 - u : u;
        const u32x2 val = *(const LAS u32x2*)(yb + s * 32 + rp);
        *(u32x2*)(Y + (size_t)dir * MT * 1024 + (size_t)(b * SEQ + t) * 1024 + hc + half * 32 + rp) = val;
      }
#undef SLOADQ
#undef SWRITEQ
#undef RMIN
#undef EX2V
    }
#undef ROWOF
    __syncthreads();
  }
#undef SCAN_BAR
}
__device__ __forceinline__ float half_sum(float v) {
  v = allred16(v);
  auto rr = __builtin_amdgcn_permlane16_swap(__float_as_uint(v), __float_as_uint(v), false, false); return __uint_as_float(rr[0]) + __uint_as_float(rr[1]);
}
__device__ __forceinline__ void rwkv_out_phase(const Params& P, const int tid) {
  const bf16_t* SH = (const bf16_t*)(P.ws + OFF_SH); const bf16_t* LO = (const bf16_t*)(P.ws + OFF_LO); bf16_t* Y = (bf16_t*)(P.ws + OFF_Y);
  const int wid = tid >> 6, lane = tid & 63, hw = lane >> 5, cp = (lane & 31) * 2;
  const int gw = P.bid * 8 + wid, NGW = P.grd * 8;
  for (int task = gw * 2; task < MT * 8; task += NGW * 2) {
    unsigned yf[2], ybk[2], rr[2], kk[2], vv[2], af[2], ab[2], gg[2]; int cc[2]; size_t tk[2];
#pragma unroll
    for (int u = 0; u < 2; ++u) { const int t_ = task + u; tk[u] = (size_t)(t_ >> 3); cc[u] = ((t_ & 7) * 2 + hw) * 64 + cp;
      const bf16_t* py = Y + tk[u] * 1024 + cc[u]; const bf16_t* ps = SH + tk[u] * SH_LD + cc[u]; const bf16_t* pl = LO + tk[u] * LO_LD + cc[u];
      yf[u] = *(const unsigned*)py; ybk[u] = *(const unsigned*)(py + (size_t)MT * 1024);
      rr[u] = *(const unsigned*)ps; kk[u] = *(const unsigned*)(ps + 1024); vv[u] = *(const unsigned*)(ps + 2048);
      af[u] = *(const unsigned*)(pl + 2048); ab[u] = *(const unsigned*)(pl + 3072); gg[u] = *(const unsigned*)(pl + 4096); }
    unsigned res[2];
#pragma unroll
    for (int u = 0; u < 2; ++u) {
      const f32x2 lw = *(const f32x2*)(P.ln_x_w + cc[u]), lb = *(const f32x2*)(P.ln_x_b + cc[u]), ka = *(const f32x2*)(P.k_a + cc[u]), rk = *(const f32x2*)(P.r_k + cc[u]);
      const f32x2 y = {bflo(yf[u]) + bflo(ybk[u]), bfhi(yf[u]) + bfhi(ybk[u])};
      const float mu = half_sum(y.x + y.y) * (1.f / 64.f); const f32x2 dv = y - mu; const float var = half_sum(dv.x * dv.x + dv.y * dv.y) * (1.f / 64.f);
      const f32x2 yn = dv * rsqrtf(var + 64e-5f) * lw + lb;
      const f32x2 r = {bflo(rr[u]), bfhi(rr[u])}, k = {bflo(kk[u]), bfhi(kk[u])}, v = {bflo(vv[u]), bfhi(vv[u])};
      const f32x2 a1 = {bflo(af[u]), bfhi(af[u])}, a2 = {bflo(ab[u]), bfhi(ab[u])}, g = {bflo(gg[u]), bfhi(gg[u])};
      const f32x2 kms = k * ((a1 - 1.f) * ka + 1.f) + k * ((a2 - 1.f) * ka + 1.f);
      const f32x2 bt = r * kms * rk;
      const float bonus = half_sum(bt.x + bt.y);
      const f32x2 o = (yn + v * bonus) * g;
      res[u] = cvt_pk_bf16(o.x, o.y);
    }
#pragma unroll
    for (int u = 0; u < 2; ++u) *(unsigned*)(Y + tk[u] * 1024 + cc[u]) = res[u];
  }
}
__device__ __forceinline__ void rope_phase(const Params& P, const int tid) {
  bf16_t* Q = (bf16_t*)(P.ws + OFF_Q); bf16_t* KB = (bf16_t*)(P.ws + OFF_KB);
  const int wid = tid >> 6, lane = tid & 63, hw = lane >> 5, li = lane & 31;
  const int gw = P.bid * 8 + wid, NGW = P.grd * 8;
  const int d1 = li < 16 ? 2 * li : 64 + 2 * (li - 16);
  const f32x2 qgA = *(const f32x2*)(P.q_norm + d1), qgB = *(const f32x2*)(P.q_norm + d1 + 32), kgA = *(const f32x2*)(P.k_norm + d1), kgB = *(const f32x2*)(P.k_norm + d1 + 32);
  const int j0 = 2 * (li & 15);
  const float inv0 = __builtin_amdgcn_exp2f(-(float)(2 * j0) * (13.287712379549449f / 64.f)), inv1 = __builtin_amdgcn_exp2f(-(float)(2 * j0 + 2) * (13.287712379549449f / 64.f));
  for (int task = gw; task < MA; task += NGW) {
    if (task < MT) {
      const int tok = task, b = tok >> 13, t = tok & (SEQ - 1);
      const float pos = (float)(li < 16 ? (t >> 6) : (t & 63));
      const float an0 = pos * inv0, an1 = pos * inv1;
      const f32x2 sn = {__sinf(an0), __sinf(an1)}, cs = {__cosf(an0), __cosf(an1)};
      unsigned lo[10], hi[10]; bf16_t* ptr[10];
#pragma unroll
      for (int i = 0; i < 10; ++i) { const int hd = 2 * i + hw;
        ptr[i] = (hd < 16 ? Q + (size_t)tok * DM + hd * 128 : KB + (size_t)(tok + b * CTXL) * 512 + (hd - 16) * 128) + d1;
        lo[i] = *(const unsigned*)ptr[i]; hi[i] = *(const unsigned*)(ptr[i] + 32); }
#pragma unroll
      for (int i = 0; i < 10; ++i) { const bool isq = i < 8;
        const f32x2 t1 = {bflo(lo[i]), bfhi(lo[i])}, t2 = {bflo(hi[i]), bfhi(hi[i])};
        const float ss = half_sum((t1.x * t1.x + t1.y * t1.y) + (t2.x * t2.x + t2.y * t2.y)); const float rs = rsqrtf(ss * (1.f / 128.f) + 1e-6f);
        const f32x2 n1 = t1 * rs * (isq ? qgA : kgA), n2 = t2 * rs * (isq ? qgB : kgB);
        const f32x2 o1 = n1 * cs - n2 * sn, o2 = n2 * cs + n1 * sn;
        lo[i] = cvt_pk_bf16(o1.x, o1.y); hi[i] = cvt_pk_bf16(o2.x, o2.y); }
#pragma unroll
      for (int i = 0; i < 10; ++i) { *(unsigned*)ptr[i] = lo[i]; *(unsigned*)(ptr[i] + 32) = hi[i]; }
    } else {
      const int ct = task - MT, b = ct >> 8, t = ct & (CTXL - 1);
      unsigned lo[2], hi[2]; bf16_t* ptr[2];
#pragma unroll
      for (int i = 0; i < 2; ++i) { ptr[i] = KB + (size_t)(b * SKV + SEQ + t) * 512 + (2 * i + hw) * 128 + d1; lo[i] = *(const unsigned*)ptr[i]; hi[i] = *(const unsigned*)(ptr[i] + 32); }
#pragma unroll
      for (int i = 0; i < 2; ++i) {
        const f32x2 t1 = {bflo(lo[i]), bfhi(lo[i])}, t2 = {bflo(hi[i]), bfhi(hi[i])};
        const float ss = half_sum((t1.x * t1.x + t1.y * t1.y) + (t2.x * t2.x + t2.y * t2.y)); const float rs = rsqrtf(ss * (1.f / 128.f) + 1e-6f);
        const f32x2 n1 = t1 * rs * kgA, n2 = t2 * rs * kgB;
        *(unsigned*)ptr[i] = cvt_pk_bf16(n1.x, n1.y); *(unsigned*)(ptr[i] + 32) = cvt_pk_bf16(n2.x, n2.y); }
    }
  }
}
__device__ __forceinline__ void attn_phase(const Params& P, unsigned char* smem, const int tid) {
  bf16_t* Q = (bf16_t*)(P.ws + OFF_Q); const bf16_t* KB = (const bf16_t*)(P.ws + OFF_KB); const bf16_t* VB = (const bf16_t*)(P.ws + OFF_VB);
  for (int u = P.bid; u < 2048; u += P.grd) {
    const int xcd = u & 7, slot = (u >> 3) & 31, rnd = u >> 8, pair = xcd + 8 * (rnd >> 2), w = (rnd & 3) * 32 + slot;
    const int b = pair >> 2, kvh = pair & 3, g = w & 3, qb = w >> 2, head = kvh * 4 + g;
    bf16_t* Qb = Q + (size_t)(b * SEQ + qb * 256) * DM + head * 128;
    const bf16_t* Kh = KB + (size_t)b * SKV * 512 + kvh * 128; const bf16_t* Vh = VB + (size_t)b * SKV * 512 + kvh * 128;
    att::attn_dense_body(Qb, Kh, Vh, Qb, SKV, (char*)smem, tid);
    __syncthreads();
  }
}
__device__ __forceinline__ void final_norm_phase(const Params& P, const int tid) {
  const int wid = tid >> 6, lane = tid & 63;
  const int gw = P.bid * 8 + wid, NGW = P.grd * 8;
  f32x4 g4[8];
#pragma unroll
  for (int j = 0; j < 8; ++j) g4[j] = *(const f32x4*)(P.norm_final + j * 256 + lane * 4);
  for (int r = gw; r < MT; r += NGW) {
    float* xr = P.out + (size_t)r * DM;
    f32x4 v[8]; float ss = 0.f;
#pragma unroll
    for (int j = 0; j < 8; ++j) v[j] = *(const f32x4*)(xr + j * 256 + lane * 4);
#pragma unroll
    for (int j = 0; j < 8; ++j) ss += v[j].x * v[j].x + v[j].y * v[j].y + v[j].z * v[j].z + v[j].w * v[j].w;
    ss = wave_sum(ss);
    const float rs = rsqrtf(ss * (1.f / DM) + 1e-6f);
#pragma unroll
    for (int j = 0; j < 8; ++j) *(f32x4*)(xr + j * 256 + lane * 4) = v[j] * rs * g4[j];
  }
}


#define XB_TMO      128
#define XB_XCNT(j)  (256  + 64 * (j))
#define XB_XSUB(j)  (1280 + 64 * (j))
#define XB_XGEN(j)  (2304 + 64 * (j))
#define XB_TOP      3328
#define XB_TOPGEN   3392
#define XCD_BAR_WORDS 3456
#define XB_SPIN_CAP (1u << 18)
__device__ __forceinline__ unsigned xb_ld(unsigned* p)              { return __hip_atomic_load(p, __ATOMIC_RELAXED, __HIP_MEMORY_SCOPE_AGENT); }
__device__ __forceinline__ unsigned xb_add(unsigned* p, unsigned v) { return __hip_atomic_fetch_add(p, v, __ATOMIC_RELAXED, __HIP_MEMORY_SCOPE_AGENT); }
__device__ __forceinline__ unsigned xb_xcc_id() { return (unsigned)__builtin_amdgcn_s_getreg((3 << 11) | 20) & 0xFu; }
#define XB_SPIN(cond, bar) do { unsigned _sp = 0; while (cond) { __builtin_amdgcn_s_sleep(1); \
    if ((++_sp & 255u) == 0u) { if (xb_ld(&(bar)[XB_TMO])) break; if (_sp > XB_SPIN_CAP) { atomicAdd(&(bar)[XB_TMO], 1u); break; } } } } while (0)
__device__ __forceinline__ void xcd_barrier_complete(unsigned* bar, unsigned x, unsigned& nloc, unsigned& nx) {
    const unsigned G = gridDim.x * gridDim.y * gridDim.z;
    unsigned sum, cnt, mine, sp = 0u;
    for (;;) {
        sum = 0u; cnt = 0u; mine = 0u;
#pragma unroll
        for (unsigned j = 0; j < 16; ++j) { const unsigned c = xb_ld(&bar[XB_XCNT(j)]); sum += c; cnt += (c > 0u) ? 1u : 0u; mine = (j == x) ? c : mine; }
        if (sum == G) break;
        __builtin_amdgcn_s_sleep(1);
        if ((++sp & 255u) == 0u) { if (xb_ld(&bar[XB_TMO])) break; if (sp > XB_SPIN_CAP) { atomicAdd(&bar[XB_TMO], 1u); break; } }
    }
    nloc = mine > 0u ? mine : 1u; nx = cnt > 0u ? cnt : 1u;
}
__device__ __forceinline__ void xcd_barrier(unsigned* bar, volatile LAS unsigned* st) {
    asm volatile("s_waitcnt vmcnt(0)" ::: "memory");
    __syncthreads();
    if (threadIdx.x == 0) {
        __builtin_amdgcn_s_waitcnt(0);
        const unsigned x = xb_xcc_id();
        unsigned nloc = st[0], nx = st[1];
        if (nloc == 0u) { xcd_barrier_complete(bar, x, nloc, nx); st[0] = nloc; st[1] = nx; }
        const unsigned old = xb_add(&bar[XB_XSUB(x)], 1u);
        const unsigned gen = old / nloc;
        if (old + 1u == (gen + 1u) * nloc) {
            __builtin_amdgcn_fence(__ATOMIC_RELEASE, "agent");
            asm volatile("s_waitcnt vmcnt(0)" ::: "memory");
            const unsigned og = xb_add(&bar[XB_TOP], 1u);
            const unsigned tg = og / nx;
            if (og + 1u == (tg + 1u) * nx) xb_add(&bar[XB_TOPGEN], 1u);
            else XB_SPIN(xb_ld(&bar[XB_TOPGEN]) == tg, bar);
            __builtin_amdgcn_fence(__ATOMIC_ACQUIRE, "agent");
            xb_add(&bar[XB_XGEN(x)], 1u);
            asm volatile("s_waitcnt vmcnt(0)" ::: "memory");
        } else {
            XB_SPIN(xb_ld(&bar[XB_XGEN(x)]) == gen, bar);
            __builtin_amdgcn_fence(__ATOMIC_ACQUIRE, "agent");
            asm volatile("s_waitcnt vmcnt(0)" ::: "memory");
        }
    }
    __syncthreads();
}

constexpr int NPH = 20;
__device__ __forceinline__ bool gemm_desc(int ph, const Params& P, GemmDesc& d) {
  unsigned char* ws = P.ws;
  const bf16_t* H = (const bf16_t*)(ws + OFF_H);
  d.a_tiled = 0; d.nt0 = 0; d.nt1 = 0; d.ksplit1 = 1; d.G = P.grd; d.c = P.bid; d.A1 = nullptr; d.B1 = nullptr; d.pm01 = 0; d.nN1 = 1; d.n1 = 0; d.pm00 = 0; d.xin = nullptr; d.gidx = 0; d.gscale = 0.f; d.act = nullptr;
  switch (ph) {
  case 2: d.K = 2048; d.mode = M_SWIGLU; d.A0 = H; d.B0 = (const bf16_t*)(ws + OFF_W1A); d.nM0 = 132; d.nN0 = 44; d.act = (bf16_t*)(ws + OFF_ACT); break;
  case 3: d.a_tiled = 1; d.K = DFF; d.mode = M_RESID; d.A0 = (const bf16_t*)(ws + OFF_ACT); d.B0 = (const bf16_t*)(ws + OFF_W1B); d.nM0 = 128; d.nN0 = 8; d.xin = P.x; d.gidx = 2; d.gscale = 0.5f;
          d.A1 = d.A0; d.B1 = d.B0; d.pm01 = 128; d.nN1 = 8; d.ksplit1 = 4; d.nt1 = 22; d.n1 = 4 * 8 * 4; break;
  case 5: d.K = 2048; d.mode = M_RW; d.A0 = H; d.B0 = (const bf16_t*)(ws + OFF_WRW); d.nM0 = 132; d.nN0 = 14;
          d.A1 = H; d.B1 = (const bf16_t*)(ws + OFF_WQKVG) + (size_t)2048 * 2048; d.pm01 = 128; d.nN1 = 4; d.n1 = 16; break;
  case 7: d.K = 384; d.mode = M_LORA; d.A0 = (const bf16_t*)(ws + OFF_LIN); d.B0 = (const bf16_t*)(ws + OFF_WLORA); d.nM0 = 132; d.nN0 = 20; break;
  case 10: d.K = 2048; d.mode = M_QKVG; d.A0 = H; d.B0 = (const bf16_t*)(ws + OFF_WQKVG); d.nM0 = 128; d.nN0 = 28; break;
  case 13: d.K = 2048; d.mode = M_T1; d.A0 = (const bf16_t*)(ws + OFF_Q); d.B0 = (const bf16_t*)(ws + OFF_WOA); d.nM0 = 128; d.nN0 = 8; break;
  case 14: d.K = 1024; d.mode = M_M; d.A0 = (const bf16_t*)(ws + OFF_Y); d.B0 = (const bf16_t*)(ws + OFF_WOR); d.nM0 = 128; d.nN0 = 8; break;
  case 15: d.K = 2048; d.mode = M_RESID; d.A0 = (const bf16_t*)(ws + OFF_GR); d.B0 = (const bf16_t*)(ws + OFF_WOUT); d.nM0 = 128; d.nN0 = 8; d.xin = P.out; d.gidx = 5; d.gscale = 1.f; break;
  case 17: d.K = 2048; d.mode = M_SWIGLU; d.A0 = H; d.B0 = (const bf16_t*)(ws + OFF_W2A); d.nM0 = 128; d.nN0 = 44; d.act = (bf16_t*)(ws + OFF_ACT); break;
  case 18: d.a_tiled = 1; d.K = DFF; d.mode = M_RESID; d.A0 = (const bf16_t*)(ws + OFF_ACT); d.B0 = (const bf16_t*)(ws + OFF_W2B); d.nM0 = 128; d.nN0 = 8; d.xin = P.out; d.gidx = 8; d.gscale = 0.5f; break;
  default: return false;
  }
  d.n0 = d.nM0 * d.nN0;
  if (!d.nt0) d.nt0 = d.K / BK;
  if (!d.nt1) d.nt1 = d.K / BK;
  if (d.mode == M_LORA) d.nt0 = 2;
  return true;
}

__global__ void __launch_bounds__(512) mega_fwd(Params P) {
  extern __shared__ __attribute__((aligned(16))) unsigned char smem[];
  LAS unsigned char* lds = (LAS unsigned char*)smem;
  cg::grid_group grid = cg::this_grid();
  volatile LAS unsigned* bst = (volatile LAS unsigned*)(lds + LDS_BYTES + 192);
  unsigned* gbar = (unsigned*)(P.ws + OFF_BAR);
#if ONE_LAUNCH
  if (threadIdx.x == 0) { bst[0] = 0u; bst[1] = 0u; (void)xb_add(&gbar[XB_XCNT(xb_xcc_id())], 1u); }
  __syncthreads();
#endif
#pragma nounroll
  for (int ph = P.ph_lo; ph < P.ph_hi; ++ph) {
    GemmDesc d;
    int tid = threadIdx.x; asm volatile("" : "+v"(tid));
#if PROBE
    if (blockIdx.x == 0 && tid == 0) ((LAS unsigned long long*)(lds + LDS_BYTES))[ph] = __builtin_amdgcn_s_memrealtime();
#endif
    const __attribute__((address_space(4))) Params* kp = (const __attribute__((address_space(4))) Params*)__builtin_amdgcn_kernarg_segment_ptr();
    asm volatile("" : "+s"(kp));
#if defined(__HIP_DEVICE_COMPILE__)
    Params L = *kp;
#else
    Params L = P;
#endif
    { int b_ = blockIdx.x, g_ = gridDim.x; asm volatile("" : "+s"(b_), "+s"(g_)); L.bid = b_; L.grd = g_; }
    if (gemm_desc(ph, L, d)) gemm_phase(lds, d, L, tid);
    else switch (ph) {
      case 0: mod_phase(L, lds, tid); __syncthreads(); convert_phase(L, lds, tid); break;
      case 1: norm_mod_phase(L, L.x, L.ctx, MA, L.norm_ffn1, 0, nullptr, tid); break;
      case 4: norm_mod_phase(L, L.out, L.ctx, MA, L.norm_mix, 3, (const float*)(L.ws + OFF_PART), tid); break;
      case 6: shift_phase(L, tid); break;
      case 8: scan_phase(L, lds, tid); break;
      case 9: rwkv_out_phase(L, tid); break;
      case 11: rope_phase(L, tid); break;
      case 12: attn_phase(L, smem, tid); break;
      case 16: norm_mod_phase(L, L.out, nullptr, MT, L.norm_ffn2, 6, nullptr, tid); break;
      case 19: final_norm_phase(L, tid); break;
      default: break;
    }
    if (ph + 1 < P.ph_hi) { if (ph == 0) grid.sync(); else if (ph != 13 || !ONE_LAUNCH) xcd_barrier(gbar, bst); }
  }
#if PROBE
  grid.sync();
  if (blockIdx.x == 0) {
    LAS unsigned long long* TS = (LAS unsigned long long*)(lds + LDS_BYTES);
    if (threadIdx.x == 0) TS[NPH] = __builtin_amdgcn_s_memrealtime();
    __syncthreads();
    const int K = (int)((TS[PROBE_HI] - TS[PROBE_LO]) / 100ull);
    int t2 = threadIdx.x; asm volatile("" : "+v"(t2));
    for (int i = t2; i < K && i < 16000; i += 512) P.out[(size_t)i * 4099] += 0.1f;
  }
#endif
}

extern "C" void kernel_launch(void* const* d_in, const int* in_sizes, int n_in, void* d_out, int out_size, void* d_ws, size_t ws_size, hipStream_t stream) {
  static int grid_blocks = 0;
  if (!grid_blocks) {
    if (n_in != 31 || out_size != MT * DM || ws_size < WS_TOTAL) { fprintf(stderr, "kernel_launch: unexpected shapes n_in %d out %d ws %zu (need %zu)\n", n_in, out_size, ws_size, WS_TOTAL); return; }
    if (hipFuncSetAttribute((const void*)mega_fwd, hipFuncAttributeMaxDynamicSharedMemorySize, LDS_BYTES + 256) != hipSuccess) { fprintf(stderr, "kernel_launch: hipFuncSetAttribute failed\n"); return; }
    int dev = 0, cus = 0, per_cu = 0;
    hipGetDevice(&dev);
    hipDeviceGetAttribute(&cus, hipDeviceAttributeMultiprocessorCount, dev);
    hipOccupancyMaxActiveBlocksPerMultiprocessor(&per_cu, mega_fwd, 512, LDS_BYTES + 256);
    if (per_cu < 1) { fprintf(stderr, "kernel_launch: occupancy query returned %d\n", per_cu); per_cu = 1; }
    grid_blocks = cus;
  }
  Params p{};
  const float** pf = (const float**)&p;
  for (int i = 0; i < 31; ++i) pf[i] = (const float*)d_in[i];
  p.out = (float*)d_out; p.ws = (unsigned char*)d_ws; p.bid = 0; p.grd = 0;
#if ONE_LAUNCH
  p.ph_lo = 0; p.ph_hi = NPH;
  if (hipMemsetAsync((char*)d_ws + OFF_BAR, 0, 3456 * 4, stream) != hipSuccess) { fprintf(stderr, "kernel_launch: memset of barrier words failed\n"); return; }
  void* args[] = {&p};
  hipError_t e = hipLaunchCooperativeKernel((const void*)mega_fwd, dim3(grid_blocks), dim3(512), args, LDS_BYTES + 256, stream);
  if (e != hipSuccess) fprintf(stderr, "cooperative launch failed: %s (grid %d)\n", hipGetErrorString(e), grid_blocks);
#else
  for (int ph = 0; ph < NPH; ++ph) { p.ph_lo = ph; p.ph_hi = ph + 1; hipLaunchKernelGGL(mega_fwd, dim3(grid_blocks), dim3(512), LDS_BYTES + 256, stream, p); }
#endif
}
```

```cpp
#include <hip/hip_runtime.h>
#include <hip/hip_cooperative_groups.h>
#include <cstdio>
#include <cstdint>
namespace cg = cooperative_groups;

#ifndef ONE_LAUNCH
#define ONE_LAUNCH 1
#endif

#ifndef PROBE
#define PROBE 0
#endif
#define PROBE_LO 8
#define PROBE_HI 9
#define LAS __attribute__((address_space(3)))
typedef unsigned short bf16_t;
typedef short bf16x8 __attribute__((ext_vector_type(8)));
typedef short s16x4 __attribute__((ext_vector_type(4)));
typedef float f32x4 __attribute__((ext_vector_type(4)));
typedef float f32x2 __attribute__((ext_vector_type(2)));
typedef float f32x16 __attribute__((ext_vector_type(16)));
typedef unsigned u32x4 __attribute__((ext_vector_type(4)));
typedef unsigned u32x2 __attribute__((ext_vector_type(2)));

constexpr int DM = 2048, NB = 4, SEQ = 8192, CTXL = 256, MT = NB * SEQ, MC = NB * CTXL, MA = MT + MC;
constexpr int DFF = 5632, SKV = SEQ + CTXL, NMODC = 9 * DM;
constexpr int PRW_LD = 3584, SH_LD = 3072, LIN_LD = 384, LO_LD = 5120;
constexpr int LDS_BYTES = 139264;

constexpr size_t SZ_WA = (size_t)11264 * 2048 * 2, SZ_WB = (size_t)2048 * 5632 * 2;
constexpr size_t OFF_W1A = 0, OFF_W1B = OFF_W1A + SZ_WA, OFF_W2A = OFF_W1B + SZ_WB, OFF_W2B = OFF_W2A + SZ_WA;
constexpr size_t OFF_WRW = OFF_W2B + SZ_WB, OFF_WQKVG = OFF_WRW + (size_t)3584 * 2048 * 2, OFF_WOA = OFF_WQKVG + (size_t)7168 * 2048 * 2;
constexpr size_t OFF_WOR = OFF_WOA + (size_t)2048 * 2048 * 2, OFF_WOUT = OFF_WOR + (size_t)2048 * 1024 * 2, OFF_WLORA = OFF_WOUT + (size_t)2048 * 2048 * 2;
constexpr size_t OFF_MOD = OFF_WLORA + (size_t)5120 * 384 * 2, OFF_CX = OFF_MOD + (size_t)5 * NMODC * 4, OFF_H = OFF_CX + (size_t)MC * DM * 4;
constexpr size_t OFF_BIG = OFF_H + (size_t)MA * DM * 2;
constexpr size_t SZ_KV = (size_t)NB * SKV * 512 * 2;
constexpr size_t OFF_KB = OFF_W1A, OFF_VB = OFF_KB + SZ_KV;
static_assert(OFF_VB + SZ_KV <= OFF_W2A, "KV overlay");
constexpr size_t OFF_ACT = OFF_BIG;
constexpr size_t OFF_PART = OFF_ACT + (size_t)MA * DFF * 2;
constexpr size_t OFF_PRW = OFF_BIG, OFF_LO = OFF_BIG, OFF_SH = OFF_LO + (size_t)MA * LO_LD * 2, OFF_LIN = OFF_SH + (size_t)MA * SH_LD * 2, OFF_Y = OFF_LIN;
constexpr size_t OFF_Q = OFF_BIG, OFF_GA = OFF_Q + (size_t)MT * DM * 2, OFF_GR = OFF_GA + (size_t)MT * DM * 2;
constexpr size_t END_A = OFF_ACT + (size_t)MA * DFF * 2, END_B = OFF_Y + (size_t)2 * MT * 1024 * 2, END_C = OFF_LIN + (size_t)MA * LIN_LD * 2;
constexpr size_t WS_END = END_A > END_B ? (END_A > END_C ? END_A : END_C) : (END_B > END_C ? END_B : END_C);
constexpr size_t OFF_BAR = (WS_END + 255) / 256 * 256, OFF_RN = OFF_BAR + 3456 * 4, WS_TOTAL = OFF_RN + (size_t)MA * 16 * 4;
static_assert((size_t)MA * PRW_LD * 2 <= (size_t)MA * LO_LD * 2, "PRW under LO");
static_assert(OFF_GR + (size_t)MT * DM * 2 <= OFF_Y, "GR below RWO");

struct Params {
  const float *x, *c, *ctx, *c_ctx, *w_mod, *b_mod, *norm_ffn1, *ffn1_w_in, *ffn1_w_out, *norm_mix, *w_in, *q_norm, *k_norm, *rwkv_mu, *w0, *w2, *a0, *a2,
      *g2, *k_k, *k_a, *r_k, *ln_x_w, *ln_x_b, *w_oa, *w_or, *w_out, *norm_ffn2, *ffn2_w_in, *ffn2_w_out, *norm_final;
  float* out; unsigned char* ws; int ph_lo, ph_hi; int bid, grd;
};

__device__ __forceinline__ unsigned cvt_pk_bf16(float lo, float hi) { unsigned r; asm("v_cvt_pk_bf16_f32 %0, %1, %2" : "=v"(r) : "v"(lo), "v"(hi)); return r; }
__device__ __forceinline__ float bf2f(unsigned short b) { return __uint_as_float(((unsigned)b) << 16); }
__device__ __forceinline__ float bflo(unsigned w) { return __uint_as_float(w << 16); }
__device__ __forceinline__ float bfhi(unsigned w) { return __uint_as_float(w & 0xffff0000u); }
__device__ __forceinline__ unsigned short f2bf(float f) { return (unsigned short)(cvt_pk_bf16(f, 0.f) & 0xffffu); }
__device__ __forceinline__ float sigmoidf_(float x) { return __builtin_amdgcn_rcpf(1.f + __builtin_amdgcn_exp2f(-1.4426950408889634f * x)); }
template <int CTRL> __device__ __forceinline__ float dpp_mov(float x) { return __int_as_float(__builtin_amdgcn_update_dpp(0, __float_as_int(x), CTRL, 0xF, 0xF, true)); }
__device__ __forceinline__ float allred16(float x) {
  x += dpp_mov<0xB1>(x); x += dpp_mov<0x4E>(x); x += dpp_mov<0x141>(x); x += dpp_mov<0x140>(x); return x;
}

__device__ __forceinline__ float wave_sum(float v) {
  v = allred16(v);
  { auto rr = __builtin_amdgcn_permlane16_swap(__float_as_uint(v), __float_as_uint(v), false, false); v = __uint_as_float(rr[0]) + __uint_as_float(rr[1]); }
  { auto rr = __builtin_amdgcn_permlane32_swap(__float_as_uint(v), __float_as_uint(v), false, false); v = __uint_as_float(rr[0]) + __uint_as_float(rr[1]); }
  return v;
}

__device__ __forceinline__ float allred8(float x) { x += dpp_mov<0xB1>(x); x += dpp_mov<0x4E>(x); x += dpp_mov<0x141>(x); return x; }
constexpr int BM = 256, BK = 64, HALF = 128, HTB = HALF * BK * 2;
__device__ __forceinline__ int lds_byte(int r, int c) { const int st = (r >> 4) * 2 + (c >> 5), rr = r & 15, cc = c & 31, ob = rr * 64 + cc * 2; return st * 1024 + (ob ^ (((ob >> 9) & 1) << 5)); }
__device__ __forceinline__ void stage_rc(int b, int& R, int& C) { const int st = b / 1024, sb = b % 1024, swz = sb ^ (((sb >> 9) & 1) << 5); R = (st >> 1) * 16 + swz / 64; C = (st & 1) * 32 + (swz % 64) / 2; }
__device__ __forceinline__ int perm32(int rho) { const int n = rho >> 4, i = rho & 15; return 8 * (i >> 2) + 4 * n + (i & 3); }

enum { M_SWIGLU = 0, M_RESID = 1, M_RW = 2, M_QKVG = 3, M_LORA = 4, M_T1 = 5, M_M = 6 };
struct Unit { const char* A; const char* B; int pm, pn, seg, nt; };
struct GemmDesc {
  int K, mode, G, c;
  const bf16_t *A0, *B0; int pm00, nM0, nN0, n0;
  const bf16_t *A1, *B1; int pm01, nN1, n1;
  int a_tiled;
  int nt0, nt1, ksplit1;
  const float* xin; int gidx; float gscale;
  bf16_t* act;
};
__device__ __forceinline__ bool sched_next(const GemmDesc& d, int i, Unit& u) {
  long L = (long)i * d.G + d.c;
  if (L < d.n0) {
    int wgid = (int)L; const int nwg = d.n0;
    { const int q = nwg / 8, r = nwg % 8, xcd = wgid % 8, off = wgid / 8; wgid = (xcd < r ? xcd * (q + 1) : r * (q + 1) + (xcd - r) * q) + off; }
    const int nig = 8 * d.nN0, gid = wgid / nig, fm = gid * 8, gsz = (d.nM0 - fm) < 8 ? (d.nM0 - fm) : 8;
    const int pm = fm + ((wgid % nig) % gsz), pn = (wgid % nig) / gsz;
    u.pm = d.pm00 + pm; u.pn = pn; u.seg = 0; u.nt = d.nt0;
    u.A = (const char*)d.A0 + (size_t)u.pm * 512 * d.K; u.B = (const char*)d.B0 + (size_t)pn * 512 * d.K;
    if (d.mode == M_LORA) { const int ko = (pn < 8 ? 0 : (pn < 16 ? 128 : 256)) * 2; u.A += ko; u.B += ko; }
    return true;
  }
  L -= d.n0;
  if (L < d.n1) {
    const int sp = (int)L % d.ksplit1, l2 = (int)L / d.ksplit1;
    const int pm = l2 / d.nN1, pn = l2 % d.nN1; u.pm = d.pm01 + pm; u.pn = pn; u.seg = 1 + sp; u.nt = d.nt1;
    const size_t ko = (size_t)sp * d.nt1 * 128, koA = d.a_tiled ? (size_t)sp * d.nt1 * 32768 : ko;
    u.A = (const char*)d.A1 + (size_t)u.pm * 512 * d.K + koA; u.B = (const char*)d.B1 + (size_t)pn * 512 * d.K + ko; return true;
  }
  return false;
}

__device__ __forceinline__ void gemm_epilogue(const f32x4 (&acc)[2][2][4][2], const Unit& u, const GemmDesc& d, const Params& P, int wr, int wc, int fr, int fq) {
  unsigned char* ws = P.ws;
  asm volatile("" : "+v"(fr), "+v"(fq));
  const int rl0 = wr * 64 + fr, cl0 = wc * 32 + 8 * fq;
  switch (d.mode) {
  case M_SWIGLU: {
    bf16_t* base = d.act + ((size_t)(u.pm * 88 + u.pn * 2 + (cl0 >> 6)) * 256) * 64 + (cl0 & 63);
#pragma unroll
    for (int ai = 0; ai < 2; ++ai)
#pragma unroll
      for (int m = 0; m < 4; ++m) {
        const int row = rl0 + 128 * ai + 16 * m;
        float o[8];
#pragma unroll
        for (int n = 0; n < 2; ++n)
#pragma unroll
          for (int j = 0; j < 4; ++j) { const float g = acc[ai][0][m][n][j], up = acc[ai][1][m][n][j]; o[4 * n + j] = g * sigmoidf_(g) * up; }
        u32x4 w; w.x = cvt_pk_bf16(o[0], o[1]); w.y = cvt_pk_bf16(o[2], o[3]); w.z = cvt_pk_bf16(o[4], o[5]); w.w = cvt_pk_bf16(o[6], o[7]);
        *(u32x4*)(base + (size_t)row * 64) = w;
      }
  } break;
  case M_RESID: {
    if (u.seg >= 1) {
      float* po = (float*)(ws + OFF_PART) + (size_t)(u.seg - 1) * MC * DM + (size_t)(u.pm - 128) * 256 * DM + u.pn * 256 + cl0;
#pragma unroll
      for (int ai = 0; ai < 2; ++ai)
#pragma unroll
        for (int m = 0; m < 4; ++m)
#pragma unroll
          for (int bj = 0; bj < 2; ++bj)
#pragma unroll
            for (int n = 0; n < 2; ++n) *(f32x4*)(po + (size_t)(rl0 + 128 * ai + 16 * m) * DM + 128 * bj + 4 * n) = acc[ai][bj][m][n];
      break;
    }
    const bool isc = u.pm >= 128; const int b = isc ? 4 : (u.pm >> 5);
    const float* xin = isc ? P.ctx + (size_t)(u.pm - 128) * 256 * DM : d.xin + (size_t)u.pm * 256 * DM;
    float* xo = isc ? (float*)(ws + OFF_CX) + (size_t)(u.pm - 128) * 256 * DM : P.out + (size_t)u.pm * 256 * DM;
    const float* gate = (const float*)(ws + OFF_MOD) + b * NMODC + d.gidx * DM + u.pn * 256 + cl0;
    f32x4 g4[2][2];
#pragma unroll
    for (int bj = 0; bj < 2; ++bj)
#pragma unroll
      for (int n = 0; n < 2; ++n) g4[bj][n] = *(const f32x4*)(gate + 128 * bj + 4 * n) * d.gscale;
#pragma unroll
    for (int ai = 0; ai < 2; ++ai)
#pragma unroll
      for (int m = 0; m < 4; ++m) {
        const size_t ro = (size_t)(rl0 + 128 * ai + 16 * m) * DM + u.pn * 256 + cl0;
#pragma unroll
        for (int bj = 0; bj < 2; ++bj)
#pragma unroll
          for (int n = 0; n < 2; ++n) {
            const f32x4 xv = *(const f32x4*)(xin + ro + 128 * bj + 4 * n);
            *(f32x4*)(xo + ro + 128 * bj + 4 * n) = xv + g4[bj][n] * acc[ai][bj][m][n];
          }
      }
  } break;
  case M_RW: case M_QKVG: case M_LORA: {
    bf16_t* base; int ld; int act = 0; const float* bias = nullptr;
    if (d.mode == M_RW) {
      if (u.seg == 0) { base = (bf16_t*)(ws + OFF_PRW) + (size_t)u.pm * 256 * PRW_LD + u.pn * 256; ld = PRW_LD; }
      else { const int b = u.pm - 128; base = (bf16_t*)(ws + (u.pn < 2 ? OFF_KB : OFF_VB)) + (size_t)(b * SKV + SEQ) * 512 + (u.pn & 1) * 256; ld = 512; }
    } else if (d.mode == M_QKVG) {
      const int b = u.pm >> 5;
      if (u.pn < 8) { base = (bf16_t*)(ws + OFF_Q) + (size_t)u.pm * 256 * DM + u.pn * 256; ld = DM; }
      else if (u.pn < 12) { base = (bf16_t*)(ws + (u.pn < 10 ? OFF_KB : OFF_VB)) + (size_t)(u.pm * 256 + b * CTXL) * 512 + (u.pn & 1) * 256; ld = 512; }
      else { base = (bf16_t*)(ws + (u.pn < 20 ? OFF_GA : OFF_GR)) + (size_t)u.pm * 256 * DM + ((u.pn - 12) & 7) * 256; ld = DM; act = 1; }
    } else {
      base = (bf16_t*)(ws + OFF_LO) + (size_t)u.pm * 256 * LO_LD + u.pn * 256; ld = LO_LD;
      if (u.pn < 8) { act = 2; bias = P.w0 + u.pn * 256; } else if (u.pn < 16) { act = 1; bias = P.a0 + (u.pn - 8) * 256; }
    }
#pragma unroll
    for (int bj = 0; bj < 2; ++bj) {
      f32x4 b0 = {0.f, 0.f, 0.f, 0.f}, b1 = {0.f, 0.f, 0.f, 0.f};
      if (bias) { b0 = *(const f32x4*)(bias + 128 * bj + cl0); b1 = *(const f32x4*)(bias + 128 * bj + cl0 + 4); }
#pragma unroll
      for (int ai = 0; ai < 2; ++ai)
#pragma unroll
        for (int m = 0; m < 4; ++m) {
          const int row = rl0 + 128 * ai + 16 * m;
          f32x4 v0 = acc[ai][bj][m][0] + b0, v1 = acc[ai][bj][m][1] + b1;
          if (act) {
            const float sc = act == 2 ? 0.60653065971263342f * 1.4426950408889634f : 1.f;
#pragma unroll
            for (int j = 0; j < 4; ++j) { v0[j] = sc * sigmoidf_(v0[j]); v1[j] = sc * sigmoidf_(v1[j]); }
          }
          u32x4 w; w.x = cvt_pk_bf16(v0[0], v0[1]); w.y = cvt_pk_bf16(v0[2], v0[3]); w.z = cvt_pk_bf16(v1[0], v1[1]); w.w = cvt_pk_bf16(v1[2], v1[3]);
          *(u32x4*)(base + (size_t)row * ld + 128 * bj + cl0) = w;
        }
    }
  } break;
  case M_T1: case M_M: {
    bf16_t* ga = (bf16_t*)(ws + OFF_GA) + (size_t)u.pm * 256 * DM + u.pn * 256 + cl0;
    bf16_t* gr = (bf16_t*)(ws + OFF_GR) + (size_t)u.pm * 256 * DM + u.pn * 256 + cl0;
    const bool isM = d.mode == M_M;
#pragma unroll
    for (int ai = 0; ai < 2; ++ai)
#pragma unroll
      for (int m = 0; m < 4; ++m)
#pragma unroll
        for (int bj = 0; bj < 2; ++bj) {
          const size_t o = (size_t)(rl0 + 128 * ai + 16 * m) * DM + 128 * bj;
          const f32x4 v0 = acc[ai][bj][m][0], v1 = acc[ai][bj][m][1];
          const u32x4 a = *(const u32x4*)(ga + o);
          u32x4 w;
          if (!isM) {
            w.x = cvt_pk_bf16(bflo(a.x) * v0[0], bfhi(a.x) * v0[1]); w.y = cvt_pk_bf16(bflo(a.y) * v0[2], bfhi(a.y) * v0[3]);
            w.z = cvt_pk_bf16(bflo(a.z) * v1[0], bfhi(a.z) * v1[1]); w.w = cvt_pk_bf16(bflo(a.w) * v1[2], bfhi(a.w) * v1[3]);
            *(u32x4*)(ga + o) = w;
          } else {
            const u32x4 g = *(const u32x4*)(gr + o);
            w.x = cvt_pk_bf16(bflo(a.x) + bflo(g.x) * v0[0], bfhi(a.x) + bfhi(g.x) * v0[1]); w.y = cvt_pk_bf16(bflo(a.y) + bflo(g.y) * v0[2], bfhi(a.y) + bfhi(g.y) * v0[3]);
            w.z = cvt_pk_bf16(bflo(a.z) + bflo(g.z) * v1[0], bfhi(a.z) + bfhi(g.z) * v1[1]); w.w = cvt_pk_bf16(bflo(a.w) + bflo(g.w) * v1[2], bfhi(a.w) + bfhi(g.w) * v1[3]);
            *(u32x4*)(gr + o) = w;
          }
        }
  } break;
  }
}

__device__ __forceinline__ void gemm_phase(LAS unsigned char* lds, const GemmDesc& d, const Params& P, const int tid) {
  const int wid = __builtin_amdgcn_readfirstlane(tid >> 6), lane = tid & 63, wr = wid >> 2, wc = wid & 3, fr = lane & 15, fq = lane >> 4;
  const int K = d.K;
  unsigned voffA[2], voffB[2];
#pragma unroll
  for (int i = 0; i < 2; ++i) { int R, C; stage_rc(tid * 16 + i * 8192, R, C); const int Rb = (R & ~31) + perm32(R & 31);
    voffA[i] = d.a_tiled ? (unsigned)(R * 64 + C) * 2u : (unsigned)(R * K + C) * 2u; voffB[i] = (unsigned)(Rb * K + C) * 2u; }
  const size_t kstep = (size_t)(BK * 2);
  const size_t hstep = (size_t)HALF * K * 2;
  const size_t kstepA = d.a_tiled ? (size_t)32768 : kstep, hstepA = d.a_tiled ? (size_t)16384 : hstep;
  const unsigned ldsw = (unsigned)wid * 1024u;
  const int aoff = lds_byte(wr * 64 + fr, fq * 8), boff = lds_byte(wc * 32 + fr, fq * 8);
#define PG8_SA(b, h) (((b) * 2 + (h)) * HTB)
#define PG8_SB(b, h) ((4 + (b) * 2 + (h)) * HTB)
#define PG8_STAGE(bufoff, gbase, voff) do { _Pragma("unroll") for (int _i = 0; _i < 2; ++_i) \
    __builtin_amdgcn_global_load_lds((const unsigned*)((const char*)(gbase) + (voff)[_i]), (LAS unsigned*)(lds + (bufoff) + ldsw + _i * 8192), 16, 0, 0); } while (0)
#define PG8_LDA(dst, b, h) do { _Pragma("unroll") for (int m = 0; m < 4; ++m) _Pragma("unroll") for (int k = 0; k < 2; ++k) dst[m][k] = *(const LAS bf16x8*)(lds + PG8_SA(b, h) + aoff + m * 2048 + k * 1024); } while (0)
#define PG8_LDB(dst, b, h) do { _Pragma("unroll") for (int n = 0; n < 2; ++n) _Pragma("unroll") for (int k = 0; k < 2; ++k) dst[n][k] = *(const LAS bf16x8*)(lds + PG8_SB(b, h) + boff + n * 2048 + k * 1024); } while (0)
#define PG8_MMA(ai, bj, At, Bt) do { __builtin_amdgcn_s_setprio(1); _Pragma("unroll") for (int m = 0; m < 4; ++m) _Pragma("unroll") for (int n = 0; n < 2; ++n) _Pragma("unroll") for (int k = 0; k < 2; ++k) \
    acc[ai][bj][m][n] = __builtin_amdgcn_mfma_f32_16x16x32_bf16(Bt[n][k], At[m][k], acc[ai][bj][m][n], 0, 0, 0); __builtin_amdgcn_s_setprio(0); } while (0)
#define PG8_WAIT_V(n) asm volatile("s_waitcnt vmcnt(" #n ")" ::: "memory")
#define PG8_WAIT_L(n) asm volatile("s_waitcnt lgkmcnt(" #n ")" ::: "memory")
#define PG8_BAR __builtin_amdgcn_s_barrier()
#define PG8_SCHED __builtin_amdgcn_sched_barrier(0)
  Unit cur, nxt; int ui = 0;
  if (!sched_next(d, 0, cur)) return;
  f32x4 acc[2][2][4][2];
#pragma unroll
  for (int a = 0; a < 2; ++a)
#pragma unroll
    for (int b = 0; b < 2; ++b)
#pragma unroll
      for (int m = 0; m < 4; ++m)
#pragma unroll
        for (int n = 0; n < 2; ++n) acc[a][b][m][n] = (f32x4){0.f, 0.f, 0.f, 0.f};
  bf16x8 At[4][2], B0[2][2], B1[2][2];
  const char* cA = cur.A; const char* cB = cur.B;
  PG8_STAGE(PG8_SB(0, 0), cB, voffB); PG8_STAGE(PG8_SB(0, 1), cB + hstep, voffB); PG8_STAGE(PG8_SA(0, 0), cA, voffA); PG8_STAGE(PG8_SA(0, 1), cA + hstepA, voffA);
  if (wr == 1) PG8_BAR;
  PG8_WAIT_V(2); PG8_BAR;
  PG8_STAGE(PG8_SB(1, 0), cB + kstep, voffB); PG8_STAGE(PG8_SA(1, 0), cA + kstepA, voffA); PG8_STAGE(PG8_SB(1, 1), cB + hstep + kstep, voffB);
  PG8_WAIT_V(6); PG8_BAR;
  for (;;) {
    const bool has_next = sched_next(d, ui + 1, nxt);
    const char* nA = has_next ? nxt.A : cA; const char* nB = has_next ? nxt.B : cB;
    const int nt = cur.nt;
    for (int t = 0; t < nt; t += 2) {
      const bool last = (t == nt - 2);
      const char* a1 = cA + (size_t)(t + 1) * kstepA;
      const char* a2 = last ? nA : cA + (size_t)(t + 2) * kstepA; const char* b2 = last ? nB : cB + (size_t)(t + 2) * kstep;
      const char* a3 = a2 + kstepA; const char* b3 = b2 + kstep;
      PG8_LDB(B0, 0, 0); PG8_LDB(B1, 0, 1); PG8_SCHED; PG8_LDA(At, 0, 0); PG8_STAGE(PG8_SA(1, 1), a1 + hstepA, voffA);
      PG8_WAIT_V(8); PG8_WAIT_L(0); PG8_BAR; PG8_MMA(0, 0, At, B0); PG8_MMA(0, 1, At, B1); PG8_BAR; PG8_SCHED;
      PG8_LDA(At, 0, 1); PG8_STAGE(PG8_SB(0, 0), b2, voffB); PG8_STAGE(PG8_SB(0, 1), b2 + hstep, voffB); PG8_STAGE(PG8_SA(0, 0), a2, voffA);
      PG8_WAIT_V(8); PG8_WAIT_L(0); PG8_BAR; PG8_MMA(1, 0, At, B0); PG8_MMA(1, 1, At, B1); PG8_BAR; PG8_SCHED;
      PG8_LDB(B0, 1, 0); PG8_LDB(B1, 1, 1); PG8_SCHED; PG8_LDA(At, 1, 0); PG8_STAGE(PG8_SA(0, 1), a2 + hstepA, voffA);
      PG8_WAIT_V(8); PG8_WAIT_L(0); PG8_BAR; PG8_MMA(0, 0, At, B0); PG8_MMA(0, 1, At, B1); PG8_BAR; PG8_SCHED;
      PG8_LDA(At, 1, 1); PG8_STAGE(PG8_SB(1, 0), b3, voffB); PG8_STAGE(PG8_SB(1, 1), b3 + hstep, voffB); PG8_STAGE(PG8_SA(1, 0), a3, voffA);
      PG8_WAIT_V(8); PG8_WAIT_L(0); PG8_BAR; PG8_MMA(1, 0, At, B0); PG8_MMA(1, 1, At, B1); PG8_BAR; PG8_SCHED;
    }
    if (wr == 0) PG8_BAR;
    gemm_epilogue(acc, cur, d, P, wr, wc, fr, fq);
    if (!has_next) break;
#pragma unroll
    for (int a = 0; a < 2; ++a)
#pragma unroll
      for (int b = 0; b < 2; ++b)
#pragma unroll
        for (int m = 0; m < 4; ++m)
#pragma unroll
          for (int n = 0; n < 2; ++n) acc[a][b][m][n] = (f32x4){0.f, 0.f, 0.f, 0.f};
    cur = nxt; cA = nA; cB = nB; ++ui;
    if (wr == 1) PG8_BAR;
  }
  PG8_WAIT_V(0);
  PG8_BAR;
#undef PG8_SA
#undef PG8_SB
#undef PG8_STAGE
#undef PG8_LDA
#undef PG8_LDB
#undef PG8_MMA
#undef PG8_WAIT_V
#undef PG8_WAIT_L
#undef PG8_BAR
#undef PG8_SCHED
}

namespace att {
constexpr int D = 128, NW = 8, QBLK = 32, KVBLK = 64;
constexpr float SCALE = 0.088388347648318440f;
constexpr float THR = 8.f;
constexpr int LDQ = 2048, LDK = 512, LDO = 2048;
constexpr size_t SHM_V = KVBLK * D * 2, SHM_K = KVBLK * D * 2;
#define KSWZ(row, colB) ((row) * 256 + ((colB) ^ (((row) & 7) << 4)))
#define SBAR() __builtin_amdgcn_sched_barrier(0)
__device__ __forceinline__ int crow(int r, int hi) { return (r & 3) + 8 * (r >> 2) + 4 * hi; }
__device__ __forceinline__ unsigned cvtpk(float lo, float hi) { unsigned r; asm volatile("v_cvt_pk_bf16_f32 %0, %1, %2" : "=v"(r) : "v"(lo), "v"(hi)); return r; }
__device__ __forceinline__ void partialSM(f32x16& p0, f32x16& p1, float& m_reg, float& mn, float& alpha) {
  constexpr float C = SCALE * 1.4426950408889634f;
  float pmax = p0[0];
#pragma unroll
  for (int r = 1; r < 16; ++r) pmax = fmaxf(pmax, p0[r]);
#pragma unroll
  for (int r = 0; r < 16; ++r) pmax = fmaxf(pmax, p1[r]);
  { auto rr = __builtin_amdgcn_permlane32_swap(__float_as_uint(pmax), __float_as_uint(pmax), false, false);
    pmax = fmaxf(__uint_as_float(rr[0]), __uint_as_float(rr[1])); }
  if (__builtin_expect(__all(pmax - m_reg <= THR / SCALE), 1)) { mn = m_reg; alpha = 1.f; }
  else { mn = fmaxf(m_reg, pmax); alpha = __builtin_amdgcn_exp2f((m_reg - mn) * C); m_reg = mn; }
  float mnC = -mn * C;
#pragma unroll
  for (int r = 0; r < 16; ++r) p0[r] = fmaf(p0[r], C, mnC);
#pragma unroll
  for (int r = 0; r < 16; ++r) p1[r] = fmaf(p1[r], C, mnC);
#pragma unroll
  for (int r = 0; r < 16; ++r) p0[r] = __builtin_amdgcn_exp2f(p0[r]);
}
__device__ __forceinline__ void finishSM(f32x16& p0, f32x16& p1, float alpha, float& l_reg, bf16x8& pa0, bf16x8& pa1, bf16x8& pa2, bf16x8& pa3) {
#pragma unroll
  for (int r = 0; r < 16; ++r) p1[r] = __builtin_amdgcn_exp2f(p1[r]);
  float ps = 0;
#pragma unroll
  for (int r = 0; r < 16; ++r) ps += p0[r];
#pragma unroll
  for (int r = 0; r < 16; ++r) ps += p1[r];
  { auto rr = __builtin_amdgcn_permlane32_swap(__float_as_uint(ps), __float_as_uint(ps), false, false);
    ps = __uint_as_float(rr[0]) + __uint_as_float(rr[1]); }
  l_reg = l_reg * alpha + ps;
#define PK4(P, BASE, OUT) do { unsigned a0 = cvtpk(P[BASE + 0], P[BASE + 1]), a1 = cvtpk(P[BASE + 2], P[BASE + 3]);   \
    unsigned b0 = cvtpk(P[BASE + 4], P[BASE + 5]), b1 = cvtpk(P[BASE + 6], P[BASE + 7]);                              \
    auto r0 = __builtin_amdgcn_permlane32_swap(a0, b0, false, false); auto r1 = __builtin_amdgcn_permlane32_swap(a1, b1, false, false); \
    u32x4 w = {r0[0], r1[0], r0[1], r1[1]}; OUT = *reinterpret_cast<bf16x8*>(&w); } while (0)
  PK4(p0, 0, pa0); PK4(p0, 8, pa1); PK4(p1, 0, pa2); PK4(p1, 8, pa3);
#undef PK4
}
__device__ __forceinline__ void qkt(f32x16& p0, f32x16& p1, const bf16_t* Ks, const bf16x8* qr, int r32, int hi) {
  p0 = f32x16{}; p1 = f32x16{};
#pragma unroll
  for (int d0 = 0; d0 < 8; ++d0) { int cb = (d0 * 16 + hi * 8) * 2;
    bf16x8 b0 = *reinterpret_cast<const bf16x8*>((const char*)Ks + KSWZ(r32, cb));
    bf16x8 b1 = *reinterpret_cast<const bf16x8*>((const char*)Ks + KSWZ(32 + r32, cb));
    p0 = __builtin_amdgcn_mfma_f32_32x32x16_bf16(b0, qr[d0], p0, 0, 0, 0);
    p1 = __builtin_amdgcn_mfma_f32_32x32x16_bf16(b1, qr[d0], p1, 0, 0, 0); }
}
__device__ __forceinline__ int v_st(int k, int c) { const int kk = (k & ~0xC) | ((k & 4) << 1) | ((k & 8) >> 1); return ((kk >> 3) * 4 + (c >> 5)) * 512 + ((kk & 7) * 32 + (c & 31)) * 2; }
__device__ __forceinline__ int v_rd_base(int lane) { return ((lane & 3) << 3) | (((lane >> 2) & 3) << 6) | (((lane >> 4) & 1) << 5) | (((lane >> 5) & 1) << 8); }
constexpr int v_rd_off(int d0, int ks, int half) { return d0 * 512 + ks * 4096 + half * 2048; }
template <int OFF> __device__ __forceinline__ s16x4 tr_read(int vb) {
  s16x4 r; asm volatile("ds_read_b64_tr_b16 %0, %1 offset:%2" : "=&v"(r) : "v"(vb), "i"(OFF) : "memory"); return r;
}
template <int D0> __device__ __forceinline__ void pv_one(f32x16& od, int vb, bf16x8 pa0, bf16x8 pa1, bf16x8 pa2, bf16x8 pa3) {
  const s16x4 l0 = tr_read<v_rd_off(D0, 0, 0)>(vb), h0 = tr_read<v_rd_off(D0, 0, 1)>(vb), l1 = tr_read<v_rd_off(D0, 1, 0)>(vb), h1 = tr_read<v_rd_off(D0, 1, 1)>(vb);
  const s16x4 l2 = tr_read<v_rd_off(D0, 2, 0)>(vb), h2 = tr_read<v_rd_off(D0, 2, 1)>(vb), l3 = tr_read<v_rd_off(D0, 3, 0)>(vb), h3 = tr_read<v_rd_off(D0, 3, 1)>(vb);
  asm volatile("s_waitcnt lgkmcnt(0)" ::: "memory"); SBAR();
#define PK(L, H) (bf16x8){L[0], L[1], L[2], L[3], H[0], H[1], H[2], H[3]}
  od = __builtin_amdgcn_mfma_f32_32x32x16_bf16(pa0, PK(l0, h0), od, 0, 0, 0);
  od = __builtin_amdgcn_mfma_f32_32x32x16_bf16(pa1, PK(l1, h1), od, 0, 0, 0);
  od = __builtin_amdgcn_mfma_f32_32x32x16_bf16(pa2, PK(l2, h2), od, 0, 0, 0);
  od = __builtin_amdgcn_mfma_f32_32x32x16_bf16(pa3, PK(l3, h3), od, 0, 0, 0);
#undef PK
}
__device__ __forceinline__ void pv_d0(f32x16* o, int vb, bf16x8 pa0, bf16x8 pa1, bf16x8 pa2, bf16x8 pa3) {
  pv_one<0>(o[0], vb, pa0, pa1, pa2, pa3); pv_one<1>(o[1], vb, pa0, pa1, pa2, pa3); pv_one<2>(o[2], vb, pa0, pa1, pa2, pa3); pv_one<3>(o[3], vb, pa0, pa1, pa2, pa3);
}
__device__ __forceinline__ void attn_dense_body(const bf16_t* __restrict__ Qb, const bf16_t* __restrict__ Kh, const bf16_t* __restrict__ Vh,
                                                bf16_t* __restrict__ Ob, int seq, char* lds, const int tid) {
  const int wid = tid >> 6, lane = tid & 63, r32 = lane & 31, hi = lane >> 5;
  bf16_t* V_lds = (bf16_t*)lds; bf16_t* K_lds = (bf16_t*)(lds + 2 * SHM_V);
  float* wsf = (float*)(lds + 2 * SHM_V + 2 * SHM_K) + wid * 64; float* li_l = wsf; float* al_l = wsf + 32;
  float m_reg = -1e30f, l_reg = 0; f32x16 o[4] = {}; bf16x8 qr[8];
  const bf16_t* Qw = Qb + (long)(wid * QBLK + r32) * LDQ + hi * 8;
#pragma unroll
  for (int d0 = 0; d0 < 8; ++d0) qr[d0] = *reinterpret_cast<const bf16x8*>(Qw + d0 * 16);
  const int sr = tid >> 4, sc = (tid & 15) * 8, vst0 = v_st(sr, sc), vst1 = v_st(32 + sr, sc);
  const int vb0 = (int)(uintptr_t)V_lds + v_rd_base(lane);
  struct { bf16x8 vs0, vs1, ks0, ks1; } sr_[2];
#define LD8(p) (*reinterpret_cast<const bf16x8*>(p))
  const unsigned voff = (unsigned)(sr * LDK + sc) * 2u;
#define SLOAD(i, k0) do { const char* vb_ = (const char*)(Vh + (size_t)(k0) * LDK); const char* kb_ = (const char*)(Kh + (size_t)(k0) * LDK); \
    sr_[i].vs0 = LD8(vb_ + voff); sr_[i].vs1 = LD8(vb_ + 32 * LDK * 2 + voff); sr_[i].ks0 = LD8(kb_ + voff); sr_[i].ks1 = LD8(kb_ + 32 * LDK * 2 + voff); } while (0)
#define SWRITE(b, i) do { *(bf16x8*)((char*)V_lds + (b) * SHM_V + vst0) = sr_[i].vs0;          \
    *(bf16x8*)((char*)V_lds + (b) * SHM_V + vst1) = sr_[i].vs1; int kc = sc * 2;               \
    *(bf16x8*)((char*)K_lds + (b) * SHM_K + KSWZ(sr, kc)) = sr_[i].ks0;                       \
    *(bf16x8*)((char*)K_lds + (b) * SHM_K + KSWZ(32 + sr, kc)) = sr_[i].ks1; } while (0)
#define SWAIT() asm volatile("s_waitcnt vmcnt(4)" ::: "memory")
#define RESC(a) do { if (__any((a) < 1.f)) { if (hi == 0) al_l[r32] = (a); asm volatile("s_waitcnt lgkmcnt(0)" ::: "memory"); \
    _Pragma("unroll") for (int d = 0; d < 4; ++d) _Pragma("unroll") for (int r = 0; r < 16; ++r) o[d][r] *= al_l[crow(r, hi)]; } } while (0)
  f32x16 pA0, pA1, pB0, pB1; float mnA, mnB, alA, alB; bf16x8 pa0, pa1, pa2, pa3; const int NT = seq / KVBLK;
  constexpr int SE = 0, SO = 1;
  SLOAD(SE, 0); asm volatile("s_waitcnt vmcnt(0)" ::: "memory"); SWRITE(0, SE); __syncthreads();
  qkt(pA0, pA1, K_lds, qr, r32, hi); partialSM(pA0, pA1, m_reg, mnA, alA);
  SLOAD(SO, KVBLK); if (2 < NT) SLOAD(SE, 2 * KVBLK);
  SWAIT(); SWRITE(1, SO); __syncthreads();
  for (int j = 1; j + 1 < NT; j += 2) {
    SBAR(); qkt(pB0, pB1, (bf16_t*)((char*)K_lds + SHM_K), qr, r32, hi);
    finishSM(pA0, pA1, alA, l_reg, pa0, pa1, pa2, pa3); SBAR();
    SLOAD(SO, (j + 2) * KVBLK); SBAR();
    pv_d0(o, vb0, pa0, pa1, pa2, pa3); partialSM(pB0, pB1, m_reg, mnB, alB);
    __syncthreads(); SWAIT(); SWRITE(0, SE);
    RESC(alB); __syncthreads();
    SBAR(); qkt(pA0, pA1, K_lds, qr, r32, hi);
    finishSM(pB0, pB1, alB, l_reg, pa0, pa1, pa2, pa3); SBAR();
    if (j + 3 < NT) SLOAD(SE, (j + 3) * KVBLK); SBAR();
    pv_d0(o, vb0 + (int)SHM_V, pa0, pa1, pa2, pa3); partialSM(pA0, pA1, m_reg, mnA, alA);
    __syncthreads(); SWAIT(); SWRITE(1, SO);
    RESC(alA); __syncthreads();
  }
  SBAR(); qkt(pB0, pB1, (bf16_t*)((char*)K_lds + SHM_K), qr, r32, hi);
  finishSM(pA0, pA1, alA, l_reg, pa0, pa1, pa2, pa3); SBAR();
  pv_d0(o, vb0, pa0, pa1, pa2, pa3); partialSM(pB0, pB1, m_reg, mnB, alB);
  __syncthreads(); RESC(alB);
  finishSM(pB0, pB1, alB, l_reg, pa0, pa1, pa2, pa3); SBAR();
  pv_d0(o, vb0 + (int)SHM_V, pa0, pa1, pa2, pa3);
  if (hi == 0) li_l[r32] = l_reg; asm volatile("s_waitcnt lgkmcnt(0)" ::: "memory");
  float rli[16];
#pragma unroll
  for (int r = 0; r < 16; ++r) rli[r] = __builtin_amdgcn_rcpf(li_l[crow(r, hi)]);
  bf16_t* Ow = Ob + (long)(wid * QBLK) * LDO;
#pragma unroll
  for (int r = 0; r < 16; ++r) { int orow = crow(r, hi);
#pragma unroll
    for (int d0 = 0; d0 < 4; ++d0) Ow[(long)orow * LDO + d0 * 32 + r32] = f2bf(o[d0][r] * rli[r]); }
#undef LD8
#undef SLOAD
#undef SWRITE
#undef SWAIT
#undef RESC
}
}

__device__ __forceinline__ void mod_phase(const Params& P, LAS unsigned char* lds, const int tid) {
  LAS float* sc = (LAS float*)lds; LAS float* red = sc + 5 * 2048;
  const int wid = tid >> 6, lane = tid & 63;
  for (int i = tid; i < 5 * 2048; i += 512) { const int j = i >> 11, k = i & 2047; const float v = (j < 4) ? P.c[j * 2048 + k] : P.c_ctx[k]; sc[i] = v * sigmoidf_(v); }
  __syncthreads();
  float* MOD = (float*)(P.ws + OFF_MOD);
  for (int task = P.bid; task < 256; task += P.grd) {
    const int n0 = task * 72 + lane * 2;
    float a0[5], a1[5];
#pragma unroll
    for (int j = 0; j < 5; ++j) { a0[j] = 0.f; a1[j] = 0.f; }
    if (lane < 36) {
      const float* wp = P.w_mod + (size_t)(wid * 256) * NMODC + n0;
#pragma unroll 16
      for (int k = 0; k < 256; ++k) {
        const f32x2 w = *(const f32x2*)(wp + (size_t)k * NMODC);
#pragma unroll
        for (int j = 0; j < 5; ++j) { const float s = sc[j * 2048 + wid * 256 + k]; a0[j] += s * w.x; a1[j] += s * w.y; }
      }
#pragma unroll
      for (int j = 0; j < 5; ++j) { red[(wid * 5 + j) * 72 + lane * 2] = a0[j]; red[(wid * 5 + j) * 72 + lane * 2 + 1] = a1[j]; }
    }
    __syncthreads();
    if (tid < 360) { const int j = tid / 72, ci = tid % 72; float s = 0.f;
#pragma unroll
      for (int w = 0; w < 8; ++w) s += red[(w * 5 + j) * 72 + ci];
      MOD[j * NMODC + task * 72 + ci] = s + P.b_mod[task * 72 + ci]; }
    __syncthreads();
  }
}
__device__ __forceinline__ void tr_load(float (&tv)[32], const float* __restrict__ W, int ldw, int k0, int n0, int lane) {
#pragma unroll
  for (int i = 0; i < 32; ++i) { const int kk = 2 * i + (lane >> 5); tv[i] = W[(size_t)(k0 + kk) * ldw + n0 + (lane & 31)]; }
}
__device__ __forceinline__ void tr_store(const float (&tv)[32], int k0, bf16_t* __restrict__ WT, int ldt, int drow0, int dk0, LAS float* scr, int lane) {
#pragma unroll
  for (int i = 0; i < 32; ++i) { const int kk = 2 * i + (lane >> 5); scr[kk * 33 + (lane & 31)] = tv[i]; }
  asm volatile("s_waitcnt lgkmcnt(0)" ::: "memory");
  const int c = lane & 7;
#pragma unroll
  for (int j = 0; j < 4; ++j) { const int n = (lane >> 3) + 8 * j; const LAS float* s = scr + (8 * c) * 33 + n;
    u32x4 o; o.x = cvt_pk_bf16(s[0 * 33], s[1 * 33]); o.y = cvt_pk_bf16(s[2 * 33], s[3 * 33]); o.z = cvt_pk_bf16(s[4 * 33], s[5 * 33]); o.w = cvt_pk_bf16(s[6 * 33], s[7 * 33]);
    *(u32x4*)(WT + (size_t)(drow0 + n) * ldt + dk0 + k0 + 8 * c) = o; }
  asm volatile("s_waitcnt lgkmcnt(0)" ::: "memory");
}
__device__ __forceinline__ void tr_item(const float* __restrict__ W, int ldw, int k0, int n0, bf16_t* __restrict__ WT, int ldt, int drow0, int dk0, LAS float* scr, int lane) {
  float tv[32]; tr_load(tv, W, ldw, k0, n0, lane); tr_store(tv, k0, WT, ldt, drow0, dk0, scr, lane);
}
constexpr int N_LATE = 16896 + 6144 + 2048 + 1024 + 2048;
__device__ __forceinline__ void late_item_addr(const Params& P, int j, const float*& W, int& ldw, int& k0, int& n0, bf16_t*& WT, int& ldt, int& drow) {
  if (j < 11264) { const int kb = j / 352, nb = j % 352; n0 = nb * 32; k0 = kb * 64; W = P.ffn2_w_in; ldw = 2 * DFF; WT = (bf16_t*)(P.ws + OFF_W2A); ldt = 2048;
    drow = n0 < DFF ? (n0 >> 7) * 256 + (n0 & 127) : ((n0 - DFF) >> 7) * 256 + 128 + ((n0 - DFF) & 127); return; }
  j -= 11264;
  if (j < 5632) { const int kb = j >> 6, nb = j & 63; n0 = nb * 32; k0 = kb * 64; W = P.ffn2_w_out; ldw = 2048; WT = (bf16_t*)(P.ws + OFF_W2B); ldt = DFF; drow = n0; return; }
  j -= 5632;
  if (j < 6144) { const int kb = j / 192, nbi = j % 192, nb = nbi < 64 ? nbi : nbi + 32;
    n0 = nb < 96 ? nb * 32 : 6528 + (nb - 96) * 32; k0 = kb * 64; W = P.w_in; ldw = 10624; WT = (bf16_t*)(P.ws + OFF_WQKVG); ldt = 2048; drow = nb * 32; return; }
  j -= 6144;
  if (j < 2048) { k0 = (j >> 6) * 64; n0 = (j & 63) * 32; W = P.w_oa; ldw = 2048; WT = (bf16_t*)(P.ws + OFF_WOA); ldt = 2048; drow = n0; return; }
  j -= 2048;
  if (j < 1024) { k0 = (j >> 6) * 64; n0 = (j & 63) * 32; W = P.w_or; ldw = 2048; WT = (bf16_t*)(P.ws + OFF_WOR); ldt = 1024; drow = n0; return; }
  j -= 1024;
  k0 = (j >> 6) * 64; n0 = (j & 63) * 32; W = P.w_out; ldw = 2048; WT = (bf16_t*)(P.ws + OFF_WOUT); ldt = 2048; drow = n0;
}
__device__ __forceinline__ void convert_phase(const Params& P, LAS unsigned char* lds, const int tid) {
  const int wid = tid >> 6, lane = tid & 63;
  LAS float* scr = (LAS float*)(lds + wid * 8704);
  unsigned char* ws = P.ws;
  bf16_t *W1A = (bf16_t*)(ws + OFF_W1A), *W1B = (bf16_t*)(ws + OFF_W1B), *W2A = (bf16_t*)(ws + OFF_W2A), *W2B = (bf16_t*)(ws + OFF_W2B);
  bf16_t *WRW = (bf16_t*)(ws + OFF_WRW), *WQKVG = (bf16_t*)(ws + OFF_WQKVG), *WOA = (bf16_t*)(ws + OFF_WOA), *WOR = (bf16_t*)(ws + OFF_WOR), *WOUT = (bf16_t*)(ws + OFF_WOUT), *WLORA = (bf16_t*)(ws + OFF_WLORA);
  const int G = P.grd, gw = P.bid * 8 + wid, NGW = G * 8;
  constexpr int NITEMS = 22528 + 11264 + 3456 + 7168 + 2048 + 1024 + 2048 + 192;
  for (int it = gw; it < NITEMS; it += NGW) {
    int r = it;
    if (r < 22528) { const int which = r >= 11264; r -= which * 11264; const int kb = r / 352, nb = r % 352, n0 = nb * 32;
      const int drow = n0 < DFF ? (n0 >> 7) * 256 + (n0 & 127) : ((n0 - DFF) >> 7) * 256 + 128 + ((n0 - DFF) & 127);
      if (!which) tr_item(P.ffn1_w_in, 2 * DFF, kb * 64, n0, W1A, 2048, drow, 0, scr, lane);
      continue; }
    r -= 22528;
    if (r < 11264) { const int which = r >= 5632; r -= which * 5632; const int kb = r >> 6, nb = r & 63;
      if (!which) tr_item(P.ffn1_w_out, 2048, kb * 64, nb * 32, W1B, DFF, nb * 32, 0, scr, lane);
      continue; }
    r -= 11264;
    if (r < 3456) { const int kb = r / 108, nb = r % 108; tr_item(P.w_in, 10624, kb * 64, 3072 + nb * 32, WRW, 2048, nb * 32, 0, scr, lane); continue; }
    r -= 3456;
    if (r < 7168) { const int kb = r / 224, nb = r % 224; const int n0 = nb < 96 ? nb * 32 : 6528 + (nb - 96) * 32;
      if (nb >= 64 && nb < 96) tr_item(P.w_in, 10624, kb * 64, n0, WQKVG, 2048, nb * 32, 0, scr, lane);
      continue; }
    r -= 7168;
    if (r < 2048) continue;
    r -= 2048;
    if (r < 1024) continue;
    r -= 1024;
    if (r < 2048) continue;
    r -= 2048;
    if (r < 64) { const int z = r >> 5, nb = r & 31; tr_item(P.w2 + (size_t)z * 64 * 1024, 1024, 0, nb * 32, WLORA, LIN_LD, z * 1024 + nb * 32, z * 64, scr, lane); continue; }
    r -= 64;
    if (r < 64) { const int z = r >> 5, nb = r & 31; tr_item(P.a2 + (size_t)z * 64 * 1024, 1024, 0, nb * 32, WLORA, LIN_LD, 2048 + z * 1024 + nb * 32, 128 + z * 64, scr, lane); continue; }
    r -= 64;
    { const int kb = r >> 5, nb = r & 31; tr_item(P.g2, 1024, kb * 64, nb * 32, WLORA, LIN_LD, 4096 + nb * 32, 256, scr, lane); }
  }
  const int gt = P.bid * 512 + tid, NT = G * 512;
  unsigned zz = 0u; asm volatile("" : "+v"(zz));
  const u32x4 z4 = {zz, zz, zz, zz};
  for (int i = gt; i < 128 * 256; i += NT) *(u32x4*)(WRW + (size_t)3456 * 2048 + (size_t)i * 8) = z4;
  for (int i = gt; i < 5120 * 48; i += NT) { const int row = i / 48, kc = (i % 48) * 8, rb = row >> 10;
    const int lo = rb < 4 ? rb * 64 : 256, hi = rb < 4 ? rb * 64 + 64 : 384;
    if (kc < lo || kc >= hi) *(u32x4*)(WLORA + (size_t)row * LIN_LD + kc) = z4; }
}
__device__ __forceinline__ void norm_mod_phase(const Params& P, const float* __restrict__ lat, const float* __restrict__ ctxp, int nrows, const float* __restrict__ g, int midx, const float* __restrict__ parts, const int tid) {
  const int wid = tid >> 6, lane = tid & 63;
  const int gw = P.bid * 8 + wid, NGW = P.grd * 8;
  const float* __restrict__ MOD = (const float*)(P.ws + OFF_MOD); bf16_t* __restrict__ H = (bf16_t*)(P.ws + OFF_H);
  for (int r = gw; r < nrows; r += NGW) {
    const float* xr = r < MT ? lat + (size_t)r * DM : ctxp + (size_t)(r - MT) * DM;
    const int b = r < MT ? (r >> 13) : 4;
    const float* sh = MOD + b * NMODC + midx * DM; const float* scp = sh + DM;
    f32x4 v[8], g4[8], s4[8], c4[8]; float ss = 0.f;
#pragma unroll
    for (int j = 0; j < 8; ++j) v[j] = *(const f32x4*)(xr + j * 256 + lane * 4);
    if (parts && r >= MT) {
      const float* pp = parts + (size_t)(r - MT) * DM; const float* gt = MOD + 4 * NMODC + 2 * DM;
#pragma unroll
      for (int j = 0; j < 8; ++j) { const int c = j * 256 + lane * 4;
        const f32x4 s = (*(const f32x4*)(pp + c) + *(const f32x4*)(pp + (size_t)MC * DM + c)) + (*(const f32x4*)(pp + (size_t)2 * MC * DM + c) + *(const f32x4*)(pp + (size_t)3 * MC * DM + c));
        v[j] = v[j] + *(const f32x4*)(gt + c) * 0.5f * s; }
    }
#pragma unroll
    for (int j = 0; j < 8; ++j) { const int c = j * 256 + lane * 4; g4[j] = *(const f32x4*)(g + c); s4[j] = *(const f32x4*)(sh + c); c4[j] = *(const f32x4*)(scp + c); }
#pragma unroll
    for (int j = 0; j < 8; ++j) ss += v[j].x * v[j].x + v[j].y * v[j].y + v[j].z * v[j].z + v[j].w * v[j].w;
    ss = wave_sum(ss);
    const float rs = rsqrtf(ss * (1.f / DM) + 1e-6f);
#pragma unroll
    for (int j = 0; j < 8; ++j) { const int c = j * 256 + lane * 4;
      const f32x4 y = v[j] * rs * g4[j]; const f32x4 h = y * (c4[j] + 1.f) + s4[j];
      u32x2 w; w.x = cvt_pk_bf16(h.x, h.y); w.y = cvt_pk_bf16(h.z, h.w);
      *(u32x2*)(H + (size_t)r * DM + c) = w; }
  }
}
__device__ __forceinline__ void shift_phase(const Params& P, const int tid) {
  const bf16_t* __restrict__ PRW = (const bf16_t*)(P.ws + OFF_PRW); bf16_t* __restrict__ SH = (bf16_t*)(P.ws + OFF_SH); bf16_t* __restrict__ LIN = (bf16_t*)(P.ws + OFF_LIN);
  const int gt = P.bid * 512 + tid, NT = P.grd * 512;
#pragma unroll 2
  for (int idx = gt; idx < MA * 432; idx += NT) {
    const int r = idx / 432, c = (idx % 432) * 8;
    bool first, last;
    if (r < MT) { const int t = r & (SEQ - 1); first = t == 0; last = t == SEQ - 1; } else { const int t = (r - MT) & (CTXL - 1); first = t == 0; last = t == CTXL - 1; }
    const u32x4 z4 = {0u, 0u, 0u, 0u};
    const u32x4 p = *(const u32x4*)(PRW + (size_t)r * PRW_LD + c);
    const u32x4 pv = first ? z4 : *(const u32x4*)(PRW + (size_t)(r - 1) * PRW_LD + c);
    const u32x4 nx = last ? z4 : *(const u32x4*)(PRW + (size_t)(r + 1) * PRW_LD + c);
    const f32x4 m0 = *(const f32x4*)(P.rwkv_mu + c), m1 = *(const f32x4*)(P.rwkv_mu + c + 4);
    float o[8];
#define SHF(e, W, MU, HI) { const float pp = HI ? bfhi(p.W) : bflo(p.W), a = HI ? bfhi(pv.W) : bflo(pv.W), b = HI ? bfhi(nx.W) : bflo(nx.W); o[e] = pp + MU * (0.5f * (a + b) - pp); }
    SHF(0, x, m0.x, 0) SHF(1, x, m0.y, 1) SHF(2, y, m0.z, 0) SHF(3, y, m0.w, 1) SHF(4, z, m1.x, 0) SHF(5, z, m1.y, 1) SHF(6, w, m1.z, 0) SHF(7, w, m1.w, 1)
#undef SHF
    bf16_t* dst;
    if (c >= 1024 && c < 2048) {
      const f32x4 q0 = *(const f32x4*)(P.k_k + (c - 1024)), q1 = *(const f32x4*)(P.k_k + (c - 1024) + 4);
      float ss = 0.f;
#define KQ(e, qv) { const float kq = bflo(cvt_pk_bf16(o[e], 0.f)) * qv; ss += kq * kq; }
      KQ(0, q0.x) KQ(1, q0.y) KQ(2, q0.z) KQ(3, q0.w) KQ(4, q1.x) KQ(5, q1.y) KQ(6, q1.z) KQ(7, q1.w)
#undef KQ
      ss = allred8(ss);
      if ((idx & 7) == 0) ((float*)(P.ws + OFF_RN))[(size_t)r * 16 + ((c - 1024) >> 6)] = rsqrtf(fmaxf(ss, 1e-24f));
    }
    if (c < 3072) dst = SH + (size_t)r * SH_LD + c;
    else { const int cl = c - 3072; dst = LIN + (size_t)r * LIN_LD + cl;
      if (cl < 128) {
#pragma unroll
        for (int e = 0; e < 8; ++e) { const float ex = __builtin_amdgcn_exp2f(2.8853900817779268f * o[e]); o[e] = 1.f - 2.f * __builtin_amdgcn_rcpf(ex + 1.f); }
      } else if (cl >= 256) {
#pragma unroll
        for (int e = 0; e < 8; ++e) o[e] = sigmoidf_(o[e]);
      } }
    u32x4 w; w.x = cvt_pk_bf16(o[0], o[1]); w.y = cvt_pk_bf16(o[2], o[3]); w.z = cvt_pk_bf16(o[4], o[5]); w.w = cvt_pk_bf16(o[6], o[7]);
    *(u32x4*)dst = w;
  }
}
__device__ __forceinline__ float SFMA(float a, float b, float c) { float d; asm("v_fma_f32 %0, %1, %2, %3" : "=v"(d) : "v"(a), "v"(b), "v"(c)); return d; }
__device__ __forceinline__ float SMUL(float a, float b) { float d; asm("v_mul_f32 %0, %1, %2" : "=v"(d) : "v"(a), "v"(b)); return d; }
__device__ __forceinline__ void scan_phase(const Params& P, LAS unsigned char* lds, const int tid) {
  constexpr int FSTEP = 320, FBUF = 32 * FSTEP + 4 * 64;
  LAS float* F = (LAS float*)lds;
  LAS unsigned short* YB = (LAS unsigned short*)(lds + 2 * FBUF * 4);
  constexpr int TR_OFF = 2 * FBUF * 4 + 4096;
  const bf16_t* SH = (const bf16_t*)(P.ws + OFF_SH); const bf16_t* LO = (const bf16_t*)(P.ws + OFF_LO); bf16_t* Y = (bf16_t*)(P.ws + OFF_Y);
  const int wid = __builtin_amdgcn_readfirstlane(tid >> 6), lane = tid & 63;
  constexpr int NCH = SKV / 32;
#define SCAN_BAR() do { asm volatile("s_waitcnt lgkmcnt(0)" ::: "memory"); __builtin_amdgcn_s_barrier(); asm volatile("" ::: "memory"); } while (0)
  for (int task = P.bid; task < 256; task += P.grd) {
    const int half = (task >> 3) & 1, chain = (task & 7) | ((task >> 4) << 3);
    const int dir = chain & 1, h = (chain >> 1) & 15, b = chain >> 5, hc = h * 64;
#define ROWOF(g) ((g) < CTXL ? (MT + b * CTXL + (dir ? CTXL - 1 - (g) : (g))) : (b * SEQ + (dir ? SEQ - 1 - ((g) - CTXL) : ((g) - CTXL))))
    if (wid < 4) {
      const int rloc = wid * 8 + (lane >> 3), irow = half * 32 + rloc, cA = (lane & 7) * 4, cB = 32 + cA;
      f32x4 S0 = {0.f, 0.f, 0.f, 0.f}, S1 = {0.f, 0.f, 0.f, 0.f};
      SCAN_BAR();
      for (int q = 0; q < NCH; ++q) {
        const LAS float* f = F + (q & 1) * FBUF;
        LAS unsigned short* yb = YB + (q & 1) * 1024;
        f32x4 a0 = *(const LAS f32x4*)(f + cA), a1 = *(const LAS f32x4*)(f + cB);
        f32x4 b0 = *(const LAS f32x4*)(f + 64 + cA), b1 = *(const LAS f32x4*)(f + 64 + cB);
        f32x4 k0 = *(const LAS f32x4*)(f + 128 + cA), k1 = *(const LAS f32x4*)(f + 128 + cB);
        f32x4 r0 = *(const LAS f32x4*)(f + 192 + cA), r1 = *(const LAS f32x4*)(f + 192 + cB);
        float vv = f[256 + irow];
        float ykeep = 0.f; f32x4 gA = {1.f, 1.f, 1.f, 1.f}, gB = gA;
#pragma unroll 2
        for (int s = 0; s < 32; ++s) {
          const LAS float* fn = f + (s < 31 ? s + 1 : 31) * FSTEP;
          const f32x4 na0 = *(const LAS f32x4*)(fn + cA), na1 = *(const LAS f32x4*)(fn + cB);
          const f32x4 nb0 = *(const LAS f32x4*)(fn + 64 + cA), nb1 = *(const LAS f32x4*)(fn + 64 + cB);
          const f32x4 nk0 = *(const LAS f32x4*)(fn + 128 + cA), nk1 = *(const LAS f32x4*)(fn + 128 + cB);
          const f32x4 nr0 = *(const LAS f32x4*)(fn + 192 + cA), nr1 = *(const LAS f32x4*)(fn + 192 + cB);
          const float nvv = fn[256 + irow];
          if ((s & 7) == 5) { const LAS float* gp = f + 32 * FSTEP + (s >> 3) * 64; gA = *(const LAS f32x4*)(gp + cA); gB = *(const LAS f32x4*)(gp + cB); }
          __builtin_amdgcn_sched_barrier(0);
          f32x4 p = S0 * a0 + S1 * a1;
          const float sa_ = allred8((p.x + p.y) + (p.z + p.w));
          S0 = __builtin_elementwise_fma(k0, (f32x4){vv, vv, vv, vv}, __builtin_elementwise_fma(b0, (f32x4){sa_, sa_, sa_, sa_}, S0));
          S1 = __builtin_elementwise_fma(k1, (f32x4){vv, vv, vv, vv}, __builtin_elementwise_fma(b1, (f32x4){sa_, sa_, sa_, sa_}, S1));
          p = S0 * r0 + S1 * r1;
          const float y = allred8((p.x + p.y) + (p.z + p.w));
          ykeep = ((s & 7) == (lane & 7)) ? y : ykeep;
          if ((s & 7) == 7) {
            yb[((s & ~7) + (lane & 7)) * 32 + rloc] = f2bf(ykeep);
            S0 = S0 * gA; S1 = S1 * gB;
          }
          __builtin_amdgcn_sched_barrier(0);
          a0 = na0; a1 = na1; b0 = nb0; b1 = nb1; k0 = nk0; k1 = nk1; r0 = nr0; r1 = nr1; vv = nvv;
        }
        SCAN_BAR();
      }
    } else {
      const int sw = wid - 4, hw = lane >> 5, cp = (lane & 31) * 2;
      const f32x2 kk_c = *(const f32x2*)(P.k_k + hc + cp), ka_c = *(const f32x2*)(P.k_a + hc + cp);
      unsigned voS[4], voL[4];
#pragma unroll
      for (int e = 0; e < 4; ++e) { const int tk = hw * 4 + e, ro = dir ? 7 - tk : tk; voS[e] = (unsigned)(ro * SH_LD + cp) * 2u; voL[e] = (unsigned)(ro * LO_LD + cp) * 2u; }
      unsigned sr[4], sk[4], sv[4], sl[4], sa[4]; float srn[4]; int roff[4];
#pragma unroll
      for (int e = 0; e < 4; ++e) { const int tk = hw * 4 + e; roff[e] = (dir ? 7 - tk : tk) * 16; }
      const float* RN = (const float*)(P.ws + OFF_RN);
#define RMIN(q) ({ const int g0_ = (q) * 32 + sw * 8; const int ra_ = ROWOF(g0_), rb_ = ROWOF(g0_ + 7); ra_ < rb_ ? ra_ : rb_; })
#define SLOADQ(q) do { const size_t rmin_ = (size_t)RMIN(q); const char* bs_ = (const char*)(SH + rmin_ * SH_LD + hc); const char* bl_ = (const char*)(LO + rmin_ * LO_LD + dir * 1024 + hc); \
      _Pragma("unroll") for (int e = 0; e < 4; ++e) { sr[e] = *(const unsigned*)(bs_ + voS[e]); sk[e] = *(const unsigned*)(bs_ + 2048 + voS[e]); sv[e] = *(const unsigned*)(bs_ + 4096 + voS[e]); \
        sl[e] = *(const unsigned*)(bl_ + voL[e]); sa[e] = *(const unsigned*)(bl_ + 4096 + voL[e]); srn[e] = RN[rmin_ * 16 + h + roff[e]]; } } while (0)
#define EX2V(V) (f32x2){__builtin_amdgcn_exp2f((V).x), __builtin_amdgcn_exp2f((V).y)}
#define SWRITEQ(buf) do { \
      f32x2 Lc[4]; { f32x2 run = {0.f, 0.f}; _Pragma("unroll") for (int e = 0; e < 4; ++e) { run = run + (f32x2){bflo(sl[e]), bfhi(sl[e])}; Lc[e] = run; } } \
      f32x2 qlo, qhi; { auto r0_ = __builtin_amdgcn_permlane32_swap(__float_as_uint(Lc[3].x), __float_as_uint(Lc[3].x), false, false); \
                        auto r1_ = __builtin_amdgcn_permlane32_swap(__float_as_uint(Lc[3].y), __float_as_uint(Lc[3].y), false, false); \
                        qlo = (f32x2){__uint_as_float(r0_[0]), __uint_as_float(r1_[0])}; qhi = (f32x2){__uint_as_float(r0_[1]), __uint_as_float(r1_[1])}; } \
      const f32x2 base_ = hw ? qlo : (f32x2){0.f, 0.f}; \
      if (hw == 0) *(LAS f32x2*)(F + (buf) * FBUF + 32 * FSTEP + sw * 64 + cp) = EX2V(-(qlo + qhi)); \
      f32x2 Pm = EX2V(-base_); \
      _Pragma("unroll") for (int e = 0; e < 4; ++e) { LAS float* f_ = F + (buf) * FBUF + (sw * 8 + hw * 4 + e) * FSTEP + cp; \
        const f32x2 r_ = {bflo(sr[e]), bfhi(sr[e])}, k_ = {bflo(sk[e]), bfhi(sk[e])}, v_ = {bflo(sv[e]), bfhi(sv[e])}, aa = {bflo(sa[e]), bfhi(sa[e])}; \
        const f32x2 lj = base_ + Lc[e]; \
        const f32x2 Pj = EX2V(-lj), Pi = EX2V(lj); \
        const f32x2 kk = k_ * kk_c * srn[e]; const f32x2 kki = kk * Pi; \
        *(LAS f32x2*)(f_) = -kk * Pm; *(LAS f32x2*)(f_ + 64) = kki * aa; *(LAS f32x2*)(f_ + 128) = k_ * ((aa - 1.f) * ka_c + 1.f) * Pi; \
        *(LAS f32x2*)(f_ + 192) = r_ * Pj; *(LAS f32x2*)(f_ + 256) = v_; Pm = Pj; } } while (0)
      LAS float* trscr = (LAS float*)(lds + TR_OFF + sw * 8704);
      float tv[32]; int w2j = task * 4 + sw;
      SLOADQ(0); SWRITEQ(0); SLOADQ(1);
      SCAN_BAR();
      for (int q = 0; q < NCH; ++q) {
        if (q >= 9) {
          const int qq = q - 1; const LAS unsigned short* yb = YB + (qq & 1) * 1024;
          const int t256 = sw * 64 + lane, s = t256 >> 3, rp = (t256 & 7) * 4; const int u = qq * 32 + s - CTXL; const int t = dir ? SEQ - 1 - u : u;
          const u32x2 val = *(const LAS u32x2*)(yb + s * 32 + rp);
          *(u32x2*)(Y + (size_t)dir * MT * 1024 + (size_t)(b * SEQ + t) * 1024 + hc + half * 32 + rp) = val;
        }
        if (q + 1 < NCH) SWRITEQ((q + 1) & 1);
        if ((q & 7) == 3 && w2j < N_LATE) {
          const float* W_; int ldw_, k0_, n0_, ldt_, drow_; bf16_t* WT_; late_item_addr(P, w2j, W_, ldw_, k0_, n0_, WT_, ldt_, drow_);
          tr_store(tv, k0_, WT_, ldt_, drow_, 0, trscr, lane); w2j += 1024;
        }
        if (q + 2 < NCH) SLOADQ(q + 2);
        if ((q & 7) == 2 && w2j < N_LATE) {
          const float* W_; int ldw_, k0_, n0_, ldt_, drow_; bf16_t* WT_; late_item_addr(P, w2j, W_, ldw_, k0_, n0_, WT_, ldt_, drow_);
          tr_load(tv, W_, ldw_, k0_, n0_, lane);
        }
        SCAN_BAR();
      }
      {
        const int qq = NCH - 1; const LAS unsigned short* yb = YB + (qq & 1) * 1024;
        const int t256 = sw * 64 + lane, s = t256 >> 3, rp = (t256 & 7) * 4; const int u = qq * 32 + s - CTXL; const int t = dir ? SEQ - 1 - u : u;
        const u32x2 val = *(const LAS u32x2*)(yb + s * 32 + rp);
        *(u32x2*)(Y + (size_t)dir * MT * 1024 + (size_t)(b * SEQ + t) * 1024 + hc + half * 32 + rp) = val;
      }
#undef SLOADQ
#undef SWRITEQ
#undef RMIN
#undef EX2V
    }
#undef ROWOF
    __syncthreads();
  }
#undef SCAN_BAR
}
__device__ __forceinline__ float half_sum(float v) {
  v = allred16(v);
  auto rr = __builtin_amdgcn_permlane16_swap(__float_as_uint(v), __float_as_uint(v), false, false); return __uint_as_float(rr[0]) + __uint_as_float(rr[1]);
}
__device__ __forceinline__ void rwkv_out_phase(const Params& P, const int tid) {
  const bf16_t* SH = (const bf16_t*)(P.ws + OFF_SH); const bf16_t* LO = (const bf16_t*)(P.ws + OFF_LO); bf16_t* Y = (bf16_t*)(P.ws + OFF_Y);
  const int wid = tid >> 6, lane = tid & 63, hw = lane >> 5, cp = (lane & 31) * 2;
  const int gw = P.bid * 8 + wid, NGW = P.grd * 8;
  for (int task = gw * 2; task < MT * 8; task += NGW * 2) {
    unsigned yf[2], ybk[2], rr[2], kk[2], vv[2], af[2], ab[2], gg[2]; int cc[2]; size_t tk[2];
#pragma unroll
    for (int u = 0; u < 2; ++u) { const int t_ = task + u; tk[u] = (size_t)(t_ >> 3); cc[u] = ((t_ & 7) * 2 + hw) * 64 + cp;
      const bf16_t* py = Y + tk[u] * 1024 + cc[u]; const bf16_t* ps = SH + tk[u] * SH_LD + cc[u]; const bf16_t* pl = LO + tk[u] * LO_LD + cc[u];
      yf[u] = *(const unsigned*)py; ybk[u] = *(const unsigned*)(py + (size_t)MT * 1024);
      rr[u] = *(const unsigned*)ps; kk[u] = *(const unsigned*)(ps + 1024); vv[u] = *(const unsigned*)(ps + 2048);
      af[u] = *(const unsigned*)(pl + 2048); ab[u] = *(const unsigned*)(pl + 3072); gg[u] = *(const unsigned*)(pl + 4096); }
    unsigned res[2];
#pragma unroll
    for (int u = 0; u < 2; ++u) {
      const f32x2 lw = *(const f32x2*)(P.ln_x_w + cc[u]), lb = *(const f32x2*)(P.ln_x_b + cc[u]), ka = *(const f32x2*)(P.k_a + cc[u]), rk = *(const f32x2*)(P.r_k + cc[u]);
      const f32x2 y = {bflo(yf[u]) + bflo(ybk[u]), bfhi(yf[u]) + bfhi(ybk[u])};
      const float mu = half_sum(y.x + y.y) * (1.f / 64.f); const f32x2 dv = y - mu; const float var = half_sum(dv.x * dv.x + dv.y * dv.y) * (1.f / 64.f);
      const f32x2 yn = dv * rsqrtf(var + 64e-5f) * lw + lb;
      const f32x2 r = {bflo(rr[u]), bfhi(rr[u])}, k = {bflo(kk[u]), bfhi(kk[u])}, v = {bflo(vv[u]), bfhi(vv[u])};
      const f32x2 a1 = {bflo(af[u]), bfhi(af[u])}, a2 = {bflo(ab[u]), bfhi(ab[u])}, g = {bflo(gg[u]), bfhi(gg[u])};
      const f32x2 kms = k * ((a1 - 1.f) * ka + 1.f) + k * ((a2 - 1.f) * ka + 1.f);
      const f32x2 bt = r * kms * rk;
      const float bonus = half_sum(bt.x + bt.y);
      const f32x2 o = (yn + v * bonus) * g;
      res[u] = cvt_pk_bf16(o.x, o.y);
    }
#pragma unroll
    for (int u = 0; u < 2; ++u) *(unsigned*)(Y + tk[u] * 1024 + cc[u]) = res[u];
  }
}
__device__ __forceinline__ void rope_phase(const Params& P, const int tid) {
  bf16_t* Q = (bf16_t*)(P.ws + OFF_Q); bf16_t* KB = (bf16_t*)(P.ws + OFF_KB);
  const int wid = tid >> 6, lane = tid & 63, hw = lane >> 5, li = lane & 31;
  const int gw = P.bid * 8 + wid, NGW = P.grd * 8;
  const int d1 = li < 16 ? 2 * li : 64 + 2 * (li - 16);
  const f32x2 qgA = *(const f32x2*)(P.q_norm + d1), qgB = *(const f32x2*)(P.q_norm + d1 + 32), kgA = *(const f32x2*)(P.k_norm + d1), kgB = *(const f32x2*)(P.k_norm + d1 + 32);
  const int j0 = 2 * (li & 15);
  const float inv0 = __builtin_amdgcn_exp2f(-(float)(2 * j0) * (13.287712379549449f / 64.f)), inv1 = __builtin_amdgcn_exp2f(-(float)(2 * j0 + 2) * (13.287712379549449f / 64.f));
  for (int task = gw; task < MA; task += NGW) {
    if (task < MT) {
      const int tok = task, b = tok >> 13, t = tok & (SEQ - 1);
      const float pos = (float)(li < 16 ? (t >> 6) : (t & 63));
      const float an0 = pos * inv0, an1 = pos * inv1;
      const f32x2 sn = {__sinf(an0), __sinf(an1)}, cs = {__cosf(an0), __cosf(an1)};
      unsigned lo[10], hi[10]; bf16_t* ptr[10];
#pragma unroll
      for (int i = 0; i < 10; ++i) { const int hd = 2 * i + hw;
        ptr[i] = (hd < 16 ? Q + (size_t)tok * DM + hd * 128 : KB + (size_t)(tok + b * CTXL) * 512 + (hd - 16) * 128) + d1;
        lo[i] = *(const unsigned*)ptr[i]; hi[i] = *(const unsigned*)(ptr[i] + 32); }
#pragma unroll
      for (int i = 0; i < 10; ++i) { const bool isq = i < 8;
        const f32x2 t1 = {bflo(lo[i]), bfhi(lo[i])}, t2 = {bflo(hi[i]), bfhi(hi[i])};
        const float ss = half_sum((t1.x * t1.x + t1.y * t1.y) + (t2.x * t2.x + t2.y * t2.y)); const float rs = rsqrtf(ss * (1.f / 128.f) + 1e-6f);
        const f32x2 n1 = t1 * rs * (isq ? qgA : kgA), n2 = t2 * rs * (isq ? qgB : kgB);
        const f32x2 o1 = n1 * cs - n2 * sn, o2 = n2 * cs + n1 * sn;
        lo[i] = cvt_pk_bf16(o1.x, o1.y); hi[i] = cvt_pk_bf16(o2.x, o2.y); }
#pragma unroll
      for (int i = 0; i < 10; ++i) { *(unsigned*)ptr[i] = lo[i]; *(unsigned*)(ptr[i] + 32) = hi[i]; }
    } else {
      const int ct = task - MT, b = ct >> 8, t = ct & (CTXL - 1);
      unsigned lo[2], hi[2]; bf16_t* ptr[2];
#pragma unroll
      for (int i = 0; i < 2; ++i) { ptr[i] = KB + (size_t)(b * SKV + SEQ + t) * 512 + (2 * i + hw) * 128 + d1; lo[i] = *(const unsigned*)ptr[i]; hi[i] = *(const unsigned*)(ptr[i] + 32); }
#pragma unroll
      for (int i = 0; i < 2; ++i) {
        const f32x2 t1 = {bflo(lo[i]), bfhi(lo[i])}, t2 = {bflo(hi[i]), bfhi(hi[i])};
        const float ss = half_sum((t1.x * t1.x + t1.y * t1.y) + (t2.x * t2.x + t2.y * t2.y)); const float rs = rsqrtf(ss * (1.f / 128.f) + 1e-6f);
        const f32x2 n1 = t1 * rs * kgA, n2 = t2 * rs * kgB;
        *(unsigned*)ptr[i] = cvt_pk_bf16(n1.x, n1.y); *(unsigned*)(ptr[i] + 32) = cvt_pk_bf16(n2.x, n2.y); }
    }
  }
}
__device__ __forceinline__ void attn_phase(const Params& P, unsigned char* smem, const int tid) {
  bf16_t* Q = (bf16_t*)(P.ws + OFF_Q); const bf16_t* KB = (const bf16_t*)(P.ws + OFF_KB); const bf16_t* VB = (const bf16_t*)(P.ws + OFF_VB);
  for (int u = P.bid; u < 2048; u += P.grd) {
    const int xcd = u & 7, slot = (u >> 3) & 31, rnd = u >> 8, pair = xcd + 8 * (rnd >> 2), w = (rnd & 3) * 32 + slot;
    const int b = pair >> 2, kvh = pair & 3, g = w & 3, qb = w >> 2, head = kvh * 4 + g;
    bf16_t* Qb = Q + (size_t)(b * SEQ + qb * 256) * DM + head * 128;
    const bf16_t* Kh = KB + (size_t)b * SKV * 512 + kvh * 128; const bf16_t* Vh = VB + (size_t)b * SKV * 512 + kvh * 128;
    att::attn_dense_body(Qb, Kh, Vh, Qb, SKV, (char*)smem, tid);
    __syncthreads();
  }
}
__device__ __forceinline__ void final_norm_phase(const Params& P, const int tid) {
  const int wid = tid >> 6, lane = tid & 63;
  const int gw = P.bid * 8 + wid, NGW = P.grd * 8;
  f32x4 g4[8];
#pragma unroll
  for (int j = 0; j < 8; ++j) g4[j] = *(const f32x4*)(P.norm_final + j * 256 + lane * 4);
  for (int r = gw; r < MT; r += NGW) {
    float* xr = P.out + (size_t)r * DM;
    f32x4 v[8]; float ss = 0.f;
#pragma unroll
    for (int j = 0; j < 8; ++j) v[j] = *(const f32x4*)(xr + j * 256 + lane * 4);
#pragma unroll
    for (int j = 0; j < 8; ++j) ss += v[j].x * v[j].x + v[j].y * v[j].y + v[j].z * v[j].z + v[j].w * v[j].w;
    ss = wave_sum(ss);
    const float rs = rsqrtf(ss * (1.f / DM) + 1e-6f);
#pragma unroll
    for (int j = 0; j < 8; ++j) *(f32x4*)(xr + j * 256 + lane * 4) = v[j] * rs * g4[j];
  }
}


#define XB_TMO      128
#define XB_XCNT(j)  (256  + 64 * (j))
#define XB_XSUB(j)  (1280 + 64 * (j))
#define XB_XGEN(j)  (2304 + 64 * (j))
#define XB_TOP      3328
#define XB_TOPGEN   3392
#define XCD_BAR_WORDS 3456
#define XB_SPIN_CAP (1u << 18)
__device__ __forceinline__ unsigned xb_ld(unsigned* p)              { return __hip_atomic_load(p, __ATOMIC_RELAXED, __HIP_MEMORY_SCOPE_AGENT); }
__device__ __forceinline__ unsigned xb_add(unsigned* p, unsigned v) { return __hip_atomic_fetch_add(p, v, __ATOMIC_RELAXED, __HIP_MEMORY_SCOPE_AGENT); }
__device__ __forceinline__ unsigned xb_xcc_id() { return (unsigned)__builtin_amdgcn_s_getreg((3 << 11) | 20) & 0xFu; }
#define XB_SPIN(cond, bar) do { unsigned _sp = 0; while (cond) { __builtin_amdgcn_s_sleep(1); \
    if ((++_sp & 255u) == 0u) { if (xb_ld(&(bar)[XB_TMO])) break; if (_sp > XB_SPIN_CAP) { atomicAdd(&(bar)[XB_TMO], 1u); break; } } } } while (0)
__device__ __forceinline__ void xcd_barrier_complete(unsigned* bar, unsigned x, unsigned& nloc, unsigned& nx) {
    const unsigned G = gridDim.x * gridDim.y * gridDim.z;
    unsigned sum, cnt, mine, sp = 0u;
    for (;;) {
        sum = 0u; cnt = 0u; mine = 0u;
#pragma unroll
        for (unsigned j = 0; j < 16; ++j) { const unsigned c = xb_ld(&bar[XB_XCNT(j)]); sum += c; cnt += (c > 0u) ? 1u : 0u; mine = (j == x) ? c : mine; }
        if (sum == G) break;
        __builtin_amdgcn_s_sleep(1);
        if ((++sp & 255u) == 0u) { if (xb_ld(&bar[XB_TMO])) break; if (sp > XB_SPIN_CAP) { atomicAdd(&bar[XB_TMO], 1u); break; } }
    }
    nloc = mine > 0u ? mine : 1u; nx = cnt > 0u ? cnt : 1u;
}
__device__ __forceinline__ void xcd_barrier(unsigned* bar, volatile LAS unsigned* st) {
    asm volatile("s_waitcnt vmcnt(0)" ::: "memory");
    __syncthreads();
    if (threadIdx.x == 0) {
        __builtin_amdgcn_s_waitcnt(0);
        const unsigned x = xb_xcc_id();
        unsigned nloc = st[0], nx = st[1];
        if (nloc == 0u) { xcd_barrier_complete(bar, x, nloc, nx); st[0] = nloc; st[1] = nx; }
        const unsigned old = xb_add(&bar[XB_XSUB(x)], 1u);
        const unsigned gen = old / nloc;
        if (old + 1u == (gen + 1u) * nloc) {
            __builtin_amdgcn_fence(__ATOMIC_RELEASE, "agent");
            asm volatile("s_waitcnt vmcnt(0)" ::: "memory");
            const unsigned og = xb_add(&bar[XB_TOP], 1u);
            const unsigned tg = og / nx;
            if (og + 1u == (tg + 1u) * nx) xb_add(&bar[XB_TOPGEN], 1u);
            else XB_SPIN(xb_ld(&bar[XB_TOPGEN]) == tg, bar);
            __builtin_amdgcn_fence(__ATOMIC_ACQUIRE, "agent");
            xb_add(&bar[XB_XGEN(x)], 1u);
            asm volatile("s_waitcnt vmcnt(0)" ::: "memory");
        } else {
            XB_SPIN(xb_ld(&bar[XB_XGEN(x)]) == gen, bar);
            __builtin_amdgcn_fence(__ATOMIC_ACQUIRE, "agent");
            asm volatile("s_waitcnt vmcnt(0)" ::: "memory");
        }
    }
    __syncthreads();
}

constexpr int NPH = 20;
__device__ __forceinline__ bool gemm_desc(int ph, const Params& P, GemmDesc& d) {
  unsigned char* ws = P.ws;
  const bf16_t* H = (const bf16_t*)(ws + OFF_H);
  d.a_tiled = 0; d.nt0 = 0; d.nt1 = 0; d.ksplit1 = 1; d.G = P.grd; d.c = P.bid; d.A1 = nullptr; d.B1 = nullptr; d.pm01 = 0; d.nN1 = 1; d.n1 = 0; d.pm00 = 0; d.xin = nullptr; d.gidx = 0; d.gscale = 0.f; d.act = nullptr;
  switch (ph) {
  case 2: d.K = 2048; d.mode = M_SWIGLU; d.A0 = H; d.B0 = (const bf16_t*)(ws + OFF_W1A); d.nM0 = 132; d.nN0 = 44; d.act = (bf16_t*)(ws + OFF_ACT); break;
  case 3: d.a_tiled = 1; d.K = DFF; d.mode = M_RESID; d.A0 = (const bf16_t*)(ws + OFF_ACT); d.B0 = (const bf16_t*)(ws + OFF_W1B); d.nM0 = 128; d.nN0 = 8; d.xin = P.x; d.gidx = 2; d.gscale = 0.5f;
          d.A1 = d.A0; d.B1 = d.B0; d.pm01 = 128; d.nN1 = 8; d.ksplit1 = 4; d.nt1 = 22; d.n1 = 4 * 8 * 4; break;
  case 5: d.K = 2048; d.mode = M_RW; d.A0 = H; d.B0 = (const bf16_t*)(ws + OFF_WRW); d.nM0 = 132; d.nN0 = 14;
          d.A1 = H; d.B1 = (const bf16_t*)(ws + OFF_WQKVG) + (size_t)2048 * 2048; d.pm01 = 128; d.nN1 = 4; d.n1 = 16; break;
  case 7: d.K = 384; d.mode = M_LORA; d.A0 = (const bf16_t*)(ws + OFF_LIN); d.B0 = (const bf16_t*)(ws + OFF_WLORA); d.nM0 = 132; d.nN0 = 20; break;
  case 10: d.K = 2048; d.mode = M_QKVG; d.A0 = H; d.B0 = (const bf16_t*)(ws + OFF_WQKVG); d.nM0 = 128; d.nN0 = 28; break;
  case 13: d.K = 2048; d.mode = M_T1; d.A0 = (const bf16_t*)(ws + OFF_Q); d.B0 = (const bf16_t*)(ws + OFF_WOA); d.nM0 = 128; d.nN0 = 8; break;
  case 14: d.K = 1024; d.mode = M_M; d.A0 = (const bf16_t*)(ws + OFF_Y); d.B0 = (const bf16_t*)(ws + OFF_WOR); d.nM0 = 128; d.nN0 = 8; break;
  case 15: d.K = 2048; d.mode = M_RESID; d.A0 = (const bf16_t*)(ws + OFF_GR); d.B0 = (const bf16_t*)(ws + OFF_WOUT); d.nM0 = 128; d.nN0 = 8; d.xin = P.out; d.gidx = 5; d.gscale = 1.f; break;
  case 17: d.K = 2048; d.mode = M_SWIGLU; d.A0 = H; d.B0 = (const bf16_t*)(ws + OFF_W2A); d.nM0 = 128; d.nN0 = 44; d.act = (bf16_t*)(ws + OFF_ACT); break;
  case 18: d.a_tiled = 1; d.K = DFF; d.mode = M_RESID; d.A0 = (const bf16_t*)(ws + OFF_ACT); d.B0 = (const bf16_t*)(ws + OFF_W2B); d.nM0 = 128; d.nN0 = 8; d.xin = P.out; d.gidx = 8; d.gscale = 0.5f; break;
  default: return false;
  }
  d.n0 = d.nM0 * d.nN0;
  if (!d.nt0) d.nt0 = d.K / BK;
  if (!d.nt1) d.nt1 = d.K / BK;
  if (d.mode == M_LORA) d.nt0 = 2;
  return true;
}

__global__ void __launch_bounds__(512) mega_fwd(Params P) {
  extern __shared__ __attribute__((aligned(16))) unsigned char smem[];
  LAS unsigned char* lds = (LAS unsigned char*)smem;
  cg::grid_group grid = cg::this_grid();
  volatile LAS unsigned* bst = (volatile LAS unsigned*)(lds + LDS_BYTES + 192);
  unsigned* gbar = (unsigned*)(P.ws + OFF_BAR);
#if ONE_LAUNCH
  if (threadIdx.x == 0) { bst[0] = 0u; bst[1] = 0u; (void)xb_add(&gbar[XB_XCNT(xb_xcc_id())], 1u); }
  __syncthreads();
#endif
#pragma nounroll
  for (int ph = P.ph_lo; ph < P.ph_hi; ++ph) {
    GemmDesc d;
    int tid = threadIdx.x; asm volatile("" : "+v"(tid));
#if PROBE
    if (blockIdx.x == 0 && tid == 0) ((LAS unsigned long long*)(lds + LDS_BYTES))[ph] = __builtin_amdgcn_s_memrealtime();
#endif
    const __attribute__((address_space(4))) Params* kp = (const __attribute__((address_space(4))) Params*)__builtin_amdgcn_kernarg_segment_ptr();
    asm volatile("" : "+s"(kp));
#if defined(__HIP_DEVICE_COMPILE__)
    Params L = *kp;
#else
    Params L = P;
#endif
    { int b_ = blockIdx.x, g_ = gridDim.x; asm volatile("" : "+s"(b_), "+s"(g_)); L.bid = b_; L.grd = g_; }
    if (gemm_desc(ph, L, d)) gemm_phase(lds, d, L, tid);
    else switch (ph) {
      case 0: mod_phase(L, lds, tid); __syncthreads(); convert_phase(L, lds, tid); break;
      case 1: norm_mod_phase(L, L.x, L.ctx, MA, L.norm_ffn1, 0, nullptr, tid); break;
      case 4: norm_mod_phase(L, L.out, L.ctx, MA, L.norm_mix, 3, (const float*)(L.ws + OFF_PART), tid); break;
      case 6: shift_phase(L, tid); break;
      case 8: scan_phase(L, lds, tid); break;
      case 9: rwkv_out_phase(L, tid); break;
      case 11: rope_phase(L, tid); break;
      case 12: attn_phase(L, smem, tid); break;
      case 16: norm_mod_phase(L, L.out, nullptr, MT, L.norm_ffn2, 6, nullptr, tid); break;
      case 19: final_norm_phase(L, tid); break;
      default: break;
    }
    if (ph + 1 < P.ph_hi) { if (ph == 0) grid.sync(); else if (ph != 13 || !ONE_LAUNCH) xcd_barrier(gbar, bst); }
  }
#if PROBE
  grid.sync();
  if (blockIdx.x == 0) {
    LAS unsigned long long* TS = (LAS unsigned long long*)(lds + LDS_BYTES);
    if (threadIdx.x == 0) TS[NPH] = __builtin_amdgcn_s_memrealtime();
    __syncthreads();
    const int K = (int)((TS[PROBE_HI] - TS[PROBE_LO]) / 100ull);
    int t2 = threadIdx.x; asm volatile("" : "+v"(t2));
    for (int i = t2; i < K && i < 16000; i += 512) P.out[(size_t)i * 4099] += 0.1f;
  }
#endif
}

extern "C" void kernel_launch(void* const* d_in, const int* in_sizes, int n_in, void* d_out, int out_size, void* d_ws, size_t ws_size, hipStream_t stream) {
  static int grid_blocks = 0;
  if (!grid_blocks) {
    if (n_in != 31 || out_size != MT * DM || ws_size < WS_TOTAL) { fprintf(stderr, "kernel_launch: unexpected shapes n_in %d out %d ws %zu (need %zu)\n", n_in, out_size, ws_size, WS_TOTAL); return; }
    if (hipFuncSetAttribute((const void*)mega_fwd, hipFuncAttributeMaxDynamicSharedMemorySize, LDS_BYTES + 256) != hipSuccess) { fprintf(stderr, "kernel_launch: hipFuncSetAttribute failed\n"); return; }
    int dev = 0, cus = 0, per_cu = 0;
    hipGetDevice(&dev);
    hipDeviceGetAttribute(&cus, hipDeviceAttributeMultiprocessorCount, dev);
    hipOccupancyMaxActiveBlocksPerMultiprocessor(&per_cu, mega_fwd, 512, LDS_BYTES + 256);
    if (per_cu < 1) { fprintf(stderr, "kernel_launch: occupancy query returned %d\n", per_cu); per_cu = 1; }
    grid_blocks = cus;
  }
  Params p{};
  const float** pf = (const float**)&p;
  for (int i = 0; i < 31; ++i) pf[i] = (const float*)d_in[i];
  p.out = (float*)d_out; p.ws = (unsigned char*)d_ws; p.bid = 0; p.grd = 0;
#if ONE_LAUNCH
  p.ph_lo = 0; p.ph_hi = NPH;
  if (hipMemsetAsync((char*)d_ws + OFF_BAR, 0, 3456 * 4, stream) != hipSuccess) { fprintf(stderr, "kernel_launch: memset of barrier words failed\n"); return; }
  void* args[] = {&p};
  hipError_t e = hipLaunchCooperativeKernel((const void*)mega_fwd, dim3(grid_blocks), dim3(512), args, LDS_BYTES + 256, stream);
  if (e != hipSuccess) fprintf(stderr, "cooperative launch failed: %s (grid %d)\n", hipGetErrorString(e), grid_blocks);
#else
  for (int ph = 0; ph < NPH; ++ph) { p.ph_lo = ph; p.ph_hi = ph + 1; hipLaunchKernelGGL(mega_fwd, dim3(grid_blocks), dim3(512), LDS_BYTES + 256, stream, p); }
#endif
}
```

```cpp
#include <hip/hip_runtime.h>
#include <hip/hip_cooperative_groups.h>
#include <cstdio>
#include <cstdint>
namespace cg = cooperative_groups;

#ifndef ONE_LAUNCH
#define ONE_LAUNCH 1
#endif

#ifndef PROBE
#define PROBE 0
#endif
#define PROBE_LO 8
#define PROBE_HI 9
#define LAS __attribute__((address_space(3)))
typedef unsigned short bf16_t;
typedef short bf16x8 __attribute__((ext_vector_type(8)));
typedef short s16x4 __attribute__((ext_vector_type(4)));
typedef float f32x4 __attribute__((ext_vector_type(4)));
typedef float f32x2 __attribute__((ext_vector_type(2)));
typedef float f32x16 __attribute__((ext_vector_type(16)));
typedef unsigned u32x4 __attribute__((ext_vector_type(4)));
typedef unsigned u32x2 __attribute__((ext_vector_type(2)));

constexpr int DM = 2048, NB = 4, SEQ = 8192, CTXL = 256, MT = NB * SEQ, MC = NB * CTXL, MA = MT + MC;
constexpr int DFF = 5632, SKV = SEQ + CTXL, NMODC = 9 * DM;
constexpr int PRW_LD = 3584, SH_LD = 3072, LIN_LD = 384, LO_LD = 5120;
constexpr int LDS_BYTES = 139264;

constexpr size_t SZ_WA = (size_t)11264 * 2048 * 2, SZ_WB = (size_t)2048 * 5632 * 2;
constexpr size_t OFF_W1A = 0, OFF_W1B = OFF_W1A + SZ_WA, OFF_W2A = OFF_W1B + SZ_WB, OFF_W2B = OFF_W2A + SZ_WA;
constexpr size_t OFF_WRW = OFF_W2B + SZ_WB, OFF_WQKVG = OFF_WRW + (size_t)3584 * 2048 * 2, OFF_WOA = OFF_WQKVG + (size_t)7168 * 2048 * 2;
constexpr size_t OFF_WOR = OFF_WOA + (size_t)2048 * 2048 * 2, OFF_WOUT = OFF_WOR + (size_t)2048 * 1024 * 2, OFF_WLORA = OFF_WOUT + (size_t)2048 * 2048 * 2;
constexpr size_t OFF_MOD = OFF_WLORA + (size_t)5120 * 384 * 2, OFF_CX = OFF_MOD + (size_t)5 * NMODC * 4, OFF_H = OFF_CX + (size_t)MC * DM * 4;
constexpr size_t OFF_BIG = OFF_H + (size_t)MA * DM * 2;
constexpr size_t SZ_KV = (size_t)NB * SKV * 512 * 2;
constexpr size_t OFF_KB = OFF_W1A, OFF_VB = OFF_KB + SZ_KV;
static_assert(OFF_VB + SZ_KV <= OFF_W2A, "KV overlay");
constexpr size_t OFF_ACT = OFF_BIG;
constexpr size_t OFF_PART = OFF_ACT + (size_t)MA * DFF * 2;
constexpr size_t OFF_PRW = OFF_BIG, OFF_LO = OFF_BIG, OFF_SH = OFF_LO + (size_t)MA * LO_LD * 2, OFF_LIN = OFF_SH + (size_t)MA * SH_LD * 2, OFF_Y = OFF_LIN;
constexpr size_t OFF_Q = OFF_BIG, OFF_GA = OFF_Q + (size_t)MT * DM * 2, OFF_GR = OFF_GA + (size_t)MT * DM * 2;
constexpr size_t END_A = OFF_ACT + (size_t)MA * DFF * 2, END_B = OFF_Y + (size_t)2 * MT * 1024 * 2, END_C = OFF_LIN + (size_t)MA * LIN_LD * 2;
constexpr size_t WS_END = END_A > END_B ? (END_A > END_C ? END_A : END_C) : (END_B > END_C ? END_B : END_C);
constexpr size_t OFF_BAR = (WS_END + 255) / 256 * 256, OFF_RN = OFF_BAR + 3456 * 4, WS_TOTAL = OFF_RN + (size_t)MA * 16 * 4;
static_assert((size_t)MA * PRW_LD * 2 <= (size_t)MA * LO_LD * 2, "PRW under LO");
static_assert(OFF_GR + (size_t)MT * DM * 2 <= OFF_Y, "GR below RWO");

struct Params {
  const float *x, *c, *ctx, *c_ctx, *w_mod, *b_mod, *norm_ffn1, *ffn1_w_in, *ffn1_w_out, *norm_mix, *w_in, *q_norm, *k_norm, *rwkv_mu, *w0, *w2, *a0, *a2,
      *g2, *k_k, *k_a, *r_k, *ln_x_w, *ln_x_b, *w_oa, *w_or, *w_out, *norm_ffn2, *ffn2_w_in, *ffn2_w_out, *norm_final;
  float* out; unsigned char* ws; int ph_lo, ph_hi; int bid, grd;
};

__device__ __forceinline__ unsigned cvt_pk_bf16(float lo, float hi) { unsigned r; asm("v_cvt_pk_bf16_f32 %0, %1, %2" : "=v"(r) : "v"(lo), "v"(hi)); return r; }
__device__ __forceinline__ float bf2f(unsigned short b) { return __uint_as_float(((unsigned)b) << 16); }
__device__ __forceinline__ float bflo(unsigned w) { return __uint_as_float(w << 16); }
__device__ __forceinline__ float bfhi(unsigned w) { return __uint_as_float(w & 0xffff0000u); }
__device__ __forceinline__ unsigned short f2bf(float f) { return (unsigned short)(cvt_pk_bf16(f, 0.f) & 0xffffu); }
__device__ __forceinline__ float sigmoidf_(float x) { return __builtin_amdgcn_rcpf(1.f + __builtin_amdgcn_exp2f(-1.4426950408889634f * x)); }
template <int CTRL> __device__ __forceinline__ float dpp_mov(float x) { return __int_as_float(__builtin_amdgcn_update_dpp(0, __float_as_int(x), CTRL, 0xF, 0xF, true)); }
__device__ __forceinline__ float allred16(float x) {
  x += dpp_mov<0xB1>(x); x += dpp_mov<0x4E>(x); x += dpp_mov<0x141>(x); x += dpp_mov<0x140>(x); return x;
}

__device__ __forceinline__ float wave_sum(float v) {
  v = allred16(v);
  { auto rr = __builtin_amdgcn_permlane16_swap(__float_as_uint(v), __float_as_uint(v), false, false); v = __uint_as_float(rr[0]) + __uint_as_float(rr[1]); }
  { auto rr = __builtin_amdgcn_permlane32_swap(__float_as_uint(v), __float_as_uint(v), false, false); v = __uint_as_float(rr[0]) + __uint_as_float(rr[1]); }
  return v;
}

__device__ __forceinline__ float allred8(float x) { x += dpp_mov<0xB1>(x); x += dpp_mov<0x4E>(x); x += dpp_mov<0x141>(x); return x; }
constexpr int BM = 256, BK = 64, HALF = 128, HTB = HALF * BK * 2;
__device__ __forceinline__ int lds_byte(int r, int c) { const int st = (r >> 4) * 2 + (c >> 5), rr = r & 15, cc = c & 31, ob = rr * 64 + cc * 2; return st * 1024 + (ob ^ (((ob >> 9) & 1) << 5)); }
__device__ __forceinline__ void stage_rc(int b, int& R, int& C) { const int st = b / 1024, sb = b % 1024, swz = sb ^ (((sb >> 9) & 1) << 5); R = (st >> 1) * 16 + swz / 64; C = (st & 1) * 32 + (swz % 64) / 2; }
__device__ __forceinline__ int perm32(int rho) { const int n = rho >> 4, i = rho & 15; return 8 * (i >> 2) + 4 * n + (i & 3); }

enum { M_SWIGLU = 0, M_RESID = 1, M_RW = 2, M_QKVG = 3, M_LORA = 4, M_T1 = 5, M_M = 6 };
struct Unit { const char* A; const char* B; int pm, pn, seg, nt; };
struct GemmDesc {
  int K, mode, G, c;
  const bf16_t *A0, *B0; int pm00, nM0, nN0, n0;
  const bf16_t *A1, *B1; int pm01, nN1, n1;
  int a_tiled;
  int nt0, nt1, ksplit1;
  const float* xin; int gidx; float gscale;
  bf16_t* act;
};
__device__ __forceinline__ bool sched_next(const GemmDesc& d, int i, Unit& u) {
  long L = (long)i * d.G + d.c;
  if (L < d.n0) {
    int wgid = (int)L; const int nwg = d.n0;
    { const int q = nwg / 8, r = nwg % 8, xcd = wgid % 8, off = wgid / 8; wgid = (xcd < r ? xcd * (q + 1) : r * (q + 1) + (xcd - r) * q) + off; }
    const int nig = 8 * d.nN0, gid = wgid / nig, fm = gid * 8, gsz = (d.nM0 - fm) < 8 ? (d.nM0 - fm) : 8;
    const int pm = fm + ((wgid % nig) % gsz), pn = (wgid % nig) / gsz;
    u.pm = d.pm00 + pm; u.pn = pn; u.seg = 0; u.nt = d.nt0;
    u.A = (const char*)d.A0 + (size_t)u.pm * 512 * d.K; u.B = (const char*)d.B0 + (size_t)pn * 512 * d.K;
    if (d.mode == M_LORA) { const int ko = (pn < 8 ? 0 : (pn < 16 ? 128 : 256)) * 2; u.A += ko; u.B += ko; }
    return true;
  }
  L -= d.n0;
  if (L < d.n1) {
    const int sp = (int)L % d.ksplit1, l2 = (int)L / d.ksplit1;
    const int pm = l2 / d.nN1, pn = l2 % d.nN1; u.pm = d.pm01 + pm; u.pn = pn; u.seg = 1 + sp; u.nt = d.nt1;
    const size_t ko = (size_t)sp * d.nt1 * 128, koA = d.a_tiled ? (size_t)sp * d.nt1 * 32768 : ko;
    u.A = (const char*)d.A1 + (size_t)u.pm * 512 * d.K + koA; u.B = (const char*)d.B1 + (size_t)pn * 512 * d.K + ko; return true;
  }
  return false;
}

__device__ __forceinline__ void gemm_epilogue(const f32x4 (&acc)[2][2][4][2], const Unit& u, const GemmDesc& d, const Params& P, int wr, int wc, int fr, int fq) {
  unsigned char* ws = P.ws;
  asm volatile("" : "+v"(fr), "+v"(fq));
  const int rl0 = wr * 64 + fr, cl0 = wc * 32 + 8 * fq;
  switch (d.mode) {
  case M_SWIGLU: {
    bf16_t* base = d.act + ((size_t)(u.pm * 88 + u.pn * 2 + (cl0 >> 6)) * 256) * 64 + (cl0 & 63);
#pragma unroll
    for (int ai = 0; ai < 2; ++ai)
#pragma unroll
      for (int m = 0; m < 4; ++m) {
        const int row = rl0 + 128 * ai + 16 * m;
        float o[8];
#pragma unroll
        for (int n = 0; n < 2; ++n)
#pragma unroll
          for (int j = 0; j < 4; ++j) { const float g = acc[ai][0][m][n][j], up = acc[ai][1][m][n][j]; o[4 * n + j] = g * sigmoidf_(g) * up; }
        u32x4 w; w.x = cvt_pk_bf16(o[0], o[1]); w.y = cvt_pk_bf16(o[2], o[3]); w.z = cvt_pk_bf16(o[4], o[5]); w.w = cvt_pk_bf16(o[6], o[7]);
        *(u32x4*)(base + (size_t)row * 64) = w;
      }
  } break;
  case M_RESID: {
    if (u.seg >= 1) {
      float* po = (float*)(ws + OFF_PART) + (size_t)(u.seg - 1) * MC * DM + (size_t)(u.pm - 128) * 256 * DM + u.pn * 256 + cl0;
#pragma unroll
      for (int ai = 0; ai < 2; ++ai)
#pragma unroll
        for (int m = 0; m < 4; ++m)
#pragma unroll
          for (int bj = 0; bj < 2; ++bj)
#pragma unroll
            for (int n = 0; n < 2; ++n) *(f32x4*)(po + (size_t)(rl0 + 128 * ai + 16 * m) * DM + 128 * bj + 4 * n) = acc[ai][bj][m][n];
      break;
    }
    const bool isc = u.pm >= 128; const int b = isc ? 4 : (u.pm >> 5);
    const float* xin = isc ? P.ctx + (size_t)(u.pm - 128) * 256 * DM : d.xin + (size_t)u.pm * 256 * DM;
    float* xo = isc ? (float*)(ws + OFF_CX) + (size_t)(u.pm - 128) * 256 * DM : P.out + (size_t)u.pm * 256 * DM;
    const float* gate = (const float*)(ws + OFF_MOD) + b * NMODC + d.gidx * DM + u.pn * 256 + cl0;
    f32x4 g4[2][2];
#pragma unroll
    for (int bj = 0; bj < 2; ++bj)
#pragma unroll
      for (int n = 0; n < 2; ++n) g4[bj][n] = *(const f32x4*)(gate + 128 * bj + 4 * n) * d.gscale;
#pragma unroll
    for (int ai = 0; ai < 2; ++ai)
#pragma unroll
      for (int m = 0; m < 4; ++m) {
        const size_t ro = (size_t)(rl0 + 128 * ai + 16 * m) * DM + u.pn * 256 + cl0;
#pragma unroll
        for (int bj = 0; bj < 2; ++bj)
#pragma unroll
          for (int n = 0; n < 2; ++n) {
            const f32x4 xv = *(const f32x4*)(xin + ro + 128 * bj + 4 * n);
            *(f32x4*)(xo + ro + 128 * bj + 4 * n) = xv + g4[bj][n] * acc[ai][bj][m][n];
          }
      }
  } break;
  case M_RW: case M_QKVG: case M_LORA: {
    bf16_t* base; int ld; int act = 0; const float* bias = nullptr;
    if (d.mode == M_RW) {
      if (u.seg == 0) { base = (bf16_t*)(ws + OFF_PRW) + (size_t)u.pm * 256 * PRW_LD + u.pn * 256; ld = PRW_LD; }
      else { const int b = u.pm - 128; base = (bf16_t*)(ws + (u.pn < 2 ? OFF_KB : OFF_VB)) + (size_t)(b * SKV + SEQ) * 512 + (u.pn & 1) * 256; ld = 512; }
    } else if (d.mode == M_QKVG) {
      const int b = u.pm >> 5;
      if (u.pn < 8) { base = (bf16_t*)(ws + OFF_Q) + (size_t)u.pm * 256 * DM + u.pn * 256; ld = DM; }
      else if (u.pn < 12) { base = (bf16_t*)(ws + (u.pn < 10 ? OFF_KB : OFF_VB)) + (size_t)(u.pm * 256 + b * CTXL) * 512 + (u.pn & 1) * 256; ld = 512; }
      else { base = (bf16_t*)(ws + (u.pn < 20 ? OFF_GA : OFF_GR)) + (size_t)u.pm * 256 * DM + ((u.pn - 12) & 7) * 256; ld = DM; act = 1; }
    } else {
      base = (bf16_t*)(ws + OFF_LO) + (size_t)u.pm * 256 * LO_LD + u.pn * 256; ld = LO_LD;
      if (u.pn < 8) { act = 2; bias = P.w0 + u.pn * 256; } else if (u.pn < 16) { act = 1; bias = P.a0 + (u.pn - 8) * 256; }
    }
#pragma unroll
    for (int bj = 0; bj < 2; ++bj) {
      f32x4 b0 = {0.f, 0.f, 0.f, 0.f}, b1 = {0.f, 0.f, 0.f, 0.f};
      if (bias) { b0 = *(const f32x4*)(bias + 128 * bj + cl0); b1 = *(const f32x4*)(bias + 128 * bj + cl0 + 4); }
#pragma unroll
      for (int ai = 0; ai < 2; ++ai)
#pragma unroll
        for (int m = 0; m < 4; ++m) {
          const int row = rl0 + 128 * ai + 16 * m;
          f32x4 v0 = acc[ai][bj][m][0] + b0, v1 = acc[ai][bj][m][1] + b1;
          if (act) {
            const float sc = act == 2 ? 0.60653065971263342f * 1.4426950408889634f : 1.f;
#pragma unroll
            for (int j = 0; j < 4; ++j) { v0[j] = sc * sigmoidf_(v0[j]); v1[j] = sc * sigmoidf_(v1[j]); }
          }
          u32x4 w; w.x = cvt_pk_bf16(v0[0], v0[1]); w.y = cvt_pk_bf16(v0[2], v0[3]); w.z = cvt_pk_bf16(v1[0], v1[1]); w.w = cvt_pk_bf16(v1[2], v1[3]);
          *(u32x4*)(base + (size_t)row * ld + 128 * bj + cl0) = w;
        }
    }
  } break;
  case M_T1: case M_M: {
    bf16_t* ga = (bf16_t*)(ws + OFF_GA) + (size_t)u.pm * 256 * DM + u.pn * 256 + cl0;
    bf16_t* gr = (bf16_t*)(ws + OFF_GR) + (size_t)u.pm * 256 * DM + u.pn * 256 + cl0;
    const bool isM = d.mode == M_M;
#pragma unroll
    for (int ai = 0; ai < 2; ++ai)
#pragma unroll
      for (int m = 0; m < 4; ++m)
#pragma unroll
        for (int bj = 0; bj < 2; ++bj) {
          const size_t o = (size_t)(rl0 + 128 * ai + 16 * m) * DM + 128 * bj;
          const f32x4 v0 = acc[ai][bj][m][0], v1 = acc[ai][bj][m][1];
          const u32x4 a = *(const u32x4*)(ga + o);
          u32x4 w;
          if (!isM) {
            w.x = cvt_pk_bf16(bflo(a.x) * v0[0], bfhi(a.x) * v0[1]); w.y = cvt_pk_bf16(bflo(a.y) * v0[2], bfhi(a.y) * v0[3]);
            w.z = cvt_pk_bf16(bflo(a.z) * v1[0], bfhi(a.z) * v1[1]); w.w = cvt_pk_bf16(bflo(a.w) * v1[2], bfhi(a.w) * v1[3]);
            *(u32x4*)(ga + o) = w;
          } else {
            const u32x4 g = *(const u32x4*)(gr + o);
            w.x = cvt_pk_bf16(bflo(a.x) + bflo(g.x) * v0[0], bfhi(a.x) + bfhi(g.x) * v0[1]); w.y = cvt_pk_bf16(bflo(a.y) + bflo(g.y) * v0[2], bfhi(a.y) + bfhi(g.y) * v0[3]);
            w.z = cvt_pk_bf16(bflo(a.z) + bflo(g.z) * v1[0], bfhi(a.z) + bfhi(g.z) * v1[1]); w.w = cvt_pk_bf16(bflo(a.w) + bflo(g.w) * v1[2], bfhi(a.w) + bfhi(g.w) * v1[3]);
            *(u32x4*)(gr + o) = w;
          }
        }
  } break;
  }
}

__device__ __forceinline__ void gemm_phase(LAS unsigned char* lds, const GemmDesc& d, const Params& P, const int tid) {
  const int wid = __builtin_amdgcn_readfirstlane(tid >> 6), lane = tid & 63, wr = wid >> 2, wc = wid & 3, fr = lane & 15, fq = lane >> 4;
  const int K = d.K;
  unsigned voffA[2], voffB[2];
#pragma unroll
  for (int i = 0; i < 2; ++i) { int R, C; stage_rc(tid * 16 + i * 8192, R, C); const int Rb = (R & ~31) + perm32(R & 31);
    voffA[i] = d.a_tiled ? (unsigned)(R * 64 + C) * 2u : (unsigned)(R * K + C) * 2u; voffB[i] = (unsigned)(Rb * K + C) * 2u; }
  const size_t kstep = (size_t)(BK * 2);
  const size_t hstep = (size_t)HALF * K * 2;
  const size_t kstepA = d.a_tiled ? (size_t)32768 : kstep, hstepA = d.a_tiled ? (size_t)16384 : hstep;
  const unsigned ldsw = (unsigned)wid * 1024u;
  const int aoff = lds_byte(wr * 64 + fr, fq * 8), boff = lds_byte(wc * 32 + fr, fq * 8);
#define PG8_SA(b, h) (((b) * 2 + (h)) * HTB)
#define PG8_SB(b, h) ((4 + (b) * 2 + (h)) * HTB)
#define PG8_STAGE(bufoff, gbase, voff) do { _Pragma("unroll") for (int _i = 0; _i < 2; ++_i) \
    __builtin_amdgcn_global_load_lds((const unsigned*)((const char*)(gbase) + (voff)[_i]), (LAS unsigned*)(lds + (bufoff) + ldsw + _i * 8192), 16, 0, 0); } while (0)
#define PG8_LDA(dst, b, h) do { _Pragma("unroll") for (int m = 0; m < 4; ++m) _Pragma("unroll") for (int k = 0; k < 2; ++k) dst[m][k] = *(const LAS bf16x8*)(lds + PG8_SA(b, h) + aoff + m * 2048 + k * 1024); } while (0)
#define PG8_LDB(dst, b, h) do { _Pragma("unroll") for (int n = 0; n < 2; ++n) _Pragma("unroll") for (int k = 0; k < 2; ++k) dst[n][k] = *(const LAS bf16x8*)(lds + PG8_SB(b, h) + boff + n * 2048 + k * 1024); } while (0)
#define PG8_MMA(ai, bj, At, Bt) do { __builtin_amdgcn_s_setprio(1); _Pragma("unroll") for (int m = 0; m < 4; ++m) _Pragma("unroll") for (int n = 0; n < 2; ++n) _Pragma("unroll") for (int k = 0; k < 2; ++k) \
    acc[ai][bj][m][n] = __builtin_amdgcn_mfma_f32_16x16x32_bf16(Bt[n][k], At[m][k], acc[ai][bj][m][n], 0, 0, 0); __builtin_amdgcn_s_setprio(0); } while (0)
#define PG8_WAIT_V(n) asm volatile("s_waitcnt vmcnt(" #n ")" ::: "memory")
#define PG8_WAIT_L(n) asm volatile("s_waitcnt lgkmcnt(" #n ")" ::: "memory")
#define PG8_BAR __builtin_amdgcn_s_barrier()
#define PG8_SCHED __builtin_amdgcn_sched_barrier(0)
  Unit cur, nxt; int ui = 0;
  if (!sched_next(d, 0, cur)) return;
  f32x4 acc[2][2][4][2];
#pragma unroll
  for (int a = 0; a < 2; ++a)
#pragma unroll
    for (int b = 0; b < 2; ++b)
#pragma unroll
      for (int m = 0; m < 4; ++m)
#pragma unroll
        for (int n = 0; n < 2; ++n) acc[a][b][m][n] = (f32x4){0.f, 0.f, 0.f, 0.f};
  bf16x8 At[4][2], B0[2][2], B1[2][2];
  const char* cA = cur.A; const char* cB = cur.B;
  PG8_STAGE(PG8_SB(0, 0), cB, voffB); PG8_STAGE(PG8_SB(0, 1), cB + hstep, voffB); PG8_STAGE(PG8_SA(0, 0), cA, voffA); PG8_STAGE(PG8_SA(0, 1), cA + hstepA, voffA);
  if (wr == 1) PG8_BAR;
  PG8_WAIT_V(2); PG8_BAR;
  PG8_STAGE(PG8_SB(1, 0), cB + kstep, voffB); PG8_STAGE(PG8_SA(1, 0), cA + kstepA, voffA); PG8_STAGE(PG8_SB(1, 1), cB + hstep + kstep, voffB);
  PG8_WAIT_V(6); PG8_BAR;
  for (;;) {
    const bool has_next = sched_next(d, ui + 1, nxt);
    const char* nA = has_next ? nxt.A : cA; const char* nB = has_next ? nxt.B : cB;
    const int nt = cur.nt;
    for (int t = 0; t < nt; t += 2) {
      const bool last = (t == nt - 2);
      const char* a1 = cA + (size_t)(t + 1) * kstepA;
      const char* a2 = last ? nA : cA + (size_t)(t + 2) * kstepA; const char* b2 = last ? nB : cB + (size_t)(t + 2) * kstep;
      const char* a3 = a2 + kstepA; const char* b3 = b2 + kstep;
      PG8_LDB(B0, 0, 0); PG8_LDB(B1, 0, 1); PG8_SCHED; PG8_LDA(At, 0, 0); PG8_STAGE(PG8_SA(1, 1), a1 + hstepA, voffA);
      PG8_WAIT_V(8); PG8_WAIT_L(0); PG8_BAR; PG8_MMA(0, 0, At, B0); PG8_MMA(0, 1, At, B1); PG8_BAR; PG8_SCHED;
      PG8_LDA(At, 0, 1); PG8_STAGE(PG8_SB(0, 0), b2, voffB); PG8_STAGE(PG8_SB(0, 1), b2 + hstep, voffB); PG8_STAGE(PG8_SA(0, 0), a2, voffA);
      PG8_WAIT_V(8); PG8_WAIT_L(0); PG8_BAR; PG8_MMA(1, 0, At, B0); PG8_MMA(1, 1, At, B1); PG8_BAR; PG8_SCHED;
      PG8_LDB(B0, 1, 0); PG8_LDB(B1, 1, 1); PG8_SCHED; PG8_LDA(At, 1, 0); PG8_STAGE(PG8_SA(0, 1), a2 + hstepA, voffA);
      PG8_WAIT_V(8); PG8_WAIT_L(0); PG8_BAR; PG8_MMA(0, 0, At, B0); PG8_MMA(0, 1, At, B1); PG8_BAR; PG8_SCHED;
      PG8_LDA(At, 1, 1); PG8_STAGE(PG8_SB(1, 0), b3, voffB); PG8_STAGE(PG8_SB(1, 1), b3 + hstep, voffB); PG8_STAGE(PG8_SA(1, 0), a3, voffA);
      PG8_WAIT_V(8); PG8_WAIT_L(0); PG8_BAR; PG8_MMA(1, 0, At, B0); PG8_MMA(1, 1, At, B1); PG8_BAR; PG8_SCHED;
    }
    if (wr == 0) PG8_BAR;
    gemm_epilogue(acc, cur, d, P, wr, wc, fr, fq);
    if (!has_next) break;
#pragma unroll
    for (int a = 0; a < 2; ++a)
#pragma unroll
      for (int b = 0; b < 2; ++b)
#pragma unroll
        for (int m = 0; m < 4; ++m)
#pragma unroll
          for (int n = 0; n < 2; ++n) acc[a][b][m][n] = (f32x4){0.f, 0.f, 0.f, 0.f};
    cur = nxt; cA = nA; cB = nB; ++ui;
    if (wr == 1) PG8_BAR;
  }
  PG8_WAIT_V(0);
  PG8_BAR;
#undef PG8_SA
#undef PG8_SB
#undef PG8_STAGE
#undef PG8_LDA
#undef PG8_LDB
#undef PG8_MMA
#undef PG8_WAIT_V
#undef PG8_WAIT_L
#undef PG8_BAR
#undef PG8_SCHED
}

namespace att {
constexpr int D = 128, NW = 8, QBLK = 32, KVBLK = 64;
constexpr float SCALE = 0.088388347648318440f;
constexpr float THR = 8.f;
constexpr int LDQ = 2048, LDK = 512, LDO = 2048;
constexpr size_t SHM_V = KVBLK * D * 2, SHM_K = KVBLK * D * 2;
#define KSWZ(row, colB) ((row) * 256 + ((colB) ^ (((row) & 7) << 4)))
#define SBAR() __builtin_amdgcn_sched_barrier(0)
__device__ __forceinline__ int crow(int r, int hi) { return (r & 3) + 8 * (r >> 2) + 4 * hi; }
__device__ __forceinline__ unsigned cvtpk(float lo, float hi) { unsigned r; asm volatile("v_cvt_pk_bf16_f32 %0, %1, %2" : "=v"(r) : "v"(lo), "v"(hi)); return r; }
__device__ __forceinline__ void partialSM(f32x16& p0, f32x16& p1, float& m_reg, float& mn, float& alpha) {
  constexpr float C = SCALE * 1.4426950408889634f;
  float pmax = p0[0];
#pragma unroll
  for (int r = 1; r < 16; ++r) pmax = fmaxf(pmax, p0[r]);
#pragma unroll
  for (int r = 0; r < 16; ++r) pmax = fmaxf(pmax, p1[r]);
  { auto rr = __builtin_amdgcn_permlane32_swap(__float_as_uint(pmax), __float_as_uint(pmax), false, false);
    pmax = fmaxf(__uint_as_float(rr[0]), __uint_as_float(rr[1])); }
  if (__builtin_expect(__all(pmax - m_reg <= THR / SCALE), 1)) { mn = m_reg; alpha = 1.f; }
  else { mn = fmaxf(m_reg, pmax); alpha = __builtin_amdgcn_exp2f((m_reg - mn) * C); m_reg = mn; }
  float mnC = -mn * C;
#pragma unroll
  for (int r = 0; r < 16; ++r) p0[r] = fmaf(p0[r], C, mnC);
#pragma unroll
  for (int r = 0; r < 16; ++r) p1[r] = fmaf(p1[r], C, mnC);
#pragma unroll
  for (int r = 0; r < 16; ++r) p0[r] = __builtin_amdgcn_exp2f(p0[r]);
}
__device__ __forceinline__ void finishSM(f32x16& p0, f32x16& p1, float alpha, float& l_reg, bf16x8& pa0, bf16x8& pa1, bf16x8& pa2, bf16x8& pa3) {
#pragma unroll
  for (int r = 0; r < 16; ++r) p1[r] = __builtin_amdgcn_exp2f(p1[r]);
  float ps = 0;
#pragma unroll
  for (int r = 0; r < 16; ++r) ps += p0[r];
#pragma unroll
  for (int r = 0; r < 16; ++r) ps += p1[r];
  { auto rr = __builtin_amdgcn_permlane32_swap(__float_as_uint(ps), __float_as_uint(ps), false, false);
    ps = __uint_as_float(rr[0]) + __uint_as_float(rr[1]); }
  l_reg = l_reg * alpha + ps;
#define PK4(P, BASE, OUT) do { unsigned a0 = cvtpk(P[BASE + 0], P[BASE + 1]), a1 = cvtpk(P[BASE + 2], P[BASE + 3]);   \
    unsigned b0 = cvtpk(P[BASE + 4], P[BASE + 5]), b1 = cvtpk(P[BASE + 6], P[BASE + 7]);                              \
    auto r0 = __builtin_amdgcn_permlane32_swap(a0, b0, false, false); auto r1 = __builtin_amdgcn_permlane32_swap(a1, b1, false, false); \
    u32x4 w = {r0[0], r1[0], r0[1], r1[1]}; OUT = *reinterpret_cast<bf16x8*>(&w); } while (0)
  PK4(p0, 0, pa0); PK4(p0, 8, pa1); PK4(p1, 0, pa2); PK4(p1, 8, pa3);
#undef PK4
}
__device__ __forceinline__ void qkt(f32x16& p0, f32x16& p1, const bf16_t* Ks, const bf16x8* qr, int r32, int hi) {
  p0 = f32x16{}; p1 = f32x16{};
#pragma unroll
  for (int d0 = 0; d0 < 8; ++d0) { int cb = (d0 * 16 + hi * 8) * 2;
    bf16x8 b0 = *reinterpret_cast<const bf16x8*>((const char*)Ks + KSWZ(r32, cb));
    bf16x8 b1 = *reinterpret_cast<const bf16x8*>((const char*)Ks + KSWZ(32 + r32, cb));
    p0 = __builtin_amdgcn_mfma_f32_32x32x16_bf16(b0, qr[d0], p0, 0, 0, 0);
    p1 = __builtin_amdgcn_mfma_f32_32x32x16_bf16(b1, qr[d0], p1, 0, 0, 0); }
}
__device__ __forceinline__ int v_st(int k, int c) { const int kk = (k & ~0xC) | ((k & 4) << 1) | ((k & 8) >> 1); return ((kk >> 3) * 4 + (c >> 5)) * 512 + ((kk & 7) * 32 + (c & 31)) * 2; }
__device__ __forceinline__ int v_rd_base(int lane) { return ((lane & 3) << 3) | (((lane >> 2) & 3) << 6) | (((lane >> 4) & 1) << 5) | (((lane >> 5) & 1) << 8); }
constexpr int v_rd_off(int d0, int ks, int half) { return d0 * 512 + ks * 4096 + half * 2048; }
template <int OFF> __device__ __forceinline__ s16x4 tr_read(int vb) {
  s16x4 r; asm volatile("ds_read_b64_tr_b16 %0, %1 offset:%2" : "=&v"(r) : "v"(vb), "i"(OFF) : "memory"); return r;
}
template <int D0> __device__ __forceinline__ void pv_one(f32x16& od, int vb, bf16x8 pa0, bf16x8 pa1, bf16x8 pa2, bf16x8 pa3) {
  const s16x4 l0 = tr_read<v_rd_off(D0, 0, 0)>(vb), h0 = tr_read<v_rd_off(D0, 0, 1)>(vb), l1 = tr_read<v_rd_off(D0, 1, 0)>(vb), h1 = tr_read<v_rd_off(D0, 1, 1)>(vb);
  const s16x4 l2 = tr_read<v_rd_off(D0, 2, 0)>(vb), h2 = tr_read<v_rd_off(D0, 2, 1)>(vb), l3 = tr_read<v_rd_off(D0, 3, 0)>(vb), h3 = tr_read<v_rd_off(D0, 3, 1)>(vb);
  asm volatile("s_waitcnt lgkmcnt(0)" ::: "memory"); SBAR();
#define PK(L, H) (bf16x8){L[0], L[1], L[2], L[3], H[0], H[1], H[2], H[3]}
  od = __builtin_amdgcn_mfma_f32_32x32x16_bf16(pa0, PK(l0, h0), od, 0, 0, 0);
  od = __builtin_amdgcn_mfma_f32_32x32x16_bf16(pa1, PK(l1, h1), od, 0, 0, 0);
  od = __builtin_amdgcn_mfma_f32_32x32x16_bf16(pa2, PK(l2, h2), od, 0, 0, 0);
  od = __builtin_amdgcn_mfma_f32_32x32x16_bf16(pa3, PK(l3, h3), od, 0, 0, 0);
#undef PK
}
__device__ __forceinline__ void pv_d0(f32x16* o, int vb, bf16x8 pa0, bf16x8 pa1, bf16x8 pa2, bf16x8 pa3) {
  pv_one<0>(o[0], vb, pa0, pa1, pa2, pa3); pv_one<1>(o[1], vb, pa0, pa1, pa2, pa3); pv_one<2>(o[2], vb, pa0, pa1, pa2, pa3); pv_one<3>(o[3], vb, pa0, pa1, pa2, pa3);
}
__device__ __forceinline__ void attn_dense_body(const bf16_t* __restrict__ Qb, const bf16_t* __restrict__ Kh, const bf16_t* __restrict__ Vh,
                                                bf16_t* __restrict__ Ob, int seq, char* lds, const int tid) {
  const int wid = tid >> 6, lane = tid & 63, r32 = lane & 31, hi = lane >> 5;
  bf16_t* V_lds = (bf16_t*)lds; bf16_t* K_lds = (bf16_t*)(lds + 2 * SHM_V);
  float* wsf = (float*)(lds + 2 * SHM_V + 2 * SHM_K) + wid * 64; float* li_l = wsf; float* al_l = wsf + 32;
  float m_reg = -1e30f, l_reg = 0; f32x16 o[4] = {}; bf16x8 qr[8];
  const bf16_t* Qw = Qb + (long)(wid * QBLK + r32) * LDQ + hi * 8;
#pragma unroll
  for (int d0 = 0; d0 < 8; ++d0) qr[d0] = *reinterpret_cast<const bf16x8*>(Qw + d0 * 16);
  const int sr = tid >> 4, sc = (tid & 15) * 8, vst0 = v_st(sr, sc), vst1 = v_st(32 + sr, sc);
  const int vb0 = (int)(uintptr_t)V_lds + v_rd_base(lane);
  struct { bf16x8 vs0, vs1, ks0, ks1; } sr_[2];
#define LD8(p) (*reinterpret_cast<const bf16x8*>(p))
  const unsigned voff = (unsigned)(sr * LDK + sc) * 2u;
#define SLOAD(i, k0) do { const char* vb_ = (const char*)(Vh + (size_t)(k0) * LDK); const char* kb_ = (const char*)(Kh + (size_t)(k0) * LDK); \
    sr_[i].vs0 = LD8(vb_ + voff); sr_[i].vs1 = LD8(vb_ + 32 * LDK * 2 + voff); sr_[i].ks0 = LD8(kb_ + voff); sr_[i].ks1 = LD8(kb_ + 32 * LDK * 2 + voff); } while (0)
#define SWRITE(b, i) do { *(bf16x8*)((char*)V_lds + (b) * SHM_V + vst0) = sr_[i].vs0;          \
    *(bf16x8*)((char*)V_lds + (b) * SHM_V + vst1) = sr_[i].vs1; int kc = sc * 2;               \
    *(bf16x8*)((char*)K_lds + (b) * SHM_K + KSWZ(sr, kc)) = sr_[i].ks0;                       \
    *(bf16x8*)((char*)K_lds + (b) * SHM_K + KSWZ(32 + sr, kc)) = sr_[i].ks1; } while (0)
#define SWAIT() asm volatile("s_waitcnt vmcnt(4)" ::: "memory")
#define RESC(a) do { if (__any((a) < 1.f)) { if (hi == 0) al_l[r32] = (a); asm volatile("s_waitcnt lgkmcnt(0)" ::: "memory"); \
    _Pragma("unroll") for (int d = 0; d < 4; ++d) _Pragma("unroll") for (int r = 0; r < 16; ++r) o[d][r] *= al_l[crow(r, hi)]; } } while (0)
  f32x16 pA0, pA1, pB0, pB1; float mnA, mnB, alA, alB; bf16x8 pa0, pa1, pa2, pa3; const int NT = seq / KVBLK;
  constexpr int SE = 0, SO = 1;
  SLOAD(SE, 0); asm volatile("s_waitcnt vmcnt(0)" ::: "memory"); SWRITE(0, SE); __syncthreads();
  qkt(pA0, pA1, K_lds, qr, r32, hi); partialSM(pA0, pA1, m_reg, mnA, alA);
  SLOAD(SO, KVBLK); if (2 < NT) SLOAD(SE, 2 * KVBLK);
  SWAIT(); SWRITE(1, SO); __syncthreads();
  for (int j = 1; j + 1 < NT; j += 2) {
    SBAR(); qkt(pB0, pB1, (bf16_t*)((char*)K_lds + SHM_K), qr, r32, hi);
    finishSM(pA0, pA1, alA, l_reg, pa0, pa1, pa2, pa3); SBAR();
    SLOAD(SO, (j + 2) * KVBLK); SBAR();
    pv_d0(o, vb0, pa0, pa1, pa2, pa3); partialSM(pB0, pB1, m_reg, mnB, alB);
    __syncthreads(); SWAIT(); SWRITE(0, SE);
    RESC(alB); __syncthreads();
    SBAR(); qkt(pA0, pA1, K_lds, qr, r32, hi);
    finishSM(pB0, pB1, alB, l_reg, pa0, pa1, pa2, pa3); SBAR();
    if (j + 3 < NT) SLOAD(SE, (j + 3) * KVBLK); SBAR();
    pv_d0(o, vb0 + (int)SHM_V, pa0, pa1, pa2, pa3); partialSM(pA0, pA1, m_reg, mnA, alA);
    __syncthreads(); SWAIT(); SWRITE(1, SO);
    RESC(alA); __syncthreads();
  }
  SBAR(); qkt(pB0, pB1, (bf16_t*)((char*)K_lds + SHM_K), qr, r32, hi);
  finishSM(pA0, pA1, alA, l_reg, pa0, pa1, pa2, pa3); SBAR();
  pv_d0(o, vb0, pa0, pa1, pa2, pa3); partialSM(pB0, pB1, m_reg, mnB, alB);
  __syncthreads(); RESC(alB);
  finishSM(pB0, pB1, alB, l_reg, pa0, pa1, pa2, pa3); SBAR();
  pv_d0(o, vb0 + (int)SHM_V, pa0, pa1, pa2, pa3);
  if (hi == 0) li_l[r32] = l_reg; asm volatile("s_waitcnt lgkmcnt(0)" ::: "memory");
  float rli[16];
#pragma unroll
  for (int r = 0; r < 16; ++r) rli[r] = __builtin_amdgcn_rcpf(li_l[crow(r, hi)]);
  bf16_t* Ow = Ob + (long)(wid * QBLK) * LDO;
#pragma unroll
  for (int r = 0; r < 16; ++r) { int orow = crow(r, hi);
#pragma unroll
    for (int d0 = 0; d0 < 4; ++d0) Ow[(long)orow * LDO + d0 * 32 + r32] = f2bf(o[d0][r] * rli[r]); }
#undef LD8
#undef SLOAD
#undef SWRITE
#undef SWAIT
#undef RESC
}
}

__device__ __forceinline__ void mod_phase(const Params& P, LAS unsigned char* lds, const int tid) {
  LAS float* sc = (LAS float*)lds; LAS float* red = sc + 5 * 2048;
  const int wid = tid >> 6, lane = tid & 63;
  for (int i = tid; i < 5 * 2048; i += 512) { const int j = i >> 11, k = i & 2047; const float v = (j < 4) ? P.c[j * 2048 + k] : P.c_ctx[k]; sc[i] = v * sigmoidf_(v); }
  __syncthreads();
  float* MOD = (float*)(P.ws + OFF_MOD);
  for (int task = P.bid; task < 256; task += P.grd) {
    const int n0 = task * 72 + lane * 2;
    float a0[5], a1[5];
#pragma unroll
    for (int j = 0; j < 5; ++j) { a0[j] = 0.f; a1[j] = 0.f; }
    if (lane < 36) {
      const float* wp = P.w_mod + (size_t)(wid * 256) * NMODC + n0;
#pragma unroll 16
      for (int k = 0; k < 256; ++k) {
        const f32x2 w = *(const f32x2*)(wp + (size_t)k * NMODC);
#pragma unroll
        for (int j = 0; j < 5; ++j) { const float s = sc[j * 2048 + wid * 256 + k]; a0[j] += s * w.x; a1[j] += s * w.y; }
      }
#pragma unroll
      for (int j = 0; j < 5; ++j) { red[(wid * 5 + j) * 72 + lane * 2] = a0[j]; red[(wid * 5 + j) * 72 + lane * 2 + 1] = a1[j]; }
    }
    __syncthreads();
    if (tid < 360) { const int j = tid / 72, ci = tid % 72; float s = 0.f;
#pragma unroll
      for (int w = 0; w < 8; ++w) s += red[(w * 5 + j) * 72 + ci];
      MOD[j * NMODC + task * 72 + ci] = s + P.b_mod[task * 72 + ci]; }
    __syncthreads();
  }
}
__device__ __forceinline__ void tr_load(float (&tv)[32], const float* __restrict__ W, int ldw, int k0, int n0, int lane) {
#pragma unroll
  for (int i = 0; i < 32; ++i) { const int kk = 2 * i + (lane >> 5); tv[i] = W[(size_t)(k0 + kk) * ldw + n0 + (lane & 31)]; }
}
__device__ __forceinline__ void tr_store(const float (&tv)[32], int k0, bf16_t* __restrict__ WT, int ldt, int drow0, int dk0, LAS float* scr, int lane) {
#pragma unroll
  for (int i = 0; i < 32; ++i) { const int kk = 2 * i + (lane >> 5); scr[kk * 33 + (lane & 31)] = tv[i]; }
  asm volatile("s_waitcnt lgkmcnt(0)" ::: "memory");
  const int c = lane & 7;
#pragma unroll
  for (int j = 0; j < 4; ++j) { const int n = (lane >> 3) + 8 * j; const LAS float* s = scr + (8 * c) * 33 + n;
    u32x4 o; o.x = cvt_pk_bf16(s[0 * 33], s[1 * 33]); o.y = cvt_pk_bf16(s[2 * 33], s[3 * 33]); o.z = cvt_pk_bf16(s[4 * 33], s[5 * 33]); o.w = cvt_pk_bf16(s[6 * 33], s[7 * 33]);
    *(u32x4*)(WT + (size_t)(drow0 + n) * ldt + dk0 + k0 + 8 * c) = o; }
  asm volatile("s_waitcnt lgkmcnt(0)" ::: "memory");
}
__device__ __forceinline__ void tr_item(const float* __restrict__ W, int ldw, int k0, int n0, bf16_t* __restrict__ WT, int ldt, int drow0, int dk0, LAS float* scr, int lane) {
  float tv[32]; tr_load(tv, W, ldw, k0, n0, lane); tr_store(tv, k0, WT, ldt, drow0, dk0, scr, lane);
}
constexpr int N_LATE = 16896 + 6144 + 2048 + 1024 + 2048;
__device__ __forceinline__ void late_item_addr(const Params& P, int j, const float*& W, int& ldw, int& k0, int& n0, bf16_t*& WT, int& ldt, int& drow) {
  if (j < 11264) { const int kb = j / 352, nb = j % 352; n0 = nb * 32; k0 = kb * 64; W = P.ffn2_w_in; ldw = 2 * DFF; WT = (bf16_t*)(P.ws + OFF_W2A); ldt = 2048;
    drow = n0 < DFF ? (n0 >> 7) * 256 + (n0 & 127) : ((n0 - DFF) >> 7) * 256 + 128 + ((n0 - DFF) & 127); return; }
  j -= 11264;
  if (j < 5632) { const int kb = j >> 6, nb = j & 63; n0 = nb * 32; k0 = kb * 64; W = P.ffn2_w_out; ldw = 2048; WT = (bf16_t*)(P.ws + OFF_W2B); ldt = DFF; drow = n0; return; }
  j -= 5632;
  if (j < 6144) { const int kb = j / 192, nbi = j % 192, nb = nbi < 64 ? nbi : nbi + 32;
    n0 = nb < 96 ? nb * 32 : 6528 + (nb - 96) * 32; k0 = kb * 64; W = P.w_in; ldw = 10624; WT = (bf16_t*)(P.ws + OFF_WQKVG); ldt = 2048; drow = nb * 32; return; }
  j -= 6144;
  if (j < 2048) { k0 = (j >> 6) * 64; n0 = (j & 63) * 32; W = P.w_oa; ldw = 2048; WT = (bf16_t*)(P.ws + OFF_WOA); ldt = 2048; drow = n0; return; }
  j -= 2048;
  if (j < 1024) { k0 = (j >> 6) * 64; n0 = (j & 63) * 32; W = P.w_or; ldw = 2048; WT = (bf16_t*)(P.ws + OFF_WOR); ldt = 1024; drow = n0; return; }
  j -= 1024;
  k0 = (j >> 6) * 64; n0 = (j & 63) * 32; W = P.w_out; ldw = 2048; WT = (bf16_t*)(P.ws + OFF_WOUT); ldt = 2048; drow = n0;
}
__device__ __forceinline__ void convert_phase(const Params& P, LAS unsigned char* lds, const int tid) {
  const int wid = tid >> 6, lane = tid & 63;
  LAS float* scr = (LAS float*)(lds + wid * 8704);
  unsigned char* ws = P.ws;
  bf16_t *W1A = (bf16_t*)(ws + OFF_W1A), *W1B = (bf16_t*)(ws + OFF_W1B), *W2A = (bf16_t*)(ws + OFF_W2A), *W2B = (bf16_t*)(ws + OFF_W2B);
  bf16_t *WRW = (bf16_t*)(ws + OFF_WRW), *WQKVG = (bf16_t*)(ws + OFF_WQKVG), *WOA = (bf16_t*)(ws + OFF_WOA), *WOR = (bf16_t*)(ws + OFF_WOR), *WOUT = (bf16_t*)(ws + OFF_WOUT), *WLORA = (bf16_t*)(ws + OFF_WLORA);
  const int G = P.grd, gw = P.bid * 8 + wid, NGW = G * 8;
  constexpr int NITEMS = 22528 + 11264 + 3456 + 7168 + 2048 + 1024 + 2048 + 192;
  for (int it = gw; it < NITEMS; it += NGW) {
    int r = it;
    if (r < 22528) { const int which = r >= 11264; r -= which * 11264; const int kb = r / 352, nb = r % 352, n0 = nb * 32;
      const int drow = n0 < DFF ? (n0 >> 7) * 256 + (n0 & 127) : ((n0 - DFF) >> 7) * 256 + 128 + ((n0 - DFF) & 127);
      if (!which) tr_item(P.ffn1_w_in, 2 * DFF, kb * 64, n0, W1A, 2048, drow, 0, scr, lane);
      continue; }
    r -= 22528;
    if (r < 11264) { const int which = r >= 5632; r -= which * 5632; const int kb = r >> 6, nb = r & 63;
      if (!which) tr_item(P.ffn1_w_out, 2048, kb * 64, nb * 32, W1B, DFF, nb * 32, 0, scr, lane);
      continue; }
    r -= 11264;
    if (r < 3456) { const int kb = r / 108, nb = r % 108; tr_item(P.w_in, 10624, kb * 64, 3072 + nb * 32, WRW, 2048, nb * 32, 0, scr, lane); continue; }
    r -= 3456;
    if (r < 7168) { const int kb = r / 224, nb = r % 224; const int n0 = nb < 96 ? nb * 32 : 6528 + (nb - 96) * 32;
      if (nb >= 64 && nb < 96) tr_item(P.w_in, 10624, kb * 64, n0, WQKVG, 2048, nb * 32, 0, scr, lane);
      continue; }
    r -= 7168;
    if (r < 2048) continue;
    r -= 2048;
    if (r < 1024) continue;
    r -= 1024;
    if (r < 2048) continue;
    r -= 2048;
    if (r < 64) { const int z = r >> 5, nb = r & 31; tr_item(P.w2 + (size_t)z * 64 * 1024, 1024, 0, nb * 32, WLORA, LIN_LD, z * 1024 + nb * 32, z * 64, scr, lane); continue; }
    r -= 64;
    if (r < 64) { const int z = r >> 5, nb = r & 31; tr_item(P.a2 + (size_t)z * 64 * 1024, 1024, 0, nb * 32, WLORA, LIN_LD, 2048 + z * 1024 + nb * 32, 128 + z * 64, scr, lane); continue; }
    r -= 64;
    { const int kb = r >> 5, nb = r & 31; tr_item(P.g2, 1024, kb * 64, nb * 32, WLORA, LIN_LD, 4096 + nb * 32, 256, scr, lane); }
  }
  const int gt = P.bid * 512 + tid, NT = G * 512;
  unsigned zz = 0u; asm volatile("" : "+v"(zz));
  const u32x4 z4 = {zz, zz, zz, zz};
  for (int i = gt; i < 128 * 256; i += NT) *(u32x4*)(WRW + (size_t)3456 * 2048 + (size_t)i * 8) = z4;
  for (int i = gt; i < 5120 * 48; i += NT) { const int row = i / 48, kc = (i % 48) * 8, rb = row >> 10;
    const int lo = rb < 4 ? rb * 64 : 256, hi = rb < 4 ? rb * 64 + 64 : 384;
    if (kc < lo || kc >= hi) *(u32x4*)(WLORA + (size_t)row * LIN_LD + kc) = z4; }
}
__device__ __forceinline__ void norm_mod_phase(const Params& P, const float* __restrict__ lat, const float* __restrict__ ctxp, int nrows, const float* __restrict__ g, int midx, const float* __restrict__ parts, const int tid) {
  const int wid = tid >> 6, lane = tid & 63;
  const int gw = P.bid * 8 + wid, NGW = P.grd * 8;
  const float* __restrict__ MOD = (const float*)(P.ws + OFF_MOD); bf16_t* __restrict__ H = (bf16_t*)(P.ws + OFF_H);
  for (int r = gw; r < nrows; r += NGW) {
    const float* xr = r < MT ? lat + (size_t)r * DM : ctxp + (size_t)(r - MT) * DM;
    const int b = r < MT ? (r >> 13) : 4;
    const float* sh = MOD + b * NMODC + midx * DM; const float* scp = sh + DM;
    f32x4 v[8], g4[8], s4[8], c4[8]; float ss = 0.f;
#pragma unroll
    for (int j = 0; j < 8; ++j) v[j] = *(const f32x4*)(xr + j * 256 + lane * 4);
    if (parts && r >= MT) {
      const float* pp = parts + (size_t)(r - MT) * DM; const float* gt = MOD + 4 * NMODC + 2 * DM;
#pragma unroll
      for (int j = 0; j < 8; ++j) { const int c = j * 256 + lane * 4;
        const f32x4 s = (*(const f32x4*)(pp + c) + *(const f32x4*)(pp + (size_t)MC * DM + c)) + (*(const f32x4*)(pp + (size_t)2 * MC * DM + c) + *(const f32x4*)(pp + (size_t)3 * MC * DM + c));
        v[j] = v[j] + *(const f32x4*)(gt + c) * 0.5f * s; }
    }
#pragma unroll
    for (int j = 0; j < 8; ++j) { const int c = j * 256 + lane * 4; g4[j] = *(const f32x4*)(g + c); s4[j] = *(const f32x4*)(sh + c); c4[j] = *(const f32x4*)(scp + c); }
#pragma unroll
    for (int j = 0; j < 8; ++j) ss += v[j].x * v[j].x + v[j].y * v[j].y + v[j].z * v[j].z + v[j].w * v[j].w;
    ss = wave_sum(ss);
    const float rs = rsqrtf(ss * (1.f / DM) + 1e-6f);
#pragma unroll
    for (int j = 0; j < 8; ++j) { const int c = j * 256 + lane * 4;
      const f32x4 y = v[j] * rs * g4[j]; const f32x4 h = y * (c4[j] + 1.f) + s4[j];
      u32x2 w; w.x = cvt_pk_bf16(h.x, h.y); w.y = cvt_pk_bf16(h.z, h.w);
      *(u32x2*)(H + (size_t)r * DM + c) = w; }
  }
}
__device__ __forceinline__ void shift_phase(const Params& P, const int tid) {
  const bf16_t* __restrict__ PRW = (const bf16_t*)(P.ws + OFF_PRW); bf16_t* __restrict__ SH = (bf16_t*)(P.ws + OFF_SH); bf16_t* __restrict__ LIN = (bf16_t*)(P.ws + OFF_LIN);
  const int gt = P.bid * 512 + tid, NT = P.grd * 512;
#pragma unroll 2
  for (int idx = gt; idx < MA * 432; idx += NT) {
    const int r = idx / 432, c = (idx % 432) * 8;
    bool first, last;
    if (r < MT) { const int t = r & (SEQ - 1); first = t == 0; last = t == SEQ - 1; } else { const int t = (r - MT) & (CTXL - 1); first = t == 0; last = t == CTXL - 1; }
    const u32x4 z4 = {0u, 0u, 0u, 0u};
    const u32x4 p = *(const u32x4*)(PRW + (size_t)r * PRW_LD + c);
    const u32x4 pv = first ? z4 : *(const u32x4*)(PRW + (size_t)(r - 1) * PRW_LD + c);
    const u32x4 nx = last ? z4 : *(const u32x4*)(PRW + (size_t)(r + 1) * PRW_LD + c);
    const f32x4 m0 = *(const f32x4*)(P.rwkv_mu + c), m1 = *(const f32x4*)(P.rwkv_mu + c + 4);
    float o[8];
#define SHF(e, W, MU, HI) { const float pp = HI ? bfhi(p.W) : bflo(p.W), a = HI ? bfhi(pv.W) : bflo(pv.W), b = HI ? bfhi(nx.W) : bflo(nx.W); o[e] = pp + MU * (0.5f * (a + b) - pp); }
    SHF(0, x, m0.x, 0) SHF(1, x, m0.y, 1) SHF(2, y, m0.z, 0) SHF(3, y, m0.w, 1) SHF(4, z, m1.x, 0) SHF(5, z, m1.y, 1) SHF(6, w, m1.z, 0) SHF(7, w, m1.w, 1)
#undef SHF
    bf16_t* dst;
    if (c >= 1024 && c < 2048) {
      const f32x4 q0 = *(const f32x4*)(P.k_k + (c - 1024)), q1 = *(const f32x4*)(P.k_k + (c - 1024) + 4);
      float ss = 0.f;
#define KQ(e, qv) { const float kq = bflo(cvt_pk_bf16(o[e], 0.f)) * qv; ss += kq * kq; }
      KQ(0, q0.x) KQ(1, q0.y) KQ(2, q0.z) KQ(3, q0.w) KQ(4, q1.x) KQ(5, q1.y) KQ(6, q1.z) KQ(7, q1.w)
#undef KQ
      ss = allred8(ss);
      if ((idx & 7) == 0) ((float*)(P.ws + OFF_RN))[(size_t)r * 16 + ((c - 1024) >> 6)] = rsqrtf(fmaxf(ss, 1e-24f));
    }
    if (c < 3072) dst = SH + (size_t)r * SH_LD + c;
    else { const int cl = c - 3072; dst = LIN + (size_t)r * LIN_LD + cl;
      if (cl < 128) {
#pragma unroll
        for (int e = 0; e < 8; ++e) { const float ex = __builtin_amdgcn_exp2f(2.8853900817779268f * o[e]); o[e] = 1.f - 2.f * __builtin_amdgcn_rcpf(ex + 1.f); }
      } else if (cl >= 256) {
#pragma unroll
        for (int e = 0; e < 8; ++e) o[e] = sigmoidf_(o[e]);
      } }
    u32x4 w; w.x = cvt_pk_bf16(o[0], o[1]); w.y = cvt_pk_bf16(o[2], o[3]); w.z = cvt_pk_bf16(o[4], o[5]); w.w = cvt_pk_bf16(o[6], o[7]);
    *(u32x4*)dst = w;
  }
}
__device__ __forceinline__ float SFMA(float a, float b, float c) { float d; asm("v_fma_f32 %0, %1, %2, %3" : "=v"(d) : "v"(a), "v"(b), "v"(c)); return d; }
__device__ __forceinline__ float SMUL(float a, float b) { float d; asm("v_mul_f32 %0, %1, %2" : "=v"(d) : "v"(a), "v"(b)); return d; }
__device__ __forceinline__ void scan_phase(const Params& P, LAS unsigned char* lds, const int tid) {
  constexpr int FSTEP = 320, FBUF = 32 * FSTEP + 4 * 64;
  LAS float* F = (LAS float*)lds;
  LAS unsigned short* YB = (LAS unsigned short*)(lds + 2 * FBUF * 4);
  constexpr int TR_OFF = 2 * FBUF * 4 + 4096;
  const bf16_t* SH = (const bf16_t*)(P.ws + OFF_SH); const bf16_t* LO = (const bf16_t*)(P.ws + OFF_LO); bf16_t* Y = (bf16_t*)(P.ws + OFF_Y);
  const int wid = __builtin_amdgcn_readfirstlane(tid >> 6), lane = tid & 63;
  constexpr int NCH = SKV / 32;
#define SCAN_BAR() do { asm volatile("s_waitcnt lgkmcnt(0)" ::: "memory"); __builtin_amdgcn_s_barrier(); asm volatile("" ::: "memory"); } while (0)
  for (int task = P.bid; task < 256; task += P.grd) {
    const int half = (task >> 3) & 1, chain = (task & 7) | ((task >> 4) << 3);
    const int dir = chain & 1, h = (chain >> 1) & 15, b = chain >> 5, hc = h * 64;
#define ROWOF(g) ((g) < CTXL ? (MT + b * CTXL + (dir ? CTXL - 1 - (g) : (g))) : (b * SEQ + (dir ? SEQ - 1 - ((g) - CTXL) : ((g) - CTXL))))
    if (wid < 4) {
      const int rloc = wid * 8 + (lane >> 3), irow = half * 32 + rloc, cA = (lane & 7) * 4, cB = 32 + cA;
      f32x4 S0 = {0.f, 0.f, 0.f, 0.f}, S1 = {0.f, 0.f, 0.f, 0.f};
      SCAN_BAR();
      for (int q = 0; q < NCH; ++q) {
        const LAS float* f = F + (q & 1) * FBUF;
        LAS unsigned short* yb = YB + (q & 1) * 1024;
        f32x4 a0 = *(const LAS f32x4*)(f + cA), a1 = *(const LAS f32x4*)(f + cB);
        f32x4 b0 = *(const LAS f32x4*)(f + 64 + cA), b1 = *(const LAS f32x4*)(f + 64 + cB);
        f32x4 k0 = *(const LAS f32x4*)(f + 128 + cA), k1 = *(const LAS f32x4*)(f + 128 + cB);
        f32x4 r0 = *(const LAS f32x4*)(f + 192 + cA), r1 = *(const LAS f32x4*)(f + 192 + cB);
        float vv = f[256 + irow];
        float ykeep = 0.f; f32x4 gA = {1.f, 1.f, 1.f, 1.f}, gB = gA;
#pragma unroll 16
        for (int s = 0; s < 32; ++s) {
          const LAS float* fn = f + (s < 31 ? s + 1 : 31) * FSTEP;
          const f32x4 na0 = *(const LAS f32x4*)(fn + cA), na1 = *(const LAS f32x4*)(fn + cB);
          const f32x4 nb0 = *(const LAS f32x4*)(fn + 64 + cA), nb1 = *(const LAS f32x4*)(fn + 64 + cB);
          const f32x4 nk0 = *(const LAS f32x4*)(fn + 128 + cA), nk1 = *(const LAS f32x4*)(fn + 128 + cB);
          const f32x4 nr0 = *(const LAS f32x4*)(fn + 192 + cA), nr1 = *(const LAS f32x4*)(fn + 192 + cB);
          const float nvv = fn[256 + irow];
          if ((s & 7) == 5) { const LAS float* gp = f + 32 * FSTEP + (s >> 3) * 64; gA = *(const LAS f32x4*)(gp + cA); gB = *(const LAS f32x4*)(gp + cB); }
          f32x4 p = S0 * a0 + S1 * a1;
          const float sa_ = allred8((p.x + p.y) + (p.z + p.w));
          S0 = __builtin_elementwise_fma(k0, (f32x4){vv, vv, vv, vv}, __builtin_elementwise_fma(b0, (f32x4){sa_, sa_, sa_, sa_}, S0));
          S1 = __builtin_elementwise_fma(k1, (f32x4){vv, vv, vv, vv}, __builtin_elementwise_fma(b1, (f32x4){sa_, sa_, sa_, sa_}, S1));
          p = S0 * r0 + S1 * r1;
          const float y = allred8((p.x + p.y) + (p.z + p.w));
          ykeep = ((s & 7) == (lane & 7)) ? y : ykeep;
          if ((s & 7) == 7) {
            yb[((s & ~7) + (lane & 7)) * 32 + rloc] = f2bf(ykeep);
            S0 = S0 * gA; S1 = S1 * gB;
          }
          a0 = na0; a1 = na1; b0 = nb0; b1 = nb1; k0 = nk0; k1 = nk1; r0 = nr0; r1 = nr1; vv = nvv;
        }
        SCAN_BAR();
      }
    } else {
      const int sw = wid - 4, hw = lane >> 5, cp = (lane & 31) * 2;
      const f32x2 kk_c = *(const f32x2*)(P.k_k + hc + cp), ka_c = *(const f32x2*)(P.k_a + hc + cp);
      unsigned voS[4], voL[4];
#pragma unroll
      for (int e = 0; e < 4; ++e) { const int tk = hw * 4 + e, ro = dir ? 7 - tk : tk; voS[e] = (unsigned)(ro * SH_LD + cp) * 2u; voL[e] = (unsigned)(ro * LO_LD + cp) * 2u; }
      unsigned sr[4], sk[4], sv[4], sl[4], sa[4]; float srn[4]; int roff[4];
#pragma unroll
      for (int e = 0; e < 4; ++e) { const int tk = hw * 4 + e; roff[e] = (dir ? 7 - tk : tk) * 16; }
      const float* RN = (const float*)(P.ws + OFF_RN);
#define RMIN(q) ({ const int g0_ = (q) * 32 + sw * 8; const int ra_ = ROWOF(g0_), rb_ = ROWOF(g0_ + 7); ra_ < rb_ ? ra_ : rb_; })
#define SLOADQ(q) do { const size_t rmin_ = (size_t)RMIN(q); const char* bs_ = (const char*)(SH + rmin_ * SH_LD + hc); const char* bl_ = (const char*)(LO + rmin_ * LO_LD + dir * 1024 + hc); \
      _Pragma("unroll") for (int e = 0; e < 4; ++e) { sr[e] = *(const unsigned*)(bs_ + voS[e]); sk[e] = *(const unsigned*)(bs_ + 2048 + voS[e]); sv[e] = *(const unsigned*)(bs_ + 4096 + voS[e]); \
        sl[e] = *(const unsigned*)(bl_ + voL[e]); sa[e] = *(const unsigned*)(bl_ + 4096 + voL[e]); srn[e] = RN[rmin_ * 16 + h + roff[e]]; } } while (0)
#define EX2V(V) (f32x2){__builtin_amdgcn_exp2f((V).x), __builtin_amdgcn_exp2f((V).y)}
#define SWRITEQ(buf) do { \
      f32x2 Lc[4]; { f32x2 run = {0.f, 0.f}; _Pragma("unroll") for (int e = 0; e < 4; ++e) { run = run + (f32x2){bflo(sl[e]), bfhi(sl[e])}; Lc[e] = run; } } \
      f32x2 qlo, qhi; { auto r0_ = __builtin_amdgcn_permlane32_swap(__float_as_uint(Lc[3].x), __float_as_uint(Lc[3].x), false, false); \
                        auto r1_ = __builtin_amdgcn_permlane32_swap(__float_as_uint(Lc[3].y), __float_as_uint(Lc[3].y), false, false); \
                        qlo = (f32x2){__uint_as_float(r0_[0]), __uint_as_float(r1_[0])}; qhi = (f32x2){__uint_as_float(r0_[1]), __uint_as_float(r1_[1])}; } \
      const f32x2 base_ = hw ? qlo : (f32x2){0.f, 0.f}; \
      if (hw == 0) *(LAS f32x2*)(F + (buf) * FBUF + 32 * FSTEP + sw * 64 + cp) = EX2V(-(qlo + qhi)); \
      f32x2 Pm = EX2V(-base_); \
      _Pragma("unroll") for (int e = 0; e < 4; ++e) { LAS float* f_ = F + (buf) * FBUF + (sw * 8 + hw * 4 + e) * FSTEP + cp; \
        const f32x2 r_ = {bflo(sr[e]), bfhi(sr[e])}, k_ = {bflo(sk[e]), bfhi(sk[e])}, v_ = {bflo(sv[e]), bfhi(sv[e])}, aa = {bflo(sa[e]), bfhi(sa[e])}; \
        const f32x2 lj = base_ + Lc[e]; \
        const f32x2 Pj = EX2V(-lj), Pi = EX2V(lj); \
        const f32x2 kk = k_ * kk_c * srn[e]; const f32x2 kki = kk * Pi; \
        *(LAS f32x2*)(f_) = -kk * Pm; *(LAS f32x2*)(f_ + 64) = kki * aa; *(LAS f32x2*)(f_ + 128) = k_ * ((aa - 1.f) * ka_c + 1.f) * Pi; \
        *(LAS f32x2*)(f_ + 192) = r_ * Pj; *(LAS f32x2*)(f_ + 256) = v_; Pm = Pj; } } while (0)
      LAS float* trscr = (LAS float*)(lds + TR_OFF + sw * 8704);
      float tv[32]; int w2j = task * 4 + sw;
      SLOADQ(0); SWRITEQ(0); SLOADQ(1);
      SCAN_BAR();
      for (int q = 0; q < NCH; ++q) {
        if (q >= 9) {
          const int qq = q - 1; const LAS unsigned short* yb = YB + (qq & 1) * 1024;
          const int t256 = sw * 64 + lane, s = t256 >> 3, rp = (t256 & 7) * 4; const int u = qq * 32 + s - CTXL; const int t = dir ? SEQ - 1 - u : u;
          const u32x2 val = *(const LAS u32x2*)(yb + s * 32 + rp);
          *(u32x2*)(Y + (size_t)dir * MT * 1024 + (size_t)(b * SEQ + t) * 1024 + hc + half * 32 + rp) = val;
        }
        if (q + 1 < NCH) SWRITEQ((q + 1) & 1);
        if ((q & 7) == 3 && w2j < N_LATE) {
          const float* W_; int ldw_, k0_, n0_, ldt_, drow_; bf16_t* WT_; late_item_addr(P, w2j, W_, ldw_, k0_, n0_, WT_, ldt_, drow_);
          tr_store(tv, k0_, WT_, ldt_, drow_, 0, trscr, lane); w2j += 1024;
        }
        if (q + 2 < NCH) SLOADQ(q + 2);
        if ((q & 7) == 2 && w2j < N_LATE) {
          const float* W_; int ldw_, k0_, n0_, ldt_, drow_; bf16_t* WT_; late_item_addr(P, w2j, W_, ldw_, k0_, n0_, WT_, ldt_, drow_);
          tr_load(tv, W_, ldw_, k0_, n0_, lane);
        }
        SCAN_BAR();
      }
      {
        const int qq = NCH - 1; const LAS unsigned short* yb = YB + (qq & 1) * 1024;
        const int t256 = sw * 64 + lane, s = t256 >> 3, rp = (t256 & 7) * 4; const int u = qq * 32 + s - CTXL; const int t = dir ? SEQ - 1 - u : u;
        const u32x2 val = *(const LAS u32x2*)(yb + s * 32 + rp);
        *(u32x2*)(Y + (size_t)dir * MT * 1024 + (size_t)(b * SEQ + t) * 1024 + hc + half * 32 + rp) = val;
      }
#undef SLOADQ
#undef SWRITEQ
#undef RMIN
#undef EX2V
    }
#undef ROWOF
    __syncthreads();
  }
#undef SCAN_BAR
}
__device__ __forceinline__ float half_sum(float v) {
  v = allred16(v);
  auto rr = __builtin_amdgcn_permlane16_swap(__float_as_uint(v), __float_as_uint(v), false, false); return __uint_as_float(rr[0]) + __uint_as_float(rr[1]);
}
__device__ __forceinline__ void rwkv_out_phase(const Params& P, const int tid) {
  const bf16_t* SH = (const bf16_t*)(P.ws + OFF_SH); const bf16_t* LO = (const bf16_t*)(P.ws + OFF_LO); bf16_t* Y = (bf16_t*)(P.ws + OFF_Y);
  const int wid = tid >> 6, lane = tid & 63, hw = lane >> 5, cp = (lane & 31) * 2;
  const int gw = P.bid * 8 + wid, NGW = P.grd * 8;
  for (int task = gw * 2; task < MT * 8; task += NGW * 2) {
    unsigned yf[2], ybk[2], rr[2], kk[2], vv[2], af[2], ab[2], gg[2]; int cc[2]; size_t tk[2];
#pragma unroll
    for (int u = 0; u < 2; ++u) { const int t_ = task + u; tk[u] = (size_t)(t_ >> 3); cc[u] = ((t_ & 7) * 2 + hw) * 64 + cp;
      const bf16_t* py = Y + tk[u] * 1024 + cc[u]; const bf16_t* ps = SH + tk[u] * SH_LD + cc[u]; const bf16_t* pl = LO + tk[u] * LO_LD + cc[u];
      yf[u] = *(const unsigned*)py; ybk[u] = *(const unsigned*)(py + (size_t)MT * 1024);
      rr[u] = *(const unsigned*)ps; kk[u] = *(const unsigned*)(ps + 1024); vv[u] = *(const unsigned*)(ps + 2048);
      af[u] = *(const unsigned*)(pl + 2048); ab[u] = *(const unsigned*)(pl + 3072); gg[u] = *(const unsigned*)(pl + 4096); }
    unsigned res[2];
#pragma unroll
    for (int u = 0; u < 2; ++u) {
      const f32x2 lw = *(const f32x2*)(P.ln_x_w + cc[u]), lb = *(const f32x2*)(P.ln_x_b + cc[u]), ka = *(const f32x2*)(P.k_a + cc[u]), rk = *(const f32x2*)(P.r_k + cc[u]);
      const f32x2 y = {bflo(yf[u]) + bflo(ybk[u]), bfhi(yf[u]) + bfhi(ybk[u])};
      const float mu = half_sum(y.x + y.y) * (1.f / 64.f); const f32x2 dv = y - mu; const float var = half_sum(dv.x * dv.x + dv.y * dv.y) * (1.f / 64.f);
      const f32x2 yn = dv * rsqrtf(var + 64e-5f) * lw + lb;
      const f32x2 r = {bflo(rr[u]), bfhi(rr[u])}, k = {bflo(kk[u]), bfhi(kk[u])}, v = {bflo(vv[u]), bfhi(vv[u])};
      const f32x2 a1 = {bflo(af[u]), bfhi(af[u])}, a2 = {bflo(ab[u]), bfhi(ab[u])}, g = {bflo(gg[u]), bfhi(gg[u])};
      const f32x2 kms = k * ((a1 - 1.f) * ka + 1.f) + k * ((a2 - 1.f) * ka + 1.f);
      const f32x2 bt = r * kms * rk;
      const float bonus = half_sum(bt.x + bt.y);
      const f32x2 o = (yn + v * bonus) * g;
      res[u] = cvt_pk_bf16(o.x, o.y);
    }
#pragma unroll
    for (int u = 0; u < 2; ++u) *(unsigned*)(Y + tk[u] * 1024 + cc[u]) = res[u];
  }
}
__device__ __forceinline__ void rope_phase(const Params& P, const int tid) {
  bf16_t* Q = (bf16_t*)(P.ws + OFF_Q); bf16_t* KB = (bf16_t*)(P.ws + OFF_KB);
  const int wid = tid >> 6, lane = tid & 63, hw = lane >> 5, li = lane & 31;
  const int gw = P.bid * 8 + wid, NGW = P.grd * 8;
  const int d1 = li < 16 ? 2 * li : 64 + 2 * (li - 16);
  const f32x2 qgA = *(const f32x2*)(P.q_norm + d1), qgB = *(const f32x2*)(P.q_norm + d1 + 32), kgA = *(const f32x2*)(P.k_norm + d1), kgB = *(const f32x2*)(P.k_norm + d1 + 32);
  const int j0 = 2 * (li & 15);
  const float inv0 = __builtin_amdgcn_exp2f(-(float)(2 * j0) * (13.287712379549449f / 64.f)), inv1 = __builtin_amdgcn_exp2f(-(float)(2 * j0 + 2) * (13.287712379549449f / 64.f));
  for (int task = gw; task < MA; task += NGW) {
    if (task < MT) {
      const int tok = task, b = tok >> 13, t = tok & (SEQ - 1);
      const float pos = (float)(li < 16 ? (t >> 6) : (t & 63));
      const float an0 = pos * inv0, an1 = pos * inv1;
      const f32x2 sn = {__sinf(an0), __sinf(an1)}, cs = {__cosf(an0), __cosf(an1)};
      unsigned lo[10], hi[10]; bf16_t* ptr[10];
#pragma unroll
      for (int i = 0; i < 10; ++i) { const int hd = 2 * i + hw;
        ptr[i] = (hd < 16 ? Q + (size_t)tok * DM + hd * 128 : KB + (size_t)(tok + b * CTXL) * 512 + (hd - 16) * 128) + d1;
        lo[i] = *(const unsigned*)ptr[i]; hi[i] = *(const unsigned*)(ptr[i] + 32); }
#pragma unroll
      for (int i = 0; i < 10; ++i) { const bool isq = i < 8;
        const f32x2 t1 = {bflo(lo[i]), bfhi(lo[i])}, t2 = {bflo(hi[i]), bfhi(hi[i])};
        const float ss = half_sum((t1.x * t1.x + t1.y * t1.y) + (t2.x * t2.x + t2.y * t2.y)); const float rs = rsqrtf(ss * (1.f / 128.f) + 1e-6f);
        const f32x2 n1 = t1 * rs * (isq ? qgA : kgA), n2 = t2 * rs * (isq ? qgB : kgB);
        const f32x2 o1 = n1 * cs - n2 * sn, o2 = n2 * cs + n1 * sn;
        lo[i] = cvt_pk_bf16(o1.x, o1.y); hi[i] = cvt_pk_bf16(o2.x, o2.y); }
#pragma unroll
      for (int i = 0; i < 10; ++i) { *(unsigned*)ptr[i] = lo[i]; *(unsigned*)(ptr[i] + 32) = hi[i]; }
    } else {
      const int ct = task - MT, b = ct >> 8, t = ct & (CTXL - 1);
      unsigned lo[2], hi[2]; bf16_t* ptr[2];
#pragma unroll
      for (int i = 0; i < 2; ++i) { ptr[i] = KB + (size_t)(b * SKV + SEQ + t) * 512 + (2 * i + hw) * 128 + d1; lo[i] = *(const unsigned*)ptr[i]; hi[i] = *(const unsigned*)(ptr[i] + 32); }
#pragma unroll
      for (int i = 0; i < 2; ++i) {
        const f32x2 t1 = {bflo(lo[i]), bfhi(lo[i])}, t2 = {bflo(hi[i]), bfhi(hi[i])};
        const float ss = half_sum((t1.x * t1.x + t1.y * t1.y) + (t2.x * t2.x + t2.y * t2.y)); const float rs = rsqrtf(ss * (1.f / 128.f) + 1e-6f);
        const f32x2 n1 = t1 * rs * kgA, n2 = t2 * rs * kgB;
        *(unsigned*)ptr[i] = cvt_pk_bf16(n1.x, n1.y); *(unsigned*)(ptr[i] + 32) = cvt_pk_bf16(n2.x, n2.y); }
    }
  }
}
__device__ __forceinline__ void attn_phase(const Params& P, unsigned char* smem, const int tid) {
  bf16_t* Q = (bf16_t*)(P.ws + OFF_Q); const bf16_t* KB = (const bf16_t*)(P.ws + OFF_KB); const bf16_t* VB = (const bf16_t*)(P.ws + OFF_VB);
  for (int u = P.bid; u < 2048; u += P.grd) {
    const int xcd = u & 7, slot = (u >> 3) & 31, rnd = u >> 8, pair = xcd + 8 * (rnd >> 2), w = (rnd & 3) * 32 + slot;
    const int b = pair >> 2, kvh = pair & 3, g = w & 3, qb = w >> 2, head = kvh * 4 + g;
    bf16_t* Qb = Q + (size_t)(b * SEQ + qb * 256) * DM + head * 128;
    const bf16_t* Kh = KB + (size_t)b * SKV * 512 + kvh * 128; const bf16_t* Vh = VB + (size_t)b * SKV * 512 + kvh * 128;
    att::attn_dense_body(Qb, Kh, Vh, Qb, SKV, (char*)smem, tid);
    __syncthreads();
  }
}
__device__ __forceinline__ void final_norm_phase(const Params& P, const int tid) {
  const int wid = tid >> 6, lane = tid & 63;
  const int gw = P.bid * 8 + wid, NGW = P.grd * 8;
  f32x4 g4[8];
#pragma unroll
  for (int j = 0; j < 8; ++j) g4[j] = *(const f32x4*)(P.norm_final + j * 256 + lane * 4);
  for (int r = gw; r < MT; r += NGW) {
    float* xr = P.out + (size_t)r * DM;
    f32x4 v[8]; float ss = 0.f;
#pragma unroll
    for (int j = 0; j < 8; ++j) v[j] = *(const f32x4*)(xr + j * 256 + lane * 4);
#pragma unroll
    for (int j = 0; j < 8; ++j) ss += v[j].x * v[j].x + v[j].y * v[j].y + v[j].z * v[j].z + v[j].w * v[j].w;
    ss = wave_sum(ss);
    const float rs = rsqrtf(ss * (1.f / DM) + 1e-6f);
#pragma unroll
    for (int j = 0; j < 8; ++j) *(f32x4*)(xr + j * 256 + lane * 4) = v[j] * rs * g4[j];
  }
}


#define XB_TMO      128
#define XB_XCNT(j)  (256  + 64 * (j))
#define XB_XSUB(j)  (1280 + 64 * (j))
#define XB_XGEN(j)  (2304 + 64 * (j))
#define XB_TOP      3328
#define XB_TOPGEN   3392
#define XCD_BAR_WORDS 3456
#define XB_SPIN_CAP (1u << 18)
__device__ __forceinline__ unsigned xb_ld(unsigned* p)              { return __hip_atomic_load(p, __ATOMIC_RELAXED, __HIP_MEMORY_SCOPE_AGENT); }
__device__ __forceinline__ unsigned xb_add(unsigned* p, unsigned v) { return __hip_atomic_fetch_add(p, v, __ATOMIC_RELAXED, __HIP_MEMORY_SCOPE_AGENT); }
__device__ __forceinline__ unsigned xb_xcc_id() { return (unsigned)__builtin_amdgcn_s_getreg((3 << 11) | 20) & 0xFu; }
#define XB_SPIN(cond, bar) do { unsigned _sp = 0; while (cond) { __builtin_amdgcn_s_sleep(1); \
    if ((++_sp & 255u) == 0u) { if (xb_ld(&(bar)[XB_TMO])) break; if (_sp > XB_SPIN_CAP) { atomicAdd(&(bar)[XB_TMO], 1u); break; } } } } while (0)
__device__ __forceinline__ void xcd_barrier_complete(unsigned* bar, unsigned x, unsigned& nloc, unsigned& nx) {
    const unsigned G = gridDim.x * gridDim.y * gridDim.z;
    unsigned sum, cnt, mine, sp = 0u;
    for (;;) {
        sum = 0u; cnt = 0u; mine = 0u;
#pragma unroll
        for (unsigned j = 0; j < 16; ++j) { const unsigned c = xb_ld(&bar[XB_XCNT(j)]); sum += c; cnt += (c > 0u) ? 1u : 0u; mine = (j == x) ? c : mine; }
        if (sum == G) break;
        __builtin_amdgcn_s_sleep(1);
        if ((++sp & 255u) == 0u) { if (xb_ld(&bar[XB_TMO])) break; if (sp > XB_SPIN_CAP) { atomicAdd(&bar[XB_TMO], 1u); break; } }
    }
    nloc = mine > 0u ? mine : 1u; nx = cnt > 0u ? cnt : 1u;
}
__device__ __forceinline__ void xcd_barrier(unsigned* bar, volatile LAS unsigned* st) {
    asm volatile("s_waitcnt vmcnt(0)" ::: "memory");
    __syncthreads();
    if (threadIdx.x == 0) {
        __builtin_amdgcn_s_waitcnt(0);
        const unsigned x = xb_xcc_id();
        unsigned nloc = st[0], nx = st[1];
        if (nloc == 0u) { xcd_barrier_complete(bar, x, nloc, nx); st[0] = nloc; st[1] = nx; }
        const unsigned old = xb_add(&bar[XB_XSUB(x)], 1u);
        const unsigned gen = old / nloc;
        if (old + 1u == (gen + 1u) * nloc) {
            __builtin_amdgcn_fence(__ATOMIC_RELEASE, "agent");
            asm volatile("s_waitcnt vmcnt(0)" ::: "memory");
            const unsigned og = xb_add(&bar[XB_TOP], 1u);
            const unsigned tg = og / nx;
            if (og + 1u == (tg + 1u) * nx) xb_add(&bar[XB_TOPGEN], 1u);
            else XB_SPIN(xb_ld(&bar[XB_TOPGEN]) == tg, bar);
            __builtin_amdgcn_fence(__ATOMIC_ACQUIRE, "agent");
            xb_add(&bar[XB_XGEN(x)], 1u);
            asm volatile("s_waitcnt vmcnt(0)" ::: "memory");
        } else {
            XB_SPIN(xb_ld(&bar[XB_XGEN(x)]) == gen, bar);
            __builtin_amdgcn_fence(__ATOMIC_ACQUIRE, "agent");
            asm volatile("s_waitcnt vmcnt(0)" ::: "memory");
        }
    }
    __syncthreads();
}

constexpr int NPH = 20;
__device__ __forceinline__ bool gemm_desc(int ph, const Params& P, GemmDesc& d) {
  unsigned char* ws = P.ws;
  const bf16_t* H = (const bf16_t*)(ws + OFF_H);
  d.a_tiled = 0; d.nt0 = 0; d.nt1 = 0; d.ksplit1 = 1; d.G = P.grd; d.c = P.bid; d.A1 = nullptr; d.B1 = nullptr; d.pm01 = 0; d.nN1 = 1; d.n1 = 0; d.pm00 = 0; d.xin = nullptr; d.gidx = 0; d.gscale = 0.f; d.act = nullptr;
  switch (ph) {
  case 2: d.K = 2048; d.mode = M_SWIGLU; d.A0 = H; d.B0 = (const bf16_t*)(ws + OFF_W1A); d.nM0 = 132; d.nN0 = 44; d.act = (bf16_t*)(ws + OFF_ACT); break;
  case 3: d.a_tiled = 1; d.K = DFF; d.mode = M_RESID; d.A0 = (const bf16_t*)(ws + OFF_ACT); d.B0 = (const bf16_t*)(ws + OFF_W1B); d.nM0 = 128; d.nN0 = 8; d.xin = P.x; d.gidx = 2; d.gscale = 0.5f;
          d.A1 = d.A0; d.B1 = d.B0; d.pm01 = 128; d.nN1 = 8; d.ksplit1 = 4; d.nt1 = 22; d.n1 = 4 * 8 * 4; break;
  case 5: d.K = 2048; d.mode = M_RW; d.A0 = H; d.B0 = (const bf16_t*)(ws + OFF_WRW); d.nM0 = 132; d.nN0 = 14;
          d.A1 = H; d.B1 = (const bf16_t*)(ws + OFF_WQKVG) + (size_t)2048 * 2048; d.pm01 = 128; d.nN1 = 4; d.n1 = 16; break;
  case 7: d.K = 384; d.mode = M_LORA; d.A0 = (const bf16_t*)(ws + OFF_LIN); d.B0 = (const bf16_t*)(ws + OFF_WLORA); d.nM0 = 132; d.nN0 = 20; break;
  case 10: d.K = 2048; d.mode = M_QKVG; d.A0 = H; d.B0 = (const bf16_t*)(ws + OFF_WQKVG); d.nM0 = 128; d.nN0 = 28; break;
  case 13: d.K = 2048; d.mode = M_T1; d.A0 = (const bf16_t*)(ws + OFF_Q); d.B0 = (const bf16_t*)(ws + OFF_WOA); d.nM0 = 128; d.nN0 = 8; break;
  case 14: d.K = 1024; d.mode = M_M; d.A0 = (const bf16_t*)(ws + OFF_Y); d.B0 = (const bf16_t*)(ws + OFF_WOR); d.nM0 = 128; d.nN0 = 8; break;
  case 15: d.K = 2048; d.mode = M_RESID; d.A0 = (const bf16_t*)(ws + OFF_GR); d.B0 = (const bf16_t*)(ws + OFF_WOUT); d.nM0 = 128; d.nN0 = 8; d.xin = P.out; d.gidx = 5; d.gscale = 1.f; break;
  case 17: d.K = 2048; d.mode = M_SWIGLU; d.A0 = H; d.B0 = (const bf16_t*)(ws + OFF_W2A); d.nM0 = 128; d.nN0 = 44; d.act = (bf16_t*)(ws + OFF_ACT); break;
  case 18: d.a_tiled = 1; d.K = DFF; d.mode = M_RESID; d.A0 = (const bf16_t*)(ws + OFF_ACT); d.B0 = (const bf16_t*)(ws + OFF_W2B); d.nM0 = 128; d.nN0 = 8; d.xin = P.out; d.gidx = 8; d.gscale = 0.5f; break;
  default: return false;
  }
  d.n0 = d.nM0 * d.nN0;
  if (!d.nt0) d.nt0 = d.K / BK;
  if (!d.nt1) d.nt1 = d.K / BK;
  if (d.mode == M_LORA) d.nt0 = 2;
  return true;
}

__global__ void __launch_bounds__(512) mega_fwd(Params P) {
  extern __shared__ __attribute__((aligned(16))) unsigned char smem[];
  LAS unsigned char* lds = (LAS unsigned char*)smem;
  cg::grid_group grid = cg::this_grid();
  volatile LAS unsigned* bst = (volatile LAS unsigned*)(lds + LDS_BYTES + 192);
  unsigned* gbar = (unsigned*)(P.ws + OFF_BAR);
#if ONE_LAUNCH
  if (threadIdx.x == 0) { bst[0] = 0u; bst[1] = 0u; (void)xb_add(&gbar[XB_XCNT(xb_xcc_id())], 1u); }
  __syncthreads();
#endif
#pragma nounroll
  for (int ph = P.ph_lo; ph < P.ph_hi; ++ph) {
    GemmDesc d;
    int tid = threadIdx.x; asm volatile("" : "+v"(tid));
#if PROBE
    if (blockIdx.x == 0 && tid == 0) ((LAS unsigned long long*)(lds + LDS_BYTES))[ph] = __builtin_amdgcn_s_memrealtime();
#endif
    const __attribute__((address_space(4))) Params* kp = (const __attribute__((address_space(4))) Params*)__builtin_amdgcn_kernarg_segment_ptr();
    asm volatile("" : "+s"(kp));
#if defined(__HIP_DEVICE_COMPILE__)
    Params L = *kp;
#else
    Params L = P;
#endif
    { int b_ = blockIdx.x, g_ = gridDim.x; asm volatile("" : "+s"(b_), "+s"(g_)); L.bid = b_; L.grd = g_; }
    if (gemm_desc(ph, L, d)) gemm_phase(lds, d, L, tid);
    else switch (ph) {
      case 0: mod_phase(L, lds, tid); __syncthreads(); convert_phase(L, lds, tid); break;
      case 1: norm_mod_phase(L, L.x, L.ctx, MA, L.norm_ffn1, 0, nullptr, tid); break;
      case 4: norm_mod_phase(L, L.out, L.ctx, MA, L.norm_mix, 3, (const float*)(L.ws + OFF_PART), tid); break;
      case 6: shift_phase(L, tid); break;
      case 8: scan_phase(L, lds, tid); break;
      case 9: rwkv_out_phase(L, tid); break;
      case 11: rope_phase(L, tid); break;
      case 12: attn_phase(L, smem, tid); break;
      case 16: norm_mod_phase(L, L.out, nullptr, MT, L.norm_ffn2, 6, nullptr, tid); break;
      case 19: final_norm_phase(L, tid); break;
      default: break;
    }
    if (ph + 1 < P.ph_hi) { if (ph == 0) grid.sync(); else if (ph != 13 || !ONE_LAUNCH) xcd_barrier(gbar, bst); }
  }
#if PROBE
  grid.sync();
  if (blockIdx.x == 0) {
    LAS unsigned long long* TS = (LAS unsigned long long*)(lds + LDS_BYTES);
    if (threadIdx.x == 0) TS[NPH] = __builtin_amdgcn_s_memrealtime();
    __syncthreads();
    const int K = (int)((TS[PROBE_HI] - TS[PROBE_LO]) / 100ull);
    int t2 = threadIdx.x; asm volatile("" : "+v"(t2));
    for (int i = t2; i < K && i < 16000; i += 512) P.out[(size_t)i * 4099] += 0.1f;
  }
#endif
}

extern "C" void kernel_launch(void* const* d_in, const int* in_sizes, int n_in, void* d_out, int out_size, void* d_ws, size_t ws_size, hipStream_t stream) {
  static int grid_blocks = 0;
  if (!grid_blocks) {
    if (n_in != 31 || out_size != MT * DM || ws_size < WS_TOTAL) { fprintf(stderr, "kernel_launch: unexpected shapes n_in %d out %d ws %zu (need %zu)\n", n_in, out_size, ws_size, WS_TOTAL); return; }
    if (hipFuncSetAttribute((const void*)mega_fwd, hipFuncAttributeMaxDynamicSharedMemorySize, LDS_BYTES + 256) != hipSuccess) { fprintf(stderr, "kernel_launch: hipFuncSetAttribute failed\n"); return; }
    int dev = 0, cus = 0, per_cu = 0;
    hipGetDevice(&dev);
    hipDeviceGetAttribute(&cus, hipDeviceAttributeMultiprocessorCount, dev);
    hipOccupancyMaxActiveBlocksPerMultiprocessor(&per_cu, mega_fwd, 512, LDS_BYTES + 256);
    if (per_cu < 1) { fprintf(stderr, "kernel_launch: occupancy query returned %d\n", per_cu); per_cu = 1; }
    grid_blocks = cus;
  }
  Params p{};
  const float** pf = (const float**)&p;
  for (int i = 0; i < 31; ++i) pf[i] = (const float*)d_in[i];
  p.out = (float*)d_out; p.ws = (unsigned char*)d_ws; p.bid = 0; p.grd = 0;
#if ONE_LAUNCH
  p.ph_lo = 0; p.ph_hi = NPH;
  if (hipMemsetAsync((char*)d_ws + OFF_BAR, 0, 3456 * 4, stream) != hipSuccess) { fprintf(stderr, "kernel_launch: memset of barrier words failed\n"); return; }
  void* args[] = {&p};
  hipError_t e = hipLaunchCooperativeKernel((const void*)mega_fwd, dim3(grid_blocks), dim3(512), args, LDS_BYTES + 256, stream);
  if (e != hipSuccess) fprintf(stderr, "cooperative launch failed: %s (grid %d)\n", hipGetErrorString(e), grid_blocks);
#else
  for (int ph = 0; ph < NPH; ++ph) { p.ph_lo = ph; p.ph_hi = ph + 1; hipLaunchKernelGGL(mega_fwd, dim3(grid_blocks), dim3(512), LDS_BYTES + 256, stream, p); }
#endif
}
```

```cpp
#include <hip/hip_runtime.h>
#include <hip/hip_cooperative_groups.h>
#include <cstdio>
#include <cstdint>
namespace cg = cooperative_groups;

#ifndef ONE_LAUNCH
#define ONE_LAUNCH 1
#endif

#ifndef PROBE
#define PROBE 0
#endif
#define PROBE_LO 8
#define PROBE_HI 9
#define LAS __attribute__((address_space(3)))
typedef unsigned short bf16_t;
typedef short bf16x8 __attribute__((ext_vector_type(8)));
typedef short s16x4 __attribute__((ext_vector_type(4)));
typedef float f32x4 __attribute__((ext_vector_type(4)));
typedef float f32x2 __attribute__((ext_vector_type(2)));
typedef float f32x16 __attribute__((ext_vector_type(16)));
typedef unsigned u32x4 __attribute__((ext_vector_type(4)));
typedef unsigned u32x2 __attribute__((ext_vector_type(2)));

constexpr int DM = 2048, NB = 4, SEQ = 8192, CTXL = 256, MT = NB * SEQ, MC = NB * CTXL, MA = MT + MC;
constexpr int DFF = 5632, SKV = SEQ + CTXL, NMODC = 9 * DM;
constexpr int PRW_LD = 3584, SH_LD = 3072, LIN_LD = 384, LO_LD = 5120;
constexpr int LDS_BYTES = 139264;

constexpr size_t SZ_WA = (size_t)11264 * 2048 * 2, SZ_WB = (size_t)2048 * 5632 * 2;
constexpr size_t OFF_W1A = 0, OFF_W1B = OFF_W1A + SZ_WA, OFF_W2A = OFF_W1B + SZ_WB, OFF_W2B = OFF_W2A + SZ_WA;
constexpr size_t OFF_WRW = OFF_W2B + SZ_WB, OFF_WQKVG = OFF_WRW + (size_t)3584 * 2048 * 2, OFF_WOA = OFF_WQKVG + (size_t)7168 * 2048 * 2;
constexpr size_t OFF_WOR = OFF_WOA + (size_t)2048 * 2048 * 2, OFF_WOUT = OFF_WOR + (size_t)2048 * 1024 * 2, OFF_WLORA = OFF_WOUT + (size_t)2048 * 2048 * 2;
constexpr size_t OFF_MOD = OFF_WLORA + (size_t)5120 * 384 * 2, OFF_CX = OFF_MOD + (size_t)5 * NMODC * 4, OFF_H = OFF_CX + (size_t)MC * DM * 4;
constexpr size_t OFF_BIG = OFF_H + (size_t)MA * DM * 2;
constexpr size_t SZ_KV = (size_t)NB * SKV * 512 * 2;
constexpr size_t OFF_KB = OFF_W1A, OFF_VB = OFF_KB + SZ_KV;
static_assert(OFF_VB + SZ_KV <= OFF_W2A, "KV overlay");
constexpr size_t OFF_ACT = OFF_BIG;
constexpr size_t OFF_PART = OFF_ACT + (size_t)MA * DFF * 2;
constexpr size_t OFF_PRW = OFF_BIG, OFF_LO = OFF_BIG, OFF_SH = OFF_LO + (size_t)MA * LO_LD * 2, OFF_LIN = OFF_SH + (size_t)MA * SH_LD * 2, OFF_Y = OFF_LIN;
constexpr size_t OFF_Q = OFF_BIG, OFF_GA = OFF_Q + (size_t)MT * DM * 2, OFF_GR = OFF_GA + (size_t)MT * DM * 2;
constexpr size_t END_A = OFF_ACT + (size_t)MA * DFF * 2, END_B = OFF_Y + (size_t)2 * MT * 1024 * 2, END_C = OFF_LIN + (size_t)MA * LIN_LD * 2;
constexpr size_t WS_END = END_A > END_B ? (END_A > END_C ? END_A : END_C) : (END_B > END_C ? END_B : END_C);
constexpr size_t OFF_BAR = (WS_END + 255) / 256 * 256, OFF_RN = OFF_BAR + 3456 * 4, WS_TOTAL = OFF_RN + (size_t)MA * 16 * 4;
static_assert((size_t)MA * PRW_LD * 2 <= (size_t)MA * LO_LD * 2, "PRW under LO");
static_assert(OFF_GR + (size_t)MT * DM * 2 <= OFF_Y, "GR below RWO");

struct Params {
  const float *x, *c, *ctx, *c_ctx, *w_mod, *b_mod, *norm_ffn1, *ffn1_w_in, *ffn1_w_out, *norm_mix, *w_in, *q_norm, *k_norm, *rwkv_mu, *w0, *w2, *a0, *a2,
      *g2, *k_k, *k_a, *r_k, *ln_x_w, *ln_x_b, *w_oa, *w_or, *w_out, *norm_ffn2, *ffn2_w_in, *ffn2_w_out, *norm_final;
  float* out; unsigned char* ws; int ph_lo, ph_hi; int bid, grd;
};

__device__ __forceinline__ unsigned cvt_pk_bf16(float lo, float hi) { unsigned r; asm("v_cvt_pk_bf16_f32 %0, %1, %2" : "=v"(r) : "v"(lo), "v"(hi)); return r; }
__device__ __forceinline__ float bf2f(unsigned short b) { return __uint_as_float(((unsigned)b) << 16); }
__device__ __forceinline__ float bflo(unsigned w) { return __uint_as_float(w << 16); }
__device__ __forceinline__ float bfhi(unsigned w) { return __uint_as_float(w & 0xffff0000u); }
__device__ __forceinline__ unsigned short f2bf(float f) { return (unsigned short)(cvt_pk_bf16(f, 0.f) & 0xffffu); }
__device__ __forceinline__ float sigmoidf_(float x) { return __builtin_amdgcn_rcpf(1.f + __builtin_amdgcn_exp2f(-1.4426950408889634f * x)); }
template <int CTRL> __device__ __forceinline__ float dpp_mov(float x) { return __int_as_float(__builtin_amdgcn_update_dpp(0, __float_as_int(x), CTRL, 0xF, 0xF, true)); }
__device__ __forceinline__ float allred16(float x) {
  x += dpp_mov<0xB1>(x); x += dpp_mov<0x4E>(x); x += dpp_mov<0x141>(x); x += dpp_mov<0x140>(x); return x;
}

__device__ __forceinline__ float wave_sum(float v) {
  v = allred16(v);
  { auto rr = __builtin_amdgcn_permlane16_swap(__float_as_uint(v), __float_as_uint(v), false, false); v = __uint_as_float(rr[0]) + __uint_as_float(rr[1]); }
  { auto rr = __builtin_amdgcn_permlane32_swap(__float_as_uint(v), __float_as_uint(v), false, false); v = __uint_as_float(rr[0]) + __uint_as_float(rr[1]); }
  return v;
}

__device__ __forceinline__ float allred8(float x) { x += dpp_mov<0xB1>(x); x += dpp_mov<0x4E>(x); x += dpp_mov<0x141>(x); return x; }
constexpr int BM = 256, BK = 64, HALF = 128, HTB = HALF * BK * 2;
__device__ __forceinline__ int lds_byte(int r, int c) { const int st = (r >> 4) * 2 + (c >> 5), rr = r & 15, cc = c & 31, ob = rr * 64 + cc * 2; return st * 1024 + (ob ^ (((ob >> 9) & 1) << 5)); }
__device__ __forceinline__ void stage_rc(int b, int& R, int& C) { const int st = b / 1024, sb = b % 1024, swz = sb ^ (((sb >> 9) & 1) << 5); R = (st >> 1) * 16 + swz / 64; C = (st & 1) * 32 + (swz % 64) / 2; }
__device__ __forceinline__ int perm32(int rho) { const int n = rho >> 4, i = rho & 15; return 8 * (i >> 2) + 4 * n + (i & 3); }

enum { M_SWIGLU = 0, M_RESID = 1, M_RW = 2, M_QKVG = 3, M_LORA = 4, M_T1 = 5, M_M = 6 };
struct Unit { const char* A; const char* B; int pm, pn, seg, nt; };
struct GemmDesc {
  int K, mode, G, c;
  const bf16_t *A0, *B0; int pm00, nM0, nN0, n0;
  const bf16_t *A1, *B1; int pm01, nN1, n1;
  int a_tiled;
  int nt0, nt1, ksplit1;
  const float* xin; int gidx; float gscale;
  bf16_t* act;
};
__device__ __forceinline__ bool sched_next(const GemmDesc& d, int i, Unit& u) {
  long L = (long)i * d.G + d.c;
  if (L < d.n0) {
    int wgid = (int)L; const int nwg = d.n0;
    { const int q = nwg / 8, r = nwg % 8, xcd = wgid % 8, off = wgid / 8; wgid = (xcd < r ? xcd * (q + 1) : r * (q + 1) + (xcd - r) * q) + off; }
    const int nig = 8 * d.nN0, gid = wgid / nig, fm = gid * 8, gsz = (d.nM0 - fm) < 8 ? (d.nM0 - fm) : 8;
    const int pm = fm + ((wgid % nig) % gsz), pn = (wgid % nig) / gsz;
    u.pm = d.pm00 + pm; u.pn = pn; u.seg = 0; u.nt = d.nt0;
    u.A = (const char*)d.A0 + (size_t)u.pm * 512 * d.K; u.B = (const char*)d.B0 + (size_t)pn * 512 * d.K;
    if (d.mode == M_LORA) { const int ko = (pn < 8 ? 0 : (pn < 16 ? 128 : 256)) * 2; u.A += ko; u.B += ko; }
    return true;
  }
  L -= d.n0;
  if (L < d.n1) {
    const int sp = (int)L % d.ksplit1, l2 = (int)L / d.ksplit1;
    const int pm = l2 / d.nN1, pn = l2 % d.nN1; u.pm = d.pm01 + pm; u.pn = pn; u.seg = 1 + sp; u.nt = d.nt1;
    const size_t ko = (size_t)sp * d.nt1 * 128, koA = d.a_tiled ? (size_t)sp * d.nt1 * 32768 : ko;
    u.A = (const char*)d.A1 + (size_t)u.pm * 512 * d.K + koA; u.B = (const char*)d.B1 + (size_t)pn * 512 * d.K + ko; return true;
  }
  return false;
}

__device__ __forceinline__ void gemm_epilogue(const f32x4 (&acc)[2][2][4][2], const Unit& u, const GemmDesc& d, const Params& P, int wr, int wc, int fr, int fq) {
  unsigned char* ws = P.ws;
  asm volatile("" : "+v"(fr), "+v"(fq));
  const int rl0 = wr * 64 + fr, cl0 = wc * 32 + 8 * fq;
  switch (d.mode) {
  case M_SWIGLU: {
    bf16_t* base = d.act + ((size_t)(u.pm * 88 + u.pn * 2 + (cl0 >> 6)) * 256) * 64 + (cl0 & 63);
#pragma unroll
    for (int ai = 0; ai < 2; ++ai)
#pragma unroll
      for (int m = 0; m < 4; ++m) {
        const int row = rl0 + 128 * ai + 16 * m;
        float o[8];
#pragma unroll
        for (int n = 0; n < 2; ++n)
#pragma unroll
          for (int j = 0; j < 4; ++j) { const float g = acc[ai][0][m][n][j], up = acc[ai][1][m][n][j]; o[4 * n + j] = g * sigmoidf_(g) * up; }
        u32x4 w; w.x = cvt_pk_bf16(o[0], o[1]); w.y = cvt_pk_bf16(o[2], o[3]); w.z = cvt_pk_bf16(o[4], o[5]); w.w = cvt_pk_bf16(o[6], o[7]);
        *(u32x4*)(base + (size_t)row * 64) = w;
      }
  } break;
  case M_RESID: {
    if (u.seg >= 1) {
      float* po = (float*)(ws + OFF_PART) + (size_t)(u.seg - 1) * MC * DM + (size_t)(u.pm - 128) * 256 * DM + u.pn * 256 + cl0;
#pragma unroll
      for (int ai = 0; ai < 2; ++ai)
#pragma unroll
        for (int m = 0; m < 4; ++m)
#pragma unroll
          for (int bj = 0; bj < 2; ++bj)
#pragma unroll
            for (int n = 0; n < 2; ++n) *(f32x4*)(po + (size_t)(rl0 + 128 * ai + 16 * m) * DM + 128 * bj + 4 * n) = acc[ai][bj][m][n];
      break;
    }
    const bool isc = u.pm >= 128; const int b = isc ? 4 : (u.pm >> 5);
    const float* xin = isc ? P.ctx + (size_t)(u.pm - 128) * 256 * DM : d.xin + (size_t)u.pm * 256 * DM;
    float* xo = isc ? (float*)(ws + OFF_CX) + (size_t)(u.pm - 128) * 256 * DM : P.out + (size_t)u.pm * 256 * DM;
    const float* gate = (const float*)(ws + OFF_MOD) + b * NMODC + d.gidx * DM + u.pn * 256 + cl0;
    f32x4 g4[2][2];
#pragma unroll
    for (int bj = 0; bj < 2; ++bj)
#pragma unroll
      for (int n = 0; n < 2; ++n) g4[bj][n] = *(const f32x4*)(gate + 128 * bj + 4 * n) * d.gscale;
#pragma unroll
    for (int ai = 0; ai < 2; ++ai)
#pragma unroll
      for (int m = 0; m < 4; ++m) {
        const size_t ro = (size_t)(rl0 + 128 * ai + 16 * m) * DM + u.pn * 256 + cl0;
#pragma unroll
        for (int bj = 0; bj < 2; ++bj)
#pragma unroll
          for (int n = 0; n < 2; ++n) {
            const f32x4 xv = *(const f32x4*)(xin + ro + 128 * bj + 4 * n);
            *(f32x4*)(xo + ro + 128 * bj + 4 * n) = xv + g4[bj][n] * acc[ai][bj][m][n];
          }
      }
  } break;
  case M_RW: case M_QKVG: case M_LORA: {
    bf16_t* base; int ld; int act = 0; const float* bias = nullptr;
    if (d.mode == M_RW) {
      if (u.seg == 0) { base = (bf16_t*)(ws + OFF_PRW) + (size_t)u.pm * 256 * PRW_LD + u.pn * 256; ld = PRW_LD; }
      else { const int b = u.pm - 128; base = (bf16_t*)(ws + (u.pn < 2 ? OFF_KB : OFF_VB)) + (size_t)(b * SKV + SEQ) * 512 + (u.pn & 1) * 256; ld = 512; }
    } else if (d.mode == M_QKVG) {
      const int b = u.pm >> 5;
      if (u.pn < 8) { base = (bf16_t*)(ws + OFF_Q) + (size_t)u.pm * 256 * DM + u.pn * 256; ld = DM; }
      else if (u.pn < 12) { base = (bf16_t*)(ws + (u.pn < 10 ? OFF_KB : OFF_VB)) + (size_t)(u.pm * 256 + b * CTXL) * 512 + (u.pn & 1) * 256; ld = 512; }
      else { base = (bf16_t*)(ws + (u.pn < 20 ? OFF_GA : OFF_GR)) + (size_t)u.pm * 256 * DM + ((u.pn - 12) & 7) * 256; ld = DM; act = 1; }
    } else {
      base = (bf16_t*)(ws + OFF_LO) + (size_t)u.pm * 256 * LO_LD + u.pn * 256; ld = LO_LD;
      if (u.pn < 8) { act = 2; bias = P.w0 + u.pn * 256; } else if (u.pn < 16) { act = 1; bias = P.a0 + (u.pn - 8) * 256; }
    }
#pragma unroll
    for (int bj = 0; bj < 2; ++bj) {
      f32x4 b0 = {0.f, 0.f, 0.f, 0.f}, b1 = {0.f, 0.f, 0.f, 0.f};
      if (bias) { b0 = *(const f32x4*)(bias + 128 * bj + cl0); b1 = *(const f32x4*)(bias + 128 * bj + cl0 + 4); }
#pragma unroll
      for (int ai = 0; ai < 2; ++ai)
#pragma unroll
        for (int m = 0; m < 4; ++m) {
          const int row = rl0 + 128 * ai + 16 * m;
          f32x4 v0 = acc[ai][bj][m][0] + b0, v1 = acc[ai][bj][m][1] + b1;
          if (act) {
            const float sc = act == 2 ? 0.60653065971263342f * 1.4426950408889634f : 1.f;
#pragma unroll
            for (int j = 0; j < 4; ++j) { v0[j] = sc * sigmoidf_(v0[j]); v1[j] = sc * sigmoidf_(v1[j]); }
          }
          u32x4 w; w.x = cvt_pk_bf16(v0[0], v0[1]); w.y = cvt_pk_bf16(v0[2], v0[3]); w.z = cvt_pk_bf16(v1[0], v1[1]); w.w = cvt_pk_bf16(v1[2], v1[3]);
          *(u32x4*)(base + (size_t)row * ld + 128 * bj + cl0) = w;
        }
    }
  } break;
  case M_T1: case M_M: {
    bf16_t* ga = (bf16_t*)(ws + OFF_GA) + (size_t)u.pm * 256 * DM + u.pn * 256 + cl0;
    bf16_t* gr = (bf16_t*)(ws + OFF_GR) + (size_t)u.pm * 256 * DM + u.pn * 256 + cl0;
    const bool isM = d.mode == M_M;
#pragma unroll
    for (int ai = 0; ai < 2; ++ai)
#pragma unroll
      for (int m = 0; m < 4; ++m)
#pragma unroll
        for (int bj = 0; bj < 2; ++bj) {
          const size_t o = (size_t)(rl0 + 128 * ai + 16 * m) * DM + 128 * bj;
          const f32x4 v0 = acc[ai][bj][m][0], v1 = acc[ai][bj][m][1];
          const u32x4 a = *(const u32x4*)(ga + o);
          u32x4 w;
          if (!isM) {
            w.x = cvt_pk_bf16(bflo(a.x) * v0[0], bfhi(a.x) * v0[1]); w.y = cvt_pk_bf16(bflo(a.y) * v0[2], bfhi(a.y) * v0[3]);
            w.z = cvt_pk_bf16(bflo(a.z) * v1[0], bfhi(a.z) * v1[1]); w.w = cvt_pk_bf16(bflo(a.w) * v1[2], bfhi(a.w) * v1[3]);
            *(u32x4*)(ga + o) = w;
          } else {
            const u32x4 g = *(const u32x4*)(gr + o);
            w.x = cvt_pk_bf16(bflo(a.x) + bflo(g.x) * v0[0], bfhi(a.x) + bfhi(g.x) * v0[1]); w.y = cvt_pk_bf16(bflo(a.y) + bflo(g.y) * v0[2], bfhi(a.y) + bfhi(g.y) * v0[3]);
            w.z = cvt_pk_bf16(bflo(a.z) + bflo(g.z) * v1[0], bfhi(a.z) + bfhi(g.z) * v1[1]); w.w = cvt_pk_bf16(bflo(a.w) + bflo(g.w) * v1[2], bfhi(a.w) + bfhi(g.w) * v1[3]);
            *(u32x4*)(gr + o) = w;
          }
        }
  } break;
  }
}

__device__ __forceinline__ void gemm_phase(LAS unsigned char* lds, const GemmDesc& d, const Params& P, const int tid) {
  const int wid = __builtin_amdgcn_readfirstlane(tid >> 6), lane = tid & 63, wr = wid >> 2, wc = wid & 3, fr = lane & 15, fq = lane >> 4;
  const int K = d.K;
  unsigned voffA[2], voffB[2];
#pragma unroll
  for (int i = 0; i < 2; ++i) { int R, C; stage_rc(tid * 16 + i * 8192, R, C); const int Rb = (R & ~31) + perm32(R & 31);
    voffA[i] = d.a_tiled ? (unsigned)(R * 64 + C) * 2u : (unsigned)(R * K + C) * 2u; voffB[i] = (unsigned)(Rb * K + C) * 2u; }
  const size_t kstep = (size_t)(BK * 2);
  const size_t hstep = (size_t)HALF * K * 2;
  const size_t kstepA = d.a_tiled ? (size_t)32768 : kstep, hstepA = d.a_tiled ? (size_t)16384 : hstep;
  const unsigned ldsw = (unsigned)wid * 1024u;
  const int aoff = lds_byte(wr * 64 + fr, fq * 8), boff = lds_byte(wc * 32 + fr, fq * 8);
#define PG8_SA(b, h) (((b) * 2 + (h)) * HTB)
#define PG8_SB(b, h) ((4 + (b) * 2 + (h)) * HTB)
#define PG8_STAGE(bufoff, gbase, voff) do { _Pragma("unroll") for (int _i = 0; _i < 2; ++_i) \
    __builtin_amdgcn_global_load_lds((const unsigned*)((const char*)(gbase) + (voff)[_i]), (LAS unsigned*)(lds + (bufoff) + ldsw + _i * 8192), 16, 0, 0); } while (0)
#define PG8_LDA(dst, b, h) do { _Pragma("unroll") for (int m = 0; m < 4; ++m) _Pragma("unroll") for (int k = 0; k < 2; ++k) dst[m][k] = *(const LAS bf16x8*)(lds + PG8_SA(b, h) + aoff + m * 2048 + k * 1024); } while (0)
#define PG8_LDB(dst, b, h) do { _Pragma("unroll") for (int n = 0; n < 2; ++n) _Pragma("unroll") for (int k = 0; k < 2; ++k) dst[n][k] = *(const LAS bf16x8*)(lds + PG8_SB(b, h) + boff + n * 2048 + k * 1024); } while (0)
#define PG8_MMA(ai, bj, At, Bt) do { __builtin_amdgcn_s_setprio(1); _Pragma("unroll") for (int m = 0; m < 4; ++m) _Pragma("unroll") for (int n = 0; n < 2; ++n) _Pragma("unroll") for (int k = 0; k < 2; ++k) \
    acc[ai][bj][m][n] = __builtin_amdgcn_mfma_f32_16x16x32_bf16(Bt[n][k], At[m][k], acc[ai][bj][m][n], 0, 0, 0); __builtin_amdgcn_s_setprio(0); } while (0)
#define PG8_WAIT_V(n) asm volatile("s_waitcnt vmcnt(" #n ")" ::: "memory")
#define PG8_WAIT_L(n) asm volatile("s_waitcnt lgkmcnt(" #n ")" ::: "memory")
#define PG8_BAR __builtin_amdgcn_s_barrier()
#define PG8_SCHED __builtin_amdgcn_sched_barrier(0)
  Unit cur, nxt; int ui = 0;
  if (!sched_next(d, 0, cur)) return;
  f32x4 acc[2][2][4][2];
#pragma unroll
  for (int a = 0; a < 2; ++a)
#pragma unroll
    for (int b = 0; b < 2; ++b)
#pragma unroll
      for (int m = 0; m < 4; ++m)
#pragma unroll
        for (int n = 0; n < 2; ++n) acc[a][b][m][n] = (f32x4){0.f, 0.f, 0.f, 0.f};
  bf16x8 At[4][2], B0[2][2], B1[2][2];
  const char* cA = cur.A; const char* cB = cur.B;
  PG8_STAGE(PG8_SB(0, 0), cB, voffB); PG8_STAGE(PG8_SB(0, 1), cB + hstep, voffB); PG8_STAGE(PG8_SA(0, 0), cA, voffA); PG8_STAGE(PG8_SA(0, 1), cA + hstepA, voffA);
  if (wr == 1) PG8_BAR;
  PG8_WAIT_V(2); PG8_BAR;
  PG8_STAGE(PG8_SB(1, 0), cB + kstep, voffB); PG8_STAGE(PG8_SA(1, 0), cA + kstepA, voffA); PG8_STAGE(PG8_SB(1, 1), cB + hstep + kstep, voffB);
  PG8_WAIT_V(6); PG8_BAR;
  for (;;) {
    const bool has_next = sched_next(d, ui + 1, nxt);
    const char* nA = has_next ? nxt.A : cA; const char* nB = has_next ? nxt.B : cB;
    const int nt = cur.nt;
    for (int t = 0; t < nt; t += 2) {
      const bool last = (t == nt - 2);
      const char* a1 = cA + (size_t)(t + 1) * kstepA;
      const char* a2 = last ? nA : cA + (size_t)(t + 2) * kstepA; const char* b2 = last ? nB : cB + (size_t)(t + 2) * kstep;
      const char* a3 = a2 + kstepA; const char* b3 = b2 + kstep;
      PG8_LDB(B0, 0, 0); PG8_LDB(B1, 0, 1); PG8_SCHED; PG8_LDA(At, 0, 0); PG8_STAGE(PG8_SA(1, 1), a1 + hstepA, voffA);
      PG8_WAIT_V(8); PG8_WAIT_L(0); PG8_BAR; PG8_MMA(0, 0, At, B0); PG8_MMA(0, 1, At, B1); PG8_BAR; PG8_SCHED;
      PG8_LDA(At, 0, 1); PG8_STAGE(PG8_SB(0, 0), b2, voffB); PG8_STAGE(PG8_SB(0, 1), b2 + hstep, voffB); PG8_STAGE(PG8_SA(0, 0), a2, voffA);
      PG8_WAIT_V(8); PG8_WAIT_L(0); PG8_BAR; PG8_MMA(1, 0, At, B0); PG8_MMA(1, 1, At, B1); PG8_BAR; PG8_SCHED;
      PG8_LDB(B0, 1, 0); PG8_LDB(B1, 1, 1); PG8_SCHED; PG8_LDA(At, 1, 0); PG8_STAGE(PG8_SA(0, 1), a2 + hstepA, voffA);
      PG8_WAIT_V(8); PG8_WAIT_L(0); PG8_BAR; PG8_MMA(0, 0, At, B0); PG8_MMA(0, 1, At, B1); PG8_BAR; PG8_SCHED;
      PG8_LDA(At, 1, 1); PG8_STAGE(PG8_SB(1, 0), b3, voffB); PG8_STAGE(PG8_SB(1, 1), b3 + hstep, voffB); PG8_STAGE(PG8_SA(1, 0), a3, voffA);
      PG8_WAIT_V(8); PG8_WAIT_L(0); PG8_BAR; PG8_MMA(1, 0, At, B0); PG8_MMA(1, 1, At, B1); PG8_BAR; PG8_SCHED;
    }
    if (wr == 0) PG8_BAR;
    gemm_epilogue(acc, cur, d, P, wr, wc, fr, fq);
    if (!has_next) break;
#pragma unroll
    for (int a = 0; a < 2; ++a)
#pragma unroll
      for (int b = 0; b < 2; ++b)
#pragma unroll
        for (int m = 0; m < 4; ++m)
#pragma unroll
          for (int n = 0; n < 2; ++n) acc[a][b][m][n] = (f32x4){0.f, 0.f, 0.f, 0.f};
    cur = nxt; cA = nA; cB = nB; ++ui;
    if (wr == 1) PG8_BAR;
  }
  PG8_WAIT_V(0);
  PG8_BAR;
#undef PG8_SA
#undef PG8_SB
#undef PG8_STAGE
#undef PG8_LDA
#undef PG8_LDB
#undef PG8_MMA
#undef PG8_WAIT_V
#undef PG8_WAIT_L
#undef PG8_BAR
#undef PG8_SCHED
}

namespace att {
constexpr int D = 128, NW = 8, QBLK = 32, KVBLK = 64;
constexpr float SCALE = 0.088388347648318440f;
constexpr float THR = 8.f;
constexpr int LDQ = 2048, LDK = 512, LDO = 2048;
constexpr size_t SHM_V = KVBLK * D * 2, SHM_K = KVBLK * D * 2;
#define KSWZ(row, colB) ((row) * 256 + ((colB) ^ (((row) & 7) << 4)))
#define SBAR() __builtin_amdgcn_sched_barrier(0)
__device__ __forceinline__ int crow(int r, int hi) { return (r & 3) + 8 * (r >> 2) + 4 * hi; }
__device__ __forceinline__ unsigned cvtpk(float lo, float hi) { unsigned r; asm volatile("v_cvt_pk_bf16_f32 %0, %1, %2" : "=v"(r) : "v"(lo), "v"(hi)); return r; }
__device__ __forceinline__ void partialSM(f32x16& p0, f32x16& p1, float& m_reg, float& mn, float& alpha) {
  constexpr float C = SCALE * 1.4426950408889634f;
  float pmax = p0[0];
#pragma unroll
  for (int r = 1; r < 16; ++r) pmax = fmaxf(pmax, p0[r]);
#pragma unroll
  for (int r = 0; r < 16; ++r) pmax = fmaxf(pmax, p1[r]);
  { auto rr = __builtin_amdgcn_permlane32_swap(__float_as_uint(pmax), __float_as_uint(pmax), false, false);
    pmax = fmaxf(__uint_as_float(rr[0]), __uint_as_float(rr[1])); }
  if (__builtin_expect(__all(pmax - m_reg <= THR / SCALE), 1)) { mn = m_reg; alpha = 1.f; }
  else { mn = fmaxf(m_reg, pmax); alpha = __builtin_amdgcn_exp2f((m_reg - mn) * C); m_reg = mn; }
  float mnC = -mn * C;
#pragma unroll
  for (int r = 0; r < 16; ++r) p0[r] = fmaf(p0[r], C, mnC);
#pragma unroll
  for (int r = 0; r < 16; ++r) p1[r] = fmaf(p1[r], C, mnC);
#pragma unroll
  for (int r = 0; r < 16; ++r) p0[r] = __builtin_amdgcn_exp2f(p0[r]);
}
__device__ __forceinline__ void finishSM(f32x16& p0, f32x16& p1, float alpha, float& l_reg, bf16x8& pa0, bf16x8& pa1, bf16x8& pa2, bf16x8& pa3) {
#pragma unroll
  for (int r = 0; r < 16; ++r) p1[r] = __builtin_amdgcn_exp2f(p1[r]);
  float ps = 0;
#pragma unroll
  for (int r = 0; r < 16; ++r) ps += p0[r];
#pragma unroll
  for (int r = 0; r < 16; ++r) ps += p1[r];
  { auto rr = __builtin_amdgcn_permlane32_swap(__float_as_uint(ps), __float_as_uint(ps), false, false);
    ps = __uint_as_float(rr[0]) + __uint_as_float(rr[1]); }
  l_reg = l_reg * alpha + ps;
#define PK4(P, BASE, OUT) do { unsigned a0 = cvtpk(P[BASE + 0], P[BASE + 1]), a1 = cvtpk(P[BASE + 2], P[BASE + 3]);   \
    unsigned b0 = cvtpk(P[BASE + 4], P[BASE + 5]), b1 = cvtpk(P[BASE + 6], P[BASE + 7]);                              \
    auto r0 = __builtin_amdgcn_permlane32_swap(a0, b0, false, false); auto r1 = __builtin_amdgcn_permlane32_swap(a1, b1, false, false); \
    u32x4 w = {r0[0], r1[0], r0[1], r1[1]}; OUT = *reinterpret_cast<bf16x8*>(&w); } while (0)
  PK4(p0, 0, pa0); PK4(p0, 8, pa1); PK4(p1, 0, pa2); PK4(p1, 8, pa3);
#undef PK4
}
__device__ __forceinline__ void qkt(f32x16& p0, f32x16& p1, const bf16_t* Ks, const bf16x8* qr, int r32, int hi) {
  p0 = f32x16{}; p1 = f32x16{};
#pragma unroll
  for (int d0 = 0; d0 < 8; ++d0) { int cb = (d0 * 16 + hi * 8) * 2;
    bf16x8 b0 = *reinterpret_cast<const bf16x8*>((const char*)Ks + KSWZ(r32, cb));
    bf16x8 b1 = *reinterpret_cast<const bf16x8*>((const char*)Ks + KSWZ(32 + r32, cb));
    p0 = __builtin_amdgcn_mfma_f32_32x32x16_bf16(b0, qr[d0], p0, 0, 0, 0);
    p1 = __builtin_amdgcn_mfma_f32_32x32x16_bf16(b1, qr[d0], p1, 0, 0, 0); }
}
__device__ __forceinline__ int v_st(int k, int c) { const int kk = (k & ~0xC) | ((k & 4) << 1) | ((k & 8) >> 1); return ((kk >> 3) * 4 + (c >> 5)) * 512 + ((kk & 7) * 32 + (c & 31)) * 2; }
__device__ __forceinline__ int v_rd_base(int lane) { return ((lane & 3) << 3) | (((lane >> 2) & 3) << 6) | (((lane >> 4) & 1) << 5) | (((lane >> 5) & 1) << 8); }
constexpr int v_rd_off(int d0, int ks, int half) { return d0 * 512 + ks * 4096 + half * 2048; }
template <int OFF> __device__ __forceinline__ s16x4 tr_read(int vb) {
  s16x4 r; asm volatile("ds_read_b64_tr_b16 %0, %1 offset:%2" : "=&v"(r) : "v"(vb), "i"(OFF) : "memory"); return r;
}
template <int D0> __device__ __forceinline__ void pv_one(f32x16& od, int vb, bf16x8 pa0, bf16x8 pa1, bf16x8 pa2, bf16x8 pa3) {
  const s16x4 l0 = tr_read<v_rd_off(D0, 0, 0)>(vb), h0 = tr_read<v_rd_off(D0, 0, 1)>(vb), l1 = tr_read<v_rd_off(D0, 1, 0)>(vb), h1 = tr_read<v_rd_off(D0, 1, 1)>(vb);
  const s16x4 l2 = tr_read<v_rd_off(D0, 2, 0)>(vb), h2 = tr_read<v_rd_off(D0, 2, 1)>(vb), l3 = tr_read<v_rd_off(D0, 3, 0)>(vb), h3 = tr_read<v_rd_off(D0, 3, 1)>(vb);
  asm volatile("s_waitcnt lgkmcnt(0)" ::: "memory"); SBAR();
#define PK(L, H) (bf16x8){L[0], L[1], L[2], L[3], H[0], H[1], H[2], H[3]}
  od = __builtin_amdgcn_mfma_f32_32x32x16_bf16(pa0, PK(l0, h0), od, 0, 0, 0);
  od = __builtin_amdgcn_mfma_f32_32x32x16_bf16(pa1, PK(l1, h1), od, 0, 0, 0);
  od = __builtin_amdgcn_mfma_f32_32x32x16_bf16(pa2, PK(l2, h2), od, 0, 0, 0);
  od = __builtin_amdgcn_mfma_f32_32x32x16_bf16(pa3, PK(l3, h3), od, 0, 0, 0);
#undef PK
}
__device__ __forceinline__ void pv_d0(f32x16* o, int vb, bf16x8 pa0, bf16x8 pa1, bf16x8 pa2, bf16x8 pa3) {
  pv_one<0>(o[0], vb, pa0, pa1, pa2, pa3); pv_one<1>(o[1], vb, pa0, pa1, pa2, pa3); pv_one<2>(o[2], vb, pa0, pa1, pa2, pa3); pv_one<3>(o[3], vb, pa0, pa1, pa2, pa3);
}
__device__ __forceinline__ void attn_dense_body(const bf16_t* __restrict__ Qb, const bf16_t* __restrict__ Kh, const bf16_t* __restrict__ Vh,
                                                bf16_t* __restrict__ Ob, int seq, char* lds, const int tid) {
  const int wid = tid >> 6, lane = tid & 63, r32 = lane & 31, hi = lane >> 5;
  bf16_t* V_lds = (bf16_t*)lds; bf16_t* K_lds = (bf16_t*)(lds + 2 * SHM_V);
  float* wsf = (float*)(lds + 2 * SHM_V + 2 * SHM_K) + wid * 64; float* li_l = wsf; float* al_l = wsf + 32;
  float m_reg = -1e30f, l_reg = 0; f32x16 o[4] = {}; bf16x8 qr[8];
  const bf16_t* Qw = Qb + (long)(wid * QBLK + r32) * LDQ + hi * 8;
#pragma unroll
  for (int d0 = 0; d0 < 8; ++d0) qr[d0] = *reinterpret_cast<const bf16x8*>(Qw + d0 * 16);
  const int sr = tid >> 4, sc = (tid & 15) * 8, vst0 = v_st(sr, sc), vst1 = v_st(32 + sr, sc);
  const int vb0 = (int)(uintptr_t)V_lds + v_rd_base(lane);
  struct { bf16x8 vs0, vs1, ks0, ks1; } sr_[2];
#define LD8(p) (*reinterpret_cast<const bf16x8*>(p))
  const unsigned voff = (unsigned)(sr * LDK + sc) * 2u;
#define SLOAD(i, k0) do { const char* vb_ = (const char*)(Vh + (size_t)(k0) * LDK); const char* kb_ = (const char*)(Kh + (size_t)(k0) * LDK); \
    sr_[i].vs0 = LD8(vb_ + voff); sr_[i].vs1 = LD8(vb_ + 32 * LDK * 2 + voff); sr_[i].ks0 = LD8(kb_ + voff); sr_[i].ks1 = LD8(kb_ + 32 * LDK * 2 + voff); } while (0)
#define SWRITE(b, i) do { *(bf16x8*)((char*)V_lds + (b) * SHM_V + vst0) = sr_[i].vs0;          \
    *(bf16x8*)((char*)V_lds + (b) * SHM_V + vst1) = sr_[i].vs1; int kc = sc * 2;               \
    *(bf16x8*)((char*)K_lds + (b) * SHM_K + KSWZ(sr, kc)) = sr_[i].ks0;                       \
    *(bf16x8*)((char*)K_lds + (b) * SHM_K + KSWZ(32 + sr, kc)) = sr_[i].ks1; } while (0)
#define SWAIT() asm volatile("s_waitcnt vmcnt(4)" ::: "memory")
#define RESC(a) do { if (__any((a) < 1.f)) { if (hi == 0) al_l[r32] = (a); asm volatile("s_waitcnt lgkmcnt(0)" ::: "memory"); \
    _Pragma("unroll") for (int d = 0; d < 4; ++d) _Pragma("unroll") for (int r = 0; r < 16; ++r) o[d][r] *= al_l[crow(r, hi)]; } } while (0)
  f32x16 pA0, pA1, pB0, pB1; float mnA, mnB, alA, alB; bf16x8 pa0, pa1, pa2, pa3; const int NT = seq / KVBLK;
  constexpr int SE = 0, SO = 1;
  SLOAD(SE, 0); asm volatile("s_waitcnt vmcnt(0)" ::: "memory"); SWRITE(0, SE); __syncthreads();
  qkt(pA0, pA1, K_lds, qr, r32, hi); partialSM(pA0, pA1, m_reg, mnA, alA);
  SLOAD(SO, KVBLK); if (2 < NT) SLOAD(SE, 2 * KVBLK);
  SWAIT(); SWRITE(1, SO); __syncthreads();
  for (int j = 1; j + 1 < NT; j += 2) {
    SBAR(); qkt(pB0, pB1, (bf16_t*)((char*)K_lds + SHM_K), qr, r32, hi);
    finishSM(pA0, pA1, alA, l_reg, pa0, pa1, pa2, pa3); SBAR();
    SLOAD(SO, (j + 2) * KVBLK); SBAR();
    pv_d0(o, vb0, pa0, pa1, pa2, pa3); partialSM(pB0, pB1, m_reg, mnB, alB);
    __syncthreads(); SWAIT(); SWRITE(0, SE);
    RESC(alB); __syncthreads();
    SBAR(); qkt(pA0, pA1, K_lds, qr, r32, hi);
    finishSM(pB0, pB1, alB, l_reg, pa0, pa1, pa2, pa3); SBAR();
    if (j + 3 < NT) SLOAD(SE, (j + 3) * KVBLK); SBAR();
    pv_d0(o, vb0 + (int)SHM_V, pa0, pa1, pa2, pa3); partialSM(pA0, pA1, m_reg, mnA, alA);
    __syncthreads(); SWAIT(); SWRITE(1, SO);
    RESC(alA); __syncthreads();
  }
  SBAR(); qkt(pB0, pB1, (bf16_t*)((char*)K_lds + SHM_K), qr, r32, hi);
  finishSM(pA0, pA1, alA, l_reg, pa0, pa1, pa2, pa3); SBAR();
  pv_d0(o, vb0, pa0, pa1, pa2, pa3); partialSM(pB0, pB1, m_reg, mnB, alB);
  __syncthreads(); RESC(alB);
  finishSM(pB0, pB1, alB, l_reg, pa0, pa1, pa2, pa3); SBAR();
  pv_d0(o, vb0 + (int)SHM_V, pa0, pa1, pa2, pa3);
  if (hi == 0) li_l[r32] = l_reg; asm volatile("s_waitcnt lgkmcnt(0)" ::: "memory");
  float rli[16];
#pragma unroll
  for (int r = 0; r < 16; ++r) rli[r] = __builtin_amdgcn_rcpf(li_l[crow(r, hi)]);
  bf16_t* Ow = Ob + (long)(wid * QBLK) * LDO;
#pragma unroll
  for (int r = 0; r < 16; ++r) { int orow = crow(r, hi);
#pragma unroll
    for (int d0 = 0; d0 < 4; ++d0) Ow[(long)orow * LDO + d0 * 32 + r32] = f2bf(o[d0][r] * rli[r]); }
#undef LD8
#undef SLOAD
#undef SWRITE
#undef SWAIT
#undef RESC
}
}

__device__ __forceinline__ void mod_phase(const Params& P, LAS unsigned char* lds, const int tid) {
  LAS float* sc = (LAS float*)lds; LAS float* red = sc + 5 * 2048;
  const int wid = tid >> 6, lane = tid & 63;
  for (int i = tid; i < 5 * 2048; i += 512) { const int j = i >> 11, k = i & 2047; const float v = (j < 4) ? P.c[j * 2048 + k] : P.c_ctx[k]; sc[i] = v * sigmoidf_(v); }
  __syncthreads();
  float* MOD = (float*)(P.ws + OFF_MOD);
  for (int task = P.bid; task < 256; task += P.grd) {
    const int n0 = task * 72 + lane * 2;
    float a0[5], a1[5];
#pragma unroll
    for (int j = 0; j < 5; ++j) { a0[j] = 0.f; a1[j] = 0.f; }
    if (lane < 36) {
      const float* wp = P.w_mod + (size_t)(wid * 256) * NMODC + n0;
#pragma unroll 16
      for (int k = 0; k < 256; ++k) {
        const f32x2 w = *(const f32x2*)(wp + (size_t)k * NMODC);
#pragma unroll
        for (int j = 0; j < 5; ++j) { const float s = sc[j * 2048 + wid * 256 + k]; a0[j] += s * w.x; a1[j] += s * w.y; }
      }
#pragma unroll
      for (int j = 0; j < 5; ++j) { red[(wid * 5 + j) * 72 + lane * 2] = a0[j]; red[(wid * 5 + j) * 72 + lane * 2 + 1] = a1[j]; }
    }
    __syncthreads();
    if (tid < 360) { const int j = tid / 72, ci = tid % 72; float s = 0.f;
#pragma unroll
      for (int w = 0; w < 8; ++w) s += red[(w * 5 + j) * 72 + ci];
      MOD[j * NMODC + task * 72 + ci] = s + P.b_mod[task * 72 + ci]; }
    __syncthreads();
  }
}
__device__ __forceinline__ void tr_load(float (&tv)[32], const float* __restrict__ W, int ldw, int k0, int n0, int lane) {
#pragma unroll
  for (int i = 0; i < 32; ++i) { const int kk = 2 * i + (lane >> 5); tv[i] = W[(size_t)(k0 + kk) * ldw + n0 + (lane & 31)]; }
}
__device__ __forceinline__ void tr_store(const float (&tv)[32], int k0, bf16_t* __restrict__ WT, int ldt, int drow0, int dk0, LAS float* scr, int lane) {
#pragma unroll
  for (int i = 0; i < 32; ++i) { const int kk = 2 * i + (lane >> 5); scr[kk * 33 + (lane & 31)] = tv[i]; }
  asm volatile("s_waitcnt lgkmcnt(0)" ::: "memory");
  const int c = lane & 7;
#pragma unroll
  for (int j = 0; j < 4; ++j) { const int n = (lane >> 3) + 8 * j; const LAS float* s = scr + (8 * c) * 33 + n;
    u32x4 o; o.x = cvt_pk_bf16(s[0 * 33], s[1 * 33]); o.y = cvt_pk_bf16(s[2 * 33], s[3 * 33]); o.z = cvt_pk_bf16(s[4 * 33], s[5 * 33]); o.w = cvt_pk_bf16(s[6 * 33], s[7 * 33]);
    *(u32x4*)(WT + (size_t)(drow0 + n) * ldt + dk0 + k0 + 8 * c) = o; }
  asm volatile("s_waitcnt lgkmcnt(0)" ::: "memory");
}
__device__ __forceinline__ void tr_item(const float* __restrict__ W, int ldw, int k0, int n0, bf16_t* __restrict__ WT, int ldt, int drow0, int dk0, LAS float* scr, int lane) {
  float tv[32]; tr_load(tv, W, ldw, k0, n0, lane); tr_store(tv, k0, WT, ldt, drow0, dk0, scr, lane);
}
constexpr int N_LATE = 16896 + 6144 + 2048 + 1024 + 2048;
__device__ __forceinline__ void late_item_addr(const Params& P, int j, const float*& W, int& ldw, int& k0, int& n0, bf16_t*& WT, int& ldt, int& drow) {
  if (j < 11264) { const int kb = j / 352, nb = j % 352; n0 = nb * 32; k0 = kb * 64; W = P.ffn2_w_in; ldw = 2 * DFF; WT = (bf16_t*)(P.ws + OFF_W2A); ldt = 2048;
    drow = n0 < DFF ? (n0 >> 7) * 256 + (n0 & 127) : ((n0 - DFF) >> 7) * 256 + 128 + ((n0 - DFF) & 127); return; }
  j -= 11264;
  if (j < 5632) { const int kb = j >> 6, nb = j & 63; n0 = nb * 32; k0 = kb * 64; W = P.ffn2_w_out; ldw = 2048; WT = (bf16_t*)(P.ws + OFF_W2B); ldt = DFF; drow = n0; return; }
  j -= 5632;
  if (j < 6144) { const int kb = j / 192, nbi = j % 192, nb = nbi < 64 ? nbi : nbi + 32;
    n0 = nb < 96 ? nb * 32 : 6528 + (nb - 96) * 32; k0 = kb * 64; W = P.w_in; ldw = 10624; WT = (bf16_t*)(P.ws + OFF_WQKVG); ldt = 2048; drow = nb * 32; return; }
  j -= 6144;
  if (j < 2048) { k0 = (j >> 6) * 64; n0 = (j & 63) * 32; W = P.w_oa; ldw = 2048; WT = (bf16_t*)(P.ws + OFF_WOA); ldt = 2048; drow = n0; return; }
  j -= 2048;
  if (j < 1024) { k0 = (j >> 6) * 64; n0 = (j & 63) * 32; W = P.w_or; ldw = 2048; WT = (bf16_t*)(P.ws + OFF_WOR); ldt = 1024; drow = n0; return; }
  j -= 1024;
  k0 = (j >> 6) * 64; n0 = (j & 63) * 32; W = P.w_out; ldw = 2048; WT = (bf16_t*)(P.ws + OFF_WOUT); ldt = 2048; drow = n0;
}
constexpr int N_EARLY = 11264 + 5632 + 3456 + 1024 + 192;
__device__ __forceinline__ void early_item_addr(const Params& P, int j, const float*& W, int& ldw, int& k0, int& n0, bf16_t*& WT, int& ldt, int& drow, int& dk0) {
  unsigned char* ws = P.ws; dk0 = 0;
  if (j < 11264) { const int kb = j / 352, nb = j % 352; n0 = nb * 32; k0 = kb * 64; W = P.ffn1_w_in; ldw = 2 * DFF; WT = (bf16_t*)(ws + OFF_W1A); ldt = 2048;
    drow = n0 < DFF ? (n0 >> 7) * 256 + (n0 & 127) : ((n0 - DFF) >> 7) * 256 + 128 + ((n0 - DFF) & 127); return; }
  j -= 11264;
  if (j < 5632) { const int kb = j >> 6, nb = j & 63; n0 = nb * 32; k0 = kb * 64; W = P.ffn1_w_out; ldw = 2048; WT = (bf16_t*)(ws + OFF_W1B); ldt = DFF; drow = n0; return; }
  j -= 5632;
  if (j < 3456) { const int kb = j / 108, nb = j % 108; n0 = 3072 + nb * 32; k0 = kb * 64; W = P.w_in; ldw = 10624; WT = (bf16_t*)(ws + OFF_WRW); ldt = 2048; drow = nb * 32; return; }
  j -= 3456;
  if (j < 1024) { const int kb = j >> 5, nb = 64 + (j & 31); n0 = nb * 32; k0 = kb * 64; W = P.w_in; ldw = 10624; WT = (bf16_t*)(ws + OFF_WQKVG); ldt = 2048; drow = nb * 32; return; }
  j -= 1024;
  if (j < 64) { const int z = j >> 5, nb = j & 31; W = P.w2 + (size_t)z * 64 * 1024; ldw = 1024; k0 = 0; n0 = nb * 32; WT = (bf16_t*)(ws + OFF_WLORA); ldt = LIN_LD; drow = z * 1024 + nb * 32; dk0 = z * 64; return; }
  j -= 64;
  if (j < 64) { const int z = j >> 5, nb = j & 31; W = P.a2 + (size_t)z * 64 * 1024; ldw = 1024; k0 = 0; n0 = nb * 32; WT = (bf16_t*)(ws + OFF_WLORA); ldt = LIN_LD; drow = 2048 + z * 1024 + nb * 32; dk0 = 128 + z * 64; return; }
  j -= 64;
  { const int kb = j >> 5, nb = j & 31; W = P.g2; ldw = 1024; k0 = kb * 64; n0 = nb * 32; WT = (bf16_t*)(ws + OFF_WLORA); ldt = LIN_LD; drow = 4096 + nb * 32; dk0 = 256; }
}
__device__ __forceinline__ void convert_phase(const Params& P, LAS unsigned char* lds, const int tid) {
  const int wid = tid >> 6, lane = tid & 63;
  LAS float* scr = (LAS float*)(lds + wid * 8704);
  unsigned char* ws = P.ws;
  bf16_t *W1A = (bf16_t*)(ws + OFF_W1A), *W1B = (bf16_t*)(ws + OFF_W1B), *W2A = (bf16_t*)(ws + OFF_W2A), *W2B = (bf16_t*)(ws + OFF_W2B);
  bf16_t *WRW = (bf16_t*)(ws + OFF_WRW), *WQKVG = (bf16_t*)(ws + OFF_WQKVG), *WOA = (bf16_t*)(ws + OFF_WOA), *WOR = (bf16_t*)(ws + OFF_WOR), *WOUT = (bf16_t*)(ws + OFF_WOUT), *WLORA = (bf16_t*)(ws + OFF_WLORA);
  const int G = P.grd, gw = P.bid * 8 + wid, NGW = G * 8;
  for (int it = gw; it < N_EARLY; it += 2 * NGW) {
    float tA[32], tB[32];
    const float* Wa; int ldwa, k0a, n0a, ldta, drowa, dk0a; bf16_t* WTa; early_item_addr(P, it, Wa, ldwa, k0a, n0a, WTa, ldta, drowa, dk0a);
    tr_load(tA, Wa, ldwa, k0a, n0a, lane);
    const bool hb = it + NGW < N_EARLY;
    const float* Wb = Wa; int ldwb = ldwa, k0b = k0a, n0b = n0a, ldtb = ldta, drowb = drowa, dk0b = dk0a; bf16_t* WTb = WTa;
    if (hb) { early_item_addr(P, it + NGW, Wb, ldwb, k0b, n0b, WTb, ldtb, drowb, dk0b); tr_load(tB, Wb, ldwb, k0b, n0b, lane); }
    tr_store(tA, k0a, WTa, ldta, drowa, dk0a, scr, lane);
    if (hb) tr_store(tB, k0b, WTb, ldtb, drowb, dk0b, scr, lane);
  }
  const int gt = P.bid * 512 + tid, NT = G * 512;
  unsigned zz = 0u; asm volatile("" : "+v"(zz));
  const u32x4 z4 = {zz, zz, zz, zz};
  for (int i = gt; i < 128 * 256; i += NT) *(u32x4*)(WRW + (size_t)3456 * 2048 + (size_t)i * 8) = z4;
  for (int i = gt; i < 5120 * 48; i += NT) { const int row = i / 48, kc = (i % 48) * 8, rb = row >> 10;
    const int lo = rb < 4 ? rb * 64 : 256, hi = rb < 4 ? rb * 64 + 64 : 384;
    if (kc < lo || kc >= hi) *(u32x4*)(WLORA + (size_t)row * LIN_LD + kc) = z4; }
}
__device__ __forceinline__ void norm_mod_phase(const Params& P, const float* __restrict__ lat, const float* __restrict__ ctxp, int nrows, const float* __restrict__ g, int midx, const float* __restrict__ parts, const int tid) {
  const int wid = tid >> 6, lane = tid & 63;
  const int gw = P.bid * 8 + wid, NGW = P.grd * 8;
  const float* __restrict__ MOD = (const float*)(P.ws + OFF_MOD); bf16_t* __restrict__ H = (bf16_t*)(P.ws + OFF_H);
  for (int r = gw; r < nrows; r += NGW) {
    const float* xr = r < MT ? lat + (size_t)r * DM : ctxp + (size_t)(r - MT) * DM;
    const int b = r < MT ? (r >> 13) : 4;
    const float* sh = MOD + b * NMODC + midx * DM; const float* scp = sh + DM;
    f32x4 v[8], g4[8], s4[8], c4[8]; float ss = 0.f;
#pragma unroll
    for (int j = 0; j < 8; ++j) v[j] = *(const f32x4*)(xr + j * 256 + lane * 4);
    if (parts && r >= MT) {
      const float* pp = parts + (size_t)(r - MT) * DM; const float* gt = MOD + 4 * NMODC + 2 * DM;
#pragma unroll
      for (int j = 0; j < 8; ++j) { const int c = j * 256 + lane * 4;
        const f32x4 s = (*(const f32x4*)(pp + c) + *(const f32x4*)(pp + (size_t)MC * DM + c)) + (*(const f32x4*)(pp + (size_t)2 * MC * DM + c) + *(const f32x4*)(pp + (size_t)3 * MC * DM + c));
        v[j] = v[j] + *(const f32x4*)(gt + c) * 0.5f * s; }
    }
#pragma unroll
    for (int j = 0; j < 8; ++j) { const int c = j * 256 + lane * 4; g4[j] = *(const f32x4*)(g + c); s4[j] = *(const f32x4*)(sh + c); c4[j] = *(const f32x4*)(scp + c); }
#pragma unroll
    for (int j = 0; j < 8; ++j) ss += v[j].x * v[j].x + v[j].y * v[j].y + v[j].z * v[j].z + v[j].w * v[j].w;
    ss = wave_sum(ss);
    const float rs = rsqrtf(ss * (1.f / DM) + 1e-6f);
#pragma unroll
    for (int j = 0; j < 8; ++j) { const int c = j * 256 + lane * 4;
      const f32x4 y = v[j] * rs * g4[j]; const f32x4 h = y * (c4[j] + 1.f) + s4[j];
      u32x2 w; w.x = cvt_pk_bf16(h.x, h.y); w.y = cvt_pk_bf16(h.z, h.w);
      *(u32x2*)(H + (size_t)r * DM + c) = w; }
  }
}
__device__ __forceinline__ void shift_phase(const Params& P, const int tid) {
  const bf16_t* __restrict__ PRW = (const bf16_t*)(P.ws + OFF_PRW); bf16_t* __restrict__ SH = (bf16_t*)(P.ws + OFF_SH); bf16_t* __restrict__ LIN = (bf16_t*)(P.ws + OFF_LIN);
  const int gt = P.bid * 512 + tid, NT = P.grd * 512;
#pragma unroll 2
  for (int idx = gt; idx < MA * 432; idx += NT) {
    const int r = idx / 432, c = (idx % 432) * 8;
    bool first, last;
    if (r < MT) { const int t = r & (SEQ - 1); first = t == 0; last = t == SEQ - 1; } else { const int t = (r - MT) & (CTXL - 1); first = t == 0; last = t == CTXL - 1; }
    const u32x4 z4 = {0u, 0u, 0u, 0u};
    const u32x4 p = *(const u32x4*)(PRW + (size_t)r * PRW_LD + c);
    const u32x4 pv = first ? z4 : *(const u32x4*)(PRW + (size_t)(r - 1) * PRW_LD + c);
    const u32x4 nx = last ? z4 : *(const u32x4*)(PRW + (size_t)(r + 1) * PRW_LD + c);
    const f32x4 m0 = *(const f32x4*)(P.rwkv_mu + c), m1 = *(const f32x4*)(P.rwkv_mu + c + 4);
    float o[8];
#define SHF(e, W, MU, HI) { const float pp = HI ? bfhi(p.W) : bflo(p.W), a = HI ? bfhi(pv.W) : bflo(pv.W), b = HI ? bfhi(nx.W) : bflo(nx.W); o[e] = pp + MU * (0.5f * (a + b) - pp); }
    SHF(0, x, m0.x, 0) SHF(1, x, m0.y, 1) SHF(2, y, m0.z, 0) SHF(3, y, m0.w, 1) SHF(4, z, m1.x, 0) SHF(5, z, m1.y, 1) SHF(6, w, m1.z, 0) SHF(7, w, m1.w, 1)
#undef SHF
    bf16_t* dst;
    if (c >= 1024 && c < 2048) {
      const f32x4 q0 = *(const f32x4*)(P.k_k + (c - 1024)), q1 = *(const f32x4*)(P.k_k + (c - 1024) + 4);
      float ss = 0.f;
#define KQ(e, qv) { const float kq = bflo(cvt_pk_bf16(o[e], 0.f)) * qv; ss += kq * kq; }
      KQ(0, q0.x) KQ(1, q0.y) KQ(2, q0.z) KQ(3, q0.w) KQ(4, q1.x) KQ(5, q1.y) KQ(6, q1.z) KQ(7, q1.w)
#undef KQ
      ss = allred8(ss);
      if ((idx & 7) == 0) ((float*)(P.ws + OFF_RN))[(size_t)r * 16 + ((c - 1024) >> 6)] = rsqrtf(fmaxf(ss, 1e-24f));
    }
    if (c < 3072) dst = SH + (size_t)r * SH_LD + c;
    else { const int cl = c - 3072; dst = LIN + (size_t)r * LIN_LD + cl;
      if (cl < 128) {
#pragma unroll
        for (int e = 0; e < 8; ++e) { const float ex = __builtin_amdgcn_exp2f(2.8853900817779268f * o[e]); o[e] = 1.f - 2.f * __builtin_amdgcn_rcpf(ex + 1.f); }
      } else if (cl >= 256) {
#pragma unroll
        for (int e = 0; e < 8; ++e) o[e] = sigmoidf_(o[e]);
      } }
    u32x4 w; w.x = cvt_pk_bf16(o[0], o[1]); w.y = cvt_pk_bf16(o[2], o[3]); w.z = cvt_pk_bf16(o[4], o[5]); w.w = cvt_pk_bf16(o[6], o[7]);
    *(u32x4*)dst = w;
  }
}
__device__ __forceinline__ float SFMA(float a, float b, float c) { float d; asm("v_fma_f32 %0, %1, %2, %3" : "=v"(d) : "v"(a), "v"(b), "v"(c)); return d; }
__device__ __forceinline__ float SMUL(float a, float b) { float d; asm("v_mul_f32 %0, %1, %2" : "=v"(d) : "v"(a), "v"(b)); return d; }
__device__ __forceinline__ void scan_phase(const Params& P, LAS unsigned char* lds, const int tid) {
  constexpr int FSTEP = 320, FBUF = 32 * FSTEP + 4 * 64;
  LAS float* F = (LAS float*)lds;
  LAS unsigned short* YB = (LAS unsigned short*)(lds + 2 * FBUF * 4);
  constexpr int TR_OFF = 2 * FBUF * 4 + 4096;
  const bf16_t* SH = (const bf16_t*)(P.ws + OFF_SH); const bf16_t* LO = (const bf16_t*)(P.ws + OFF_LO); bf16_t* Y = (bf16_t*)(P.ws + OFF_Y);
  const int wid = __builtin_amdgcn_readfirstlane(tid >> 6), lane = tid & 63;
  constexpr int NCH = SKV / 32;
#define SCAN_BAR() do { asm volatile("s_waitcnt lgkmcnt(0)" ::: "memory"); __builtin_amdgcn_s_barrier(); asm volatile("" ::: "memory"); } while (0)
  for (int task = P.bid; task < 256; task += P.grd) {
    const int half = (task >> 3) & 1, chain = (task & 7) | ((task >> 4) << 3);
    const int dir = chain & 1, h = (chain >> 1) & 15, b = chain >> 5, hc = h * 64;
#define ROWOF(g) ((g) < CTXL ? (MT + b * CTXL + (dir ? CTXL - 1 - (g) : (g))) : (b * SEQ + (dir ? SEQ - 1 - ((g) - CTXL) : ((g) - CTXL))))
    if (wid < 4) {
      const int rloc = wid * 8 + (lane >> 3), irow = half * 32 + rloc, cA = (lane & 7) * 4, cB = 32 + cA;
      f32x4 S0 = {0.f, 0.f, 0.f, 0.f}, S1 = {0.f, 0.f, 0.f, 0.f};
      SCAN_BAR();
      for (int q = 0; q < NCH; ++q) {
        const LAS float* f = F + (q & 1) * FBUF;
        LAS unsigned short* yb = YB + (q & 1) * 1024;
        f32x4 a0 = *(const LAS f32x4*)(f + cA), a1 = *(const LAS f32x4*)(f + cB);
        f32x4 b0 = *(const LAS f32x4*)(f + 64 + cA), b1 = *(const LAS f32x4*)(f + 64 + cB);
        f32x4 k0 = *(const LAS f32x4*)(f + 128 + cA), k1 = *(const LAS f32x4*)(f + 128 + cB);
        f32x4 r0 = *(const LAS f32x4*)(f + 192 + cA), r1 = *(const LAS f32x4*)(f + 192 + cB);
        float vv = f[256 + irow];
        float ykeep = 0.f; f32x4 gA = {1.f, 1.f, 1.f, 1.f}, gB = gA;
#pragma unroll 16
        for (int s = 0; s < 32; ++s) {
          const LAS float* fn = f + (s < 31 ? s + 1 : 31) * FSTEP;
          const f32x4 na0 = *(const LAS f32x4*)(fn + cA), na1 = *(const LAS f32x4*)(fn + cB);
          const f32x4 nb0 = *(const LAS f32x4*)(fn + 64 + cA), nb1 = *(const LAS f32x4*)(fn + 64 + cB);
          const f32x4 nk0 = *(const LAS f32x4*)(fn + 128 + cA), nk1 = *(const LAS f32x4*)(fn + 128 + cB);
          const f32x4 nr0 = *(const LAS f32x4*)(fn + 192 + cA), nr1 = *(const LAS f32x4*)(fn + 192 + cB);
          const float nvv = fn[256 + irow];
          if ((s & 7) == 5) { const LAS float* gp = f + 32 * FSTEP + (s >> 3) * 64; gA = *(const LAS f32x4*)(gp + cA); gB = *(const LAS f32x4*)(gp + cB); }
          f32x4 p = S0 * a0 + S1 * a1;
          const float sa_ = allred8((p.x + p.y) + (p.z + p.w));
          S0 = __builtin_elementwise_fma(k0, (f32x4){vv, vv, vv, vv}, __builtin_elementwise_fma(b0, (f32x4){sa_, sa_, sa_, sa_}, S0));
          S1 = __builtin_elementwise_fma(k1, (f32x4){vv, vv, vv, vv}, __builtin_elementwise_fma(b1, (f32x4){sa_, sa_, sa_, sa_}, S1));
          p = S0 * r0 + S1 * r1;
          const float y = allred8((p.x + p.y) + (p.z + p.w));
          ykeep = ((s & 7) == (lane & 7)) ? y : ykeep;
          if ((s & 7) == 7) {
            yb[((s & ~7) + (lane & 7)) * 32 + rloc] = f2bf(ykeep);
            S0 = S0 * gA; S1 = S1 * gB;
          }
          a0 = na0; a1 = na1; b0 = nb0; b1 = nb1; k0 = nk0; k1 = nk1; r0 = nr0; r1 = nr1; vv = nvv;
        }
        SCAN_BAR();
      }
    } else {
      const int sw = wid - 4, hw = lane >> 5, cp = (lane & 31) * 2;
      const f32x2 kk_c = *(const f32x2*)(P.k_k + hc + cp), ka_c = *(const f32x2*)(P.k_a + hc + cp);
      unsigned voS[4], voL[4];
#pragma unroll
      for (int e = 0; e < 4; ++e) { const int tk = hw * 4 + e, ro = dir ? 7 - tk : tk; voS[e] = (unsigned)(ro * SH_LD + cp) * 2u; voL[e] = (unsigned)(ro * LO_LD + cp) * 2u; }
      unsigned sr[4], sk[4], sv[4], sl[4], sa[4]; float srn[4]; int roff[4];
#pragma unroll
      for (int e = 0; e < 4; ++e) { const int tk = hw * 4 + e; roff[e] = (dir ? 7 - tk : tk) * 16; }
      const float* RN = (const float*)(P.ws + OFF_RN);
#define RMIN(q) ({ const int g0_ = (q) * 32 + sw * 8; const int ra_ = ROWOF(g0_), rb_ = ROWOF(g0_ + 7); ra_ < rb_ ? ra_ : rb_; })
#define SLOADQ(q) do { const size_t rmin_ = (size_t)RMIN(q); const char* bs_ = (const char*)(SH + rmin_ * SH_LD + hc); const char* bl_ = (const char*)(LO + rmin_ * LO_LD + dir * 1024 + hc); \
      _Pragma("unroll") for (int e = 0; e < 4; ++e) { sr[e] = *(const unsigned*)(bs_ + voS[e]); sk[e] = *(const unsigned*)(bs_ + 2048 + voS[e]); sv[e] = *(const unsigned*)(bs_ + 4096 + voS[e]); \
        sl[e] = *(const unsigned*)(bl_ + voL[e]); sa[e] = *(const unsigned*)(bl_ + 4096 + voL[e]); srn[e] = RN[rmin_ * 16 + h + roff[e]]; } } while (0)
#define EX2V(V) (f32x2){__builtin_amdgcn_exp2f((V).x), __builtin_amdgcn_exp2f((V).y)}
#define SWRITEQ(buf) do { \
      f32x2 Lc[4]; { f32x2 run = {0.f, 0.f}; _Pragma("unroll") for (int e = 0; e < 4; ++e) { run = run + (f32x2){bflo(sl[e]), bfhi(sl[e])}; Lc[e] = run; } } \
      f32x2 qlo, qhi; { auto r0_ = __builtin_amdgcn_permlane32_swap(__float_as_uint(Lc[3].x), __float_as_uint(Lc[3].x), false, false); \
                        auto r1_ = __builtin_amdgcn_permlane32_swap(__float_as_uint(Lc[3].y), __float_as_uint(Lc[3].y), false, false); \
                        qlo = (f32x2){__uint_as_float(r0_[0]), __uint_as_float(r1_[0])}; qhi = (f32x2){__uint_as_float(r0_[1]), __uint_as_float(r1_[1])}; } \
      const f32x2 base_ = hw ? qlo : (f32x2){0.f, 0.f}; \
      if (hw == 0) *(LAS f32x2*)(F + (buf) * FBUF + 32 * FSTEP + sw * 64 + cp) = EX2V(-(qlo + qhi)); \
      f32x2 Pm = EX2V(-base_); \
      _Pragma("unroll") for (int e = 0; e < 4; ++e) { LAS float* f_ = F + (buf) * FBUF + (sw * 8 + hw * 4 + e) * FSTEP + cp; \
        const f32x2 r_ = {bflo(sr[e]), bfhi(sr[e])}, k_ = {bflo(sk[e]), bfhi(sk[e])}, v_ = {bflo(sv[e]), bfhi(sv[e])}, aa = {bflo(sa[e]), bfhi(sa[e])}; \
        const f32x2 lj = base_ + Lc[e]; \
        const f32x2 Pj = EX2V(-lj), Pi = EX2V(lj); \
        const f32x2 kk = k_ * kk_c * srn[e]; const f32x2 kki = kk * Pi; \
        *(LAS f32x2*)(f_) = -kk * Pm; *(LAS f32x2*)(f_ + 64) = kki * aa; *(LAS f32x2*)(f_ + 128) = k_ * ((aa - 1.f) * ka_c + 1.f) * Pi; \
        *(LAS f32x2*)(f_ + 192) = r_ * Pj; *(LAS f32x2*)(f_ + 256) = v_; Pm = Pj; } } while (0)
      LAS float* trscr = (LAS float*)(lds + TR_OFF + sw * 8704);
      float tv[32]; int w2j = task * 4 + sw;
      SLOADQ(0); SWRITEQ(0); SLOADQ(1);
      SCAN_BAR();
      for (int q = 0; q < NCH; ++q) {
        if (q >= 9) {
          const int qq = q - 1; const LAS unsigned short* yb = YB + (qq & 1) * 1024;
          const int t256 = sw * 64 + lane, s = t256 >> 3, rp = (t256 & 7) * 4; const int u = qq * 32 + s - CTXL; const int t = dir ? SEQ - 1 - u : u;
          const u32x2 val = *(const LAS u32x2*)(yb + s * 32 + rp);
          *(u32x2*)(Y + (size_t)dir * MT * 1024 + (size_t)(b * SEQ + t) * 1024 + hc + half * 32 + rp) = val;
        }
        if (q + 1 < NCH) SWRITEQ((q + 1) & 1);
        if ((q & 7) == 3 && w2j < N_LATE) {
          const float* W_; int ldw_, k0_, n0_, ldt_, drow_; bf16_t* WT_; late_item_addr(P, w2j, W_, ldw_, k0_, n0_, WT_, ldt_, drow_);
          tr_store(tv, k0_, WT_, ldt_, drow_, 0, trscr, lane); w2j += 1024;
        }
        if (q + 2 < NCH) SLOADQ(q + 2);
        if ((q & 7) == 2 && w2j < N_LATE) {
          const float* W_; int ldw_, k0_, n0_, ldt_, drow_; bf16_t* WT_; late_item_addr(P, w2j, W_, ldw_, k0_, n0_, WT_, ldt_, drow_);
          tr_load(tv, W_, ldw_, k0_, n0_, lane);
        }
        SCAN_BAR();
      }
      {
        const int qq = NCH - 1; const LAS unsigned short* yb = YB + (qq & 1) * 1024;
        const int t256 = sw * 64 + lane, s = t256 >> 3, rp = (t256 & 7) * 4; const int u = qq * 32 + s - CTXL; const int t = dir ? SEQ - 1 - u : u;
        const u32x2 val = *(const LAS u32x2*)(yb + s * 32 + rp);
        *(u32x2*)(Y + (size_t)dir * MT * 1024 + (size_t)(b * SEQ + t) * 1024 + hc + half * 32 + rp) = val;
      }
#undef SLOADQ
#undef SWRITEQ
#undef RMIN
#undef EX2V
    }
#undef ROWOF
    __syncthreads();
  }
#undef SCAN_BAR
}
__device__ __forceinline__ float half_sum(float v) {
  v = allred16(v);
  auto rr = __builtin_amdgcn_permlane16_swap(__float_as_uint(v), __float_as_uint(v), false, false); return __uint_as_float(rr[0]) + __uint_as_float(rr[1]);
}
__device__ __forceinline__ void rwkv_out_phase(const Params& P, const int tid) {
  const bf16_t* SH = (const bf16_t*)(P.ws + OFF_SH); const bf16_t* LO = (const bf16_t*)(P.ws + OFF_LO); bf16_t* Y = (bf16_t*)(P.ws + OFF_Y);
  const int wid = tid >> 6, lane = tid & 63, hw = lane >> 5, cp = (lane & 31) * 2;
  const int gw = P.bid * 8 + wid, NGW = P.grd * 8;
  for (int task = gw * 2; task < MT * 8; task += NGW * 2) {
    unsigned yf[2], ybk[2], rr[2], kk[2], vv[2], af[2], ab[2], gg[2]; int cc[2]; size_t tk[2];
#pragma unroll
    for (int u = 0; u < 2; ++u) { const int t_ = task + u; tk[u] = (size_t)(t_ >> 3); cc[u] = ((t_ & 7) * 2 + hw) * 64 + cp;
      const bf16_t* py = Y + tk[u] * 1024 + cc[u]; const bf16_t* ps = SH + tk[u] * SH_LD + cc[u]; const bf16_t* pl = LO + tk[u] * LO_LD + cc[u];
      yf[u] = *(const unsigned*)py; ybk[u] = *(const unsigned*)(py + (size_t)MT * 1024);
      rr[u] = *(const unsigned*)ps; kk[u] = *(const unsigned*)(ps + 1024); vv[u] = *(const unsigned*)(ps + 2048);
      af[u] = *(const unsigned*)(pl + 2048); ab[u] = *(const unsigned*)(pl + 3072); gg[u] = *(const unsigned*)(pl + 4096); }
    unsigned res[2];
#pragma unroll
    for (int u = 0; u < 2; ++u) {
      const f32x2 lw = *(const f32x2*)(P.ln_x_w + cc[u]), lb = *(const f32x2*)(P.ln_x_b + cc[u]), ka = *(const f32x2*)(P.k_a + cc[u]), rk = *(const f32x2*)(P.r_k + cc[u]);
      const f32x2 y = {bflo(yf[u]) + bflo(ybk[u]), bfhi(yf[u]) + bfhi(ybk[u])};
      const float mu = half_sum(y.x + y.y) * (1.f / 64.f); const f32x2 dv = y - mu; const float var = half_sum(dv.x * dv.x + dv.y * dv.y) * (1.f / 64.f);
      const f32x2 yn = dv * rsqrtf(var + 64e-5f) * lw + lb;
      const f32x2 r = {bflo(rr[u]), bfhi(rr[u])}, k = {bflo(kk[u]), bfhi(kk[u])}, v = {bflo(vv[u]), bfhi(vv[u])};
      const f32x2 a1 = {bflo(af[u]), bfhi(af[u])}, a2 = {bflo(ab[u]), bfhi(ab[u])}, g = {bflo(gg[u]), bfhi(gg[u])};
      const f32x2 kms = k * ((a1 - 1.f) * ka + 1.f) + k * ((a2 - 1.f) * ka + 1.f);
      const f32x2 bt = r * kms * rk;
      const float bonus = half_sum(bt.x + bt.y);
      const f32x2 o = (yn + v * bonus) * g;
      res[u] = cvt_pk_bf16(o.x, o.y);
    }
#pragma unroll
    for (int u = 0; u < 2; ++u) *(unsigned*)(Y + tk[u] * 1024 + cc[u]) = res[u];
  }
}
__device__ __forceinline__ void rope_phase(const Params& P, const int tid) {
  bf16_t* Q = (bf16_t*)(P.ws + OFF_Q); bf16_t* KB = (bf16_t*)(P.ws + OFF_KB);
  const int wid = tid >> 6, lane = tid & 63, hw = lane >> 5, li = lane & 31;
  const int gw = P.bid * 8 + wid, NGW = P.grd * 8;
  const int d1 = li < 16 ? 2 * li : 64 + 2 * (li - 16);
  const f32x2 qgA = *(const f32x2*)(P.q_norm + d1), qgB = *(const f32x2*)(P.q_norm + d1 + 32), kgA = *(const f32x2*)(P.k_norm + d1), kgB = *(const f32x2*)(P.k_norm + d1 + 32);
  const int j0 = 2 * (li & 15);
  const float inv0 = __builtin_amdgcn_exp2f(-(float)(2 * j0) * (13.287712379549449f / 64.f)), inv1 = __builtin_amdgcn_exp2f(-(float)(2 * j0 + 2) * (13.287712379549449f / 64.f));
  for (int task = gw; task < MA; task += NGW) {
    if (task < MT) {
      const int tok = task, b = tok >> 13, t = tok & (SEQ - 1);
      const float pos = (float)(li < 16 ? (t >> 6) : (t & 63));
      const float an0 = pos * inv0, an1 = pos * inv1;
      const f32x2 sn = {__sinf(an0), __sinf(an1)}, cs = {__cosf(an0), __cosf(an1)};
      unsigned lo[10], hi[10]; bf16_t* ptr[10];
#pragma unroll
      for (int i = 0; i < 10; ++i) { const int hd = 2 * i + hw;
        ptr[i] = (hd < 16 ? Q + (size_t)tok * DM + hd * 128 : KB + (size_t)(tok + b * CTXL) * 512 + (hd - 16) * 128) + d1;
        lo[i] = *(const unsigned*)ptr[i]; hi[i] = *(const unsigned*)(ptr[i] + 32); }
#pragma unroll
      for (int i = 0; i < 10; ++i) { const bool isq = i < 8;
        const f32x2 t1 = {bflo(lo[i]), bfhi(lo[i])}, t2 = {bflo(hi[i]), bfhi(hi[i])};
        const float ss = half_sum((t1.x * t1.x + t1.y * t1.y) + (t2.x * t2.x + t2.y * t2.y)); const float rs = rsqrtf(ss * (1.f / 128.f) + 1e-6f);
        const f32x2 n1 = t1 * rs * (isq ? qgA : kgA), n2 = t2 * rs * (isq ? qgB : kgB);
        const f32x2 o1 = n1 * cs - n2 * sn, o2 = n2 * cs + n1 * sn;
        lo[i] = cvt_pk_bf16(o1.x, o1.y); hi[i] = cvt_pk_bf16(o2.x, o2.y); }
#pragma unroll
      for (int i = 0; i < 10; ++i) { *(unsigned*)ptr[i] = lo[i]; *(unsigned*)(ptr[i] + 32) = hi[i]; }
    } else {
      const int ct = task - MT, b = ct >> 8, t = ct & (CTXL - 1);
      unsigned lo[2], hi[2]; bf16_t* ptr[2];
#pragma unroll
      for (int i = 0; i < 2; ++i) { ptr[i] = KB + (size_t)(b * SKV + SEQ + t) * 512 + (2 * i + hw) * 128 + d1; lo[i] = *(const unsigned*)ptr[i]; hi[i] = *(const unsigned*)(ptr[i] + 32); }
#pragma unroll
      for (int i = 0; i < 2; ++i) {
        const f32x2 t1 = {bflo(lo[i]), bfhi(lo[i])}, t2 = {bflo(hi[i]), bfhi(hi[i])};
        const float ss = half_sum((t1.x * t1.x + t1.y * t1.y) + (t2.x * t2.x + t2.y * t2.y)); const float rs = rsqrtf(ss * (1.f / 128.f) + 1e-6f);
        const f32x2 n1 = t1 * rs * kgA, n2 = t2 * rs * kgB;
        *(unsigned*)ptr[i] = cvt_pk_bf16(n1.x, n1.y); *(unsigned*)(ptr[i] + 32) = cvt_pk_bf16(n2.x, n2.y); }
    }
  }
}
__device__ __forceinline__ void attn_phase(const Params& P, unsigned char* smem, const int tid) {
  bf16_t* Q = (bf16_t*)(P.ws + OFF_Q); const bf16_t* KB = (const bf16_t*)(P.ws + OFF_KB); const bf16_t* VB = (const bf16_t*)(P.ws + OFF_VB);
  for (int u = P.bid; u < 2048; u += P.grd) {
    const int xcd = u & 7, slot = (u >> 3) & 31, rnd = u >> 8, pair = xcd + 8 * (rnd >> 2), w = (rnd & 3) * 32 + slot;
    const int b = pair >> 2, kvh = pair & 3, g = w & 3, qb = w >> 2, head = kvh * 4 + g;
    bf16_t* Qb = Q + (size_t)(b * SEQ + qb * 256) * DM + head * 128;
    const bf16_t* Kh = KB + (size_t)b * SKV * 512 + kvh * 128; const bf16_t* Vh = VB + (size_t)b * SKV * 512 + kvh * 128;
    att::attn_dense_body(Qb, Kh, Vh, Qb, SKV, (char*)smem, tid);
    __syncthreads();
  }
}
__device__ __forceinline__ void final_norm_phase(const Params& P, const int tid) {
  const int wid = tid >> 6, lane = tid & 63;
  const int gw = P.bid * 8 + wid, NGW = P.grd * 8;
  f32x4 g4[8];
#pragma unroll
  for (int j = 0; j < 8; ++j) g4[j] = *(const f32x4*)(P.norm_final + j * 256 + lane * 4);
  for (int r = gw; r < MT; r += NGW) {
    float* xr = P.out + (size_t)r * DM;
    f32x4 v[8]; float ss = 0.f;
#pragma unroll
    for (int j = 0; j < 8; ++j) v[j] = *(const f32x4*)(xr + j * 256 + lane * 4);
#pragma unroll
    for (int j = 0; j < 8; ++j) ss += v[j].x * v[j].x + v[j].y * v[j].y + v[j].z * v[j].z + v[j].w * v[j].w;
    ss = wave_sum(ss);
    const float rs = rsqrtf(ss * (1.f / DM) + 1e-6f);
#pragma unroll
    for (int j = 0; j < 8; ++j) *(f32x4*)(xr + j * 256 + lane * 4) = v[j] * rs * g4[j];
  }
}


#define XB_TMO      128
#define XB_XCNT(j)  (256  + 64 * (j))
#define XB_XSUB(j)  (1280 + 64 * (j))
#define XB_XGEN(j)  (2304 + 64 * (j))
#define XB_TOP      3328
#define XB_TOPGEN   3392
#define XCD_BAR_WORDS 3456
#define XB_SPIN_CAP (1u << 18)
__device__ __forceinline__ unsigned xb_ld(unsigned* p)              { return __hip_atomic_load(p, __ATOMIC_RELAXED, __HIP_MEMORY_SCOPE_AGENT); }
__device__ __forceinline__ unsigned xb_add(unsigned* p, unsigned v) { return __hip_atomic_fetch_add(p, v, __ATOMIC_RELAXED, __HIP_MEMORY_SCOPE_AGENT); }
__device__ __forceinline__ unsigned xb_xcc_id() { return (unsigned)__builtin_amdgcn_s_getreg((3 << 11) | 20) & 0xFu; }
#define XB_SPIN(cond, bar) do { unsigned _sp = 0; while (cond) { __builtin_amdgcn_s_sleep(1); \
    if ((++_sp & 255u) == 0u) { if (xb_ld(&(bar)[XB_TMO])) break; if (_sp > XB_SPIN_CAP) { atomicAdd(&(bar)[XB_TMO], 1u); break; } } } } while (0)
__device__ __forceinline__ void xcd_barrier_complete(unsigned* bar, unsigned x, unsigned& nloc, unsigned& nx) {
    const unsigned G = gridDim.x * gridDim.y * gridDim.z;
    unsigned sum, cnt, mine, sp = 0u;
    for (;;) {
        sum = 0u; cnt = 0u; mine = 0u;
#pragma unroll
        for (unsigned j = 0; j < 16; ++j) { const unsigned c = xb_ld(&bar[XB_XCNT(j)]); sum += c; cnt += (c > 0u) ? 1u : 0u; mine = (j == x) ? c : mine; }
        if (sum == G) break;
        __builtin_amdgcn_s_sleep(1);
        if ((++sp & 255u) == 0u) { if (xb_ld(&bar[XB_TMO])) break; if (sp > XB_SPIN_CAP) { atomicAdd(&bar[XB_TMO], 1u); break; } }
    }
    nloc = mine > 0u ? mine : 1u; nx = cnt > 0u ? cnt : 1u;
}
__device__ __forceinline__ void xcd_barrier(unsigned* bar, volatile LAS unsigned* st) {
    asm volatile("s_waitcnt vmcnt(0)" ::: "memory");
    __syncthreads();
    if (threadIdx.x == 0) {
        __builtin_amdgcn_s_waitcnt(0);
        const unsigned x = xb_xcc_id();
        unsigned nloc = st[0], nx = st[1];
        if (nloc == 0u) { xcd_barrier_complete(bar, x, nloc, nx); st[0] = nloc; st[1] = nx; }
        const unsigned old = xb_add(&bar[XB_XSUB(x)], 1u);
        const unsigned gen = old / nloc;
        if (old + 1u == (gen + 1u) * nloc) {
            __builtin_amdgcn_fence(__ATOMIC_RELEASE, "agent");
            asm volatile("s_waitcnt vmcnt(0)" ::: "memory");
            const unsigned og = xb_add(&bar[XB_TOP], 1u);
            const unsigned tg = og / nx;
            if (og + 1u == (tg + 1u) * nx) xb_add(&bar[XB_TOPGEN], 1u);
            else XB_SPIN(xb_ld(&bar[XB_TOPGEN]) == tg, bar);
            __builtin_amdgcn_fence(__ATOMIC_ACQUIRE, "agent");
            xb_add(&bar[XB_XGEN(x)], 1u);
            asm volatile("s_waitcnt vmcnt(0)" ::: "memory");
        } else {
            XB_SPIN(xb_ld(&bar[XB_XGEN(x)]) == gen, bar);
            __builtin_amdgcn_fence(__ATOMIC_ACQUIRE, "agent");
            asm volatile("s_waitcnt vmcnt(0)" ::: "memory");
        }
    }
    __syncthreads();
}

constexpr int NPH = 20;
__device__ __forceinline__ bool gemm_desc(int ph, const Params& P, GemmDesc& d) {
  unsigned char* ws = P.ws;
  const bf16_t* H = (const bf16_t*)(ws + OFF_H);
  d.a_tiled = 0; d.nt0 = 0; d.nt1 = 0; d.ksplit1 = 1; d.G = P.grd; d.c = P.bid; d.A1 = nullptr; d.B1 = nullptr; d.pm01 = 0; d.nN1 = 1; d.n1 = 0; d.pm00 = 0; d.xin = nullptr; d.gidx = 0; d.gscale = 0.f; d.act = nullptr;
  switch (ph) {
  case 2: d.K = 2048; d.mode = M_SWIGLU; d.A0 = H; d.B0 = (const bf16_t*)(ws + OFF_W1A); d.nM0 = 132; d.nN0 = 44; d.act = (bf16_t*)(ws + OFF_ACT); break;
  case 3: d.a_tiled = 1; d.K = DFF; d.mode = M_RESID; d.A0 = (const bf16_t*)(ws + OFF_ACT); d.B0 = (const bf16_t*)(ws + OFF_W1B); d.nM0 = 128; d.nN0 = 8; d.xin = P.x; d.gidx = 2; d.gscale = 0.5f;
          d.A1 = d.A0; d.B1 = d.B0; d.pm01 = 128; d.nN1 = 8; d.ksplit1 = 4; d.nt1 = 22; d.n1 = 4 * 8 * 4; break;
  case 5: d.K = 2048; d.mode = M_RW; d.A0 = H; d.B0 = (const bf16_t*)(ws + OFF_WRW); d.nM0 = 132; d.nN0 = 14;
          d.A1 = H; d.B1 = (const bf16_t*)(ws + OFF_WQKVG) + (size_t)2048 * 2048; d.pm01 = 128; d.nN1 = 4; d.n1 = 16; break;
  case 7: d.K = 384; d.mode = M_LORA; d.A0 = (const bf16_t*)(ws + OFF_LIN); d.B0 = (const bf16_t*)(ws + OFF_WLORA); d.nM0 = 132; d.nN0 = 20; break;
  case 10: d.K = 2048; d.mode = M_QKVG; d.A0 = H; d.B0 = (const bf16_t*)(ws + OFF_WQKVG); d.nM0 = 128; d.nN0 = 28; break;
  case 13: d.K = 2048; d.mode = M_T1; d.A0 = (const bf16_t*)(ws + OFF_Q); d.B0 = (const bf16_t*)(ws + OFF_WOA); d.nM0 = 128; d.nN0 = 8; break;
  case 14: d.K = 1024; d.mode = M_M; d.A0 = (const bf16_t*)(ws + OFF_Y); d.B0 = (const bf16_t*)(ws + OFF_WOR); d.nM0 = 128; d.nN0 = 8; break;
  case 15: d.K = 2048; d.mode = M_RESID; d.A0 = (const bf16_t*)(ws + OFF_GR); d.B0 = (const bf16_t*)(ws + OFF_WOUT); d.nM0 = 128; d.nN0 = 8; d.xin = P.out; d.gidx = 5; d.gscale = 1.f; break;
  case 17: d.K = 2048; d.mode = M_SWIGLU; d.A0 = H; d.B0 = (const bf16_t*)(ws + OFF_W2A); d.nM0 = 128; d.nN0 = 44; d.act = (bf16_t*)(ws + OFF_ACT); break;
  case 18: d.a_tiled = 1; d.K = DFF; d.mode = M_RESID; d.A0 = (const bf16_t*)(ws + OFF_ACT); d.B0 = (const bf16_t*)(ws + OFF_W2B); d.nM0 = 128; d.nN0 = 8; d.xin = P.out; d.gidx = 8; d.gscale = 0.5f; break;
  default: return false;
  }
  d.n0 = d.nM0 * d.nN0;
  if (!d.nt0) d.nt0 = d.K / BK;
  if (!d.nt1) d.nt1 = d.K / BK;
  if (d.mode == M_LORA) d.nt0 = 2;
  return true;
}

__global__ void __launch_bounds__(512) mega_fwd(Params P) {
  extern __shared__ __attribute__((aligned(16))) unsigned char smem[];
  LAS unsigned char* lds = (LAS unsigned char*)smem;
  cg::grid_group grid = cg::this_grid();
  volatile LAS unsigned* bst = (volatile LAS unsigned*)(lds + LDS_BYTES + 192);
  unsigned* gbar = (unsigned*)(P.ws + OFF_BAR);
#if ONE_LAUNCH
  if (threadIdx.x == 0) { bst[0] = 0u; bst[1] = 0u; (void)xb_add(&gbar[XB_XCNT(xb_xcc_id())], 1u); }
  __syncthreads();
#endif
#pragma nounroll
  for (int ph = P.ph_lo; ph < P.ph_hi; ++ph) {
    GemmDesc d;
    int tid = threadIdx.x; asm volatile("" : "+v"(tid));
#if PROBE
    if (blockIdx.x == 0 && tid == 0) ((LAS unsigned long long*)(lds + LDS_BYTES))[ph] = __builtin_amdgcn_s_memrealtime();
#endif
    const __attribute__((address_space(4))) Params* kp = (const __attribute__((address_space(4))) Params*)__builtin_amdgcn_kernarg_segment_ptr();
    asm volatile("" : "+s"(kp));
#if defined(__HIP_DEVICE_COMPILE__)
    Params L = *kp;
#else
    Params L = P;
#endif
    { int b_ = blockIdx.x, g_ = gridDim.x; asm volatile("" : "+s"(b_), "+s"(g_)); L.bid = b_; L.grd = g_; }
    if (gemm_desc(ph, L, d)) gemm_phase(lds, d, L, tid);
    else switch (ph) {
      case 0: mod_phase(L, lds, tid); __syncthreads(); convert_phase(L, lds, tid); break;
      case 1: norm_mod_phase(L, L.x, L.ctx, MA, L.norm_ffn1, 0, nullptr, tid); break;
      case 4: norm_mod_phase(L, L.out, L.ctx, MA, L.norm_mix, 3, (const float*)(L.ws + OFF_PART), tid); break;
      case 6: shift_phase(L, tid); break;
      case 8: scan_phase(L, lds, tid); break;
      case 9: rwkv_out_phase(L, tid); break;
      case 11: rope_phase(L, tid); break;
      case 12: attn_phase(L, smem, tid); break;
      case 16: norm_mod_phase(L, L.out, nullptr, MT, L.norm_ffn2, 6, nullptr, tid); break;
      case 19: final_norm_phase(L, tid); break;
      default: break;
    }
    if (ph + 1 < P.ph_hi) { if (ph == 0) grid.sync(); else if (ph != 13 || !ONE_LAUNCH) xcd_barrier(gbar, bst); }
  }
#if PROBE
  grid.sync();
  if (blockIdx.x == 0) {
    LAS unsigned long long* TS = (LAS unsigned long long*)(lds + LDS_BYTES);
    if (threadIdx.x == 0) TS[NPH] = __builtin_amdgcn_s_memrealtime();
    __syncthreads();
    const int K = (int)((TS[PROBE_HI] - TS[PROBE_LO]) / 100ull);
    int t2 = threadIdx.x; asm volatile("" : "+v"(t2));
    for (int i = t2; i < K && i < 16000; i += 512) P.out[(size_t)i * 4099] += 0.1f;
  }
#endif
}

extern "C" void kernel_launch(void* const* d_in, const int* in_sizes, int n_in, void* d_out, int out_size, void* d_ws, size_t ws_size, hipStream_t stream) {
  static int grid_blocks = 0;
  if (!grid_blocks) {
    if (n_in != 31 || out_size != MT * DM || ws_size < WS_TOTAL) { fprintf(stderr, "kernel_launch: unexpected shapes n_in %d out %d ws %zu (need %zu)\n", n_in, out_size, ws_size, WS_TOTAL); return; }
    if (hipFuncSetAttribute((const void*)mega_fwd, hipFuncAttributeMaxDynamicSharedMemorySize, LDS_BYTES + 256) != hipSuccess) { fprintf(stderr, "kernel_launch: hipFuncSetAttribute failed\n"); return; }
    int dev = 0, cus = 0, per_cu = 0;
    hipGetDevice(&dev);
    hipDeviceGetAttribute(&cus, hipDeviceAttributeMultiprocessorCount, dev);
    hipOccupancyMaxActiveBlocksPerMultiprocessor(&per_cu, mega_fwd, 512, LDS_BYTES + 256);
    if (per_cu < 1) { fprintf(stderr, "kernel_launch: occupancy query returned %d\n", per_cu); per_cu = 1; }
    grid_blocks = cus;
  }
  Params p{};
  const float** pf = (const float**)&p;
  for (int i = 0; i < 31; ++i) pf[i] = (const float*)d_in[i];
  p.out = (float*)d_out; p.ws = (unsigned char*)d_ws; p.bid = 0; p.grd = 0;
#if ONE_LAUNCH
  p.ph_lo = 0; p.ph_hi = NPH;
  if (hipMemsetAsync((char*)d_ws + OFF_BAR, 0, 3456 * 4, stream) != hipSuccess) { fprintf(stderr, "kernel_launch: memset of barrier words failed\n"); return; }
  void* args[] = {&p};
  hipError_t e = hipLaunchCooperativeKernel((const void*)mega_fwd, dim3(grid_blocks), dim3(512), args, LDS_BYTES + 256, stream);
  if (e != hipSuccess) fprintf(stderr, "cooperative launch failed: %s (grid %d)\n", hipGetErrorString(e), grid_blocks);
#else
  for (int ph = 0; ph < NPH; ++ph) { p.ph_lo = ph; p.ph_hi = ph + 1; hipLaunchKernelGGL(mega_fwd, dim3(grid_blocks), dim3(512), LDS_BYTES + 256, stream, p); }
#endif
}
```

```cpp
#include <hip/hip_runtime.h>
#include <hip/hip_cooperative_groups.h>
#include <cstdio>
#include <cstdint>
namespace cg = cooperative_groups;

#ifndef ONE_LAUNCH
#define ONE_LAUNCH 1
#endif

#ifndef PROBE
#define PROBE 0
#endif
#define PROBE_LO 8
#define PROBE_HI 9
#define LAS __attribute__((address_space(3)))
typedef unsigned short bf16_t;
typedef short bf16x8 __attribute__((ext_vector_type(8)));
typedef short s16x4 __attribute__((ext_vector_type(4)));
typedef float f32x4 __attribute__((ext_vector_type(4)));
typedef float f32x2 __attribute__((ext_vector_type(2)));
typedef float f32x16 __attribute__((ext_vector_type(16)));
typedef unsigned u32x4 __attribute__((ext_vector_type(4)));
typedef unsigned u32x2 __attribute__((ext_vector_type(2)));

constexpr int DM = 2048, NB = 4, SEQ = 8192, CTXL = 256, MT = NB * SEQ, MC = NB * CTXL, MA = MT + MC;
constexpr int DFF = 5632, SKV = SEQ + CTXL, NMODC = 9 * DM;
constexpr int PRW_LD = 3584, SH_LD = 3072, LIN_LD = 384, LO_LD = 5120;
constexpr int LDS_BYTES = 139264;

constexpr size_t SZ_WA = (size_t)11264 * 2048 * 2, SZ_WB = (size_t)2048 * 5632 * 2;
constexpr size_t OFF_W1A = 0, OFF_W1B = OFF_W1A + SZ_WA, OFF_W2A = OFF_W1B + SZ_WB, OFF_W2B = OFF_W2A + SZ_WA;
constexpr size_t OFF_WRW = OFF_W2B + SZ_WB, OFF_WQKVG = OFF_WRW + (size_t)3584 * 2048 * 2, OFF_WOA = OFF_WQKVG + (size_t)7168 * 2048 * 2;
constexpr size_t OFF_WOR = OFF_WOA + (size_t)2048 * 2048 * 2, OFF_WOUT = OFF_WOR + (size_t)2048 * 1024 * 2, OFF_WLORA = OFF_WOUT + (size_t)2048 * 2048 * 2;
constexpr size_t OFF_MOD = OFF_WLORA + (size_t)5120 * 384 * 2, OFF_CX = OFF_MOD + (size_t)5 * NMODC * 4, OFF_H = OFF_CX + (size_t)MC * DM * 4;
constexpr size_t OFF_BIG = OFF_H + (size_t)MA * DM * 2;
constexpr size_t SZ_KV = (size_t)NB * SKV * 512 * 2;
constexpr size_t OFF_KB = OFF_W1A, OFF_VB = OFF_KB + SZ_KV;
static_assert(OFF_VB + SZ_KV <= OFF_W2A, "KV overlay");
constexpr size_t OFF_ACT = OFF_BIG;
constexpr size_t OFF_PART = OFF_ACT + (size_t)MA * DFF * 2;
constexpr size_t OFF_PRW = OFF_BIG, OFF_LO = OFF_BIG, OFF_SH = OFF_LO + (size_t)MA * LO_LD * 2, OFF_LIN = OFF_SH + (size_t)MA * SH_LD * 2, OFF_Y = OFF_LIN;
constexpr size_t OFF_Q = OFF_BIG, OFF_GA = OFF_Q + (size_t)MT * DM * 2, OFF_GR = OFF_GA + (size_t)MT * DM * 2;
constexpr size_t END_A = OFF_ACT + (size_t)MA * DFF * 2, END_B = OFF_Y + (size_t)2 * MT * 1024 * 2, END_C = OFF_LIN + (size_t)MA * LIN_LD * 2;
constexpr size_t WS_END = END_A > END_B ? (END_A > END_C ? END_A : END_C) : (END_B > END_C ? END_B : END_C);
constexpr size_t OFF_BAR = (WS_END + 255) / 256 * 256, OFF_RN = OFF_BAR + 3456 * 4, WS_TOTAL = OFF_RN + (size_t)MA * 16 * 4;
static_assert((size_t)MA * PRW_LD * 2 <= (size_t)MA * LO_LD * 2, "PRW under LO");
static_assert(OFF_GR + (size_t)MT * DM * 2 <= OFF_Y, "GR below RWO");

struct Params {
  const float *x, *c, *ctx, *c_ctx, *w_mod, *b_mod, *norm_ffn1, *ffn1_w_in, *ffn1_w_out, *norm_mix, *w_in, *q_norm, *k_norm, *rwkv_mu, *w0, *w2, *a0, *a2,
      *g2, *k_k, *k_a, *r_k, *ln_x_w, *ln_x_b, *w_oa, *w_or, *w_out, *norm_ffn2, *ffn2_w_in, *ffn2_w_out, *norm_final;
  float* out; unsigned char* ws; int ph_lo, ph_hi; int bid, grd;
};

__device__ __forceinline__ unsigned cvt_pk_bf16(float lo, float hi) { unsigned r; asm("v_cvt_pk_bf16_f32 %0, %1, %2" : "=v"(r) : "v"(lo), "v"(hi)); return r; }
__device__ __forceinline__ float bf2f(unsigned short b) { return __uint_as_float(((unsigned)b) << 16); }
__device__ __forceinline__ float bflo(unsigned w) { return __uint_as_float(w << 16); }
__device__ __forceinline__ float bfhi(unsigned w) { return __uint_as_float(w & 0xffff0000u); }
__device__ __forceinline__ unsigned short f2bf(float f) { return (unsigned short)(cvt_pk_bf16(f, 0.f) & 0xffffu); }
__device__ __forceinline__ float sigmoidf_(float x) { return __builtin_amdgcn_rcpf(1.f + __builtin_amdgcn_exp2f(-1.4426950408889634f * x)); }
template <int CTRL> __device__ __forceinline__ float dpp_mov(float x) { return __int_as_float(__builtin_amdgcn_update_dpp(0, __float_as_int(x), CTRL, 0xF, 0xF, true)); }
__device__ __forceinline__ float allred16(float x) {
  x += dpp_mov<0xB1>(x); x += dpp_mov<0x4E>(x); x += dpp_mov<0x141>(x); x += dpp_mov<0x140>(x); return x;
}

__device__ __forceinline__ float wave_sum(float v) {
  v = allred16(v);
  { auto rr = __builtin_amdgcn_permlane16_swap(__float_as_uint(v), __float_as_uint(v), false, false); v = __uint_as_float(rr[0]) + __uint_as_float(rr[1]); }
  { auto rr = __builtin_amdgcn_permlane32_swap(__float_as_uint(v), __float_as_uint(v), false, false); v = __uint_as_float(rr[0]) + __uint_as_float(rr[1]); }
  return v;
}

__device__ __forceinline__ float allred8(float x) { x += dpp_mov<0xB1>(x); x += dpp_mov<0x4E>(x); x += dpp_mov<0x141>(x); return x; }
constexpr int BM = 256, BK = 64, HALF = 128, HTB = HALF * BK * 2;
__device__ __forceinline__ int lds_byte(int r, int c) { const int st = (r >> 4) * 2 + (c >> 5), rr = r & 15, cc = c & 31, ob = rr * 64 + cc * 2; return st * 1024 + (ob ^ (((ob >> 9) & 1) << 5)); }
__device__ __forceinline__ void stage_rc(int b, int& R, int& C) { const int st = b / 1024, sb = b % 1024, swz = sb ^ (((sb >> 9) & 1) << 5); R = (st >> 1) * 16 + swz / 64; C = (st & 1) * 32 + (swz % 64) / 2; }
__device__ __forceinline__ int perm32(int rho) { const int n = rho >> 4, i = rho & 15; return 8 * (i >> 2) + 4 * n + (i & 3); }

enum { M_SWIGLU = 0, M_RESID = 1, M_RW = 2, M_QKVG = 3, M_LORA = 4, M_T1 = 5, M_M = 6 };
struct Unit { const char* A; const char* B; int pm, pn, seg, nt; };
struct GemmDesc {
  int K, mode, G, c;
  const bf16_t *A0, *B0; int pm00, nM0, nN0, n0;
  const bf16_t *A1, *B1; int pm01, nN1, n1;
  int a_tiled;
  int nt0, nt1, ksplit1;
  const float* xin; int gidx; float gscale;
  bf16_t* act;
};
__device__ __forceinline__ bool sched_next(const GemmDesc& d, int i, Unit& u) {
  long L = (long)i * d.G + d.c;
  if (L < d.n0) {
    int wgid = (int)L; const int nwg = d.n0;
    { const int q = nwg / 8, r = nwg % 8, xcd = wgid % 8, off = wgid / 8; wgid = (xcd < r ? xcd * (q + 1) : r * (q + 1) + (xcd - r) * q) + off; }
    const int nig = 8 * d.nN0, gid = wgid / nig, fm = gid * 8, gsz = (d.nM0 - fm) < 8 ? (d.nM0 - fm) : 8;
    const int pm = fm + ((wgid % nig) % gsz), pn = (wgid % nig) / gsz;
    u.pm = d.pm00 + pm; u.pn = pn; u.seg = 0; u.nt = d.nt0;
    u.A = (const char*)d.A0 + (size_t)u.pm * 512 * d.K; u.B = (const char*)d.B0 + (size_t)pn * 512 * d.K;
    if (d.mode == M_LORA) { const int ko = (pn < 8 ? 0 : (pn < 16 ? 128 : 256)) * 2; u.A += ko; u.B += ko; }
    return true;
  }
  L -= d.n0;
  if (L < d.n1) {
    const int sp = (int)L % d.ksplit1, l2 = (int)L / d.ksplit1;
    const int pm = l2 / d.nN1, pn = l2 % d.nN1; u.pm = d.pm01 + pm; u.pn = pn; u.seg = 1 + sp; u.nt = d.nt1;
    const size_t ko = (size_t)sp * d.nt1 * 128, koA = d.a_tiled ? (size_t)sp * d.nt1 * 32768 : ko;
    u.A = (const char*)d.A1 + (size_t)u.pm * 512 * d.K + koA; u.B = (const char*)d.B1 + (size_t)pn * 512 * d.K + ko; return true;
  }
  return false;
}

__device__ __forceinline__ void gemm_epilogue(const f32x4 (&acc)[2][2][4][2], const Unit& u, const GemmDesc& d, const Params& P, int wr, int wc, int fr, int fq) {
  unsigned char* ws = P.ws;
  asm volatile("" : "+v"(fr), "+v"(fq));
  const int rl0 = wr * 64 + fr, cl0 = wc * 32 + 8 * fq;
  switch (d.mode) {
  case M_SWIGLU: {
    bf16_t* base = d.act + ((size_t)(u.pm * 88 + u.pn * 2 + (cl0 >> 6)) * 256) * 64 + (cl0 & 63);
#pragma unroll
    for (int ai = 0; ai < 2; ++ai)
#pragma unroll
      for (int m = 0; m < 4; ++m) {
        const int row = rl0 + 128 * ai + 16 * m;
        float o[8];
#pragma unroll
        for (int n = 0; n < 2; ++n)
#pragma unroll
          for (int j = 0; j < 4; ++j) { const float g = acc[ai][0][m][n][j], up = acc[ai][1][m][n][j]; o[4 * n + j] = g * sigmoidf_(g) * up; }
        u32x4 w; w.x = cvt_pk_bf16(o[0], o[1]); w.y = cvt_pk_bf16(o[2], o[3]); w.z = cvt_pk_bf16(o[4], o[5]); w.w = cvt_pk_bf16(o[6], o[7]);
        *(u32x4*)(base + (size_t)row * 64) = w;
      }
  } break;
  case M_RESID: {
    if (u.seg >= 1) {
      float* po = (float*)(ws + OFF_PART) + (size_t)(u.seg - 1) * MC * DM + (size_t)(u.pm - 128) * 256 * DM + u.pn * 256 + cl0;
#pragma unroll
      for (int ai = 0; ai < 2; ++ai)
#pragma unroll
        for (int m = 0; m < 4; ++m)
#pragma unroll
          for (int bj = 0; bj < 2; ++bj)
#pragma unroll
            for (int n = 0; n < 2; ++n) *(f32x4*)(po + (size_t)(rl0 + 128 * ai + 16 * m) * DM + 128 * bj + 4 * n) = acc[ai][bj][m][n];
      break;
    }
    const bool isc = u.pm >= 128; const int b = isc ? 4 : (u.pm >> 5);
    const float* xin = isc ? P.ctx + (size_t)(u.pm - 128) * 256 * DM : d.xin + (size_t)u.pm * 256 * DM;
    float* xo = isc ? (float*)(ws + OFF_CX) + (size_t)(u.pm - 128) * 256 * DM : P.out + (size_t)u.pm * 256 * DM;
    const float* gate = (const float*)(ws + OFF_MOD) + b * NMODC + d.gidx * DM + u.pn * 256 + cl0;
    f32x4 g4[2][2];
#pragma unroll
    for (int bj = 0; bj < 2; ++bj)
#pragma unroll
      for (int n = 0; n < 2; ++n) g4[bj][n] = *(const f32x4*)(gate + 128 * bj + 4 * n) * d.gscale;
#pragma unroll
    for (int ai = 0; ai < 2; ++ai)
#pragma unroll
      for (int m = 0; m < 4; ++m) {
        const size_t ro = (size_t)(rl0 + 128 * ai + 16 * m) * DM + u.pn * 256 + cl0;
#pragma unroll
        for (int bj = 0; bj < 2; ++bj)
#pragma unroll
          for (int n = 0; n < 2; ++n) {
            const f32x4 xv = *(const f32x4*)(xin + ro + 128 * bj + 4 * n);
            *(f32x4*)(xo + ro + 128 * bj + 4 * n) = xv + g4[bj][n] * acc[ai][bj][m][n];
          }
      }
  } break;
  case M_RW: case M_QKVG: case M_LORA: {
    bf16_t* base; int ld; int act = 0; const float* bias = nullptr;
    if (d.mode == M_RW) {
      if (u.seg == 0) { base = (bf16_t*)(ws + OFF_PRW) + (size_t)u.pm * 256 * PRW_LD + u.pn * 256; ld = PRW_LD; }
      else { const int b = u.pm - 128; base = (bf16_t*)(ws + (u.pn < 2 ? OFF_KB : OFF_VB)) + (size_t)(b * SKV + SEQ) * 512 + (u.pn & 1) * 256; ld = 512; }
    } else if (d.mode == M_QKVG) {
      const int b = u.pm >> 5;
      if (u.pn < 8) { base = (bf16_t*)(ws + OFF_Q) + (size_t)u.pm * 256 * DM + u.pn * 256; ld = DM; }
      else if (u.pn < 12) { base = (bf16_t*)(ws + (u.pn < 10 ? OFF_KB : OFF_VB)) + (size_t)(u.pm * 256 + b * CTXL) * 512 + (u.pn & 1) * 256; ld = 512; }
      else { base = (bf16_t*)(ws + (u.pn < 20 ? OFF_GA : OFF_GR)) + (size_t)u.pm * 256 * DM + ((u.pn - 12) & 7) * 256; ld = DM; act = 1; }
    } else {
      base = (bf16_t*)(ws + OFF_LO) + (size_t)u.pm * 256 * LO_LD + u.pn * 256; ld = LO_LD;
      if (u.pn < 8) { act = 2; bias = P.w0 + u.pn * 256; } else if (u.pn < 16) { act = 1; bias = P.a0 + (u.pn - 8) * 256; }
    }
#pragma unroll
    for (int bj = 0; bj < 2; ++bj) {
      f32x4 b0 = {0.f, 0.f, 0.f, 0.f}, b1 = {0.f, 0.f, 0.f, 0.f};
      if (bias) { b0 = *(const f32x4*)(bias + 128 * bj + cl0); b1 = *(const f32x4*)(bias + 128 * bj + cl0 + 4); }
#pragma unroll
      for (int ai = 0; ai < 2; ++ai)
#pragma unroll
        for (int m = 0; m < 4; ++m) {
          const int row = rl0 + 128 * ai + 16 * m;
          f32x4 v0 = acc[ai][bj][m][0] + b0, v1 = acc[ai][bj][m][1] + b1;
          if (act) {
            const float sc = act == 2 ? 0.60653065971263342f * 1.4426950408889634f : 1.f;
#pragma unroll
            for (int j = 0; j < 4; ++j) { v0[j] = sc * sigmoidf_(v0[j]); v1[j] = sc * sigmoidf_(v1[j]); }
          }
          u32x4 w; w.x = cvt_pk_bf16(v0[0], v0[1]); w.y = cvt_pk_bf16(v0[2], v0[3]); w.z = cvt_pk_bf16(v1[0], v1[1]); w.w = cvt_pk_bf16(v1[2], v1[3]);
          *(u32x4*)(base + (size_t)row * ld + 128 * bj + cl0) = w;
        }
    }
  } break;
  case M_T1: case M_M: {
    bf16_t* ga = (bf16_t*)(ws + OFF_GA) + (size_t)u.pm * 256 * DM + u.pn * 256 + cl0;
    bf16_t* gr = (bf16_t*)(ws + OFF_GR) + (size_t)u.pm * 256 * DM + u.pn * 256 + cl0;
    const bool isM = d.mode == M_M;
#pragma unroll
    for (int ai = 0; ai < 2; ++ai)
#pragma unroll
      for (int m = 0; m < 4; ++m)
#pragma unroll
        for (int bj = 0; bj < 2; ++bj) {
          const size_t o = (size_t)(rl0 + 128 * ai + 16 * m) * DM + 128 * bj;
          const f32x4 v0 = acc[ai][bj][m][0], v1 = acc[ai][bj][m][1];
          const u32x4 a = *(const u32x4*)(ga + o);
          u32x4 w;
          if (!isM) {
            w.x = cvt_pk_bf16(bflo(a.x) * v0[0], bfhi(a.x) * v0[1]); w.y = cvt_pk_bf16(bflo(a.y) * v0[2], bfhi(a.y) * v0[3]);
            w.z = cvt_pk_bf16(bflo(a.z) * v1[0], bfhi(a.z) * v1[1]); w.w = cvt_pk_bf16(bflo(a.w) * v1[2], bfhi(a.w) * v1[3]);
            *(u32x4*)(ga + o) = w;
          } else {
            const u32x4 g = *(const u32x4*)(gr + o);
            w.x = cvt_pk_bf16(bflo(a.x) + bflo(g.x) * v0[0], bfhi(a.x) + bfhi(g.x) * v0[1]); w.y = cvt_pk_bf16(bflo(a.y) + bflo(g.y) * v0[2], bfhi(a.y) + bfhi(g.y) * v0[3]);
            w.z = cvt_pk_bf16(bflo(a.z) + bflo(g.z) * v1[0], bfhi(a.z) + bfhi(g.z) * v1[1]); w.w = cvt_pk_bf16(bflo(a.w) + bflo(g.w) * v1[2], bfhi(a.w) + bfhi(g.w) * v1[3]);
            *(u32x4*)(gr + o) = w;
          }
        }
  } break;
  }
}

__device__ __forceinline__ void gemm_phase(LAS unsigned char* lds, const GemmDesc& d, const Params& P, const int tid) {
  const int wid = __builtin_amdgcn_readfirstlane(tid >> 6), lane = tid & 63, wr = wid >> 2, wc = wid & 3, fr = lane & 15, fq = lane >> 4;
  const int K = d.K;
  unsigned voffA[2], voffB[2];
#pragma unroll
  for (int i = 0; i < 2; ++i) { int R, C; stage_rc(tid * 16 + i * 8192, R, C); const int Rb = (R & ~31) + perm32(R & 31);
    voffA[i] = d.a_tiled ? (unsigned)(R * 64 + C) * 2u : (unsigned)(R * K + C) * 2u; voffB[i] = (unsigned)(Rb * K + C) * 2u; }
  const size_t kstep = (size_t)(BK * 2);
  const size_t hstep = (size_t)HALF * K * 2;
  const size_t kstepA = d.a_tiled ? (size_t)32768 : kstep, hstepA = d.a_tiled ? (size_t)16384 : hstep;
  const unsigned ldsw = (unsigned)wid * 1024u;
  const int aoff = lds_byte(wr * 64 + fr, fq * 8), boff = lds_byte(wc * 32 + fr, fq * 8);
#define PG8_SA(b, h) (((b) * 2 + (h)) * HTB)
#define PG8_SB(b, h) ((4 + (b) * 2 + (h)) * HTB)
#define PG8_STAGE(bufoff, gbase, voff) do { _Pragma("unroll") for (int _i = 0; _i < 2; ++_i) \
    __builtin_amdgcn_global_load_lds((const unsigned*)((const char*)(gbase) + (voff)[_i]), (LAS unsigned*)(lds + (bufoff) + ldsw + _i * 8192), 16, 0, 0); } while (0)
#define PG8_LDA(dst, b, h) do { _Pragma("unroll") for (int m = 0; m < 4; ++m) _Pragma("unroll") for (int k = 0; k < 2; ++k) dst[m][k] = *(const LAS bf16x8*)(lds + PG8_SA(b, h) + aoff + m * 2048 + k * 1024); } while (0)
#define PG8_LDB(dst, b, h) do { _Pragma("unroll") for (int n = 0; n < 2; ++n) _Pragma("unroll") for (int k = 0; k < 2; ++k) dst[n][k] = *(const LAS bf16x8*)(lds + PG8_SB(b, h) + boff + n * 2048 + k * 1024); } while (0)
#define PG8_MMA(ai, bj, At, Bt) do { __builtin_amdgcn_s_setprio(1); _Pragma("unroll") for (int m = 0; m < 4; ++m) _Pragma("unroll") for (int n = 0; n < 2; ++n) _Pragma("unroll") for (int k = 0; k < 2; ++k) \
    acc[ai][bj][m][n] = __builtin_amdgcn_mfma_f32_16x16x32_bf16(Bt[n][k], At[m][k], acc[ai][bj][m][n], 0, 0, 0); __builtin_amdgcn_s_setprio(0); } while (0)
#define PG8_WAIT_V(n) asm volatile("s_waitcnt vmcnt(" #n ")" ::: "memory")
#define PG8_WAIT_L(n) asm volatile("s_waitcnt lgkmcnt(" #n ")" ::: "memory")
#define PG8_BAR __builtin_amdgcn_s_barrier()
#define PG8_SCHED __builtin_amdgcn_sched_barrier(0)
  Unit cur, nxt; int ui = 0;
  if (!sched_next(d, 0, cur)) return;
  f32x4 acc[2][2][4][2];
#pragma unroll
  for (int a = 0; a < 2; ++a)
#pragma unroll
    for (int b = 0; b < 2; ++b)
#pragma unroll
      for (int m = 0; m < 4; ++m)
#pragma unroll
        for (int n = 0; n < 2; ++n) acc[a][b][m][n] = (f32x4){0.f, 0.f, 0.f, 0.f};
  bf16x8 At[4][2], B0[2][2], B1[2][2];
  const char* cA = cur.A; const char* cB = cur.B;
  PG8_STAGE(PG8_SB(0, 0), cB, voffB); PG8_STAGE(PG8_SB(0, 1), cB + hstep, voffB); PG8_STAGE(PG8_SA(0, 0), cA, voffA); PG8_STAGE(PG8_SA(0, 1), cA + hstepA, voffA);
  if (wr == 1) PG8_BAR;
  PG8_WAIT_V(2); PG8_BAR;
  PG8_STAGE(PG8_SB(1, 0), cB + kstep, voffB); PG8_STAGE(PG8_SA(1, 0), cA + kstepA, voffA); PG8_STAGE(PG8_SB(1, 1), cB + hstep + kstep, voffB);
  PG8_WAIT_V(6); PG8_BAR;
  for (;;) {
    const bool has_next = sched_next(d, ui + 1, nxt);
    const char* nA = has_next ? nxt.A : cA; const char* nB = has_next ? nxt.B : cB;
    const int nt = cur.nt;
    for (int t = 0; t < nt; t += 2) {
      const bool last = (t == nt - 2);
      const char* a1 = cA + (size_t)(t + 1) * kstepA;
      const char* a2 = last ? nA : cA + (size_t)(t + 2) * kstepA; const char* b2 = last ? nB : cB + (size_t)(t + 2) * kstep;
      const char* a3 = a2 + kstepA; const char* b3 = b2 + kstep;
      PG8_LDB(B0, 0, 0); PG8_LDB(B1, 0, 1); PG8_SCHED; PG8_LDA(At, 0, 0); PG8_STAGE(PG8_SA(1, 1), a1 + hstepA, voffA);
      PG8_WAIT_V(8); PG8_WAIT_L(0); PG8_BAR; PG8_MMA(0, 0, At, B0); PG8_MMA(0, 1, At, B1); PG8_BAR; PG8_SCHED;
      PG8_LDA(At, 0, 1); PG8_STAGE(PG8_SB(0, 0), b2, voffB); PG8_STAGE(PG8_SB(0, 1), b2 + hstep, voffB); PG8_STAGE(PG8_SA(0, 0), a2, voffA);
      PG8_WAIT_V(8); PG8_WAIT_L(0); PG8_BAR; PG8_MMA(1, 0, At, B0); PG8_MMA(1, 1, At, B1); PG8_BAR; PG8_SCHED;
      PG8_LDB(B0, 1, 0); PG8_LDB(B1, 1, 1); PG8_SCHED; PG8_LDA(At, 1, 0); PG8_STAGE(PG8_SA(0, 1), a2 + hstepA, voffA);
      PG8_WAIT_V(8); PG8_WAIT_L(0); PG8_BAR; PG8_MMA(0, 0, At, B0); PG8_MMA(0, 1, At, B1); PG8_BAR; PG8_SCHED;
      PG8_LDA(At, 1, 1); PG8_STAGE(PG8_SB(1, 0), b3, voffB); PG8_STAGE(PG8_SB(1, 1), b3 + hstep, voffB); PG8_STAGE(PG8_SA(1, 0), a3, voffA);
      PG8_WAIT_V(8); PG8_WAIT_L(0); PG8_BAR; PG8_MMA(1, 0, At, B0); PG8_MMA(1, 1, At, B1); PG8_BAR; PG8_SCHED;
    }
    if (wr == 0) PG8_BAR;
    gemm_epilogue(acc, cur, d, P, wr, wc, fr, fq);
    if (!has_next) break;
#pragma unroll
    for (int a = 0; a < 2; ++a)
#pragma unroll
      for (int b = 0; b < 2; ++b)
#pragma unroll
        for (int m = 0; m < 4; ++m)
#pragma unroll
          for (int n = 0; n < 2; ++n) acc[a][b][m][n] = (f32x4){0.f, 0.f, 0.f, 0.f};
    cur = nxt; cA = nA; cB = nB; ++ui;
    if (wr == 1) PG8_BAR;
  }
  PG8_WAIT_V(0);
  PG8_BAR;
#undef PG8_SA
#undef PG8_SB
#undef PG8_STAGE
#undef PG8_LDA
#undef PG8_LDB
#undef PG8_MMA
#undef PG8_WAIT_V
#undef PG8_WAIT_L
#undef PG8_BAR
#undef PG8_SCHED
}

namespace att {
constexpr int D = 128, NW = 8, QBLK = 32, KVBLK = 64;
constexpr float SCALE = 0.088388347648318440f;
constexpr float THR = 8.f;
constexpr int LDQ = 2048, LDK = 512, LDO = 2048;
constexpr size_t SHM_V = KVBLK * D * 2, SHM_K = KVBLK * D * 2;
#define KSWZ(row, colB) ((row) * 256 + ((colB) ^ (((row) & 7) << 4)))
#define SBAR() __builtin_amdgcn_sched_barrier(0)
__device__ __forceinline__ int crow(int r, int hi) { return (r & 3) + 8 * (r >> 2) + 4 * hi; }
__device__ __forceinline__ unsigned cvtpk(float lo, float hi) { unsigned r; asm volatile("v_cvt_pk_bf16_f32 %0, %1, %2" : "=v"(r) : "v"(lo), "v"(hi)); return r; }
__device__ __forceinline__ void partialSM(f32x16& p0, f32x16& p1, float& m_reg, float& mn, float& alpha) {
  constexpr float C = SCALE * 1.4426950408889634f;
  float pmax = p0[0];
#pragma unroll
  for (int r = 1; r < 16; ++r) pmax = fmaxf(pmax, p0[r]);
#pragma unroll
  for (int r = 0; r < 16; ++r) pmax = fmaxf(pmax, p1[r]);
  { auto rr = __builtin_amdgcn_permlane32_swap(__float_as_uint(pmax), __float_as_uint(pmax), false, false);
    pmax = fmaxf(__uint_as_float(rr[0]), __uint_as_float(rr[1])); }
  if (__builtin_expect(__all(pmax - m_reg <= THR / SCALE), 1)) { mn = m_reg; alpha = 1.f; }
  else { mn = fmaxf(m_reg, pmax); alpha = __builtin_amdgcn_exp2f((m_reg - mn) * C); m_reg = mn; }
  float mnC = -mn * C;
#pragma unroll
  for (int r = 0; r < 16; ++r) p0[r] = fmaf(p0[r], C, mnC);
#pragma unroll
  for (int r = 0; r < 16; ++r) p1[r] = fmaf(p1[r], C, mnC);
#pragma unroll
  for (int r = 0; r < 16; ++r) p0[r] = __builtin_amdgcn_exp2f(p0[r]);
}
__device__ __forceinline__ void finishSM(f32x16& p0, f32x16& p1, float alpha, float& l_reg, bf16x8& pa0, bf16x8& pa1, bf16x8& pa2, bf16x8& pa3) {
#pragma unroll
  for (int r = 0; r < 16; ++r) p1[r] = __builtin_amdgcn_exp2f(p1[r]);
  float ps = 0;
#pragma unroll
  for (int r = 0; r < 16; ++r) ps += p0[r];
#pragma unroll
  for (int r = 0; r < 16; ++r) ps += p1[r];
  { auto rr = __builtin_amdgcn_permlane32_swap(__float_as_uint(ps), __float_as_uint(ps), false, false);
    ps = __uint_as_float(rr[0]) + __uint_as_float(rr[1]); }
  l_reg = l_reg * alpha + ps;
#define PK4(P, BASE, OUT) do { unsigned a0 = cvtpk(P[BASE + 0], P[BASE + 1]), a1 = cvtpk(P[BASE + 2], P[BASE + 3]);   \
    unsigned b0 = cvtpk(P[BASE + 4], P[BASE + 5]), b1 = cvtpk(P[BASE + 6], P[BASE + 7]);                              \
    auto r0 = __builtin_amdgcn_permlane32_swap(a0, b0, false, false); auto r1 = __builtin_amdgcn_permlane32_swap(a1, b1, false, false); \
    u32x4 w = {r0[0], r1[0], r0[1], r1[1]}; OUT = *reinterpret_cast<bf16x8*>(&w); } while (0)
  PK4(p0, 0, pa0); PK4(p0, 8, pa1); PK4(p1, 0, pa2); PK4(p1, 8, pa3);
#undef PK4
}
__device__ __forceinline__ void qkt(f32x16& p0, f32x16& p1, const bf16_t* Ks, const bf16x8* qr, int r32, int hi) {
  p0 = f32x16{}; p1 = f32x16{};
#pragma unroll
  for (int d0 = 0; d0 < 8; ++d0) { int cb = (d0 * 16 + hi * 8) * 2;
    bf16x8 b0 = *reinterpret_cast<const bf16x8*>((const char*)Ks + KSWZ(r32, cb));
    bf16x8 b1 = *reinterpret_cast<const bf16x8*>((const char*)Ks + KSWZ(32 + r32, cb));
    p0 = __builtin_amdgcn_mfma_f32_32x32x16_bf16(b0, qr[d0], p0, 0, 0, 0);
    p1 = __builtin_amdgcn_mfma_f32_32x32x16_bf16(b1, qr[d0], p1, 0, 0, 0); }
}
__device__ __forceinline__ int v_st(int k, int c) { const int kk = (k & ~0xC) | ((k & 4) << 1) | ((k & 8) >> 1); return ((kk >> 3) * 4 + (c >> 5)) * 512 + ((kk & 7) * 32 + (c & 31)) * 2; }
__device__ __forceinline__ int v_rd_base(int lane) { return ((lane & 3) << 3) | (((lane >> 2) & 3) << 6) | (((lane >> 4) & 1) << 5) | (((lane >> 5) & 1) << 8); }
constexpr int v_rd_off(int d0, int ks, int half) { return d0 * 512 + ks * 4096 + half * 2048; }
template <int OFF> __device__ __forceinline__ s16x4 tr_read(int vb) {
  s16x4 r; asm volatile("ds_read_b64_tr_b16 %0, %1 offset:%2" : "=&v"(r) : "v"(vb), "i"(OFF) : "memory"); return r;
}
template <int D0> __device__ __forceinline__ void pv_one(f32x16& od, int vb, bf16x8 pa0, bf16x8 pa1, bf16x8 pa2, bf16x8 pa3) {
  const s16x4 l0 = tr_read<v_rd_off(D0, 0, 0)>(vb), h0 = tr_read<v_rd_off(D0, 0, 1)>(vb), l1 = tr_read<v_rd_off(D0, 1, 0)>(vb), h1 = tr_read<v_rd_off(D0, 1, 1)>(vb);
  const s16x4 l2 = tr_read<v_rd_off(D0, 2, 0)>(vb), h2 = tr_read<v_rd_off(D0, 2, 1)>(vb), l3 = tr_read<v_rd_off(D0, 3, 0)>(vb), h3 = tr_read<v_rd_off(D0, 3, 1)>(vb);
  asm volatile("s_waitcnt lgkmcnt(0)" ::: "memory"); SBAR();
#define PK(L, H) (bf16x8){L[0], L[1], L[2], L[3], H[0], H[1], H[2], H[3]}
  od = __builtin_amdgcn_mfma_f32_32x32x16_bf16(pa0, PK(l0, h0), od, 0, 0, 0);
  od = __builtin_amdgcn_mfma_f32_32x32x16_bf16(pa1, PK(l1, h1), od, 0, 0, 0);
  od = __builtin_amdgcn_mfma_f32_32x32x16_bf16(pa2, PK(l2, h2), od, 0, 0, 0);
  od = __builtin_amdgcn_mfma_f32_32x32x16_bf16(pa3, PK(l3, h3), od, 0, 0, 0);
#undef PK
}
__device__ __forceinline__ void pv_d0(f32x16* o, int vb, bf16x8 pa0, bf16x8 pa1, bf16x8 pa2, bf16x8 pa3) {
  pv_one<0>(o[0], vb, pa0, pa1, pa2, pa3); pv_one<1>(o[1], vb, pa0, pa1, pa2, pa3); pv_one<2>(o[2], vb, pa0, pa1, pa2, pa3); pv_one<3>(o[3], vb, pa0, pa1, pa2, pa3);
}
__device__ __forceinline__ void attn_dense_body(const bf16_t* __restrict__ Qb, const bf16_t* __restrict__ Kh, const bf16_t* __restrict__ Vh,
                                                bf16_t* __restrict__ Ob, int seq, char* lds, const int tid) {
  const int wid = tid >> 6, lane = tid & 63, r32 = lane & 31, hi = lane >> 5;
  bf16_t* V_lds = (bf16_t*)lds; bf16_t* K_lds = (bf16_t*)(lds + 2 * SHM_V);
  float* wsf = (float*)(lds + 2 * SHM_V + 2 * SHM_K) + wid * 64; float* li_l = wsf; float* al_l = wsf + 32;
  float m_reg = -1e30f, l_reg = 0; f32x16 o[4] = {}; bf16x8 qr[8];
  const bf16_t* Qw = Qb + (long)(wid * QBLK + r32) * LDQ + hi * 8;
#pragma unroll
  for (int d0 = 0; d0 < 8; ++d0) qr[d0] = *reinterpret_cast<const bf16x8*>(Qw + d0 * 16);
  const int sr = tid >> 4, sc = (tid & 15) * 8, vst0 = v_st(sr, sc), vst1 = v_st(32 + sr, sc);
  const int vb0 = (int)(uintptr_t)V_lds + v_rd_base(lane);
  struct { bf16x8 vs0, vs1, ks0, ks1; } sr_[2];
#define LD8(p) (*reinterpret_cast<const bf16x8*>(p))
  const unsigned voff = (unsigned)(sr * LDK + sc) * 2u;
#define SLOAD(i, k0) do { const char* vb_ = (const char*)(Vh + (size_t)(k0) * LDK); const char* kb_ = (const char*)(Kh + (size_t)(k0) * LDK); \
    sr_[i].vs0 = LD8(vb_ + voff); sr_[i].vs1 = LD8(vb_ + 32 * LDK * 2 + voff); sr_[i].ks0 = LD8(kb_ + voff); sr_[i].ks1 = LD8(kb_ + 32 * LDK * 2 + voff); } while (0)
#define SWRITE(b, i) do { *(bf16x8*)((char*)V_lds + (b) * SHM_V + vst0) = sr_[i].vs0;          \
    *(bf16x8*)((char*)V_lds + (b) * SHM_V + vst1) = sr_[i].vs1; int kc = sc * 2;               \
    *(bf16x8*)((char*)K_lds + (b) * SHM_K + KSWZ(sr, kc)) = sr_[i].ks0;                       \
    *(bf16x8*)((char*)K_lds + (b) * SHM_K + KSWZ(32 + sr, kc)) = sr_[i].ks1; } while (0)
#define SWAIT() asm volatile("s_waitcnt vmcnt(4)" ::: "memory")
#define RESC(a) do { if (__any((a) < 1.f)) { if (hi == 0) al_l[r32] = (a); asm volatile("s_waitcnt lgkmcnt(0)" ::: "memory"); \
    _Pragma("unroll") for (int d = 0; d < 4; ++d) _Pragma("unroll") for (int r = 0; r < 16; ++r) o[d][r] *= al_l[crow(r, hi)]; } } while (0)
  f32x16 pA0, pA1, pB0, pB1; float mnA, mnB, alA, alB; bf16x8 pa0, pa1, pa2, pa3; const int NT = seq / KVBLK;
  constexpr int SE = 0, SO = 1;
  SLOAD(SE, 0); asm volatile("s_waitcnt vmcnt(0)" ::: "memory"); SWRITE(0, SE); __syncthreads();
  qkt(pA0, pA1, K_lds, qr, r32, hi); partialSM(pA0, pA1, m_reg, mnA, alA);
  SLOAD(SO, KVBLK); if (2 < NT) SLOAD(SE, 2 * KVBLK);
  SWAIT(); SWRITE(1, SO); __syncthreads();
  for (int j = 1; j + 1 < NT; j += 2) {
    SBAR(); qkt(pB0, pB1, (bf16_t*)((char*)K_lds + SHM_K), qr, r32, hi);
    finishSM(pA0, pA1, alA, l_reg, pa0, pa1, pa2, pa3); SBAR();
    SLOAD(SO, (j + 2) * KVBLK); SBAR();
    pv_d0(o, vb0, pa0, pa1, pa2, pa3); partialSM(pB0, pB1, m_reg, mnB, alB);
    __syncthreads(); SWAIT(); SWRITE(0, SE);
    RESC(alB); __syncthreads();
    SBAR(); qkt(pA0, pA1, K_lds, qr, r32, hi);
    finishSM(pB0, pB1, alB, l_reg, pa0, pa1, pa2, pa3); SBAR();
    if (j + 3 < NT) SLOAD(SE, (j + 3) * KVBLK); SBAR();
    pv_d0(o, vb0 + (int)SHM_V, pa0, pa1, pa2, pa3); partialSM(pA0, pA1, m_reg, mnA, alA);
    __syncthreads(); SWAIT(); SWRITE(1, SO);
    RESC(alA); __syncthreads();
  }
  SBAR(); qkt(pB0, pB1, (bf16_t*)((char*)K_lds + SHM_K), qr, r32, hi);
  finishSM(pA0, pA1, alA, l_reg, pa0, pa1, pa2, pa3); SBAR();
  pv_d0(o, vb0, pa0, pa1, pa2, pa3); partialSM(pB0, pB1, m_reg, mnB, alB);
  __syncthreads(); RESC(alB);
  finishSM(pB0, pB1, alB, l_reg, pa0, pa1, pa2, pa3); SBAR();
  pv_d0(o, vb0 + (int)SHM_V, pa0, pa1, pa2, pa3);
  if (hi == 0) li_l[r32] = l_reg; asm volatile("s_waitcnt lgkmcnt(0)" ::: "memory");
  float rli[16];
#pragma unroll
  for (int r = 0; r < 16; ++r) rli[r] = __builtin_amdgcn_rcpf(li_l[crow(r, hi)]);
  bf16_t* Ow = Ob + (long)(wid * QBLK) * LDO;
#pragma unroll
  for (int r = 0; r < 16; ++r) { int orow = crow(r, hi);
#pragma unroll
    for (int d0 = 0; d0 < 4; ++d0) Ow[(long)orow * LDO + d0 * 32 + r32] = f2bf(o[d0][r] * rli[r]); }
#undef LD8
#undef SLOAD
#undef SWRITE
#undef SWAIT
#undef RESC
}
}

__device__ __forceinline__ void mod_phase(const Params& P, LAS unsigned char* lds, const int tid) {
  LAS float* sc = (LAS float*)lds; LAS float* red = sc + 5 * 2048;
  const int wid = tid >> 6, lane = tid & 63;
  for (int i = tid; i < 5 * 2048; i += 512) { const int j = i >> 11, k = i & 2047; const float v = (j < 4) ? P.c[j * 2048 + k] : P.c_ctx[k]; sc[i] = v * sigmoidf_(v); }
  __syncthreads();
  float* MOD = (float*)(P.ws + OFF_MOD);
  const int rg = lane / 18, cl = lane - rg * 18;
  for (int task = P.bid; task < 256; task += P.grd) {
    f32x4 a[5];
#pragma unroll
    for (int j = 0; j < 5; ++j) a[j] = (f32x4){0.f, 0.f, 0.f, 0.f};
    if (lane < 54) {
      const float* wp = P.w_mod + (size_t)(wid * 256 + rg) * NMODC + task * 72 + cl * 4;
#pragma unroll 8
      for (int i = 0; i < 86; ++i) {
        const int kk = 3 * i + rg;
        if (kk < 256) {
          const f32x4 w = *(const f32x4*)(wp + (size_t)(3 * i) * NMODC);
#pragma unroll
          for (int j = 0; j < 5; ++j) a[j] += w * sc[j * 2048 + wid * 256 + kk];
        }
      }
#pragma unroll
      for (int j = 0; j < 5; ++j) *(LAS f32x4*)(red + ((wid * 3 + rg) * 5 + j) * 72 + cl * 4) = a[j];
    }
    __syncthreads();
    if (tid < 360) { const int j = tid / 72, ci = tid % 72; float s = 0.f;
#pragma unroll
      for (int w = 0; w < 24; ++w) s += red[(w * 5 + j) * 72 + ci];
      MOD[j * NMODC + task * 72 + ci] = s + P.b_mod[task * 72 + ci]; }
    __syncthreads();
  }
}
__device__ __forceinline__ void tr_load(float (&tv)[32], const float* __restrict__ W, int ldw, int k0, int n0, int lane) {
#pragma unroll
  for (int i = 0; i < 32; ++i) { const int kk = 2 * i + (lane >> 5); tv[i] = W[(size_t)(k0 + kk) * ldw + n0 + (lane & 31)]; }
}
__device__ __forceinline__ void tr_store(const float (&tv)[32], int k0, bf16_t* __restrict__ WT, int ldt, int drow0, int dk0, LAS float* scr, int lane) {
#pragma unroll
  for (int i = 0; i < 32; ++i) { const int kk = 2 * i + (lane >> 5); scr[kk * 33 + (lane & 31)] = tv[i]; }
  asm volatile("s_waitcnt lgkmcnt(0)" ::: "memory");
  const int c = lane & 7;
#pragma unroll
  for (int j = 0; j < 4; ++j) { const int n = (lane >> 3) + 8 * j; const LAS float* s = scr + (8 * c) * 33 + n;
    u32x4 o; o.x = cvt_pk_bf16(s[0 * 33], s[1 * 33]); o.y = cvt_pk_bf16(s[2 * 33], s[3 * 33]); o.z = cvt_pk_bf16(s[4 * 33], s[5 * 33]); o.w = cvt_pk_bf16(s[6 * 33], s[7 * 33]);
    *(u32x4*)(WT + (size_t)(drow0 + n) * ldt + dk0 + k0 + 8 * c) = o; }
  asm volatile("s_waitcnt lgkmcnt(0)" ::: "memory");
}
__device__ __forceinline__ void tr_item(const float* __restrict__ W, int ldw, int k0, int n0, bf16_t* __restrict__ WT, int ldt, int drow0, int dk0, LAS float* scr, int lane) {
  float tv[32]; tr_load(tv, W, ldw, k0, n0, lane); tr_store(tv, k0, WT, ldt, drow0, dk0, scr, lane);
}
constexpr int N_LATE = 16896 + 6144 + 2048 + 1024 + 2048;
__device__ __forceinline__ void late_item_addr(const Params& P, int j, const float*& W, int& ldw, int& k0, int& n0, bf16_t*& WT, int& ldt, int& drow) {
  if (j < 11264) { const int kb = j / 352, nb = j % 352; n0 = nb * 32; k0 = kb * 64; W = P.ffn2_w_in; ldw = 2 * DFF; WT = (bf16_t*)(P.ws + OFF_W2A); ldt = 2048;
    drow = n0 < DFF ? (n0 >> 7) * 256 + (n0 & 127) : ((n0 - DFF) >> 7) * 256 + 128 + ((n0 - DFF) & 127); return; }
  j -= 11264;
  if (j < 5632) { const int kb = j >> 6, nb = j & 63; n0 = nb * 32; k0 = kb * 64; W = P.ffn2_w_out; ldw = 2048; WT = (bf16_t*)(P.ws + OFF_W2B); ldt = DFF; drow = n0; return; }
  j -= 5632;
  if (j < 6144) { const int kb = j / 192, nbi = j % 192, nb = nbi < 64 ? nbi : nbi + 32;
    n0 = nb < 96 ? nb * 32 : 6528 + (nb - 96) * 32; k0 = kb * 64; W = P.w_in; ldw = 10624; WT = (bf16_t*)(P.ws + OFF_WQKVG); ldt = 2048; drow = nb * 32; return; }
  j -= 6144;
  if (j < 2048) { k0 = (j >> 6) * 64; n0 = (j & 63) * 32; W = P.w_oa; ldw = 2048; WT = (bf16_t*)(P.ws + OFF_WOA); ldt = 2048; drow = n0; return; }
  j -= 2048;
  if (j < 1024) { k0 = (j >> 6) * 64; n0 = (j & 63) * 32; W = P.w_or; ldw = 2048; WT = (bf16_t*)(P.ws + OFF_WOR); ldt = 1024; drow = n0; return; }
  j -= 1024;
  k0 = (j >> 6) * 64; n0 = (j & 63) * 32; W = P.w_out; ldw = 2048; WT = (bf16_t*)(P.ws + OFF_WOUT); ldt = 2048; drow = n0;
}
constexpr int N_EARLY = 11264 + 5632 + 3456 + 1024 + 192;
__device__ __forceinline__ void early_item_addr(const Params& P, int j, const float*& W, int& ldw, int& k0, int& n0, bf16_t*& WT, int& ldt, int& drow, int& dk0) {
  unsigned char* ws = P.ws; dk0 = 0;
  if (j < 11264) { const int kb = j / 352, nb = j % 352; n0 = nb * 32; k0 = kb * 64; W = P.ffn1_w_in; ldw = 2 * DFF; WT = (bf16_t*)(ws + OFF_W1A); ldt = 2048;
    drow = n0 < DFF ? (n0 >> 7) * 256 + (n0 & 127) : ((n0 - DFF) >> 7) * 256 + 128 + ((n0 - DFF) & 127); return; }
  j -= 11264;
  if (j < 5632) { const int kb = j >> 6, nb = j & 63; n0 = nb * 32; k0 = kb * 64; W = P.ffn1_w_out; ldw = 2048; WT = (bf16_t*)(ws + OFF_W1B); ldt = DFF; drow = n0; return; }
  j -= 5632;
  if (j < 3456) { const int kb = j / 108, nb = j % 108; n0 = 3072 + nb * 32; k0 = kb * 64; W = P.w_in; ldw = 10624; WT = (bf16_t*)(ws + OFF_WRW); ldt = 2048; drow = nb * 32; return; }
  j -= 3456;
  if (j < 1024) { const int kb = j >> 5, nb = 64 + (j & 31); n0 = nb * 32; k0 = kb * 64; W = P.w_in; ldw = 10624; WT = (bf16_t*)(ws + OFF_WQKVG); ldt = 2048; drow = nb * 32; return; }
  j -= 1024;
  if (j < 64) { const int z = j >> 5, nb = j & 31; W = P.w2 + (size_t)z * 64 * 1024; ldw = 1024; k0 = 0; n0 = nb * 32; WT = (bf16_t*)(ws + OFF_WLORA); ldt = LIN_LD; drow = z * 1024 + nb * 32; dk0 = z * 64; return; }
  j -= 64;
  if (j < 64) { const int z = j >> 5, nb = j & 31; W = P.a2 + (size_t)z * 64 * 1024; ldw = 1024; k0 = 0; n0 = nb * 32; WT = (bf16_t*)(ws + OFF_WLORA); ldt = LIN_LD; drow = 2048 + z * 1024 + nb * 32; dk0 = 128 + z * 64; return; }
  j -= 64;
  { const int kb = j >> 5, nb = j & 31; W = P.g2; ldw = 1024; k0 = kb * 64; n0 = nb * 32; WT = (bf16_t*)(ws + OFF_WLORA); ldt = LIN_LD; drow = 4096 + nb * 32; dk0 = 256; }
}
__device__ __forceinline__ void convert_phase(const Params& P, LAS unsigned char* lds, const int tid) {
  const int wid = tid >> 6, lane = tid & 63;
  LAS float* scr = (LAS float*)(lds + wid * 8704);
  unsigned char* ws = P.ws;
  bf16_t *W1A = (bf16_t*)(ws + OFF_W1A), *W1B = (bf16_t*)(ws + OFF_W1B), *W2A = (bf16_t*)(ws + OFF_W2A), *W2B = (bf16_t*)(ws + OFF_W2B);
  bf16_t *WRW = (bf16_t*)(ws + OFF_WRW), *WQKVG = (bf16_t*)(ws + OFF_WQKVG), *WOA = (bf16_t*)(ws + OFF_WOA), *WOR = (bf16_t*)(ws + OFF_WOR), *WOUT = (bf16_t*)(ws + OFF_WOUT), *WLORA = (bf16_t*)(ws + OFF_WLORA);
  const int G = P.grd, gw = P.bid * 8 + wid, NGW = G * 8;
  for (int it = gw; it < N_EARLY; it += 2 * NGW) {
    float tA[32], tB[32];
    const float* Wa; int ldwa, k0a, n0a, ldta, drowa, dk0a; bf16_t* WTa; early_item_addr(P, it, Wa, ldwa, k0a, n0a, WTa, ldta, drowa, dk0a);
    tr_load(tA, Wa, ldwa, k0a, n0a, lane);
    const bool hb = it + NGW < N_EARLY;
    const float* Wb = Wa; int ldwb = ldwa, k0b = k0a, n0b = n0a, ldtb = ldta, drowb = drowa, dk0b = dk0a; bf16_t* WTb = WTa;
    if (hb) { early_item_addr(P, it + NGW, Wb, ldwb, k0b, n0b, WTb, ldtb, drowb, dk0b); tr_load(tB, Wb, ldwb, k0b, n0b, lane); }
    tr_store(tA, k0a, WTa, ldta, drowa, dk0a, scr, lane);
    if (hb) tr_store(tB, k0b, WTb, ldtb, drowb, dk0b, scr, lane);
  }
  const int gt = P.bid * 512 + tid, NT = G * 512;
  unsigned zz = 0u; asm volatile("" : "+v"(zz));
  const u32x4 z4 = {zz, zz, zz, zz};
  for (int i = gt; i < 128 * 256; i += NT) *(u32x4*)(WRW + (size_t)3456 * 2048 + (size_t)i * 8) = z4;
  for (int i = gt; i < 5120 * 48; i += NT) { const int row = i / 48, kc = (i % 48) * 8, rb = row >> 10;
    const int lo = rb < 4 ? rb * 64 : 256, hi = rb < 4 ? rb * 64 + 64 : 384;
    if (kc < lo || kc >= hi) *(u32x4*)(WLORA + (size_t)row * LIN_LD + kc) = z4; }
}
__device__ __forceinline__ void norm_mod_phase(const Params& P, const float* __restrict__ lat, const float* __restrict__ ctxp, int nrows, const float* __restrict__ g, int midx, const float* __restrict__ parts, const int tid) {
  const int wid = tid >> 6, lane = tid & 63;
  const int gw = P.bid * 8 + wid, NGW = P.grd * 8;
  const float* __restrict__ MOD = (const float*)(P.ws + OFF_MOD); bf16_t* __restrict__ H = (bf16_t*)(P.ws + OFF_H);
  for (int r = gw; r < nrows; r += NGW) {
    const float* xr = r < MT ? lat + (size_t)r * DM : ctxp + (size_t)(r - MT) * DM;
    const int b = r < MT ? (r >> 13) : 4;
    const float* sh = MOD + b * NMODC + midx * DM; const float* scp = sh + DM;
    f32x4 v[8], g4[8], s4[8], c4[8]; float ss = 0.f;
#pragma unroll
    for (int j = 0; j < 8; ++j) v[j] = *(const f32x4*)(xr + j * 256 + lane * 4);
    if (parts && r >= MT) {
      const float* pp = parts + (size_t)(r - MT) * DM; const float* gt = MOD + 4 * NMODC + 2 * DM;
#pragma unroll
      for (int j = 0; j < 8; ++j) { const int c = j * 256 + lane * 4;
        const f32x4 s = (*(const f32x4*)(pp + c) + *(const f32x4*)(pp + (size_t)MC * DM + c)) + (*(const f32x4*)(pp + (size_t)2 * MC * DM + c) + *(const f32x4*)(pp + (size_t)3 * MC * DM + c));
        v[j] = v[j] + *(const f32x4*)(gt + c) * 0.5f * s; }
    }
#pragma unroll
    for (int j = 0; j < 8; ++j) { const int c = j * 256 + lane * 4; g4[j] = *(const f32x4*)(g + c); s4[j] = *(const f32x4*)(sh + c); c4[j] = *(const f32x4*)(scp + c); }
#pragma unroll
    for (int j = 0; j < 8; ++j) ss += v[j].x * v[j].x + v[j].y * v[j].y + v[j].z * v[j].z + v[j].w * v[j].w;
    ss = wave_sum(ss);
    const float rs = rsqrtf(ss * (1.f / DM) + 1e-6f);
#pragma unroll
    for (int j = 0; j < 8; ++j) { const int c = j * 256 + lane * 4;
      const f32x4 y = v[j] * rs * g4[j]; const f32x4 h = y * (c4[j] + 1.f) + s4[j];
      u32x2 w; w.x = cvt_pk_bf16(h.x, h.y); w.y = cvt_pk_bf16(h.z, h.w);
      *(u32x2*)(H + (size_t)r * DM + c) = w; }
  }
}
__device__ __forceinline__ void shift_phase(const Params& P, const int tid) {
  const bf16_t* __restrict__ PRW = (const bf16_t*)(P.ws + OFF_PRW); bf16_t* __restrict__ SH = (bf16_t*)(P.ws + OFF_SH); bf16_t* __restrict__ LIN = (bf16_t*)(P.ws + OFF_LIN);
  const int gt = P.bid * 512 + tid, NT = P.grd * 512;
#pragma unroll 2
  for (int idx = gt; idx < MA * 432; idx += NT) {
    const int r = idx / 432, c = (idx % 432) * 8;
    bool first, last;
    if (r < MT) { const int t = r & (SEQ - 1); first = t == 0; last = t == SEQ - 1; } else { const int t = (r - MT) & (CTXL - 1); first = t == 0; last = t == CTXL - 1; }
    const u32x4 z4 = {0u, 0u, 0u, 0u};
    const u32x4 p = *(const u32x4*)(PRW + (size_t)r * PRW_LD + c);
    const u32x4 pv = first ? z4 : *(const u32x4*)(PRW + (size_t)(r - 1) * PRW_LD + c);
    const u32x4 nx = last ? z4 : *(const u32x4*)(PRW + (size_t)(r + 1) * PRW_LD + c);
    const f32x4 m0 = *(const f32x4*)(P.rwkv_mu + c), m1 = *(const f32x4*)(P.rwkv_mu + c + 4);
    float o[8];
#define SHF(e, W, MU, HI) { const float pp = HI ? bfhi(p.W) : bflo(p.W), a = HI ? bfhi(pv.W) : bflo(pv.W), b = HI ? bfhi(nx.W) : bflo(nx.W); o[e] = pp + MU * (0.5f * (a + b) - pp); }
    SHF(0, x, m0.x, 0) SHF(1, x, m0.y, 1) SHF(2, y, m0.z, 0) SHF(3, y, m0.w, 1) SHF(4, z, m1.x, 0) SHF(5, z, m1.y, 1) SHF(6, w, m1.z, 0) SHF(7, w, m1.w, 1)
#undef SHF
    bf16_t* dst;
    if (c >= 1024 && c < 2048) {
      const f32x4 q0 = *(const f32x4*)(P.k_k + (c - 1024)), q1 = *(const f32x4*)(P.k_k + (c - 1024) + 4);
      float ss = 0.f;
#define KQ(e, qv) { const float kq = bflo(cvt_pk_bf16(o[e], 0.f)) * qv; ss += kq * kq; }
      KQ(0, q0.x) KQ(1, q0.y) KQ(2, q0.z) KQ(3, q0.w) KQ(4, q1.x) KQ(5, q1.y) KQ(6, q1.z) KQ(7, q1.w)
#undef KQ
      ss = allred8(ss);
      if ((idx & 7) == 0) ((float*)(P.ws + OFF_RN))[(size_t)r * 16 + ((c - 1024) >> 6)] = rsqrtf(fmaxf(ss, 1e-24f));
    }
    if (c < 3072) dst = SH + (size_t)r * SH_LD + c;
    else { const int cl = c - 3072; dst = LIN + (size_t)r * LIN_LD + cl;
      if (cl < 128) {
#pragma unroll
        for (int e = 0; e < 8; ++e) { const float ex = __builtin_amdgcn_exp2f(2.8853900817779268f * o[e]); o[e] = 1.f - 2.f * __builtin_amdgcn_rcpf(ex + 1.f); }
      } else if (cl >= 256) {
#pragma unroll
        for (int e = 0; e < 8; ++e) o[e] = sigmoidf_(o[e]);
      } }
    u32x4 w; w.x = cvt_pk_bf16(o[0], o[1]); w.y = cvt_pk_bf16(o[2], o[3]); w.z = cvt_pk_bf16(o[4], o[5]); w.w = cvt_pk_bf16(o[6], o[7]);
    *(u32x4*)dst = w;
  }
}
__device__ __forceinline__ float SFMA(float a, float b, float c) { float d; asm("v_fma_f32 %0, %1, %2, %3" : "=v"(d) : "v"(a), "v"(b), "v"(c)); return d; }
__device__ __forceinline__ float SMUL(float a, float b) { float d; asm("v_mul_f32 %0, %1, %2" : "=v"(d) : "v"(a), "v"(b)); return d; }
__device__ __forceinline__ void scan_phase(const Params& P, LAS unsigned char* lds, const int tid) {
  constexpr int FSTEP = 320, FBUF = 32 * FSTEP + 4 * 64;
  LAS float* F = (LAS float*)lds;
  LAS unsigned short* YB = (LAS unsigned short*)(lds + 2 * FBUF * 4);
  constexpr int TR_OFF = 2 * FBUF * 4 + 4096;
  const bf16_t* SH = (const bf16_t*)(P.ws + OFF_SH); const bf16_t* LO = (const bf16_t*)(P.ws + OFF_LO); bf16_t* Y = (bf16_t*)(P.ws + OFF_Y);
  const int wid = __builtin_amdgcn_readfirstlane(tid >> 6), lane = tid & 63;
  constexpr int NCH = SKV / 32;
#define SCAN_BAR() do { asm volatile("s_waitcnt lgkmcnt(0)" ::: "memory"); __builtin_amdgcn_s_barrier(); asm volatile("" ::: "memory"); } while (0)
  for (int task = P.bid; task < 256; task += P.grd) {
    const int half = (task >> 3) & 1, chain = (task & 7) | ((task >> 4) << 3);
    const int dir = chain & 1, h = (chain >> 1) & 15, b = chain >> 5, hc = h * 64;
#define ROWOF(g) ((g) < CTXL ? (MT + b * CTXL + (dir ? CTXL - 1 - (g) : (g))) : (b * SEQ + (dir ? SEQ - 1 - ((g) - CTXL) : ((g) - CTXL))))
    if (wid < 4) {
      const int rloc = wid * 8 + (lane >> 3), irow = half * 32 + rloc, cA = (lane & 7) * 4, cB = 32 + cA;
      f32x4 S0 = {0.f, 0.f, 0.f, 0.f}, S1 = {0.f, 0.f, 0.f, 0.f};
      SCAN_BAR();
      for (int q = 0; q < NCH; ++q) {
        const LAS float* f = F + (q & 1) * FBUF;
        LAS unsigned short* yb = YB + (q & 1) * 1024;
        f32x4 a0 = *(const LAS f32x4*)(f + cA), a1 = *(const LAS f32x4*)(f + cB);
        f32x4 b0 = *(const LAS f32x4*)(f + 64 + cA), b1 = *(const LAS f32x4*)(f + 64 + cB);
        f32x4 k0 = *(const LAS f32x4*)(f + 128 + cA), k1 = *(const LAS f32x4*)(f + 128 + cB);
        f32x4 r0 = *(const LAS f32x4*)(f + 192 + cA), r1 = *(const LAS f32x4*)(f + 192 + cB);
        float vv = f[256 + irow];
        float ykeep = 0.f; f32x4 gA = {1.f, 1.f, 1.f, 1.f}, gB = gA;
#pragma unroll 16
        for (int s = 0; s < 32; ++s) {
          const LAS float* fn = f + (s < 31 ? s + 1 : 31) * FSTEP;
          const f32x4 na0 = *(const LAS f32x4*)(fn + cA), na1 = *(const LAS f32x4*)(fn + cB);
          const f32x4 nb0 = *(const LAS f32x4*)(fn + 64 + cA), nb1 = *(const LAS f32x4*)(fn + 64 + cB);
          const f32x4 nk0 = *(const LAS f32x4*)(fn + 128 + cA), nk1 = *(const LAS f32x4*)(fn + 128 + cB);
          const f32x4 nr0 = *(const LAS f32x4*)(fn + 192 + cA), nr1 = *(const LAS f32x4*)(fn + 192 + cB);
          const float nvv = fn[256 + irow];
          if ((s & 7) == 5) { const LAS float* gp = f + 32 * FSTEP + (s >> 3) * 64; gA = *(const LAS f32x4*)(gp + cA); gB = *(const LAS f32x4*)(gp + cB); }
          f32x4 p = S0 * a0 + S1 * a1;
          const float sa_ = allred8((p.x + p.y) + (p.z + p.w));
          S0 = __builtin_elementwise_fma(k0, (f32x4){vv, vv, vv, vv}, __builtin_elementwise_fma(b0, (f32x4){sa_, sa_, sa_, sa_}, S0));
          S1 = __builtin_elementwise_fma(k1, (f32x4){vv, vv, vv, vv}, __builtin_elementwise_fma(b1, (f32x4){sa_, sa_, sa_, sa_}, S1));
          p = S0 * r0 + S1 * r1;
          const float y = allred8((p.x + p.y) + (p.z + p.w));
          ykeep = ((s & 7) == (lane & 7)) ? y : ykeep;
          if ((s & 7) == 7) {
            yb[((s & ~7) + (lane & 7)) * 32 + rloc] = f2bf(ykeep);
            S0 = S0 * gA; S1 = S1 * gB;
          }
          a0 = na0; a1 = na1; b0 = nb0; b1 = nb1; k0 = nk0; k1 = nk1; r0 = nr0; r1 = nr1; vv = nvv;
        }
        SCAN_BAR();
      }
    } else {
      const int sw = wid - 4, hw = lane >> 5, cp = (lane & 31) * 2;
      const f32x2 kk_c = *(const f32x2*)(P.k_k + hc + cp), ka_c = *(const f32x2*)(P.k_a + hc + cp);
      unsigned voS[4], voL[4];
#pragma unroll
      for (int e = 0; e < 4; ++e) { const int tk = hw * 4 + e, ro = dir ? 7 - tk : tk; voS[e] = (unsigned)(ro * SH_LD + cp) * 2u; voL[e] = (unsigned)(ro * LO_LD + cp) * 2u; }
      unsigned sr[4], sk[4], sv[4], sl[4], sa[4]; float srn[4]; int roff[4];
#pragma unroll
      for (int e = 0; e < 4; ++e) { const int tk = hw * 4 + e; roff[e] = (dir ? 7 - tk : tk) * 16; }
      const float* RN = (const float*)(P.ws + OFF_RN);
#define RMIN(q) ({ const int g0_ = (q) * 32 + sw * 8; const int ra_ = ROWOF(g0_), rb_ = ROWOF(g0_ + 7); ra_ < rb_ ? ra_ : rb_; })
#define SLOADQ(q) do { const size_t rmin_ = (size_t)RMIN(q); const char* bs_ = (const char*)(SH + rmin_ * SH_LD + hc); const char* bl_ = (const char*)(LO + rmin_ * LO_LD + dir * 1024 + hc); \
      _Pragma("unroll") for (int e = 0; e < 4; ++e) { sr[e] = *(const unsigned*)(bs_ + voS[e]); sk[e] = *(const unsigned*)(bs_ + 2048 + voS[e]); sv[e] = *(const unsigned*)(bs_ + 4096 + voS[e]); \
        sl[e] = *(const unsigned*)(bl_ + voL[e]); sa[e] = *(const unsigned*)(bl_ + 4096 + voL[e]); srn[e] = RN[rmin_ * 16 + h + roff[e]]; } } while (0)
#define EX2V(V) (f32x2){__builtin_amdgcn_exp2f((V).x), __builtin_amdgcn_exp2f((V).y)}
#define SWRITEQ(buf) do { \
      f32x2 Lc[4]; { f32x2 run = {0.f, 0.f}; _Pragma("unroll") for (int e = 0; e < 4; ++e) { run = run + (f32x2){bflo(sl[e]), bfhi(sl[e])}; Lc[e] = run; } } \
      f32x2 qlo, qhi; { auto r0_ = __builtin_amdgcn_permlane32_swap(__float_as_uint(Lc[3].x), __float_as_uint(Lc[3].x), false, false); \
                        auto r1_ = __builtin_amdgcn_permlane32_swap(__float_as_uint(Lc[3].y), __float_as_uint(Lc[3].y), false, false); \
                        qlo = (f32x2){__uint_as_float(r0_[0]), __uint_as_float(r1_[0])}; qhi = (f32x2){__uint_as_float(r0_[1]), __uint_as_float(r1_[1])}; } \
      const f32x2 base_ = hw ? qlo : (f32x2){0.f, 0.f}; \
      if (hw == 0) *(LAS f32x2*)(F + (buf) * FBUF + 32 * FSTEP + sw * 64 + cp) = EX2V(-(qlo + qhi)); \
      f32x2 Pm = EX2V(-base_); \
      _Pragma("unroll") for (int e = 0; e < 4; ++e) { LAS float* f_ = F + (buf) * FBUF + (sw * 8 + hw * 4 + e) * FSTEP + cp; \
        const f32x2 r_ = {bflo(sr[e]), bfhi(sr[e])}, k_ = {bflo(sk[e]), bfhi(sk[e])}, v_ = {bflo(sv[e]), bfhi(sv[e])}, aa = {bflo(sa[e]), bfhi(sa[e])}; \
        const f32x2 lj = base_ + Lc[e]; \
        const f32x2 Pj = EX2V(-lj), Pi = EX2V(lj); \
        const f32x2 kk = k_ * kk_c * srn[e]; const f32x2 kki = kk * Pi; \
        *(LAS f32x2*)(f_) = -kk * Pm; *(LAS f32x2*)(f_ + 64) = kki * aa; *(LAS f32x2*)(f_ + 128) = k_ * ((aa - 1.f) * ka_c + 1.f) * Pi; \
        *(LAS f32x2*)(f_ + 192) = r_ * Pj; *(LAS f32x2*)(f_ + 256) = v_; Pm = Pj; } } while (0)
      LAS float* trscr = (LAS float*)(lds + TR_OFF + sw * 8704);
      float tv[32]; int w2j = task * 4 + sw;
      SLOADQ(0); SWRITEQ(0); SLOADQ(1);
      SCAN_BAR();
      for (int q = 0; q < NCH; ++q) {
        if (q >= 9) {
          const int qq = q - 1; const LAS unsigned short* yb = YB + (qq & 1) * 1024;
          const int t256 = sw * 64 + lane, s = t256 >> 3, rp = (t256 & 7) * 4; const int u = qq * 32 + s - CTXL; const int t = dir ? SEQ - 1 - u : u;
          const u32x2 val = *(const LAS u32x2*)(yb + s * 32 + rp);
          *(u32x2*)(Y + (size_t)dir * MT * 1024 + (size_t)(b * SEQ + t) * 1024 + hc + half * 32 + rp) = val;
        }
        if (q + 1 < NCH) SWRITEQ((q + 1) & 1);
        if ((q & 7) == 3 && w2j < N_LATE) {
          const float* W_; int ldw_, k0_, n0_, ldt_, drow_; bf16_t* WT_; late_item_addr(P, w2j, W_, ldw_, k0_, n0_, WT_, ldt_, drow_);
          tr_store(tv, k0_, WT_, ldt_, drow_, 0, trscr, lane); w2j += 1024;
        }
        if (q + 2 < NCH) SLOADQ(q + 2);
        if ((q & 7) == 2 && w2j < N_LATE) {
          const float* W_; int ldw_, k0_, n0_, ldt_, drow_; bf16_t* WT_; late_item_addr(P, w2j, W_, ldw_, k0_, n0_, WT_, ldt_, drow_);
          tr_load(tv, W_, ldw_, k0_, n0_, lane);
        }
        SCAN_BAR();
      }
      {
        const int qq = NCH - 1; const LAS unsigned short* yb = YB + (qq & 1) * 1024;
        const int t256 = sw * 64 + lane, s = t256 >> 3, rp = (t256 & 7) * 4; const int u = qq * 32 + s - CTXL; const int t = dir ? SEQ - 1 - u : u;
        const u32x2 val = *(const LAS u32x2*)(yb + s * 32 + rp);
        *(u32x2*)(Y + (size_t)dir * MT * 1024 + (size_t)(b * SEQ + t) * 1024 + hc + half * 32 + rp) = val;
      }
#undef SLOADQ
#undef SWRITEQ
#undef RMIN
#undef EX2V
    }
#undef ROWOF
    __syncthreads();
  }
#undef SCAN_BAR
}
__device__ __forceinline__ float half_sum(float v) {
  v = allred16(v);
  auto rr = __builtin_amdgcn_permlane16_swap(__float_as_uint(v), __float_as_uint(v), false, false); return __uint_as_float(rr[0]) + __uint_as_float(rr[1]);
}
__device__ __forceinline__ void rwkv_out_phase(const Params& P, const int tid) {
  const bf16_t* SH = (const bf16_t*)(P.ws + OFF_SH); const bf16_t* LO = (const bf16_t*)(P.ws + OFF_LO); bf16_t* Y = (bf16_t*)(P.ws + OFF_Y);
  const int wid = tid >> 6, lane = tid & 63, hw = lane >> 5, cp = (lane & 31) * 2;
  const int gw = P.bid * 8 + wid, NGW = P.grd * 8;
  for (int task = gw * 2; task < MT * 8; task += NGW * 2) {
    unsigned yf[2], ybk[2], rr[2], kk[2], vv[2], af[2], ab[2], gg[2]; int cc[2]; size_t tk[2];
#pragma unroll
    for (int u = 0; u < 2; ++u) { const int t_ = task + u; tk[u] = (size_t)(t_ >> 3); cc[u] = ((t_ & 7) * 2 + hw) * 64 + cp;
      const bf16_t* py = Y + tk[u] * 1024 + cc[u]; const bf16_t* ps = SH + tk[u] * SH_LD + cc[u]; const bf16_t* pl = LO + tk[u] * LO_LD + cc[u];
      yf[u] = *(const unsigned*)py; ybk[u] = *(const unsigned*)(py + (size_t)MT * 1024);
      rr[u] = *(const unsigned*)ps; kk[u] = *(const unsigned*)(ps + 1024); vv[u] = *(const unsigned*)(ps + 2048);
      af[u] = *(const unsigned*)(pl + 2048); ab[u] = *(const unsigned*)(pl + 3072); gg[u] = *(const unsigned*)(pl + 4096); }
    unsigned res[2];
#pragma unroll
    for (int u = 0; u < 2; ++u) {
      const f32x2 lw = *(const f32x2*)(P.ln_x_w + cc[u]), lb = *(const f32x2*)(P.ln_x_b + cc[u]), ka = *(const f32x2*)(P.k_a + cc[u]), rk = *(const f32x2*)(P.r_k + cc[u]);
      const f32x2 y = {bflo(yf[u]) + bflo(ybk[u]), bfhi(yf[u]) + bfhi(ybk[u])};
      const float mu = half_sum(y.x + y.y) * (1.f / 64.f); const f32x2 dv = y - mu; const float var = half_sum(dv.x * dv.x + dv.y * dv.y) * (1.f / 64.f);
      const f32x2 yn = dv * rsqrtf(var + 64e-5f) * lw + lb;
      const f32x2 r = {bflo(rr[u]), bfhi(rr[u])}, k = {bflo(kk[u]), bfhi(kk[u])}, v = {bflo(vv[u]), bfhi(vv[u])};
      const f32x2 a1 = {bflo(af[u]), bfhi(af[u])}, a2 = {bflo(ab[u]), bfhi(ab[u])}, g = {bflo(gg[u]), bfhi(gg[u])};
      const f32x2 kms = k * ((a1 - 1.f) * ka + 1.f) + k * ((a2 - 1.f) * ka + 1.f);
      const f32x2 bt = r * kms * rk;
      const float bonus = half_sum(bt.x + bt.y);
      const f32x2 o = (yn + v * bonus) * g;
      res[u] = cvt_pk_bf16(o.x, o.y);
    }
#pragma unroll
    for (int u = 0; u < 2; ++u) *(unsigned*)(Y + tk[u] * 1024 + cc[u]) = res[u];
  }
}
__device__ __forceinline__ void rope_phase(const Params& P, const int tid) {
  bf16_t* Q = (bf16_t*)(P.ws + OFF_Q); bf16_t* KB = (bf16_t*)(P.ws + OFF_KB);
  const int wid = tid >> 6, lane = tid & 63, hw = lane >> 5, li = lane & 31;
  const int gw = P.bid * 8 + wid, NGW = P.grd * 8;
  const int d1 = li < 16 ? 2 * li : 64 + 2 * (li - 16);
  const f32x2 qgA = *(const f32x2*)(P.q_norm + d1), qgB = *(const f32x2*)(P.q_norm + d1 + 32), kgA = *(const f32x2*)(P.k_norm + d1), kgB = *(const f32x2*)(P.k_norm + d1 + 32);
  const int j0 = 2 * (li & 15);
  const float inv0 = __builtin_amdgcn_exp2f(-(float)(2 * j0) * (13.287712379549449f / 64.f)), inv1 = __builtin_amdgcn_exp2f(-(float)(2 * j0 + 2) * (13.287712379549449f / 64.f));
  for (int task = gw; task < MA; task += NGW) {
    if (task < MT) {
      const int tok = task, b = tok >> 13, t = tok & (SEQ - 1);
      const float pos = (float)(li < 16 ? (t >> 6) : (t & 63));
      const float an0 = pos * inv0, an1 = pos * inv1;
      const f32x2 sn = {__sinf(an0), __sinf(an1)}, cs = {__cosf(an0), __cosf(an1)};
      unsigned lo[10], hi[10]; bf16_t* ptr[10];
#pragma unroll
      for (int i = 0; i < 10; ++i) { const int hd = 2 * i + hw;
        ptr[i] = (hd < 16 ? Q + (size_t)tok * DM + hd * 128 : KB + (size_t)(tok + b * CTXL) * 512 + (hd - 16) * 128) + d1;
        lo[i] = *(const unsigned*)ptr[i]; hi[i] = *(const unsigned*)(ptr[i] + 32); }
#pragma unroll
      for (int i = 0; i < 10; ++i) { const bool isq = i < 8;
        const f32x2 t1 = {bflo(lo[i]), bfhi(lo[i])}, t2 = {bflo(hi[i]), bfhi(hi[i])};
        const float ss = half_sum((t1.x * t1.x + t1.y * t1.y) + (t2.x * t2.x + t2.y * t2.y)); const float rs = rsqrtf(ss * (1.f / 128.f) + 1e-6f);
        const f32x2 n1 = t1 * rs * (isq ? qgA : kgA), n2 = t2 * rs * (isq ? qgB : kgB);
        const f32x2 o1 = n1 * cs - n2 * sn, o2 = n2 * cs + n1 * sn;
        lo[i] = cvt_pk_bf16(o1.x, o1.y); hi[i] = cvt_pk_bf16(o2.x, o2.y); }
#pragma unroll
      for (int i = 0; i < 10; ++i) { *(unsigned*)ptr[i] = lo[i]; *(unsigned*)(ptr[i] + 32) = hi[i]; }
    } else {
      const int ct = task - MT, b = ct >> 8, t = ct & (CTXL - 1);
      unsigned lo[2], hi[2]; bf16_t* ptr[2];
#pragma unroll
      for (int i = 0; i < 2; ++i) { ptr[i] = KB + (size_t)(b * SKV + SEQ + t) * 512 + (2 * i + hw) * 128 + d1; lo[i] = *(const unsigned*)ptr[i]; hi[i] = *(const unsigned*)(ptr[i] + 32); }
#pragma unroll
      for (int i = 0; i < 2; ++i) {
        const f32x2 t1 = {bflo(lo[i]), bfhi(lo[i])}, t2 = {bflo(hi[i]), bfhi(hi[i])};
        const float ss = half_sum((t1.x * t1.x + t1.y * t1.y) + (t2.x * t2.x + t2.y * t2.y)); const float rs = rsqrtf(ss * (1.f / 128.f) + 1e-6f);
        const f32x2 n1 = t1 * rs * kgA, n2 = t2 * rs * kgB;
        *(unsigned*)ptr[i] = cvt_pk_bf16(n1.x, n1.y); *(unsigned*)(ptr[i] + 32) = cvt_pk_bf16(n2.x, n2.y); }
    }
  }
}
__device__ __forceinline__ void attn_phase(const Params& P, unsigned char* smem, const int tid) {
  bf16_t* Q = (bf16_t*)(P.ws + OFF_Q); const bf16_t* KB = (const bf16_t*)(P.ws + OFF_KB); const bf16_t* VB = (const bf16_t*)(P.ws + OFF_VB);
  for (int u = P.bid; u < 2048; u += P.grd) {
    const int xcd = u & 7, slot = (u >> 3) & 31, rnd = u >> 8, pair = xcd + 8 * (rnd >> 2), w = (rnd & 3) * 32 + slot;
    const int b = pair >> 2, kvh = pair & 3, g = w & 3, qb = w >> 2, head = kvh * 4 + g;
    bf16_t* Qb = Q + (size_t)(b * SEQ + qb * 256) * DM + head * 128;
    const bf16_t* Kh = KB + (size_t)b * SKV * 512 + kvh * 128; const bf16_t* Vh = VB + (size_t)b * SKV * 512 + kvh * 128;
    att::attn_dense_body(Qb, Kh, Vh, Qb, SKV, (char*)smem, tid);
    __syncthreads();
  }
}
__device__ __forceinline__ void final_norm_phase(const Params& P, const int tid) {
  const int wid = tid >> 6, lane = tid & 63;
  const int gw = P.bid * 8 + wid, NGW = P.grd * 8;
  f32x4 g4[8];
#pragma unroll
  for (int j = 0; j < 8; ++j) g4[j] = *(const f32x4*)(P.norm_final + j * 256 + lane * 4);
  for (int r = gw; r < MT; r += NGW) {
    float* xr = P.out + (size_t)r * DM;
    f32x4 v[8]; float ss = 0.f;
#pragma unroll
    for (int j = 0; j < 8; ++j) v[j] = *(const f32x4*)(xr + j * 256 + lane * 4);
#pragma unroll
    for (int j = 0; j < 8; ++j) ss += v[j].x * v[j].x + v[j].y * v[j].y + v[j].z * v[j].z + v[j].w * v[j].w;
    ss = wave_sum(ss);
    const float rs = rsqrtf(ss * (1.f / DM) + 1e-6f);
#pragma unroll
    for (int j = 0; j < 8; ++j) *(f32x4*)(xr + j * 256 + lane * 4) = v[j] * rs * g4[j];
  }
}


#define XB_TMO      128
#define XB_XCNT(j)  (256  + 64 * (j))
#define XB_XSUB(j)  (1280 + 64 * (j))
#define XB_XGEN(j)  (2304 + 64 * (j))
#define XB_TOP      3328
#define XB_TOPGEN   3392
#define XCD_BAR_WORDS 3456
#define XB_SPIN_CAP (1u << 18)
__device__ __forceinline__ unsigned xb_ld(unsigned* p)              { return __hip_atomic_load(p, __ATOMIC_RELAXED, __HIP_MEMORY_SCOPE_AGENT); }
__device__ __forceinline__ unsigned xb_add(unsigned* p, unsigned v) { return __hip_atomic_fetch_add(p, v, __ATOMIC_RELAXED, __HIP_MEMORY_SCOPE_AGENT); }
__device__ __forceinline__ unsigned xb_xcc_id() { return (unsigned)__builtin_amdgcn_s_getreg((3 << 11) | 20) & 0xFu; }
#define XB_SPIN(cond, bar) do { unsigned _sp = 0; while (cond) { __builtin_amdgcn_s_sleep(1); \
    if ((++_sp & 255u) == 0u) { if (xb_ld(&(bar)[XB_TMO])) break; if (_sp > XB_SPIN_CAP) { atomicAdd(&(bar)[XB_TMO], 1u); break; } } } } while (0)
__device__ __forceinline__ void xcd_barrier_complete(unsigned* bar, unsigned x, unsigned& nloc, unsigned& nx) {
    const unsigned G = gridDim.x * gridDim.y * gridDim.z;
    unsigned sum, cnt, mine, sp = 0u;
    for (;;) {
        sum = 0u; cnt = 0u; mine = 0u;
#pragma unroll
        for (unsigned j = 0; j < 16; ++j) { const unsigned c = xb_ld(&bar[XB_XCNT(j)]); sum += c; cnt += (c > 0u) ? 1u : 0u; mine = (j == x) ? c : mine; }
        if (sum == G) break;
        __builtin_amdgcn_s_sleep(1);
        if ((++sp & 255u) == 0u) { if (xb_ld(&bar[XB_TMO])) break; if (sp > XB_SPIN_CAP) { atomicAdd(&bar[XB_TMO], 1u); break; } }
    }
    nloc = mine > 0u ? mine : 1u; nx = cnt > 0u ? cnt : 1u;
}
__device__ __forceinline__ void xcd_barrier(unsigned* bar, volatile LAS unsigned* st) {
    asm volatile("s_waitcnt vmcnt(0)" ::: "memory");
    __syncthreads();
    if (threadIdx.x == 0) {
        __builtin_amdgcn_s_waitcnt(0);
        const unsigned x = xb_xcc_id();
        unsigned nloc = st[0], nx = st[1];
        if (nloc == 0u) { xcd_barrier_complete(bar, x, nloc, nx); st[0] = nloc; st[1] = nx; }
        const unsigned old = xb_add(&bar[XB_XSUB(x)], 1u);
        const unsigned gen = old / nloc;
        if (old + 1u == (gen + 1u) * nloc) {
            __builtin_amdgcn_fence(__ATOMIC_RELEASE, "agent");
            asm volatile("s_waitcnt vmcnt(0)" ::: "memory");
            const unsigned og = xb_add(&bar[XB_TOP], 1u);
            const unsigned tg = og / nx;
            if (og + 1u == (tg + 1u) * nx) xb_add(&bar[XB_TOPGEN], 1u);
            else XB_SPIN(xb_ld(&bar[XB_TOPGEN]) == tg, bar);
            __builtin_amdgcn_fence(__ATOMIC_ACQUIRE, "agent");
            xb_add(&bar[XB_XGEN(x)], 1u);
            asm volatile("s_waitcnt vmcnt(0)" ::: "memory");
        } else {
            XB_SPIN(xb_ld(&bar[XB_XGEN(x)]) == gen, bar);
            __builtin_amdgcn_fence(__ATOMIC_ACQUIRE, "agent");
            asm volatile("s_waitcnt vmcnt(0)" ::: "memory");
        }
    }
    __syncthreads();
}

constexpr int NPH = 20;
__device__ __forceinline__ bool gemm_desc(int ph, const Params& P, GemmDesc& d) {
  unsigned char* ws = P.ws;
  const bf16_t* H = (const bf16_t*)(ws + OFF_H);
  d.a_tiled = 0; d.nt0 = 0; d.nt1 = 0; d.ksplit1 = 1; d.G = P.grd; d.c = P.bid; d.A1 = nullptr; d.B1 = nullptr; d.pm01 = 0; d.nN1 = 1; d.n1 = 0; d.pm00 = 0; d.xin = nullptr; d.gidx = 0; d.gscale = 0.f; d.act = nullptr;
  switch (ph) {
  case 2: d.K = 2048; d.mode = M_SWIGLU; d.A0 = H; d.B0 = (const bf16_t*)(ws + OFF_W1A); d.nM0 = 132; d.nN0 = 44; d.act = (bf16_t*)(ws + OFF_ACT); break;
  case 3: d.a_tiled = 1; d.K = DFF; d.mode = M_RESID; d.A0 = (const bf16_t*)(ws + OFF_ACT); d.B0 = (const bf16_t*)(ws + OFF_W1B); d.nM0 = 128; d.nN0 = 8; d.xin = P.x; d.gidx = 2; d.gscale = 0.5f;
          d.A1 = d.A0; d.B1 = d.B0; d.pm01 = 128; d.nN1 = 8; d.ksplit1 = 4; d.nt1 = 22; d.n1 = 4 * 8 * 4; break;
  case 5: d.K = 2048; d.mode = M_RW; d.A0 = H; d.B0 = (const bf16_t*)(ws + OFF_WRW); d.nM0 = 132; d.nN0 = 14;
          d.A1 = H; d.B1 = (const bf16_t*)(ws + OFF_WQKVG) + (size_t)2048 * 2048; d.pm01 = 128; d.nN1 = 4; d.n1 = 16; break;
  case 7: d.K = 384; d.mode = M_LORA; d.A0 = (const bf16_t*)(ws + OFF_LIN); d.B0 = (const bf16_t*)(ws + OFF_WLORA); d.nM0 = 132; d.nN0 = 20; break;
  case 10: d.K = 2048; d.mode = M_QKVG; d.A0 = H; d.B0 = (const bf16_t*)(ws + OFF_WQKVG); d.nM0 = 128; d.nN0 = 28; break;
  case 13: d.K = 2048; d.mode = M_T1; d.A0 = (const bf16_t*)(ws + OFF_Q); d.B0 = (const bf16_t*)(ws + OFF_WOA); d.nM0 = 128; d.nN0 = 8; break;
  case 14: d.K = 1024; d.mode = M_M; d.A0 = (const bf16_t*)(ws + OFF_Y); d.B0 = (const bf16_t*)(ws + OFF_WOR); d.nM0 = 128; d.nN0 = 8; break;
  case 15: d.K = 2048; d.mode = M_RESID; d.A0 = (const bf16_t*)(ws + OFF_GR); d.B0 = (const bf16_t*)(ws + OFF_WOUT); d.nM0 = 128; d.nN0 = 8; d.xin = P.out; d.gidx = 5; d.gscale = 1.f; break;
  case 17: d.K = 2048; d.mode = M_SWIGLU; d.A0 = H; d.B0 = (const bf16_t*)(ws + OFF_W2A); d.nM0 = 128; d.nN0 = 44; d.act = (bf16_t*)(ws + OFF_ACT); break;
  case 18: d.a_tiled = 1; d.K = DFF; d.mode = M_RESID; d.A0 = (const bf16_t*)(ws + OFF_ACT); d.B0 = (const bf16_t*)(ws + OFF_W2B); d.nM0 = 128; d.nN0 = 8; d.xin = P.out; d.gidx = 8; d.gscale = 0.5f; break;
  default: return false;
  }
  d.n0 = d.nM0 * d.nN0;
  if (!d.nt0) d.nt0 = d.K / BK;
  if (!d.nt1) d.nt1 = d.K / BK;
  if (d.mode == M_LORA) d.nt0 = 2;
  return true;
}

__global__ void __launch_bounds__(512) mega_fwd(Params P) {
  extern __shared__ __attribute__((aligned(16))) unsigned char smem[];
  LAS unsigned char* lds = (LAS unsigned char*)smem;
  cg::grid_group grid = cg::this_grid();
  volatile LAS unsigned* bst = (volatile LAS unsigned*)(lds + LDS_BYTES + 192);
  unsigned* gbar = (unsigned*)(P.ws + OFF_BAR);
#if ONE_LAUNCH
  if (threadIdx.x == 0) { bst[0] = 0u; bst[1] = 0u; (void)xb_add(&gbar[XB_XCNT(xb_xcc_id())], 1u); }
  __syncthreads();
#endif
#pragma nounroll
  for (int ph = P.ph_lo; ph < P.ph_hi; ++ph) {
    GemmDesc d;
    int tid = threadIdx.x; asm volatile("" : "+v"(tid));
#if PROBE
    if (blockIdx.x == 0 && tid == 0) ((LAS unsigned long long*)(lds + LDS_BYTES))[ph] = __builtin_amdgcn_s_memrealtime();
#endif
    const __attribute__((address_space(4))) Params* kp = (const __attribute__((address_space(4))) Params*)__builtin_amdgcn_kernarg_segment_ptr();
    asm volatile("" : "+s"(kp));
#if defined(__HIP_DEVICE_COMPILE__)
    Params L = *kp;
#else
    Params L = P;
#endif
    { int b_ = blockIdx.x, g_ = gridDim.x; asm volatile("" : "+s"(b_), "+s"(g_)); L.bid = b_; L.grd = g_; }
    if (gemm_desc(ph, L, d)) gemm_phase(lds, d, L, tid);
    else switch (ph) {
      case 0: mod_phase(L, lds, tid); __syncthreads(); convert_phase(L, lds, tid); break;
      case 1: norm_mod_phase(L, L.x, L.ctx, MA, L.norm_ffn1, 0, nullptr, tid); break;
      case 4: norm_mod_phase(L, L.out, L.ctx, MA, L.norm_mix, 3, (const float*)(L.ws + OFF_PART), tid); break;
      case 6: shift_phase(L, tid); break;
      case 8: scan_phase(L, lds, tid); break;
      case 9: rwkv_out_phase(L, tid); break;
      case 11: rope_phase(L, tid); break;
      case 12: attn_phase(L, smem, tid); break;
      case 16: norm_mod_phase(L, L.out, nullptr, MT, L.norm_ffn2, 6, nullptr, tid); break;
      case 19: final_norm_phase(L, tid); break;
      default: break;
    }
    if (ph + 1 < P.ph_hi) { if (ph == 0) grid.sync(); else if (ph != 13 || !ONE_LAUNCH) xcd_barrier(gbar, bst); }
  }
#if PROBE
  grid.sync();
  if (blockIdx.x == 0) {
    LAS unsigned long long* TS = (LAS unsigned long long*)(lds + LDS_BYTES);
    if (threadIdx.x == 0) TS[NPH] = __builtin_amdgcn_s_memrealtime();
    __syncthreads();
    const int K = (int)((TS[PROBE_HI] - TS[PROBE_LO]) / 100ull);
    int t2 = threadIdx.x; asm volatile("" : "+v"(t2));
    for (int i = t2; i < K && i < 16000; i += 512) P.out[(size_t)i * 4099] += 0.1f;
  }
#endif
}

extern "C" void kernel_launch(void* const* d_in, const int* in_sizes, int n_in, void* d_out, int out_size, void* d_ws, size_t ws_size, hipStream_t stream) {
  static int grid_blocks = 0;
  if (!grid_blocks) {
    if (n_in != 31 || out_size != MT * DM || ws_size < WS_TOTAL) { fprintf(stderr, "kernel_launch: unexpected shapes n_in %d out %d ws %zu (need %zu)\n", n_in, out_size, ws_size, WS_TOTAL); return; }
    if (hipFuncSetAttribute((const void*)mega_fwd, hipFuncAttributeMaxDynamicSharedMemorySize, LDS_BYTES + 256) != hipSuccess) { fprintf(stderr, "kernel_launch: hipFuncSetAttribute failed\n"); return; }
    int dev = 0, cus = 0, per_cu = 0;
    hipGetDevice(&dev);
    hipDeviceGetAttribute(&cus, hipDeviceAttributeMultiprocessorCount, dev);
    hipOccupancyMaxActiveBlocksPerMultiprocessor(&per_cu, mega_fwd, 512, LDS_BYTES + 256);
    if (per_cu < 1) { fprintf(stderr, "kernel_launch: occupancy query returned %d\n", per_cu); per_cu = 1; }
    grid_blocks = cus;
  }
  Params p{};
  const float** pf = (const float**)&p;
  for (int i = 0; i < 31; ++i) pf[i] = (const float*)d_in[i];
  p.out = (float*)d_out; p.ws = (unsigned char*)d_ws; p.bid = 0; p.grd = 0;
#if ONE_LAUNCH
  p.ph_lo = 0; p.ph_hi = NPH;
  if (hipMemsetAsync((char*)d_ws + OFF_BAR, 0, 3456 * 4, stream) != hipSuccess) { fprintf(stderr, "kernel_launch: memset of barrier words failed\n"); return; }
  void* args[] = {&p};
  hipError_t e = hipLaunchCooperativeKernel((const void*)mega_fwd, dim3(grid_blocks), dim3(512), args, LDS_BYTES + 256, stream);
  if (e != hipSuccess) fprintf(stderr, "cooperative launch failed: %s (grid %d)\n", hipGetErrorString(e), grid_blocks);
#else
  for (int ph = 0; ph < NPH; ++ph) { p.ph_lo = ph; p.ph_hi = ph + 1; hipLaunchKernelGGL(mega_fwd, dim3(grid_blocks), dim3(512), LDS_BYTES + 256, stream, p); }
#endif
}
```

```cpp
#include <hip/hip_runtime.h>
#include <hip/hip_cooperative_groups.h>
#include <cstdio>
#include <cstdint>
namespace cg = cooperative_groups;

#ifndef ONE_LAUNCH
#define ONE_LAUNCH 1
#endif

#ifndef PROBE
#define PROBE 0
#endif
#define PROBE_LO 8
#define PROBE_HI 9
#define LAS __attribute__((address_space(3)))
typedef unsigned short bf16_t;
typedef short bf16x8 __attribute__((ext_vector_type(8)));
typedef short s16x4 __attribute__((ext_vector_type(4)));
typedef float f32x4 __attribute__((ext_vector_type(4)));
typedef float f32x2 __attribute__((ext_vector_type(2)));
typedef float f32x16 __attribute__((ext_vector_type(16)));
typedef unsigned u32x4 __attribute__((ext_vector_type(4)));
typedef unsigned u32x2 __attribute__((ext_vector_type(2)));

constexpr int DM = 2048, NB = 4, SEQ = 8192, CTXL = 256, MT = NB * SEQ, MC = NB * CTXL, MA = MT + MC;
constexpr int DFF = 5632, SKV = SEQ + CTXL, NMODC = 9 * DM;
constexpr int PRW_LD = 3584, SH_LD = 3072, LIN_LD = 384, LO_LD = 5120;
constexpr int LDS_BYTES = 139264;

constexpr size_t SZ_WA = (size_t)11264 * 2048 * 2, SZ_WB = (size_t)2048 * 5632 * 2;
constexpr size_t OFF_W1A = 0, OFF_W1B = OFF_W1A + SZ_WA, OFF_W2A = OFF_W1B + SZ_WB, OFF_W2B = OFF_W2A + SZ_WA;
constexpr size_t OFF_WRW = OFF_W2B + SZ_WB, OFF_WQKVG = OFF_WRW + (size_t)3584 * 2048 * 2, OFF_WOA = OFF_WQKVG + (size_t)7168 * 2048 * 2;
constexpr size_t OFF_WOR = OFF_WOA + (size_t)2048 * 2048 * 2, OFF_WOUT = OFF_WOR + (size_t)2048 * 1024 * 2, OFF_WLORA = OFF_WOUT + (size_t)2048 * 2048 * 2;
constexpr size_t OFF_MOD = OFF_WLORA + (size_t)5120 * 384 * 2, OFF_CX = OFF_MOD + (size_t)5 * NMODC * 4, OFF_H = OFF_CX + (size_t)MC * DM * 4;
constexpr size_t OFF_BIG = OFF_H + (size_t)MA * DM * 2;
constexpr size_t SZ_KV = (size_t)NB * SKV * 512 * 2;
constexpr size_t OFF_KB = OFF_W1A, OFF_VB = OFF_KB + SZ_KV;
static_assert(OFF_VB + SZ_KV <= OFF_W2A, "KV overlay");
constexpr size_t OFF_ACT = OFF_BIG;
constexpr size_t OFF_PART = OFF_ACT + (size_t)MA * DFF * 2;
constexpr size_t OFF_PRW = OFF_BIG, OFF_LO = OFF_BIG, OFF_SH = OFF_LO + (size_t)MA * LO_LD * 2, OFF_LIN = OFF_SH + (size_t)MA * SH_LD * 2, OFF_Y = OFF_LIN;
constexpr size_t OFF_Q = OFF_BIG, OFF_GA = OFF_Q + (size_t)MT * DM * 2, OFF_GR = OFF_GA + (size_t)MT * DM * 2;
constexpr size_t END_A = OFF_ACT + (size_t)MA * DFF * 2, END_B = OFF_Y + (size_t)2 * MT * 1024 * 2, END_C = OFF_LIN + (size_t)MA * LIN_LD * 2;
constexpr size_t WS_END = END_A > END_B ? (END_A > END_C ? END_A : END_C) : (END_B > END_C ? END_B : END_C);
constexpr size_t OFF_BAR = (WS_END + 255) / 256 * 256, OFF_RN = OFF_BAR + 3456 * 4, WS_TOTAL = OFF_RN + (size_t)MA * 16 * 4;
static_assert((size_t)MA * PRW_LD * 2 <= (size_t)MA * LO_LD * 2, "PRW under LO");
static_assert(OFF_GR + (size_t)MT * DM * 2 <= OFF_Y, "GR below RWO");

struct Params {
  const float *x, *c, *ctx, *c_ctx, *w_mod, *b_mod, *norm_ffn1, *ffn1_w_in, *ffn1_w_out, *norm_mix, *w_in, *q_norm, *k_norm, *rwkv_mu, *w0, *w2, *a0, *a2,
      *g2, *k_k, *k_a, *r_k, *ln_x_w, *ln_x_b, *w_oa, *w_or, *w_out, *norm_ffn2, *ffn2_w_in, *ffn2_w_out, *norm_final;
  float* out; unsigned char* ws; int ph_lo, ph_hi; int bid, grd;
};

__device__ __forceinline__ unsigned cvt_pk_bf16(float lo, float hi) { unsigned r; asm("v_cvt_pk_bf16_f32 %0, %1, %2" : "=v"(r) : "v"(lo), "v"(hi)); return r; }
__device__ __forceinline__ float bf2f(unsigned short b) { return __uint_as_float(((unsigned)b) << 16); }
__device__ __forceinline__ float bflo(unsigned w) { return __uint_as_float(w << 16); }
__device__ __forceinline__ float bfhi(unsigned w) { return __uint_as_float(w & 0xffff0000u); }
__device__ __forceinline__ unsigned short f2bf(float f) { return (unsigned short)(cvt_pk_bf16(f, 0.f) & 0xffffu); }
__device__ __forceinline__ float sigmoidf_(float x) { return __builtin_amdgcn_rcpf(1.f + __builtin_amdgcn_exp2f(-1.4426950408889634f * x)); }
template <int CTRL> __device__ __forceinline__ float dpp_mov(float x) { return __int_as_float(__builtin_amdgcn_update_dpp(0, __float_as_int(x), CTRL, 0xF, 0xF, true)); }
__device__ __forceinline__ float allred16(float x) {
  x += dpp_mov<0xB1>(x); x += dpp_mov<0x4E>(x); x += dpp_mov<0x141>(x); x += dpp_mov<0x140>(x); return x;
}

__device__ __forceinline__ float wave_sum(float v) {
  v = allred16(v);
  { auto rr = __builtin_amdgcn_permlane16_swap(__float_as_uint(v), __float_as_uint(v), false, false); v = __uint_as_float(rr[0]) + __uint_as_float(rr[1]); }
  { auto rr = __builtin_amdgcn_permlane32_swap(__float_as_uint(v), __float_as_uint(v), false, false); v = __uint_as_float(rr[0]) + __uint_as_float(rr[1]); }
  return v;
}

__device__ __forceinline__ float allred8(float x) { x += dpp_mov<0xB1>(x); x += dpp_mov<0x4E>(x); x += dpp_mov<0x141>(x); return x; }
constexpr int BM = 256, BK = 64, HALF = 128, HTB = HALF * BK * 2;
__device__ __forceinline__ int lds_byte(int r, int c) { const int st = (r >> 4) * 2 + (c >> 5), rr = r & 15, cc = c & 31, ob = rr * 64 + cc * 2; return st * 1024 + (ob ^ (((ob >> 9) & 1) << 5)); }
__device__ __forceinline__ void stage_rc(int b, int& R, int& C) { const int st = b / 1024, sb = b % 1024, swz = sb ^ (((sb >> 9) & 1) << 5); R = (st >> 1) * 16 + swz / 64; C = (st & 1) * 32 + (swz % 64) / 2; }
__device__ __forceinline__ int perm32(int rho) { const int n = rho >> 4, i = rho & 15; return 8 * (i >> 2) + 4 * n + (i & 3); }

enum { M_SWIGLU = 0, M_RESID = 1, M_RW = 2, M_QKVG = 3, M_LORA = 4, M_T1 = 5, M_M = 6 };
struct Unit { const char* A; const char* B; int pm, pn, seg, nt; };
struct GemmDesc {
  int K, mode, G, c;
  const bf16_t *A0, *B0; int pm00, nM0, nN0, n0;
  const bf16_t *A1, *B1; int pm01, nN1, n1;
  int a_tiled;
  int nt0, nt1, ksplit1;
  const float* xin; int gidx; float gscale;
  bf16_t* act;
};
__device__ __forceinline__ bool sched_next(const GemmDesc& d, int i, Unit& u) {
  long L = (long)i * d.G + d.c;
  if (L < d.n0) {
    int wgid = (int)L; const int nwg = d.n0;
    { const int q = nwg / 8, r = nwg % 8, xcd = wgid % 8, off = wgid / 8; wgid = (xcd < r ? xcd * (q + 1) : r * (q + 1) + (xcd - r) * q) + off; }
    const int nig = 8 * d.nN0, gid = wgid / nig, fm = gid * 8, gsz = (d.nM0 - fm) < 8 ? (d.nM0 - fm) : 8;
    const int pm = fm + ((wgid % nig) % gsz), pn = (wgid % nig) / gsz;
    u.pm = d.pm00 + pm; u.pn = pn; u.seg = 0; u.nt = d.nt0;
    u.A = (const char*)d.A0 + (size_t)u.pm * 512 * d.K; u.B = (const char*)d.B0 + (size_t)pn * 512 * d.K;
    if (d.mode == M_LORA) { const int ko = (pn < 8 ? 0 : (pn < 16 ? 128 : 256)) * 2; u.A += ko; u.B += ko; }
    return true;
  }
  L -= d.n0;
  if (L < d.n1) {
    const int sp = (int)L % d.ksplit1, l2 = (int)L / d.ksplit1;
    const int pm = l2 / d.nN1, pn = l2 % d.nN1; u.pm = d.pm01 + pm; u.pn = pn; u.seg = 1 + sp; u.nt = d.nt1;
    const size_t ko = (size_t)sp * d.nt1 * 128, koA = d.a_tiled ? (size_t)sp * d.nt1 * 32768 : ko;
    u.A = (const char*)d.A1 + (size_t)u.pm * 512 * d.K + koA; u.B = (const char*)d.B1 + (size_t)pn * 512 * d.K + ko; return true;
  }
  return false;
}

__device__ __forceinline__ void gemm_epilogue(const f32x4 (&acc)[2][2][4][2], const Unit& u, const GemmDesc& d, const Params& P, int wr, int wc, int fr, int fq) {
  unsigned char* ws = P.ws;
  asm volatile("" : "+v"(fr), "+v"(fq));
  const int rl0 = wr * 64 + fr, cl0 = wc * 32 + 8 * fq;
  switch (d.mode) {
  case M_SWIGLU: {
    bf16_t* base = d.act + ((size_t)(u.pm * 88 + u.pn * 2 + (cl0 >> 6)) * 256) * 64 + (cl0 & 63);
#pragma unroll
    for (int ai = 0; ai < 2; ++ai)
#pragma unroll
      for (int m = 0; m < 4; ++m) {
        const int row = rl0 + 128 * ai + 16 * m;
        float o[8];
#pragma unroll
        for (int n = 0; n < 2; ++n)
#pragma unroll
          for (int j = 0; j < 4; ++j) { const float g = acc[ai][0][m][n][j], up = acc[ai][1][m][n][j]; o[4 * n + j] = g * sigmoidf_(g) * up; }
        u32x4 w; w.x = cvt_pk_bf16(o[0], o[1]); w.y = cvt_pk_bf16(o[2], o[3]); w.z = cvt_pk_bf16(o[4], o[5]); w.w = cvt_pk_bf16(o[6], o[7]);
        *(u32x4*)(base + (size_t)row * 64) = w;
      }
  } break;
  case M_RESID: {
    if (u.seg >= 1) {
      float* po = (float*)(ws + OFF_PART) + (size_t)(u.seg - 1) * MC * DM + (size_t)(u.pm - 128) * 256 * DM + u.pn * 256 + cl0;
#pragma unroll
      for (int ai = 0; ai < 2; ++ai)
#pragma unroll
        for (int m = 0; m < 4; ++m)
#pragma unroll
          for (int bj = 0; bj < 2; ++bj)
#pragma unroll
            for (int n = 0; n < 2; ++n) *(f32x4*)(po + (size_t)(rl0 + 128 * ai + 16 * m) * DM + 128 * bj + 4 * n) = acc[ai][bj][m][n];
      break;
    }
    const bool isc = u.pm >= 128; const int b = isc ? 4 : (u.pm >> 5);
    const float* xin = isc ? P.ctx + (size_t)(u.pm - 128) * 256 * DM : d.xin + (size_t)u.pm * 256 * DM;
    float* xo = isc ? (float*)(ws + OFF_CX) + (size_t)(u.pm - 128) * 256 * DM : P.out + (size_t)u.pm * 256 * DM;
    const float* gate = (const float*)(ws + OFF_MOD) + b * NMODC + d.gidx * DM + u.pn * 256 + cl0;
    f32x4 g4[2][2];
#pragma unroll
    for (int bj = 0; bj < 2; ++bj)
#pragma unroll
      for (int n = 0; n < 2; ++n) g4[bj][n] = *(const f32x4*)(gate + 128 * bj + 4 * n) * d.gscale;
#pragma unroll
    for (int ai = 0; ai < 2; ++ai)
#pragma unroll
      for (int m = 0; m < 4; ++m) {
        const size_t ro = (size_t)(rl0 + 128 * ai + 16 * m) * DM + u.pn * 256 + cl0;
#pragma unroll
        for (int bj = 0; bj < 2; ++bj)
#pragma unroll
          for (int n = 0; n < 2; ++n) {
            const f32x4 xv = *(const f32x4*)(xin + ro + 128 * bj + 4 * n);
            *(f32x4*)(xo + ro + 128 * bj + 4 * n) = xv + g4[bj][n] * acc[ai][bj][m][n];
          }
      }
  } break;
  case M_RW: case M_QKVG: case M_LORA: {
    bf16_t* base; int ld; int act = 0; const float* bias = nullptr;
    if (d.mode == M_RW) {
      if (u.seg == 0) { base = (bf16_t*)(ws + OFF_PRW) + (size_t)u.pm * 256 * PRW_LD + u.pn * 256; ld = PRW_LD; }
      else { const int b = u.pm - 128; base = (bf16_t*)(ws + (u.pn < 2 ? OFF_KB : OFF_VB)) + (size_t)(b * SKV + SEQ) * 512 + (u.pn & 1) * 256; ld = 512; }
    } else if (d.mode == M_QKVG) {
      const int b = u.pm >> 5;
      if (u.pn < 8) { base = (bf16_t*)(ws + OFF_Q) + (size_t)u.pm * 256 * DM + u.pn * 256; ld = DM; }
      else if (u.pn < 12) { base = (bf16_t*)(ws + (u.pn < 10 ? OFF_KB : OFF_VB)) + (size_t)(u.pm * 256 + b * CTXL) * 512 + (u.pn & 1) * 256; ld = 512; }
      else { base = (bf16_t*)(ws + (u.pn < 20 ? OFF_GA : OFF_GR)) + (size_t)u.pm * 256 * DM + ((u.pn - 12) & 7) * 256; ld = DM; act = 1; }
    } else {
      base = (bf16_t*)(ws + OFF_LO) + (size_t)u.pm * 256 * LO_LD + u.pn * 256; ld = LO_LD;
      if (u.pn < 8) { act = 2; bias = P.w0 + u.pn * 256; } else if (u.pn < 16) { act = 1; bias = P.a0 + (u.pn - 8) * 256; }
    }
#pragma unroll
    for (int bj = 0; bj < 2; ++bj) {
      f32x4 b0 = {0.f, 0.f, 0.f, 0.f}, b1 = {0.f, 0.f, 0.f, 0.f};
      if (bias) { b0 = *(const f32x4*)(bias + 128 * bj + cl0); b1 = *(const f32x4*)(bias + 128 * bj + cl0 + 4); }
#pragma unroll
      for (int ai = 0; ai < 2; ++ai)
#pragma unroll
        for (int m = 0; m < 4; ++m) {
          const int row = rl0 + 128 * ai + 16 * m;
          f32x4 v0 = acc[ai][bj][m][0] + b0, v1 = acc[ai][bj][m][1] + b1;
          if (act) {
            const float sc = act == 2 ? 0.60653065971263342f * 1.4426950408889634f : 1.f;
#pragma unroll
            for (int j = 0; j < 4; ++j) { v0[j] = sc * sigmoidf_(v0[j]); v1[j] = sc * sigmoidf_(v1[j]); }
          }
          u32x4 w; w.x = cvt_pk_bf16(v0[0], v0[1]); w.y = cvt_pk_bf16(v0[2], v0[3]); w.z = cvt_pk_bf16(v1[0], v1[1]); w.w = cvt_pk_bf16(v1[2], v1[3]);
          *(u32x4*)(base + (size_t)row * ld + 128 * bj + cl0) = w;
        }
    }
  } break;
  case M_T1: case M_M: {
    bf16_t* ga = (bf16_t*)(ws + OFF_GA) + (size_t)u.pm * 256 * DM + u.pn * 256 + cl0;
    bf16_t* gr = (bf16_t*)(ws + OFF_GR) + (size_t)u.pm * 256 * DM + u.pn * 256 + cl0;
    const bool isM = d.mode == M_M;
#pragma unroll
    for (int ai = 0; ai < 2; ++ai)
#pragma unroll
      for (int m = 0; m < 4; ++m)
#pragma unroll
        for (int bj = 0; bj < 2; ++bj) {
          const size_t o = (size_t)(rl0 + 128 * ai + 16 * m) * DM + 128 * bj;
          const f32x4 v0 = acc[ai][bj][m][0], v1 = acc[ai][bj][m][1];
          const u32x4 a = *(const u32x4*)(ga + o);
          u32x4 w;
          if (!isM) {
            w.x = cvt_pk_bf16(bflo(a.x) * v0[0], bfhi(a.x) * v0[1]); w.y = cvt_pk_bf16(bflo(a.y) * v0[2], bfhi(a.y) * v0[3]);
            w.z = cvt_pk_bf16(bflo(a.z) * v1[0], bfhi(a.z) * v1[1]); w.w = cvt_pk_bf16(bflo(a.w) * v1[2], bfhi(a.w) * v1[3]);
            *(u32x4*)(ga + o) = w;
          } else {
            const u32x4 g = *(const u32x4*)(gr + o);
            w.x = cvt_pk_bf16(bflo(a.x) + bflo(g.x) * v0[0], bfhi(a.x) + bfhi(g.x) * v0[1]); w.y = cvt_pk_bf16(bflo(a.y) + bflo(g.y) * v0[2], bfhi(a.y) + bfhi(g.y) * v0[3]);
            w.z = cvt_pk_bf16(bflo(a.z) + bflo(g.z) * v1[0], bfhi(a.z) + bfhi(g.z) * v1[1]); w.w = cvt_pk_bf16(bflo(a.w) + bflo(g.w) * v1[2], bfhi(a.w) + bfhi(g.w) * v1[3]);
            *(u32x4*)(gr + o) = w;
          }
        }
  } break;
  }
}

__device__ __forceinline__ void gemm_phase(LAS unsigned char* lds, const GemmDesc& d, const Params& P, const int tid) {
  const int wid = __builtin_amdgcn_readfirstlane(tid >> 6), lane = tid & 63, wr = wid >> 2, wc = wid & 3, fr = lane & 15, fq = lane >> 4;
  const int K = d.K;
  unsigned voffA[2], voffB[2];
#pragma unroll
  for (int i = 0; i < 2; ++i) { int R, C; stage_rc(tid * 16 + i * 8192, R, C); const int Rb = (R & ~31) + perm32(R & 31);
    voffA[i] = d.a_tiled ? (unsigned)(R * 64 + C) * 2u : (unsigned)(R * K + C) * 2u; voffB[i] = (unsigned)(Rb * K + C) * 2u; }
  const size_t kstep = (size_t)(BK * 2);
  const size_t hstep = (size_t)HALF * K * 2;
  const size_t kstepA = d.a_tiled ? (size_t)32768 : kstep, hstepA = d.a_tiled ? (size_t)16384 : hstep;
  const unsigned ldsw = (unsigned)wid * 1024u;
  const int aoff = lds_byte(wr * 64 + fr, fq * 8), boff = lds_byte(wc * 32 + fr, fq * 8);
#define PG8_SA(b, h) (((b) * 2 + (h)) * HTB)
#define PG8_SB(b, h) ((4 + (b) * 2 + (h)) * HTB)
#define PG8_STAGE(bufoff, gbase, voff) do { _Pragma("unroll") for (int _i = 0; _i < 2; ++_i) \
    __builtin_amdgcn_global_load_lds((const unsigned*)((const char*)(gbase) + (voff)[_i]), (LAS unsigned*)(lds + (bufoff) + ldsw + _i * 8192), 16, 0, 0); } while (0)
#define PG8_LDA(dst, b, h) do { _Pragma("unroll") for (int m = 0; m < 4; ++m) _Pragma("unroll") for (int k = 0; k < 2; ++k) dst[m][k] = *(const LAS bf16x8*)(lds + PG8_SA(b, h) + aoff + m * 2048 + k * 1024); } while (0)
#define PG8_LDB(dst, b, h) do { _Pragma("unroll") for (int n = 0; n < 2; ++n) _Pragma("unroll") for (int k = 0; k < 2; ++k) dst[n][k] = *(const LAS bf16x8*)(lds + PG8_SB(b, h) + boff + n * 2048 + k * 1024); } while (0)
#define PG8_MMA(ai, bj, At, Bt) do { __builtin_amdgcn_s_setprio(1); _Pragma("unroll") for (int m = 0; m < 4; ++m) _Pragma("unroll") for (int n = 0; n < 2; ++n) _Pragma("unroll") for (int k = 0; k < 2; ++k) \
    acc[ai][bj][m][n] = __builtin_amdgcn_mfma_f32_16x16x32_bf16(Bt[n][k], At[m][k], acc[ai][bj][m][n], 0, 0, 0); __builtin_amdgcn_s_setprio(0); } while (0)
#define PG8_WAIT_V(n) asm volatile("s_waitcnt vmcnt(" #n ")" ::: "memory")
#define PG8_WAIT_L(n) asm volatile("s_waitcnt lgkmcnt(" #n ")" ::: "memory")
#define PG8_BAR __builtin_amdgcn_s_barrier()
#define PG8_SCHED __builtin_amdgcn_sched_barrier(0)
  Unit cur, nxt; int ui = 0;
  if (!sched_next(d, 0, cur)) return;
  f32x4 acc[2][2][4][2];
#pragma unroll
  for (int a = 0; a < 2; ++a)
#pragma unroll
    for (int b = 0; b < 2; ++b)
#pragma unroll
      for (int m = 0; m < 4; ++m)
#pragma unroll
        for (int n = 0; n < 2; ++n) acc[a][b][m][n] = (f32x4){0.f, 0.f, 0.f, 0.f};
  bf16x8 At[4][2], B0[2][2], B1[2][2];
  const char* cA = cur.A; const char* cB = cur.B;
  PG8_STAGE(PG8_SB(0, 0), cB, voffB); PG8_STAGE(PG8_SB(0, 1), cB + hstep, voffB); PG8_STAGE(PG8_SA(0, 0), cA, voffA); PG8_STAGE(PG8_SA(0, 1), cA + hstepA, voffA);
  if (wr == 1) PG8_BAR;
  PG8_WAIT_V(2); PG8_BAR;
  PG8_STAGE(PG8_SB(1, 0), cB + kstep, voffB); PG8_STAGE(PG8_SA(1, 0), cA + kstepA, voffA); PG8_STAGE(PG8_SB(1, 1), cB + hstep + kstep, voffB);
  PG8_WAIT_V(6); PG8_BAR;
  for (;;) {
    const bool has_next = sched_next(d, ui + 1, nxt);
    const char* nA = has_next ? nxt.A : cA; const char* nB = has_next ? nxt.B : cB;
    const int nt = cur.nt;
    for (int t = 0; t < nt; t += 2) {
      const bool last = (t == nt - 2);
      const char* a1 = cA + (size_t)(t + 1) * kstepA;
      const char* a2 = last ? nA : cA + (size_t)(t + 2) * kstepA; const char* b2 = last ? nB : cB + (size_t)(t + 2) * kstep;
      const char* a3 = a2 + kstepA; const char* b3 = b2 + kstep;
      PG8_LDB(B0, 0, 0); PG8_LDB(B1, 0, 1); PG8_SCHED; PG8_LDA(At, 0, 0); PG8_STAGE(PG8_SA(1, 1), a1 + hstepA, voffA);
      PG8_WAIT_V(8); PG8_WAIT_L(0); PG8_BAR; PG8_MMA(0, 0, At, B0); PG8_MMA(0, 1, At, B1); PG8_BAR; PG8_SCHED;
      PG8_LDA(At, 0, 1); PG8_STAGE(PG8_SB(0, 0), b2, voffB); PG8_STAGE(PG8_SB(0, 1), b2 + hstep, voffB); PG8_STAGE(PG8_SA(0, 0), a2, voffA);
      PG8_WAIT_V(8); PG8_WAIT_L(0); PG8_BAR; PG8_MMA(1, 0, At, B0); PG8_MMA(1, 1, At, B1); PG8_BAR; PG8_SCHED;
      PG8_LDB(B0, 1, 0); PG8_LDB(B1, 1, 1); PG8_SCHED; PG8_LDA(At, 1, 0); PG8_STAGE(PG8_SA(0, 1), a2 + hstepA, voffA);
      PG8_WAIT_V(8); PG8_WAIT_L(0); PG8_BAR; PG8_MMA(0, 0, At, B0); PG8_MMA(0, 1, At, B1); PG8_BAR; PG8_SCHED;
      PG8_LDA(At, 1, 1); PG8_STAGE(PG8_SB(1, 0), b3, voffB); PG8_STAGE(PG8_SB(1, 1), b3 + hstep, voffB); PG8_STAGE(PG8_SA(1, 0), a3, voffA);
      PG8_WAIT_V(8); PG8_WAIT_L(0); PG8_BAR; PG8_MMA(1, 0, At, B0); PG8_MMA(1, 1, At, B1); PG8_BAR; PG8_SCHED;
    }
    if (wr == 0) PG8_BAR;
    gemm_epilogue(acc, cur, d, P, wr, wc, fr, fq);
    if (!has_next) break;
#pragma unroll
    for (int a = 0; a < 2; ++a)
#pragma unroll
      for (int b = 0; b < 2; ++b)
#pragma unroll
        for (int m = 0; m < 4; ++m)
#pragma unroll
          for (int n = 0; n < 2; ++n) acc[a][b][m][n] = (f32x4){0.f, 0.f, 0.f, 0.f};
    cur = nxt; cA = nA; cB = nB; ++ui;
    if (wr == 1) PG8_BAR;
  }
  PG8_WAIT_V(0);
  PG8_BAR;
#undef PG8_SA
#undef PG8_SB
#undef PG8_STAGE
#undef PG8_LDA
#undef PG8_LDB
#undef PG8_MMA
#undef PG8_WAIT_V
#undef PG8_WAIT_L
#undef PG8_BAR
#undef PG8_SCHED
}

namespace att {
constexpr int D = 128, NW = 8, QBLK = 32, KVBLK = 64;
constexpr float SCALE = 0.088388347648318440f;
constexpr float THR = 8.f;
constexpr int LDQ = 2048, LDK = 512, LDO = 2048;
constexpr size_t SHM_V = KVBLK * D * 2, SHM_K = KVBLK * D * 2;
#define KSWZ(row, colB) ((row) * 256 + ((colB) ^ (((row) & 7) << 4)))
#define SBAR() __builtin_amdgcn_sched_barrier(0)
__device__ __forceinline__ int crow(int r, int hi) { return (r & 3) + 8 * (r >> 2) + 4 * hi; }
__device__ __forceinline__ unsigned cvtpk(float lo, float hi) { unsigned r; asm volatile("v_cvt_pk_bf16_f32 %0, %1, %2" : "=v"(r) : "v"(lo), "v"(hi)); return r; }
__device__ __forceinline__ void partialSM(f32x16& p0, f32x16& p1, float& m_reg, float& mn, float& alpha) {
  constexpr float C = SCALE * 1.4426950408889634f;
  float pmax = p0[0];
#pragma unroll
  for (int r = 1; r < 16; ++r) pmax = fmaxf(pmax, p0[r]);
#pragma unroll
  for (int r = 0; r < 16; ++r) pmax = fmaxf(pmax, p1[r]);
  { auto rr = __builtin_amdgcn_permlane32_swap(__float_as_uint(pmax), __float_as_uint(pmax), false, false);
    pmax = fmaxf(__uint_as_float(rr[0]), __uint_as_float(rr[1])); }
  if (__builtin_expect(__all(pmax - m_reg <= THR / SCALE), 1)) { mn = m_reg; alpha = 1.f; }
  else { mn = fmaxf(m_reg, pmax); alpha = __builtin_amdgcn_exp2f((m_reg - mn) * C); m_reg = mn; }
  float mnC = -mn * C;
#pragma unroll
  for (int r = 0; r < 16; ++r) p0[r] = fmaf(p0[r], C, mnC);
#pragma unroll
  for (int r = 0; r < 16; ++r) p1[r] = fmaf(p1[r], C, mnC);
#pragma unroll
  for (int r = 0; r < 16; ++r) p0[r] = __builtin_amdgcn_exp2f(p0[r]);
}
__device__ __forceinline__ void finishSM(f32x16& p0, f32x16& p1, float alpha, float& l_reg, bf16x8& pa0, bf16x8& pa1, bf16x8& pa2, bf16x8& pa3) {
#pragma unroll
  for (int r = 0; r < 16; ++r) p1[r] = __builtin_amdgcn_exp2f(p1[r]);
  float ps = 0;
#pragma unroll
  for (int r = 0; r < 16; ++r) ps += p0[r];
#pragma unroll
  for (int r = 0; r < 16; ++r) ps += p1[r];
  { auto rr = __builtin_amdgcn_permlane32_swap(__float_as_uint(ps), __float_as_uint(ps), false, false);
    ps = __uint_as_float(rr[0]) + __uint_as_float(rr[1]); }
  l_reg = l_reg * alpha + ps;
#define PK4(P, BASE, OUT) do { unsigned a0 = cvtpk(P[BASE + 0], P[BASE + 1]), a1 = cvtpk(P[BASE + 2], P[BASE + 3]);   \
    unsigned b0 = cvtpk(P[BASE + 4], P[BASE + 5]), b1 = cvtpk(P[BASE + 6], P[BASE + 7]);                              \
    auto r0 = __builtin_amdgcn_permlane32_swap(a0, b0, false, false); auto r1 = __builtin_amdgcn_permlane32_swap(a1, b1, false, false); \
    u32x4 w = {r0[0], r1[0], r0[1], r1[1]}; OUT = *reinterpret_cast<bf16x8*>(&w); } while (0)
  PK4(p0, 0, pa0); PK4(p0, 8, pa1); PK4(p1, 0, pa2); PK4(p1, 8, pa3);
#undef PK4
}
__device__ __forceinline__ void qkt(f32x16& p0, f32x16& p1, const bf16_t* Ks, const bf16x8* qr, int r32, int hi) {
  p0 = f32x16{}; p1 = f32x16{};
#pragma unroll
  for (int d0 = 0; d0 < 8; ++d0) { int cb = (d0 * 16 + hi * 8) * 2;
    bf16x8 b0 = *reinterpret_cast<const bf16x8*>((const char*)Ks + KSWZ(r32, cb));
    bf16x8 b1 = *reinterpret_cast<const bf16x8*>((const char*)Ks + KSWZ(32 + r32, cb));
    p0 = __builtin_amdgcn_mfma_f32_32x32x16_bf16(b0, qr[d0], p0, 0, 0, 0);
    p1 = __builtin_amdgcn_mfma_f32_32x32x16_bf16(b1, qr[d0], p1, 0, 0, 0); }
}
__device__ __forceinline__ int v_st(int k, int c) { const int kk = (k & ~0xC) | ((k & 4) << 1) | ((k & 8) >> 1); return ((kk >> 3) * 4 + (c >> 5)) * 512 + ((kk & 7) * 32 + (c & 31)) * 2; }
__device__ __forceinline__ int v_rd_base(int lane) { return ((lane & 3) << 3) | (((lane >> 2) & 3) << 6) | (((lane >> 4) & 1) << 5) | (((lane >> 5) & 1) << 8); }
constexpr int v_rd_off(int d0, int ks, int half) { return d0 * 512 + ks * 4096 + half * 2048; }
template <int OFF> __device__ __forceinline__ s16x4 tr_read(int vb) {
  s16x4 r; asm volatile("ds_read_b64_tr_b16 %0, %1 offset:%2" : "=&v"(r) : "v"(vb), "i"(OFF) : "memory"); return r;
}
template <int D0> __device__ __forceinline__ void pv_one(f32x16& od, int vb, bf16x8 pa0, bf16x8 pa1, bf16x8 pa2, bf16x8 pa3) {
  const s16x4 l0 = tr_read<v_rd_off(D0, 0, 0)>(vb), h0 = tr_read<v_rd_off(D0, 0, 1)>(vb), l1 = tr_read<v_rd_off(D0, 1, 0)>(vb), h1 = tr_read<v_rd_off(D0, 1, 1)>(vb);
  const s16x4 l2 = tr_read<v_rd_off(D0, 2, 0)>(vb), h2 = tr_read<v_rd_off(D0, 2, 1)>(vb), l3 = tr_read<v_rd_off(D0, 3, 0)>(vb), h3 = tr_read<v_rd_off(D0, 3, 1)>(vb);
  asm volatile("s_waitcnt lgkmcnt(0)" ::: "memory"); SBAR();
#define PK(L, H) (bf16x8){L[0], L[1], L[2], L[3], H[0], H[1], H[2], H[3]}
  od = __builtin_amdgcn_mfma_f32_32x32x16_bf16(pa0, PK(l0, h0), od, 0, 0, 0);
  od = __builtin_amdgcn_mfma_f32_32x32x16_bf16(pa1, PK(l1, h1), od, 0, 0, 0);
  od = __builtin_amdgcn_mfma_f32_32x32x16_bf16(pa2, PK(l2, h2), od, 0, 0, 0);
  od = __builtin_amdgcn_mfma_f32_32x32x16_bf16(pa3, PK(l3, h3), od, 0, 0, 0);
#undef PK
}
__device__ __forceinline__ void pv_d0(f32x16* o, int vb, bf16x8 pa0, bf16x8 pa1, bf16x8 pa2, bf16x8 pa3) {
  pv_one<0>(o[0], vb, pa0, pa1, pa2, pa3); pv_one<1>(o[1], vb, pa0, pa1, pa2, pa3); pv_one<2>(o[2], vb, pa0, pa1, pa2, pa3); pv_one<3>(o[3], vb, pa0, pa1, pa2, pa3);
}
__device__ __forceinline__ void attn_dense_body(const bf16_t* __restrict__ Qb, const bf16_t* __restrict__ Kh, const bf16_t* __restrict__ Vh,
                                                bf16_t* __restrict__ Ob, int seq, char* lds, const int tid) {
  const int wid = tid >> 6, lane = tid & 63, r32 = lane & 31, hi = lane >> 5;
  bf16_t* V_lds = (bf16_t*)lds; bf16_t* K_lds = (bf16_t*)(lds + 2 * SHM_V);
  float* wsf = (float*)(lds + 2 * SHM_V + 2 * SHM_K) + wid * 64; float* li_l = wsf; float* al_l = wsf + 32;
  float m_reg = -1e30f, l_reg = 0; f32x16 o[4] = {}; bf16x8 qr[8];
  const bf16_t* Qw = Qb + (long)(wid * QBLK + r32) * LDQ + hi * 8;
#pragma unroll
  for (int d0 = 0; d0 < 8; ++d0) qr[d0] = *reinterpret_cast<const bf16x8*>(Qw + d0 * 16);
  const int sr = tid >> 4, sc = (tid & 15) * 8, vst0 = v_st(sr, sc), vst1 = v_st(32 + sr, sc);
  const int vb0 = (int)(uintptr_t)V_lds + v_rd_base(lane);
  struct { bf16x8 vs0, vs1, ks0, ks1; } sr_[2];
#define LD8(p) (*reinterpret_cast<const bf16x8*>(p))
  const unsigned voff = (unsigned)(sr * LDK + sc) * 2u;
#define SLOAD(i, k0) do { const char* vb_ = (const char*)(Vh + (size_t)(k0) * LDK); const char* kb_ = (const char*)(Kh + (size_t)(k0) * LDK); \
    sr_[i].vs0 = LD8(vb_ + voff); sr_[i].vs1 = LD8(vb_ + 32 * LDK * 2 + voff); sr_[i].ks0 = LD8(kb_ + voff); sr_[i].ks1 = LD8(kb_ + 32 * LDK * 2 + voff); } while (0)
#define SWRITE(b, i) do { *(bf16x8*)((char*)V_lds + (b) * SHM_V + vst0) = sr_[i].vs0;          \
    *(bf16x8*)((char*)V_lds + (b) * SHM_V + vst1) = sr_[i].vs1; int kc = sc * 2;               \
    *(bf16x8*)((char*)K_lds + (b) * SHM_K + KSWZ(sr, kc)) = sr_[i].ks0;                       \
    *(bf16x8*)((char*)K_lds + (b) * SHM_K + KSWZ(32 + sr, kc)) = sr_[i].ks1; } while (0)
#define SWAIT() asm volatile("s_waitcnt vmcnt(4)" ::: "memory")
#define RESC(a) do { if (__any((a) < 1.f)) { if (hi == 0) al_l[r32] = (a); asm volatile("s_waitcnt lgkmcnt(0)" ::: "memory"); \
    _Pragma("unroll") for (int d = 0; d < 4; ++d) _Pragma("unroll") for (int r = 0; r < 16; ++r) o[d][r] *= al_l[crow(r, hi)]; } } while (0)
  f32x16 pA0, pA1, pB0, pB1; float mnA, mnB, alA, alB; bf16x8 pa0, pa1, pa2, pa3; const int NT = seq / KVBLK;
  constexpr int SE = 0, SO = 1;
  SLOAD(SE, 0); asm volatile("s_waitcnt vmcnt(0)" ::: "memory"); SWRITE(0, SE); __syncthreads();
  qkt(pA0, pA1, K_lds, qr, r32, hi); partialSM(pA0, pA1, m_reg, mnA, alA);
  SLOAD(SO, KVBLK); if (2 < NT) SLOAD(SE, 2 * KVBLK);
  SWAIT(); SWRITE(1, SO); __syncthreads();
  for (int j = 1; j + 1 < NT; j += 2) {
    SBAR(); qkt(pB0, pB1, (bf16_t*)((char*)K_lds + SHM_K), qr, r32, hi);
    finishSM(pA0, pA1, alA, l_reg, pa0, pa1, pa2, pa3); SBAR();
    SLOAD(SO, (j + 2) * KVBLK); SBAR();
    pv_d0(o, vb0, pa0, pa1, pa2, pa3); partialSM(pB0, pB1, m_reg, mnB, alB);
    __syncthreads(); SWAIT(); SWRITE(0, SE);
    RESC(alB); __syncthreads();
    SBAR(); qkt(pA0, pA1, K_lds, qr, r32, hi);
    finishSM(pB0, pB1, alB, l_reg, pa0, pa1, pa2, pa3); SBAR();
    if (j + 3 < NT) SLOAD(SE, (j + 3) * KVBLK); SBAR();
    pv_d0(o, vb0 + (int)SHM_V, pa0, pa1, pa2, pa3); partialSM(pA0, pA1, m_reg, mnA, alA);
    __syncthreads(); SWAIT(); SWRITE(1, SO);
    RESC(alA); __syncthreads();
  }
  SBAR(); qkt(pB0, pB1, (bf16_t*)((char*)K_lds + SHM_K), qr, r32, hi);
  finishSM(pA0, pA1, alA, l_reg, pa0, pa1, pa2, pa3); SBAR();
  pv_d0(o, vb0, pa0, pa1, pa2, pa3); partialSM(pB0, pB1, m_reg, mnB, alB);
  __syncthreads(); RESC(alB);
  finishSM(pB0, pB1, alB, l_reg, pa0, pa1, pa2, pa3); SBAR();
  pv_d0(o, vb0 + (int)SHM_V, pa0, pa1, pa2, pa3);
  if (hi == 0) li_l[r32] = l_reg; asm volatile("s_waitcnt lgkmcnt(0)" ::: "memory");
  float rli[16];
#pragma unroll
  for (int r = 0; r < 16; ++r) rli[r] = __builtin_amdgcn_rcpf(li_l[crow(r, hi)]);
  bf16_t* Ow = Ob + (long)(wid * QBLK) * LDO;
#pragma unroll
  for (int r = 0; r < 16; ++r) { int orow = crow(r, hi);
#pragma unroll
    for (int d0 = 0; d0 < 4; ++d0) Ow[(long)orow * LDO + d0 * 32 + r32] = f2bf(o[d0][r] * rli[r]); }
#undef LD8
#undef SLOAD
#undef SWRITE
#undef SWAIT
#undef RESC
}
}

__device__ __forceinline__ void mod_phase(const Params& P, LAS unsigned char* lds, const int tid) {
  LAS float* sc = (LAS float*)lds; LAS float* red = sc + 5 * 2048;
  const int wid = tid >> 6, lane = tid & 63;
  for (int i = tid; i < 5 * 2048; i += 512) { const int j = i >> 11, k = i & 2047; const float v = (j < 4) ? P.c[j * 2048 + k] : P.c_ctx[k]; sc[i] = v * sigmoidf_(v); }
  __syncthreads();
  float* MOD = (float*)(P.ws + OFF_MOD);
  const int rg = lane / 18, cl = lane - rg * 18;
  for (int task = P.bid; task < 256; task += P.grd) {
    f32x4 a[5];
#pragma unroll
    for (int j = 0; j < 5; ++j) a[j] = (f32x4){0.f, 0.f, 0.f, 0.f};
    if (lane < 54) {
      const float* wp = P.w_mod + (size_t)(wid * 256 + rg) * NMODC + task * 72 + cl * 4;
#pragma unroll 8
      for (int i = 0; i < 86; ++i) {
        const int kk = 3 * i + rg;
        if (kk < 256) {
          const f32x4 w = *(const f32x4*)(wp + (size_t)(3 * i) * NMODC);
#pragma unroll
          for (int j = 0; j < 5; ++j) a[j] += w * sc[j * 2048 + wid * 256 + kk];
        }
      }
#pragma unroll
      for (int j = 0; j < 5; ++j) *(LAS f32x4*)(red + ((wid * 3 + rg) * 5 + j) * 72 + cl * 4) = a[j];
    }
    __syncthreads();
    if (tid < 360) { const int j = tid / 72, ci = tid % 72; float s = 0.f;
#pragma unroll
      for (int w = 0; w < 24; ++w) s += red[(w * 5 + j) * 72 + ci];
      MOD[j * NMODC + task * 72 + ci] = s + P.b_mod[task * 72 + ci]; }
    __syncthreads();
  }
}
__device__ __forceinline__ void tr_load(float (&tv)[32], const float* __restrict__ W, int ldw, int k0, int n0, int lane) {
#pragma unroll
  for (int i = 0; i < 32; ++i) { const int kk = 2 * i + (lane >> 5); tv[i] = W[(size_t)(k0 + kk) * ldw + n0 + (lane & 31)]; }
}
__device__ __forceinline__ void tr_store(const float (&tv)[32], int k0, bf16_t* __restrict__ WT, int ldt, int drow0, int dk0, LAS float* scr, int lane) {
#pragma unroll
  for (int i = 0; i < 32; ++i) { const int kk = 2 * i + (lane >> 5); scr[kk * 33 + (lane & 31)] = tv[i]; }
  asm volatile("s_waitcnt lgkmcnt(0)" ::: "memory");
  const int c = lane & 7;
#pragma unroll
  for (int j = 0; j < 4; ++j) { const int n = (lane >> 3) + 8 * j; const LAS float* s = scr + (8 * c) * 33 + n;
    u32x4 o; o.x = cvt_pk_bf16(s[0 * 33], s[1 * 33]); o.y = cvt_pk_bf16(s[2 * 33], s[3 * 33]); o.z = cvt_pk_bf16(s[4 * 33], s[5 * 33]); o.w = cvt_pk_bf16(s[6 * 33], s[7 * 33]);
    *(u32x4*)(WT + (size_t)(drow0 + n) * ldt + dk0 + k0 + 8 * c) = o; }
  asm volatile("s_waitcnt lgkmcnt(0)" ::: "memory");
}
__device__ __forceinline__ void tr_item(const float* __restrict__ W, int ldw, int k0, int n0, bf16_t* __restrict__ WT, int ldt, int drow0, int dk0, LAS float* scr, int lane) {
  float tv[32]; tr_load(tv, W, ldw, k0, n0, lane); tr_store(tv, k0, WT, ldt, drow0, dk0, scr, lane);
}
constexpr int N_LATE = 16896 + 6144 + 2048 + 1024 + 2048;
__device__ __forceinline__ void late_item_addr(const Params& P, int j, const float*& W, int& ldw, int& k0, int& n0, bf16_t*& WT, int& ldt, int& drow) {
  if (j < 11264) { const int kb = j / 352, nb = j % 352; n0 = nb * 32; k0 = kb * 64; W = P.ffn2_w_in; ldw = 2 * DFF; WT = (bf16_t*)(P.ws + OFF_W2A); ldt = 2048;
    drow = n0 < DFF ? (n0 >> 7) * 256 + (n0 & 127) : ((n0 - DFF) >> 7) * 256 + 128 + ((n0 - DFF) & 127); return; }
  j -= 11264;
  if (j < 5632) { const int kb = j >> 6, nb = j & 63; n0 = nb * 32; k0 = kb * 64; W = P.ffn2_w_out; ldw = 2048; WT = (bf16_t*)(P.ws + OFF_W2B); ldt = DFF; drow = n0; return; }
  j -= 5632;
  if (j < 6144) { const int kb = j / 192, nbi = j % 192, nb = nbi < 64 ? nbi : nbi + 32;
    n0 = nb < 96 ? nb * 32 : 6528 + (nb - 96) * 32; k0 = kb * 64; W = P.w_in; ldw = 10624; WT = (bf16_t*)(P.ws + OFF_WQKVG); ldt = 2048; drow = nb * 32; return; }
  j -= 6144;
  if (j < 2048) { k0 = (j >> 6) * 64; n0 = (j & 63) * 32; W = P.w_oa; ldw = 2048; WT = (bf16_t*)(P.ws + OFF_WOA); ldt = 2048; drow = n0; return; }
  j -= 2048;
  if (j < 1024) { k0 = (j >> 6) * 64; n0 = (j & 63) * 32; W = P.w_or; ldw = 2048; WT = (bf16_t*)(P.ws + OFF_WOR); ldt = 1024; drow = n0; return; }
  j -= 1024;
  k0 = (j >> 6) * 64; n0 = (j & 63) * 32; W = P.w_out; ldw = 2048; WT = (bf16_t*)(P.ws + OFF_WOUT); ldt = 2048; drow = n0;
}
constexpr int N_EARLY = 11264 + 5632 + 3456 + 1024 + 192;
__device__ __forceinline__ void early_item_addr(const Params& P, int j, const float*& W, int& ldw, int& k0, int& n0, bf16_t*& WT, int& ldt, int& drow, int& dk0) {
  unsigned char* ws = P.ws; dk0 = 0;
  if (j < 11264) { const int kb = j / 352, nb = j % 352; n0 = nb * 32; k0 = kb * 64; W = P.ffn1_w_in; ldw = 2 * DFF; WT = (bf16_t*)(ws + OFF_W1A); ldt = 2048;
    drow = n0 < DFF ? (n0 >> 7) * 256 + (n0 & 127) : ((n0 - DFF) >> 7) * 256 + 128 + ((n0 - DFF) & 127); return; }
  j -= 11264;
  if (j < 5632) { const int kb = j >> 6, nb = j & 63; n0 = nb * 32; k0 = kb * 64; W = P.ffn1_w_out; ldw = 2048; WT = (bf16_t*)(ws + OFF_W1B); ldt = DFF; drow = n0; return; }
  j -= 5632;
  if (j < 3456) { const int kb = j / 108, nb = j % 108; n0 = 3072 + nb * 32; k0 = kb * 64; W = P.w_in; ldw = 10624; WT = (bf16_t*)(ws + OFF_WRW); ldt = 2048; drow = nb * 32; return; }
  j -= 3456;
  if (j < 1024) { const int kb = j >> 5, nb = 64 + (j & 31); n0 = nb * 32; k0 = kb * 64; W = P.w_in; ldw = 10624; WT = (bf16_t*)(ws + OFF_WQKVG); ldt = 2048; drow = nb * 32; return; }
  j -= 1024;
  if (j < 64) { const int z = j >> 5, nb = j & 31; W = P.w2 + (size_t)z * 64 * 1024; ldw = 1024; k0 = 0; n0 = nb * 32; WT = (bf16_t*)(ws + OFF_WLORA); ldt = LIN_LD; drow = z * 1024 + nb * 32; dk0 = z * 64; return; }
  j -= 64;
  if (j < 64) { const int z = j >> 5, nb = j & 31; W = P.a2 + (size_t)z * 64 * 1024; ldw = 1024; k0 = 0; n0 = nb * 32; WT = (bf16_t*)(ws + OFF_WLORA); ldt = LIN_LD; drow = 2048 + z * 1024 + nb * 32; dk0 = 128 + z * 64; return; }
  j -= 64;
  { const int kb = j >> 5, nb = j & 31; W = P.g2; ldw = 1024; k0 = kb * 64; n0 = nb * 32; WT = (bf16_t*)(ws + OFF_WLORA); ldt = LIN_LD; drow = 4096 + nb * 32; dk0 = 256; }
}
__device__ __forceinline__ void convert_phase(const Params& P, LAS unsigned char* lds, const int tid) {
  const int wid = tid >> 6, lane = tid & 63;
  LAS float* scr = (LAS float*)(lds + wid * 8704);
  unsigned char* ws = P.ws;
  bf16_t *W1A = (bf16_t*)(ws + OFF_W1A), *W1B = (bf16_t*)(ws + OFF_W1B), *W2A = (bf16_t*)(ws + OFF_W2A), *W2B = (bf16_t*)(ws + OFF_W2B);
  bf16_t *WRW = (bf16_t*)(ws + OFF_WRW), *WQKVG = (bf16_t*)(ws + OFF_WQKVG), *WOA = (bf16_t*)(ws + OFF_WOA), *WOR = (bf16_t*)(ws + OFF_WOR), *WOUT = (bf16_t*)(ws + OFF_WOUT), *WLORA = (bf16_t*)(ws + OFF_WLORA);
  const int G = P.grd, gw = P.bid * 8 + wid, NGW = G * 8;
  for (int it = gw; it < N_EARLY; it += 2 * NGW) {
    float tA[32], tB[32];
    const float* Wa; int ldwa, k0a, n0a, ldta, drowa, dk0a; bf16_t* WTa; early_item_addr(P, it, Wa, ldwa, k0a, n0a, WTa, ldta, drowa, dk0a);
    tr_load(tA, Wa, ldwa, k0a, n0a, lane);
    const bool hb = it + NGW < N_EARLY;
    const float* Wb = Wa; int ldwb = ldwa, k0b = k0a, n0b = n0a, ldtb = ldta, drowb = drowa, dk0b = dk0a; bf16_t* WTb = WTa;
    if (hb) { early_item_addr(P, it + NGW, Wb, ldwb, k0b, n0b, WTb, ldtb, drowb, dk0b); tr_load(tB, Wb, ldwb, k0b, n0b, lane); }
    tr_store(tA, k0a, WTa, ldta, drowa, dk0a, scr, lane);
    if (hb) tr_store(tB, k0b, WTb, ldtb, drowb, dk0b, scr, lane);
  }
  const int gt = P.bid * 512 + tid, NT = G * 512;
  unsigned zz = 0u; asm volatile("" : "+v"(zz));
  const u32x4 z4 = {zz, zz, zz, zz};
  for (int i = gt; i < 128 * 256; i += NT) *(u32x4*)(WRW + (size_t)3456 * 2048 + (size_t)i * 8) = z4;
  for (int i = gt; i < 5120 * 48; i += NT) { const int row = i / 48, kc = (i % 48) * 8, rb = row >> 10;
    const int lo = rb < 4 ? rb * 64 : 256, hi = rb < 4 ? rb * 64 + 64 : 384;
    if (kc < lo || kc >= hi) *(u32x4*)(WLORA + (size_t)row * LIN_LD + kc) = z4; }
}
__device__ __forceinline__ void norm_mod_phase(const Params& P, const float* __restrict__ lat, const float* __restrict__ ctxp, int nrows, const float* __restrict__ g, int midx, const float* __restrict__ parts, const int tid) {
  const int wid = tid >> 6, lane = tid & 63;
  const int gw = P.bid * 8 + wid, NGW = P.grd * 8;
  const float* __restrict__ MOD = (const float*)(P.ws + OFF_MOD); bf16_t* __restrict__ H = (bf16_t*)(P.ws + OFF_H);
  for (int r = gw; r < nrows; r += NGW) {
    const float* xr = r < MT ? lat + (size_t)r * DM : ctxp + (size_t)(r - MT) * DM;
    const int b = r < MT ? (r >> 13) : 4;
    const float* sh = MOD + b * NMODC + midx * DM; const float* scp = sh + DM;
    f32x4 v[8], g4[8], s4[8], c4[8]; float ss = 0.f;
#pragma unroll
    for (int j = 0; j < 8; ++j) v[j] = *(const f32x4*)(xr + j * 256 + lane * 4);
    if (parts && r >= MT) {
      const float* pp = parts + (size_t)(r - MT) * DM; const float* gt = MOD + 4 * NMODC + 2 * DM;
#pragma unroll
      for (int j = 0; j < 8; ++j) { const int c = j * 256 + lane * 4;
        const f32x4 s = (*(const f32x4*)(pp + c) + *(const f32x4*)(pp + (size_t)MC * DM + c)) + (*(const f32x4*)(pp + (size_t)2 * MC * DM + c) + *(const f32x4*)(pp + (size_t)3 * MC * DM + c));
        v[j] = v[j] + *(const f32x4*)(gt + c) * 0.5f * s; }
    }
#pragma unroll
    for (int j = 0; j < 8; ++j) { const int c = j * 256 + lane * 4; g4[j] = *(const f32x4*)(g + c); s4[j] = *(const f32x4*)(sh + c); c4[j] = *(const f32x4*)(scp + c); }
#pragma unroll
    for (int j = 0; j < 8; ++j) ss += v[j].x * v[j].x + v[j].y * v[j].y + v[j].z * v[j].z + v[j].w * v[j].w;
    ss = wave_sum(ss);
    const float rs = rsqrtf(ss * (1.f / DM) + 1e-6f);
#pragma unroll
    for (int j = 0; j < 8; ++j) { const int c = j * 256 + lane * 4;
      const f32x4 y = v[j] * rs * g4[j]; const f32x4 h = y * (c4[j] + 1.f) + s4[j];
      u32x2 w; w.x = cvt_pk_bf16(h.x, h.y); w.y = cvt_pk_bf16(h.z, h.w);
      *(u32x2*)(H + (size_t)r * DM + c) = w; }
  }
}
__device__ __forceinline__ void shift_phase(const Params& P, const int tid) {
  const bf16_t* __restrict__ PRW = (const bf16_t*)(P.ws + OFF_PRW); bf16_t* __restrict__ SH = (bf16_t*)(P.ws + OFF_SH); bf16_t* __restrict__ LIN = (bf16_t*)(P.ws + OFF_LIN);
  const int gt = P.bid * 512 + tid, NT = P.grd * 512;
  for (int idx0 = gt; idx0 < MA * 432; idx0 += 4 * NT) {
    u32x4 pb[4], pvb[4], nxb[4];
#pragma unroll
    for (int u = 0; u < 4; ++u) {
      const int idx = idx0 + u * NT; const bool ok = idx < MA * 432;
      const int r = ok ? idx / 432 : 0, c = ok ? (idx % 432) * 8 : 0;
      bool first, last;
      if (r < MT) { const int t = r & (SEQ - 1); first = t == 0; last = t == SEQ - 1; } else { const int t = (r - MT) & (CTXL - 1); first = t == 0; last = t == CTXL - 1; }
      const u32x4 z4 = {0u, 0u, 0u, 0u};
      pb[u] = *(const u32x4*)(PRW + (size_t)r * PRW_LD + c);
      pvb[u] = first ? z4 : *(const u32x4*)(PRW + (size_t)(r - 1) * PRW_LD + c);
      nxb[u] = last ? z4 : *(const u32x4*)(PRW + (size_t)(r + 1) * PRW_LD + c);
    }
#pragma unroll
    for (int u = 0; u < 4; ++u) {
    const int idx = idx0 + u * NT; if (idx >= MA * 432) break;
    const int r = idx / 432, c = (idx % 432) * 8;
    const u32x4 p = pb[u], pv = pvb[u], nx = nxb[u];
    const f32x4 m0 = *(const f32x4*)(P.rwkv_mu + c), m1 = *(const f32x4*)(P.rwkv_mu + c + 4);
    float o[8];
#define SHF(e, W, MU, HI) { const float pp = HI ? bfhi(p.W) : bflo(p.W), a = HI ? bfhi(pv.W) : bflo(pv.W), b = HI ? bfhi(nx.W) : bflo(nx.W); o[e] = pp + MU * (0.5f * (a + b) - pp); }
    SHF(0, x, m0.x, 0) SHF(1, x, m0.y, 1) SHF(2, y, m0.z, 0) SHF(3, y, m0.w, 1) SHF(4, z, m1.x, 0) SHF(5, z, m1.y, 1) SHF(6, w, m1.z, 0) SHF(7, w, m1.w, 1)
#undef SHF
    bf16_t* dst;
    if (c >= 1024 && c < 2048) {
      const f32x4 q0 = *(const f32x4*)(P.k_k + (c - 1024)), q1 = *(const f32x4*)(P.k_k + (c - 1024) + 4);
      float ss = 0.f;
#define KQ(e, qv) { const float kq = bflo(cvt_pk_bf16(o[e], 0.f)) * qv; ss += kq * kq; }
      KQ(0, q0.x) KQ(1, q0.y) KQ(2, q0.z) KQ(3, q0.w) KQ(4, q1.x) KQ(5, q1.y) KQ(6, q1.z) KQ(7, q1.w)
#undef KQ
      ss = allred8(ss);
      if ((idx & 7) == 0) ((float*)(P.ws + OFF_RN))[(size_t)r * 16 + ((c - 1024) >> 6)] = rsqrtf(fmaxf(ss, 1e-24f));
    }
    if (c < 3072) dst = SH + (size_t)r * SH_LD + c;
    else { const int cl = c - 3072; dst = LIN + (size_t)r * LIN_LD + cl;
      if (cl < 128) {
#pragma unroll
        for (int e = 0; e < 8; ++e) { const float ex = __builtin_amdgcn_exp2f(2.8853900817779268f * o[e]); o[e] = 1.f - 2.f * __builtin_amdgcn_rcpf(ex + 1.f); }
      } else if (cl >= 256) {
#pragma unroll
        for (int e = 0; e < 8; ++e) o[e] = sigmoidf_(o[e]);
      } }
    u32x4 w; w.x = cvt_pk_bf16(o[0], o[1]); w.y = cvt_pk_bf16(o[2], o[3]); w.z = cvt_pk_bf16(o[4], o[5]); w.w = cvt_pk_bf16(o[6], o[7]);
    *(u32x4*)dst = w;
    }
  }
}
__device__ __forceinline__ float SFMA(float a, float b, float c) { float d; asm("v_fma_f32 %0, %1, %2, %3" : "=v"(d) : "v"(a), "v"(b), "v"(c)); return d; }
__device__ __forceinline__ float SMUL(float a, float b) { float d; asm("v_mul_f32 %0, %1, %2" : "=v"(d) : "v"(a), "v"(b)); return d; }
__device__ __forceinline__ void scan_phase(const Params& P, LAS unsigned char* lds, const int tid) {
  constexpr int FSTEP = 320, FBUF = 32 * FSTEP + 4 * 64;
  LAS float* F = (LAS float*)lds;
  LAS unsigned short* YB = (LAS unsigned short*)(lds + 2 * FBUF * 4);
  constexpr int TR_OFF = 2 * FBUF * 4 + 4096;
  const bf16_t* SH = (const bf16_t*)(P.ws + OFF_SH); const bf16_t* LO = (const bf16_t*)(P.ws + OFF_LO); bf16_t* Y = (bf16_t*)(P.ws + OFF_Y);
  const int wid = __builtin_amdgcn_readfirstlane(tid >> 6), lane = tid & 63;
  constexpr int NCH = SKV / 32;
#define SCAN_BAR() do { asm volatile("s_waitcnt lgkmcnt(0)" ::: "memory"); __builtin_amdgcn_s_barrier(); asm volatile("" ::: "memory"); } while (0)
  for (int task = P.bid; task < 256; task += P.grd) {
    const int half = (task >> 3) & 1, chain = (task & 7) | ((task >> 4) << 3);
    const int dir = chain & 1, h = (chain >> 1) & 15, b = chain >> 5, hc = h * 64;
#define ROWOF(g) ((g) < CTXL ? (MT + b * CTXL + (dir ? CTXL - 1 - (g) : (g))) : (b * SEQ + (dir ? SEQ - 1 - ((g) - CTXL) : ((g) - CTXL))))
    if (wid < 4) {
      const int rloc = wid * 8 + (lane >> 3), irow = half * 32 + rloc, cA = (lane & 7) * 4, cB = 32 + cA;
      f32x4 S0 = {0.f, 0.f, 0.f, 0.f}, S1 = {0.f, 0.f, 0.f, 0.f};
      SCAN_BAR();
      for (int q = 0; q < NCH; ++q) {
        const LAS float* f = F + (q & 1) * FBUF;
        LAS unsigned short* yb = YB + (q & 1) * 1024;
        f32x4 a0 = *(const LAS f32x4*)(f + cA), a1 = *(const LAS f32x4*)(f + cB);
        f32x4 b0 = *(const LAS f32x4*)(f + 64 + cA), b1 = *(const LAS f32x4*)(f + 64 + cB);
        f32x4 k0 = *(const LAS f32x4*)(f + 128 + cA), k1 = *(const LAS f32x4*)(f + 128 + cB);
        f32x4 r0 = *(const LAS f32x4*)(f + 192 + cA), r1 = *(const LAS f32x4*)(f + 192 + cB);
        float vv = f[256 + irow];
        float ykeep = 0.f; f32x4 gA = {1.f, 1.f, 1.f, 1.f}, gB = gA;
#pragma unroll 16
        for (int s = 0; s < 32; ++s) {
          const LAS float* fn = f + (s < 31 ? s + 1 : 31) * FSTEP;
          const f32x4 na0 = *(const LAS f32x4*)(fn + cA), na1 = *(const LAS f32x4*)(fn + cB);
          const f32x4 nb0 = *(const LAS f32x4*)(fn + 64 + cA), nb1 = *(const LAS f32x4*)(fn + 64 + cB);
          const f32x4 nk0 = *(const LAS f32x4*)(fn + 128 + cA), nk1 = *(const LAS f32x4*)(fn + 128 + cB);
          const f32x4 nr0 = *(const LAS f32x4*)(fn + 192 + cA), nr1 = *(const LAS f32x4*)(fn + 192 + cB);
          const float nvv = fn[256 + irow];
          if ((s & 7) == 5) { const LAS float* gp = f + 32 * FSTEP + (s >> 3) * 64; gA = *(const LAS f32x4*)(gp + cA); gB = *(const LAS f32x4*)(gp + cB); }
          f32x4 p = S0 * a0 + S1 * a1;
          const float sa_ = allred8((p.x + p.y) + (p.z + p.w));
          S0 = __builtin_elementwise_fma(k0, (f32x4){vv, vv, vv, vv}, __builtin_elementwise_fma(b0, (f32x4){sa_, sa_, sa_, sa_}, S0));
          S1 = __builtin_elementwise_fma(k1, (f32x4){vv, vv, vv, vv}, __builtin_elementwise_fma(b1, (f32x4){sa_, sa_, sa_, sa_}, S1));
          p = S0 * r0 + S1 * r1;
          const float y = allred8((p.x + p.y) + (p.z + p.w));
          ykeep = ((s & 7) == (lane & 7)) ? y : ykeep;
          if ((s & 7) == 7) {
            yb[((s & ~7) + (lane & 7)) * 32 + rloc] = f2bf(ykeep);
            S0 = S0 * gA; S1 = S1 * gB;
          }
          a0 = na0; a1 = na1; b0 = nb0; b1 = nb1; k0 = nk0; k1 = nk1; r0 = nr0; r1 = nr1; vv = nvv;
        }
        SCAN_BAR();
      }
    } else {
      const int sw = wid - 4, hw = lane >> 5, cp = (lane & 31) * 2;
      const f32x2 kk_c = *(const f32x2*)(P.k_k + hc + cp), ka_c = *(const f32x2*)(P.k_a + hc + cp);
      unsigned voS[4], voL[4];
#pragma unroll
      for (int e = 0; e < 4; ++e) { const int tk = hw * 4 + e, ro = dir ? 7 - tk : tk; voS[e] = (unsigned)(ro * SH_LD + cp) * 2u; voL[e] = (unsigned)(ro * LO_LD + cp) * 2u; }
      unsigned sr[4], sk[4], sv[4], sl[4], sa[4]; float srn[4]; int roff[4];
#pragma unroll
      for (int e = 0; e < 4; ++e) { const int tk = hw * 4 + e; roff[e] = (dir ? 7 - tk : tk) * 16; }
      const float* RN = (const float*)(P.ws + OFF_RN);
#define RMIN(q) ({ const int g0_ = (q) * 32 + sw * 8; const int ra_ = ROWOF(g0_), rb_ = ROWOF(g0_ + 7); ra_ < rb_ ? ra_ : rb_; })
#define SLOADQ(q) do { const size_t rmin_ = (size_t)RMIN(q); const char* bs_ = (const char*)(SH + rmin_ * SH_LD + hc); const char* bl_ = (const char*)(LO + rmin_ * LO_LD + dir * 1024 + hc); \
      _Pragma("unroll") for (int e = 0; e < 4; ++e) { sr[e] = *(const unsigned*)(bs_ + voS[e]); sk[e] = *(const unsigned*)(bs_ + 2048 + voS[e]); sv[e] = *(const unsigned*)(bs_ + 4096 + voS[e]); \
        sl[e] = *(const unsigned*)(bl_ + voL[e]); sa[e] = *(const unsigned*)(bl_ + 4096 + voL[e]); srn[e] = RN[rmin_ * 16 + h + roff[e]]; } } while (0)
#define EX2V(V) (f32x2){__builtin_amdgcn_exp2f((V).x), __builtin_amdgcn_exp2f((V).y)}
#define SWRITEQ(buf) do { \
      f32x2 Lc[4]; { f32x2 run = {0.f, 0.f}; _Pragma("unroll") for (int e = 0; e < 4; ++e) { run = run + (f32x2){bflo(sl[e]), bfhi(sl[e])}; Lc[e] = run; } } \
      f32x2 qlo, qhi; { auto r0_ = __builtin_amdgcn_permlane32_swap(__float_as_uint(Lc[3].x), __float_as_uint(Lc[3].x), false, false); \
                        auto r1_ = __builtin_amdgcn_permlane32_swap(__float_as_uint(Lc[3].y), __float_as_uint(Lc[3].y), false, false); \
                        qlo = (f32x2){__uint_as_float(r0_[0]), __uint_as_float(r1_[0])}; qhi = (f32x2){__uint_as_float(r0_[1]), __uint_as_float(r1_[1])}; } \
      const f32x2 base_ = hw ? qlo : (f32x2){0.f, 0.f}; \
      if (hw == 0) *(LAS f32x2*)(F + (buf) * FBUF + 32 * FSTEP + sw * 64 + cp) = EX2V(-(qlo + qhi)); \
      f32x2 Pm = EX2V(-base_); \
      _Pragma("unroll") for (int e = 0; e < 4; ++e) { LAS float* f_ = F + (buf) * FBUF + (sw * 8 + hw * 4 + e) * FSTEP + cp; \
        const f32x2 r_ = {bflo(sr[e]), bfhi(sr[e])}, k_ = {bflo(sk[e]), bfhi(sk[e])}, v_ = {bflo(sv[e]), bfhi(sv[e])}, aa = {bflo(sa[e]), bfhi(sa[e])}; \
        const f32x2 lj = base_ + Lc[e]; \
        const f32x2 Pj = EX2V(-lj), Pi = EX2V(lj); \
        const f32x2 kk = k_ * kk_c * srn[e]; const f32x2 kki = kk * Pi; \
        *(LAS f32x2*)(f_) = -kk * Pm; *(LAS f32x2*)(f_ + 64) = kki * aa; *(LAS f32x2*)(f_ + 128) = k_ * ((aa - 1.f) * ka_c + 1.f) * Pi; \
        *(LAS f32x2*)(f_ + 192) = r_ * Pj; *(LAS f32x2*)(f_ + 256) = v_; Pm = Pj; } } while (0)
      LAS float* trscr = (LAS float*)(lds + TR_OFF + sw * 8704);
      float tv[32]; int w2j = task * 4 + sw;
      SLOADQ(0); SWRITEQ(0); SLOADQ(1);
      SCAN_BAR();
      for (int q = 0; q < NCH; ++q) {
        if (q >= 9) {
          const int qq = q - 1; const LAS unsigned short* yb = YB + (qq & 1) * 1024;
          const int t256 = sw * 64 + lane, s = t256 >> 3, rp = (t256 & 7) * 4; const int u = qq * 32 + s - CTXL; const int t = dir ? SEQ - 1 - u : u;
          const u32x2 val = *(const LAS u32x2*)(yb + s * 32 + rp);
          *(u32x2*)(Y + (size_t)dir * MT * 1024 + (size_t)(b * SEQ + t) * 1024 + hc + half * 32 + rp) = val;
        }
        if (q + 1 < NCH) SWRITEQ((q + 1) & 1);
        if ((q & 7) == 3 && w2j < N_LATE) {
          const float* W_; int ldw_, k0_, n0_, ldt_, drow_; bf16_t* WT_; late_item_addr(P, w2j, W_, ldw_, k0_, n0_, WT_, ldt_, drow_);
          tr_store(tv, k0_, WT_, ldt_, drow_, 0, trscr, lane); w2j += 1024;
        }
        if (q + 2 < NCH) SLOADQ(q + 2);
        if ((q & 7) == 2 && w2j < N_LATE) {
          const float* W_; int ldw_, k0_, n0_, ldt_, drow_; bf16_t* WT_; late_item_addr(P, w2j, W_, ldw_, k0_, n0_, WT_, ldt_, drow_);
          tr_load(tv, W_, ldw_, k0_, n0_, lane);
        }
        SCAN_BAR();
      }
      {
        const int qq = NCH - 1; const LAS unsigned short* yb = YB + (qq & 1) * 1024;
        const int t256 = sw * 64 + lane, s = t256 >> 3, rp = (t256 & 7) * 4; const int u = qq * 32 + s - CTXL; const int t = dir ? SEQ - 1 - u : u;
        const u32x2 val = *(const LAS u32x2*)(yb + s * 32 + rp);
        *(u32x2*)(Y + (size_t)dir * MT * 1024 + (size_t)(b * SEQ + t) * 1024 + hc + half * 32 + rp) = val;
      }
#undef SLOADQ
#undef SWRITEQ
#undef RMIN
#undef EX2V
    }
#undef ROWOF
    __syncthreads();
  }
#undef SCAN_BAR
}
__device__ __forceinline__ float half_sum(float v) {
  v = allred16(v);
  auto rr = __builtin_amdgcn_permlane16_swap(__float_as_uint(v), __float_as_uint(v), false, false); return __uint_as_float(rr[0]) + __uint_as_float(rr[1]);
}
__device__ __forceinline__ void rwkv_out_phase(const Params& P, const int tid) {
  const bf16_t* SH = (const bf16_t*)(P.ws + OFF_SH); const bf16_t* LO = (const bf16_t*)(P.ws + OFF_LO); bf16_t* Y = (bf16_t*)(P.ws + OFF_Y);
  const int wid = tid >> 6, lane = tid & 63, hw = lane >> 5, cp = (lane & 31) * 2;
  const int gw = P.bid * 8 + wid, NGW = P.grd * 8;
  for (int task = gw * 2; task < MT * 8; task += NGW * 2) {
    unsigned yf[2], ybk[2], rr[2], kk[2], vv[2], af[2], ab[2], gg[2]; int cc[2]; size_t tk[2];
#pragma unroll
    for (int u = 0; u < 2; ++u) { const int t_ = task + u; tk[u] = (size_t)(t_ >> 3); cc[u] = ((t_ & 7) * 2 + hw) * 64 + cp;
      const bf16_t* py = Y + tk[u] * 1024 + cc[u]; const bf16_t* ps = SH + tk[u] * SH_LD + cc[u]; const bf16_t* pl = LO + tk[u] * LO_LD + cc[u];
      yf[u] = *(const unsigned*)py; ybk[u] = *(const unsigned*)(py + (size_t)MT * 1024);
      rr[u] = *(const unsigned*)ps; kk[u] = *(const unsigned*)(ps + 1024); vv[u] = *(const unsigned*)(ps + 2048);
      af[u] = *(const unsigned*)(pl + 2048); ab[u] = *(const unsigned*)(pl + 3072); gg[u] = *(const unsigned*)(pl + 4096); }
    unsigned res[2];
#pragma unroll
    for (int u = 0; u < 2; ++u) {
      const f32x2 lw = *(const f32x2*)(P.ln_x_w + cc[u]), lb = *(const f32x2*)(P.ln_x_b + cc[u]), ka = *(const f32x2*)(P.k_a + cc[u]), rk = *(const f32x2*)(P.r_k + cc[u]);
      const f32x2 y = {bflo(yf[u]) + bflo(ybk[u]), bfhi(yf[u]) + bfhi(ybk[u])};
      const float mu = half_sum(y.x + y.y) * (1.f / 64.f); const f32x2 dv = y - mu; const float var = half_sum(dv.x * dv.x + dv.y * dv.y) * (1.f / 64.f);
      const f32x2 yn = dv * rsqrtf(var + 64e-5f) * lw + lb;
      const f32x2 r = {bflo(rr[u]), bfhi(rr[u])}, k = {bflo(kk[u]), bfhi(kk[u])}, v = {bflo(vv[u]), bfhi(vv[u])};
      const f32x2 a1 = {bflo(af[u]), bfhi(af[u])}, a2 = {bflo(ab[u]), bfhi(ab[u])}, g = {bflo(gg[u]), bfhi(gg[u])};
      const f32x2 kms = k * ((a1 - 1.f) * ka + 1.f) + k * ((a2 - 1.f) * ka + 1.f);
      const f32x2 bt = r * kms * rk;
      const float bonus = half_sum(bt.x + bt.y);
      const f32x2 o = (yn + v * bonus) * g;
      res[u] = cvt_pk_bf16(o.x, o.y);
    }
#pragma unroll
    for (int u = 0; u < 2; ++u) *(unsigned*)(Y + tk[u] * 1024 + cc[u]) = res[u];
  }
}
__device__ __forceinline__ void rope_phase(const Params& P, const int tid) {
  bf16_t* Q = (bf16_t*)(P.ws + OFF_Q); bf16_t* KB = (bf16_t*)(P.ws + OFF_KB);
  const int wid = tid >> 6, lane = tid & 63, hw = lane >> 5, li = lane & 31;
  const int gw = P.bid * 8 + wid, NGW = P.grd * 8;
  const int d1 = li < 16 ? 2 * li : 64 + 2 * (li - 16);
  const f32x2 qgA = *(const f32x2*)(P.q_norm + d1), qgB = *(const f32x2*)(P.q_norm + d1 + 32), kgA = *(const f32x2*)(P.k_norm + d1), kgB = *(const f32x2*)(P.k_norm + d1 + 32);
  const int j0 = 2 * (li & 15);
  const float inv0 = __builtin_amdgcn_exp2f(-(float)(2 * j0) * (13.287712379549449f / 64.f)), inv1 = __builtin_amdgcn_exp2f(-(float)(2 * j0 + 2) * (13.287712379549449f / 64.f));
  for (int task = gw; task < MA; task += NGW) {
    if (task < MT) {
      const int tok = task, b = tok >> 13, t = tok & (SEQ - 1);
      const float pos = (float)(li < 16 ? (t >> 6) : (t & 63));
      const float an0 = pos * inv0, an1 = pos * inv1;
      const f32x2 sn = {__sinf(an0), __sinf(an1)}, cs = {__cosf(an0), __cosf(an1)};
      unsigned lo[10], hi[10]; bf16_t* ptr[10];
#pragma unroll
      for (int i = 0; i < 10; ++i) { const int hd = 2 * i + hw;
        ptr[i] = (hd < 16 ? Q + (size_t)tok * DM + hd * 128 : KB + (size_t)(tok + b * CTXL) * 512 + (hd - 16) * 128) + d1;
        lo[i] = *(const unsigned*)ptr[i]; hi[i] = *(const unsigned*)(ptr[i] + 32); }
#pragma unroll
      for (int i = 0; i < 10; ++i) { const bool isq = i < 8;
        const f32x2 t1 = {bflo(lo[i]), bfhi(lo[i])}, t2 = {bflo(hi[i]), bfhi(hi[i])};
        const float ss = half_sum((t1.x * t1.x + t1.y * t1.y) + (t2.x * t2.x + t2.y * t2.y)); const float rs = rsqrtf(ss * (1.f / 128.f) + 1e-6f);
        const f32x2 n1 = t1 * rs * (isq ? qgA : kgA), n2 = t2 * rs * (isq ? qgB : kgB);
        const f32x2 o1 = n1 * cs - n2 * sn, o2 = n2 * cs + n1 * sn;
        lo[i] = cvt_pk_bf16(o1.x, o1.y); hi[i] = cvt_pk_bf16(o2.x, o2.y); }
#pragma unroll
      for (int i = 0; i < 10; ++i) { *(unsigned*)ptr[i] = lo[i]; *(unsigned*)(ptr[i] + 32) = hi[i]; }
    } else {
      const int ct = task - MT, b = ct >> 8, t = ct & (CTXL - 1);
      unsigned lo[2], hi[2]; bf16_t* ptr[2];
#pragma unroll
      for (int i = 0; i < 2; ++i) { ptr[i] = KB + (size_t)(b * SKV + SEQ + t) * 512 + (2 * i + hw) * 128 + d1; lo[i] = *(const unsigned*)ptr[i]; hi[i] = *(const unsigned*)(ptr[i] + 32); }
#pragma unroll
      for (int i = 0; i < 2; ++i) {
        const f32x2 t1 = {bflo(lo[i]), bfhi(lo[i])}, t2 = {bflo(hi[i]), bfhi(hi[i])};
        const float ss = half_sum((t1.x * t1.x + t1.y * t1.y) + (t2.x * t2.x + t2.y * t2.y)); const float rs = rsqrtf(ss * (1.f / 128.f) + 1e-6f);
        const f32x2 n1 = t1 * rs * kgA, n2 = t2 * rs * kgB;
        *(unsigned*)ptr[i] = cvt_pk_bf16(n1.x, n1.y); *(unsigned*)(ptr[i] + 32) = cvt_pk_bf16(n2.x, n2.y); }
    }
  }
}
__device__ __forceinline__ void attn_phase(const Params& P, unsigned char* smem, const int tid) {
  bf16_t* Q = (bf16_t*)(P.ws + OFF_Q); const bf16_t* KB = (const bf16_t*)(P.ws + OFF_KB); const bf16_t* VB = (const bf16_t*)(P.ws + OFF_VB);
  for (int u = P.bid; u < 2048; u += P.grd) {
    const int xcd = u & 7, slot = (u >> 3) & 31, rnd = u >> 8, pair = xcd + 8 * (rnd >> 2), w = (rnd & 3) * 32 + slot;
    const int b = pair >> 2, kvh = pair & 3, g = w & 3, qb = w >> 2, head = kvh * 4 + g;
    bf16_t* Qb = Q + (size_t)(b * SEQ + qb * 256) * DM + head * 128;
    const bf16_t* Kh = KB + (size_t)b * SKV * 512 + kvh * 128; const bf16_t* Vh = VB + (size_t)b * SKV * 512 + kvh * 128;
    att::attn_dense_body(Qb, Kh, Vh, Qb, SKV, (char*)smem, tid);
    __syncthreads();
  }
}
__device__ __forceinline__ void final_norm_phase(const Params& P, const int tid) {
  const int wid = tid >> 6, lane = tid & 63;
  const int gw = P.bid * 8 + wid, NGW = P.grd * 8;
  f32x4 g4[8];
#pragma unroll
  for (int j = 0; j < 8; ++j) g4[j] = *(const f32x4*)(P.norm_final + j * 256 + lane * 4);
  for (int r = gw; r < MT; r += NGW) {
    float* xr = P.out + (size_t)r * DM;
    f32x4 v[8]; float ss = 0.f;
#pragma unroll
    for (int j = 0; j < 8; ++j) v[j] = *(const f32x4*)(xr + j * 256 + lane * 4);
#pragma unroll
    for (int j = 0; j < 8; ++j) ss += v[j].x * v[j].x + v[j].y * v[j].y + v[j].z * v[j].z + v[j].w * v[j].w;
    ss = wave_sum(ss);
    const float rs = rsqrtf(ss * (1.f / DM) + 1e-6f);
#pragma unroll
    for (int j = 0; j < 8; ++j) *(f32x4*)(xr + j * 256 + lane * 4) = v[j] * rs * g4[j];
  }
}


#define XB_TMO      128
#define XB_XCNT(j)  (256  + 64 * (j))
#define XB_XSUB(j)  (1280 + 64 * (j))
#define XB_XGEN(j)  (2304 + 64 * (j))
#define XB_TOP      3328
#define XB_TOPGEN   3392
#define XCD_BAR_WORDS 3456
#define XB_SPIN_CAP (1u << 18)
__device__ __forceinline__ unsigned xb_ld(unsigned* p)              { return __hip_atomic_load(p, __ATOMIC_RELAXED, __HIP_MEMORY_SCOPE_AGENT); }
__device__ __forceinline__ unsigned xb_add(unsigned* p, unsigned v) { return __hip_atomic_fetch_add(p, v, __ATOMIC_RELAXED, __HIP_MEMORY_SCOPE_AGENT); }
__device__ __forceinline__ unsigned xb_xcc_id() { return (unsigned)__builtin_amdgcn_s_getreg((3 << 11) | 20) & 0xFu; }
#define XB_SPIN(cond, bar) do { unsigned _sp = 0; while (cond) { __builtin_amdgcn_s_sleep(1); \
    if ((++_sp & 255u) == 0u) { if (xb_ld(&(bar)[XB_TMO])) break; if (_sp > XB_SPIN_CAP) { atomicAdd(&(bar)[XB_TMO], 1u); break; } } } } while (0)
__device__ __forceinline__ void xcd_barrier_complete(unsigned* bar, unsigned x, unsigned& nloc, unsigned& nx) {
    const unsigned G = gridDim.x * gridDim.y * gridDim.z;
    unsigned sum, cnt, mine, sp = 0u;
    for (;;) {
        sum = 0u; cnt = 0u; mine = 0u;
#pragma unroll
        for (unsigned j = 0; j < 16; ++j) { const unsigned c = xb_ld(&bar[XB_XCNT(j)]); sum += c; cnt += (c > 0u) ? 1u : 0u; mine = (j == x) ? c : mine; }
        if (sum == G) break;
        __builtin_amdgcn_s_sleep(1);
        if ((++sp & 255u) == 0u) { if (xb_ld(&bar[XB_TMO])) break; if (sp > XB_SPIN_CAP) { atomicAdd(&bar[XB_TMO], 1u); break; } }
    }
    nloc = mine > 0u ? mine : 1u; nx = cnt > 0u ? cnt : 1u;
}
__device__ __forceinline__ void xcd_barrier(unsigned* bar, volatile LAS unsigned* st) {
    asm volatile("s_waitcnt vmcnt(0)" ::: "memory");
    __syncthreads();
    if (threadIdx.x == 0) {
        __builtin_amdgcn_s_waitcnt(0);
        const unsigned x = xb_xcc_id();
        unsigned nloc = st[0], nx = st[1];
        if (nloc == 0u) { xcd_barrier_complete(bar, x, nloc, nx); st[0] = nloc; st[1] = nx; }
        const unsigned old = xb_add(&bar[XB_XSUB(x)], 1u);
        const unsigned gen = old / nloc;
        if (old + 1u == (gen + 1u) * nloc) {
            __builtin_amdgcn_fence(__ATOMIC_RELEASE, "agent");
            asm volatile("s_waitcnt vmcnt(0)" ::: "memory");
            const unsigned og = xb_add(&bar[XB_TOP], 1u);
            const unsigned tg = og / nx;
            if (og + 1u == (tg + 1u) * nx) xb_add(&bar[XB_TOPGEN], 1u);
            else XB_SPIN(xb_ld(&bar[XB_TOPGEN]) == tg, bar);
            __builtin_amdgcn_fence(__ATOMIC_ACQUIRE, "agent");
            xb_add(&bar[XB_XGEN(x)], 1u);
            asm volatile("s_waitcnt vmcnt(0)" ::: "memory");
        } else {
            XB_SPIN(xb_ld(&bar[XB_XGEN(x)]) == gen, bar);
            __builtin_amdgcn_fence(__ATOMIC_ACQUIRE, "agent");
            asm volatile("s_waitcnt vmcnt(0)" ::: "memory");
        }
    }
    __syncthreads();
}

constexpr int NPH = 20;
__device__ __forceinline__ bool gemm_desc(int ph, const Params& P, GemmDesc& d) {
  unsigned char* ws = P.ws;
  const bf16_t* H = (const bf16_t*)(ws + OFF_H);
  d.a_tiled = 0; d.nt0 = 0; d.nt1 = 0; d.ksplit1 = 1; d.G = P.grd; d.c = P.bid; d.A1 = nullptr; d.B1 = nullptr; d.pm01 = 0; d.nN1 = 1; d.n1 = 0; d.pm00 = 0; d.xin = nullptr; d.gidx = 0; d.gscale = 0.f; d.act = nullptr;
  switch (ph) {
  case 2: d.K = 2048; d.mode = M_SWIGLU; d.A0 = H; d.B0 = (const bf16_t*)(ws + OFF_W1A); d.nM0 = 132; d.nN0 = 44; d.act = (bf16_t*)(ws + OFF_ACT); break;
  case 3: d.a_tiled = 1; d.K = DFF; d.mode = M_RESID; d.A0 = (const bf16_t*)(ws + OFF_ACT); d.B0 = (const bf16_t*)(ws + OFF_W1B); d.nM0 = 128; d.nN0 = 8; d.xin = P.x; d.gidx = 2; d.gscale = 0.5f;
          d.A1 = d.A0; d.B1 = d.B0; d.pm01 = 128; d.nN1 = 8; d.ksplit1 = 4; d.nt1 = 22; d.n1 = 4 * 8 * 4; break;
  case 5: d.K = 2048; d.mode = M_RW; d.A0 = H; d.B0 = (const bf16_t*)(ws + OFF_WRW); d.nM0 = 132; d.nN0 = 14;
          d.A1 = H; d.B1 = (const bf16_t*)(ws + OFF_WQKVG) + (size_t)2048 * 2048; d.pm01 = 128; d.nN1 = 4; d.n1 = 16; break;
  case 7: d.K = 384; d.mode = M_LORA; d.A0 = (const bf16_t*)(ws + OFF_LIN); d.B0 = (const bf16_t*)(ws + OFF_WLORA); d.nM0 = 132; d.nN0 = 20; break;
  case 10: d.K = 2048; d.mode = M_QKVG; d.A0 = H; d.B0 = (const bf16_t*)(ws + OFF_WQKVG); d.nM0 = 128; d.nN0 = 28; break;
  case 13: d.K = 2048; d.mode = M_T1; d.A0 = (const bf16_t*)(ws + OFF_Q); d.B0 = (const bf16_t*)(ws + OFF_WOA); d.nM0 = 128; d.nN0 = 8; break;
  case 14: d.K = 1024; d.mode = M_M; d.A0 = (const bf16_t*)(ws + OFF_Y); d.B0 = (const bf16_t*)(ws + OFF_WOR); d.nM0 = 128; d.nN0 = 8; break;
  case 15: d.K = 2048; d.mode = M_RESID; d.A0 = (const bf16_t*)(ws + OFF_GR); d.B0 = (const bf16_t*)(ws + OFF_WOUT); d.nM0 = 128; d.nN0 = 8; d.xin = P.out; d.gidx = 5; d.gscale = 1.f; break;
  case 17: d.K = 2048; d.mode = M_SWIGLU; d.A0 = H; d.B0 = (const bf16_t*)(ws + OFF_W2A); d.nM0 = 128; d.nN0 = 44; d.act = (bf16_t*)(ws + OFF_ACT); break;
  case 18: d.a_tiled = 1; d.K = DFF; d.mode = M_RESID; d.A0 = (const bf16_t*)(ws + OFF_ACT); d.B0 = (const bf16_t*)(ws + OFF_W2B); d.nM0 = 128; d.nN0 = 8; d.xin = P.out; d.gidx = 8; d.gscale = 0.5f; break;
  default: return false;
  }
  d.n0 = d.nM0 * d.nN0;
  if (!d.nt0) d.nt0 = d.K / BK;
  if (!d.nt1) d.nt1 = d.K / BK;
  if (d.mode == M_LORA) d.nt0 = 2;
  return true;
}

__global__ void __launch_bounds__(512) mega_fwd(Params P) {
  extern __shared__ __attribute__((aligned(16))) unsigned char smem[];
  LAS unsigned char* lds = (LAS unsigned char*)smem;
  cg::grid_group grid = cg::this_grid();
  volatile LAS unsigned* bst = (volatile LAS unsigned*)(lds + LDS_BYTES + 192);
  unsigned* gbar = (unsigned*)(P.ws + OFF_BAR);
#if ONE_LAUNCH
  if (threadIdx.x == 0) { bst[0] = 0u; bst[1] = 0u; (void)xb_add(&gbar[XB_XCNT(xb_xcc_id())], 1u); }
  __syncthreads();
#endif
#pragma nounroll
  for (int ph = P.ph_lo; ph < P.ph_hi; ++ph) {
    GemmDesc d;
    int tid = threadIdx.x; asm volatile("" : "+v"(tid));
#if PROBE
    if (blockIdx.x == 0 && tid == 0) ((LAS unsigned long long*)(lds + LDS_BYTES))[ph] = __builtin_amdgcn_s_memrealtime();
#endif
    const __attribute__((address_space(4))) Params* kp = (const __attribute__((address_space(4))) Params*)__builtin_amdgcn_kernarg_segment_ptr();
    asm volatile("" : "+s"(kp));
#if defined(__HIP_DEVICE_COMPILE__)
    Params L = *kp;
#else
    Params L = P;
#endif
    { int b_ = blockIdx.x, g_ = gridDim.x; asm volatile("" : "+s"(b_), "+s"(g_)); L.bid = b_; L.grd = g_; }
    if (gemm_desc(ph, L, d)) gemm_phase(lds, d, L, tid);
    else switch (ph) {
      case 0: mod_phase(L, lds, tid); __syncthreads(); convert_phase(L, lds, tid); break;
      case 1: norm_mod_phase(L, L.x, L.ctx, MA, L.norm_ffn1, 0, nullptr, tid); break;
      case 4: norm_mod_phase(L, L.out, L.ctx, MA, L.norm_mix, 3, (const float*)(L.ws + OFF_PART), tid); break;
      case 6: shift_phase(L, tid); break;
      case 8: scan_phase(L, lds, tid); break;
      case 9: rwkv_out_phase(L, tid); break;
      case 11: rope_phase(L, tid); break;
      case 12: attn_phase(L, smem, tid); break;
      case 16: norm_mod_phase(L, L.out, nullptr, MT, L.norm_ffn2, 6, nullptr, tid); break;
      case 19: final_norm_phase(L, tid); break;
      default: break;
    }
    if (ph + 1 < P.ph_hi) { if (ph == 0) grid.sync(); else if (ph != 13 || !ONE_LAUNCH) xcd_barrier(gbar, bst); }
  }
#if PROBE
  grid.sync();
  if (blockIdx.x == 0) {
    LAS unsigned long long* TS = (LAS unsigned long long*)(lds + LDS_BYTES);
    if (threadIdx.x == 0) TS[NPH] = __builtin_amdgcn_s_memrealtime();
    __syncthreads();
    const int K = (int)((TS[PROBE_HI] - TS[PROBE_LO]) / 100ull);
    int t2 = threadIdx.x; asm volatile("" : "+v"(t2));
    for (int i = t2; i < K && i < 16000; i += 512) P.out[(size_t)i * 4099] += 0.1f;
  }
#endif
}

extern "C" void kernel_launch(void* const* d_in, const int* in_sizes, int n_in, void* d_out, int out_size, void* d_ws, size_t ws_size, hipStream_t stream) {
  static int grid_blocks = 0;
  if (!grid_blocks) {
    if (n_in != 31 || out_size != MT * DM || ws_size < WS_TOTAL) { fprintf(stderr, "kernel_launch: unexpected shapes n_in %d out %d ws %zu (need %zu)\n", n_in, out_size, ws_size, WS_TOTAL); return; }
    if (hipFuncSetAttribute((const void*)mega_fwd, hipFuncAttributeMaxDynamicSharedMemorySize, LDS_BYTES + 256) != hipSuccess) { fprintf(stderr, "kernel_launch: hipFuncSetAttribute failed\n"); return; }
    int dev = 0, cus = 0, per_cu = 0;
    hipGetDevice(&dev);
    hipDeviceGetAttribute(&cus, hipDeviceAttributeMultiprocessorCount, dev);
    hipOccupancyMaxActiveBlocksPerMultiprocessor(&per_cu, mega_fwd, 512, LDS_BYTES + 256);
    if (per_cu < 1) { fprintf(stderr, "kernel_launch: occupancy query returned %d\n", per_cu); per_cu = 1; }
    grid_blocks = cus;
  }
  Params p{};
  const float** pf = (const float**)&p;
  for (int i = 0; i < 31; ++i) pf[i] = (const float*)d_in[i];
  p.out = (float*)d_out; p.ws = (unsigned char*)d_ws; p.bid = 0; p.grd = 0;
#if ONE_LAUNCH
  p.ph_lo = 0; p.ph_hi = NPH;
  if (hipMemsetAsync((char*)d_ws + OFF_BAR, 0, 3456 * 4, stream) != hipSuccess) { fprintf(stderr, "kernel_launch: memset of barrier words failed\n"); return; }
  void* args[] = {&p};
  hipError_t e = hipLaunchCooperativeKernel((const void*)mega_fwd, dim3(grid_blocks), dim3(512), args, LDS_BYTES + 256, stream);
  if (e != hipSuccess) fprintf(stderr, "cooperative launch failed: %s (grid %d)\n", hipGetErrorString(e), grid_blocks);
#else
  for (int ph = 0; ph < NPH; ++ph) { p.ph_lo = ph; p.ph_hi = ph + 1; hipLaunchKernelGGL(mega_fwd, dim3(grid_blocks), dim3(512), LDS_BYTES + 256, stream, p); }
#endif
}
```
